# Optimizing an MI355X kernel written in HIP

```python
import math
import jax, jax.numpy as jnp
from jax import lax
import numpy as np


D_MODEL = 2048
BATCH = 4
SEQ = 4096
DEPTH = 4

GRID_W = 64
CTX_LEN = 256
N_MIXERS = 3
N_RG_LAYERS = (DEPTH + N_MIXERS - 1) // N_MIXERS
N_RW_LAYERS = (DEPTH + N_MIXERS - 2) // N_MIXERS
N_RET_LAYERS = DEPTH // N_MIXERS
DEEPNORM_ALPHA = (2 * DEPTH) ** 0.25
DEEPNORM_BETA = (8 * DEPTH) ** -0.25
LN_EPS = 1e-5

D_RNN = D_MODEL
RG_BLOCKS = 8
RG_BLOCK = D_RNN // RG_BLOCKS
CONV_W = 4
RG_C = 8.0

RW_HEAD = 64
RW_HEADS = D_MODEL // RW_HEAD
RW_DECAY_LORA = 96
RW_ICL_LORA = 96
RW_GATE_LORA = 256
RW_DECAY_SCALE = math.exp(-0.5)
RW_GN_EPS = 64e-5

RET_HEADS = 8
RET_DK = D_MODEL // RET_HEADS
RET_DV = 2 * RET_DK
RET_CHUNK = 128
RET_QK = RET_HEADS * RET_DK
RET_V = RET_HEADS * RET_DV
RET_IN = 2 * RET_QK + 3 * RET_V

N_KEYS = 128
N_EXPERTS = N_KEYS * N_KEYS
PEER_HEADS = 8
PEER_DKEY = 256
PEER_DHALF = PEER_DKEY // 2
PEER_TOPK = 16
PEER_BLOCK = 128

kernel_name = 'hybrid_rglru_rwkv7_retention_peer_dit'


def layer_norm(x, g, b):
    xf = x.astype(jnp.float32)
    mu = jnp.mean(xf, -1, keepdims=True)
    var = jnp.mean(jnp.square(xf - mu), -1, keepdims=True)
    return ((xf - mu) * lax.rsqrt(var + LN_EPS)).astype(x.dtype) * g + b


def head_norm(y, eps):
    yf = y.astype(jnp.float32)
    mu = jnp.mean(yf, -1, keepdims=True)
    var = jnp.mean(jnp.square(yf - mu), -1, keepdims=True)
    return ((yf - mu) * lax.rsqrt(var + eps)).astype(y.dtype)


def l2_normalize(t):
    tf = t.astype(jnp.float32)
    return (tf * lax.rsqrt(jnp.sum(tf * tf, -1, keepdims=True) + 1e-12)).astype(t.dtype)


def adaln_mod(cvec, w, b):
    return jnp.split(jax.nn.silu(cvec) @ w + b, 6, axis=-1)


def modulate(x, shift, scale):
    return x * (1.0 + scale) + shift


def q_shift(x):
    Bn, L, D = x.shape
    rows = L // GRID_W
    g = x.reshape(Bn, rows, GRID_W, D)
    q = D // 4
    left = jnp.pad(g[:, :, :-1, :q], ((0, 0), (0, 0), (1, 0), (0, 0)))
    right = jnp.pad(g[:, :, 1:, q:2 * q], ((0, 0), (0, 0), (0, 1), (0, 0)))
    up = jnp.pad(g[:, :-1, :, 2 * q:3 * q], ((0, 0), (1, 0), (0, 0), (0, 0)))
    down = jnp.pad(g[:, 1:, :, 3 * q:], ((0, 0), (0, 1), (0, 0), (0, 0)))
    return jnp.concatenate([left, right, up, down], -1).reshape(Bn, L, D)


def seq_shift(x):
    h = x.shape[-1] // 2
    prev = jnp.pad(x[:, :-1, :h], ((0, 0), (1, 0), (0, 0)))
    nxt = jnp.pad(x[:, 1:, h:], ((0, 0), (0, 1), (0, 0)))
    return jnp.concatenate([prev, nxt], -1)


def depthwise_conv_centred(x, w, b):
    L = x.shape[1]
    xp = jnp.pad(x, ((0, 0), (CONV_W // 2, CONV_W - 1 - CONV_W // 2), (0, 0)))
    return sum(xp[:, j:j + L] * w[j] for j in range(CONV_W)) + b


def linear_scan(a, b, h0, reverse):
    def op(l, r):
        return (l[0] * r[0], r[0] * l[1] + r[1])
    A, h = lax.associative_scan(op, (a, b), axis=1, reverse=reverse)
    return h if h0 is None else h + A * h0[:, None, :]


def rglru_coeffs(xc, gate_w, gate_b, lam):
    Bn, L, _ = xc.shape
    xb = xc.reshape(Bn, L, RG_BLOCKS, RG_BLOCK)
    pre = jnp.einsum('blnk,gnkj->gblnj', xb, gate_w).reshape(2, Bn, L, D_RNN) + gate_b[:, None, None, :]
    r_gate = jax.nn.sigmoid(pre[0])
    i_gate = jax.nn.sigmoid(pre[1])
    log_a = -RG_C * r_gate * jax.nn.softplus(-lam)
    a = jnp.exp(log_a)
    b = jnp.sqrt(-jnp.expm1(2.0 * log_a)) * (i_gate * xc)
    return a, b


def rglru_mixer(h_ctx, h_lat, w_in, conv_w, conv_b, gate_w, gate_b, lam, w_out, ctx_out):
    u_l = h_lat @ w_in
    xc_l = depthwise_conv_centred(u_l[..., D_RNN:], conv_w, conv_b)
    u_c = h_ctx @ (w_in if ctx_out else w_in[:, D_RNN:])
    xc_c = depthwise_conv_centred(u_c[..., -D_RNN:], conv_w, conv_b)
    rec_c, rec_l = [], []
    for d, rev in enumerate((False, True)):
        a_c, b_c = rglru_coeffs(xc_c, gate_w[d], gate_b[d], lam[d])
        h_c = linear_scan(a_c, b_c, None, rev)
        a_l, b_l = rglru_coeffs(xc_l, gate_w[d], gate_b[d], lam[d])
        rec_l.append(linear_scan(a_l, b_l, h_c[:, 0] if rev else h_c[:, -1], rev))
        rec_c.append(h_c)
    y_l = (jax.nn.gelu(u_l[..., :D_RNN]) * (rec_l[0] + rec_l[1])) @ w_out
    y_c = (jax.nn.gelu(u_c[..., :D_RNN]) * (rec_c[0] + rec_c[1])) @ w_out if ctx_out else None
    return y_c, y_l


def rw_heads(t):
    return t.reshape(t.shape[:-1] + (RW_HEADS, RW_HEAD))


def rwkv7_scan(r, v, kk, w, k, a, S0, reverse):
    def step(S, inp):
        r_t, v_t, kk_t, w_t, k_t, a_t = inp
        S = (S * w_t[:, :, None, :]
             - jnp.einsum('bhvk,bhk->bhv', S, kk_t)[..., None] * (kk_t * a_t)[:, :, None, :]
             + v_t[..., None] * k_t[:, :, None, :])
        return S, jnp.einsum('bhvk,bhk->bhv', S, r_t)
    xs = tuple(jnp.moveaxis(t, 1, 0) for t in (r, v, kk, w, k, a))
    S_end, y = lax.scan(step, S0, xs, reverse=reverse)
    return S_end, jnp.moveaxis(y, 0, 1)


def rwkv7_mixer(h_ctx, h_lat, mu, w_rkv, w_o, dec0, dec1, dec2, icl0, icl1, icl2,
                g1, g2, k_k, k_a, r_k, gn_g, gn_b, ctx_out):
    def project(h, shifted):
        xx = shifted - h
        mix = lambda m: h + xx * mu[m]
        r = mix(0) @ w_rkv[0]
        k = mix(1) @ w_rkv[1]
        v = mix(2) @ w_rkv[2]
        xw, xa = mix(3), mix(4)
        kk = l2_normalize(rw_heads(k * k_k))
        dirs = []
        for d in range(2):
            w = jnp.exp(-RW_DECAY_SCALE * jax.nn.sigmoid(dec0[d] + jnp.tanh(xw @ dec1[d]) @ dec2[d]))
            a = jax.nn.sigmoid(icl0[d] + (xa @ icl1[d]) @ icl2[d])
            kd = k * (1.0 + (a - 1.0) * k_a)
            dirs.append((rw_heads(w), rw_heads(kd), rw_heads(a)))
        return rw_heads(r), rw_heads(v), kk, dirs, h, xx

    def finish(p, ys):
        r, v, kk, dirs, h, xx = p
        Bn, L = r.shape[:2]
        y = head_norm(ys[0] + ys[1], RW_GN_EPS).reshape(Bn, L, D_MODEL) * gn_g + gn_b
        bonus = sum(jnp.sum(r * kd * r_k, -1, keepdims=True) * v for (_, kd, _) in dirs)
        g = jax.nn.sigmoid((h + xx * mu[5]) @ g1) @ g2
        return ((y + bonus.reshape(Bn, L, D_MODEL)) * g) @ w_o

    pc = project(h_ctx, seq_shift(h_ctx))
    pl = project(h_lat, q_shift(h_lat))
    S0 = jnp.zeros((h_lat.shape[0], RW_HEADS, RW_HEAD, RW_HEAD), h_lat.dtype)
    ys_c, ys_l = [], []
    for d, rev in enumerate((False, True)):
        S_ctx, yc = rwkv7_scan(pc[0], pc[1], pc[2], *pc[3][d], S0, rev)
        _, yl = rwkv7_scan(pl[0], pl[1], pl[2], *pl[3][d], S_ctx, rev)
        ys_c.append(yc)
        ys_l.append(yl)
    y_l = finish(pl, ys_l)
    y_c = finish(pc, ys_c) if ctx_out else None
    return y_c, y_l


def rotary(t, pos):
    half = t.shape[-1] // 2
    theta = 1.0 / (10000.0 ** jnp.linspace(0.0, 1.0, half, dtype=jnp.float32))
    ang = pos[:, None] * theta[None, :]
    cos = jnp.cos(ang)[None, :, None, :]
    sin = jnp.sin(ang)[None, :, None, :]
    t1 = t[..., :half].astype(jnp.float32)
    t2 = t[..., half:].astype(jnp.float32)
    return jnp.concatenate([t1 * cos - t2 * sin, t1 * sin + t2 * cos], -1).astype(t.dtype)


def retention_chunkwise(q, k, v, R0, log_gamma):
    Bn, H, L, _ = q.shape
    n_chunks = L // RET_CHUNK
    dt = q.dtype
    pos = jnp.arange(RET_CHUNK, dtype=jnp.float32)
    diff = pos[:, None] - pos[None, :]
    decay_mask = jnp.where(diff >= 0, jnp.exp(jnp.maximum(diff, 0.0) * log_gamma[:, None, None]), 0.0).astype(dt)
    xi = jnp.exp((pos + 1.0) * log_gamma[:, None]).astype(dt)[..., None]
    zeta = jnp.exp((RET_CHUNK - 1.0 - pos) * log_gamma[:, None]).astype(dt)[..., None]
    chunk_decay = jnp.exp(RET_CHUNK * log_gamma).astype(dt)[:, None, None]

    def chunks(t):
        return jnp.moveaxis(t.reshape(Bn, H, n_chunks, RET_CHUNK, t.shape[-1]), 2, 0)

    def step(R, qkv):
        qc, kc, vc = qkv
        scores = jnp.einsum('bhid,bhjd->bhij', qc, kc) * decay_mask
        o = jnp.einsum('bhij,bhje->bhie', scores, vc) + jnp.einsum('bhid,bhde->bhie', qc * xi, R)
        R = R * chunk_decay + jnp.einsum('bhjd,bhje->bhde', kc * zeta, vc)
        return R, o

    R, o = lax.scan(step, R0, (chunks(q), chunks(k), chunks(v)))
    return R, jnp.moveaxis(o, 0, 2).reshape(Bn, H, L, RET_DV)


def retention_mixer(h_ctx, h_lat, w_in, w_out, ctx_out):
    log_gamma = jnp.log1p(-jnp.exp2(-5.0 - jnp.arange(RET_HEADS, dtype=jnp.float32)))

    def split_heads(u, pos0):
        Bn, L, _ = u.shape
        pos = pos0 + jnp.arange(L, dtype=jnp.float32)
        q = rotary(u[..., :RET_QK].reshape(Bn, L, RET_HEADS, RET_DK), pos)
        k = rotary(u[..., RET_QK:2 * RET_QK].reshape(Bn, L, RET_HEADS, RET_DK), pos) * RET_DK ** -0.5
        v = u[..., 2 * RET_QK:2 * RET_QK + RET_V].reshape(Bn, L, RET_HEADS, RET_DV)
        return tuple(jnp.swapaxes(t, 1, 2) for t in (q, k, v))

    u_l = h_lat @ w_in
    u_c = h_ctx @ (w_in if ctx_out else w_in[:, :2 * RET_QK + RET_V])
    qc, kc, vc = split_heads(u_c, 0.0)
    ql, kl, vl = split_heads(u_l, float(CTX_LEN))
    flip = lambda t: t[:, :, ::-1]
    R0 = jnp.zeros((h_lat.shape[0], RET_HEADS, RET_DK, RET_DV), ql.dtype)
    R_f, oc_f = retention_chunkwise(qc, kc, vc, R0, log_gamma)
    _, ol_f = retention_chunkwise(ql, kl, vl, R_f, log_gamma)
    R_b, oc_b = retention_chunkwise(flip(qc), flip(kc), flip(vc), R0, log_gamma)
    _, ol_b = retention_chunkwise(flip(ql), flip(kl), flip(vl), R_b, log_gamma)

    def merge(u, o_f, o_b_rev):
        Bn, L, _ = u.shape
        g_f = u[..., 2 * RET_QK + RET_V:2 * RET_QK + 2 * RET_V]
        g_b = u[..., 2 * RET_QK + 2 * RET_V:]
        n_f = jnp.swapaxes(head_norm(o_f, LN_EPS), 1, 2).reshape(Bn, L, RET_V)
        n_b = jnp.swapaxes(head_norm(flip(o_b_rev), LN_EPS), 1, 2).reshape(Bn, L, RET_V)
        return (jax.nn.silu(g_f) * n_f + jax.nn.silu(g_b) * n_b) @ w_out

    y_l = merge(u_l, ol_f, ol_b)
    y_c = merge(u_c, oc_f, oc_b) if ctx_out else None
    return y_c, y_l


def peer_ffn(tok, w_q, sub_keys, u_tab, v_tab):
    T, D = tok.shape

    def block(xb):
        q = (xb @ w_q).reshape(PEER_BLOCK, PEER_HEADS, 2, PEER_DHALF)
        s = jnp.einsum('thpd,hpkd->thpk', q, sub_keys)
        s_top, i_top = lax.top_k(s, PEER_TOPK)
        cand_s = (s_top[:, :, 0, :, None] + s_top[:, :, 1, None, :]).reshape(PEER_BLOCK, PEER_HEADS, PEER_TOPK * PEER_TOPK)
        cand_e = (i_top[:, :, 0, :, None] * N_KEYS + i_top[:, :, 1, None, :]).reshape(PEER_BLOCK, PEER_HEADS, PEER_TOPK * PEER_TOPK)
        best_s, best_j = lax.top_k(cand_s, PEER_TOPK)
        expert = jnp.take_along_axis(cand_e, best_j, axis=-1)
        g = jax.nn.softmax(best_s.astype(jnp.float32), axis=-1).astype(xb.dtype)
        act = jax.nn.gelu(jnp.einsum('thkd,td->thk', u_tab[expert], xb))
        return jnp.einsum('thk,thkd->td', g * act, v_tab[expert])

    return lax.map(block, tok.reshape(T // PEER_BLOCK, PEER_BLOCK, D)).reshape(T, D)


def setup_inputs(seed: int = 0) -> dict:
    key = jax.random.key(seed)
    ks = iter(jax.random.split(key, 64))
    nrm = lambda shape, std: jax.random.normal(next(ks), shape, jnp.float32) * std
    D = D_MODEL
    a_pow = jax.random.uniform(next(ks), (N_RG_LAYERS, 2, D_RNN), jnp.float32, 0.9, 0.999)
    a_base = a_pow ** (1.0 / RG_C)
    return {
        'x': nrm((BATCH, SEQ, D), 1.0),
        'c': nrm((BATCH, D), 1.0),
        'ctx': nrm((BATCH, CTX_LEN, D), 1.0),
        'c_ctx': nrm((D,), 1.0),
        'ada_w': nrm((DEPTH, D, 6 * D), D ** -0.5),
        'ada_b': nrm((DEPTH, 6 * D), 0.02),
        'ln_g': 1.0 + nrm((DEPTH, 2, D), 0.02),
        'ln_b': nrm((DEPTH, 2, D), 0.02),
        'peer_wq': nrm((DEPTH, D, PEER_HEADS * PEER_DKEY), D ** -0.5),
        'peer_keys': nrm((DEPTH, PEER_HEADS, 2, N_KEYS, PEER_DHALF), PEER_DHALF ** -0.5),
        'peer_u': nrm((DEPTH, N_EXPERTS, D), D ** -0.5),
        'peer_v': nrm((DEPTH, N_EXPERTS, D), DEEPNORM_BETA * PEER_HEADS ** -0.5),
        'rg_w_in': nrm((N_RG_LAYERS, D, 2 * D_RNN), D ** -0.5),
        'rg_conv_w': nrm((N_RG_LAYERS, CONV_W, D_RNN), CONV_W ** -0.5),
        'rg_conv_b': nrm((N_RG_LAYERS, D_RNN), 0.02),
        'rg_gate_w': nrm((N_RG_LAYERS, 2, 2, RG_BLOCKS, RG_BLOCK, RG_BLOCK), RG_BLOCK ** -0.5),
        'rg_gate_b': nrm((N_RG_LAYERS, 2, 2, D_RNN), 0.02),
        'rg_lam': jnp.log(a_base) - jnp.log1p(-a_base),
        'rg_w_out': nrm((N_RG_LAYERS, D_RNN, D), DEEPNORM_BETA * D_RNN ** -0.5),
        'rw_mu': jax.random.uniform(next(ks), (N_RW_LAYERS, 6, D), jnp.float32),
        'rw_w_rkv': nrm((N_RW_LAYERS, 3, D, D), D ** -0.5),
        'rw_w_o': nrm((N_RW_LAYERS, D, D), DEEPNORM_BETA * D ** -0.5),
        'rw_dec0': nrm((N_RW_LAYERS, 2, D), 1.0),
        'rw_dec1': nrm((N_RW_LAYERS, 2, D, RW_DECAY_LORA), D ** -0.5),
        'rw_dec2': nrm((N_RW_LAYERS, 2, RW_DECAY_LORA, D), 0.1 * RW_DECAY_LORA ** -0.5),
        'rw_icl0': nrm((N_RW_LAYERS, 2, D), 0.5),
        'rw_icl1': nrm((N_RW_LAYERS, 2, D, RW_ICL_LORA), D ** -0.5),
        'rw_icl2': nrm((N_RW_LAYERS, 2, RW_ICL_LORA, D), 0.1 * RW_ICL_LORA ** -0.5),
        'rw_g1': nrm((N_RW_LAYERS, D, RW_GATE_LORA), D ** -0.5),
        'rw_g2': nrm((N_RW_LAYERS, RW_GATE_LORA, D), RW_GATE_LORA ** -0.5),
        'rw_k_k': 0.85 + nrm((N_RW_LAYERS, D), 0.02),
        'rw_k_a': 1.0 + nrm((N_RW_LAYERS, D), 0.02),
        'rw_r_k': nrm((N_RW_LAYERS, RW_HEADS, RW_HEAD), 0.1),
        'rw_gn_g': 1.0 + nrm((N_RW_LAYERS, D), 0.02),
        'rw_gn_b': nrm((N_RW_LAYERS, D), 0.02),
        'ret_w_in': nrm((N_RET_LAYERS, D, RET_IN), D ** -0.5),
        'ret_w_out': nrm((N_RET_LAYERS, RET_V, D), DEEPNORM_BETA * RET_V ** -0.5),
    }


def reference(x, c, ctx, c_ctx, ada_w, ada_b, ln_g, ln_b,
              peer_wq, peer_keys, peer_u, peer_v,
              rg_w_in, rg_conv_w, rg_conv_b, rg_gate_w, rg_gate_b, rg_lam, rg_w_out,
              rw_mu, rw_w_rkv, rw_w_o, rw_dec0, rw_dec1, rw_dec2, rw_icl0, rw_icl1, rw_icl2,
              rw_g1, rw_g2, rw_k_k, rw_k_a, rw_r_k, rw_gn_g, rw_gn_b,
              ret_w_in, ret_w_out):
    x_lat, x_ctx = x, ctx
    for i in range(DEPTH):
        kind, j = i % N_MIXERS, i // N_MIXERS
        last = i == DEPTH - 1
        mod_l = adaln_mod(c[:, None, :], ada_w[i], ada_b[i])
        mod_c = adaln_mod(c_ctx, ada_w[i], ada_b[i])
        h_c = modulate(x_ctx, mod_c[0], mod_c[1])
        h_l = modulate(x_lat, mod_l[0], mod_l[1])
        if kind == 0:
            y_c, y_l = rglru_mixer(h_c, h_l, rg_w_in[j], rg_conv_w[j], rg_conv_b[j], rg_gate_w[j],
                                   rg_gate_b[j], rg_lam[j], rg_w_out[j], not last)
        elif kind == 1:
            y_c, y_l = rwkv7_mixer(h_c, h_l, rw_mu[j], rw_w_rkv[j], rw_w_o[j], rw_dec0[j], rw_dec1[j],
                                   rw_dec2[j], rw_icl0[j], rw_icl1[j], rw_icl2[j], rw_g1[j], rw_g2[j],
                                   rw_k_k[j], rw_k_a[j], rw_r_k[j], rw_gn_g[j], rw_gn_b[j], not last)
        else:
            y_c, y_l = retention_mixer(h_c, h_l, ret_w_in[j], ret_w_out[j], not last)
        x_lat = layer_norm(DEEPNORM_ALPHA * x_lat + mod_l[2] * y_l, ln_g[i, 0], ln_b[i, 0])
        h_l = modulate(x_lat, mod_l[3], mod_l[4])
        if last:
            y_l = peer_ffn(h_l.reshape(-1, D_MODEL), peer_wq[i], peer_keys[i], peer_u[i], peer_v[i]).reshape(x_lat.shape)
        else:
            x_ctx = layer_norm(DEEPNORM_ALPHA * x_ctx + mod_c[2] * y_c, ln_g[i, 0], ln_b[i, 0])
            h_c = modulate(x_ctx, mod_c[3], mod_c[4])
            n_ctx_tok = h_c.shape[0] * h_c.shape[1]
            y = peer_ffn(jnp.concatenate([h_c.reshape(-1, D_MODEL), h_l.reshape(-1, D_MODEL)], 0),
                         peer_wq[i], peer_keys[i], peer_u[i], peer_v[i])
            y_c = y[:n_ctx_tok].reshape(x_ctx.shape)
            y_l = y[n_ctx_tok:].reshape(x_lat.shape)
            x_ctx = layer_norm(DEEPNORM_ALPHA * x_ctx + mod_c[5] * y_c, ln_g[i, 1], ln_b[i, 1])
        x_lat = layer_norm(DEEPNORM_ALPHA * x_lat + mod_l[5] * y_l, ln_g[i, 1], ln_b[i, 1])
    return x_lat
```

```cpp
#include <hip/hip_runtime.h>
#include <cstdio>
#include <cstring>

#define LAS __attribute__((address_space(3)))
typedef unsigned short bf16_t;
typedef short bf16x8 __attribute__((ext_vector_type(8)));
typedef float f32x4 __attribute__((ext_vector_type(4)));
typedef float f32x2 __attribute__((ext_vector_type(2)));
typedef unsigned u32x4 __attribute__((ext_vector_type(4)));
typedef unsigned u32x2 __attribute__((ext_vector_type(2)));
typedef __bf16 bf16v2 __attribute__((ext_vector_type(2)));

#ifndef DBG_ZERO
#define DBG_ZERO 0
#endif
#ifndef PROBE
#define PROBE 0
#endif
#define PROBE_REP(bit) for (int _rep = 0; _rep < (((PROBE) >> (bit)) & 1) + 1; ++_rep)
constexpr int D = 2048, NBATCH = 4, SEQ = 4096, CTX = 256;
constexpr int NCTX = NBATCH * CTX, NLAT = NBATCH * SEQ, T = NCTX + NLAT;
constexpr int SLEN = CTX + SEQ;
constexpr float ALPHA = 1.681792830507429f;
constexpr float LN_EPS = 1e-5f;
constexpr size_t TD = (size_t)T * D;

constexpr size_t MiB = 1u << 20;
constexpr size_t WS_CTL = 0, CTL_BYTES = 1 * MiB;
constexpr size_t WS_MODP = 2 * MiB;
constexpr size_t WS_MOD = 10 * MiB;
constexpr size_t WS_CS = 11 * MiB;
constexpr size_t WS_SPT = 15 * MiB + 512 * 1024;
constexpr size_t WS_CA = 16 * MiB, WS_CH = 21 * MiB, WS_CIN = 26 * MiB;
constexpr size_t WS_WQ = 32 * MiB;
constexpr size_t WS_KEYS = 64 * MiB;
constexpr size_t WS_RGIN = 68 * MiB;
constexpr size_t WS_RGGATE = 100 * MiB;
constexpr size_t WS_RGOUT = 108 * MiB;
constexpr size_t WS_RW1 = 124 * MiB;
constexpr size_t WS_RW2 = 152 * MiB;
constexpr size_t WS_RWO = 160 * MiB;
constexpr size_t WS_RETIN = 168 * MiB;
constexpr size_t WS_RETOUT = 232 * MiB;
constexpr size_t WS_PU = 256 * MiB;
constexpr size_t WS_PV = 384 * MiB;
constexpr size_t WS_PSC = 512 * MiB;
constexpr size_t WS_X = 768 * MiB;
constexpr size_t WS_A0 = 904 * MiB;
constexpr size_t WS_H2 = 972 * MiB;
constexpr size_t WS_Q = 1040 * MiB;
constexpr size_t WS_WQN = 1040 * MiB;
constexpr size_t WS_S = 1108 * MiB;
constexpr size_t WS_L = 1244 * MiB;
constexpr size_t WS_SELW = 1893 * MiB;
constexpr size_t WS_END = 1902 * MiB;
constexpr size_t P_SE16 = WS_L + 288 * MiB;
constexpr size_t P_PART = WS_L, P_Y = WS_L + 136 * MiB, P_C = WS_L + 272 * MiB;
constexpr int CW_PQ = 16384;
constexpr size_t L_UG = WS_L, L_UR = WS_L + 68 * MiB, L_XC = WS_L + 136 * MiB, L_LA = WS_L + 204 * MiB, L_BB = WS_L + 340 * MiB, L_YIN = WS_L + 476 * MiB;
constexpr size_t L_AALL = WS_L;
constexpr size_t L_W = WS_L, L_AD = WS_L + 136 * MiB, L_G = WS_L + 272 * MiB;
constexpr size_t L_RKV = WS_L + 408 * MiB;
constexpr size_t L_A2 = WS_L + 612 * MiB;
constexpr size_t L_Y0 = WS_H2, L_Y1 = WS_H2 + 136 * MiB;
constexpr size_t L_Z = WS_A0;
constexpr size_t L_RQ = WS_L, L_RK = WS_L + 68 * MiB, L_RV = WS_L + 136 * MiB, L_GF = WS_L + 272 * MiB, L_GB = WS_L + 408 * MiB;
constexpr size_t L_OF = WS_H2, L_OB = WS_H2 + 136 * MiB;
constexpr size_t L_RZ = WS_L;

__device__ __forceinline__ float bf2f(unsigned b) { return __uint_as_float(b << 16); }
__device__ __forceinline__ unsigned cvt_pk_bf16(float lo, float hi) { bf16v2 t; t.x = (__bf16)lo; t.y = (__bf16)hi; return __builtin_bit_cast(unsigned, t); }
__device__ __forceinline__ float bflo(unsigned u) { return __uint_as_float(u << 16); }
__device__ __forceinline__ float bfhi(unsigned u) { return __uint_as_float(u & 0xffff0000u); }
__device__ __forceinline__ float sigmoidf_(float x) { return 1.0f / (1.0f + __expf(-x)); }
__device__ __forceinline__ float siluf_(float x) { return x / (1.0f + __expf(-x)); }
__device__ __forceinline__ float tanhf_(float x) { return 1.0f - 2.0f / (1.0f + __expf(2.0f * x)); }
__device__ __forceinline__ float gelu_tanh(float x) { const float z = 1.5957691216057308f * (x + 0.044715f * x * x * x); return x / (1.0f + __expf(-z)); }
__device__ __forceinline__ void unpack8(const u32x4 u, float (&f)[8]) { f[0] = bflo(u.x); f[1] = bfhi(u.x); f[2] = bflo(u.y); f[3] = bfhi(u.y); f[4] = bflo(u.z); f[5] = bfhi(u.z); f[6] = bflo(u.w); f[7] = bfhi(u.w); }
template <int CTRL> __device__ __forceinline__ float dpp_mov(float v) { const int x = __builtin_bit_cast(int, v); return __builtin_bit_cast(float, __builtin_amdgcn_update_dpp(x, x, CTRL, 0xF, 0xF, false)); }
__device__ __forceinline__ float rl_f(float v, int lane) { return __builtin_bit_cast(float, __builtin_amdgcn_readlane(__builtin_bit_cast(int, v), lane)); }
__device__ __forceinline__ float sum8(float v) { v += dpp_mov<0xB1>(v); v += dpp_mov<0x4E>(v); v += dpp_mov<0x141>(v); return v; }
__device__ __forceinline__ float sum16(float v) { v = sum8(v); v += dpp_mov<0x140>(v); return v; }
__device__ __forceinline__ float fma_s(float a, float b, float c) { float d; asm("v_fma_f32 %0, %1, %2, %3" : "=v"(d) : "v"(a), "v"(b), "v"(c)); return d; }
__device__ __forceinline__ float mul_s(float a, float b) { float d; asm("v_mul_f32 %0, %1, %2" : "=v"(d) : "v"(a), "v"(b)); return d; }
__device__ __forceinline__ void sum8_pair(float& a, float& b) {
    asm volatile("s_nop 1\n\t"
        "v_add_f32_dpp %0, %0, %0 quad_perm:[1,0,3,2] row_mask:0xf bank_mask:0xf\n\tv_add_f32_dpp %1, %1, %1 quad_perm:[1,0,3,2] row_mask:0xf bank_mask:0xf\n\ts_nop 0\n\t"
        "v_add_f32_dpp %0, %0, %0 quad_perm:[2,3,0,1] row_mask:0xf bank_mask:0xf\n\tv_add_f32_dpp %1, %1, %1 quad_perm:[2,3,0,1] row_mask:0xf bank_mask:0xf\n\ts_nop 0\n\t"
        "v_add_f32_dpp %0, %0, %0 row_half_mirror row_mask:0xf bank_mask:0xf\n\tv_add_f32_dpp %1, %1, %1 row_half_mirror row_mask:0xf bank_mask:0xf"
        : "+v"(a), "+v"(b));
}
__device__ __forceinline__ void sum16_pair(float& a, float& b) {
    asm volatile("s_nop 1\n\t"
        "v_add_f32_dpp %0, %0, %0 quad_perm:[1,0,3,2] row_mask:0xf bank_mask:0xf\n\tv_add_f32_dpp %1, %1, %1 quad_perm:[1,0,3,2] row_mask:0xf bank_mask:0xf\n\ts_nop 0\n\t"
        "v_add_f32_dpp %0, %0, %0 quad_perm:[2,3,0,1] row_mask:0xf bank_mask:0xf\n\tv_add_f32_dpp %1, %1, %1 quad_perm:[2,3,0,1] row_mask:0xf bank_mask:0xf\n\ts_nop 0\n\t"
        "v_add_f32_dpp %0, %0, %0 row_half_mirror row_mask:0xf bank_mask:0xf\n\tv_add_f32_dpp %1, %1, %1 row_half_mirror row_mask:0xf bank_mask:0xf\n\ts_nop 0\n\t"
        "v_add_f32_dpp %0, %0, %0 row_mirror row_mask:0xf bank_mask:0xf\n\tv_add_f32_dpp %1, %1, %1 row_mirror row_mask:0xf bank_mask:0xf"
        : "+v"(a), "+v"(b));
}
__device__ __forceinline__ void sum16_quad(float& a, float& b, float& c, float& d) {
    asm volatile("s_nop 1\n\t"
        "v_add_f32_dpp %0, %0, %0 quad_perm:[1,0,3,2] row_mask:0xf bank_mask:0xf\n\tv_add_f32_dpp %1, %1, %1 quad_perm:[1,0,3,2] row_mask:0xf bank_mask:0xf\n\t"
        "v_add_f32_dpp %2, %2, %2 quad_perm:[1,0,3,2] row_mask:0xf bank_mask:0xf\n\tv_add_f32_dpp %3, %3, %3 quad_perm:[1,0,3,2] row_mask:0xf bank_mask:0xf\n\t"
        "v_add_f32_dpp %0, %0, %0 quad_perm:[2,3,0,1] row_mask:0xf bank_mask:0xf\n\tv_add_f32_dpp %1, %1, %1 quad_perm:[2,3,0,1] row_mask:0xf bank_mask:0xf\n\t"
        "v_add_f32_dpp %2, %2, %2 quad_perm:[2,3,0,1] row_mask:0xf bank_mask:0xf\n\tv_add_f32_dpp %3, %3, %3 quad_perm:[2,3,0,1] row_mask:0xf bank_mask:0xf\n\t"
        "v_add_f32_dpp %0, %0, %0 row_half_mirror row_mask:0xf bank_mask:0xf\n\tv_add_f32_dpp %1, %1, %1 row_half_mirror row_mask:0xf bank_mask:0xf\n\t"
        "v_add_f32_dpp %2, %2, %2 row_half_mirror row_mask:0xf bank_mask:0xf\n\tv_add_f32_dpp %3, %3, %3 row_half_mirror row_mask:0xf bank_mask:0xf\n\t"
        "v_add_f32_dpp %0, %0, %0 row_mirror row_mask:0xf bank_mask:0xf\n\tv_add_f32_dpp %1, %1, %1 row_mirror row_mask:0xf bank_mask:0xf\n\t"
        "v_add_f32_dpp %2, %2, %2 row_mirror row_mask:0xf bank_mask:0xf\n\tv_add_f32_dpp %3, %3, %3 row_mirror row_mask:0xf bank_mask:0xf"
        : "+v"(a), "+v"(b), "+v"(c), "+v"(d));
}
__device__ __forceinline__ void sum8_quad(float& a, float& b, float& c, float& d) {
    asm volatile("s_nop 1\n\t"
        "v_add_f32_dpp %0, %0, %0 quad_perm:[1,0,3,2] row_mask:0xf bank_mask:0xf\n\tv_add_f32_dpp %1, %1, %1 quad_perm:[1,0,3,2] row_mask:0xf bank_mask:0xf\n\t"
        "v_add_f32_dpp %2, %2, %2 quad_perm:[1,0,3,2] row_mask:0xf bank_mask:0xf\n\tv_add_f32_dpp %3, %3, %3 quad_perm:[1,0,3,2] row_mask:0xf bank_mask:0xf\n\t"
        "v_add_f32_dpp %0, %0, %0 quad_perm:[2,3,0,1] row_mask:0xf bank_mask:0xf\n\tv_add_f32_dpp %1, %1, %1 quad_perm:[2,3,0,1] row_mask:0xf bank_mask:0xf\n\t"
        "v_add_f32_dpp %2, %2, %2 quad_perm:[2,3,0,1] row_mask:0xf bank_mask:0xf\n\tv_add_f32_dpp %3, %3, %3 quad_perm:[2,3,0,1] row_mask:0xf bank_mask:0xf\n\t"
        "v_add_f32_dpp %0, %0, %0 row_half_mirror row_mask:0xf bank_mask:0xf\n\tv_add_f32_dpp %1, %1, %1 row_half_mirror row_mask:0xf bank_mask:0xf\n\t"
        "v_add_f32_dpp %2, %2, %2 row_half_mirror row_mask:0xf bank_mask:0xf\n\tv_add_f32_dpp %3, %3, %3 row_half_mirror row_mask:0xf bank_mask:0xf"
        : "+v"(a), "+v"(b), "+v"(c), "+v"(d));
}
__device__ __forceinline__ float wave_sum(float v) { v = sum8(v); v += dpp_mov<0x140>(v); return (rl_f(v, 0) + rl_f(v, 16)) + (rl_f(v, 32) + rl_f(v, 48)); }
__device__ __forceinline__ float wave_max(float v) {
    v = fmaxf(v, dpp_mov<0xB1>(v)); v = fmaxf(v, dpp_mov<0x4E>(v)); v = fmaxf(v, dpp_mov<0x141>(v)); v = fmaxf(v, dpp_mov<0x140>(v));
    return fmaxf(fmaxf(rl_f(v, 0), rl_f(v, 16)), fmaxf(rl_f(v, 32), rl_f(v, 48)));
}
__device__ __forceinline__ int row_vec(int row) { return row < NCTX ? 4 : ((row - NCTX) >> 12); }
__device__ __forceinline__ int panel_vec(int pm) { return pm < 4 ? 4 : ((pm - 4) >> 4); }
__device__ __forceinline__ int seq_row(int b, int dir, int s) {
    if (s < CTX) { const int t = dir ? (CTX - 1 - s) : s; return b * CTX + t; }
    int t = s - CTX; if (dir) t = SEQ - 1 - t; return NCTX + b * SEQ + t;
}
__device__ __forceinline__ int row_pos(int row) { return row < NCTX ? (row & (CTX - 1)) : CTX + ((row - NCTX) & (SEQ - 1)); }

namespace pg8 {
constexpr int BM = 256, BK = 64, HALF = 128, HTB = HALF * BK * 2, STAGE_BYTES = 8 * HTB, NXCD = 8, WGM = 8;
__host__ __device__ __forceinline__ int lds_byte(int r, int c) { const int st = (r >> 4) * 2 + (c >> 5), rr = r & 15, cc = c & 31, ob = rr * 64 + cc * 2; return st * 1024 + (ob ^ (((ob >> 9) & 1) << 5)); }
__host__ __device__ __forceinline__ void stage_rc(int b, int& R, int& C) { const int st = b / 1024, sb = b % 1024, swz = sb ^ (((sb >> 9) & 1) << 5); R = (st >> 1) * 16 + swz / 64; C = (st & 1) * 32 + (swz % 64) / 2; }
__host__ __device__ __forceinline__ int perm32(int rho) { const int n = rho >> 4, i = rho & 15; return 8 * (i >> 2) + 4 * n + (i & 3); }
struct Unit { int pm, pn; };
struct StaticOrder {
    int nM, nN, nwg, G, c, pm0;
    __device__ void init(int M, int N, int G_, int c_, int pm0_ = 0) { pm0 = pm0_; nM = M / BM - pm0_; nN = N / BM; nwg = nM * nN; G = G_; c = c_; }
    __device__ bool next(int i, Unit& u) const {
        const long L = (long)i * G + c; if (L >= nwg) return false;
        int wgid = (int)L; { const int q = nwg / NXCD, r = nwg % NXCD, xcd = wgid % NXCD, off = wgid / NXCD; wgid = (xcd < r ? xcd * (q + 1) : r * (q + 1) + (xcd - r) * q) + off; }
        const int nig = WGM * nN, gid = wgid / nig, fm = gid * WGM, gsz = (nM - fm) < WGM ? (nM - fm) : WGM;
        u.pm = pm0 + fm + ((wgid % nig) % gsz); u.pn = (wgid % nig) / gsz; return true;
    }
};
template <class Epi, class GT>
__device__ __forceinline__ void gemm_phase(LAS unsigned char* lds, const GT g, const StaticOrder& S, const Epi& E) {
    int tid_ = threadIdx.x; asm volatile("" : "+v"(tid_));
    const int tid = tid_, wid = __builtin_amdgcn_readfirstlane(tid >> 6), lane = tid & 63, wr = wid >> 2, wc = wid & 3, fr = lane & 15, fq = lane >> 4;
    const int K = g.K, nt = K / BK;
    unsigned voffA[2], voffB[2];
#pragma unroll
    for (int i = 0; i < 2; ++i) { int R, C; stage_rc(tid * 16 + i * 8192, R, C); const int Rb = Epi::PERM ? ((R & ~31) + perm32(R & 31)) : R;
        voffA[i] = (unsigned)(R * g.lda + C) * 2u; voffB[i] = (unsigned)(Rb * g.ldb + C) * 2u; }
    const size_t kstep = (size_t)(BK * 2);
    const size_t hstepA = (size_t)HALF * g.lda * 2, hstepB = (size_t)HALF * g.ldb * 2;
    const unsigned ldsw = (unsigned)wid * 1024u;
    const int aoff = lds_byte(wr * 64 + fr, fq * 8), boff = lds_byte(wc * 32 + fr, fq * 8);
#define PG8_SA(b, h) (((b) * 2 + (h)) * HTB)
#define PG8_SB(b, h) ((4 + (b) * 2 + (h)) * HTB)
#define PG8_STAGE(bufoff, gbase, voff) do { _Pragma("unroll") for (int _i = 0; _i < 2; ++_i) \
        __builtin_amdgcn_global_load_lds((const unsigned*)((const char*)(gbase) + (voff)[_i]), (LAS unsigned*)(lds + (bufoff) + ldsw + _i * 8192), 16, 0, 0); } while (0)
#define PG8_LDA(dst, b, h) do { _Pragma("unroll") for (int m = 0; m < 4; ++m) _Pragma("unroll") for (int k = 0; k < 2; ++k) dst[m][k] = *(const LAS bf16x8*)(lds + PG8_SA(b, h) + aoff + m * 2048 + k * 1024); } while (0)
#define PG8_LDB(dst, b, h) do { _Pragma("unroll") for (int n = 0; n < 2; ++n) _Pragma("unroll") for (int k = 0; k < 2; ++k) dst[n][k] = *(const LAS bf16x8*)(lds + PG8_SB(b, h) + boff + n * 2048 + k * 1024); } while (0)
#define PG8_MMA(ai, bj, At, Bt) do { __builtin_amdgcn_s_setprio(1); _Pragma("unroll") for (int m = 0; m < 4; ++m) _Pragma("unroll") for (int n = 0; n < 2; ++n) _Pragma("unroll") for (int k = 0; k < 2; ++k) \
        acc[ai][bj][m][n] = __builtin_amdgcn_mfma_f32_16x16x32_bf16(Bt[n][k], At[m][k], acc[ai][bj][m][n], 0, 0, 0); __builtin_amdgcn_s_setprio(0); } while (0)
#define PG8_WAIT_V(n) asm volatile("s_waitcnt vmcnt(" #n ")" ::: "memory")
#define PG8_WAIT_L(n) asm volatile("s_waitcnt lgkmcnt(" #n ")" ::: "memory")
#define PG8_BAR __builtin_amdgcn_s_barrier()
#define PG8_SCHED __builtin_amdgcn_sched_barrier(0)
    Unit cur, nxt; int ui = 0;
    if (!S.next(0, cur)) return;
    f32x4 acc[2][2][4][2];
#pragma unroll
    for (int a = 0; a < 2; ++a)
#pragma unroll
        for (int b = 0; b < 2; ++b)
#pragma unroll
            for (int m = 0; m < 4; ++m)
#pragma unroll
                for (int n = 0; n < 2; ++n) acc[a][b][m][n] = (f32x4){0.f, 0.f, 0.f, 0.f};
    bf16x8 At[4][2], B0[2][2], B1[2][2];
    const char* cA = g.a_ptr(cur); const char* cB = g.b_ptr(cur);
    PG8_STAGE(PG8_SB(0, 0), cB, voffB); PG8_STAGE(PG8_SA(0, 0), cA, voffA); PG8_STAGE(PG8_SB(0, 1), cB + hstepB, voffB); PG8_STAGE(PG8_SA(0, 1), cA + hstepA, voffA);
    if (wr == 1) PG8_BAR;
    PG8_WAIT_V(4); PG8_BAR;
    PG8_STAGE(PG8_SB(1, 0), cB + kstep, voffB); PG8_STAGE(PG8_SA(1, 0), cA + kstep, voffA); PG8_STAGE(PG8_SB(1, 1), cB + hstepB + kstep, voffB);
    PG8_WAIT_V(6); PG8_BAR;
    for (;;) {
        const bool has_next = S.next(ui + 1, nxt);
        const char* nA = has_next ? g.a_ptr(nxt) : cA; const char* nB = has_next ? g.b_ptr(nxt) : cB;
        for (int t = 0; t < nt; t += 2) {
            const bool last = (t == nt - 2);
            const char* a1 = cA + (size_t)(t + 1) * kstep;
            const char* a2 = last ? nA : cA + (size_t)(t + 2) * kstep; const char* b2 = last ? nB : cB + (size_t)(t + 2) * kstep;
            const char* a3 = a2 + kstep; const char* b3 = b2 + kstep;
            PG8_LDB(B0, 0, 0); PG8_SCHED; PG8_LDA(At, 0, 0); PG8_STAGE(PG8_SA(1, 1), a1 + hstepA, voffA);
            PG8_WAIT_L(8); PG8_BAR; PG8_WAIT_L(0); PG8_MMA(0, 0, At, B0); PG8_BAR; PG8_SCHED;
            PG8_LDB(B1, 0, 1); PG8_STAGE(PG8_SB(0, 0), b2, voffB);
            PG8_BAR; PG8_WAIT_L(0); PG8_MMA(0, 1, At, B1); PG8_BAR;
            PG8_LDA(At, 0, 1); PG8_STAGE(PG8_SA(0, 0), a2, voffA);
            PG8_BAR; PG8_WAIT_L(0); PG8_MMA(1, 0, At, B0); PG8_BAR; PG8_SCHED;
            PG8_STAGE(PG8_SB(0, 1), b2 + hstepB, voffB);
            PG8_WAIT_V(6); PG8_BAR; PG8_MMA(1, 1, At, B1); PG8_BAR;
            PG8_LDB(B0, 1, 0); PG8_SCHED; PG8_LDA(At, 1, 0); PG8_STAGE(PG8_SA(0, 1), a2 + hstepA, voffA);
            PG8_WAIT_L(8); PG8_BAR; PG8_WAIT_L(0); PG8_MMA(0, 0, At, B0); PG8_BAR; PG8_SCHED;
            PG8_LDB(B1, 1, 1); PG8_STAGE(PG8_SB(1, 0), b3, voffB);
            PG8_BAR; PG8_WAIT_L(0); PG8_MMA(0, 1, At, B1); PG8_BAR;
            PG8_LDA(At, 1, 1); PG8_STAGE(PG8_SA(1, 0), a3, voffA);
            PG8_BAR; PG8_WAIT_L(0); PG8_MMA(1, 0, At, B0); PG8_BAR; PG8_SCHED;
            PG8_STAGE(PG8_SB(1, 1), b3 + hstepB, voffB);
            PG8_WAIT_V(6); PG8_BAR; PG8_MMA(1, 1, At, B1); PG8_BAR;
        }
        E(acc, cur, wr, wc, fr, fq);
        if (!has_next) break;
#pragma unroll
        for (int a = 0; a < 2; ++a)
#pragma unroll
            for (int b = 0; b < 2; ++b)
#pragma unroll
                for (int m = 0; m < 4; ++m)
#pragma unroll
                    for (int n = 0; n < 2; ++n) acc[a][b][m][n] = (f32x4){0.f, 0.f, 0.f, 0.f};
        cur = nxt; cA = nA; cB = nB; ++ui;
    }
    PG8_WAIT_V(0);
    if (wr == 0) PG8_BAR;
    PG8_BAR;
#undef PG8_SA
#undef PG8_SB
#undef PG8_STAGE
#undef PG8_LDA
#undef PG8_LDB
#undef PG8_MMA
#undef PG8_WAIT_V
#undef PG8_WAIT_L
#undef PG8_BAR
#undef PG8_SCHED
}
}
using pg8::Unit;
typedef const f32x4 (&AccRef)[2][2][4][2];

#define XB_TMO      128
#define XB_XCNT(j)  (256  + 64 * (j))
#define XB_XSUB(j)  (1280 + 64 * (j))
#define XB_XGEN(j)  (2304 + 64 * (j))
#define XB_TOP      3328
#define XB_TOPGEN   3392
#define XCD_BAR_WORDS 3456
#define XB_SPIN_CAP (1u << 18)
__device__ __forceinline__ unsigned xb_ld(unsigned* p)              { return __hip_atomic_load(p, __ATOMIC_RELAXED, __HIP_MEMORY_SCOPE_AGENT); }
__device__ __forceinline__ unsigned xb_add(unsigned* p, unsigned v) { return __hip_atomic_fetch_add(p, v, __ATOMIC_RELAXED, __HIP_MEMORY_SCOPE_AGENT); }
__device__ __forceinline__ unsigned xb_xcc_id() { return (unsigned)__builtin_amdgcn_s_getreg((3 << 11) | 20) & 0xFu; }
#define XB_SPIN(cond, bar) do { unsigned _sp = 0; while (cond) { __builtin_amdgcn_s_sleep(1); \
    if ((++_sp & 255u) == 0u) { if (xb_ld(&(bar)[XB_TMO])) break; if (_sp > XB_SPIN_CAP) { atomicAdd(&(bar)[XB_TMO], 1u); break; } } } } while (0)
struct XcdBarrier { unsigned* bar; unsigned x; volatile LAS unsigned* st; };
__device__ __forceinline__ XcdBarrier xcd_barrier_post(unsigned* bar, volatile LAS unsigned* st) {
    XcdBarrier b; b.bar = bar; b.x = xb_xcc_id(); b.st = st;
    if (threadIdx.x == 0) (void)xb_add(&bar[XB_XCNT(b.x)], 1u);
    return b;
}
__device__ __forceinline__ void xcd_barrier_complete(unsigned* bar, unsigned x, unsigned& nloc, unsigned& nx) {
    const unsigned G = gridDim.x * gridDim.y * gridDim.z;
    unsigned sum, cnt, mine, sp = 0u;
    for (;;) {
        sum = 0u; cnt = 0u; mine = 0u;
#pragma unroll
        for (unsigned j = 0; j < 16; ++j) { const unsigned c = xb_ld(&bar[XB_XCNT(j)]); sum += c; cnt += (c > 0u) ? 1u : 0u; mine = (j == x) ? c : mine; }
        if (sum == G) break;
        __builtin_amdgcn_s_sleep(1);
        if ((++sp & 255u) == 0u) { if (xb_ld(&bar[XB_TMO])) break; if (sp > XB_SPIN_CAP) { atomicAdd(&bar[XB_TMO], 1u); break; } }
    }
    nloc = mine > 0u ? mine : 1u; nx = cnt > 0u ? cnt : 1u;
}
__device__ __forceinline__ void xcd_barrier(const XcdBarrier& b) {
    asm volatile("s_waitcnt vmcnt(0)" ::: "memory");
    __syncthreads();
    if (threadIdx.x == 0) {
        unsigned* bar = b.bar;
        __builtin_amdgcn_s_waitcnt(0);
        unsigned nloc = b.st[0], nx = b.st[1];
        if (nloc == 0u) { xcd_barrier_complete(bar, b.x, nloc, nx); b.st[0] = nloc; b.st[1] = nx; }
        const unsigned old = xb_add(&bar[XB_XSUB(b.x)], 1u);
        const unsigned gen = old / nloc;
        if (old + 1u == (gen + 1u) * nloc) {
            __builtin_amdgcn_fence(__ATOMIC_RELEASE, "agent");
            asm volatile("s_waitcnt vmcnt(0)" ::: "memory");
            const unsigned og = xb_add(&bar[XB_TOP], 1u);
            const unsigned tg = og / nx;
            if (og + 1u == (tg + 1u) * nx) xb_add(&bar[XB_TOPGEN], 1u);
            else XB_SPIN(xb_ld(&bar[XB_TOPGEN]) == tg, bar);
            __builtin_amdgcn_fence(__ATOMIC_ACQUIRE, "agent");
            xb_add(&bar[XB_XGEN(b.x)], 1u);
            asm volatile("s_waitcnt vmcnt(0)" ::: "memory");
        } else {
            XB_SPIN(xb_ld(&bar[XB_XGEN(b.x)]) == gen, bar);
            __builtin_amdgcn_fence(__ATOMIC_ACQUIRE, "agent");
            asm volatile("s_waitcnt vmcnt(0)" ::: "memory");
        }
    }
    __syncthreads();
}

struct Params { const float* in[37]; float* out; unsigned char* ws; };
typedef const __attribute__((address_space(4))) Params* KP;
__device__ __forceinline__ KP kp_fresh() { KP p = (KP)__builtin_amdgcn_kernarg_segment_ptr(); asm volatile("" : "+s"(p)); return p; }
enum { I_X = 0, I_C, I_CTX, I_CCTX, I_ADAW, I_ADAB, I_LNG, I_LNB, I_PWQ, I_PKEYS, I_PU, I_PV, I_RGWIN, I_RGCW, I_RGCB, I_RGGW, I_RGGB, I_RGLAM, I_RGWOUT,
       I_RWMU, I_RWRKV, I_RWWO, I_RWDEC0, I_RWDEC1, I_RWDEC2, I_RWICL0, I_RWICL1, I_RWICL2, I_RWG1, I_RWG2, I_RWKK, I_RWKA, I_RWRK, I_RWGNG, I_RWGNB, I_RETWIN, I_RETWOUT };
constexpr int LDS_BYTES = 147456;
constexpr int MISC_OFF = 147200;

__device__ __forceinline__ const float* modp(KP P, int layer, int v, int slot) { return (const float*)(P->ws + WS_MOD) + ((size_t)(layer * 5 + v) * 6 + slot) * D; }

struct GPlain { const bf16_t* A; const bf16_t* Bt; int K, lda, ldb;
    __device__ __forceinline__ const char* a_ptr(const Unit& u) const { return (const char*)(A + (size_t)u.pm * 256 * lda); }
    __device__ __forceinline__ const char* b_ptr(const Unit& u) const { return (const char*)(Bt + (size_t)u.pn * 256 * ldb); } };
struct GGate { const bf16_t* A; const bf16_t* Bt; int K, lda, ldb;
    __device__ __forceinline__ const char* a_ptr(const Unit& u) const { return (const char*)(A + (size_t)u.pm * 256 * lda + ((u.pn >> 1) & 7) * 256); }
    __device__ __forceinline__ const char* b_ptr(const Unit& u) const { return (const char*)(Bt + (size_t)u.pn * 256 * ldb); } };
struct GScore { const bf16_t* A; const bf16_t* Bt; int K, lda, ldb;
    __device__ __forceinline__ const char* a_ptr(const Unit& u) const { return (const char*)(A + (size_t)u.pm * 256 * lda + u.pn * 256); }
    __device__ __forceinline__ const char* b_ptr(const Unit& u) const { return (const char*)(Bt + (size_t)u.pn * 256 * ldb); } };
struct GFold { const bf16_t* A; const bf16_t* Bt; int K, lda, ldb;
    __device__ __forceinline__ const char* a_ptr(const Unit& u) const { return (const char*)(A + (size_t)u.pm * 256 * lda); }
    __device__ __forceinline__ const char* b_ptr(const Unit& u) const { return (const char*)(Bt + (size_t)(u.pm >> 3) * D * D + (size_t)u.pn * 256 * ldb + (u.pm & 7) * 256); } };
struct GRw1 { const bf16_t* A; const bf16_t* Bt; int K, lda, ldb;
    __device__ __forceinline__ const char* a_ptr(const Unit& u) const { const int blk = u.pn < 24 ? (u.pn >> 3) : (u.pn - 21); return (const char*)(A + (size_t)u.pm * 256 * lda + blk * 2048); }
    __device__ __forceinline__ const char* b_ptr(const Unit& u) const { return (const char*)(Bt + (size_t)u.pn * 256 * ldb); } };
struct GRw2 { const bf16_t* A; const bf16_t* Bt; int K, lda, ldb;
    __device__ __forceinline__ const char* a_ptr(const Unit& u) const { const int blk = u.pn < 16 ? 0 : (u.pn < 32 ? 1 : 2); return (const char*)(A + (size_t)u.pm * 256 * lda + blk * 256); }
    __device__ __forceinline__ const char* b_ptr(const Unit& u) const { return (const char*)(Bt + (size_t)u.pn * 256 * ldb); } };

template <int ACT> __device__ __forceinline__ float actf(float x) {
    if (ACT == 1) return gelu_tanh(x); if (ACT == 2) return tanhf_(x); if (ACT == 3) return sigmoidf_(x); if (ACT == 4) return siluf_(x); return x; }
template <int ACT> __device__ __forceinline__ void store_tile_bf16(AccRef acc, bf16_t* dst, int ld, int row0, int col0) {
#pragma unroll
    for (int ai = 0; ai < 2; ++ai)
#pragma unroll
        for (int m = 0; m < 4; ++m) { bf16_t* rowp = dst + (size_t)(row0 + ai * 128 + m * 16) * ld + col0;
#pragma unroll
            for (int bj = 0; bj < 2; ++bj) { const f32x4 v0 = acc[ai][bj][m][0], v1 = acc[ai][bj][m][1];
                u32x4 w; w.x = cvt_pk_bf16(actf<ACT>(v0[0]), actf<ACT>(v0[1])); w.y = cvt_pk_bf16(actf<ACT>(v0[2]), actf<ACT>(v0[3]));
                w.z = cvt_pk_bf16(actf<ACT>(v1[0]), actf<ACT>(v1[1])); w.w = cvt_pk_bf16(actf<ACT>(v1[2]), actf<ACT>(v1[3]));
                *(u32x4*)(rowp + bj * 128) = w; } }
}
struct EpiBf16Plain { static constexpr bool PERM = true; bf16_t* O; int ldc;
    __device__ __forceinline__ void operator()(AccRef acc, const Unit& u, int wr, int wc, int fr, int fq) const {
        store_tile_bf16<0>(acc, O, ldc, u.pm * 256 + wr * 64 + fr, u.pn * 256 + wc * 32 + 8 * fq); } };
struct EpiF32Plain { static constexpr bool PERM = false; float* C; int ldc;
    __device__ __forceinline__ void operator()(AccRef acc, const Unit& u, int wr, int wc, int fr, int fq) const {
        const int row0 = u.pm * 256 + wr * 64 + fr, col0 = u.pn * 256 + wc * 32 + 4 * fq;
#pragma unroll
        for (int ai = 0; ai < 2; ++ai)
#pragma unroll
            for (int m = 0; m < 4; ++m) { float* rowp = C + (size_t)(row0 + ai * 128 + m * 16) * ldc + col0;
#pragma unroll
                for (int bj = 0; bj < 2; ++bj)
#pragma unroll
                    for (int n = 0; n < 2; ++n) *(f32x4*)(rowp + bj * 128 + n * 16) = acc[ai][bj][m][n]; } } };
struct GSplitK { const bf16_t* A; const bf16_t* Bt; int K, lda, ldb;
    __device__ __forceinline__ const char* a_ptr(const Unit& u) const { return (const char*)(A + (size_t)u.pm * 256 * lda + (u.pn >> 3) * 512); }
    __device__ __forceinline__ const char* b_ptr(const Unit& u) const { return (const char*)(Bt + (size_t)(u.pn & 7) * 256 * ldb + (u.pn >> 3) * 512); } };
struct EpiPartial { static constexpr bool PERM = false; float* PX;
    __device__ __forceinline__ void operator()(AccRef acc, const Unit& u, int wr, int wc, int fr, int fq) const {
        const int row0 = u.pm * 256 + wr * 64 + fr, col0 = (u.pn & 7) * 256 + wc * 32 + 4 * fq; float* base = PX + (size_t)(u.pn >> 3) * NCTX * D;
#pragma unroll
        for (int ai = 0; ai < 2; ++ai)
#pragma unroll
            for (int m = 0; m < 4; ++m) { float* rowp = base + (size_t)(row0 + ai * 128 + m * 16) * D + col0;
#pragma unroll
                for (int bj = 0; bj < 2; ++bj)
#pragma unroll
                    for (int n = 0; n < 2; ++n) *(f32x4*)(rowp + bj * 128 + n * 16) = acc[ai][bj][m][n]; } } };
struct EpiResid { static constexpr bool PERM = false; float* X; const float* gate_base; float ymul;
    __device__ __forceinline__ void operator()(AccRef acc, const Unit& u, int wr, int wc, int fr, int fq) const {
        const int row0 = u.pm * 256 + wr * 64 + fr, col0 = u.pn * 256 + wc * 32 + 4 * fq;
        const float* gp = gate_base + (size_t)panel_vec(u.pm) * 6 * D + col0;
        f32x4 gv[2][2];
#pragma unroll
        for (int bj = 0; bj < 2; ++bj)
#pragma unroll
            for (int n = 0; n < 2; ++n) gv[bj][n] = *(const f32x4*)(gp + bj * 128 + n * 16);
#pragma unroll
        for (int ai = 0; ai < 2; ++ai)
#pragma unroll
            for (int m = 0; m < 4; ++m) { float* rowp = X + (size_t)(row0 + ai * 128 + m * 16) * D + col0;
#pragma unroll
                for (int bj = 0; bj < 2; ++bj)
#pragma unroll
                    for (int n = 0; n < 2; ++n) { f32x4* p = (f32x4*)(rowp + bj * 128 + n * 16); const f32x4 x = *p; *p = x * ALPHA + gv[bj][n] * (acc[ai][bj][m][n] * ymul); } } } };
struct EpiRgIn { static constexpr bool PERM = true; bf16_t* UG; bf16_t* UR;
    __device__ __forceinline__ void operator()(AccRef acc, const Unit& u, int wr, int wc, int fr, int fq) const {
        const int row0 = u.pm * 256 + wr * 64 + fr, col0 = (u.pn & 7) * 256 + wc * 32 + 8 * fq;
        if (u.pn < 8) store_tile_bf16<1>(acc, UG, D, row0, col0); else store_tile_bf16<0>(acc, UR, D, row0, col0); } };
struct EpiRgGate { static constexpr bool PERM = true; const bf16_t* XC; bf16_t* LA; bf16_t* BB; const float* gate_b; const float* spt;
    __device__ __forceinline__ void operator()(AccRef acc, const Unit& u, int wr, int wc, int fr, int fq) const {
        const int d = u.pn >> 4, ch0 = ((u.pn >> 1) & 7) * 256 + (u.pn & 1) * 128 + wc * 32 + 8 * fq;
        const int row0 = u.pm * 256 + wr * 64 + fr;
        float br[8], bi[8], sp[8];
#pragma unroll
        for (int j = 0; j < 8; ++j) { br[j] = gate_b[(d * 2 + 0) * D + ch0 + j]; bi[j] = gate_b[(d * 2 + 1) * D + ch0 + j];
            sp[j] = spt[d * D + ch0 + j]; }
#pragma unroll
        for (int ai = 0; ai < 2; ++ai)
#pragma unroll
            for (int m = 0; m < 4; ++m) { const int row = row0 + ai * 128 + m * 16;
                const u32x4 xr = *(const u32x4*)(XC + (size_t)row * D + ch0);
                float xc[8] = {bflo(xr.x), bfhi(xr.x), bflo(xr.y), bfhi(xr.y), bflo(xr.z), bfhi(xr.z), bflo(xr.w), bfhi(xr.w)};
                float la[8], bb[8];
#pragma unroll
                for (int j = 0; j < 8; ++j) { const float ar = acc[ai][0][m][j >> 2][j & 3], ai_ = acc[ai][1][m][j >> 2][j & 3];
                    const float rg = sigmoidf_(ar + br[j]), ig = sigmoidf_(ai_ + bi[j]);
                    const float l = sp[j] * rg; la[j] = l; bb[j] = sqrtf(1.0f - __expf(2.0f * l)) * (ig * xc[j]); }
                u32x4 w; w.x = cvt_pk_bf16(la[0], la[1]); w.y = cvt_pk_bf16(la[2], la[3]); w.z = cvt_pk_bf16(la[4], la[5]); w.w = cvt_pk_bf16(la[6], la[7]);
                *(u32x4*)(LA + ((size_t)row * 2 + d) * D + ch0) = w;
                w.x = cvt_pk_bf16(bb[0], bb[1]); w.y = cvt_pk_bf16(bb[2], bb[3]); w.z = cvt_pk_bf16(bb[4], bb[5]); w.w = cvt_pk_bf16(bb[6], bb[7]);
                *(u32x4*)(BB + ((size_t)row * 2 + d) * D + ch0) = w; } } };
struct EpiRw1 { static constexpr bool PERM = true; bf16_t* RKV; bf16_t* A2;
    __device__ __forceinline__ void operator()(AccRef acc, const Unit& u, int wr, int wc, int fr, int fq) const {
        const int row0 = u.pm * 256 + wr * 64 + fr, cw = wc * 32 + 8 * fq;
        if (u.pn < 24) store_tile_bf16<0>(acc, RKV + (size_t)(u.pn >> 3) * TD, D, row0, (u.pn & 7) * 256 + cw);
        else if (u.pn == 24) store_tile_bf16<2>(acc, A2, 768, row0, cw);
        else if (u.pn == 25) store_tile_bf16<0>(acc, A2, 768, row0, 256 + cw);
        else store_tile_bf16<3>(acc, A2, 768, row0, 512 + cw); } };
struct EpiRw2 { static constexpr bool PERM = true; bf16_t* W; bf16_t* AD; bf16_t* G; const float* dec0; const float* icl0;
    __device__ __forceinline__ void operator()(AccRef acc, const Unit& u, int wr, int wc, int fr, int fq) const {
        const int row0 = u.pm * 256 + wr * 64 + fr, c0 = (u.pn & 7) * 256 + wc * 32 + 8 * fq;
        if (u.pn >= 32) { store_tile_bf16<0>(acc, G, D, row0, c0); return; }
        const int isa = u.pn >= 16, d = (u.pn >> 3) & 1;
        const float* bias = (isa ? icl0 : dec0) + d * D + c0;
        bf16_t* dst = (isa ? AD : W);
        float bv[2][8];
#pragma unroll
        for (int bj = 0; bj < 2; ++bj)
#pragma unroll
            for (int j = 0; j < 8; ++j) bv[bj][j] = bias[bj * 128 + j];
#pragma unroll
        for (int ai = 0; ai < 2; ++ai)
#pragma unroll
            for (int m = 0; m < 4; ++m) { const int row = row0 + ai * 128 + m * 16;
#pragma unroll
                for (int bj = 0; bj < 2; ++bj) { float o[8];
#pragma unroll
                    for (int j = 0; j < 8; ++j) { const float s = sigmoidf_(acc[ai][bj][m][j >> 2][j & 3] + bv[bj][j]); o[j] = isa ? s : __expf(-0.6065306597126334f * s); }
                    u32x4 w; w.x = cvt_pk_bf16(o[0], o[1]); w.y = cvt_pk_bf16(o[2], o[3]); w.z = cvt_pk_bf16(o[4], o[5]); w.w = cvt_pk_bf16(o[6], o[7]);
                    *(u32x4*)(dst + ((size_t)row * 2 + d) * D + c0 + bj * 128) = w; } } } };
struct EpiRetIn { static constexpr bool PERM = true; bf16_t* Q; bf16_t* Kk; bf16_t* V; bf16_t* GF; bf16_t* GB; const float* CS;
    __device__ __forceinline__ void operator()(AccRef acc, const Unit& u, int wr, int wc, int fr, int fq) const {
        const int row0 = u.pm * 256 + wr * 64 + fr, cw = wc * 32 + 8 * fq;
        if (u.pn >= 48) { store_tile_bf16<4>(acc, GB, 4096, row0, (u.pn - 48) * 256 + cw); return; }
        if (u.pn >= 32) { store_tile_bf16<4>(acc, GF, 4096, row0, (u.pn - 32) * 256 + cw); return; }
        if (u.pn >= 16) { store_tile_bf16<0>(acc, V, 4096, row0, (u.pn - 16) * 256 + cw); return; }
        const float sc = u.pn >= 8 ? 0.0625f : 1.0f; bf16_t* dst = u.pn >= 8 ? Kk : Q; const int hc = (u.pn & 7) * 256;
#pragma unroll
        for (int ai = 0; ai < 2; ++ai)
#pragma unroll
            for (int m = 0; m < 4; ++m) { const int row = row0 + ai * 128 + m * 16; const float* cs = CS + ((size_t)row_pos(row) * 128 + cw) * 2;
                float o1[8], o2[8];
#pragma unroll
                for (int j = 0; j < 8; ++j) { const float co = cs[2 * j], si = cs[2 * j + 1]; const float t1 = acc[ai][0][m][j >> 2][j & 3], t2 = acc[ai][1][m][j >> 2][j & 3];
                    o1[j] = (t1 * co - t2 * si) * sc; o2[j] = (t1 * si + t2 * co) * sc; }
                u32x4 w; w.x = cvt_pk_bf16(o1[0], o1[1]); w.y = cvt_pk_bf16(o1[2], o1[3]); w.z = cvt_pk_bf16(o1[4], o1[5]); w.w = cvt_pk_bf16(o1[6], o1[7]);
                *(u32x4*)(dst + (size_t)row * D + hc + cw) = w;
                w.x = cvt_pk_bf16(o2[0], o2[1]); w.y = cvt_pk_bf16(o2[2], o2[3]); w.z = cvt_pk_bf16(o2[4], o2[5]); w.w = cvt_pk_bf16(o2[6], o2[7]);
                *(u32x4*)(dst + (size_t)row * D + hc + 128 + cw) = w; } } };

#define LDS_WAIT() asm volatile("s_waitcnt lgkmcnt(0)" ::: "memory")
struct Ctx { LAS unsigned char* lds; int tid, lane, wave, gw, ngw, gtid, ngt; };

__device__ __forceinline__ void transpose_item(const float* W, int ldw, bf16_t* WT, int ldt, int k0, int n0, int dst_row0, LAS float* scr, int lane) {
#pragma unroll
    for (int i = 0; i < 8; ++i) { const int kk = 8 * i + (lane >> 3), nn = (lane & 7) * 4; const f32x4 wv = *(const f32x4*)(W + (size_t)(k0 + kk) * ldw + n0 + nn);
        LAS float* d = scr + kk * 33 + nn; d[0] = wv[0]; d[1] = wv[1]; d[2] = wv[2]; d[3] = wv[3]; }
    LDS_WAIT(); asm volatile("" ::: "memory");
    const int c = lane & 7;
#pragma unroll
    for (int j = 0; j < 4; ++j) { const int n = (lane >> 3) + 8 * j; const LAS float* s = scr + (8 * c) * 33 + n;
        u32x4 o; o.x = cvt_pk_bf16(s[0 * 33], s[1 * 33]); o.y = cvt_pk_bf16(s[2 * 33], s[3 * 33]); o.z = cvt_pk_bf16(s[4 * 33], s[5 * 33]); o.w = cvt_pk_bf16(s[6 * 33], s[7 * 33]);
        *(u32x4*)(WT + (size_t)(dst_row0 + n) * ldt + k0 + 8 * c) = o; }
    LDS_WAIT(); asm volatile("" ::: "memory");
}
__device__ __forceinline__ void tr_job(const Ctx& c, int& rot, const float* W, int K, int N, int ldw, bf16_t* WT, int ldt, int row_off) {
    LAS float* scr = (LAS float*)(c.lds + c.wave * 16384);
    const int nblk = N / 32, items = (K / 64) * nblk;
    int first = c.gw - (rot % c.ngw); if (first < 0) first += c.ngw;
    int lane = c.lane; asm volatile("" : "+v"(lane));
    f32x4 r[8];
#define TR_LOAD(it_) do { const int kb_ = (it_) / nblk, nb_ = (it_) % nblk; _Pragma("unroll") for (int i = 0; i < 8; ++i) r[i] = *(const f32x4*)(W + (size_t)(kb_ * 64 + 8 * i + (lane >> 3)) * ldw + nb_ * 32 + (lane & 7) * 4); } while (0)
    if (first < items) TR_LOAD(first);
    for (int it = first; it < items; it += c.ngw) { const int kb = it / nblk, nb = it % nblk;
#pragma unroll
        for (int i = 0; i < 8; ++i) { LAS float* d = scr + (8 * i + (lane >> 3)) * 33 + (lane & 7) * 4; d[0] = r[i][0]; d[1] = r[i][1]; d[2] = r[i][2]; d[3] = r[i][3]; }
        if (it + c.ngw < items) TR_LOAD(it + c.ngw);
        LDS_WAIT(); asm volatile("" ::: "memory");
        const int cc = lane & 7;
#pragma unroll
        for (int j = 0; j < 4; ++j) { const int n = (lane >> 3) + 8 * j; const LAS float* sp = scr + (8 * cc) * 33 + n;
            u32x4 o; o.x = cvt_pk_bf16(sp[0 * 33], sp[1 * 33]); o.y = cvt_pk_bf16(sp[2 * 33], sp[3 * 33]); o.z = cvt_pk_bf16(sp[4 * 33], sp[5 * 33]); o.w = cvt_pk_bf16(sp[6 * 33], sp[7 * 33]);
            *(u32x4*)(WT + (size_t)(row_off + nb * 32 + n) * ldt + kb * 64 + 8 * cc) = o; }
        LDS_WAIT(); asm volatile("" ::: "memory"); }
#undef TR_LOAD
    rot += items;
}

__device__ __forceinline__ void peer_convert_rows(KP P, const Ctx& c, int g_lo, int g_hi, int rank, int nranks) {
    unsigned char* ws = P->ws;
    for (int g0 = g_lo + (rank * 8 + c.wave) * 2; g0 < g_hi; g0 += nranks * 16) {
        f32x4 x[2][8]; float am[2] = {0.f, 0.f};
#pragma unroll
        for (int h = 0; h < 2; ++h) { const int g = (g0 + h < g_hi) ? g0 + h : g0; const int lt = g >> 14, e = g & 16383, layer = lt >> 1, t = lt & 1;
            const float* sp = P->in[t ? I_PV : I_PU] + ((size_t)layer * 16384 + e) * D + c.lane * 16;
#pragma unroll
            for (int q = 0; q < 8; ++q) x[h][q] = *(const f32x4*)(sp + (q >> 2) * 1024 + (q & 3) * 4); }
#pragma unroll
        for (int h = 0; h < 2; ++h) { if (g0 + h >= g_hi) break;
            const int g = g0 + h; const int lt = g >> 14, e = g & 16383, layer = lt >> 1, t = lt & 1;
#pragma unroll
            for (int q = 0; q < 8; ++q) am[h] = fmaxf(am[h], fmaxf(fmaxf(fabsf(x[h][q][0]), fabsf(x[h][q][1])), fmaxf(fabsf(x[h][q][2]), fabsf(x[h][q][3]))));
            const float a = wave_max(am[h]);
            const float sc = a > 0.f ? exp2f(floorf(log2f(384.0f / a))) : 1.0f;
            if (c.lane == 0) ((float*)(ws + WS_PSC))[(size_t)t * 4 * 16384 + layer * 16384 + e] = 1.0f / sc;
            unsigned char* dst = ws + (t ? WS_PV : WS_PU) + (size_t)layer * 16384 * D;
#pragma unroll
            for (int jj = 0; jj < 2; ++jj) { u32x4 o;
#pragma unroll
                for (int w = 0; w < 4; ++w) { const f32x4 v = x[h][jj * 4 + w] * sc; int p = 0; p = __builtin_amdgcn_cvt_pk_fp8_f32(v[0], v[1], p, false); p = __builtin_amdgcn_cvt_pk_fp8_f32(v[2], v[3], p, true); o[w] = (unsigned)p; }
                const int db = (c.lane >> 3) + 8 * jj;
                *(u32x4*)(dst + ((size_t)db * 16384 + e) * 128 + (c.lane & 7) * 16) = o; } } }
}
__device__ __forceinline__ void phase_prologue(KP P, const Ctx& c) {
    unsigned char* ws = P->ws;
    PROBE_REP(14) {
        LAS float* sl = (LAS float*)c.lds;
        LAS float* red = sl + 1280;
        for (int un = blockIdx.x; un < 4 * 24 * 8; un += gridDim.x) {
            const int layer = un / 192, r = un % 192, nb = r / 8, kc = r % 8;
            __syncthreads();
            for (int i = c.tid; i < 5 * 256; i += 512) { const int v = i >> 8, k = kc * 256 + (i & 255); const float x = v < 4 ? P->in[I_C][v * D + k] : P->in[I_CCTX][k]; sl[i] = siluf_(x); }
            __syncthreads();
            const int cg = c.tid & 127, ks = c.tid >> 7;
            const float* w = P->in[I_ADAW] + ((size_t)layer * D + kc * 256 + ks * 64) * 12288 + nb * 512 + cg * 4;
            f32x4 a0 = (f32x4){0.f, 0.f, 0.f, 0.f}, a1 = a0, a2 = a0, a3 = a0, a4 = a0;
            f32x4 wn[8];
#pragma unroll
            for (int i = 0; i < 8; ++i) wn[i] = *(const f32x4*)(w + (size_t)i * 12288);
#pragma unroll 1
            for (int k0 = 0; k0 < 64; k0 += 8) { f32x4 wc[8];
#pragma unroll
                for (int i = 0; i < 8; ++i) wc[i] = wn[i];
                if (k0 + 8 < 64) {
#pragma unroll
                    for (int i = 0; i < 8; ++i) wn[i] = *(const f32x4*)(w + (size_t)(k0 + 8 + i) * 12288); }
#pragma unroll
                for (int i = 0; i < 8; ++i) { const f32x4 wv = wc[i]; const int kk = ks * 64 + k0 + i;
                    a0 += wv * sl[kk]; a1 += wv * sl[256 + kk]; a2 += wv * sl[512 + kk]; a3 += wv * sl[768 + kk]; a4 += wv * sl[1024 + kk]; } }
            LAS float* rp = red + (ks * 5) * 512 + cg * 4;
            *(LAS f32x4*)(rp) = a0; *(LAS f32x4*)(rp + 512) = a1; *(LAS f32x4*)(rp + 1024) = a2; *(LAS f32x4*)(rp + 1536) = a3; *(LAS f32x4*)(rp + 2048) = a4;
            __syncthreads();
            for (int i = c.tid; i < 5 * 512; i += 512) { const int v = i >> 9, n = i & 511;
                const float sum = (red[(0 * 5 + v) * 512 + n] + red[(1 * 5 + v) * 512 + n]) + (red[(2 * 5 + v) * 512 + n] + red[(3 * 5 + v) * 512 + n]);
                ((float*)(ws + WS_MODP))[((size_t)(layer * 8 + kc) * 5 + v) * 12288 + nb * 512 + n] = sum; }
        }
        __syncthreads();
    }
    PROBE_REP(16) {
    int rot = 0;
    for (int j = 0; j < 2; ++j) {
        tr_job(c, rot, P->in[I_RGWIN] + (size_t)j * D * 4096, D, 4096, 4096, (bf16_t*)(ws + WS_RGIN) + (size_t)j * 4096 * D, D, 0);
        tr_job(c, rot, P->in[I_RGWOUT] + (size_t)j * D * D, D, D, D, (bf16_t*)(ws + WS_RGOUT) + (size_t)j * D * D, D, 0);
    }
    {
        LAS float* scr = (LAS float*)(c.lds + c.wave * 16384);
        const int items = 64 * 32;
        int first = c.gw - (rot % c.ngw); if (first < 0) first += c.ngw;
        for (int it = first; it < items; it += c.ngw) {
            const int mat = it >> 5, sub = it & 31, kb = sub >> 3, nb32 = sub & 7;
            const int jl = mat >> 5, d = (mat >> 4) & 1, g = (mat >> 3) & 1, nblk = mat & 7;
            const int n0 = nb32 * 32, hf = n0 >> 7, pn = (d * 8 + nblk) * 2 + hf;
            transpose_item(P->in[I_RGGW] + (size_t)mat * 65536, 256, (bf16_t*)(ws + WS_RGGATE) + (size_t)jl * 8192 * 256, 256, kb * 64, n0, pn * 256 + g * 128 + (n0 & 127), scr, c.lane);
        }
        rot += items;
    }
    for (int m = 0; m < 3; ++m) tr_job(c, rot, P->in[I_RWRKV] + (size_t)m * D * D, D, D, D, (bf16_t*)(ws + WS_RW1), D, m * D);
    for (int d = 0; d < 2; ++d) {
        tr_job(c, rot, P->in[I_RWDEC1] + (size_t)d * D * 96, D, 96, 96, (bf16_t*)(ws + WS_RW1), D, 6144 + d * 96);
        tr_job(c, rot, P->in[I_RWICL1] + (size_t)d * D * 96, D, 96, 96, (bf16_t*)(ws + WS_RW1), D, 6400 + d * 96);
    }
    tr_job(c, rot, P->in[I_RWG1], D, 256, 256, (bf16_t*)(ws + WS_RW1), D, 6656);
    tr_job(c, rot, P->in[I_RWWO], D, D, D, (bf16_t*)(ws + WS_RWO), D, 0);
    tr_job(c, rot, P->in[I_RETWIN], D, 16384, 16384, (bf16_t*)(ws + WS_RETIN), D, 0);
    tr_job(c, rot, P->in[I_RETWOUT], 4096, D, D, (bf16_t*)(ws + WS_RETOUT), 4096, 0);
    }
    PROBE_REP(17) {
    for (size_t i = c.gtid; i < (size_t)4 * D * D / 8; i += c.ngt) { const f32x4 a = *(const f32x4*)(P->in[I_PWQ] + i * 8), b = *(const f32x4*)(P->in[I_PWQ] + i * 8 + 4);
        *(u32x4*)((bf16_t*)(ws + WS_WQN) + i * 8) = (u32x4){cvt_pk_bf16(a[0], a[1]), cvt_pk_bf16(a[2], a[3]), cvt_pk_bf16(b[0], b[1]), cvt_pk_bf16(b[2], b[3])}; }
    for (int i = c.gtid; i < 2 * 64 * (D / 8); i += c.ngt) { const int blk = i / (64 * (D / 8)), r = (i / (D / 8)) % 64, c8 = i % (D / 8);
        *(u32x4*)((bf16_t*)(ws + WS_RW1) + (size_t)(6144 + blk * 256 + 192 + r) * D + c8 * 8) = (u32x4){0u, 0u, 0u, 0u}; }
    for (int i = c.gtid; i < 4 * 2048 * 32; i += c.ngt) { const int c8 = i & 31, row = (i >> 5) & 2047, l = i >> 16; const int p = (row >> 7) & 1, col = c8 * 8;
        u32x4 o = (u32x4){0u, 0u, 0u, 0u};
        if ((col >> 7) == p) { const float* s = P->in[I_PKEYS] + ((size_t)l * 2048 + row) * 128 + (col & 127); const f32x4 a = *(const f32x4*)s, b = *(const f32x4*)(s + 4);
            o.x = cvt_pk_bf16(a[0], a[1]); o.y = cvt_pk_bf16(a[2], a[3]); o.z = cvt_pk_bf16(b[0], b[1]); o.w = cvt_pk_bf16(b[2], b[3]); }
        *(u32x4*)((bf16_t*)(ws + WS_KEYS) + ((size_t)l * 2048 + row) * 256 + col) = o; }
    for (int i = c.gtid; i < 10240 * 256; i += c.ngt) { const int kc = i & 255, r = i >> 8; float v = 0.f;
        if (r < 4096) { const int d = r >> 11, cc = r & 2047, k = kc - 96 * d; if (k >= 0 && k < 96) v = P->in[I_RWDEC2][((size_t)d * 96 + k) * D + cc]; }
        else if (r < 8192) { const int rr = r - 4096, d = rr >> 11, cc = rr & 2047, k = kc - 96 * d; if (k >= 0 && k < 96) v = P->in[I_RWICL2][((size_t)d * 96 + k) * D + cc]; }
        else v = P->in[I_RWG2][(size_t)kc * D + (r - 8192)];
        ((bf16_t*)(ws + WS_RW2))[i] = (bf16_t)(cvt_pk_bf16(v, 0.f) & 0xffffu); }
    }
    PROBE_REP(18)
    for (int i = c.gtid; i < 2 * 2 * D; i += c.ngt) ((float*)(ws + WS_SPT))[i] = -8.0f * log1pf(expf(-P->in[I_RGLAM][i]));
    PROBE_REP(18)
    for (int i = c.gtid; i < SLEN * 128; i += c.ngt) { const int pos = i >> 7, k = i & 127; const float theta = 1.0f / powf(10000.0f, (float)k / 127.0f); const float ang = (float)pos * theta;
        ((f32x2*)(ws + WS_CS))[i] = (f32x2){cosf(ang), sinf(ang)}; }
}
__device__ __forceinline__ void phase_modfin(KP P, const Ctx& c) {
    for (int i = c.gtid; i < 4 * 5 * 12288; i += c.ngt) { const int n = i % 12288, lv = i / 12288, l = lv / 5, v = lv % 5;
        float s = P->in[I_ADAB][l * 12288 + n];
        for (int kc = 0; kc < 8; ++kc) s += ((const float*)(P->ws + WS_MODP))[((size_t)(l * 8 + kc) * 5 + v) * 12288 + n];
        ((float*)(P->ws + WS_MOD))[i] = s; }
}
__device__ __forceinline__ void phase_xinit(KP P, const Ctx& c) {
    float* X = (float*)(P->ws + WS_X); bf16_t* A0 = (bf16_t*)(P->ws + WS_A0);
    for (size_t i0 = c.gtid; i0 < TD / 4; i0 += 4 * (size_t)c.ngt) {
        f32x4 x[4], sh[4], sc[4];
#pragma unroll
        for (int u = 0; u < 4; ++u) { const size_t i = i0 + (size_t)u * c.ngt; if (i < TD / 4) { const int row = (int)(i >> 9), c4 = (int)(i & 511) * 4;
            const float* src = row < NCTX ? P->in[I_CTX] + (size_t)row * D : P->in[I_X] + (size_t)(row - NCTX) * D; const int v = row_vec(row);
            x[u] = *(const f32x4*)(src + c4); sh[u] = *(const f32x4*)(modp(P, 0, v, 0) + c4); sc[u] = *(const f32x4*)(modp(P, 0, v, 1) + c4); } }
#pragma unroll
        for (int u = 0; u < 4; ++u) { const size_t i = i0 + (size_t)u * c.ngt; if (i < TD / 4) { const int row = (int)(i >> 9), c4 = (int)(i & 511) * 4;
            *(f32x4*)(X + (size_t)row * D + c4) = x[u];
            const f32x4 h = x[u] * (sc[u] + 1.0f) + sh[u];
            *(u32x2*)(A0 + (size_t)row * D + c4) = (u32x2){cvt_pk_bf16(h[0], h[1]), cvt_pk_bf16(h[2], h[3])}; } } }
}

__device__ __forceinline__ void phase_rg_conv(KP P, const Ctx& c, int jl) {
    const bf16_t* UR = (const bf16_t*)(P->ws + L_UR); bf16_t* XC = (bf16_t*)(P->ws + L_XC);
    const float* cw = P->in[I_RGCW] + (size_t)jl * 4 * D; const float* cb = P->in[I_RGCB] + (size_t)jl * D;
    const int c8 = (int)(c.gtid & 255) * 8;
    float w8[4][8], b8[8];
#pragma unroll
    for (int j = 0; j < 8; ++j) { b8[j] = cb[c8 + j];
#pragma unroll
        for (int tp = 0; tp < 4; ++tp) w8[tp][j] = cw[tp * D + c8 + j]; }
    for (size_t i0 = c.gtid; i0 < TD / 8; i0 += 2 * (size_t)c.ngt) {
        u32x4 u[2][4];
#pragma unroll
        for (int q = 0; q < 2; ++q) { const size_t i = i0 + (size_t)q * c.ngt; const int row = (int)(i >> 8);
            int lo, hi; if (row < NCTX) { lo = row & ~(CTX - 1); hi = lo + CTX; } else { lo = NCTX + ((row - NCTX) & ~(SEQ - 1)); hi = lo + SEQ; }
#pragma unroll
            for (int tp = 0; tp < 4; ++tp) { const int rr = row + tp - 2; u[q][tp] = (u32x4){0u, 0u, 0u, 0u};
                if (i < TD / 8 && rr >= lo && rr < hi) u[q][tp] = *(const u32x4*)(UR + (size_t)rr * D + c8); } }
#pragma unroll
        for (int q = 0; q < 2; ++q) { const size_t i = i0 + (size_t)q * c.ngt; if (i >= TD / 8) break; const int row = (int)(i >> 8);
            float a[8];
#pragma unroll
            for (int j = 0; j < 8; ++j) a[j] = b8[j];
#pragma unroll
            for (int tp = 0; tp < 4; ++tp) { const u32x4 uu = u[q][tp]; const unsigned u0 = uu.x, u1 = uu.y, u2 = uu.z, u3 = uu.w;
                a[0] += w8[tp][0] * bflo(u0); a[1] += w8[tp][1] * bfhi(u0); a[2] += w8[tp][2] * bflo(u1); a[3] += w8[tp][3] * bfhi(u1);
                a[4] += w8[tp][4] * bflo(u2); a[5] += w8[tp][5] * bfhi(u2); a[6] += w8[tp][6] * bflo(u3); a[7] += w8[tp][7] * bfhi(u3); }
            *(u32x4*)(XC + (size_t)row * D + c8) = (u32x4){cvt_pk_bf16(a[0], a[1]), cvt_pk_bf16(a[2], a[3]), cvt_pk_bf16(a[4], a[5]), cvt_pk_bf16(a[6], a[7])}; } }
}
__device__ __forceinline__ void phase_rg_scan1(KP P, const Ctx& c) {
    const bf16_t* LA = (const bf16_t*)(P->ws + L_LA); const bf16_t* BB = (const bf16_t*)(P->ws + L_BB);
    float* CA = (float*)(P->ws + WS_CA); float* CH = (float*)(P->ws + WS_CH);
    for (int u = c.gw; u < 2048; u += c.ngw) { const int b = u >> 9, dir = (u >> 8) & 1, ck = (u >> 2) & 63, ch = (u & 3) * 512 + c.lane * 8;
        float h[8], sl[8];
#pragma unroll
        for (int e = 0; e < 8; ++e) { h[e] = 0.f; sl[e] = 0.f; }
#pragma unroll 4
        for (int s_ = 0; s_ < 68; ++s_) { const int row = seq_row(b, dir, ck * 68 + s_); const size_t o = ((size_t)row * 2 + dir) * D + ch;
            float l8[8], b8[8]; unpack8(*(const u32x4*)(LA + o), l8); unpack8(*(const u32x4*)(BB + o), b8);
#pragma unroll
            for (int e = 0; e < 8; ++e) { h[e] = __expf(l8[e]) * h[e] + b8[e]; sl[e] += l8[e]; } }
        const size_t o = ((size_t)(b * 2 + dir) * 64 + ck) * D + ch;
        *(f32x4*)(CA + o) = (f32x4){sl[0], sl[1], sl[2], sl[3]}; *(f32x4*)(CA + o + 4) = (f32x4){sl[4], sl[5], sl[6], sl[7]};
        *(f32x4*)(CH + o) = (f32x4){h[0], h[1], h[2], h[3]}; *(f32x4*)(CH + o + 4) = (f32x4){h[4], h[5], h[6], h[7]}; }
}
__device__ __forceinline__ void phase_rg_scan2(KP P, const Ctx& c) {
    const float* CA = (const float*)(P->ws + WS_CA); const float* CH = (const float*)(P->ws + WS_CH); float* CIN = (float*)(P->ws + WS_CIN);
    for (int i = c.gtid; i < 4 * 2 * D; i += c.ngt) { const int ch = i & (D - 1), bd = i >> 11; float carry = 0.f;
#pragma unroll 16
        for (int ck = 0; ck < 64; ++ck) { const size_t o = ((size_t)bd * 64 + ck) * D + ch; const float a = CA[o], hh = CH[o]; CIN[o] = carry; carry = __expf(a) * carry + hh; } }
}
template <int DIR> __device__ __forceinline__ void phase_rg_scan3(KP P, const Ctx& c) {
    const bf16_t* LA = (const bf16_t*)(P->ws + L_LA); const bf16_t* BB = (const bf16_t*)(P->ws + L_BB); const bf16_t* UG = (const bf16_t*)(P->ws + L_UG);
    const float* CIN = (const float*)(P->ws + WS_CIN); bf16_t* YIN = (bf16_t*)(P->ws + L_YIN); bf16_t* HF = (bf16_t*)(P->ws + L_XC);
    for (int u = c.gw; u < 2048; u += c.ngw) { const int b = u >> 9, ck = (u >> 3) & 63, ch = (u & 7) * 256 + c.lane * 4;
        const f32x4 h0 = *(const f32x4*)(CIN + ((size_t)(b * 2 + DIR) * 64 + ck) * D + ch); float h[4] = {h0[0], h0[1], h0[2], h0[3]};
        u32x2 nl[4], nb[4], nf[4], ng[4];
#define SC3_LOAD(s0_) do { _Pragma("unroll") for (int i_ = 0; i_ < 4; ++i_) { const int row_ = seq_row(b, DIR, ck * 68 + (s0_) + i_); const size_t o_ = ((size_t)row_ * 2 + DIR) * D + ch, q_ = (size_t)row_ * D + ch; \
            nl[i_] = *(const u32x2*)(LA + o_); nb[i_] = *(const u32x2*)(BB + o_); if (DIR == 1) { nf[i_] = *(const u32x2*)(HF + q_); ng[i_] = *(const u32x2*)(UG + q_); } } } while (0)
        SC3_LOAD(0);
#pragma unroll 1
        for (int s0 = 0; s0 < 68; s0 += 4) { u32x2 cl[4], cb[4], cf[4], cg[4];
#pragma unroll
            for (int i = 0; i < 4; ++i) { cl[i] = nl[i]; cb[i] = nb[i]; if (DIR == 1) { cf[i] = nf[i]; cg[i] = ng[i]; } }
            if (s0 + 4 < 68) SC3_LOAD(s0 + 4);
#pragma unroll
            for (int i = 0; i < 4; ++i) { const int row = seq_row(b, DIR, ck * 68 + s0 + i); const size_t q = (size_t)row * D + ch;
                const unsigned l0 = cl[i].x, l1 = cl[i].y, b0 = cb[i].x, b1 = cb[i].y;
                h[0] = __expf(bflo(l0)) * h[0] + bflo(b0); h[1] = __expf(bfhi(l0)) * h[1] + bfhi(b0); h[2] = __expf(bflo(l1)) * h[2] + bflo(b1); h[3] = __expf(bfhi(l1)) * h[3] + bfhi(b1);
                if (DIR == 0) { *(u32x2*)(HF + q) = (u32x2){cvt_pk_bf16(h[0], h[1]), cvt_pk_bf16(h[2], h[3])}; }
                else { const unsigned f0 = cf[i].x, f1 = cf[i].y, g0 = cg[i].x, g1 = cg[i].y;
                    *(u32x2*)(YIN + q) = (u32x2){cvt_pk_bf16(bflo(g0) * (bflo(f0) + h[0]), bfhi(g0) * (bfhi(f0) + h[1])), cvt_pk_bf16(bflo(g1) * (bflo(f1) + h[2]), bfhi(g1) * (bfhi(f1) + h[3]))}; } } }
#undef SC3_LOAD
    }
}

__device__ __forceinline__ void phase_ln_mid(KP P, const Ctx& c, int layer, int row_lo) {
    float* X = (float*)(P->ws + WS_X); bf16_t* H2 = (bf16_t*)(P->ws + WS_H2);
    const float* lg = P->in[I_LNG] + (size_t)(layer * 2 + 0) * D; const float* lb = P->in[I_LNB] + (size_t)(layer * 2 + 0) * D;
    f32x4 xn[8];
#define LN_ROW(i_) ((row_lo == 0 && (i_) < 2048) ? ((i_) ^ 1024) : (i_))
    { const int i0 = row_lo + c.gw; if (i0 < T) { const int r0 = LN_ROW(i0);
#pragma unroll
        for (int j = 0; j < 8; ++j) xn[j] = *(const f32x4*)(X + (size_t)r0 * D + c.lane * 4 + 256 * j); } }
    for (int ri = row_lo + c.gw; ri < T; ri += c.ngw) { const int row = LN_ROW(ri); float* xr = X + (size_t)row * D + c.lane * 4; const int v = row_vec(row);
        f32x4 x[8]; float s = 0.f;
#pragma unroll
        for (int j = 0; j < 8; ++j) x[j] = xn[j];
        if (ri + c.ngw < T) { const int rn = LN_ROW(ri + c.ngw);
#pragma unroll
            for (int j = 0; j < 8; ++j) xn[j] = *(const f32x4*)(X + (size_t)rn * D + c.lane * 4 + 256 * j); }
        if (row < NCTX) {
            const float* gp = modp(P, layer, v, 2) + c.lane * 4; const float* px = (const float*)(P->ws + WS_S) + (size_t)row * D + c.lane * 4; const int ns = layer == 2 ? 8 : 4;
#pragma unroll
            for (int j = 0; j < 8; ++j) { constexpr size_t PS = (size_t)NCTX * D;
                const f32x4 p0 = *(const f32x4*)(px + 256 * j), p1 = *(const f32x4*)(px + PS + 256 * j), p2 = *(const f32x4*)(px + 2 * PS + 256 * j), p3 = *(const f32x4*)(px + 3 * PS + 256 * j);
                f32x4 ps = (p0 + p1) + (p2 + p3);
                if (ns == 8) { const f32x4 p4 = *(const f32x4*)(px + 4 * PS + 256 * j), p5 = *(const f32x4*)(px + 5 * PS + 256 * j), p6 = *(const f32x4*)(px + 6 * PS + 256 * j), p7 = *(const f32x4*)(px + 7 * PS + 256 * j);
                    ps += (p4 + p5) + (p6 + p7); }
                x[j] = x[j] * ALPHA + *(const f32x4*)(gp + 256 * j) * ps;
                if (j & 1) asm volatile("" ::: "memory"); } }
#pragma unroll
        for (int j = 0; j < 8; ++j) s += (x[j][0] + x[j][1]) + (x[j][2] + x[j][3]);
        const float mean = wave_sum(s) * (1.0f / D); float q = 0.f;
#pragma unroll
        for (int j = 0; j < 8; ++j) { x[j] = x[j] - mean; q += (x[j][0] * x[j][0] + x[j][1] * x[j][1]) + (x[j][2] * x[j][2] + x[j][3] * x[j][3]); }
        const float rstd = rsqrtf(wave_sum(q) * (1.0f / D) + LN_EPS);
        const float* m3 = modp(P, layer, v, 3) + c.lane * 4; const float* m4 = modp(P, layer, v, 4) + c.lane * 4;
#pragma unroll
        for (int j = 0; j < 8; ++j) { const f32x4 g = *(const f32x4*)(lg + c.lane * 4 + 256 * j), bb = *(const f32x4*)(lb + c.lane * 4 + 256 * j);
            const f32x4 y = x[j] * rstd * g + bb; *(f32x4*)(xr + 256 * j) = y;
            const f32x4 h = y * (*(const f32x4*)(m4 + 256 * j) + 1.0f) + *(const f32x4*)(m3 + 256 * j);
            *(u32x2*)(H2 + (size_t)row * D + c.lane * 4 + 256 * j) = (u32x2){cvt_pk_bf16(h[0], h[1]), cvt_pk_bf16(h[2], h[3])}; } }
#undef LN_ROW
}

__device__ __forceinline__ float dot2bf(unsigned a, unsigned b, float s) { return __builtin_amdgcn_fdot2_f32_bf16(__builtin_bit_cast(bf16v2, a), __builtin_bit_cast(bf16v2, b), s, false); }
__device__ __forceinline__ float dot8(const u32x4 a, const u32x4 b, float s) {
    const unsigned a0 = a.x, a1 = a.y, a2 = a.z, a3 = a.w, b0 = b.x, b1 = b.y, b2 = b.z, b3 = b.w;
    s = dot2bf(a0, b0, s); s = dot2bf(a1, b1, s); s = dot2bf(a2, b2, s); s = dot2bf(a3, b3, s);
    return s;
}
template <int CTRL> __device__ __forceinline__ int dpp_movi(int x) { return __builtin_amdgcn_update_dpp(x, x, CTRL, 0xF, 0xF, false); }
__device__ __forceinline__ int row_max_i(int m) { m = max(m, dpp_movi<0xB1>(m)); m = max(m, dpp_movi<0x4E>(m)); m = max(m, dpp_movi<0x141>(m)); m = max(m, dpp_movi<0x140>(m)); return m; }
template <int PAT> __device__ __forceinline__ int swz(int v) { return __builtin_amdgcn_ds_swizzle(v, PAT); }
__device__ __forceinline__ int f2key(float f) { const int b = __float_as_int(f); return b ^ ((b >> 31) & 0x7fffffff); }
__device__ __forceinline__ float key2f(int k) { return __int_as_float(k ^ ((k >> 31) & 0x7fffffff)); }
__device__ __forceinline__ void row_max_i_pair(int& a, int& b) {
    asm volatile("s_nop 1\n\t"
        "v_max_i32_dpp %0, %0, %0 quad_perm:[1,0,3,2] row_mask:0xf bank_mask:0xf\n\tv_max_i32_dpp %1, %1, %1 quad_perm:[1,0,3,2] row_mask:0xf bank_mask:0xf\n\ts_nop 0\n\t"
        "v_max_i32_dpp %0, %0, %0 quad_perm:[2,3,0,1] row_mask:0xf bank_mask:0xf\n\tv_max_i32_dpp %1, %1, %1 quad_perm:[2,3,0,1] row_mask:0xf bank_mask:0xf\n\ts_nop 0\n\t"
        "v_max_i32_dpp %0, %0, %0 row_half_mirror row_mask:0xf bank_mask:0xf\n\tv_max_i32_dpp %1, %1, %1 row_half_mirror row_mask:0xf bank_mask:0xf\n\ts_nop 0\n\t"
        "v_max_i32_dpp %0, %0, %0 row_mirror row_mask:0xf bank_mask:0xf\n\tv_max_i32_dpp %1, %1, %1 row_mirror row_mask:0xf bank_mask:0xf"
        : "+v"(a), "+v"(b));
}
__device__ __forceinline__ void phase_peer_select(KP P, const Ctx& c, int row_lo) {
    const float* S = (const float*)(P->ws + WS_S); float* SW = (float*)(P->ws + WS_SELW);
    constexpr int KMIN = (int)0x80000000;
    const int nps = (2 * (T - row_lo) - c.gw + c.ngw - 1) / c.ngw;
    f32x4 sn[2][2];
#define SEL_LOAD(k) do { const int pid_ = 2 * row_lo + c.gw + (k) * c.ngw; const float* sp_ = S + (size_t)(pid_ >> 1) * D + (2 * (pid_ & 1)) * 512 + lane * 8; \
        sn[0][0] = *(const f32x4*)sp_; sn[0][1] = *(const f32x4*)(sp_ + 4); sn[1][0] = *(const f32x4*)(sp_ + 512); sn[1][1] = *(const f32x4*)(sp_ + 516); } while (0)
    { int lane = c.lane; asm volatile("" : "+v"(lane)); if (nps > 0) SEL_LOAD(0); }
    {
#pragma unroll 1
        for (int kk = 0; kk < nps; ++kk) {
            const int pid = 2 * row_lo + c.gw + kk * c.ngw, row = pid >> 1, pp = pid & 1;
            int lane = c.lane; asm volatile("" : "+v"(lane));
            const int l16 = lane & 15, isS2 = (lane >> 4) & 1;
            int k8[2][8];
#pragma unroll
            for (int q = 0; q < 2; ++q) {
#pragma unroll
                for (int e = 0; e < 8; ++e) { const float v = sn[q][e >> 2][e & 3]; k8[q][e] = (f2key(v) & ~127) | (127 - (l16 * 8 + e)); } }
            if (kk + 1 < nps) SEL_LOAD(kk + 1);
#define SEL_CE(a, b) do { const int hi_ = max(a, b), lo_ = min(a, b); a = hi_; b = lo_; } while (0)
#pragma unroll
            for (int q = 0; q < 2; ++q) { int (&k)[8] = k8[q];
                SEL_CE(k[0], k[1]); SEL_CE(k[2], k[3]); SEL_CE(k[4], k[5]); SEL_CE(k[6], k[7]); SEL_CE(k[0], k[2]); SEL_CE(k[1], k[3]); SEL_CE(k[4], k[6]); SEL_CE(k[5], k[7]);
                SEL_CE(k[1], k[2]); SEL_CE(k[5], k[6]); SEL_CE(k[0], k[4]); SEL_CE(k[3], k[7]); SEL_CE(k[1], k[5]); SEL_CE(k[2], k[6]); SEL_CE(k[1], k[4]); SEL_CE(k[3], k[6]);
                SEL_CE(k[2], k[4]); SEL_CE(k[3], k[5]); SEL_CE(k[3], k[4]); }
            int own[2] = {KMIN, KMIN};
#pragma unroll
            for (int it = 0; it < 16; ++it) {
                int m0 = k8[0][0], m1 = k8[1][0];
                row_max_i_pair(m0, m1);
                const bool p0 = k8[0][0] == m0, p1 = k8[1][0] == m1;
#pragma unroll
                for (int e = 0; e < 7; ++e) { k8[0][e] = p0 ? k8[0][e + 1] : k8[0][e]; k8[1][e] = p1 ? k8[1][e + 1] : k8[1][e]; }
                k8[0][7] = p0 ? KMIN : k8[0][7]; k8[1][7] = p1 ? KMIN : k8[1][7];
                own[0] = (l16 == it) ? m0 : own[0]; own[1] = (l16 == it) ? m1 : own[1]; }
            int ck[2][4], ownIdx[2];
#pragma unroll
            for (int q = 0; q < 2; ++q) { ownIdx[q] = 127 - (own[q] & 127); const float ownVal = key2f(own[q]);
                int pk[4]; pk[0] = swz<(0x10 << 10) | (0 << 5) | 0x10>(own[q]); pk[1] = swz<(0x10 << 10) | (1 << 5) | 0x10>(own[q]); pk[2] = swz<(0x10 << 10) | (2 << 5) | 0x10>(own[q]); pk[3] = swz<(0x10 << 10) | (3 << 5) | 0x10>(own[q]);
#pragma unroll
                for (int m = 0; m < 4; ++m) { const float pv = key2f(pk[m]);
                    const int ci = isS2 ? m : l16, cj = isS2 ? l16 : m;
                    const bool valid = (isS2 ? (m <= l16) : (m < l16)) && ((ci + 1) * (cj + 1) <= 16);
                    ck[q][m] = valid ? ((f2key(ownVal + pv) & ~255) | (255 - (ci * 16 + cj))) : KMIN; } }
#pragma unroll
            for (int q = 0; q < 2; ++q) { int (&k)[4] = ck[q]; SEL_CE(k[0], k[1]); SEL_CE(k[2], k[3]); SEL_CE(k[0], k[2]); SEL_CE(k[1], k[3]); SEL_CE(k[1], k[2]); }
#undef SEL_CE
            int win[2] = {KMIN, KMIN};
#pragma unroll
            for (int it = 0; it < 16; ++it) {
                int m0 = ck[0][0], m1 = ck[1][0];
                row_max_i_pair(m0, m1);
                m0 = max(m0, swz<(0x10 << 10) | 0x1F>(m0)); m1 = max(m1, swz<(0x10 << 10) | 0x1F>(m1));
                const bool p0 = ck[0][0] == m0, p1 = ck[1][0] == m1;
#pragma unroll
                for (int e = 0; e < 3; ++e) { ck[0][e] = p0 ? ck[0][e + 1] : ck[0][e]; ck[1][e] = p1 ? ck[1][e + 1] : ck[1][e]; }
                ck[0][3] = p0 ? KMIN : ck[0][3]; ck[1][3] = p1 ? KMIN : ck[1][3];
                win[0] = (l16 == it) ? m0 : win[0]; win[1] = (l16 == it) ? m1 : win[1]; }
#pragma unroll
            for (int q = 0; q < 2; ++q) {
                const int cidx = 255 - (win[q] & 255), ci = (cidx >> 4) & 15, cj = cidx & 15, rb = lane & 32;
                const int i1 = __builtin_amdgcn_ds_bpermute((rb + ci) << 2, ownIdx[q]), i2 = __builtin_amdgcn_ds_bpermute((rb + 16 + cj) << 2, ownIdx[q]);
                const float sc = key2f(win[q]);
                const float mxf = key2f(row_max_i(f2key(sc)));
                const float ex = __expf(sc - mxf);
                float sum = ex; sum += dpp_mov<0xB1>(sum); sum += dpp_mov<0x4E>(sum); sum += dpp_mov<0x141>(sum); sum += dpp_mov<0x140>(sum);
                if (!isS2) { const size_t o = ((size_t)row * 8 + (2 * pp + q) * 2 + (lane >> 5)) * 16 + l16; const int e_ = (i1 * 128 + i2) & 16383; ((unsigned short*)(P->ws + P_SE16))[o] = (unsigned short)e_; SW[o] = ex / sum; } }
        }
    }
#undef SEL_LOAD
}

__device__ __forceinline__ float dot2bf_init(bf16v2 a, bf16v2 b) { float r; asm("v_dot2_f32_bf16 %0, %1, %2, 0" : "=v"(r) : "v"(a), "v"(b)); return r; }
__device__ __forceinline__ void unpack16_fp8(const u32x4 a, float (&f)[16]) {
#pragma unroll
    for (int w = 0; w < 4; ++w) { const int aw = (int)a[w]; const f32x2 lo = __builtin_amdgcn_cvt_pk_f32_fp8(aw, false), hi = __builtin_amdgcn_cvt_pk_f32_fp8(aw, true);
        f[4 * w + 0] = lo.x; f[4 * w + 1] = lo.y; f[4 * w + 2] = hi.x; f[4 * w + 3] = hi.y; }
}
#define PEER_QUEUE_BEGIN(phase_id, tg_lo, tg_hi) { \
    unsigned* heads_ = (unsigned*)(P->ws + WS_CTL) + CW_PQ + (phase_id) * 16 * 64; const unsigned x_ = ((PROBE >> 19) & 1) ? ((unsigned)blockIdx.x >> 5) & 7u : (xb_xcc_id() & 7u); \
    for (int k_ = 0; k_ < 16; ++k_) { const int db = (int)((x_ + 8u * (k_ & 1) + (unsigned)(k_ >> 1)) & 15u); \
        for (;;) { unsigned t0_ = 0; if (c.lane == 0) t0_ = __hip_atomic_fetch_add(heads_ + db * 64, 2u, __ATOMIC_RELAXED, __HIP_MEMORY_SCOPE_AGENT); \
            t0_ = (unsigned)__builtin_amdgcn_readfirstlane((int)t0_) + (unsigned)(tg_lo); if (t0_ >= (unsigned)(tg_hi)) break; \
            for (unsigned tg_ = t0_; tg_ < t0_ + 2u && tg_ < (unsigned)(tg_hi); ++tg_) { const int tg = (int)tg_;
#define PEER_QUEUE_END } } } }
__device__ __forceinline__ void phase_peer_u(KP P, const Ctx& c, int layer, int row_lo, int qrep) {
    const bf16_t* H2 = (const bf16_t*)(P->ws + WS_H2); const unsigned short* SE = (const unsigned short*)(P->ws + P_SE16);
    const unsigned char* U = P->ws + WS_PU + (size_t)layer * 16384 * D; bf16_t* PART = (bf16_t*)(P->ws + P_PART);
    PEER_QUEUE_BEGIN(layer * 2 + 0 + 8 * qrep, row_lo / 8, T / 8)
        int lane = c.lane; asm volatile("" : "+v"(lane));
        const int ts = lane >> 3, seg = lane & 7, t = tg * 8 + ts;
        const bf16_t* xp = H2 + (size_t)t * D + db * 128 + seg * 16; const u32x4 xa = *(const u32x4*)xp, xb = *(const u32x4*)(xp + 8);
        const unsigned short* se = SE + (size_t)t * 128; const unsigned char* ub = U + (size_t)db * 16384 * 128; const unsigned seg16 = (unsigned)seg * 16u;
        bf16_t* pp = PART + (((size_t)t * 16 + db) * 8 + seg) * 16;
        u32x4 eA[2], eB[2], gA[16], gB[16];
#define PU_IDX(E, st) do { _Pragma("unroll") for (int i_ = 0; i_ < 2; ++i_) E[i_] = *(const u32x4*)(se + 16 * (st) + 8 * i_); } while (0)
#define PU_GATHER(G, E) do { _Pragma("unroll") for (int k_ = 0; k_ < 16; ++k_) { const unsigned w_ = E[k_ >> 3][(k_ >> 1) & 3]; const unsigned e_ = ((k_ & 1) ? (w_ >> 16) : w_) & 16383u; G[k_] = *(const u32x4*)(ub + (unsigned)((e_ << 7) | seg16)); } } while (0)
#define PU_COMPUTE(G, OUT) do { float v2_[2]; \
            _Pragma("unroll") for (int cc = 0; cc < 2; ++cc) { float sk[8]; \
                _Pragma("unroll") for (int k = 0; k < 8; ++k) { float s0; \
                    _Pragma("unroll") for (int w = 0; w < 4; ++w) { const int gw_ = (int)G[8 * cc + k][w]; const unsigned x0 = w < 2 ? xa[2 * w] : xb[2 * w - 4], x1 = w < 2 ? xa[2 * w + 1] : xb[2 * w - 3]; \
                        if (w == 0) s0 = dot2bf_init(__builtin_amdgcn_cvt_scalef32_pk_bf16_fp8(gw_, 1.0f, false), __builtin_bit_cast(bf16v2, x0)); \
                        else s0 = __builtin_amdgcn_fdot2_f32_bf16(__builtin_amdgcn_cvt_scalef32_pk_bf16_fp8(gw_, 1.0f, false), __builtin_bit_cast(bf16v2, x0), s0, false); \
                        s0 = __builtin_amdgcn_fdot2_f32_bf16(__builtin_amdgcn_cvt_scalef32_pk_bf16_fp8(gw_, 1.0f, true), __builtin_bit_cast(bf16v2, x1), s0, false); } \
                    sk[k] = s0; } \
                sum8_quad(sk[0], sk[1], sk[2], sk[3]); sum8_quad(sk[4], sk[5], sk[6], sk[7]); \
                float v = 0.f; \
                _Pragma("unroll") for (int k = 0; k < 8; ++k) v = (seg == k) ? sk[k] : v; \
                v2_[cc] = v; } \
            OUT = cvt_pk_bf16(v2_[0], v2_[1]); } while (0)
        PU_IDX(eA, 0); PU_IDX(eB, 1); PU_GATHER(gA, eA);
#pragma unroll 1
        for (int j2 = 0; j2 < 4; ++j2) {
            PU_GATHER(gB, eB);
            if (j2 < 3) PU_IDX(eA, 2 * j2 + 2);
            unsigned pw0, pw1;
            PU_COMPUTE(gA, pw0);
            if (j2 < 3) { PU_GATHER(gA, eA); PU_IDX(eB, 2 * j2 + 3); }
            PU_COMPUTE(gB, pw1);
            *(u32x2*)(pp + 4 * j2) = (u32x2){pw0, pw1};
        }
#undef PU_IDX
#undef PU_GATHER
#undef PU_COMPUTE
    PEER_QUEUE_END
}
__device__ __forceinline__ void phase_peer_c(KP P, const Ctx& c, int layer, int row_lo) {
    const bf16_t* PART = (const bf16_t*)(P->ws + P_PART); const unsigned short* SE = (const unsigned short*)(P->ws + P_SE16); const float* SW = (const float*)(P->ws + WS_SELW);
    const float* ISU = (const float*)(P->ws + WS_PSC) + (size_t)layer * 16384; const float* ISV = ISU + (size_t)4 * 16384; bf16_t* C = (bf16_t*)(P->ws + P_C);
    for (size_t i = (size_t)row_lo * 64 + c.gtid; i < (size_t)T * 64; i += c.ngt) { const size_t t = i >> 6; const int jj = (int)(i & 7), seg = (int)((i >> 3) & 7);
        const unsigned* pp = (const unsigned*)(PART + ((t * 16) * 8 + seg) * 16 + 2 * jj); float s0 = 0.f, s1 = 0.f;
        const size_t o0 = t * 128 + 16 * jj + seg, o1 = o0 + 8; const int e0 = SE[o0] & 16383, e1 = SE[o1] & 16383; const float w0 = SW[o0], w1 = SW[o1];
        const float iu0 = ISU[e0], iv0 = ISV[e0], iu1 = ISU[e1], iv1 = ISV[e1];
#pragma unroll
        for (int db = 0; db < 16; ++db) { const unsigned w = pp[(size_t)db * 64]; s0 += __builtin_bit_cast(float, w << 16); s1 += __builtin_bit_cast(float, w & 0xffff0000u); }
        C[o0] = (bf16_t)(cvt_pk_bf16(w0 * gelu_tanh(s0 * iu0) * iv0, 0.f) & 0xffffu);
        C[o1] = (bf16_t)(cvt_pk_bf16(w1 * gelu_tanh(s1 * iu1) * iv1, 0.f) & 0xffffu); }
}
__device__ __forceinline__ void phase_peer_v(KP P, const Ctx& c, int layer, int row_lo, int qrep) {
    const unsigned short* SE = (const unsigned short*)(P->ws + P_SE16); const bf16_t* C = (const bf16_t*)(P->ws + P_C);
    const unsigned char* V = P->ws + WS_PV + (size_t)layer * 16384 * D; bf16_t* Y = (bf16_t*)(P->ws + P_Y);
    PEER_QUEUE_BEGIN(layer * 2 + 1 + 8 * qrep, row_lo / 8, T / 8)
        int lane = c.lane; asm volatile("" : "+v"(lane));
        const int ts = lane >> 3, seg = lane & 7, t = tg * 8 + ts;
        const unsigned short* se = SE + (size_t)t * 128; const bf16_t* cp = C + (size_t)t * 128; const unsigned char* vb = V + (size_t)db * 16384 * 128; const unsigned seg16 = (unsigned)seg * 16u;
        float acc[16];
#pragma unroll
        for (int e = 0; e < 16; ++e) acc[e] = 0.f;
        u32x4 en[2];
#pragma unroll
        for (int i = 0; i < 2; ++i) en[i] = *(const u32x4*)(se + 8 * i);
#pragma unroll 1
        for (int q = 0; q < 8; ++q) { u32x4 ec[2];
#pragma unroll
          for (int i = 0; i < 2; ++i) ec[i] = en[i];
          if (q < 7) {
#pragma unroll
            for (int i = 0; i < 2; ++i) en[i] = *(const u32x4*)(se + 16 * (q + 1) + 8 * i); }
          const u32x4 c0 = *(const u32x4*)(cp + 16 * q), c1 = *(const u32x4*)(cp + 16 * q + 8);
          u32x4 g[16];
#pragma unroll
          for (int k = 0; k < 16; ++k) { const unsigned w_ = ec[k >> 3][(k >> 1) & 3]; const unsigned e = ((k & 1) ? (w_ >> 16) : w_) & 16383u; g[k] = *(const u32x4*)(vb + (unsigned)((e << 7) | seg16)); }
#pragma unroll
          for (int k = 0; k < 16; k += 2) { const unsigned cwu = (k < 8 ? c0 : c1)[(k >> 1) & 3]; const bf16v2 cw = __builtin_bit_cast(bf16v2, cwu);
#pragma unroll
              for (int w = 0; w < 4; ++w) { const unsigned g0 = g[k][w], g1 = g[k + 1][w];
                  const int pa = (int)__builtin_amdgcn_perm(g1, g0, 0x05010400u), pb = (int)__builtin_amdgcn_perm(g1, g0, 0x07030602u);
                  acc[4 * w + 0] = __builtin_amdgcn_fdot2_f32_bf16(__builtin_amdgcn_cvt_scalef32_pk_bf16_fp8(pa, 1.0f, false), cw, acc[4 * w + 0], false);
                  acc[4 * w + 1] = __builtin_amdgcn_fdot2_f32_bf16(__builtin_amdgcn_cvt_scalef32_pk_bf16_fp8(pa, 1.0f, true), cw, acc[4 * w + 1], false);
                  acc[4 * w + 2] = __builtin_amdgcn_fdot2_f32_bf16(__builtin_amdgcn_cvt_scalef32_pk_bf16_fp8(pb, 1.0f, false), cw, acc[4 * w + 2], false);
                  acc[4 * w + 3] = __builtin_amdgcn_fdot2_f32_bf16(__builtin_amdgcn_cvt_scalef32_pk_bf16_fp8(pb, 1.0f, true), cw, acc[4 * w + 3], false); } } }
        bf16_t* yp = Y + (size_t)t * D + db * 128 + seg * 16;
#pragma unroll
        for (int q = 0; q < 2; ++q) *(u32x4*)(yp + 8 * q) = (u32x4){cvt_pk_bf16(acc[8 * q], acc[8 * q + 1]), cvt_pk_bf16(acc[8 * q + 2], acc[8 * q + 3]), cvt_pk_bf16(acc[8 * q + 4], acc[8 * q + 5]), cvt_pk_bf16(acc[8 * q + 6], acc[8 * q + 7])};
    PEER_QUEUE_END
}
template <bool LAST>
__device__ __forceinline__ void phase_peer_final(KP P, const Ctx& c, int layer) {
    const bf16_t* Y = (const bf16_t*)(P->ws + P_Y); float* X = (float*)(P->ws + WS_X); bf16_t* A0 = (bf16_t*)(P->ws + WS_A0);
    const float* lg = P->in[I_LNG] + (size_t)(layer * 2 + 1) * D; const float* lb = P->in[I_LNB] + (size_t)(layer * 2 + 1) * D;
    const float ymul = ((DBG_ZERO >> (2 * layer + 1)) & 1) ? 0.f : 1.f;
    f32x4 xn[8]; u32x2 yn[8];
    { const int r0 = (LAST ? NCTX : 0) + c.gw; if (r0 < T) {
#pragma unroll
        for (int j = 0; j < 8; ++j) { xn[j] = *(const f32x4*)(X + (size_t)r0 * D + c.lane * 4 + 256 * j); yn[j] = *(const u32x2*)(Y + (size_t)r0 * D + c.lane * 4 + 256 * j); } } }
    for (int row = (LAST ? NCTX : 0) + c.gw; row < T; row += c.ngw) {
        int l4 = c.lane * 4; asm volatile("" : "+v"(l4));
        const int v = row_vec(row); const float* m5 = modp(P, layer, v, 5) + l4;
        f32x4 x[8]; float s = 0.f;
#pragma unroll
        for (int j = 0; j < 8; ++j) { const u32x2 yb = yn[j]; const f32x4 yv = (f32x4){bflo(yb.x), bfhi(yb.x), bflo(yb.y), bfhi(yb.y)};
            x[j] = xn[j] * ALPHA + *(const f32x4*)(m5 + 256 * j) * (yv * ymul); s += (x[j][0] + x[j][1]) + (x[j][2] + x[j][3]); }
        if (row + c.ngw < T) {
#pragma unroll
            for (int j = 0; j < 8; ++j) { xn[j] = *(const f32x4*)(X + (size_t)(row + c.ngw) * D + l4 + 256 * j); yn[j] = *(const u32x2*)(Y + (size_t)(row + c.ngw) * D + l4 + 256 * j); } }
        const float mean = wave_sum(s) * (1.0f / D); float q = 0.f;
#pragma unroll
        for (int j = 0; j < 8; ++j) { x[j] = x[j] - mean; q += (x[j][0] * x[j][0] + x[j][1] * x[j][1]) + (x[j][2] * x[j][2] + x[j][3] * x[j][3]); }
        const float rstd = rsqrtf(wave_sum(q) * (1.0f / D) + LN_EPS);
#pragma unroll
        for (int j = 0; j < 8; ++j) { const int o = l4 + 256 * j; const f32x4 y = x[j] * rstd * *(const f32x4*)(lg + o) + *(const f32x4*)(lb + o);
            if (LAST) { *(f32x4*)(P->out + (size_t)(row - NCTX) * D + o) = y; }
            else { *(f32x4*)(X + (size_t)row * D + o) = y;
                if (layer != 0) {
                const f32x4 hv = y * (*(const f32x4*)(modp(P, layer + 1, v, 1) + o) + 1.0f) + *(const f32x4*)(modp(P, layer + 1, v, 0) + o);
                *(u32x2*)(A0 + (size_t)row * D + o) = (u32x2){cvt_pk_bf16(hv[0], hv[1]), cvt_pk_bf16(hv[2], hv[3])}; } } }
    }
}

__device__ __forceinline__ void phase_rw_mix(KP P, const Ctx& c, int layer) {
    const float* X = (const float*)(P->ws + WS_X); bf16_t* AALL = (bf16_t*)(P->ws + L_AALL); const float* mu = P->in[I_RWMU];
    float mu8[6][8];
    { const int c8 = (int)(c.gtid & 255) * 8;
#pragma unroll
      for (int m = 0; m < 6; ++m) { const f32x4 a = *(const f32x4*)(mu + m * D + c8), b = *(const f32x4*)(mu + m * D + c8 + 4);
#pragma unroll
          for (int j = 0; j < 4; ++j) { mu8[m][j] = a[j]; mu8[m][4 + j] = b[j]; } } }
    for (size_t i = c.gtid; i < TD / 8; i += c.ngt) { const int row = (int)(i >> 8), c8 = (int)(i & 255) * 8; const int v = row_vec(row);
        int nb = -1;
        if (row < NCTX) { const int t = row & (CTX - 1); if (c8 < 1024) { if (t > 0) nb = row - 1; } else { if (t < CTX - 1) nb = row + 1; } }
        else { const int t = (row - NCTX) & (SEQ - 1), qd = c8 >> 9;
            if (qd == 0) { if ((t & 63) != 0) nb = row - 1; } else if (qd == 1) { if ((t & 63) != 63) nb = row + 1; }
            else if (qd == 2) { if (t >= 64) nb = row - 64; } else { if (t < SEQ - 64) nb = row + 64; } }
        const float* sh = modp(P, layer, v, 0) + c8; const float* sc = modp(P, layer, v, 1) + c8;
        float h[8], xx[8];
#pragma unroll
        for (int j = 0; j < 8; ++j) { h[j] = X[(size_t)row * D + c8 + j] * (1.0f + sc[j]) + sh[j]; }
#pragma unroll
        for (int j = 0; j < 8; ++j) { const float s = nb >= 0 ? X[(size_t)nb * D + c8 + j] * (1.0f + sc[j]) + sh[j] : 0.f; xx[j] = s - h[j]; }
#pragma unroll
        for (int m = 0; m < 6; ++m) { float o[8];
#pragma unroll
            for (int j = 0; j < 8; ++j) o[j] = h[j] + xx[j] * mu8[m][j];
            *(u32x4*)(AALL + (size_t)row * (6 * D) + m * D + c8) = (u32x4){cvt_pk_bf16(o[0], o[1]), cvt_pk_bf16(o[2], o[3]), cvt_pk_bf16(o[4], o[5]), cvt_pk_bf16(o[6], o[7])}; } }
}
__device__ __forceinline__ void phase_rw_scan(KP P, const Ctx& c) {
    const bf16_t* R = (const bf16_t*)(P->ws + L_RKV); const bf16_t* Kx = R + TD; const bf16_t* Vx = R + 2 * TD;
    const bf16_t* W = (const bf16_t*)(P->ws + L_W); const bf16_t* AD = (const bf16_t*)(P->ws + L_AD);
    LAS float* rL = (LAS float*)c.lds; LAS float* wL = rL + 4096; LAS float* kkL = rL + 8192; LAS float* bL = rL + 12288; LAS float* kdL = rL + 16384; LAS float* vL = rL + 20480; LAS float* yL = rL + 24576; LAS float* scL = rL + 28672;
    const int tok = c.tid >> 3, cq = c.tid & 7;
    for (int chain = blockIdx.x; chain < 256; chain += gridDim.x) {
        const int b = chain >> 6, hd = (chain >> 1) & 31, dir = chain & 1;
        bf16_t* Y = (bf16_t*)(P->ws + (dir ? L_Y1 : L_Y0));
        const int ch0 = hd * 64 + cq * 8;
        float kkw[8], kaw[8];
#pragma unroll
        for (int j = 0; j < 8; ++j) { kkw[j] = P->in[I_RWKK][ch0 + j]; kaw[j] = P->in[I_RWKA][ch0 + j]; }
        float s[8] = {0.f, 0.f, 0.f, 0.f, 0.f, 0.f, 0.f, 0.f};
        u32x4 gr, gk, gv, gw, ga;
#define RW_GLOAD(ck) do { const int row_ = seq_row(b, dir, (ck) * 64 + tok); gr = *(const u32x4*)(R + (size_t)row_ * D + ch0); gk = *(const u32x4*)(Kx + (size_t)row_ * D + ch0); gv = *(const u32x4*)(Vx + (size_t)row_ * D + ch0); \
        gw = *(const u32x4*)(W + ((size_t)row_ * 2 + dir) * D + ch0); ga = *(const u32x4*)(AD + ((size_t)row_ * 2 + dir) * D + ch0); } while (0)
        RW_GLOAD(0);
        for (int ck = 0; ck < SLEN / 64; ++ck) {
            const int row = seq_row(b, dir, ck * 64 + tok);
            float r8[8], k8[8], v8[8], w8[8], a8[8];
            unpack8(gr, r8); unpack8(gk, k8); unpack8(gv, v8); unpack8(gw, w8); unpack8(ga, a8);
            float kx[8], ss = 0.f;
#pragma unroll
            for (int j = 0; j < 8; ++j) { kx[j] = k8[j] * kkw[j]; ss += kx[j] * kx[j]; }
            ss = sum8(ss);
            const float rn = rsqrtf(ss + 1e-12f);
            __syncthreads();
            float pbr = 0.f, pkr = 0.f;
            {   float wr_[8], kk_[8], b_[8], kd_[8];
#pragma unroll
                for (int j = 0; j < 8; ++j) { kk_[j] = kx[j] * rn; b_[j] = kk_[j] * a8[j]; kd_[j] = k8[j] * (1.0f + (a8[j] - 1.0f) * kaw[j]); wr_[j] = w8[j] * r8[j]; pbr += b_[j] * r8[j]; pkr += kd_[j] * r8[j]; }
                const int o = tok * 64 + cq * 8;
#pragma unroll
                for (int hh = 0; hh < 2; ++hh) { const int q = 4 * hh;
                    *(LAS f32x4*)(rL + o + q) = (f32x4){wr_[q], wr_[q + 1], wr_[q + 2], wr_[q + 3]}; *(LAS f32x4*)(wL + o + q) = (f32x4){w8[q], w8[q + 1], w8[q + 2], w8[q + 3]};
                    *(LAS f32x4*)(kkL + o + q) = (f32x4){kk_[q], kk_[q + 1], kk_[q + 2], kk_[q + 3]}; *(LAS f32x4*)(bL + o + q) = (f32x4){b_[q], b_[q + 1], b_[q + 2], b_[q + 3]};
                    *(LAS f32x4*)(kdL + o + q) = (f32x4){kd_[q], kd_[q + 1], kd_[q + 2], kd_[q + 3]}; *(LAS f32x4*)(vL + o + q) = (f32x4){v8[q], v8[q + 1], v8[q + 2], v8[q + 3]}; } }
            pbr = sum8(pbr); pkr = sum8(pkr);
            if (cq == 0) *(LAS f32x2*)(scL + tok * 2) = (f32x2){pbr, pkr};
            __syncthreads();
            if (ck + 1 < SLEN / 64) RW_GLOAD(ck + 1);
            f32x4 kaA, kbA, waA, wbA, baA, bbA, daA, dbA, raA, rbA, kaB, kbB, waB, wbB, baB, bbB, daB, dbB, raB, rbB; float vvA, vvB; f32x2 scA, scB;
#define RW_LLOAD(X, tk_) do { const int o_ = (tk_) * 64 + cq * 8; ka##X = *(const LAS f32x4*)(kkL + o_); kb##X = *(const LAS f32x4*)(kkL + o_ + 4); wa##X = *(const LAS f32x4*)(wL + o_); wb##X = *(const LAS f32x4*)(wL + o_ + 4); \
                ba##X = *(const LAS f32x4*)(bL + o_); bb##X = *(const LAS f32x4*)(bL + o_ + 4); da##X = *(const LAS f32x4*)(kdL + o_); db##X = *(const LAS f32x4*)(kdL + o_ + 4); ra##X = *(const LAS f32x4*)(rL + o_); rb##X = *(const LAS f32x4*)(rL + o_ + 4); \
                vv##X = vL[(tk_) * 64 + tok]; sc##X = *(const LAS f32x2*)(scL + (tk_) * 2); } while (0)
#define RW_STEP(X, tk_) do { \
                float sa = (fma_s(s[0], ka##X[0], mul_s(s[1], ka##X[1])) + fma_s(s[2], ka##X[2], mul_s(s[3], ka##X[3]))) + (fma_s(s[4], kb##X[0], mul_s(s[5], kb##X[1])) + fma_s(s[6], kb##X[2], mul_s(s[7], kb##X[3]))); \
                float yd = (fma_s(s[0], ra##X[0], mul_s(s[1], ra##X[1])) + fma_s(s[2], ra##X[2], mul_s(s[3], ra##X[3]))) + (fma_s(s[4], rb##X[0], mul_s(s[5], rb##X[1])) + fma_s(s[6], rb##X[2], mul_s(s[7], rb##X[3]))); \
                sum8_pair(sa, yd); \
                const float nsa = -sa; \
                _Pragma("unroll") for (int j2 = 0; j2 < 4; ++j2) { s[j2] = fma_s(vv##X, da##X[j2], fma_s(nsa, ba##X[j2], mul_s(s[j2], wa##X[j2]))); s[4 + j2] = fma_s(vv##X, db##X[j2], fma_s(nsa, bb##X[j2], mul_s(s[4 + j2], wb##X[j2]))); } \
                if (cq == 0) yL[(tk_) * 64 + tok] = yd - sa * sc##X[0] + vv##X * sc##X[1]; } while (0)
            RW_LLOAD(A, 0);
#pragma unroll 1
            for (int tk = 0; tk < 64; tk += 2) {
                RW_LLOAD(B, tk + 1);
                RW_STEP(A, tk);
                RW_LLOAD(A, (tk + 2) & 63);
                RW_STEP(B, tk + 1);
            }
#undef RW_STEP
#undef RW_LLOAD
            __syncthreads();
            { const f32x4 ya = *(const LAS f32x4*)(yL + tok * 64 + cq * 8), yb = *(const LAS f32x4*)(yL + tok * 64 + cq * 8 + 4);
              *(u32x4*)(Y + (size_t)row * D + ch0) = (u32x4){cvt_pk_bf16(ya[0], ya[1]), cvt_pk_bf16(ya[2], ya[3]), cvt_pk_bf16(yb[0], yb[1]), cvt_pk_bf16(yb[2], yb[3])}; }
        }
#undef RW_GLOAD
        __syncthreads();
    }
}
__device__ __forceinline__ void phase_rw_finish(KP P, const Ctx& c) {
    const bf16_t* R = (const bf16_t*)(P->ws + L_RKV); const bf16_t* Kx = R + TD; const bf16_t* Vx = R + 2 * TD;
    const bf16_t* AD = (const bf16_t*)(P->ws + L_AD); const bf16_t* G = (const bf16_t*)(P->ws + L_G);
    const bf16_t* Y0 = (const bf16_t*)(P->ws + L_Y0); const bf16_t* Y1 = (const bf16_t*)(P->ws + L_Y1); bf16_t* Z = (bf16_t*)(P->ws + L_Z);
    const int ch = c.lane * 8 + 512 * (c.gw & 3);
    float ka8[8], rk8[8], gg8[8], gb8[8];
#pragma unroll
    for (int e = 0; e < 8; ++e) { ka8[e] = P->in[I_RWKA][ch + e]; rk8[e] = P->in[I_RWRK][ch + e]; gg8[e] = P->in[I_RWGNG][ch + e]; gb8[e] = P->in[I_RWGNB][ch + e]; }
    u32x4 ny0, ny1, nr, nk, nv, na0, na1, ng;
#define RF_LOAD(k_) do { const int row_ = (k_) >> 2; const size_t o_ = (size_t)row_ * D + ch; ny0 = *(const u32x4*)(Y0 + o_); ny1 = *(const u32x4*)(Y1 + o_); nr = *(const u32x4*)(R + o_); nk = *(const u32x4*)(Kx + o_); \
        nv = *(const u32x4*)(Vx + o_); na0 = *(const u32x4*)(AD + ((size_t)row_ * 2 + 0) * D + ch); na1 = *(const u32x4*)(AD + ((size_t)row_ * 2 + 1) * D + ch); ng = *(const u32x4*)(G + o_); } while (0)
    if (c.gw < T * 4) RF_LOAD(c.gw);
    for (int k = c.gw; k < T * 4; k += c.ngw) { const size_t o = (size_t)(k >> 2) * D + ch;
            float y[8]; { float ya_[8], yb_[8]; unpack8(ny0, ya_); unpack8(ny1, yb_);
#pragma unroll
                for (int e = 0; e < 8; ++e) y[e] = ya_[e] + yb_[e]; }
            float r8[8], k8[8], v8[8], a0[8], a1[8], g8[8];
            unpack8(nr, r8); unpack8(nk, k8); unpack8(nv, v8); unpack8(na0, a0); unpack8(na1, a1); unpack8(ng, g8);
            if (k + c.ngw < T * 4) RF_LOAD(k + c.ngw);
            float s = 0.f;
#pragma unroll
            for (int e = 0; e < 8; ++e) s += y[e];
            const float mean = sum8(s) * (1.0f / 64.0f); float q = 0.f;
#pragma unroll
            for (int e = 0; e < 8; ++e) { y[e] -= mean; q += y[e] * y[e]; }
            const float rstd = rsqrtf(sum8(q) * (1.0f / 64.0f) + 64e-5f);
            float bsum = 0.f;
#pragma unroll
            for (int e = 0; e < 8; ++e) { const float ka = ka8[e], rk = rk8[e];
                const float kd0 = k8[e] * (1.0f + (a0[e] - 1.0f) * ka), kd1 = k8[e] * (1.0f + (a1[e] - 1.0f) * ka); bsum += r8[e] * (kd0 + kd1) * rk; }
            bsum = sum8(bsum);
            float z[8];
#pragma unroll
            for (int e = 0; e < 8; ++e) z[e] = (y[e] * rstd * gg8[e] + gb8[e] + bsum * v8[e]) * g8[e];
            *(u32x4*)(Z + o) = (u32x4){cvt_pk_bf16(z[0], z[1]), cvt_pk_bf16(z[2], z[3]), cvt_pk_bf16(z[4], z[5]), cvt_pk_bf16(z[6], z[7])}; }
#undef RF_LOAD
}

__device__ __forceinline__ bf16x8 frag16(const LAS unsigned char* p) { return *(const LAS bf16x8*)p; }
__device__ __forceinline__ void phase_ret_scan(KP P, const Ctx& c) {
    const bf16_t* Q = (const bf16_t*)(P->ws + L_RQ); const bf16_t* Kx = (const bf16_t*)(P->ws + L_RK); const bf16_t* Vx = (const bf16_t*)(P->ws + L_RV);
    constexpr int QP = 528, TP = 144, VP = 272;
    constexpr int OFF_Q = 0, OFF_K = 33792, OFF_KT = 67584, OFF_VT = 104448, OFF_P = 122880;
    LAS unsigned char* L = c.lds;
    const int w = c.wave;
    for (int un = blockIdx.x; un < 256; un += gridDim.x) {
        const int b = un >> 6, h = (un >> 3) & 7, dir = (un >> 2) & 1, dvs = un & 3;
        bf16_t* O = (bf16_t*)(P->ws + (dir ? L_OB : L_OF));
        int tid = c.tid;
        const float gamma = 1.0f - exp2f(-5.0f - (float)h), lg2 = log2f(gamma), g63 = exp2f(63.0f * lg2);
        f32x4 Racc[16];
#pragma unroll
        for (int i = 0; i < 16; ++i) Racc[i] = (f32x4){0.f, 0.f, 0.f, 0.f};
        u32x4 pq[4], pv[2];
#define RET_LOAD_QV(ck) do { \
        _Pragma("unroll") for (int i = 0; i < 4; ++i) { const int id = tid + 512 * i, s_ = id >> 5, dc = id & 31; \
            pq[i] = *(const u32x4*)(Q + (size_t)seq_row(b, dir, (ck) * 64 + s_) * D + h * 256 + dc * 8); } \
        _Pragma("unroll") for (int i = 0; i < 2; ++i) { const int id = tid + 512 * i, s_ = id >> 4, ec = id & 15; \
            pv[i] = *(const u32x4*)(Vx + (size_t)seq_row(b, dir, (ck) * 64 + s_) * 4096 + h * 512 + dvs * 128 + ec * 8); } } while (0)
#define RET_LOAD_K(ck, dst) do { \
        _Pragma("unroll") for (int i = 0; i < 4; ++i) { const int id = tid + 512 * i, s_ = id >> 5, dc = id & 31; \
            dst[i] = *(const u32x4*)(Kx + (size_t)seq_row(b, dir, (ck) * 64 + s_) * D + h * 256 + dc * 8); } } while (0)
#define RET_STORE_K(src) do { \
        _Pragma("unroll") for (int i = 0; i < 4; ++i) { const int id = tid + 512 * i, s_ = id >> 5, dc = id & 31; *(LAS u32x4*)(L + OFF_K + s_ * QP + dc * 16) = src[i]; } } while (0)
        RET_LOAD_QV(0);
        { u32x4 pk0[4]; RET_LOAD_K(0, pk0); __syncthreads(); RET_STORE_K(pk0); }
        for (int ck = 0; ck < SLEN / 64; ++ck) {
            asm volatile("" : "+v"(tid));
            const int lane = tid & 63, r16 = lane & 15, q4 = lane >> 4;
            __syncthreads();
#pragma unroll
            for (int i = 0; i < 4; ++i) { const int id = tid + 512 * i, s_ = id >> 5, dc = id & 31; *(LAS u32x4*)(L + OFF_Q + s_ * QP + dc * 16) = pq[i]; }
#pragma unroll
            for (int i = 0; i < 2; ++i) { const int id = tid + 512 * i, s_ = id >> 4, ec = id & 15; *(LAS u32x4*)(L + OFF_P + s_ * VP + ec * 16) = pv[i]; }
            __syncthreads();
            if (ck + 1 < SLEN / 64) RET_LOAD_QV(ck + 1);
            {   const float vs = exp2f(-lg2 * (float)lane);
#pragma unroll
                for (int i = 0; i < 4; ++i) { const int dc = w + 8 * i;
                    const u32x4 raw = *(const LAS u32x4*)(L + OFF_K + lane * QP + dc * 16);
#pragma unroll
                    for (int e = 0; e < 4; ++e) { *(LAS unsigned short*)(L + OFF_KT + (dc * 8 + 2 * e) * TP + lane * 2) = (unsigned short)(raw[e] & 0xffffu); *(LAS unsigned short*)(L + OFF_KT + (dc * 8 + 2 * e + 1) * TP + lane * 2) = (unsigned short)(raw[e] >> 16); } }
#pragma unroll
                for (int i = 0; i < 2; ++i) { const int ec = w + 8 * i; float t8[8]; unpack8(*(const LAS u32x4*)(L + OFF_P + lane * VP + ec * 16), t8);
#pragma unroll
                    for (int e = 0; e < 4; ++e) { const unsigned pk2 = cvt_pk_bf16(t8[2 * e] * vs, t8[2 * e + 1] * vs);
                        *(LAS unsigned short*)(L + OFF_VT + (ec * 8 + 2 * e) * TP + lane * 2) = (unsigned short)(pk2 & 0xffffu); *(LAS unsigned short*)(L + OFF_VT + (ec * 8 + 2 * e + 1) * TP + lane * 2) = (unsigned short)(pk2 >> 16); } } }
            const int it_s = w >> 1, jt0 = 2 * (w & 1);
            f32x4 s0 = (f32x4){0.f, 0.f, 0.f, 0.f}, s1 = s0;
#pragma unroll
            for (int ks = 0; ks < 8; ++ks) { const int co = (32 * ks + 8 * q4) * 2; if ((ks & 1) == 0) asm volatile("" ::: "memory");
                const bf16x8 qf = frag16(L + OFF_Q + (16 * it_s + r16) * QP + co), k0 = frag16(L + OFF_K + (16 * jt0 + r16) * QP + co), k1 = frag16(L + OFF_K + (16 * jt0 + 16 + r16) * QP + co);
                s0 = __builtin_amdgcn_mfma_f32_16x16x32_bf16(k0, qf, s0, 0, 0, 0); s1 = __builtin_amdgcn_mfma_f32_16x16x32_bf16(k1, qf, s1, 0, 0, 0); }
            __syncthreads();
            {   const int i_ = 16 * it_s + r16; const float gi = exp2f(lg2 * (float)i_);
                const int j0 = 16 * jt0 + 4 * q4, j1 = j0 + 16; float p0[4], p1[4];
#pragma unroll
                for (int r = 0; r < 4; ++r) { p0[r] = (j0 + r <= i_) ? s0[r] * gi : 0.f; p1[r] = (j1 + r <= i_) ? s1[r] * gi : 0.f; }
                *(LAS u32x2*)(L + OFF_P + i_ * TP + j0 * 2) = (u32x2){cvt_pk_bf16(p0[0], p0[1]), cvt_pk_bf16(p0[2], p0[3])};
                *(LAS u32x2*)(L + OFF_P + i_ * TP + j1 * 2) = (u32x2){cvt_pk_bf16(p1[0], p1[1]), cvt_pk_bf16(p1[2], p1[3])}; }
            __syncthreads();
            u32x4 pkn[4]; const bool has_next = ck + 1 < SLEN / 64;
            if (has_next) RET_LOAD_K(ck + 1, pkn);
            const LAS unsigned char* vtp = L + OFF_VT + (16 * w + r16) * TP + (8 * q4) * 2;
#pragma unroll
            for (int it = 0; it < 4; ++it) { const int i_ = 16 * it + r16; f32x4 a = (f32x4){0.f, 0.f, 0.f, 0.f};
                asm volatile("" ::: "memory");
#pragma unroll
                for (int m = 0; m < 8; ++m) {
                    const u32x4 t = (u32x4){cvt_pk_bf16(Racc[2 * m][0], Racc[2 * m][1]), cvt_pk_bf16(Racc[2 * m][2], Racc[2 * m][3]), cvt_pk_bf16(Racc[2 * m + 1][0], Racc[2 * m + 1][1]), cvt_pk_bf16(Racc[2 * m + 1][2], Racc[2 * m + 1][3])};
                    const LAS unsigned char* qp = L + OFF_Q + i_ * QP + (32 * m + 4 * q4) * 2; const u32x2 lo = *(const LAS u32x2*)qp, hi = *(const LAS u32x2*)(qp + 32);
                    const u32x4 tq = (u32x4){lo.x, lo.y, hi.x, hi.y}; a = __builtin_amdgcn_mfma_f32_16x16x32_bf16(__builtin_bit_cast(bf16x8, t), __builtin_bit_cast(bf16x8, tq), a, 0, 0, 0); }
                a = a * exp2f(lg2 * (float)(i_ + 1));
#pragma unroll
                for (int ks = 0; ks < 2; ++ks) a = __builtin_amdgcn_mfma_f32_16x16x32_bf16(frag16(vtp + 64 * ks), frag16(L + OFF_P + i_ * TP + (32 * ks + 8 * q4) * 2), a, 0, 0, 0);
                *(u32x2*)(O + (size_t)seq_row(b, dir, ck * 64 + i_) * 4096 + h * 512 + dvs * 128 + 16 * w + 4 * q4) = (u32x2){cvt_pk_bf16(a[0], a[1]), cvt_pk_bf16(a[2], a[3])}; }
            if (has_next) RET_STORE_K(pkn);
#pragma unroll
            for (int dt = 0; dt < 16; ++dt) { if ((dt & 1) == 0) asm volatile("" ::: "memory");
                f32x4 u = Racc[dt] * gamma;
#pragma unroll
                for (int ks = 0; ks < 2; ++ks) u = __builtin_amdgcn_mfma_f32_16x16x32_bf16(frag16(L + OFF_KT + (16 * dt + r16) * TP + (32 * ks + 8 * q4) * 2), frag16(vtp + 64 * ks), u, 0, 0, 0);
                Racc[dt] = u * g63; }
        }
#undef RET_LOAD_QV
#undef RET_LOAD_K
#undef RET_STORE_K
        __syncthreads();
    }
}
__device__ __forceinline__ void phase_ret_merge(KP P, const Ctx& c) {
    const bf16_t* OF = (const bf16_t*)(P->ws + L_OF); const bf16_t* OB = (const bf16_t*)(P->ws + L_OB); const bf16_t* GF = (const bf16_t*)(P->ws + L_GF); const bf16_t* GB = (const bf16_t*)(P->ws + L_GB);
    bf16_t* Z = (bf16_t*)(P->ws + L_RZ);
    u32x4 nf, nb, ngf, ngb;
#define RM_LOAD(k_) do { const size_t o_ = (size_t)(k_) * 512 + c.lane * 8; nf = *(const u32x4*)(OF + o_); nb = *(const u32x4*)(OB + o_); ngf = *(const u32x4*)(GF + o_); ngb = *(const u32x4*)(GB + o_); } while (0)
    if (c.gw < T * 8) RM_LOAD(c.gw);
    for (int k = c.gw; k < T * 8; k += c.ngw) { const size_t o = (size_t)k * 512 + c.lane * 8;
            float f[8], bk[8], gf[8], gb[8]; unpack8(nf, f); unpack8(nb, bk); unpack8(ngf, gf); unpack8(ngb, gb);
            if (k + c.ngw < T * 8) RM_LOAD(k + c.ngw);
            float sf = 0.f, sb = 0.f;
#pragma unroll
            for (int e = 0; e < 8; ++e) { sf += f[e]; sb += bk[e]; }
            const float mf = wave_sum(sf) * (1.0f / 512.0f), mb = wave_sum(sb) * (1.0f / 512.0f); float qf = 0.f, qb = 0.f;
#pragma unroll
            for (int e = 0; e < 8; ++e) { f[e] -= mf; bk[e] -= mb; qf += f[e] * f[e]; qb += bk[e] * bk[e]; }
            const float rf = rsqrtf(wave_sum(qf) * (1.0f / 512.0f) + LN_EPS), rb = rsqrtf(wave_sum(qb) * (1.0f / 512.0f) + LN_EPS);
            float z[8];
#pragma unroll
            for (int e = 0; e < 8; ++e) z[e] = gf[e] * (f[e] * rf) + gb[e] * (bk[e] * rb);
            *(u32x4*)(Z + o) = (u32x4){cvt_pk_bf16(z[0], z[1]), cvt_pk_bf16(z[2], z[3]), cvt_pk_bf16(z[4], z[5]), cvt_pk_bf16(z[6], z[7])}; }
#undef RM_LOAD
}

__device__ __forceinline__ Ctx make_ctx(LAS unsigned char* lds) {
    int t = threadIdx.x; asm volatile("" : "+v"(t));
    Ctx c; c.lds = lds; c.tid = t; c.lane = t & 63; c.wave = __builtin_amdgcn_readfirstlane(t >> 6);
    c.gw = blockIdx.x * 8 + c.wave; c.ngw = gridDim.x * 8; c.gtid = blockIdx.x * 512 + t; c.ngt = gridDim.x * 512; return c;
}
#define GRID_BAR() xcd_barrier(bar)
template <class Epi, class GT> __device__ __forceinline__ void run_gemm_m(LAS unsigned char* lds, const GT& g, int M, int N, const Epi& E) {
    pg8::StaticOrder S; S.init(M, N, (int)gridDim.x, (int)blockIdx.x); pg8::gemm_phase<Epi, GT>(lds, g, S, E);
}
template <class Epi, class GT> __device__ __forceinline__ void run_gemm(LAS unsigned char* lds, const GT& g, int N, const Epi& E, int pm0 = 0) {
    pg8::StaticOrder S; S.init(T, N, (int)gridDim.x, (int)blockIdx.x, pm0); pg8::gemm_phase<Epi, GT>(lds, g, S, E);
}
template <int LAYER, bool LAST> __device__ __forceinline__ void peer_phases(LAS unsigned char* lds, const XcdBarrier& bar) {
    phase_ln_mid(kp_fresh(), make_ctx(lds), LAYER, LAST ? NCTX : 0); GRID_BAR();
    PROBE_REP(2) { KP P = kp_fresh(); unsigned char* ws = P->ws; GPlain g{(const bf16_t*)(ws + WS_H2), (const bf16_t*)(ws + WS_WQ) + (size_t)LAYER * D * D, D, D, D}; EpiF32Plain E{(float*)(ws + WS_S), D}; run_gemm(lds, g, D, E, LAST ? 4 : 0);
        if (!LAST && _rep == 0) { constexpr int NR = 8 * 16384, SH = (NR + 2) / 3; const int lo = LAYER * SH, hi = (LAYER == 2) ? NR : (LAYER + 1) * SH;
            if ((int)gridDim.x == 256) { if ((int)blockIdx.x >= 32) peer_convert_rows(kp_fresh(), make_ctx(lds), lo, hi, (int)blockIdx.x - 32, 224); }
            else peer_convert_rows(kp_fresh(), make_ctx(lds), lo, hi, (int)blockIdx.x, (int)gridDim.x); }
        GRID_BAR(); }
    PROBE_REP(1) { phase_peer_select(kp_fresh(), make_ctx(lds), LAST ? NCTX : 0); GRID_BAR(); }
    PROBE_REP(0) { phase_peer_u(kp_fresh(), make_ctx(lds), LAYER, LAST ? NCTX : 0, _rep); GRID_BAR(); }
    phase_peer_c(kp_fresh(), make_ctx(lds), LAYER, LAST ? NCTX : 0); GRID_BAR();
    PROBE_REP(9) { phase_peer_v(kp_fresh(), make_ctx(lds), LAYER, LAST ? NCTX : 0, _rep); GRID_BAR(); }
    phase_peer_final<LAST>(kp_fresh(), make_ctx(lds), LAYER); GRID_BAR();
}
template <int LAYER, int JL> __device__ __forceinline__ void rg_phases(LAS unsigned char* lds, const XcdBarrier& bar) {
    PROBE_REP(6) { KP P = kp_fresh(); unsigned char* ws = P->ws; GPlain g{(const bf16_t*)(ws + WS_A0), (const bf16_t*)(ws + WS_RGIN) + (size_t)JL * 4096 * D, D, D, D}; EpiRgIn E{(bf16_t*)(ws + L_UG), (bf16_t*)(ws + L_UR)}; run_gemm(lds, g, 4096, E); GRID_BAR(); }
    PROBE_REP(7) { phase_rg_conv(kp_fresh(), make_ctx(lds), JL); GRID_BAR(); }
    { KP P = kp_fresh(); unsigned char* ws = P->ws; GGate g{(const bf16_t*)(ws + L_XC), (const bf16_t*)(ws + WS_RGGATE) + (size_t)JL * 8192 * 256, 256, D, 256};
      EpiRgGate E{(const bf16_t*)(ws + L_XC), (bf16_t*)(ws + L_LA), (bf16_t*)(ws + L_BB), P->in[I_RGGB] + (size_t)JL * 4 * D, (const float*)(ws + WS_SPT) + (size_t)JL * 2 * D}; PROBE_REP(11) { run_gemm(lds, g, 8192, E); GRID_BAR(); } }
    PROBE_REP(3) { phase_rg_scan1(kp_fresh(), make_ctx(lds)); GRID_BAR();
    phase_rg_scan2(kp_fresh(), make_ctx(lds)); GRID_BAR();
    phase_rg_scan3<0>(kp_fresh(), make_ctx(lds)); GRID_BAR();
    phase_rg_scan3<1>(kp_fresh(), make_ctx(lds)); GRID_BAR(); }
    { KP P = kp_fresh(); unsigned char* ws = P->ws; GPlain g{(const bf16_t*)(ws + L_YIN), (const bf16_t*)(ws + WS_RGOUT) + (size_t)JL * D * D, D, D, D}; EpiResid E{(float*)(ws + WS_X), modp(P, LAYER, 0, 2), ((DBG_ZERO >> (2 * LAYER)) & 1) ? 0.f : 1.f}; run_gemm(lds, g, D, E, 4);
      if (LAYER != 3) { GSplitK gs{(const bf16_t*)(ws + L_YIN), (const bf16_t*)(ws + WS_RGOUT) + (size_t)JL * D * D, 512, D, D}; EpiPartial Ep{(float*)(ws + WS_S)}; run_gemm_m(lds, gs, NCTX, 4 * D, Ep); } } GRID_BAR();
}
template <int LAYER> __device__ __forceinline__ void rw_phases(LAS unsigned char* lds, const XcdBarrier& bar) {
    PROBE_REP(7) { phase_rw_mix(kp_fresh(), make_ctx(lds), LAYER); GRID_BAR(); }
    PROBE_REP(6) { KP P = kp_fresh(); unsigned char* ws = P->ws; GRw1 g{(const bf16_t*)(ws + L_AALL), (const bf16_t*)(ws + WS_RW1), D, 6 * D, D}; EpiRw1 E{(bf16_t*)(ws + L_RKV), (bf16_t*)(ws + L_A2)}; run_gemm(lds, g, 6912, E); GRID_BAR(); }
    { KP P = kp_fresh(); unsigned char* ws = P->ws; GRw2 g{(const bf16_t*)(ws + L_A2), (const bf16_t*)(ws + WS_RW2), 256, 768, 256}; EpiRw2 E{(bf16_t*)(ws + L_W), (bf16_t*)(ws + L_AD), (bf16_t*)(ws + L_G), P->in[I_RWDEC0], P->in[I_RWICL0]}; PROBE_REP(12) { run_gemm(lds, g, 10240, E); GRID_BAR(); } }
    PROBE_REP(4) { phase_rw_scan(kp_fresh(), make_ctx(lds)); GRID_BAR(); }
    PROBE_REP(7) { phase_rw_finish(kp_fresh(), make_ctx(lds)); GRID_BAR(); }
    { KP P = kp_fresh(); unsigned char* ws = P->ws; GPlain g{(const bf16_t*)(ws + L_Z), (const bf16_t*)(ws + WS_RWO), D, D, D}; EpiResid E{(float*)(ws + WS_X), modp(P, LAYER, 0, 2), ((DBG_ZERO >> (2 * LAYER)) & 1) ? 0.f : 1.f}; run_gemm(lds, g, D, E, 4);
      GSplitK gs{(const bf16_t*)(ws + L_Z), (const bf16_t*)(ws + WS_RWO), 512, D, D}; EpiPartial Ep{(float*)(ws + WS_S)}; run_gemm_m(lds, gs, NCTX, 4 * D, Ep); } GRID_BAR();
}
template <int LAYER> __device__ __forceinline__ void ret_phases(LAS unsigned char* lds, const XcdBarrier& bar) {
    { KP P = kp_fresh(); unsigned char* ws = P->ws; GPlain g{(const bf16_t*)(ws + WS_A0), (const bf16_t*)(ws + WS_RETIN), D, D, D};
      EpiRetIn E{(bf16_t*)(ws + L_RQ), (bf16_t*)(ws + L_RK), (bf16_t*)(ws + L_RV), (bf16_t*)(ws + L_GF), (bf16_t*)(ws + L_GB), (const float*)(ws + WS_CS)}; PROBE_REP(10) { run_gemm(lds, g, 16384, E); GRID_BAR(); } }
    PROBE_REP(5) { phase_ret_scan(kp_fresh(), make_ctx(lds)); GRID_BAR(); }
    PROBE_REP(7) { phase_ret_merge(kp_fresh(), make_ctx(lds)); GRID_BAR(); }
    { KP P = kp_fresh(); unsigned char* ws = P->ws; GPlain g{(const bf16_t*)(ws + L_RZ), (const bf16_t*)(ws + WS_RETOUT), 4096, 4096, 4096}; EpiResid E{(float*)(ws + WS_X), modp(P, LAYER, 0, 2), ((DBG_ZERO >> (2 * LAYER)) & 1) ? 0.f : 1.f}; run_gemm(lds, g, D, E, 4);
      GSplitK gs{(const bf16_t*)(ws + L_RZ), (const bf16_t*)(ws + WS_RETOUT), 512, 4096, 4096}; EpiPartial Ep{(float*)(ws + WS_S)}; run_gemm_m(lds, gs, NCTX, 8 * D, Ep); } GRID_BAR();
}

__global__ void __launch_bounds__(512, 2) hybrid_fwd(Params Pkernarg) {
    extern __shared__ __attribute__((aligned(16))) unsigned char lds_raw[];
    LAS unsigned char* lds = (LAS unsigned char*)lds_raw;
    volatile LAS unsigned* MISC = (volatile LAS unsigned*)(lds + MISC_OFF);
    if (threadIdx.x < 64) MISC[threadIdx.x] = 0u;
    __syncthreads();
    XcdBarrier bar = xcd_barrier_post((unsigned*)(kp_fresh()->ws + WS_CTL) + 4096, MISC + 8);

    if ((PROBE >> 13) & 1) { for (int i = 0; i < 64; ++i) GRID_BAR(); }
    PROBE_REP(8) { phase_prologue(kp_fresh(), make_ctx(lds)); GRID_BAR(); }
    { KP P = kp_fresh(); unsigned char* ws = P->ws; GFold g{(const bf16_t*)(ws + WS_KEYS), (const bf16_t*)(ws + WS_WQN), 256, 256, D}; EpiBf16Plain E{(bf16_t*)(ws + WS_WQ), D}; run_gemm_m(lds, g, 4 * D, D, E); }
    phase_modfin(kp_fresh(), make_ctx(lds)); GRID_BAR();
    phase_xinit(kp_fresh(), make_ctx(lds)); GRID_BAR();
    rg_phases<0, 0>(lds, bar);  peer_phases<0, false>(lds, bar);
    rw_phases<1>(lds, bar);     peer_phases<1, false>(lds, bar);
    ret_phases<2>(lds, bar);    peer_phases<2, false>(lds, bar);
    rg_phases<3, 1>(lds, bar);  peer_phases<3, true>(lds, bar);
}

extern "C" void kernel_launch(void* const* d_in, const int* in_sizes, int n_in, void* d_out, int out_size, void* d_ws, size_t ws_size, hipStream_t stream) {
    static int grid = 0;
    if (!grid) {
        if (n_in != 37 || ws_size < WS_END) { fprintf(stderr, "kernel_launch: unexpected problem (n_in %d, ws %zu)\n", n_in, ws_size); grid = -1; return; }
        int dev = 0, cus = 0, per_cu = 0;
        if (hipGetDevice(&dev) != hipSuccess || hipDeviceGetAttribute(&cus, hipDeviceAttributeMultiprocessorCount, dev) != hipSuccess) { grid = -1; return; }
        if (hipFuncSetAttribute((const void*)hybrid_fwd, hipFuncAttributeMaxDynamicSharedMemorySize, LDS_BYTES) != hipSuccess) { fprintf(stderr, "kernel_launch: hipFuncSetAttribute failed\n"); grid = -1; return; }
        if (hipOccupancyMaxActiveBlocksPerMultiprocessor(&per_cu, (const void*)hybrid_fwd, 512, LDS_BYTES) != hipSuccess || per_cu < 1) { fprintf(stderr, "kernel_launch: occupancy query says %d\n", per_cu); grid = -1; return; }
        grid = cus;
    }
    if (grid <= 0) return;
    hipMemsetAsync((char*)d_ws + WS_CTL, 0, CTL_BYTES, stream);
    Params p; memset(&p, 0, sizeof(p));
    for (int i = 0; i < 37; ++i) p.in[i] = (const float*)d_in[i];
    p.out = (float*)d_out; p.ws = (unsigned char*)d_ws;
    hipLaunchKernelGGL(hybrid_fwd, dim3(grid), dim3(512), LDS_BYTES, stream, p);
}
```

```cpp
#include <hip/hip_runtime.h>
#include <cstdio>
#include <cstring>

#define LAS __attribute__((address_space(3)))
typedef unsigned short bf16_t;
typedef short bf16x8 __attribute__((ext_vector_type(8)));
typedef float f32x4 __attribute__((ext_vector_type(4)));
typedef float f32x2 __attribute__((ext_vector_type(2)));
typedef unsigned u32x4 __attribute__((ext_vector_type(4)));
typedef unsigned u32x2 __attribute__((ext_vector_type(2)));
typedef __bf16 bf16v2 __attribute__((ext_vector_type(2)));

#ifndef DBG_ZERO
#define DBG_ZERO 0
#endif
#ifndef PROBE
#define PROBE 0
#endif
#define PROBE_REP(bit) for (int _rep = 0; _rep < (((PROBE) >> (bit)) & 1) + 1; ++_rep)
constexpr int D = 2048, NBATCH = 4, SEQ = 4096, CTX = 256;
constexpr int NCTX = NBATCH * CTX, NLAT = NBATCH * SEQ, T = NCTX + NLAT;
constexpr int SLEN = CTX + SEQ;
constexpr float ALPHA = 1.681792830507429f;
constexpr float LN_EPS = 1e-5f;
constexpr size_t TD = (size_t)T * D;

constexpr size_t MiB = 1u << 20;
constexpr size_t WS_CTL = 0, CTL_BYTES = 1 * MiB;
constexpr size_t WS_MODP = 2 * MiB;
constexpr size_t WS_MOD = 10 * MiB;
constexpr size_t WS_CS = 11 * MiB;
constexpr size_t WS_SPT = 15 * MiB + 512 * 1024;
constexpr size_t WS_CA = 16 * MiB, WS_CH = 21 * MiB, WS_CIN = 26 * MiB;
constexpr size_t WS_WQ = 32 * MiB;
constexpr size_t WS_KEYS = 64 * MiB;
constexpr size_t WS_RGIN = 68 * MiB;
constexpr size_t WS_RGGATE = 100 * MiB;
constexpr size_t WS_RGOUT = 108 * MiB;
constexpr size_t WS_RW1 = 124 * MiB;
constexpr size_t WS_RW2 = 152 * MiB;
constexpr size_t WS_RWO = 160 * MiB;
constexpr size_t WS_RETIN = 168 * MiB;
constexpr size_t WS_RETOUT = 232 * MiB;
constexpr size_t WS_PU = 256 * MiB;
constexpr size_t WS_PV = 384 * MiB;
constexpr size_t WS_PSC = 512 * MiB;
constexpr size_t WS_X = 768 * MiB;
constexpr size_t WS_A0 = 904 * MiB;
constexpr size_t WS_H2 = 972 * MiB;
constexpr size_t WS_Q = 1040 * MiB;
constexpr size_t WS_WQN = 1040 * MiB;
constexpr size_t WS_S = 1108 * MiB;
constexpr size_t WS_L = 1244 * MiB;
constexpr size_t WS_SELW = 1893 * MiB;
constexpr size_t WS_END = 1902 * MiB;
constexpr size_t P_SE16 = WS_L + 288 * MiB;
constexpr size_t P_PART = WS_L, P_Y = WS_L + 136 * MiB, P_C = WS_L + 272 * MiB;
constexpr int CW_PQ = 16384;
constexpr size_t L_UG = WS_L, L_UR = WS_L + 68 * MiB, L_XC = WS_L + 136 * MiB, L_LA = WS_L + 204 * MiB, L_BB = WS_L + 340 * MiB, L_YIN = WS_L + 476 * MiB;
constexpr size_t L_AALL = WS_L;
constexpr size_t L_W = WS_L, L_AD = WS_L + 136 * MiB, L_G = WS_L + 272 * MiB;
constexpr size_t L_RKV = WS_L + 408 * MiB;
constexpr size_t L_A2 = WS_L + 612 * MiB;
constexpr size_t L_Y0 = WS_H2, L_Y1 = WS_H2 + 136 * MiB;
constexpr size_t L_Z = WS_A0;
constexpr size_t L_RQ = WS_L, L_RK = WS_L + 68 * MiB, L_RV = WS_L + 136 * MiB, L_GF = WS_L + 272 * MiB, L_GB = WS_L + 408 * MiB;
constexpr size_t L_OF = WS_H2, L_OB = WS_H2 + 136 * MiB;
constexpr size_t L_RZ = WS_L;

__device__ __forceinline__ float bf2f(unsigned b) { return __uint_as_float(b << 16); }
__device__ __forceinline__ unsigned cvt_pk_bf16(float lo, float hi) { bf16v2 t; t.x = (__bf16)lo; t.y = (__bf16)hi; return __builtin_bit_cast(unsigned, t); }
__device__ __forceinline__ float bflo(unsigned u) { return __uint_as_float(u << 16); }
__device__ __forceinline__ float bfhi(unsigned u) { return __uint_as_float(u & 0xffff0000u); }
__device__ __forceinline__ float sigmoidf_(float x) { return 1.0f / (1.0f + __expf(-x)); }
__device__ __forceinline__ float siluf_(float x) { return x / (1.0f + __expf(-x)); }
__device__ __forceinline__ float tanhf_(float x) { return 1.0f - 2.0f / (1.0f + __expf(2.0f * x)); }
__device__ __forceinline__ float gelu_tanh(float x) { const float z = 1.5957691216057308f * (x + 0.044715f * x * x * x); return x / (1.0f + __expf(-z)); }
__device__ __forceinline__ void unpack8(const u32x4 u, float (&f)[8]) { f[0] = bflo(u.x); f[1] = bfhi(u.x); f[2] = bflo(u.y); f[3] = bfhi(u.y); f[4] = bflo(u.z); f[5] = bfhi(u.z); f[6] = bflo(u.w); f[7] = bfhi(u.w); }
template <int CTRL> __device__ __forceinline__ float dpp_mov(float v) { const int x = __builtin_bit_cast(int, v); return __builtin_bit_cast(float, __builtin_amdgcn_update_dpp(x, x, CTRL, 0xF, 0xF, false)); }
__device__ __forceinline__ float rl_f(float v, int lane) { return __builtin_bit_cast(float, __builtin_amdgcn_readlane(__builtin_bit_cast(int, v), lane)); }
__device__ __forceinline__ float sum8(float v) { v += dpp_mov<0xB1>(v); v += dpp_mov<0x4E>(v); v += dpp_mov<0x141>(v); return v; }
__device__ __forceinline__ float sum16(float v) { v = sum8(v); v += dpp_mov<0x140>(v); return v; }
__device__ __forceinline__ float fma_s(float a, float b, float c) { float d; asm("v_fma_f32 %0, %1, %2, %3" : "=v"(d) : "v"(a), "v"(b), "v"(c)); return d; }
__device__ __forceinline__ float mul_s(float a, float b) { float d; asm("v_mul_f32 %0, %1, %2" : "=v"(d) : "v"(a), "v"(b)); return d; }
__device__ __forceinline__ void sum8_pair(float& a, float& b) {
    asm volatile("s_nop 1\n\t"
        "v_add_f32_dpp %0, %0, %0 quad_perm:[1,0,3,2] row_mask:0xf bank_mask:0xf\n\tv_add_f32_dpp %1, %1, %1 quad_perm:[1,0,3,2] row_mask:0xf bank_mask:0xf\n\ts_nop 0\n\t"
        "v_add_f32_dpp %0, %0, %0 quad_perm:[2,3,0,1] row_mask:0xf bank_mask:0xf\n\tv_add_f32_dpp %1, %1, %1 quad_perm:[2,3,0,1] row_mask:0xf bank_mask:0xf\n\ts_nop 0\n\t"
        "v_add_f32_dpp %0, %0, %0 row_half_mirror row_mask:0xf bank_mask:0xf\n\tv_add_f32_dpp %1, %1, %1 row_half_mirror row_mask:0xf bank_mask:0xf"
        : "+v"(a), "+v"(b));
}
__device__ __forceinline__ void sum16_pair(float& a, float& b) {
    asm volatile("s_nop 1\n\t"
        "v_add_f32_dpp %0, %0, %0 quad_perm:[1,0,3,2] row_mask:0xf bank_mask:0xf\n\tv_add_f32_dpp %1, %1, %1 quad_perm:[1,0,3,2] row_mask:0xf bank_mask:0xf\n\ts_nop 0\n\t"
        "v_add_f32_dpp %0, %0, %0 quad_perm:[2,3,0,1] row_mask:0xf bank_mask:0xf\n\tv_add_f32_dpp %1, %1, %1 quad_perm:[2,3,0,1] row_mask:0xf bank_mask:0xf\n\ts_nop 0\n\t"
        "v_add_f32_dpp %0, %0, %0 row_half_mirror row_mask:0xf bank_mask:0xf\n\tv_add_f32_dpp %1, %1, %1 row_half_mirror row_mask:0xf bank_mask:0xf\n\ts_nop 0\n\t"
        "v_add_f32_dpp %0, %0, %0 row_mirror row_mask:0xf bank_mask:0xf\n\tv_add_f32_dpp %1, %1, %1 row_mirror row_mask:0xf bank_mask:0xf"
        : "+v"(a), "+v"(b));
}
__device__ __forceinline__ void sum16_quad(float& a, float& b, float& c, float& d) {
    asm volatile("s_nop 1\n\t"
        "v_add_f32_dpp %0, %0, %0 quad_perm:[1,0,3,2] row_mask:0xf bank_mask:0xf\n\tv_add_f32_dpp %1, %1, %1 quad_perm:[1,0,3,2] row_mask:0xf bank_mask:0xf\n\t"
        "v_add_f32_dpp %2, %2, %2 quad_perm:[1,0,3,2] row_mask:0xf bank_mask:0xf\n\tv_add_f32_dpp %3, %3, %3 quad_perm:[1,0,3,2] row_mask:0xf bank_mask:0xf\n\t"
        "v_add_f32_dpp %0, %0, %0 quad_perm:[2,3,0,1] row_mask:0xf bank_mask:0xf\n\tv_add_f32_dpp %1, %1, %1 quad_perm:[2,3,0,1] row_mask:0xf bank_mask:0xf\n\t"
        "v_add_f32_dpp %2, %2, %2 quad_perm:[2,3,0,1] row_mask:0xf bank_mask:0xf\n\tv_add_f32_dpp %3, %3, %3 quad_perm:[2,3,0,1] row_mask:0xf bank_mask:0xf\n\t"
        "v_add_f32_dpp %0, %0, %0 row_half_mirror row_mask:0xf bank_mask:0xf\n\tv_add_f32_dpp %1, %1, %1 row_half_mirror row_mask:0xf bank_mask:0xf\n\t"
        "v_add_f32_dpp %2, %2, %2 row_half_mirror row_mask:0xf bank_mask:0xf\n\tv_add_f32_dpp %3, %3, %3 row_half_mirror row_mask:0xf bank_mask:0xf\n\t"
        "v_add_f32_dpp %0, %0, %0 row_mirror row_mask:0xf bank_mask:0xf\n\tv_add_f32_dpp %1, %1, %1 row_mirror row_mask:0xf bank_mask:0xf\n\t"
        "v_add_f32_dpp %2, %2, %2 row_mirror row_mask:0xf bank_mask:0xf\n\tv_add_f32_dpp %3, %3, %3 row_mirror row_mask:0xf bank_mask:0xf"
        : "+v"(a), "+v"(b), "+v"(c), "+v"(d));
}
__device__ __forceinline__ void sum8_quad(float& a, float& b, float& c, float& d) {
    asm volatile("s_nop 1\n\t"
        "v_add_f32_dpp %0, %0, %0 quad_perm:[1,0,3,2] row_mask:0xf bank_mask:0xf\n\tv_add_f32_dpp %1, %1, %1 quad_perm:[1,0,3,2] row_mask:0xf bank_mask:0xf\n\t"
        "v_add_f32_dpp %2, %2, %2 quad_perm:[1,0,3,2] row_mask:0xf bank_mask:0xf\n\tv_add_f32_dpp %3, %3, %3 quad_perm:[1,0,3,2] row_mask:0xf bank_mask:0xf\n\t"
        "v_add_f32_dpp %0, %0, %0 quad_perm:[2,3,0,1] row_mask:0xf bank_mask:0xf\n\tv_add_f32_dpp %1, %1, %1 quad_perm:[2,3,0,1] row_mask:0xf bank_mask:0xf\n\t"
        "v_add_f32_dpp %2, %2, %2 quad_perm:[2,3,0,1] row_mask:0xf bank_mask:0xf\n\tv_add_f32_dpp %3, %3, %3 quad_perm:[2,3,0,1] row_mask:0xf bank_mask:0xf\n\t"
        "v_add_f32_dpp %0, %0, %0 row_half_mirror row_mask:0xf bank_mask:0xf\n\tv_add_f32_dpp %1, %1, %1 row_half_mirror row_mask:0xf bank_mask:0xf\n\t"
        "v_add_f32_dpp %2, %2, %2 row_half_mirror row_mask:0xf bank_mask:0xf\n\tv_add_f32_dpp %3, %3, %3 row_half_mirror row_mask:0xf bank_mask:0xf"
        : "+v"(a), "+v"(b), "+v"(c), "+v"(d));
}
__device__ __forceinline__ float wave_sum(float v) { v = sum8(v); v += dpp_mov<0x140>(v); return (rl_f(v, 0) + rl_f(v, 16)) + (rl_f(v, 32) + rl_f(v, 48)); }
__device__ __forceinline__ float wave_max(float v) {
    v = fmaxf(v, dpp_mov<0xB1>(v)); v = fmaxf(v, dpp_mov<0x4E>(v)); v = fmaxf(v, dpp_mov<0x141>(v)); v = fmaxf(v, dpp_mov<0x140>(v));
    return fmaxf(fmaxf(rl_f(v, 0), rl_f(v, 16)), fmaxf(rl_f(v, 32), rl_f(v, 48)));
}
__device__ __forceinline__ int row_vec(int row) { return row < NCTX ? 4 : ((row - NCTX) >> 12); }
__device__ __forceinline__ int panel_vec(int pm) { return pm < 4 ? 4 : ((pm - 4) >> 4); }
__device__ __forceinline__ int seq_row(int b, int dir, int s) {
    if (s < CTX) { const int t = dir ? (CTX - 1 - s) : s; return b * CTX + t; }
    int t = s - CTX; if (dir) t = SEQ - 1 - t; return NCTX + b * SEQ + t;
}
__device__ __forceinline__ int row_pos(int row) { return row < NCTX ? (row & (CTX - 1)) : CTX + ((row - NCTX) & (SEQ - 1)); }

namespace pg8 {
constexpr int BM = 256, BK = 64, HALF = 128, HTB = HALF * BK * 2, STAGE_BYTES = 8 * HTB, NXCD = 8, WGM = 8;
__host__ __device__ __forceinline__ int lds_byte(int r, int c) { const int st = (r >> 4) * 2 + (c >> 5), rr = r & 15, cc = c & 31, ob = rr * 64 + cc * 2; return st * 1024 + (ob ^ (((ob >> 9) & 1) << 5)); }
__host__ __device__ __forceinline__ void stage_rc(int b, int& R, int& C) { const int st = b / 1024, sb = b % 1024, swz = sb ^ (((sb >> 9) & 1) << 5); R = (st >> 1) * 16 + swz / 64; C = (st & 1) * 32 + (swz % 64) / 2; }
__host__ __device__ __forceinline__ int perm32(int rho) { const int n = rho >> 4, i = rho & 15; return 8 * (i >> 2) + 4 * n + (i & 3); }
struct Unit { int pm, pn; };
struct StaticOrder {
    int nM, nN, nwg, G, c, pm0;
    __device__ void init(int M, int N, int G_, int c_, int pm0_ = 0) { pm0 = pm0_; nM = M / BM - pm0_; nN = N / BM; nwg = nM * nN; G = G_; c = c_; }
    __device__ bool next(int i, Unit& u) const {
        const long L = (long)i * G + c; if (L >= nwg) return false;
        int wgid = (int)L; { const int q = nwg / NXCD, r = nwg % NXCD, xcd = wgid % NXCD, off = wgid / NXCD; wgid = (xcd < r ? xcd * (q + 1) : r * (q + 1) + (xcd - r) * q) + off; }
        const int nig = WGM * nN, gid = wgid / nig, fm = gid * WGM, gsz = (nM - fm) < WGM ? (nM - fm) : WGM;
        u.pm = pm0 + fm + ((wgid % nig) % gsz); u.pn = (wgid % nig) / gsz; return true;
    }
};
template <class Epi, class GT>
__device__ __forceinline__ void gemm_phase(LAS unsigned char* lds, const GT g, const StaticOrder& S, const Epi& E) {
    int tid_ = threadIdx.x; asm volatile("" : "+v"(tid_));
    const int tid = tid_, wid = __builtin_amdgcn_readfirstlane(tid >> 6), lane = tid & 63, wr = wid >> 2, wc = wid & 3, fr = lane & 15, fq = lane >> 4;
    const int K = g.K, nt = K / BK;
    unsigned voffA[2], voffB[2];
#pragma unroll
    for (int i = 0; i < 2; ++i) { int R, C; stage_rc(tid * 16 + i * 8192, R, C); const int Rb = Epi::PERM ? ((R & ~31) + perm32(R & 31)) : R;
        voffA[i] = (unsigned)(R * g.lda + C) * 2u; voffB[i] = (unsigned)(Rb * g.ldb + C) * 2u; }
    const size_t kstep = (size_t)(BK * 2);
    const size_t hstepA = (size_t)HALF * g.lda * 2, hstepB = (size_t)HALF * g.ldb * 2;
    const unsigned ldsw = (unsigned)wid * 1024u;
    const int aoff = lds_byte(wr * 64 + fr, fq * 8), boff = lds_byte(wc * 32 + fr, fq * 8);
#define PG8_SA(b, h) (((b) * 2 + (h)) * HTB)
#define PG8_SB(b, h) ((4 + (b) * 2 + (h)) * HTB)
#define PG8_STAGE(bufoff, gbase, voff) do { _Pragma("unroll") for (int _i = 0; _i < 2; ++_i) \
        __builtin_amdgcn_global_load_lds((const unsigned*)((const char*)(gbase) + (voff)[_i]), (LAS unsigned*)(lds + (bufoff) + ldsw + _i * 8192), 16, 0, 0); } while (0)
#define PG8_LDA(dst, b, h) do { _Pragma("unroll") for (int m = 0; m < 4; ++m) _Pragma("unroll") for (int k = 0; k < 2; ++k) dst[m][k] = *(const LAS bf16x8*)(lds + PG8_SA(b, h) + aoff + m * 2048 + k * 1024); } while (0)
#define PG8_LDB(dst, b, h) do { _Pragma("unroll") for (int n = 0; n < 2; ++n) _Pragma("unroll") for (int k = 0; k < 2; ++k) dst[n][k] = *(const LAS bf16x8*)(lds + PG8_SB(b, h) + boff + n * 2048 + k * 1024); } while (0)
#define PG8_MMA(ai, bj, At, Bt) do { __builtin_amdgcn_s_setprio(1); _Pragma("unroll") for (int m = 0; m < 4; ++m) _Pragma("unroll") for (int n = 0; n < 2; ++n) _Pragma("unroll") for (int k = 0; k < 2; ++k) \
        acc[ai][bj][m][n] = __builtin_amdgcn_mfma_f32_16x16x32_bf16(Bt[n][k], At[m][k], acc[ai][bj][m][n], 0, 0, 0); __builtin_amdgcn_s_setprio(0); } while (0)
#define PG8_WAIT_V(n) asm volatile("s_waitcnt vmcnt(" #n ")" ::: "memory")
#define PG8_WAIT_L(n) asm volatile("s_waitcnt lgkmcnt(" #n ")" ::: "memory")
#define PG8_BAR __builtin_amdgcn_s_barrier()
#define PG8_SCHED __builtin_amdgcn_sched_barrier(0)
    Unit cur, nxt; int ui = 0;
    if (!S.next(0, cur)) return;
    f32x4 acc[2][2][4][2];
#pragma unroll
    for (int a = 0; a < 2; ++a)
#pragma unroll
        for (int b = 0; b < 2; ++b)
#pragma unroll
            for (int m = 0; m < 4; ++m)
#pragma unroll
                for (int n = 0; n < 2; ++n) acc[a][b][m][n] = (f32x4){0.f, 0.f, 0.f, 0.f};
    bf16x8 At[4][2], B0[2][2], B1[2][2];
    const char* cA = g.a_ptr(cur); const char* cB = g.b_ptr(cur);
    PG8_STAGE(PG8_SB(0, 0), cB, voffB); PG8_STAGE(PG8_SA(0, 0), cA, voffA); PG8_STAGE(PG8_SB(0, 1), cB + hstepB, voffB); PG8_STAGE(PG8_SA(0, 1), cA + hstepA, voffA);
    if (wr == 1) PG8_BAR;
    PG8_WAIT_V(4); PG8_BAR;
    PG8_STAGE(PG8_SB(1, 0), cB + kstep, voffB); PG8_STAGE(PG8_SA(1, 0), cA + kstep, voffA); PG8_STAGE(PG8_SB(1, 1), cB + hstepB + kstep, voffB);
    PG8_WAIT_V(6); PG8_BAR;
    for (;;) {
        const bool has_next = S.next(ui + 1, nxt);
        const char* nA = has_next ? g.a_ptr(nxt) : cA; const char* nB = has_next ? g.b_ptr(nxt) : cB;
        for (int t = 0; t < nt; t += 2) {
            const bool last = (t == nt - 2);
            const char* a1 = cA + (size_t)(t + 1) * kstep;
            const char* a2 = last ? nA : cA + (size_t)(t + 2) * kstep; const char* b2 = last ? nB : cB + (size_t)(t + 2) * kstep;
            const char* a3 = a2 + kstep; const char* b3 = b2 + kstep;
            PG8_LDB(B0, 0, 0); PG8_SCHED; PG8_LDA(At, 0, 0); PG8_STAGE(PG8_SA(1, 1), a1 + hstepA, voffA);
            PG8_WAIT_L(8); PG8_BAR; PG8_WAIT_L(0); PG8_MMA(0, 0, At, B0); PG8_BAR; PG8_SCHED;
            PG8_LDB(B1, 0, 1); PG8_STAGE(PG8_SB(0, 0), b2, voffB);
            PG8_BAR; PG8_WAIT_L(0); PG8_MMA(0, 1, At, B1); PG8_BAR;
            PG8_LDA(At, 0, 1); PG8_STAGE(PG8_SA(0, 0), a2, voffA);
            PG8_BAR; PG8_WAIT_L(0); PG8_MMA(1, 0, At, B0); PG8_BAR; PG8_SCHED;
            PG8_STAGE(PG8_SB(0, 1), b2 + hstepB, voffB);
            PG8_WAIT_V(6); PG8_BAR; PG8_MMA(1, 1, At, B1); PG8_BAR;
            PG8_LDB(B0, 1, 0); PG8_SCHED; PG8_LDA(At, 1, 0); PG8_STAGE(PG8_SA(0, 1), a2 + hstepA, voffA);
            PG8_WAIT_L(8); PG8_BAR; PG8_WAIT_L(0); PG8_MMA(0, 0, At, B0); PG8_BAR; PG8_SCHED;
            PG8_LDB(B1, 1, 1); PG8_STAGE(PG8_SB(1, 0), b3, voffB);
            PG8_BAR; PG8_WAIT_L(0); PG8_MMA(0, 1, At, B1); PG8_BAR;
            PG8_LDA(At, 1, 1); PG8_STAGE(PG8_SA(1, 0), a3, voffA);
            PG8_BAR; PG8_WAIT_L(0); PG8_MMA(1, 0, At, B0); PG8_BAR; PG8_SCHED;
            PG8_STAGE(PG8_SB(1, 1), b3 + hstepB, voffB);
            PG8_WAIT_V(6); PG8_BAR; PG8_MMA(1, 1, At, B1); PG8_BAR;
        }
        E(acc, cur, wr, wc, fr, fq);
        if (!has_next) break;
#pragma unroll
        for (int a = 0; a < 2; ++a)
#pragma unroll
            for (int b = 0; b < 2; ++b)
#pragma unroll
                for (int m = 0; m < 4; ++m)
#pragma unroll
                    for (int n = 0; n < 2; ++n) acc[a][b][m][n] = (f32x4){0.f, 0.f, 0.f, 0.f};
        cur = nxt; cA = nA; cB = nB; ++ui;
    }
    PG8_WAIT_V(0);
    if (wr == 0) PG8_BAR;
    PG8_BAR;
#undef PG8_SA
#undef PG8_SB
#undef PG8_STAGE
#undef PG8_LDA
#undef PG8_LDB
#undef PG8_MMA
#undef PG8_WAIT_V
#undef PG8_WAIT_L
#undef PG8_BAR
#undef PG8_SCHED
}
}
using pg8::Unit;
typedef const f32x4 (&AccRef)[2][2][4][2];

#define XB_TMO      128
#define XB_XCNT(j)  (256  + 64 * (j))
#define XB_XSUB(j)  (1280 + 64 * (j))
#define XB_XGEN(j)  (2304 + 64 * (j))
#define XB_TOP      3328
#define XB_TOPGEN   3392
#define XCD_BAR_WORDS 3456
#define XB_SPIN_CAP (1u << 18)
__device__ __forceinline__ unsigned xb_ld(unsigned* p)              { return __hip_atomic_load(p, __ATOMIC_RELAXED, __HIP_MEMORY_SCOPE_AGENT); }
__device__ __forceinline__ unsigned xb_add(unsigned* p, unsigned v) { return __hip_atomic_fetch_add(p, v, __ATOMIC_RELAXED, __HIP_MEMORY_SCOPE_AGENT); }
__device__ __forceinline__ unsigned xb_xcc_id() { return (unsigned)__builtin_amdgcn_s_getreg((3 << 11) | 20) & 0xFu; }
#define XB_SPIN(cond, bar) do { unsigned _sp = 0; while (cond) { __builtin_amdgcn_s_sleep(1); \
    if ((++_sp & 255u) == 0u) { if (xb_ld(&(bar)[XB_TMO])) break; if (_sp > XB_SPIN_CAP) { atomicAdd(&(bar)[XB_TMO], 1u); break; } } } } while (0)
struct XcdBarrier { unsigned* bar; unsigned x; volatile LAS unsigned* st; };
__device__ __forceinline__ XcdBarrier xcd_barrier_post(unsigned* bar, volatile LAS unsigned* st) {
    XcdBarrier b; b.bar = bar; b.x = xb_xcc_id(); b.st = st;
    if (threadIdx.x == 0) (void)xb_add(&bar[XB_XCNT(b.x)], 1u);
    return b;
}
__device__ __forceinline__ void xcd_barrier_complete(unsigned* bar, unsigned x, unsigned& nloc, unsigned& nx) {
    const unsigned G = gridDim.x * gridDim.y * gridDim.z;
    unsigned sum, cnt, mine, sp = 0u;
    for (;;) {
        sum = 0u; cnt = 0u; mine = 0u;
#pragma unroll
        for (unsigned j = 0; j < 16; ++j) { const unsigned c = xb_ld(&bar[XB_XCNT(j)]); sum += c; cnt += (c > 0u) ? 1u : 0u; mine = (j == x) ? c : mine; }
        if (sum == G) break;
        __builtin_amdgcn_s_sleep(1);
        if ((++sp & 255u) == 0u) { if (xb_ld(&bar[XB_TMO])) break; if (sp > XB_SPIN_CAP) { atomicAdd(&bar[XB_TMO], 1u); break; } }
    }
    nloc = mine > 0u ? mine : 1u; nx = cnt > 0u ? cnt : 1u;
}
__device__ __forceinline__ void xcd_barrier(const XcdBarrier& b) {
    asm volatile("s_waitcnt vmcnt(0)" ::: "memory");
    __syncthreads();
    if (threadIdx.x == 0) {
        unsigned* bar = b.bar;
        __builtin_amdgcn_s_waitcnt(0);
        unsigned nloc = b.st[0], nx = b.st[1];
        if (nloc == 0u) { xcd_barrier_complete(bar, b.x, nloc, nx); b.st[0] = nloc; b.st[1] = nx; }
        const unsigned old = xb_add(&bar[XB_XSUB(b.x)], 1u);
        const unsigned gen = old / nloc;
        if (old + 1u == (gen + 1u) * nloc) {
            __builtin_amdgcn_fence(__ATOMIC_RELEASE, "agent");
            asm volatile("s_waitcnt vmcnt(0)" ::: "memory");
            const unsigned og = xb_add(&bar[XB_TOP], 1u);
            const unsigned tg = og / nx;
            if (og + 1u == (tg + 1u) * nx) xb_add(&bar[XB_TOPGEN], 1u);
            else XB_SPIN(xb_ld(&bar[XB_TOPGEN]) == tg, bar);
            __builtin_amdgcn_fence(__ATOMIC_ACQUIRE, "agent");
            xb_add(&bar[XB_XGEN(b.x)], 1u);
            asm volatile("s_waitcnt vmcnt(0)" ::: "memory");
        } else {
            XB_SPIN(xb_ld(&bar[XB_XGEN(b.x)]) == gen, bar);
            __builtin_amdgcn_fence(__ATOMIC_ACQUIRE, "agent");
            asm volatile("s_waitcnt vmcnt(0)" ::: "memory");
        }
    }
    __syncthreads();
}

struct Params { const float* in[37]; float* out; unsigned char* ws; };
typedef const __attribute__((address_space(4))) Params* KP;
__device__ __forceinline__ KP kp_fresh() { KP p = (KP)__builtin_amdgcn_kernarg_segment_ptr(); asm volatile("" : "+s"(p)); return p; }
enum { I_X = 0, I_C, I_CTX, I_CCTX, I_ADAW, I_ADAB, I_LNG, I_LNB, I_PWQ, I_PKEYS, I_PU, I_PV, I_RGWIN, I_RGCW, I_RGCB, I_RGGW, I_RGGB, I_RGLAM, I_RGWOUT,
       I_RWMU, I_RWRKV, I_RWWO, I_RWDEC0, I_RWDEC1, I_RWDEC2, I_RWICL0, I_RWICL1, I_RWICL2, I_RWG1, I_RWG2, I_RWKK, I_RWKA, I_RWRK, I_RWGNG, I_RWGNB, I_RETWIN, I_RETWOUT };
constexpr int LDS_BYTES = 147456;
constexpr int MISC_OFF = 147200;

__device__ __forceinline__ const float* modp(KP P, int layer, int v, int slot) { return (const float*)(P->ws + WS_MOD) + ((size_t)(layer * 5 + v) * 6 + slot) * D; }

struct GPlain { const bf16_t* A; const bf16_t* Bt; int K, lda, ldb;
    __device__ __forceinline__ const char* a_ptr(const Unit& u) const { return (const char*)(A + (size_t)u.pm * 256 * lda); }
    __device__ __forceinline__ const char* b_ptr(const Unit& u) const { return (const char*)(Bt + (size_t)u.pn * 256 * ldb); } };
struct GGate { const bf16_t* A; const bf16_t* Bt; int K, lda, ldb;
    __device__ __forceinline__ const char* a_ptr(const Unit& u) const { return (const char*)(A + (size_t)u.pm * 256 * lda + ((u.pn >> 1) & 7) * 256); }
    __device__ __forceinline__ const char* b_ptr(const Unit& u) const { return (const char*)(Bt + (size_t)u.pn * 256 * ldb); } };
struct GScore { const bf16_t* A; const bf16_t* Bt; int K, lda, ldb;
    __device__ __forceinline__ const char* a_ptr(const Unit& u) const { return (const char*)(A + (size_t)u.pm * 256 * lda + u.pn * 256); }
    __device__ __forceinline__ const char* b_ptr(const Unit& u) const { return (const char*)(Bt + (size_t)u.pn * 256 * ldb); } };
struct GFold { const bf16_t* A; const bf16_t* Bt; int K, lda, ldb;
    __device__ __forceinline__ const char* a_ptr(const Unit& u) const { return (const char*)(A + (size_t)u.pm * 256 * lda); }
    __device__ __forceinline__ const char* b_ptr(const Unit& u) const { return (const char*)(Bt + (size_t)(u.pm >> 3) * D * D + (size_t)u.pn * 256 * ldb + (u.pm & 7) * 256); } };
struct GRw1 { const bf16_t* A; const bf16_t* Bt; int K, lda, ldb;
    __device__ __forceinline__ const char* a_ptr(const Unit& u) const { const int blk = u.pn < 24 ? (u.pn >> 3) : (u.pn - 21); return (const char*)(A + (size_t)u.pm * 256 * lda + blk * 2048); }
    __device__ __forceinline__ const char* b_ptr(const Unit& u) const { return (const char*)(Bt + (size_t)u.pn * 256 * ldb); } };
struct GRw2 { const bf16_t* A; const bf16_t* Bt; int K, lda, ldb;
    __device__ __forceinline__ const char* a_ptr(const Unit& u) const { const int blk = u.pn < 16 ? 0 : (u.pn < 32 ? 1 : 2); return (const char*)(A + (size_t)u.pm * 256 * lda + blk * 256); }
    __device__ __forceinline__ const char* b_ptr(const Unit& u) const { return (const char*)(Bt + (size_t)u.pn * 256 * ldb); } };

template <int ACT> __device__ __forceinline__ float actf(float x) {
    if (ACT == 1) return gelu_tanh(x); if (ACT == 2) return tanhf_(x); if (ACT == 3) return sigmoidf_(x); if (ACT == 4) return siluf_(x); return x; }
template <int ACT> __device__ __forceinline__ void store_tile_bf16(AccRef acc, bf16_t* dst, int ld, int row0, int col0) {
#pragma unroll
    for (int ai = 0; ai < 2; ++ai)
#pragma unroll
        for (int m = 0; m < 4; ++m) { bf16_t* rowp = dst + (size_t)(row0 + ai * 128 + m * 16) * ld + col0;
#pragma unroll
            for (int bj = 0; bj < 2; ++bj) { const f32x4 v0 = acc[ai][bj][m][0], v1 = acc[ai][bj][m][1];
                u32x4 w; w.x = cvt_pk_bf16(actf<ACT>(v0[0]), actf<ACT>(v0[1])); w.y = cvt_pk_bf16(actf<ACT>(v0[2]), actf<ACT>(v0[3]));
                w.z = cvt_pk_bf16(actf<ACT>(v1[0]), actf<ACT>(v1[1])); w.w = cvt_pk_bf16(actf<ACT>(v1[2]), actf<ACT>(v1[3]));
                *(u32x4*)(rowp + bj * 128) = w; } }
}
struct EpiBf16Plain { static constexpr bool PERM = true; bf16_t* O; int ldc;
    __device__ __forceinline__ void operator()(AccRef acc, const Unit& u, int wr, int wc, int fr, int fq) const {
        store_tile_bf16<0>(acc, O, ldc, u.pm * 256 + wr * 64 + fr, u.pn * 256 + wc * 32 + 8 * fq); } };
struct EpiF32Plain { static constexpr bool PERM = false; float* C; int ldc;
    __device__ __forceinline__ void operator()(AccRef acc, const Unit& u, int wr, int wc, int fr, int fq) const {
        const int row0 = u.pm * 256 + wr * 64 + fr, col0 = u.pn * 256 + wc * 32 + 4 * fq;
#pragma unroll
        for (int ai = 0; ai < 2; ++ai)
#pragma unroll
            for (int m = 0; m < 4; ++m) { float* rowp = C + (size_t)(row0 + ai * 128 + m * 16) * ldc + col0;
#pragma unroll
                for (int bj = 0; bj < 2; ++bj)
#pragma unroll
                    for (int n = 0; n < 2; ++n) *(f32x4*)(rowp + bj * 128 + n * 16) = acc[ai][bj][m][n]; } } };
struct GSplitK { const bf16_t* A; const bf16_t* Bt; int K, lda, ldb;
    __device__ __forceinline__ const char* a_ptr(const Unit& u) const { return (const char*)(A + (size_t)u.pm * 256 * lda + (u.pn >> 3) * 512); }
    __device__ __forceinline__ const char* b_ptr(const Unit& u) const { return (const char*)(Bt + (size_t)(u.pn & 7) * 256 * ldb + (u.pn >> 3) * 512); } };
struct EpiPartial { static constexpr bool PERM = false; float* PX;
    __device__ __forceinline__ void operator()(AccRef acc, const Unit& u, int wr, int wc, int fr, int fq) const {
        const int row0 = u.pm * 256 + wr * 64 + fr, col0 = (u.pn & 7) * 256 + wc * 32 + 4 * fq; float* base = PX + (size_t)(u.pn >> 3) * NCTX * D;
#pragma unroll
        for (int ai = 0; ai < 2; ++ai)
#pragma unroll
            for (int m = 0; m < 4; ++m) { float* rowp = base + (size_t)(row0 + ai * 128 + m * 16) * D + col0;
#pragma unroll
                for (int bj = 0; bj < 2; ++bj)
#pragma unroll
                    for (int n = 0; n < 2; ++n) *(f32x4*)(rowp + bj * 128 + n * 16) = acc[ai][bj][m][n]; } } };
struct EpiResid { static constexpr bool PERM = false; float* X; const float* gate_base; float ymul;
    __device__ __forceinline__ void operator()(AccRef acc, const Unit& u, int wr, int wc, int fr, int fq) const {
        const int row0 = u.pm * 256 + wr * 64 + fr, col0 = u.pn * 256 + wc * 32 + 4 * fq;
        const float* gp = gate_base + (size_t)panel_vec(u.pm) * 6 * D + col0;
        f32x4 gv[2][2];
#pragma unroll
        for (int bj = 0; bj < 2; ++bj)
#pragma unroll
            for (int n = 0; n < 2; ++n) gv[bj][n] = *(const f32x4*)(gp + bj * 128 + n * 16);
#pragma unroll
        for (int ai = 0; ai < 2; ++ai)
#pragma unroll
            for (int m = 0; m < 4; ++m) { float* rowp = X + (size_t)(row0 + ai * 128 + m * 16) * D + col0;
#pragma unroll
                for (int bj = 0; bj < 2; ++bj)
#pragma unroll
                    for (int n = 0; n < 2; ++n) { f32x4* p = (f32x4*)(rowp + bj * 128 + n * 16); const f32x4 x = *p; *p = x * ALPHA + gv[bj][n] * (acc[ai][bj][m][n] * ymul); } } } };
struct EpiRgIn { static constexpr bool PERM = true; bf16_t* UG; bf16_t* UR;
    __device__ __forceinline__ void operator()(AccRef acc, const Unit& u, int wr, int wc, int fr, int fq) const {
        const int row0 = u.pm * 256 + wr * 64 + fr, col0 = (u.pn & 7) * 256 + wc * 32 + 8 * fq;
        if (u.pn < 8) store_tile_bf16<1>(acc, UG, D, row0, col0); else store_tile_bf16<0>(acc, UR, D, row0, col0); } };
struct EpiRgGate { static constexpr bool PERM = true; const bf16_t* XC; bf16_t* LA; bf16_t* BB; const float* gate_b; const float* spt;
    __device__ __forceinline__ void operator()(AccRef acc, const Unit& u, int wr, int wc, int fr, int fq) const {
        const int d = u.pn >> 4, ch0 = ((u.pn >> 1) & 7) * 256 + (u.pn & 1) * 128 + wc * 32 + 8 * fq;
        const int row0 = u.pm * 256 + wr * 64 + fr;
        float br[8], bi[8], sp[8];
#pragma unroll
        for (int j = 0; j < 8; ++j) { br[j] = gate_b[(d * 2 + 0) * D + ch0 + j]; bi[j] = gate_b[(d * 2 + 1) * D + ch0 + j];
            sp[j] = spt[d * D + ch0 + j]; }
#pragma unroll
        for (int ai = 0; ai < 2; ++ai)
#pragma unroll
            for (int m = 0; m < 4; ++m) { const int row = row0 + ai * 128 + m * 16;
                const u32x4 xr = *(const u32x4*)(XC + (size_t)row * D + ch0);
                float xc[8] = {bflo(xr.x), bfhi(xr.x), bflo(xr.y), bfhi(xr.y), bflo(xr.z), bfhi(xr.z), bflo(xr.w), bfhi(xr.w)};
                float la[8], bb[8];
#pragma unroll
                for (int j = 0; j < 8; ++j) { const float ar = acc[ai][0][m][j >> 2][j & 3], ai_ = acc[ai][1][m][j >> 2][j & 3];
                    const float rg = sigmoidf_(ar + br[j]), ig = sigmoidf_(ai_ + bi[j]);
                    const float l = sp[j] * rg; la[j] = l; bb[j] = sqrtf(1.0f - __expf(2.0f * l)) * (ig * xc[j]); }
                u32x4 w; w.x = cvt_pk_bf16(la[0], la[1]); w.y = cvt_pk_bf16(la[2], la[3]); w.z = cvt_pk_bf16(la[4], la[5]); w.w = cvt_pk_bf16(la[6], la[7]);
                *(u32x4*)(LA + ((size_t)row * 2 + d) * D + ch0) = w;
                w.x = cvt_pk_bf16(bb[0], bb[1]); w.y = cvt_pk_bf16(bb[2], bb[3]); w.z = cvt_pk_bf16(bb[4], bb[5]); w.w = cvt_pk_bf16(bb[6], bb[7]);
                *(u32x4*)(BB + ((size_t)row * 2 + d) * D + ch0) = w; } } };
struct EpiRw1 { static constexpr bool PERM = true; bf16_t* RKV; bf16_t* A2;
    __device__ __forceinline__ void operator()(AccRef acc, const Unit& u, int wr, int wc, int fr, int fq) const {
        const int row0 = u.pm * 256 + wr * 64 + fr, cw = wc * 32 + 8 * fq;
        if (u.pn < 24) store_tile_bf16<0>(acc, RKV + (size_t)(u.pn >> 3) * TD, D, row0, (u.pn & 7) * 256 + cw);
        else if (u.pn == 24) store_tile_bf16<2>(acc, A2, 768, row0, cw);
        else if (u.pn == 25) store_tile_bf16<0>(acc, A2, 768, row0, 256 + cw);
        else store_tile_bf16<3>(acc, A2, 768, row0, 512 + cw); } };
struct EpiRw2 { static constexpr bool PERM = true; bf16_t* W; bf16_t* AD; bf16_t* G; const float* dec0; const float* icl0;
    __device__ __forceinline__ void operator()(AccRef acc, const Unit& u, int wr, int wc, int fr, int fq) const {
        const int row0 = u.pm * 256 + wr * 64 + fr, c0 = (u.pn & 7) * 256 + wc * 32 + 8 * fq;
        if (u.pn >= 32) { store_tile_bf16<0>(acc, G, D, row0, c0); return; }
        const int isa = u.pn >= 16, d = (u.pn >> 3) & 1;
        const float* bias = (isa ? icl0 : dec0) + d * D + c0;
        bf16_t* dst = (isa ? AD : W);
        float bv[2][8];
#pragma unroll
        for (int bj = 0; bj < 2; ++bj)
#pragma unroll
            for (int j = 0; j < 8; ++j) bv[bj][j] = bias[bj * 128 + j];
#pragma unroll
        for (int ai = 0; ai < 2; ++ai)
#pragma unroll
            for (int m = 0; m < 4; ++m) { const int row = row0 + ai * 128 + m * 16;
#pragma unroll
                for (int bj = 0; bj < 2; ++bj) { float o[8];
#pragma unroll
                    for (int j = 0; j < 8; ++j) { const float s = sigmoidf_(acc[ai][bj][m][j >> 2][j & 3] + bv[bj][j]); o[j] = isa ? s : __expf(-0.6065306597126334f * s); }
                    u32x4 w; w.x = cvt_pk_bf16(o[0], o[1]); w.y = cvt_pk_bf16(o[2], o[3]); w.z = cvt_pk_bf16(o[4], o[5]); w.w = cvt_pk_bf16(o[6], o[7]);
                    *(u32x4*)(dst + ((size_t)row * 2 + d) * D + c0 + bj * 128) = w; } } } };
struct EpiRetIn { static constexpr bool PERM = true; bf16_t* Q; bf16_t* Kk; bf16_t* V; bf16_t* GF; bf16_t* GB; const float* CS;
    __device__ __forceinline__ void operator()(AccRef acc, const Unit& u, int wr, int wc, int fr, int fq) const {
        const int row0 = u.pm * 256 + wr * 64 + fr, cw = wc * 32 + 8 * fq;
        if (u.pn >= 48) { store_tile_bf16<4>(acc, GB, 4096, row0, (u.pn - 48) * 256 + cw); return; }
        if (u.pn >= 32) { store_tile_bf16<4>(acc, GF, 4096, row0, (u.pn - 32) * 256 + cw); return; }
        if (u.pn >= 16) { store_tile_bf16<0>(acc, V, 4096, row0, (u.pn - 16) * 256 + cw); return; }
        const float sc = u.pn >= 8 ? 0.0625f : 1.0f; bf16_t* dst = u.pn >= 8 ? Kk : Q; const int hc = (u.pn & 7) * 256;
#pragma unroll
        for (int ai = 0; ai < 2; ++ai)
#pragma unroll
            for (int m = 0; m < 4; ++m) { const int row = row0 + ai * 128 + m * 16; const float* cs = CS + ((size_t)row_pos(row) * 128 + cw) * 2;
                float o1[8], o2[8];
#pragma unroll
                for (int j = 0; j < 8; ++j) { const float co = cs[2 * j], si = cs[2 * j + 1]; const float t1 = acc[ai][0][m][j >> 2][j & 3], t2 = acc[ai][1][m][j >> 2][j & 3];
                    o1[j] = (t1 * co - t2 * si) * sc; o2[j] = (t1 * si + t2 * co) * sc; }
                u32x4 w; w.x = cvt_pk_bf16(o1[0], o1[1]); w.y = cvt_pk_bf16(o1[2], o1[3]); w.z = cvt_pk_bf16(o1[4], o1[5]); w.w = cvt_pk_bf16(o1[6], o1[7]);
                *(u32x4*)(dst + (size_t)row * D + hc + cw) = w;
                w.x = cvt_pk_bf16(o2[0], o2[1]); w.y = cvt_pk_bf16(o2[2], o2[3]); w.z = cvt_pk_bf16(o2[4], o2[5]); w.w = cvt_pk_bf16(o2[6], o2[7]);
                *(u32x4*)(dst + (size_t)row * D + hc + 128 + cw) = w; } } };

#define LDS_WAIT() asm volatile("s_waitcnt lgkmcnt(0)" ::: "memory")
struct Ctx { LAS unsigned char* lds; int tid, lane, wave, gw, ngw, gtid, ngt; };

__device__ __forceinline__ void transpose_item(const float* W, int ldw, bf16_t* WT, int ldt, int k0, int n0, int dst_row0, LAS float* scr, int lane) {
#pragma unroll
    for (int i = 0; i < 8; ++i) { const int kk = 8 * i + (lane >> 3), nn = (lane & 7) * 4; const f32x4 wv = *(const f32x4*)(W + (size_t)(k0 + kk) * ldw + n0 + nn);
        LAS float* d = scr + kk * 33 + nn; d[0] = wv[0]; d[1] = wv[1]; d[2] = wv[2]; d[3] = wv[3]; }
    LDS_WAIT(); asm volatile("" ::: "memory");
    const int c = lane & 7;
#pragma unroll
    for (int j = 0; j < 4; ++j) { const int n = (lane >> 3) + 8 * j; const LAS float* s = scr + (8 * c) * 33 + n;
        u32x4 o; o.x = cvt_pk_bf16(s[0 * 33], s[1 * 33]); o.y = cvt_pk_bf16(s[2 * 33], s[3 * 33]); o.z = cvt_pk_bf16(s[4 * 33], s[5 * 33]); o.w = cvt_pk_bf16(s[6 * 33], s[7 * 33]);
        *(u32x4*)(WT + (size_t)(dst_row0 + n) * ldt + k0 + 8 * c) = o; }
    LDS_WAIT(); asm volatile("" ::: "memory");
}
__device__ __forceinline__ void tr_job(const Ctx& c, int& rot, const float* W, int K, int N, int ldw, bf16_t* WT, int ldt, int row_off) {
    LAS float* scr = (LAS float*)(c.lds + c.wave * 16384);
    const int nblk = N / 32, items = (K / 64) * nblk;
    int first = c.gw - (rot % c.ngw); if (first < 0) first += c.ngw;
    int lane = c.lane; asm volatile("" : "+v"(lane));
    f32x4 r[8];
#define TR_LOAD(it_) do { const int kb_ = (it_) / nblk, nb_ = (it_) % nblk; _Pragma("unroll") for (int i = 0; i < 8; ++i) r[i] = *(const f32x4*)(W + (size_t)(kb_ * 64 + 8 * i + (lane >> 3)) * ldw + nb_ * 32 + (lane & 7) * 4); } while (0)
    if (first < items) TR_LOAD(first);
    for (int it = first; it < items; it += c.ngw) { const int kb = it / nblk, nb = it % nblk;
#pragma unroll
        for (int i = 0; i < 8; ++i) { LAS float* d = scr + (8 * i + (lane >> 3)) * 33 + (lane & 7) * 4; d[0] = r[i][0]; d[1] = r[i][1]; d[2] = r[i][2]; d[3] = r[i][3]; }
        if (it + c.ngw < items) TR_LOAD(it + c.ngw);
        LDS_WAIT(); asm volatile("" ::: "memory");
        const int cc = lane & 7;
#pragma unroll
        for (int j = 0; j < 4; ++j) { const int n = (lane >> 3) + 8 * j; const LAS float* sp = scr + (8 * cc) * 33 + n;
            u32x4 o; o.x = cvt_pk_bf16(sp[0 * 33], sp[1 * 33]); o.y = cvt_pk_bf16(sp[2 * 33], sp[3 * 33]); o.z = cvt_pk_bf16(sp[4 * 33], sp[5 * 33]); o.w = cvt_pk_bf16(sp[6 * 33], sp[7 * 33]);
            *(u32x4*)(WT + (size_t)(row_off + nb * 32 + n) * ldt + kb * 64 + 8 * cc) = o; }
        LDS_WAIT(); asm volatile("" ::: "memory"); }
#undef TR_LOAD
    rot += items;
}

__device__ __forceinline__ void peer_convert_rows(KP P, const Ctx& c, int g_lo, int g_hi, int rank, int nranks) {
    unsigned char* ws = P->ws;
    f32x4 xn[2][8];
#define CV_LOAD(g0_) do { _Pragma("unroll") for (int h = 0; h < 2; ++h) { const int g = ((g0_) + h < g_hi) ? (g0_) + h : (g0_); const int lt = g >> 14, e = g & 16383, layer = lt >> 1, t = lt & 1; \
            const float* sp = P->in[t ? I_PV : I_PU] + ((size_t)layer * 16384 + e) * D + c.lane * 16; \
            _Pragma("unroll") for (int q = 0; q < 8; ++q) xn[h][q] = *(const f32x4*)(sp + (q >> 2) * 1024 + (q & 3) * 4); } } while (0)
    { const int gf = g_lo + (rank * 8 + c.wave) * 2; if (gf < g_hi) CV_LOAD(gf); }
    for (int g0 = g_lo + (rank * 8 + c.wave) * 2; g0 < g_hi; g0 += nranks * 16) {
        f32x4 x[2][8]; float am[2] = {0.f, 0.f};
#pragma unroll
        for (int h = 0; h < 2; ++h)
#pragma unroll
            for (int q = 0; q < 8; ++q) x[h][q] = xn[h][q];
        if (g0 + nranks * 16 < g_hi) CV_LOAD(g0 + nranks * 16);
#pragma unroll
        for (int h = 0; h < 2; ++h) { if (g0 + h >= g_hi) break;
            const int g = g0 + h; const int lt = g >> 14, e = g & 16383, layer = lt >> 1, t = lt & 1;
#pragma unroll
            for (int q = 0; q < 8; ++q) am[h] = fmaxf(am[h], fmaxf(fmaxf(fabsf(x[h][q][0]), fabsf(x[h][q][1])), fmaxf(fabsf(x[h][q][2]), fabsf(x[h][q][3]))));
            const float a = wave_max(am[h]);
            const float sc = a > 0.f ? exp2f(floorf(log2f(384.0f / a))) : 1.0f;
            if (c.lane == 0) ((float*)(ws + WS_PSC))[(size_t)t * 4 * 16384 + layer * 16384 + e] = 1.0f / sc;
            unsigned char* dst = ws + (t ? WS_PV : WS_PU) + (size_t)layer * 16384 * D;
#pragma unroll
            for (int jj = 0; jj < 2; ++jj) { u32x4 o;
#pragma unroll
                for (int w = 0; w < 4; ++w) { const f32x4 v = x[h][jj * 4 + w] * sc; int p = 0; p = __builtin_amdgcn_cvt_pk_fp8_f32(v[0], v[1], p, false); p = __builtin_amdgcn_cvt_pk_fp8_f32(v[2], v[3], p, true); o[w] = (unsigned)p; }
                const int db = (c.lane >> 3) + 8 * jj;
                *(u32x4*)(dst + ((size_t)db * 16384 + e) * 128 + (c.lane & 7) * 16) = o; } } }
#undef CV_LOAD
}
__device__ __forceinline__ void phase_prologue(KP P, const Ctx& c) {
    unsigned char* ws = P->ws;
    PROBE_REP(14) {
        LAS float* sl = (LAS float*)c.lds;
        LAS float* red = sl + 1280;
        for (int un = blockIdx.x; un < 4 * 24 * 8; un += gridDim.x) {
            const int layer = un / 192, r = un % 192, nb = r / 8, kc = r % 8;
            __syncthreads();
            for (int i = c.tid; i < 5 * 256; i += 512) { const int v = i >> 8, k = kc * 256 + (i & 255); const float x = v < 4 ? P->in[I_C][v * D + k] : P->in[I_CCTX][k]; sl[i] = siluf_(x); }
            __syncthreads();
            const int cg = c.tid & 127, ks = c.tid >> 7;
            const float* w = P->in[I_ADAW] + ((size_t)layer * D + kc * 256 + ks * 64) * 12288 + nb * 512 + cg * 4;
            f32x4 a0 = (f32x4){0.f, 0.f, 0.f, 0.f}, a1 = a0, a2 = a0, a3 = a0, a4 = a0;
            f32x4 wn[8];
#pragma unroll
            for (int i = 0; i < 8; ++i) wn[i] = *(const f32x4*)(w + (size_t)i * 12288);
#pragma unroll 1
            for (int k0 = 0; k0 < 64; k0 += 8) { f32x4 wc[8];
#pragma unroll
                for (int i = 0; i < 8; ++i) wc[i] = wn[i];
                if (k0 + 8 < 64) {
#pragma unroll
                    for (int i = 0; i < 8; ++i) wn[i] = *(const f32x4*)(w + (size_t)(k0 + 8 + i) * 12288); }
#pragma unroll
                for (int i = 0; i < 8; ++i) { const f32x4 wv = wc[i]; const int kk = ks * 64 + k0 + i;
                    a0 += wv * sl[kk]; a1 += wv * sl[256 + kk]; a2 += wv * sl[512 + kk]; a3 += wv * sl[768 + kk]; a4 += wv * sl[1024 + kk]; } }
            LAS float* rp = red + (ks * 5) * 512 + cg * 4;
            *(LAS f32x4*)(rp) = a0; *(LAS f32x4*)(rp + 512) = a1; *(LAS f32x4*)(rp + 1024) = a2; *(LAS f32x4*)(rp + 1536) = a3; *(LAS f32x4*)(rp + 2048) = a4;
            __syncthreads();
            for (int i = c.tid; i < 5 * 512; i += 512) { const int v = i >> 9, n = i & 511;
                const float sum = (red[(0 * 5 + v) * 512 + n] + red[(1 * 5 + v) * 512 + n]) + (red[(2 * 5 + v) * 512 + n] + red[(3 * 5 + v) * 512 + n]);
                ((float*)(ws + WS_MODP))[((size_t)(layer * 8 + kc) * 5 + v) * 12288 + nb * 512 + n] = sum; }
        }
        __syncthreads();
    }
    PROBE_REP(16) {
    int rot = 0;
    for (int j = 0; j < 2; ++j) {
        tr_job(c, rot, P->in[I_RGWIN] + (size_t)j * D * 4096, D, 4096, 4096, (bf16_t*)(ws + WS_RGIN) + (size_t)j * 4096 * D, D, 0);
        tr_job(c, rot, P->in[I_RGWOUT] + (size_t)j * D * D, D, D, D, (bf16_t*)(ws + WS_RGOUT) + (size_t)j * D * D, D, 0);
    }
    {
        LAS float* scr = (LAS float*)(c.lds + c.wave * 16384);
        const int items = 64 * 32;
        int first = c.gw - (rot % c.ngw); if (first < 0) first += c.ngw;
        for (int it = first; it < items; it += c.ngw) {
            const int mat = it >> 5, sub = it & 31, kb = sub >> 3, nb32 = sub & 7;
            const int jl = mat >> 5, d = (mat >> 4) & 1, g = (mat >> 3) & 1, nblk = mat & 7;
            const int n0 = nb32 * 32, hf = n0 >> 7, pn = (d * 8 + nblk) * 2 + hf;
            transpose_item(P->in[I_RGGW] + (size_t)mat * 65536, 256, (bf16_t*)(ws + WS_RGGATE) + (size_t)jl * 8192 * 256, 256, kb * 64, n0, pn * 256 + g * 128 + (n0 & 127), scr, c.lane);
        }
        rot += items;
    }
    for (int m = 0; m < 3; ++m) tr_job(c, rot, P->in[I_RWRKV] + (size_t)m * D * D, D, D, D, (bf16_t*)(ws + WS_RW1), D, m * D);
    for (int d = 0; d < 2; ++d) {
        tr_job(c, rot, P->in[I_RWDEC1] + (size_t)d * D * 96, D, 96, 96, (bf16_t*)(ws + WS_RW1), D, 6144 + d * 96);
        tr_job(c, rot, P->in[I_RWICL1] + (size_t)d * D * 96, D, 96, 96, (bf16_t*)(ws + WS_RW1), D, 6400 + d * 96);
    }
    tr_job(c, rot, P->in[I_RWG1], D, 256, 256, (bf16_t*)(ws + WS_RW1), D, 6656);
    tr_job(c, rot, P->in[I_RWWO], D, D, D, (bf16_t*)(ws + WS_RWO), D, 0);
    tr_job(c, rot, P->in[I_RETWIN], D, 16384, 16384, (bf16_t*)(ws + WS_RETIN), D, 0);
    tr_job(c, rot, P->in[I_RETWOUT], 4096, D, D, (bf16_t*)(ws + WS_RETOUT), 4096, 0);
    }
    PROBE_REP(17) {
    for (size_t i0 = c.gtid; i0 < (size_t)4 * D * D / 8; i0 += 4 * (size_t)c.ngt) { f32x4 a[4], b[4];
#pragma unroll
        for (int u = 0; u < 4; ++u) { const size_t i = i0 + (size_t)u * c.ngt; if (i < (size_t)4 * D * D / 8) { a[u] = *(const f32x4*)(P->in[I_PWQ] + i * 8); b[u] = *(const f32x4*)(P->in[I_PWQ] + i * 8 + 4); } }
#pragma unroll
        for (int u = 0; u < 4; ++u) { const size_t i = i0 + (size_t)u * c.ngt; if (i < (size_t)4 * D * D / 8)
            *(u32x4*)((bf16_t*)(ws + WS_WQN) + i * 8) = (u32x4){cvt_pk_bf16(a[u][0], a[u][1]), cvt_pk_bf16(a[u][2], a[u][3]), cvt_pk_bf16(b[u][0], b[u][1]), cvt_pk_bf16(b[u][2], b[u][3])}; } }
    for (int i = c.gtid; i < 2 * 64 * (D / 8); i += c.ngt) { const int blk = i / (64 * (D / 8)), r = (i / (D / 8)) % 64, c8 = i % (D / 8);
        *(u32x4*)((bf16_t*)(ws + WS_RW1) + (size_t)(6144 + blk * 256 + 192 + r) * D + c8 * 8) = (u32x4){0u, 0u, 0u, 0u}; }
    for (int i = c.gtid; i < 4 * 2048 * 32; i += c.ngt) { const int c8 = i & 31, row = (i >> 5) & 2047, l = i >> 16; const int p = (row >> 7) & 1, col = c8 * 8;
        u32x4 o = (u32x4){0u, 0u, 0u, 0u};
        if ((col >> 7) == p) { const float* s = P->in[I_PKEYS] + ((size_t)l * 2048 + row) * 128 + (col & 127); const f32x4 a = *(const f32x4*)s, b = *(const f32x4*)(s + 4);
            o.x = cvt_pk_bf16(a[0], a[1]); o.y = cvt_pk_bf16(a[2], a[3]); o.z = cvt_pk_bf16(b[0], b[1]); o.w = cvt_pk_bf16(b[2], b[3]); }
        *(u32x4*)((bf16_t*)(ws + WS_KEYS) + ((size_t)l * 2048 + row) * 256 + col) = o; }
    for (int i = c.gtid; i < 10240 * 256; i += c.ngt) { const int kc = i & 255, r = i >> 8; float v = 0.f;
        if (r < 4096) { const int d = r >> 11, cc = r & 2047, k = kc - 96 * d; if (k >= 0 && k < 96) v = P->in[I_RWDEC2][((size_t)d * 96 + k) * D + cc]; }
        else if (r < 8192) { const int rr = r - 4096, d = rr >> 11, cc = rr & 2047, k = kc - 96 * d; if (k >= 0 && k < 96) v = P->in[I_RWICL2][((size_t)d * 96 + k) * D + cc]; }
        else v = P->in[I_RWG2][(size_t)kc * D + (r - 8192)];
        ((bf16_t*)(ws + WS_RW2))[i] = (bf16_t)(cvt_pk_bf16(v, 0.f) & 0xffffu); }
    }
    PROBE_REP(18)
    for (int i = c.gtid; i < 2 * 2 * D; i += c.ngt) ((float*)(ws + WS_SPT))[i] = -8.0f * log1pf(expf(-P->in[I_RGLAM][i]));
    PROBE_REP(18)
    for (int i = c.gtid; i < SLEN * 128; i += c.ngt) { const int pos = i >> 7, k = i & 127; const float theta = 1.0f / powf(10000.0f, (float)k / 127.0f); const float ang = (float)pos * theta;
        ((f32x2*)(ws + WS_CS))[i] = (f32x2){cosf(ang), sinf(ang)}; }
}
__device__ __forceinline__ void phase_modfin(KP P, const Ctx& c) {
    for (int i = c.gtid; i < 4 * 5 * 12288; i += c.ngt) { const int n = i % 12288, lv = i / 12288, l = lv / 5, v = lv % 5;
        float s = P->in[I_ADAB][l * 12288 + n];
        for (int kc = 0; kc < 8; ++kc) s += ((const float*)(P->ws + WS_MODP))[((size_t)(l * 8 + kc) * 5 + v) * 12288 + n];
        ((float*)(P->ws + WS_MOD))[i] = s; }
}
__device__ __forceinline__ void phase_xinit(KP P, const Ctx& c) {
    float* X = (float*)(P->ws + WS_X); bf16_t* A0 = (bf16_t*)(P->ws + WS_A0);
    for (size_t i0 = c.gtid; i0 < TD / 4; i0 += 4 * (size_t)c.ngt) {
        f32x4 x[4], sh[4], sc[4];
#pragma unroll
        for (int u = 0; u < 4; ++u) { const size_t i = i0 + (size_t)u * c.ngt; if (i < TD / 4) { const int row = (int)(i >> 9), c4 = (int)(i & 511) * 4;
            const float* src = row < NCTX ? P->in[I_CTX] + (size_t)row * D : P->in[I_X] + (size_t)(row - NCTX) * D; const int v = row_vec(row);
            x[u] = *(const f32x4*)(src + c4); sh[u] = *(const f32x4*)(modp(P, 0, v, 0) + c4); sc[u] = *(const f32x4*)(modp(P, 0, v, 1) + c4); } }
#pragma unroll
        for (int u = 0; u < 4; ++u) { const size_t i = i0 + (size_t)u * c.ngt; if (i < TD / 4) { const int row = (int)(i >> 9), c4 = (int)(i & 511) * 4;
            *(f32x4*)(X + (size_t)row * D + c4) = x[u];
            const f32x4 h = x[u] * (sc[u] + 1.0f) + sh[u];
            *(u32x2*)(A0 + (size_t)row * D + c4) = (u32x2){cvt_pk_bf16(h[0], h[1]), cvt_pk_bf16(h[2], h[3])}; } } }
}

__device__ __forceinline__ void phase_rg_conv(KP P, const Ctx& c, int jl) {
    const bf16_t* UR = (const bf16_t*)(P->ws + L_UR); bf16_t* XC = (bf16_t*)(P->ws + L_XC);
    const float* cw = P->in[I_RGCW] + (size_t)jl * 4 * D; const float* cb = P->in[I_RGCB] + (size_t)jl * D;
    const int c8 = (int)(c.gtid & 255) * 8;
    float w8[4][8], b8[8];
#pragma unroll
    for (int j = 0; j < 8; ++j) { b8[j] = cb[c8 + j];
#pragma unroll
        for (int tp = 0; tp < 4; ++tp) w8[tp][j] = cw[tp * D + c8 + j]; }
    for (size_t i0 = c.gtid; i0 < TD / 8; i0 += 2 * (size_t)c.ngt) {
        u32x4 u[2][4];
#pragma unroll
        for (int q = 0; q < 2; ++q) { const size_t i = i0 + (size_t)q * c.ngt; const int row = (int)(i >> 8);
            int lo, hi; if (row < NCTX) { lo = row & ~(CTX - 1); hi = lo + CTX; } else { lo = NCTX + ((row - NCTX) & ~(SEQ - 1)); hi = lo + SEQ; }
#pragma unroll
            for (int tp = 0; tp < 4; ++tp) { const int rr = row + tp - 2; u[q][tp] = (u32x4){0u, 0u, 0u, 0u};
                if (i < TD / 8 && rr >= lo && rr < hi) u[q][tp] = *(const u32x4*)(UR + (size_t)rr * D + c8); } }
#pragma unroll
        for (int q = 0; q < 2; ++q) { const size_t i = i0 + (size_t)q * c.ngt; if (i >= TD / 8) break; const int row = (int)(i >> 8);
            float a[8];
#pragma unroll
            for (int j = 0; j < 8; ++j) a[j] = b8[j];
#pragma unroll
            for (int tp = 0; tp < 4; ++tp) { const u32x4 uu = u[q][tp]; const unsigned u0 = uu.x, u1 = uu.y, u2 = uu.z, u3 = uu.w;
                a[0] += w8[tp][0] * bflo(u0); a[1] += w8[tp][1] * bfhi(u0); a[2] += w8[tp][2] * bflo(u1); a[3] += w8[tp][3] * bfhi(u1);
                a[4] += w8[tp][4] * bflo(u2); a[5] += w8[tp][5] * bfhi(u2); a[6] += w8[tp][6] * bflo(u3); a[7] += w8[tp][7] * bfhi(u3); }
            *(u32x4*)(XC + (size_t)row * D + c8) = (u32x4){cvt_pk_bf16(a[0], a[1]), cvt_pk_bf16(a[2], a[3]), cvt_pk_bf16(a[4], a[5]), cvt_pk_bf16(a[6], a[7])}; } }
}
__device__ __forceinline__ void phase_rg_scan1(KP P, const Ctx& c) {
    const bf16_t* LA = (const bf16_t*)(P->ws + L_LA); const bf16_t* BB = (const bf16_t*)(P->ws + L_BB);
    float* CA = (float*)(P->ws + WS_CA); float* CH = (float*)(P->ws + WS_CH);
    for (int u = c.gw; u < 2048; u += c.ngw) { const int b = u >> 9, dir = (u >> 8) & 1, ck = (u >> 2) & 63, ch = (u & 3) * 512 + c.lane * 8;
        float h[8], sl[8];
#pragma unroll
        for (int e = 0; e < 8; ++e) { h[e] = 0.f; sl[e] = 0.f; }
#pragma unroll 4
        for (int s_ = 0; s_ < 68; ++s_) { const int row = seq_row(b, dir, ck * 68 + s_); const size_t o = ((size_t)row * 2 + dir) * D + ch;
            float l8[8], b8[8]; unpack8(*(const u32x4*)(LA + o), l8); unpack8(*(const u32x4*)(BB + o), b8);
#pragma unroll
            for (int e = 0; e < 8; ++e) { h[e] = __expf(l8[e]) * h[e] + b8[e]; sl[e] += l8[e]; } }
        const size_t o = ((size_t)(b * 2 + dir) * 64 + ck) * D + ch;
        *(f32x4*)(CA + o) = (f32x4){sl[0], sl[1], sl[2], sl[3]}; *(f32x4*)(CA + o + 4) = (f32x4){sl[4], sl[5], sl[6], sl[7]};
        *(f32x4*)(CH + o) = (f32x4){h[0], h[1], h[2], h[3]}; *(f32x4*)(CH + o + 4) = (f32x4){h[4], h[5], h[6], h[7]}; }
}
__device__ __forceinline__ void phase_rg_scan2(KP P, const Ctx& c) {
    const float* CA = (const float*)(P->ws + WS_CA); const float* CH = (const float*)(P->ws + WS_CH); float* CIN = (float*)(P->ws + WS_CIN);
    for (int i = c.gtid; i < 4 * 2 * D; i += c.ngt) { const int ch = i & (D - 1), bd = i >> 11; float carry = 0.f;
#pragma unroll 1
        for (int c0 = 0; c0 < 64; c0 += 16) { float a[16], hh[16];
#pragma unroll
            for (int q = 0; q < 16; ++q) { const size_t o = ((size_t)bd * 64 + c0 + q) * D + ch; a[q] = CA[o]; hh[q] = CH[o]; }
#pragma unroll
            for (int q = 0; q < 16; ++q) { const size_t o = ((size_t)bd * 64 + c0 + q) * D + ch; CIN[o] = carry; carry = __expf(a[q]) * carry + hh[q]; } } }
}
template <int DIR> __device__ __forceinline__ void phase_rg_scan3(KP P, const Ctx& c) {
    const bf16_t* LA = (const bf16_t*)(P->ws + L_LA); const bf16_t* BB = (const bf16_t*)(P->ws + L_BB); const bf16_t* UG = (const bf16_t*)(P->ws + L_UG);
    const float* CIN = (const float*)(P->ws + WS_CIN); bf16_t* YIN = (bf16_t*)(P->ws + L_YIN); bf16_t* HF = (bf16_t*)(P->ws + L_XC);
    for (int u = c.gw; u < 2048; u += c.ngw) { const int b = u >> 9, ck = (u >> 3) & 63, ch = (u & 7) * 256 + c.lane * 4;
        const f32x4 h0 = *(const f32x4*)(CIN + ((size_t)(b * 2 + DIR) * 64 + ck) * D + ch); float h[4] = {h0[0], h0[1], h0[2], h0[3]};
        u32x2 nl[4], nb[4], nf[4], ng[4];
#define SC3_LOAD(s0_) do { _Pragma("unroll") for (int i_ = 0; i_ < 4; ++i_) { const int row_ = seq_row(b, DIR, ck * 68 + (s0_) + i_); const size_t o_ = ((size_t)row_ * 2 + DIR) * D + ch, q_ = (size_t)row_ * D + ch; \
            nl[i_] = *(const u32x2*)(LA + o_); nb[i_] = *(const u32x2*)(BB + o_); if (DIR == 1) { nf[i_] = *(const u32x2*)(HF + q_); ng[i_] = *(const u32x2*)(UG + q_); } } } while (0)
        SC3_LOAD(0);
#pragma unroll 1
        for (int s0 = 0; s0 < 68; s0 += 4) { u32x2 cl[4], cb[4], cf[4], cg[4];
#pragma unroll
            for (int i = 0; i < 4; ++i) { cl[i] = nl[i]; cb[i] = nb[i]; if (DIR == 1) { cf[i] = nf[i]; cg[i] = ng[i]; } }
            if (s0 + 4 < 68) SC3_LOAD(s0 + 4);
#pragma unroll
            for (int i = 0; i < 4; ++i) { const int row = seq_row(b, DIR, ck * 68 + s0 + i); const size_t q = (size_t)row * D + ch;
                const unsigned l0 = cl[i].x, l1 = cl[i].y, b0 = cb[i].x, b1 = cb[i].y;
                h[0] = __expf(bflo(l0)) * h[0] + bflo(b0); h[1] = __expf(bfhi(l0)) * h[1] + bfhi(b0); h[2] = __expf(bflo(l1)) * h[2] + bflo(b1); h[3] = __expf(bfhi(l1)) * h[3] + bfhi(b1);
                if (DIR == 0) { *(u32x2*)(HF + q) = (u32x2){cvt_pk_bf16(h[0], h[1]), cvt_pk_bf16(h[2], h[3])}; }
                else { const unsigned f0 = cf[i].x, f1 = cf[i].y, g0 = cg[i].x, g1 = cg[i].y;
                    *(u32x2*)(YIN + q) = (u32x2){cvt_pk_bf16(bflo(g0) * (bflo(f0) + h[0]), bfhi(g0) * (bfhi(f0) + h[1])), cvt_pk_bf16(bflo(g1) * (bflo(f1) + h[2]), bfhi(g1) * (bfhi(f1) + h[3]))}; } } }
#undef SC3_LOAD
    }
}

__device__ __forceinline__ void phase_ln_mid(KP P, const Ctx& c, int layer, int row_lo) {
    float* X = (float*)(P->ws + WS_X); bf16_t* H2 = (bf16_t*)(P->ws + WS_H2);
    const float* lg = P->in[I_LNG] + (size_t)(layer * 2 + 0) * D; const float* lb = P->in[I_LNB] + (size_t)(layer * 2 + 0) * D;
    f32x4 xn[8];
#define LN_ROW(i_) ((row_lo == 0 && (i_) < 2048) ? ((i_) ^ 1024) : (i_))
    { const int i0 = row_lo + c.gw; if (i0 < T) { const int r0 = LN_ROW(i0);
#pragma unroll
        for (int j = 0; j < 8; ++j) xn[j] = *(const f32x4*)(X + (size_t)r0 * D + c.lane * 4 + 256 * j); } }
    for (int ri = row_lo + c.gw; ri < T; ri += c.ngw) { const int row = LN_ROW(ri); float* xr = X + (size_t)row * D + c.lane * 4; const int v = row_vec(row);
        f32x4 x[8]; float s = 0.f;
#pragma unroll
        for (int j = 0; j < 8; ++j) x[j] = xn[j];
        if (ri + c.ngw < T) { const int rn = LN_ROW(ri + c.ngw);
#pragma unroll
            for (int j = 0; j < 8; ++j) xn[j] = *(const f32x4*)(X + (size_t)rn * D + c.lane * 4 + 256 * j); }
        if (row < NCTX) {
            const float* gp = modp(P, layer, v, 2) + c.lane * 4; const float* px = (const float*)(P->ws + WS_S) + (size_t)row * D + c.lane * 4; const int ns = layer == 2 ? 8 : 4;
#pragma unroll
            for (int j = 0; j < 8; ++j) { constexpr size_t PS = (size_t)NCTX * D;
                const f32x4 p0 = *(const f32x4*)(px + 256 * j), p1 = *(const f32x4*)(px + PS + 256 * j), p2 = *(const f32x4*)(px + 2 * PS + 256 * j), p3 = *(const f32x4*)(px + 3 * PS + 256 * j);
                f32x4 ps = (p0 + p1) + (p2 + p3);
                if (ns == 8) { const f32x4 p4 = *(const f32x4*)(px + 4 * PS + 256 * j), p5 = *(const f32x4*)(px + 5 * PS + 256 * j), p6 = *(const f32x4*)(px + 6 * PS + 256 * j), p7 = *(const f32x4*)(px + 7 * PS + 256 * j);
                    ps += (p4 + p5) + (p6 + p7); }
                x[j] = x[j] * ALPHA + *(const f32x4*)(gp + 256 * j) * ps;
                if (j & 1) asm volatile("" ::: "memory"); } }
#pragma unroll
        for (int j = 0; j < 8; ++j) s += (x[j][0] + x[j][1]) + (x[j][2] + x[j][3]);
        const float mean = wave_sum(s) * (1.0f / D); float q = 0.f;
#pragma unroll
        for (int j = 0; j < 8; ++j) { x[j] = x[j] - mean; q += (x[j][0] * x[j][0] + x[j][1] * x[j][1]) + (x[j][2] * x[j][2] + x[j][3] * x[j][3]); }
        const float rstd = rsqrtf(wave_sum(q) * (1.0f / D) + LN_EPS);
        const float* m3 = modp(P, layer, v, 3) + c.lane * 4; const float* m4 = modp(P, layer, v, 4) + c.lane * 4;
#pragma unroll
        for (int j = 0; j < 8; ++j) { const f32x4 g = *(const f32x4*)(lg + c.lane * 4 + 256 * j), bb = *(const f32x4*)(lb + c.lane * 4 + 256 * j);
            const f32x4 y = x[j] * rstd * g + bb; *(f32x4*)(xr + 256 * j) = y;
            const f32x4 h = y * (*(const f32x4*)(m4 + 256 * j) + 1.0f) + *(const f32x4*)(m3 + 256 * j);
            *(u32x2*)(H2 + (size_t)row * D + c.lane * 4 + 256 * j) = (u32x2){cvt_pk_bf16(h[0], h[1]), cvt_pk_bf16(h[2], h[3])}; } }
#undef LN_ROW
}

__device__ __forceinline__ float dot2bf(unsigned a, unsigned b, float s) { return __builtin_amdgcn_fdot2_f32_bf16(__builtin_bit_cast(bf16v2, a), __builtin_bit_cast(bf16v2, b), s, false); }
__device__ __forceinline__ float dot8(const u32x4 a, const u32x4 b, float s) {
    const unsigned a0 = a.x, a1 = a.y, a2 = a.z, a3 = a.w, b0 = b.x, b1 = b.y, b2 = b.z, b3 = b.w;
    s = dot2bf(a0, b0, s); s = dot2bf(a1, b1, s); s = dot2bf(a2, b2, s); s = dot2bf(a3, b3, s);
    return s;
}
template <int CTRL> __device__ __forceinline__ int dpp_movi(int x) { return __builtin_amdgcn_update_dpp(x, x, CTRL, 0xF, 0xF, false); }
__device__ __forceinline__ int row_max_i(int m) { m = max(m, dpp_movi<0xB1>(m)); m = max(m, dpp_movi<0x4E>(m)); m = max(m, dpp_movi<0x141>(m)); m = max(m, dpp_movi<0x140>(m)); return m; }
template <int PAT> __device__ __forceinline__ int swz(int v) { return __builtin_amdgcn_ds_swizzle(v, PAT); }
__device__ __forceinline__ int f2key(float f) { const int b = __float_as_int(f); return b ^ ((b >> 31) & 0x7fffffff); }
__device__ __forceinline__ float key2f(int k) { return __int_as_float(k ^ ((k >> 31) & 0x7fffffff)); }
__device__ __forceinline__ void row_max_i_pair(int& a, int& b) {
    asm volatile("s_nop 1\n\t"
        "v_max_i32_dpp %0, %0, %0 quad_perm:[1,0,3,2] row_mask:0xf bank_mask:0xf\n\tv_max_i32_dpp %1, %1, %1 quad_perm:[1,0,3,2] row_mask:0xf bank_mask:0xf\n\ts_nop 0\n\t"
        "v_max_i32_dpp %0, %0, %0 quad_perm:[2,3,0,1] row_mask:0xf bank_mask:0xf\n\tv_max_i32_dpp %1, %1, %1 quad_perm:[2,3,0,1] row_mask:0xf bank_mask:0xf\n\ts_nop 0\n\t"
        "v_max_i32_dpp %0, %0, %0 row_half_mirror row_mask:0xf bank_mask:0xf\n\tv_max_i32_dpp %1, %1, %1 row_half_mirror row_mask:0xf bank_mask:0xf\n\ts_nop 0\n\t"
        "v_max_i32_dpp %0, %0, %0 row_mirror row_mask:0xf bank_mask:0xf\n\tv_max_i32_dpp %1, %1, %1 row_mirror row_mask:0xf bank_mask:0xf"
        : "+v"(a), "+v"(b));
}
__device__ __forceinline__ void phase_peer_select(KP P, const Ctx& c, int row_lo) {
    const float* S = (const float*)(P->ws + WS_S); float* SW = (float*)(P->ws + WS_SELW);
    constexpr int KMIN = (int)0x80000000;
    const int nps = (2 * (T - row_lo) - c.gw + c.ngw - 1) / c.ngw;
    f32x4 sn[2][2];
#define SEL_LOAD(k) do { const int pid_ = 2 * row_lo + c.gw + (k) * c.ngw; const float* sp_ = S + (size_t)(pid_ >> 1) * D + (2 * (pid_ & 1)) * 512 + lane * 8; \
        sn[0][0] = *(const f32x4*)sp_; sn[0][1] = *(const f32x4*)(sp_ + 4); sn[1][0] = *(const f32x4*)(sp_ + 512); sn[1][1] = *(const f32x4*)(sp_ + 516); } while (0)
    { int lane = c.lane; asm volatile("" : "+v"(lane)); if (nps > 0) SEL_LOAD(0); }
    {
#pragma unroll 1
        for (int kk = 0; kk < nps; ++kk) {
            const int pid = 2 * row_lo + c.gw + kk * c.ngw, row = pid >> 1, pp = pid & 1;
            int lane = c.lane; asm volatile("" : "+v"(lane));
            const int l16 = lane & 15, isS2 = (lane >> 4) & 1;
            int k8[2][8];
#pragma unroll
            for (int q = 0; q < 2; ++q) {
#pragma unroll
                for (int e = 0; e < 8; ++e) { const float v = sn[q][e >> 2][e & 3]; k8[q][e] = (f2key(v) & ~127) | (127 - (l16 * 8 + e)); } }
            if (kk + 1 < nps) SEL_LOAD(kk + 1);
#define SEL_CE(a, b) do { const int hi_ = max(a, b), lo_ = min(a, b); a = hi_; b = lo_; } while (0)
#pragma unroll
            for (int q = 0; q < 2; ++q) { int (&k)[8] = k8[q];
                SEL_CE(k[0], k[1]); SEL_CE(k[2], k[3]); SEL_CE(k[4], k[5]); SEL_CE(k[6], k[7]); SEL_CE(k[0], k[2]); SEL_CE(k[1], k[3]); SEL_CE(k[4], k[6]); SEL_CE(k[5], k[7]);
                SEL_CE(k[1], k[2]); SEL_CE(k[5], k[6]); SEL_CE(k[0], k[4]); SEL_CE(k[3], k[7]); SEL_CE(k[1], k[5]); SEL_CE(k[2], k[6]); SEL_CE(k[1], k[4]); SEL_CE(k[3], k[6]);
                SEL_CE(k[2], k[4]); SEL_CE(k[3], k[5]); SEL_CE(k[3], k[4]); }
            int own[2] = {KMIN, KMIN};
#pragma unroll
            for (int it = 0; it < 16; ++it) {
                int m0 = k8[0][0], m1 = k8[1][0];
                row_max_i_pair(m0, m1);
                const bool p0 = k8[0][0] == m0, p1 = k8[1][0] == m1;
#pragma unroll
                for (int e = 0; e < 7; ++e) { k8[0][e] = p0 ? k8[0][e + 1] : k8[0][e]; k8[1][e] = p1 ? k8[1][e + 1] : k8[1][e]; }
                k8[0][7] = p0 ? KMIN : k8[0][7]; k8[1][7] = p1 ? KMIN : k8[1][7];
                own[0] = (l16 == it) ? m0 : own[0]; own[1] = (l16 == it) ? m1 : own[1]; }
            int ck[2][4], ownIdx[2];
#pragma unroll
            for (int q = 0; q < 2; ++q) { ownIdx[q] = 127 - (own[q] & 127); const float ownVal = key2f(own[q]);
                int pk[4]; pk[0] = swz<(0x10 << 10) | (0 << 5) | 0x10>(own[q]); pk[1] = swz<(0x10 << 10) | (1 << 5) | 0x10>(own[q]); pk[2] = swz<(0x10 << 10) | (2 << 5) | 0x10>(own[q]); pk[3] = swz<(0x10 << 10) | (3 << 5) | 0x10>(own[q]);
#pragma unroll
                for (int m = 0; m < 4; ++m) { const float pv = key2f(pk[m]);
                    const int ci = isS2 ? m : l16, cj = isS2 ? l16 : m;
                    const bool valid = (isS2 ? (m <= l16) : (m < l16)) && ((ci + 1) * (cj + 1) <= 16);
                    ck[q][m] = valid ? ((f2key(ownVal + pv) & ~255) | (255 - (ci * 16 + cj))) : KMIN; } }
#pragma unroll
            for (int q = 0; q < 2; ++q) { int (&k)[4] = ck[q]; SEL_CE(k[0], k[1]); SEL_CE(k[2], k[3]); SEL_CE(k[0], k[2]); SEL_CE(k[1], k[3]); SEL_CE(k[1], k[2]); }
#undef SEL_CE
            int win[2] = {KMIN, KMIN};
#pragma unroll
            for (int it = 0; it < 16; ++it) {
                int m0 = ck[0][0], m1 = ck[1][0];
                row_max_i_pair(m0, m1);
                m0 = max(m0, swz<(0x10 << 10) | 0x1F>(m0)); m1 = max(m1, swz<(0x10 << 10) | 0x1F>(m1));
                const bool p0 = ck[0][0] == m0, p1 = ck[1][0] == m1;
#pragma unroll
                for (int e = 0; e < 3; ++e) { ck[0][e] = p0 ? ck[0][e + 1] : ck[0][e]; ck[1][e] = p1 ? ck[1][e + 1] : ck[1][e]; }
                ck[0][3] = p0 ? KMIN : ck[0][3]; ck[1][3] = p1 ? KMIN : ck[1][3];
                win[0] = (l16 == it) ? m0 : win[0]; win[1] = (l16 == it) ? m1 : win[1]; }
#pragma unroll
            for (int q = 0; q < 2; ++q) {
                const int cidx = 255 - (win[q] & 255), ci = (cidx >> 4) & 15, cj = cidx & 15, rb = lane & 32;
                const int i1 = __builtin_amdgcn_ds_bpermute((rb + ci) << 2, ownIdx[q]), i2 = __builtin_amdgcn_ds_bpermute((rb + 16 + cj) << 2, ownIdx[q]);
                const float sc = key2f(win[q]);
                const float mxf = key2f(row_max_i(f2key(sc)));
                const float ex = __expf(sc - mxf);
                float sum = ex; sum += dpp_mov<0xB1>(sum); sum += dpp_mov<0x4E>(sum); sum += dpp_mov<0x141>(sum); sum += dpp_mov<0x140>(sum);
                if (!isS2) { const size_t o = ((size_t)row * 8 + (2 * pp + q) * 2 + (lane >> 5)) * 16 + l16; const int e_ = (i1 * 128 + i2) & 16383; ((unsigned short*)(P->ws + P_SE16))[o] = (unsigned short)e_; SW[o] = ex / sum; } }
        }
    }
#undef SEL_LOAD
}

__device__ __forceinline__ float dot2bf_init(bf16v2 a, bf16v2 b) { float r; asm("v_dot2_f32_bf16 %0, %1, %2, 0" : "=v"(r) : "v"(a), "v"(b)); return r; }
__device__ __forceinline__ void unpack16_fp8(const u32x4 a, float (&f)[16]) {
#pragma unroll
    for (int w = 0; w < 4; ++w) { const int aw = (int)a[w]; const f32x2 lo = __builtin_amdgcn_cvt_pk_f32_fp8(aw, false), hi = __builtin_amdgcn_cvt_pk_f32_fp8(aw, true);
        f[4 * w + 0] = lo.x; f[4 * w + 1] = lo.y; f[4 * w + 2] = hi.x; f[4 * w + 3] = hi.y; }
}
#define PEER_QUEUE_BEGIN(phase_id, tg_lo, tg_hi) { \
    unsigned* heads_ = (unsigned*)(P->ws + WS_CTL) + CW_PQ + (phase_id) * 16 * 64; const unsigned x_ = ((PROBE >> 19) & 1) ? ((unsigned)blockIdx.x >> 5) & 7u : (xb_xcc_id() & 7u); \
    for (int k_ = 0; k_ < 16; ++k_) { const int db = (int)((x_ + 8u * (k_ & 1) + (unsigned)(k_ >> 1)) & 15u); \
        for (;;) { unsigned t0_ = 0; if (c.lane == 0) t0_ = __hip_atomic_fetch_add(heads_ + db * 64, 2u, __ATOMIC_RELAXED, __HIP_MEMORY_SCOPE_AGENT); \
            t0_ = (unsigned)__builtin_amdgcn_readfirstlane((int)t0_) + (unsigned)(tg_lo); if (t0_ >= (unsigned)(tg_hi)) break; \
            for (unsigned tg_ = t0_; tg_ < t0_ + 2u && tg_ < (unsigned)(tg_hi); ++tg_) { const int tg = (int)tg_;
#define PEER_QUEUE_END } } } }
__device__ __forceinline__ void phase_peer_u(KP P, const Ctx& c, int layer, int row_lo, int qrep) {
    const bf16_t* H2 = (const bf16_t*)(P->ws + WS_H2); const unsigned short* SE = (const unsigned short*)(P->ws + P_SE16);
    const unsigned char* U = P->ws + WS_PU + (size_t)layer * 16384 * D; bf16_t* PART = (bf16_t*)(P->ws + P_PART);
    PEER_QUEUE_BEGIN(layer * 2 + 0 + 8 * qrep, row_lo / 8, T / 8)
        int lane = c.lane; asm volatile("" : "+v"(lane));
        const int ts = lane >> 3, seg = lane & 7, t = tg * 8 + ts;
        const bf16_t* xp = H2 + (size_t)t * D + db * 128 + seg * 16; const u32x4 xa = *(const u32x4*)xp, xb = *(const u32x4*)(xp + 8);
        const unsigned short* se = SE + (size_t)t * 128; const unsigned char* ub = U + (size_t)db * 16384 * 128; const unsigned seg16 = (unsigned)seg * 16u;
        bf16_t* pp = PART + (((size_t)t * 16 + db) * 8 + seg) * 16;
        u32x4 eA[2], eB[2], gA[16], gB[16];
#define PU_IDX(E, st) do { _Pragma("unroll") for (int i_ = 0; i_ < 2; ++i_) E[i_] = *(const u32x4*)(se + 16 * (st) + 8 * i_); } while (0)
#define PU_GATHER(G, E) do { _Pragma("unroll") for (int k_ = 0; k_ < 16; ++k_) { const unsigned w_ = E[k_ >> 3][(k_ >> 1) & 3]; const unsigned e_ = ((k_ & 1) ? (w_ >> 16) : w_) & 16383u; G[k_] = *(const u32x4*)(ub + (unsigned)((e_ << 7) | seg16)); } } while (0)
#define PU_COMPUTE(G, OUT) do { float v2_[2]; \
            _Pragma("unroll") for (int cc = 0; cc < 2; ++cc) { float sk[8]; \
                _Pragma("unroll") for (int k = 0; k < 8; ++k) { float s0; \
                    _Pragma("unroll") for (int w = 0; w < 4; ++w) { const int gw_ = (int)G[8 * cc + k][w]; const unsigned x0 = w < 2 ? xa[2 * w] : xb[2 * w - 4], x1 = w < 2 ? xa[2 * w + 1] : xb[2 * w - 3]; \
                        if (w == 0) s0 = dot2bf_init(__builtin_amdgcn_cvt_scalef32_pk_bf16_fp8(gw_, 1.0f, false), __builtin_bit_cast(bf16v2, x0)); \
                        else s0 = __builtin_amdgcn_fdot2_f32_bf16(__builtin_amdgcn_cvt_scalef32_pk_bf16_fp8(gw_, 1.0f, false), __builtin_bit_cast(bf16v2, x0), s0, false); \
                        s0 = __builtin_amdgcn_fdot2_f32_bf16(__builtin_amdgcn_cvt_scalef32_pk_bf16_fp8(gw_, 1.0f, true), __builtin_bit_cast(bf16v2, x1), s0, false); } \
                    sk[k] = s0; } \
                sum8_quad(sk[0], sk[1], sk[2], sk[3]); sum8_quad(sk[4], sk[5], sk[6], sk[7]); \
                float v = 0.f; \
                _Pragma("unroll") for (int k = 0; k < 8; ++k) v = (seg == k) ? sk[k] : v; \
                v2_[cc] = v; } \
            OUT = cvt_pk_bf16(v2_[0], v2_[1]); } while (0)
        PU_IDX(eA, 0); PU_IDX(eB, 1); PU_GATHER(gA, eA);
#pragma unroll 1
        for (int j2 = 0; j2 < 4; ++j2) {
            PU_GATHER(gB, eB);
            if (j2 < 3) PU_IDX(eA, 2 * j2 + 2);
            unsigned pw0, pw1;
            PU_COMPUTE(gA, pw0);
            if (j2 < 3) { PU_GATHER(gA, eA); PU_IDX(eB, 2 * j2 + 3); }
            PU_COMPUTE(gB, pw1);
            *(u32x2*)(pp + 4 * j2) = (u32x2){pw0, pw1};
        }
#undef PU_IDX
#undef PU_GATHER
#undef PU_COMPUTE
    PEER_QUEUE_END
}
__device__ __forceinline__ void phase_peer_c(KP P, const Ctx& c, int layer, int row_lo) {
    const bf16_t* PART = (const bf16_t*)(P->ws + P_PART); const unsigned short* SE = (const unsigned short*)(P->ws + P_SE16); const float* SW = (const float*)(P->ws + WS_SELW);
    const float* ISU = (const float*)(P->ws + WS_PSC) + (size_t)layer * 16384; const float* ISV = ISU + (size_t)4 * 16384; bf16_t* C = (bf16_t*)(P->ws + P_C);
    unsigned pw[16]; unsigned short se0, se1; float w0, w1;
#define PC_LOAD(i_) do { const size_t t_ = (i_) >> 6; const int jj_ = (int)((i_) & 7), seg_ = (int)(((i_) >> 3) & 7); const unsigned* pp_ = (const unsigned*)(PART + ((t_ * 16) * 8 + seg_) * 16 + 2 * jj_); \
        _Pragma("unroll") for (int db = 0; db < 16; ++db) pw[db] = pp_[(size_t)db * 64]; \
        const size_t o_ = t_ * 128 + 16 * jj_ + seg_; se0 = SE[o_]; se1 = SE[o_ + 8]; w0 = SW[o_]; w1 = SW[o_ + 8]; } while (0)
    const size_t ibeg = (size_t)row_lo * 64 + c.gtid, iend = (size_t)T * 64;
    if (ibeg < iend) PC_LOAD(ibeg);
    for (size_t i = ibeg; i < iend; i += c.ngt) { const size_t t = i >> 6; const int jj = (int)(i & 7), seg = (int)((i >> 3) & 7);
        const size_t o0 = t * 128 + 16 * jj + seg, o1 = o0 + 8; const int e0 = se0 & 16383, e1 = se1 & 16383; const float cw0 = w0, cw1 = w1;
        const float iu0 = ISU[e0], iv0 = ISV[e0], iu1 = ISU[e1], iv1 = ISV[e1]; float s0 = 0.f, s1 = 0.f;
#pragma unroll
        for (int db = 0; db < 16; ++db) { const unsigned w = pw[db]; s0 += __builtin_bit_cast(float, w << 16); s1 += __builtin_bit_cast(float, w & 0xffff0000u); }
        if (i + c.ngt < iend) PC_LOAD(i + c.ngt);
        C[o0] = (bf16_t)(cvt_pk_bf16(cw0 * gelu_tanh(s0 * iu0) * iv0, 0.f) & 0xffffu);
        C[o1] = (bf16_t)(cvt_pk_bf16(cw1 * gelu_tanh(s1 * iu1) * iv1, 0.f) & 0xffffu); }
#undef PC_LOAD
}
__device__ __forceinline__ void phase_peer_v(KP P, const Ctx& c, int layer, int row_lo, int qrep) {
    const unsigned short* SE = (const unsigned short*)(P->ws + P_SE16); const bf16_t* C = (const bf16_t*)(P->ws + P_C);
    const unsigned char* V = P->ws + WS_PV + (size_t)layer * 16384 * D; bf16_t* Y = (bf16_t*)(P->ws + P_Y);
    PEER_QUEUE_BEGIN(layer * 2 + 1 + 8 * qrep, row_lo / 8, T / 8)
        int lane = c.lane; asm volatile("" : "+v"(lane));
        const int ts = lane >> 3, seg = lane & 7, t = tg * 8 + ts;
        const unsigned short* se = SE + (size_t)t * 128; const bf16_t* cp = C + (size_t)t * 128; const unsigned char* vb = V + (size_t)db * 16384 * 128; const unsigned seg16 = (unsigned)seg * 16u;
        float acc[16];
#pragma unroll
        for (int e = 0; e < 16; ++e) acc[e] = 0.f;
        u32x4 en[2];
#pragma unroll
        for (int i = 0; i < 2; ++i) en[i] = *(const u32x4*)(se + 8 * i);
#pragma unroll 1
        for (int q = 0; q < 8; ++q) { u32x4 ec[2];
#pragma unroll
          for (int i = 0; i < 2; ++i) ec[i] = en[i];
          if (q < 7) {
#pragma unroll
            for (int i = 0; i < 2; ++i) en[i] = *(const u32x4*)(se + 16 * (q + 1) + 8 * i); }
          const u32x4 c0 = *(const u32x4*)(cp + 16 * q), c1 = *(const u32x4*)(cp + 16 * q + 8);
          u32x4 g[16];
#pragma unroll
          for (int k = 0; k < 16; ++k) { const unsigned w_ = ec[k >> 3][(k >> 1) & 3]; const unsigned e = ((k & 1) ? (w_ >> 16) : w_) & 16383u; g[k] = *(const u32x4*)(vb + (unsigned)((e << 7) | seg16)); }
#pragma unroll
          for (int k = 0; k < 16; k += 2) { const unsigned cwu = (k < 8 ? c0 : c1)[(k >> 1) & 3]; const bf16v2 cw = __builtin_bit_cast(bf16v2, cwu);
#pragma unroll
              for (int w = 0; w < 4; ++w) { const unsigned g0 = g[k][w], g1 = g[k + 1][w];
                  const int pa = (int)__builtin_amdgcn_perm(g1, g0, 0x05010400u), pb = (int)__builtin_amdgcn_perm(g1, g0, 0x07030602u);
                  acc[4 * w + 0] = __builtin_amdgcn_fdot2_f32_bf16(__builtin_amdgcn_cvt_scalef32_pk_bf16_fp8(pa, 1.0f, false), cw, acc[4 * w + 0], false);
                  acc[4 * w + 1] = __builtin_amdgcn_fdot2_f32_bf16(__builtin_amdgcn_cvt_scalef32_pk_bf16_fp8(pa, 1.0f, true), cw, acc[4 * w + 1], false);
                  acc[4 * w + 2] = __builtin_amdgcn_fdot2_f32_bf16(__builtin_amdgcn_cvt_scalef32_pk_bf16_fp8(pb, 1.0f, false), cw, acc[4 * w + 2], false);
                  acc[4 * w + 3] = __builtin_amdgcn_fdot2_f32_bf16(__builtin_amdgcn_cvt_scalef32_pk_bf16_fp8(pb, 1.0f, true), cw, acc[4 * w + 3], false); } } }
        bf16_t* yp = Y + (size_t)t * D + db * 128 + seg * 16;
#pragma unroll
        for (int q = 0; q < 2; ++q) *(u32x4*)(yp + 8 * q) = (u32x4){cvt_pk_bf16(acc[8 * q], acc[8 * q + 1]), cvt_pk_bf16(acc[8 * q + 2], acc[8 * q + 3]), cvt_pk_bf16(acc[8 * q + 4], acc[8 * q + 5]), cvt_pk_bf16(acc[8 * q + 6], acc[8 * q + 7])};
    PEER_QUEUE_END
}
template <bool LAST>
__device__ __forceinline__ void phase_peer_final(KP P, const Ctx& c, int layer) {
    const bf16_t* Y = (const bf16_t*)(P->ws + P_Y); float* X = (float*)(P->ws + WS_X); bf16_t* A0 = (bf16_t*)(P->ws + WS_A0);
    const float* lg = P->in[I_LNG] + (size_t)(layer * 2 + 1) * D; const float* lb = P->in[I_LNB] + (size_t)(layer * 2 + 1) * D;
    const float ymul = ((DBG_ZERO >> (2 * layer + 1)) & 1) ? 0.f : 1.f;
    f32x4 xn[8]; u32x2 yn[8];
    { const int r0 = (LAST ? NCTX : 0) + c.gw; if (r0 < T) {
#pragma unroll
        for (int j = 0; j < 8; ++j) { xn[j] = *(const f32x4*)(X + (size_t)r0 * D + c.lane * 4 + 256 * j); yn[j] = *(const u32x2*)(Y + (size_t)r0 * D + c.lane * 4 + 256 * j); } } }
    for (int row = (LAST ? NCTX : 0) + c.gw; row < T; row += c.ngw) {
        int l4 = c.lane * 4; asm volatile("" : "+v"(l4));
        const int v = row_vec(row); const float* m5 = modp(P, layer, v, 5) + l4;
        f32x4 x[8]; float s = 0.f;
#pragma unroll
        for (int j = 0; j < 8; ++j) { const u32x2 yb = yn[j]; const f32x4 yv = (f32x4){bflo(yb.x), bfhi(yb.x), bflo(yb.y), bfhi(yb.y)};
            x[j] = xn[j] * ALPHA + *(const f32x4*)(m5 + 256 * j) * (yv * ymul); s += (x[j][0] + x[j][1]) + (x[j][2] + x[j][3]); }
        if (row + c.ngw < T) {
#pragma unroll
            for (int j = 0; j < 8; ++j) { xn[j] = *(const f32x4*)(X + (size_t)(row + c.ngw) * D + l4 + 256 * j); yn[j] = *(const u32x2*)(Y + (size_t)(row + c.ngw) * D + l4 + 256 * j); } }
        const float mean = wave_sum(s) * (1.0f / D); float q = 0.f;
#pragma unroll
        for (int j = 0; j < 8; ++j) { x[j] = x[j] - mean; q += (x[j][0] * x[j][0] + x[j][1] * x[j][1]) + (x[j][2] * x[j][2] + x[j][3] * x[j][3]); }
        const float rstd = rsqrtf(wave_sum(q) * (1.0f / D) + LN_EPS);
#pragma unroll
        for (int j = 0; j < 8; ++j) { const int o = l4 + 256 * j; const f32x4 y = x[j] * rstd * *(const f32x4*)(lg + o) + *(const f32x4*)(lb + o);
            if (LAST) { *(f32x4*)(P->out + (size_t)(row - NCTX) * D + o) = y; }
            else { *(f32x4*)(X + (size_t)row * D + o) = y;
                if (layer != 0) {
                const f32x4 hv = y * (*(const f32x4*)(modp(P, layer + 1, v, 1) + o) + 1.0f) + *(const f32x4*)(modp(P, layer + 1, v, 0) + o);
                *(u32x2*)(A0 + (size_t)row * D + o) = (u32x2){cvt_pk_bf16(hv[0], hv[1]), cvt_pk_bf16(hv[2], hv[3])}; } } }
    }
}

__device__ __forceinline__ void phase_rw_mix(KP P, const Ctx& c, int layer) {
    const float* X = (const float*)(P->ws + WS_X); bf16_t* AALL = (bf16_t*)(P->ws + L_AALL); const float* mu = P->in[I_RWMU];
    float mu8[6][8];
    { const int c8 = (int)(c.gtid & 255) * 8;
#pragma unroll
      for (int m = 0; m < 6; ++m) { const f32x4 a = *(const f32x4*)(mu + m * D + c8), b = *(const f32x4*)(mu + m * D + c8 + 4);
#pragma unroll
          for (int j = 0; j < 4; ++j) { mu8[m][j] = a[j]; mu8[m][4 + j] = b[j]; } } }
    for (size_t i = c.gtid; i < TD / 8; i += c.ngt) { const int row = (int)(i >> 8), c8 = (int)(i & 255) * 8; const int v = row_vec(row);
        int nb = -1;
        if (row < NCTX) { const int t = row & (CTX - 1); if (c8 < 1024) { if (t > 0) nb = row - 1; } else { if (t < CTX - 1) nb = row + 1; } }
        else { const int t = (row - NCTX) & (SEQ - 1), qd = c8 >> 9;
            if (qd == 0) { if ((t & 63) != 0) nb = row - 1; } else if (qd == 1) { if ((t & 63) != 63) nb = row + 1; }
            else if (qd == 2) { if (t >= 64) nb = row - 64; } else { if (t < SEQ - 64) nb = row + 64; } }
        const float* sh = modp(P, layer, v, 0) + c8; const float* sc = modp(P, layer, v, 1) + c8;
        float h[8], xx[8];
#pragma unroll
        for (int j = 0; j < 8; ++j) { h[j] = X[(size_t)row * D + c8 + j] * (1.0f + sc[j]) + sh[j]; }
#pragma unroll
        for (int j = 0; j < 8; ++j) { const float s = nb >= 0 ? X[(size_t)nb * D + c8 + j] * (1.0f + sc[j]) + sh[j] : 0.f; xx[j] = s - h[j]; }
#pragma unroll
        for (int m = 0; m < 6; ++m) { float o[8];
#pragma unroll
            for (int j = 0; j < 8; ++j) o[j] = h[j] + xx[j] * mu8[m][j];
            *(u32x4*)(AALL + (size_t)row * (6 * D) + m * D + c8) = (u32x4){cvt_pk_bf16(o[0], o[1]), cvt_pk_bf16(o[2], o[3]), cvt_pk_bf16(o[4], o[5]), cvt_pk_bf16(o[6], o[7])}; } }
}
__device__ __forceinline__ void phase_rw_scan(KP P, const Ctx& c) {
    const bf16_t* R = (const bf16_t*)(P->ws + L_RKV); const bf16_t* Kx = R + TD; const bf16_t* Vx = R + 2 * TD;
    const bf16_t* W = (const bf16_t*)(P->ws + L_W); const bf16_t* AD = (const bf16_t*)(P->ws + L_AD);
    LAS float* rL = (LAS float*)c.lds; LAS float* wL = rL + 4096; LAS float* kkL = rL + 8192; LAS float* bL = rL + 12288; LAS float* kdL = rL + 16384; LAS float* vL = rL + 20480; LAS float* yL = rL + 24576; LAS float* scL = rL + 28672;
    const int tok = c.tid >> 3, cq = c.tid & 7;
    for (int chain = blockIdx.x; chain < 256; chain += gridDim.x) {
        const int b = chain >> 6, hd = (chain >> 1) & 31, dir = chain & 1;
        bf16_t* Y = (bf16_t*)(P->ws + (dir ? L_Y1 : L_Y0));
        const int ch0 = hd * 64 + cq * 8;
        float kkw[8], kaw[8];
#pragma unroll
        for (int j = 0; j < 8; ++j) { kkw[j] = P->in[I_RWKK][ch0 + j]; kaw[j] = P->in[I_RWKA][ch0 + j]; }
        float s[8] = {0.f, 0.f, 0.f, 0.f, 0.f, 0.f, 0.f, 0.f};
        u32x4 gr, gk, gv, gw, ga;
#define RW_GLOAD(ck) do { const int row_ = seq_row(b, dir, (ck) * 64 + tok); gr = *(const u32x4*)(R + (size_t)row_ * D + ch0); gk = *(const u32x4*)(Kx + (size_t)row_ * D + ch0); gv = *(const u32x4*)(Vx + (size_t)row_ * D + ch0); \
        gw = *(const u32x4*)(W + ((size_t)row_ * 2 + dir) * D + ch0); ga = *(const u32x4*)(AD + ((size_t)row_ * 2 + dir) * D + ch0); } while (0)
        RW_GLOAD(0);
        for (int ck = 0; ck < SLEN / 64; ++ck) {
            const int row = seq_row(b, dir, ck * 64 + tok);
            float r8[8], k8[8], v8[8], w8[8], a8[8];
            unpack8(gr, r8); unpack8(gk, k8); unpack8(gv, v8); unpack8(gw, w8); unpack8(ga, a8);
            float kx[8], ss = 0.f;
#pragma unroll
            for (int j = 0; j < 8; ++j) { kx[j] = k8[j] * kkw[j]; ss += kx[j] * kx[j]; }
            ss = sum8(ss);
            const float rn = rsqrtf(ss + 1e-12f);
            __syncthreads();
            float pbr = 0.f, pkr = 0.f;
            {   float wr_[8], kk_[8], b_[8], kd_[8];
#pragma unroll
                for (int j = 0; j < 8; ++j) { kk_[j] = kx[j] * rn; b_[j] = kk_[j] * a8[j]; kd_[j] = k8[j] * (1.0f + (a8[j] - 1.0f) * kaw[j]); wr_[j] = w8[j] * r8[j]; pbr += b_[j] * r8[j]; pkr += kd_[j] * r8[j]; }
                const int o = tok * 64 + cq * 8;
#pragma unroll
                for (int hh = 0; hh < 2; ++hh) { const int q = 4 * hh;
                    *(LAS f32x4*)(rL + o + q) = (f32x4){wr_[q], wr_[q + 1], wr_[q + 2], wr_[q + 3]}; *(LAS f32x4*)(wL + o + q) = (f32x4){w8[q], w8[q + 1], w8[q + 2], w8[q + 3]};
                    *(LAS f32x4*)(kkL + o + q) = (f32x4){kk_[q], kk_[q + 1], kk_[q + 2], kk_[q + 3]}; *(LAS f32x4*)(bL + o + q) = (f32x4){b_[q], b_[q + 1], b_[q + 2], b_[q + 3]};
                    *(LAS f32x4*)(kdL + o + q) = (f32x4){kd_[q], kd_[q + 1], kd_[q + 2], kd_[q + 3]}; *(LAS f32x4*)(vL + o + q) = (f32x4){v8[q], v8[q + 1], v8[q + 2], v8[q + 3]}; } }
            pbr = sum8(pbr); pkr = sum8(pkr);
            if (cq == 0) *(LAS f32x2*)(scL + tok * 2) = (f32x2){pbr, pkr};
            __syncthreads();
            if (ck + 1 < SLEN / 64) RW_GLOAD(ck + 1);
            f32x4 kaA, kbA, waA, wbA, baA, bbA, daA, dbA, raA, rbA, kaB, kbB, waB, wbB, baB, bbB, daB, dbB, raB, rbB; float vvA, vvB; f32x2 scA, scB;
#define RW_LLOAD(X, tk_) do { const int o_ = (tk_) * 64 + cq * 8; ka##X = *(const LAS f32x4*)(kkL + o_); kb##X = *(const LAS f32x4*)(kkL + o_ + 4); wa##X = *(const LAS f32x4*)(wL + o_); wb##X = *(const LAS f32x4*)(wL + o_ + 4); \
                ba##X = *(const LAS f32x4*)(bL + o_); bb##X = *(const LAS f32x4*)(bL + o_ + 4); da##X = *(const LAS f32x4*)(kdL + o_); db##X = *(const LAS f32x4*)(kdL + o_ + 4); ra##X = *(const LAS f32x4*)(rL + o_); rb##X = *(const LAS f32x4*)(rL + o_ + 4); \
                vv##X = vL[(tk_) * 64 + tok]; sc##X = *(const LAS f32x2*)(scL + (tk_) * 2); } while (0)
#define RW_STEP(X, tk_) do { \
                float sa = (fma_s(s[0], ka##X[0], mul_s(s[1], ka##X[1])) + fma_s(s[2], ka##X[2], mul_s(s[3], ka##X[3]))) + (fma_s(s[4], kb##X[0], mul_s(s[5], kb##X[1])) + fma_s(s[6], kb##X[2], mul_s(s[7], kb##X[3]))); \
                float yd = (fma_s(s[0], ra##X[0], mul_s(s[1], ra##X[1])) + fma_s(s[2], ra##X[2], mul_s(s[3], ra##X[3]))) + (fma_s(s[4], rb##X[0], mul_s(s[5], rb##X[1])) + fma_s(s[6], rb##X[2], mul_s(s[7], rb##X[3]))); \
                sum8_pair(sa, yd); \
                const float nsa = -sa; \
                _Pragma("unroll") for (int j2 = 0; j2 < 4; ++j2) { s[j2] = fma_s(vv##X, da##X[j2], fma_s(nsa, ba##X[j2], mul_s(s[j2], wa##X[j2]))); s[4 + j2] = fma_s(vv##X, db##X[j2], fma_s(nsa, bb##X[j2], mul_s(s[4 + j2], wb##X[j2]))); } \
                if (cq == 0) yL[(tk_) * 64 + tok] = yd - sa * sc##X[0] + vv##X * sc##X[1]; } while (0)
            RW_LLOAD(A, 0);
#pragma unroll 1
            for (int tk = 0; tk < 64; tk += 2) {
                RW_LLOAD(B, tk + 1);
                RW_STEP(A, tk);
                RW_LLOAD(A, (tk + 2) & 63);
                RW_STEP(B, tk + 1);
            }
#undef RW_STEP
#undef RW_LLOAD
            __syncthreads();
            { const f32x4 ya = *(const LAS f32x4*)(yL + tok * 64 + cq * 8), yb = *(const LAS f32x4*)(yL + tok * 64 + cq * 8 + 4);
              *(u32x4*)(Y + (size_t)row * D + ch0) = (u32x4){cvt_pk_bf16(ya[0], ya[1]), cvt_pk_bf16(ya[2], ya[3]), cvt_pk_bf16(yb[0], yb[1]), cvt_pk_bf16(yb[2], yb[3])}; }
        }
#undef RW_GLOAD
        __syncthreads();
    }
}
__device__ __forceinline__ void phase_rw_finish(KP P, const Ctx& c) {
    const bf16_t* R = (const bf16_t*)(P->ws + L_RKV); const bf16_t* Kx = R + TD; const bf16_t* Vx = R + 2 * TD;
    const bf16_t* AD = (const bf16_t*)(P->ws + L_AD); const bf16_t* G = (const bf16_t*)(P->ws + L_G);
    const bf16_t* Y0 = (const bf16_t*)(P->ws + L_Y0); const bf16_t* Y1 = (const bf16_t*)(P->ws + L_Y1); bf16_t* Z = (bf16_t*)(P->ws + L_Z);
    const int ch = c.lane * 8 + 512 * (c.gw & 3);
    float ka8[8], rk8[8], gg8[8], gb8[8];
#pragma unroll
    for (int e = 0; e < 8; ++e) { ka8[e] = P->in[I_RWKA][ch + e]; rk8[e] = P->in[I_RWRK][ch + e]; gg8[e] = P->in[I_RWGNG][ch + e]; gb8[e] = P->in[I_RWGNB][ch + e]; }
    u32x4 ny0, ny1, nr, nk, nv, na0, na1, ng;
#define RF_LOAD(k_) do { const int row_ = (k_) >> 2; const size_t o_ = (size_t)row_ * D + ch; ny0 = *(const u32x4*)(Y0 + o_); ny1 = *(const u32x4*)(Y1 + o_); nr = *(const u32x4*)(R + o_); nk = *(const u32x4*)(Kx + o_); \
        nv = *(const u32x4*)(Vx + o_); na0 = *(const u32x4*)(AD + ((size_t)row_ * 2 + 0) * D + ch); na1 = *(const u32x4*)(AD + ((size_t)row_ * 2 + 1) * D + ch); ng = *(const u32x4*)(G + o_); } while (0)
    if (c.gw < T * 4) RF_LOAD(c.gw);
    for (int k = c.gw; k < T * 4; k += c.ngw) { const size_t o = (size_t)(k >> 2) * D + ch;
            float y[8]; { float ya_[8], yb_[8]; unpack8(ny0, ya_); unpack8(ny1, yb_);
#pragma unroll
                for (int e = 0; e < 8; ++e) y[e] = ya_[e] + yb_[e]; }
            float r8[8], k8[8], v8[8], a0[8], a1[8], g8[8];
            unpack8(nr, r8); unpack8(nk, k8); unpack8(nv, v8); unpack8(na0, a0); unpack8(na1, a1); unpack8(ng, g8);
            if (k + c.ngw < T * 4) RF_LOAD(k + c.ngw);
            float s = 0.f;
#pragma unroll
            for (int e = 0; e < 8; ++e) s += y[e];
            const float mean = sum8(s) * (1.0f / 64.0f); float q = 0.f;
#pragma unroll
            for (int e = 0; e < 8; ++e) { y[e] -= mean; q += y[e] * y[e]; }
            const float rstd = rsqrtf(sum8(q) * (1.0f / 64.0f) + 64e-5f);
            float bsum = 0.f;
#pragma unroll
            for (int e = 0; e < 8; ++e) { const float ka = ka8[e], rk = rk8[e];
                const float kd0 = k8[e] * (1.0f + (a0[e] - 1.0f) * ka), kd1 = k8[e] * (1.0f + (a1[e] - 1.0f) * ka); bsum += r8[e] * (kd0 + kd1) * rk; }
            bsum = sum8(bsum);
            float z[8];
#pragma unroll
            for (int e = 0; e < 8; ++e) z[e] = (y[e] * rstd * gg8[e] + gb8[e] + bsum * v8[e]) * g8[e];
            *(u32x4*)(Z + o) = (u32x4){cvt_pk_bf16(z[0], z[1]), cvt_pk_bf16(z[2], z[3]), cvt_pk_bf16(z[4], z[5]), cvt_pk_bf16(z[6], z[7])}; }
#undef RF_LOAD
}

__device__ __forceinline__ bf16x8 frag16(const LAS unsigned char* p) { return *(const LAS bf16x8*)p; }
__device__ __forceinline__ void phase_ret_scan(KP P, const Ctx& c) {
    const bf16_t* Q = (const bf16_t*)(P->ws + L_RQ); const bf16_t* Kx = (const bf16_t*)(P->ws + L_RK); const bf16_t* Vx = (const bf16_t*)(P->ws + L_RV);
    constexpr int QP = 528, TP = 144, VP = 272;
    constexpr int OFF_Q = 0, OFF_K = 33792, OFF_KT = 67584, OFF_VT = 104448, OFF_P = 122880;
    LAS unsigned char* L = c.lds;
    const int w = c.wave;
    for (int un = blockIdx.x; un < 256; un += gridDim.x) {
        const int b = un >> 6, h = (un >> 3) & 7, dir = (un >> 2) & 1, dvs = un & 3;
        bf16_t* O = (bf16_t*)(P->ws + (dir ? L_OB : L_OF));
        int tid = c.tid;
        const float gamma = 1.0f - exp2f(-5.0f - (float)h), lg2 = log2f(gamma), g63 = exp2f(63.0f * lg2);
        f32x4 Racc[16];
#pragma unroll
        for (int i = 0; i < 16; ++i) Racc[i] = (f32x4){0.f, 0.f, 0.f, 0.f};
        u32x4 pq[4], pv[2];
#define RET_LOAD_QV(ck) do { \
        _Pragma("unroll") for (int i = 0; i < 4; ++i) { const int id = tid + 512 * i, s_ = id >> 5, dc = id & 31; \
            pq[i] = *(const u32x4*)(Q + (size_t)seq_row(b, dir, (ck) * 64 + s_) * D + h * 256 + dc * 8); } \
        _Pragma("unroll") for (int i = 0; i < 2; ++i) { const int id = tid + 512 * i, s_ = id >> 4, ec = id & 15; \
            pv[i] = *(const u32x4*)(Vx + (size_t)seq_row(b, dir, (ck) * 64 + s_) * 4096 + h * 512 + dvs * 128 + ec * 8); } } while (0)
#define RET_LOAD_K(ck, dst) do { \
        _Pragma("unroll") for (int i = 0; i < 4; ++i) { const int id = tid + 512 * i, s_ = id >> 5, dc = id & 31; \
            dst[i] = *(const u32x4*)(Kx + (size_t)seq_row(b, dir, (ck) * 64 + s_) * D + h * 256 + dc * 8); } } while (0)
#define RET_STORE_K(src) do { \
        _Pragma("unroll") for (int i = 0; i < 4; ++i) { const int id = tid + 512 * i, s_ = id >> 5, dc = id & 31; *(LAS u32x4*)(L + OFF_K + s_ * QP + dc * 16) = src[i]; } } while (0)
        RET_LOAD_QV(0);
        { u32x4 pk0[4]; RET_LOAD_K(0, pk0); __syncthreads(); RET_STORE_K(pk0); }
        for (int ck = 0; ck < SLEN / 64; ++ck) {
            asm volatile("" : "+v"(tid));
            const int lane = tid & 63, r16 = lane & 15, q4 = lane >> 4;
            __syncthreads();
#pragma unroll
            for (int i = 0; i < 4; ++i) { const int id = tid + 512 * i, s_ = id >> 5, dc = id & 31; *(LAS u32x4*)(L + OFF_Q + s_ * QP + dc * 16) = pq[i]; }
#pragma unroll
            for (int i = 0; i < 2; ++i) { const int id = tid + 512 * i, s_ = id >> 4, ec = id & 15; *(LAS u32x4*)(L + OFF_P + s_ * VP + ec * 16) = pv[i]; }
            __syncthreads();
            if (ck + 1 < SLEN / 64) RET_LOAD_QV(ck + 1);
            {   const float vs = exp2f(-lg2 * (float)lane);
#pragma unroll
                for (int i = 0; i < 4; ++i) { const int dc = w + 8 * i;
                    const u32x4 raw = *(const LAS u32x4*)(L + OFF_K + lane * QP + dc * 16);
#pragma unroll
                    for (int e = 0; e < 4; ++e) { *(LAS unsigned short*)(L + OFF_KT + (dc * 8 + 2 * e) * TP + lane * 2) = (unsigned short)(raw[e] & 0xffffu); *(LAS unsigned short*)(L + OFF_KT + (dc * 8 + 2 * e + 1) * TP + lane * 2) = (unsigned short)(raw[e] >> 16); } }
#pragma unroll
                for (int i = 0; i < 2; ++i) { const int ec = w + 8 * i; float t8[8]; unpack8(*(const LAS u32x4*)(L + OFF_P + lane * VP + ec * 16), t8);
#pragma unroll
                    for (int e = 0; e < 4; ++e) { const unsigned pk2 = cvt_pk_bf16(t8[2 * e] * vs, t8[2 * e + 1] * vs);
                        *(LAS unsigned short*)(L + OFF_VT + (ec * 8 + 2 * e) * TP + lane * 2) = (unsigned short)(pk2 & 0xffffu); *(LAS unsigned short*)(L + OFF_VT + (ec * 8 + 2 * e + 1) * TP + lane * 2) = (unsigned short)(pk2 >> 16); } } }
            const int it_s = w >> 1, jt0 = 2 * (w & 1);
            f32x4 s0 = (f32x4){0.f, 0.f, 0.f, 0.f}, s1 = s0;
#pragma unroll
            for (int ks = 0; ks < 8; ++ks) { const int co = (32 * ks + 8 * q4) * 2; if ((ks & 1) == 0) asm volatile("" ::: "memory");
                const bf16x8 qf = frag16(L + OFF_Q + (16 * it_s + r16) * QP + co), k0 = frag16(L + OFF_K + (16 * jt0 + r16) * QP + co), k1 = frag16(L + OFF_K + (16 * jt0 + 16 + r16) * QP + co);
                s0 = __builtin_amdgcn_mfma_f32_16x16x32_bf16(k0, qf, s0, 0, 0, 0); s1 = __builtin_amdgcn_mfma_f32_16x16x32_bf16(k1, qf, s1, 0, 0, 0); }
            __syncthreads();
            {   const int i_ = 16 * it_s + r16; const float gi = exp2f(lg2 * (float)i_);
                const int j0 = 16 * jt0 + 4 * q4, j1 = j0 + 16; float p0[4], p1[4];
#pragma unroll
                for (int r = 0; r < 4; ++r) { p0[r] = (j0 + r <= i_) ? s0[r] * gi : 0.f; p1[r] = (j1 + r <= i_) ? s1[r] * gi : 0.f; }
                *(LAS u32x2*)(L + OFF_P + i_ * TP + j0 * 2) = (u32x2){cvt_pk_bf16(p0[0], p0[1]), cvt_pk_bf16(p0[2], p0[3])};
                *(LAS u32x2*)(L + OFF_P + i_ * TP + j1 * 2) = (u32x2){cvt_pk_bf16(p1[0], p1[1]), cvt_pk_bf16(p1[2], p1[3])}; }
            __syncthreads();
            u32x4 pkn[4]; const bool has_next = ck + 1 < SLEN / 64;
            if (has_next) RET_LOAD_K(ck + 1, pkn);
            const LAS unsigned char* vtp = L + OFF_VT + (16 * w + r16) * TP + (8 * q4) * 2;
#pragma unroll
            for (int it = 0; it < 4; ++it) { const int i_ = 16 * it + r16; f32x4 a = (f32x4){0.f, 0.f, 0.f, 0.f};
                asm volatile("" ::: "memory");
#pragma unroll
                for (int m = 0; m < 8; ++m) {
                    const u32x4 t = (u32x4){cvt_pk_bf16(Racc[2 * m][0], Racc[2 * m][1]), cvt_pk_bf16(Racc[2 * m][2], Racc[2 * m][3]), cvt_pk_bf16(Racc[2 * m + 1][0], Racc[2 * m + 1][1]), cvt_pk_bf16(Racc[2 * m + 1][2], Racc[2 * m + 1][3])};
                    const LAS unsigned char* qp = L + OFF_Q + i_ * QP + (32 * m + 4 * q4) * 2; const u32x2 lo = *(const LAS u32x2*)qp, hi = *(const LAS u32x2*)(qp + 32);
                    const u32x4 tq = (u32x4){lo.x, lo.y, hi.x, hi.y}; a = __builtin_amdgcn_mfma_f32_16x16x32_bf16(__builtin_bit_cast(bf16x8, t), __builtin_bit_cast(bf16x8, tq), a, 0, 0, 0); }
                a = a * exp2f(lg2 * (float)(i_ + 1));
#pragma unroll
                for (int ks = 0; ks < 2; ++ks) a = __builtin_amdgcn_mfma_f32_16x16x32_bf16(frag16(vtp + 64 * ks), frag16(L + OFF_P + i_ * TP + (32 * ks + 8 * q4) * 2), a, 0, 0, 0);
                *(u32x2*)(O + (size_t)seq_row(b, dir, ck * 64 + i_) * 4096 + h * 512 + dvs * 128 + 16 * w + 4 * q4) = (u32x2){cvt_pk_bf16(a[0], a[1]), cvt_pk_bf16(a[2], a[3])}; }
            if (has_next) RET_STORE_K(pkn);
#pragma unroll
            for (int dt = 0; dt < 16; ++dt) { if ((dt & 1) == 0) asm volatile("" ::: "memory");
                f32x4 u = Racc[dt] * gamma;
#pragma unroll
                for (int ks = 0; ks < 2; ++ks) u = __builtin_amdgcn_mfma_f32_16x16x32_bf16(frag16(L + OFF_KT + (16 * dt + r16) * TP + (32 * ks + 8 * q4) * 2), frag16(vtp + 64 * ks), u, 0, 0, 0);
                Racc[dt] = u * g63; }
        }
#undef RET_LOAD_QV
#undef RET_LOAD_K
#undef RET_STORE_K
        __syncthreads();
    }
}
__device__ __forceinline__ void phase_ret_merge(KP P, const Ctx& c) {
    const bf16_t* OF = (const bf16_t*)(P->ws + L_OF); const bf16_t* OB = (const bf16_t*)(P->ws + L_OB); const bf16_t* GF = (const bf16_t*)(P->ws + L_GF); const bf16_t* GB = (const bf16_t*)(P->ws + L_GB);
    bf16_t* Z = (bf16_t*)(P->ws + L_RZ);
    u32x4 nf, nb, ngf, ngb;
#define RM_LOAD(k_) do { const size_t o_ = (size_t)(k_) * 512 + c.lane * 8; nf = *(const u32x4*)(OF + o_); nb = *(const u32x4*)(OB + o_); ngf = *(const u32x4*)(GF + o_); ngb = *(const u32x4*)(GB + o_); } while (0)
    if (c.gw < T * 8) RM_LOAD(c.gw);
    for (int k = c.gw; k < T * 8; k += c.ngw) { const size_t o = (size_t)k * 512 + c.lane * 8;
            float f[8], bk[8], gf[8], gb[8]; unpack8(nf, f); unpack8(nb, bk); unpack8(ngf, gf); unpack8(ngb, gb);
            if (k + c.ngw < T * 8) RM_LOAD(k + c.ngw);
            float sf = 0.f, sb = 0.f;
#pragma unroll
            for (int e = 0; e < 8; ++e) { sf += f[e]; sb += bk[e]; }
            const float mf = wave_sum(sf) * (1.0f / 512.0f), mb = wave_sum(sb) * (1.0f / 512.0f); float qf = 0.f, qb = 0.f;
#pragma unroll
            for (int e = 0; e < 8; ++e) { f[e] -= mf; bk[e] -= mb; qf += f[e] * f[e]; qb += bk[e] * bk[e]; }
            const float rf = rsqrtf(wave_sum(qf) * (1.0f / 512.0f) + LN_EPS), rb = rsqrtf(wave_sum(qb) * (1.0f / 512.0f) + LN_EPS);
            float z[8];
#pragma unroll
            for (int e = 0; e < 8; ++e) z[e] = gf[e] * (f[e] * rf) + gb[e] * (bk[e] * rb);
            *(u32x4*)(Z + o) = (u32x4){cvt_pk_bf16(z[0], z[1]), cvt_pk_bf16(z[2], z[3]), cvt_pk_bf16(z[4], z[5]), cvt_pk_bf16(z[6], z[7])}; }
#undef RM_LOAD
}

__device__ __forceinline__ Ctx make_ctx(LAS unsigned char* lds) {
    int t = threadIdx.x; asm volatile("" : "+v"(t));
    Ctx c; c.lds = lds; c.tid = t; c.lane = t & 63; c.wave = __builtin_amdgcn_readfirstlane(t >> 6);
    c.gw = blockIdx.x * 8 + c.wave; c.ngw = gridDim.x * 8; c.gtid = blockIdx.x * 512 + t; c.ngt = gridDim.x * 512; return c;
}
#define GRID_BAR() xcd_barrier(bar)
template <class Epi, class GT> __device__ __forceinline__ void run_gemm_m(LAS unsigned char* lds, const GT& g, int M, int N, const Epi& E) {
    pg8::StaticOrder S; S.init(M, N, (int)gridDim.x, (int)blockIdx.x); pg8::gemm_phase<Epi, GT>(lds, g, S, E);
}
template <class Epi, class GT> __device__ __forceinline__ void run_gemm(LAS unsigned char* lds, const GT& g, int N, const Epi& E, int pm0 = 0) {
    pg8::StaticOrder S; S.init(T, N, (int)gridDim.x, (int)blockIdx.x, pm0); pg8::gemm_phase<Epi, GT>(lds, g, S, E);
}
template <int LAYER, bool LAST> __device__ __forceinline__ void peer_phases(LAS unsigned char* lds, const XcdBarrier& bar) {
    phase_ln_mid(kp_fresh(), make_ctx(lds), LAYER, LAST ? NCTX : 0); GRID_BAR();
    PROBE_REP(2) { KP P = kp_fresh(); unsigned char* ws = P->ws; GPlain g{(const bf16_t*)(ws + WS_H2), (const bf16_t*)(ws + WS_WQ) + (size_t)LAYER * D * D, D, D, D}; EpiF32Plain E{(float*)(ws + WS_S), D}; run_gemm(lds, g, D, E, LAST ? 4 : 0);
        if (!LAST && _rep == 0) { constexpr int NR = 8 * 16384, SH = (NR + 2) / 3; const int lo = LAYER * SH, hi = (LAYER == 2) ? NR : (LAYER + 1) * SH;
            if ((int)gridDim.x == 256) { if ((int)blockIdx.x >= 32) peer_convert_rows(kp_fresh(), make_ctx(lds), lo, hi, (int)blockIdx.x - 32, 224); }
            else peer_convert_rows(kp_fresh(), make_ctx(lds), lo, hi, (int)blockIdx.x, (int)gridDim.x); }
        GRID_BAR(); }
    PROBE_REP(1) { phase_peer_select(kp_fresh(), make_ctx(lds), LAST ? NCTX : 0); GRID_BAR(); }
    PROBE_REP(0) { phase_peer_u(kp_fresh(), make_ctx(lds), LAYER, LAST ? NCTX : 0, _rep); GRID_BAR(); }
    phase_peer_c(kp_fresh(), make_ctx(lds), LAYER, LAST ? NCTX : 0); GRID_BAR();
    PROBE_REP(9) { phase_peer_v(kp_fresh(), make_ctx(lds), LAYER, LAST ? NCTX : 0, _rep); GRID_BAR(); }
    phase_peer_final<LAST>(kp_fresh(), make_ctx(lds), LAYER); GRID_BAR();
}
template <int LAYER, int JL> __device__ __forceinline__ void rg_phases(LAS unsigned char* lds, const XcdBarrier& bar) {
    PROBE_REP(6) { KP P = kp_fresh(); unsigned char* ws = P->ws; GPlain g{(const bf16_t*)(ws + WS_A0), (const bf16_t*)(ws + WS_RGIN) + (size_t)JL * 4096 * D, D, D, D}; EpiRgIn E{(bf16_t*)(ws + L_UG), (bf16_t*)(ws + L_UR)}; run_gemm(lds, g, 4096, E); GRID_BAR(); }
    PROBE_REP(7) { phase_rg_conv(kp_fresh(), make_ctx(lds), JL); GRID_BAR(); }
    { KP P = kp_fresh(); unsigned char* ws = P->ws; GGate g{(const bf16_t*)(ws + L_XC), (const bf16_t*)(ws + WS_RGGATE) + (size_t)JL * 8192 * 256, 256, D, 256};
      EpiRgGate E{(const bf16_t*)(ws + L_XC), (bf16_t*)(ws + L_LA), (bf16_t*)(ws + L_BB), P->in[I_RGGB] + (size_t)JL * 4 * D, (const float*)(ws + WS_SPT) + (size_t)JL * 2 * D}; PROBE_REP(11) { run_gemm(lds, g, 8192, E); GRID_BAR(); } }
    PROBE_REP(3) { phase_rg_scan1(kp_fresh(), make_ctx(lds)); GRID_BAR();
    phase_rg_scan2(kp_fresh(), make_ctx(lds)); GRID_BAR();
    phase_rg_scan3<0>(kp_fresh(), make_ctx(lds)); GRID_BAR();
    phase_rg_scan3<1>(kp_fresh(), make_ctx(lds)); GRID_BAR(); }
    { KP P = kp_fresh(); unsigned char* ws = P->ws; GPlain g{(const bf16_t*)(ws + L_YIN), (const bf16_t*)(ws + WS_RGOUT) + (size_t)JL * D * D, D, D, D}; EpiResid E{(float*)(ws + WS_X), modp(P, LAYER, 0, 2), ((DBG_ZERO >> (2 * LAYER)) & 1) ? 0.f : 1.f}; run_gemm(lds, g, D, E, 4);
      if (LAYER != 3) { GSplitK gs{(const bf16_t*)(ws + L_YIN), (const bf16_t*)(ws + WS_RGOUT) + (size_t)JL * D * D, 512, D, D}; EpiPartial Ep{(float*)(ws + WS_S)}; run_gemm_m(lds, gs, NCTX, 4 * D, Ep); } } GRID_BAR();
}
template <int LAYER> __device__ __forceinline__ void rw_phases(LAS unsigned char* lds, const XcdBarrier& bar) {
    PROBE_REP(7) { phase_rw_mix(kp_fresh(), make_ctx(lds), LAYER); GRID_BAR(); }
    PROBE_REP(6) { KP P = kp_fresh(); unsigned char* ws = P->ws; GRw1 g{(const bf16_t*)(ws + L_AALL), (const bf16_t*)(ws + WS_RW1), D, 6 * D, D}; EpiRw1 E{(bf16_t*)(ws + L_RKV), (bf16_t*)(ws + L_A2)}; run_gemm(lds, g, 6912, E); GRID_BAR(); }
    { KP P = kp_fresh(); unsigned char* ws = P->ws; GRw2 g{(const bf16_t*)(ws + L_A2), (const bf16_t*)(ws + WS_RW2), 256, 768, 256}; EpiRw2 E{(bf16_t*)(ws + L_W), (bf16_t*)(ws + L_AD), (bf16_t*)(ws + L_G), P->in[I_RWDEC0], P->in[I_RWICL0]}; PROBE_REP(12) { run_gemm(lds, g, 10240, E); GRID_BAR(); } }
    PROBE_REP(4) { phase_rw_scan(kp_fresh(), make_ctx(lds)); GRID_BAR(); }
    PROBE_REP(7) { phase_rw_finish(kp_fresh(), make_ctx(lds)); GRID_BAR(); }
    { KP P = kp_fresh(); unsigned char* ws = P->ws; GPlain g{(const bf16_t*)(ws + L_Z), (const bf16_t*)(ws + WS_RWO), D, D, D}; EpiResid E{(float*)(ws + WS_X), modp(P, LAYER, 0, 2), ((DBG_ZERO >> (2 * LAYER)) & 1) ? 0.f : 1.f}; run_gemm(lds, g, D, E, 4);
      GSplitK gs{(const bf16_t*)(ws + L_Z), (const bf16_t*)(ws + WS_RWO), 512, D, D}; EpiPartial Ep{(float*)(ws + WS_S)}; run_gemm_m(lds, gs, NCTX, 4 * D, Ep); } GRID_BAR();
}
template <int LAYER> __device__ __forceinline__ void ret_phases(LAS unsigned char* lds, const XcdBarrier& bar) {
    { KP P = kp_fresh(); unsigned char* ws = P->ws; GPlain g{(const bf16_t*)(ws + WS_A0), (const bf16_t*)(ws + WS_RETIN), D, D, D};
      EpiRetIn E{(bf16_t*)(ws + L_RQ), (bf16_t*)(ws + L_RK), (bf16_t*)(ws + L_RV), (bf16_t*)(ws + L_GF), (bf16_t*)(ws + L_GB), (const float*)(ws + WS_CS)}; PROBE_REP(10) { run_gemm(lds, g, 16384, E); GRID_BAR(); } }
    PROBE_REP(5) { phase_ret_scan(kp_fresh(), make_ctx(lds)); GRID_BAR(); }
    PROBE_REP(7) { phase_ret_merge(kp_fresh(), make_ctx(lds)); GRID_BAR(); }
    { KP P = kp_fresh(); unsigned char* ws = P->ws; GPlain g{(const bf16_t*)(ws + L_RZ), (const bf16_t*)(ws + WS_RETOUT), 4096, 4096, 4096}; EpiResid E{(float*)(ws + WS_X), modp(P, LAYER, 0, 2), ((DBG_ZERO >> (2 * LAYER)) & 1) ? 0.f : 1.f}; run_gemm(lds, g, D, E, 4);
      GSplitK gs{(const bf16_t*)(ws + L_RZ), (const bf16_t*)(ws + WS_RETOUT), 512, 4096, 4096}; EpiPartial Ep{(float*)(ws + WS_S)}; run_gemm_m(lds, gs, NCTX, 8 * D, Ep); } GRID_BAR();
}

__global__ void __launch_bounds__(512, 2) hybrid_fwd(Params Pkernarg) {
    extern __shared__ __attribute__((aligned(16))) unsigned char lds_raw[];
    LAS unsigned char* lds = (LAS unsigned char*)lds_raw;
    volatile LAS unsigned* MISC = (volatile LAS unsigned*)(lds + MISC_OFF);
    if (threadIdx.x < 64) MISC[threadIdx.x] = 0u;
    __syncthreads();
    XcdBarrier bar = xcd_barrier_post((unsigned*)(kp_fresh()->ws + WS_CTL) + 4096, MISC + 8);

    if ((PROBE >> 13) & 1) { for (int i = 0; i < 64; ++i) GRID_BAR(); }
    PROBE_REP(8) { phase_prologue(kp_fresh(), make_ctx(lds)); GRID_BAR(); }
    { KP P = kp_fresh(); unsigned char* ws = P->ws; GFold g{(const bf16_t*)(ws + WS_KEYS), (const bf16_t*)(ws + WS_WQN), 256, 256, D}; EpiBf16Plain E{(bf16_t*)(ws + WS_WQ), D}; run_gemm_m(lds, g, 4 * D, D, E); }
    phase_modfin(kp_fresh(), make_ctx(lds)); GRID_BAR();
    phase_xinit(kp_fresh(), make_ctx(lds)); GRID_BAR();
    rg_phases<0, 0>(lds, bar);  peer_phases<0, false>(lds, bar);
    rw_phases<1>(lds, bar);     peer_phases<1, false>(lds, bar);
    ret_phases<2>(lds, bar);    peer_phases<2, false>(lds, bar);
    rg_phases<3, 1>(lds, bar);  peer_phases<3, true>(lds, bar);
}

extern "C" void kernel_launch(void* const* d_in, const int* in_sizes, int n_in, void* d_out, int out_size, void* d_ws, size_t ws_size, hipStream_t stream) {
    static int grid = 0;
    if (!grid) {
        if (n_in != 37 || ws_size < WS_END) { fprintf(stderr, "kernel_launch: unexpected problem (n_in %d, ws %zu)\n", n_in, ws_size); grid = -1; return; }
        int dev = 0, cus = 0, per_cu = 0;
        if (hipGetDevice(&dev) != hipSuccess || hipDeviceGetAttribute(&cus, hipDeviceAttributeMultiprocessorCount, dev) != hipSuccess) { grid = -1; return; }
        if (hipFuncSetAttribute((const void*)hybrid_fwd, hipFuncAttributeMaxDynamicSharedMemorySize, LDS_BYTES) != hipSuccess) { fprintf(stderr, "kernel_launch: hipFuncSetAttribute failed\n"); grid = -1; return; }
        if (hipOccupancyMaxActiveBlocksPerMultiprocessor(&per_cu, (const void*)hybrid_fwd, 512, LDS_BYTES) != hipSuccess || per_cu < 1) { fprintf(stderr, "kernel_launch: occupancy query says %d\n", per_cu); grid = -1; return; }
        grid = cus;
    }
    if (grid <= 0) return;
    hipMemsetAsync((char*)d_ws + WS_CTL, 0, CTL_BYTES, stream);
    Params p; memset(&p, 0, sizeof(p));
    for (int i = 0; i < 37; ++i) p.in[i] = (const float*)d_in[i];
    p.out = (float*)d_out; p.ws = (unsigned char*)d_ws;
    hipLaunchKernelGGL(hybrid_fwd, dim3(grid), dim3(512), LDS_BYTES, stream, p);
}
```

```cpp
#include <hip/hip_runtime.h>
#include <cstdio>
#include <cstring>

#define LAS __attribute__((address_space(3)))
typedef unsigned short bf16_t;
typedef short bf16x8 __attribute__((ext_vector_type(8)));
typedef float f32x4 __attribute__((ext_vector_type(4)));
typedef float f32x2 __attribute__((ext_vector_type(2)));
typedef unsigned u32x4 __attribute__((ext_vector_type(4)));
typedef unsigned u32x2 __attribute__((ext_vector_type(2)));
typedef __bf16 bf16v2 __attribute__((ext_vector_type(2)));

#ifndef DBG_ZERO
#define DBG_ZERO 0
#endif
#ifndef PROBE
#define PROBE 0
#endif
#define PROBE_REP(bit) for (int _rep = 0; _rep < (((PROBE) >> (bit)) & 1) + 1; ++_rep)
constexpr int D = 2048, NBATCH = 4, SEQ = 4096, CTX = 256;
constexpr int NCTX = NBATCH * CTX, NLAT = NBATCH * SEQ, T = NCTX + NLAT;
constexpr int SLEN = CTX + SEQ;
constexpr float ALPHA = 1.681792830507429f;
constexpr float LN_EPS = 1e-5f;
constexpr size_t TD = (size_t)T * D;

constexpr size_t MiB = 1u << 20;
constexpr size_t WS_CTL = 0, CTL_BYTES = 1 * MiB;
constexpr size_t WS_MODP = 2 * MiB;
constexpr size_t WS_MOD = 10 * MiB;
constexpr size_t WS_CS = 11 * MiB;
constexpr size_t WS_SPT = 15 * MiB + 512 * 1024;
constexpr size_t WS_CA = 16 * MiB, WS_CH = 21 * MiB, WS_CIN = 26 * MiB;
constexpr size_t WS_WQ = 32 * MiB;
constexpr size_t WS_KEYS = 64 * MiB;
constexpr size_t WS_RGIN = 68 * MiB;
constexpr size_t WS_RGGATE = 100 * MiB;
constexpr size_t WS_RGOUT = 108 * MiB;
constexpr size_t WS_RW1 = 124 * MiB;
constexpr size_t WS_RW2 = 152 * MiB;
constexpr size_t WS_RWO = 160 * MiB;
constexpr size_t WS_RETIN = 168 * MiB;
constexpr size_t WS_RETOUT = 232 * MiB;
constexpr size_t WS_PU = 256 * MiB;
constexpr size_t WS_PV = 384 * MiB;
constexpr size_t WS_PSC = 512 * MiB;
constexpr size_t WS_X = 768 * MiB;
constexpr size_t WS_A0 = 904 * MiB;
constexpr size_t WS_H2 = 972 * MiB;
constexpr size_t WS_Q = 1040 * MiB;
constexpr size_t WS_WQN = 1040 * MiB;
constexpr size_t WS_S = 1108 * MiB;
constexpr size_t WS_L = 1244 * MiB;
constexpr size_t WS_SELW = 1893 * MiB;
constexpr size_t WS_END = 1902 * MiB;
constexpr size_t P_SE16 = WS_L + 288 * MiB;
constexpr size_t P_PART = WS_L, P_Y = WS_L + 136 * MiB, P_C = WS_L + 272 * MiB;
constexpr int CW_PQ = 16384;
constexpr size_t L_UG = WS_L, L_UR = WS_L + 68 * MiB, L_XC = WS_L + 136 * MiB, L_LA = WS_L + 204 * MiB, L_BB = WS_L + 340 * MiB, L_YIN = WS_L + 476 * MiB;
constexpr size_t L_AALL = WS_L;
constexpr size_t L_W = WS_L, L_AD = WS_L + 136 * MiB, L_G = WS_L + 272 * MiB;
constexpr size_t L_RKV = WS_L + 408 * MiB;
constexpr size_t L_A2 = WS_L + 612 * MiB;
constexpr size_t L_Y0 = WS_H2, L_Y1 = WS_H2 + 136 * MiB;
constexpr size_t L_Z = WS_A0;
constexpr size_t L_RQ = WS_L, L_RK = WS_L + 68 * MiB, L_RV = WS_L + 136 * MiB, L_GF = WS_L + 272 * MiB, L_GB = WS_L + 408 * MiB;
constexpr size_t L_OF = WS_H2, L_OB = WS_H2 + 136 * MiB;
constexpr size_t L_RZ = WS_L;

__device__ __forceinline__ float bf2f(unsigned b) { return __uint_as_float(b << 16); }
__device__ __forceinline__ unsigned cvt_pk_bf16(float lo, float hi) { bf16v2 t; t.x = (__bf16)lo; t.y = (__bf16)hi; return __builtin_bit_cast(unsigned, t); }
__device__ __forceinline__ float bflo(unsigned u) { return __uint_as_float(u << 16); }
__device__ __forceinline__ float bfhi(unsigned u) { return __uint_as_float(u & 0xffff0000u); }
__device__ __forceinline__ float sigmoidf_(float x) { return 1.0f / (1.0f + __expf(-x)); }
__device__ __forceinline__ float siluf_(float x) { return x / (1.0f + __expf(-x)); }
__device__ __forceinline__ float tanhf_(float x) { return 1.0f - 2.0f / (1.0f + __expf(2.0f * x)); }
__device__ __forceinline__ float gelu_tanh(float x) { const float z = 1.5957691216057308f * (x + 0.044715f * x * x * x); return x / (1.0f + __expf(-z)); }
__device__ __forceinline__ void unpack8(const u32x4 u, float (&f)[8]) { f[0] = bflo(u.x); f[1] = bfhi(u.x); f[2] = bflo(u.y); f[3] = bfhi(u.y); f[4] = bflo(u.z); f[5] = bfhi(u.z); f[6] = bflo(u.w); f[7] = bfhi(u.w); }
template <int CTRL> __device__ __forceinline__ float dpp_mov(float v) { const int x = __builtin_bit_cast(int, v); return __builtin_bit_cast(float, __builtin_amdgcn_update_dpp(x, x, CTRL, 0xF, 0xF, false)); }
__device__ __forceinline__ float rl_f(float v, int lane) { return __builtin_bit_cast(float, __builtin_amdgcn_readlane(__builtin_bit_cast(int, v), lane)); }
__device__ __forceinline__ float sum8(float v) { v += dpp_mov<0xB1>(v); v += dpp_mov<0x4E>(v); v += dpp_mov<0x141>(v); return v; }
__device__ __forceinline__ float sum16(float v) { v = sum8(v); v += dpp_mov<0x140>(v); return v; }
__device__ __forceinline__ float fma_s(float a, float b, float c) { float d; asm("v_fma_f32 %0, %1, %2, %3" : "=v"(d) : "v"(a), "v"(b), "v"(c)); return d; }
__device__ __forceinline__ float mul_s(float a, float b) { float d; asm("v_mul_f32 %0, %1, %2" : "=v"(d) : "v"(a), "v"(b)); return d; }
__device__ __forceinline__ void sum8_pair(float& a, float& b) {
    asm volatile("s_nop 1\n\t"
        "v_add_f32_dpp %0, %0, %0 quad_perm:[1,0,3,2] row_mask:0xf bank_mask:0xf\n\tv_add_f32_dpp %1, %1, %1 quad_perm:[1,0,3,2] row_mask:0xf bank_mask:0xf\n\ts_nop 0\n\t"
        "v_add_f32_dpp %0, %0, %0 quad_perm:[2,3,0,1] row_mask:0xf bank_mask:0xf\n\tv_add_f32_dpp %1, %1, %1 quad_perm:[2,3,0,1] row_mask:0xf bank_mask:0xf\n\ts_nop 0\n\t"
        "v_add_f32_dpp %0, %0, %0 row_half_mirror row_mask:0xf bank_mask:0xf\n\tv_add_f32_dpp %1, %1, %1 row_half_mirror row_mask:0xf bank_mask:0xf"
        : "+v"(a), "+v"(b));
}
__device__ __forceinline__ void sum16_pair(float& a, float& b) {
    asm volatile("s_nop 1\n\t"
        "v_add_f32_dpp %0, %0, %0 quad_perm:[1,0,3,2] row_mask:0xf bank_mask:0xf\n\tv_add_f32_dpp %1, %1, %1 quad_perm:[1,0,3,2] row_mask:0xf bank_mask:0xf\n\ts_nop 0\n\t"
        "v_add_f32_dpp %0, %0, %0 quad_perm:[2,3,0,1] row_mask:0xf bank_mask:0xf\n\tv_add_f32_dpp %1, %1, %1 quad_perm:[2,3,0,1] row_mask:0xf bank_mask:0xf\n\ts_nop 0\n\t"
        "v_add_f32_dpp %0, %0, %0 row_half_mirror row_mask:0xf bank_mask:0xf\n\tv_add_f32_dpp %1, %1, %1 row_half_mirror row_mask:0xf bank_mask:0xf\n\ts_nop 0\n\t"
        "v_add_f32_dpp %0, %0, %0 row_mirror row_mask:0xf bank_mask:0xf\n\tv_add_f32_dpp %1, %1, %1 row_mirror row_mask:0xf bank_mask:0xf"
        : "+v"(a), "+v"(b));
}
__device__ __forceinline__ void sum16_quad(float& a, float& b, float& c, float& d) {
    asm volatile("s_nop 1\n\t"
        "v_add_f32_dpp %0, %0, %0 quad_perm:[1,0,3,2] row_mask:0xf bank_mask:0xf\n\tv_add_f32_dpp %1, %1, %1 quad_perm:[1,0,3,2] row_mask:0xf bank_mask:0xf\n\t"
        "v_add_f32_dpp %2, %2, %2 quad_perm:[1,0,3,2] row_mask:0xf bank_mask:0xf\n\tv_add_f32_dpp %3, %3, %3 quad_perm:[1,0,3,2] row_mask:0xf bank_mask:0xf\n\t"
        "v_add_f32_dpp %0, %0, %0 quad_perm:[2,3,0,1] row_mask:0xf bank_mask:0xf\n\tv_add_f32_dpp %1, %1, %1 quad_perm:[2,3,0,1] row_mask:0xf bank_mask:0xf\n\t"
        "v_add_f32_dpp %2, %2, %2 quad_perm:[2,3,0,1] row_mask:0xf bank_mask:0xf\n\tv_add_f32_dpp %3, %3, %3 quad_perm:[2,3,0,1] row_mask:0xf bank_mask:0xf\n\t"
        "v_add_f32_dpp %0, %0, %0 row_half_mirror row_mask:0xf bank_mask:0xf\n\tv_add_f32_dpp %1, %1, %1 row_half_mirror row_mask:0xf bank_mask:0xf\n\t"
        "v_add_f32_dpp %2, %2, %2 row_half_mirror row_mask:0xf bank_mask:0xf\n\tv_add_f32_dpp %3, %3, %3 row_half_mirror row_mask:0xf bank_mask:0xf\n\t"
        "v_add_f32_dpp %0, %0, %0 row_mirror row_mask:0xf bank_mask:0xf\n\tv_add_f32_dpp %1, %1, %1 row_mirror row_mask:0xf bank_mask:0xf\n\t"
        "v_add_f32_dpp %2, %2, %2 row_mirror row_mask:0xf bank_mask:0xf\n\tv_add_f32_dpp %3, %3, %3 row_mirror row_mask:0xf bank_mask:0xf"
        : "+v"(a), "+v"(b), "+v"(c), "+v"(d));
}
__device__ __forceinline__ void sum8_quad(float& a, float& b, float& c, float& d) {
    asm volatile("s_nop 1\n\t"
        "v_add_f32_dpp %0, %0, %0 quad_perm:[1,0,3,2] row_mask:0xf bank_mask:0xf\n\tv_add_f32_dpp %1, %1, %1 quad_perm:[1,0,3,2] row_mask:0xf bank_mask:0xf\n\t"
        "v_add_f32_dpp %2, %2, %2 quad_perm:[1,0,3,2] row_mask:0xf bank_mask:0xf\n\tv_add_f32_dpp %3, %3, %3 quad_perm:[1,0,3,2] row_mask:0xf bank_mask:0xf\n\t"
        "v_add_f32_dpp %0, %0, %0 quad_perm:[2,3,0,1] row_mask:0xf bank_mask:0xf\n\tv_add_f32_dpp %1, %1, %1 quad_perm:[2,3,0,1] row_mask:0xf bank_mask:0xf\n\t"
        "v_add_f32_dpp %2, %2, %2 quad_perm:[2,3,0,1] row_mask:0xf bank_mask:0xf\n\tv_add_f32_dpp %3, %3, %3 quad_perm:[2,3,0,1] row_mask:0xf bank_mask:0xf\n\t"
        "v_add_f32_dpp %0, %0, %0 row_half_mirror row_mask:0xf bank_mask:0xf\n\tv_add_f32_dpp %1, %1, %1 row_half_mirror row_mask:0xf bank_mask:0xf\n\t"
        "v_add_f32_dpp %2, %2, %2 row_half_mirror row_mask:0xf bank_mask:0xf\n\tv_add_f32_dpp %3, %3, %3 row_half_mirror row_mask:0xf bank_mask:0xf"
        : "+v"(a), "+v"(b), "+v"(c), "+v"(d));
}
__device__ __forceinline__ float wave_sum(float v) { v = sum8(v); v += dpp_mov<0x140>(v); return (rl_f(v, 0) + rl_f(v, 16)) + (rl_f(v, 32) + rl_f(v, 48)); }
__device__ __forceinline__ float wave_max(float v) {
    v = fmaxf(v, dpp_mov<0xB1>(v)); v = fmaxf(v, dpp_mov<0x4E>(v)); v = fmaxf(v, dpp_mov<0x141>(v)); v = fmaxf(v, dpp_mov<0x140>(v));
    return fmaxf(fmaxf(rl_f(v, 0), rl_f(v, 16)), fmaxf(rl_f(v, 32), rl_f(v, 48)));
}
__device__ __forceinline__ int row_vec(int row) { return row < NCTX ? 4 : ((row - NCTX) >> 12); }
__device__ __forceinline__ int panel_vec(int pm) { return pm < 4 ? 4 : ((pm - 4) >> 4); }
__device__ __forceinline__ int seq_row(int b, int dir, int s) {
    if (s < CTX) { const int t = dir ? (CTX - 1 - s) : s; return b * CTX + t; }
    int t = s - CTX; if (dir) t = SEQ - 1 - t; return NCTX + b * SEQ + t;
}
__device__ __forceinline__ int row_pos(int row) { return row < NCTX ? (row & (CTX - 1)) : CTX + ((row - NCTX) & (SEQ - 1)); }

namespace pg8 {
constexpr int BM = 256, BK = 64, HALF = 128, HTB = HALF * BK * 2, STAGE_BYTES = 8 * HTB, NXCD = 8, WGM = 8;
__host__ __device__ __forceinline__ int lds_byte(int r, int c) { const int st = (r >> 4) * 2 + (c >> 5), rr = r & 15, cc = c & 31, ob = rr * 64 + cc * 2; return st * 1024 + (ob ^ (((ob >> 9) & 1) << 5)); }
__host__ __device__ __forceinline__ void stage_rc(int b, int& R, int& C) { const int st = b / 1024, sb = b % 1024, swz = sb ^ (((sb >> 9) & 1) << 5); R = (st >> 1) * 16 + swz / 64; C = (st & 1) * 32 + (swz % 64) / 2; }
__host__ __device__ __forceinline__ int perm32(int rho) { const int n = rho >> 4, i = rho & 15; return 8 * (i >> 2) + 4 * n + (i & 3); }
struct Unit { int pm, pn; };
struct StaticOrder {
    int nM, nN, nwg, G, c, pm0;
    __device__ void init(int M, int N, int G_, int c_, int pm0_ = 0) { pm0 = pm0_; nM = M / BM - pm0_; nN = N / BM; nwg = nM * nN; G = G_; c = c_; }
    __device__ bool next(int i, Unit& u) const {
        const long L = (long)i * G + c; if (L >= nwg) return false;
        int wgid = (int)L; { const int q = nwg / NXCD, r = nwg % NXCD, xcd = wgid % NXCD, off = wgid / NXCD; wgid = (xcd < r ? xcd * (q + 1) : r * (q + 1) + (xcd - r) * q) + off; }
        const int nig = WGM * nN, gid = wgid / nig, fm = gid * WGM, gsz = (nM - fm) < WGM ? (nM - fm) : WGM;
        u.pm = pm0 + fm + ((wgid % nig) % gsz); u.pn = (wgid % nig) / gsz; return true;
    }
};
template <class Epi, class GT>
__device__ __forceinline__ void gemm_phase(LAS unsigned char* lds, const GT g, const StaticOrder& S, const Epi& E) {
    int tid_ = threadIdx.x; asm volatile("" : "+v"(tid_));
    const int tid = tid_, wid = __builtin_amdgcn_readfirstlane(tid >> 6), lane = tid & 63, wr = wid >> 2, wc = wid & 3, fr = lane & 15, fq = lane >> 4;
    const int K = g.K, nt = K / BK;
    unsigned voffA[2], voffB[2];
#pragma unroll
    for (int i = 0; i < 2; ++i) { int R, C; stage_rc(tid * 16 + i * 8192, R, C); const int Rb = Epi::PERM ? ((R & ~31) + perm32(R & 31)) : R;
        voffA[i] = (unsigned)(R * g.lda + C) * 2u; voffB[i] = (unsigned)(Rb * g.ldb + C) * 2u; }
    const size_t kstep = (size_t)(BK * 2);
    const size_t hstepA = (size_t)HALF * g.lda * 2, hstepB = (size_t)HALF * g.ldb * 2;
    const unsigned ldsw = (unsigned)wid * 1024u;
    const int aoff = lds_byte(wr * 64 + fr, fq * 8), boff = lds_byte(wc * 32 + fr, fq * 8);
#define PG8_SA(b, h) (((b) * 2 + (h)) * HTB)
#define PG8_SB(b, h) ((4 + (b) * 2 + (h)) * HTB)
#define PG8_STAGE(bufoff, gbase, voff) do { _Pragma("unroll") for (int _i = 0; _i < 2; ++_i) \
        __builtin_amdgcn_global_load_lds((const unsigned*)((const char*)(gbase) + (voff)[_i]), (LAS unsigned*)(lds + (bufoff) + ldsw + _i * 8192), 16, 0, 0); } while (0)
#define PG8_LDA(dst, b, h) do { _Pragma("unroll") for (int m = 0; m < 4; ++m) _Pragma("unroll") for (int k = 0; k < 2; ++k) dst[m][k] = *(const LAS bf16x8*)(lds + PG8_SA(b, h) + aoff + m * 2048 + k * 1024); } while (0)
#define PG8_LDB(dst, b, h) do { _Pragma("unroll") for (int n = 0; n < 2; ++n) _Pragma("unroll") for (int k = 0; k < 2; ++k) dst[n][k] = *(const LAS bf16x8*)(lds + PG8_SB(b, h) + boff + n * 2048 + k * 1024); } while (0)
#define PG8_MMA(ai, bj, At, Bt) do { __builtin_amdgcn_s_setprio(1); _Pragma("unroll") for (int m = 0; m < 4; ++m) _Pragma("unroll") for (int n = 0; n < 2; ++n) _Pragma("unroll") for (int k = 0; k < 2; ++k) \
        acc[ai][bj][m][n] = __builtin_amdgcn_mfma_f32_16x16x32_bf16(Bt[n][k], At[m][k], acc[ai][bj][m][n], 0, 0, 0); __builtin_amdgcn_s_setprio(0); } while (0)
#define PG8_WAIT_V(n) asm volatile("s_waitcnt vmcnt(" #n ")" ::: "memory")
#define PG8_WAIT_L(n) asm volatile("s_waitcnt lgkmcnt(" #n ")" ::: "memory")
#define PG8_BAR __builtin_amdgcn_s_barrier()
#define PG8_SCHED __builtin_amdgcn_sched_barrier(0)
    Unit cur, nxt; int ui = 0;
    if (!S.next(0, cur)) return;
    f32x4 acc[2][2][4][2];
#pragma unroll
    for (int a = 0; a < 2; ++a)
#pragma unroll
        for (int b = 0; b < 2; ++b)
#pragma unroll
            for (int m = 0; m < 4; ++m)
#pragma unroll
                for (int n = 0; n < 2; ++n) acc[a][b][m][n] = (f32x4){0.f, 0.f, 0.f, 0.f};
    bf16x8 At[4][2], B0[2][2], B1[2][2];
    const char* cA = g.a_ptr(cur); const char* cB = g.b_ptr(cur);
    PG8_STAGE(PG8_SB(0, 0), cB, voffB); PG8_STAGE(PG8_SA(0, 0), cA, voffA); PG8_STAGE(PG8_SB(0, 1), cB + hstepB, voffB); PG8_STAGE(PG8_SA(0, 1), cA + hstepA, voffA);
    if (wr == 1) PG8_BAR;
    PG8_WAIT_V(4); PG8_BAR;
    PG8_STAGE(PG8_SB(1, 0), cB + kstep, voffB); PG8_STAGE(PG8_SA(1, 0), cA + kstep, voffA); PG8_STAGE(PG8_SB(1, 1), cB + hstepB + kstep, voffB);
    PG8_WAIT_V(6); PG8_BAR;
    for (;;) {
        const bool has_next = S.next(ui + 1, nxt);
        const char* nA = has_next ? g.a_ptr(nxt) : cA; const char* nB = has_next ? g.b_ptr(nxt) : cB;
        for (int t = 0; t < nt; t += 2) {
            const bool last = (t == nt - 2);
            const char* a1 = cA + (size_t)(t + 1) * kstep;
            const char* a2 = last ? nA : cA + (size_t)(t + 2) * kstep; const char* b2 = last ? nB : cB + (size_t)(t + 2) * kstep;
            const char* a3 = a2 + kstep; const char* b3 = b2 + kstep;
            PG8_LDB(B0, 0, 0); PG8_SCHED; PG8_LDA(At, 0, 0); PG8_STAGE(PG8_SA(1, 1), a1 + hstepA, voffA);
            PG8_WAIT_L(8); PG8_BAR; PG8_WAIT_L(0); PG8_MMA(0, 0, At, B0); PG8_BAR; PG8_SCHED;
            PG8_LDB(B1, 0, 1); PG8_STAGE(PG8_SB(0, 0), b2, voffB);
            PG8_BAR; PG8_WAIT_L(0); PG8_MMA(0, 1, At, B1); PG8_BAR;
            PG8_LDA(At, 0, 1); PG8_STAGE(PG8_SA(0, 0), a2, voffA);
            PG8_BAR; PG8_WAIT_L(0); PG8_MMA(1, 0, At, B0); PG8_BAR; PG8_SCHED;
            PG8_STAGE(PG8_SB(0, 1), b2 + hstepB, voffB);
            PG8_WAIT_V(6); PG8_BAR; PG8_MMA(1, 1, At, B1); PG8_BAR;
            PG8_LDB(B0, 1, 0); PG8_SCHED; PG8_LDA(At, 1, 0); PG8_STAGE(PG8_SA(0, 1), a2 + hstepA, voffA);
            PG8_WAIT_L(8); PG8_BAR; PG8_WAIT_L(0); PG8_MMA(0, 0, At, B0); PG8_BAR; PG8_SCHED;
            PG8_LDB(B1, 1, 1); PG8_STAGE(PG8_SB(1, 0), b3, voffB);
            PG8_BAR; PG8_WAIT_L(0); PG8_MMA(0, 1, At, B1); PG8_BAR;
            PG8_LDA(At, 1, 1); PG8_STAGE(PG8_SA(1, 0), a3, voffA);
            PG8_BAR; PG8_WAIT_L(0); PG8_MMA(1, 0, At, B0); PG8_BAR; PG8_SCHED;
            PG8_STAGE(PG8_SB(1, 1), b3 + hstepB, voffB);
            PG8_WAIT_V(6); PG8_BAR; PG8_MMA(1, 1, At, B1); PG8_BAR;
        }
        E(acc, cur, wr, wc, fr, fq);
        if (!has_next) break;
#pragma unroll
        for (int a = 0; a < 2; ++a)
#pragma unroll
            for (int b = 0; b < 2; ++b)
#pragma unroll
                for (int m = 0; m < 4; ++m)
#pragma unroll
                    for (int n = 0; n < 2; ++n) acc[a][b][m][n] = (f32x4){0.f, 0.f, 0.f, 0.f};
        cur = nxt; cA = nA; cB = nB; ++ui;
    }
    PG8_WAIT_V(0);
    if (wr == 0) PG8_BAR;
    PG8_BAR;
#undef PG8_SA
#undef PG8_SB
#undef PG8_STAGE
#undef PG8_LDA
#undef PG8_LDB
#undef PG8_MMA
#undef PG8_WAIT_V
#undef PG8_WAIT_L
#undef PG8_BAR
#undef PG8_SCHED
}
}
using pg8::Unit;
typedef const f32x4 (&AccRef)[2][2][4][2];

#define XB_TMO      128
#define XB_XCNT(j)  (256  + 64 * (j))
#define XB_XSUB(j)  (1280 + 64 * (j))
#define XB_XGEN(j)  (2304 + 64 * (j))
#define XB_TOP      3328
#define XB_TOPGEN   3392
#define XCD_BAR_WORDS 3456
#define XB_SPIN_CAP (1u << 18)
__device__ __forceinline__ unsigned xb_ld(unsigned* p)              { return __hip_atomic_load(p, __ATOMIC_RELAXED, __HIP_MEMORY_SCOPE_AGENT); }
__device__ __forceinline__ unsigned xb_add(unsigned* p, unsigned v) { return __hip_atomic_fetch_add(p, v, __ATOMIC_RELAXED, __HIP_MEMORY_SCOPE_AGENT); }
__device__ __forceinline__ unsigned xb_xcc_id() { return (unsigned)__builtin_amdgcn_s_getreg((3 << 11) | 20) & 0xFu; }
#define XB_SPIN(cond, bar) do { unsigned _sp = 0; while (cond) { __builtin_amdgcn_s_sleep(1); \
    if ((++_sp & 255u) == 0u) { if (xb_ld(&(bar)[XB_TMO])) break; if (_sp > XB_SPIN_CAP) { atomicAdd(&(bar)[XB_TMO], 1u); break; } } } } while (0)
struct XcdBarrier { unsigned* bar; unsigned x; volatile LAS unsigned* st; };
__device__ __forceinline__ XcdBarrier xcd_barrier_post(unsigned* bar, volatile LAS unsigned* st) {
    XcdBarrier b; b.bar = bar; b.x = xb_xcc_id(); b.st = st;
    if (threadIdx.x == 0) (void)xb_add(&bar[XB_XCNT(b.x)], 1u);
    return b;
}
__device__ __forceinline__ void xcd_barrier_complete(unsigned* bar, unsigned x, unsigned& nloc, unsigned& nx) {
    const unsigned G = gridDim.x * gridDim.y * gridDim.z;
    unsigned sum, cnt, mine, sp = 0u;
    for (;;) {
        sum = 0u; cnt = 0u; mine = 0u;
#pragma unroll
        for (unsigned j = 0; j < 16; ++j) { const unsigned c = xb_ld(&bar[XB_XCNT(j)]); sum += c; cnt += (c > 0u) ? 1u : 0u; mine = (j == x) ? c : mine; }
        if (sum == G) break;
        __builtin_amdgcn_s_sleep(1);
        if ((++sp & 255u) == 0u) { if (xb_ld(&bar[XB_TMO])) break; if (sp > XB_SPIN_CAP) { atomicAdd(&bar[XB_TMO], 1u); break; } }
    }
    nloc = mine > 0u ? mine : 1u; nx = cnt > 0u ? cnt : 1u;
}
__device__ __forceinline__ void xcd_barrier(const XcdBarrier& b) {
    asm volatile("s_waitcnt vmcnt(0)" ::: "memory");
    __syncthreads();
    if (threadIdx.x == 0) {
        unsigned* bar = b.bar;
        __builtin_amdgcn_s_waitcnt(0);
        unsigned nloc = b.st[0], nx = b.st[1];
        if (nloc == 0u) { xcd_barrier_complete(bar, b.x, nloc, nx); b.st[0] = nloc; b.st[1] = nx; }
        const unsigned old = xb_add(&bar[XB_XSUB(b.x)], 1u);
        const unsigned gen = old / nloc;
        if (old + 1u == (gen + 1u) * nloc) {
            __builtin_amdgcn_fence(__ATOMIC_RELEASE, "agent");
            asm volatile("s_waitcnt vmcnt(0)" ::: "memory");
            const unsigned og = xb_add(&bar[XB_TOP], 1u);
            const unsigned tg = og / nx;
            if (og + 1u == (tg + 1u) * nx) xb_add(&bar[XB_TOPGEN], 1u);
            else XB_SPIN(xb_ld(&bar[XB_TOPGEN]) == tg, bar);
            __builtin_amdgcn_fence(__ATOMIC_ACQUIRE, "agent");
            xb_add(&bar[XB_XGEN(b.x)], 1u);
            asm volatile("s_waitcnt vmcnt(0)" ::: "memory");
        } else {
            XB_SPIN(xb_ld(&bar[XB_XGEN(b.x)]) == gen, bar);
            __builtin_amdgcn_fence(__ATOMIC_ACQUIRE, "agent");
            asm volatile("s_waitcnt vmcnt(0)" ::: "memory");
        }
    }
    __syncthreads();
}

struct Params { const float* in[37]; float* out; unsigned char* ws; };
typedef const __attribute__((address_space(4))) Params* KP;
__device__ __forceinline__ KP kp_fresh() { KP p = (KP)__builtin_amdgcn_kernarg_segment_ptr(); asm volatile("" : "+s"(p)); return p; }
enum { I_X = 0, I_C, I_CTX, I_CCTX, I_ADAW, I_ADAB, I_LNG, I_LNB, I_PWQ, I_PKEYS, I_PU, I_PV, I_RGWIN, I_RGCW, I_RGCB, I_RGGW, I_RGGB, I_RGLAM, I_RGWOUT,
       I_RWMU, I_RWRKV, I_RWWO, I_RWDEC0, I_RWDEC1, I_RWDEC2, I_RWICL0, I_RWICL1, I_RWICL2, I_RWG1, I_RWG2, I_RWKK, I_RWKA, I_RWRK, I_RWGNG, I_RWGNB, I_RETWIN, I_RETWOUT };
constexpr int LDS_BYTES = 147456;
constexpr int MISC_OFF = 147200;

__device__ __forceinline__ const float* modp(KP P, int layer, int v, int slot) { return (const float*)(P->ws + WS_MOD) + ((size_t)(layer * 5 + v) * 6 + slot) * D; }

struct GPlain { const bf16_t* A; const bf16_t* Bt; int K, lda, ldb;
    __device__ __forceinline__ const char* a_ptr(const Unit& u) const { return (const char*)(A + (size_t)u.pm * 256 * lda); }
    __device__ __forceinline__ const char* b_ptr(const Unit& u) const { return (const char*)(Bt + (size_t)u.pn * 256 * ldb); } };
struct GGate { const bf16_t* A; const bf16_t* Bt; int K, lda, ldb;
    __device__ __forceinline__ const char* a_ptr(const Unit& u) const { return (const char*)(A + (size_t)u.pm * 256 * lda + ((u.pn >> 1) & 7) * 256); }
    __device__ __forceinline__ const char* b_ptr(const Unit& u) const { return (const char*)(Bt + (size_t)u.pn * 256 * ldb); } };
struct GScore { const bf16_t* A; const bf16_t* Bt; int K, lda, ldb;
    __device__ __forceinline__ const char* a_ptr(const Unit& u) const { return (const char*)(A + (size_t)u.pm * 256 * lda + u.pn * 256); }
    __device__ __forceinline__ const char* b_ptr(const Unit& u) const { return (const char*)(Bt + (size_t)u.pn * 256 * ldb); } };
struct GFold { const bf16_t* A; const bf16_t* Bt; int K, lda, ldb;
    __device__ __forceinline__ const char* a_ptr(const Unit& u) const { return (const char*)(A + (size_t)u.pm * 256 * lda); }
    __device__ __forceinline__ const char* b_ptr(const Unit& u) const { return (const char*)(Bt + (size_t)(u.pm >> 3) * D * D + (size_t)u.pn * 256 * ldb + (u.pm & 7) * 256); } };
struct GRw1 { const bf16_t* A; const bf16_t* Bt; int K, lda, ldb;
    __device__ __forceinline__ const char* a_ptr(const Unit& u) const { const int blk = u.pn < 24 ? (u.pn >> 3) : (u.pn - 21); return (const char*)(A + (size_t)u.pm * 256 * lda + blk * 2048); }
    __device__ __forceinline__ const char* b_ptr(const Unit& u) const { return (const char*)(Bt + (size_t)u.pn * 256 * ldb); } };
struct GRw2 { const bf16_t* A; const bf16_t* Bt; int K, lda, ldb;
    __device__ __forceinline__ const char* a_ptr(const Unit& u) const { const int blk = u.pn < 16 ? 0 : (u.pn < 32 ? 1 : 2); return (const char*)(A + (size_t)u.pm * 256 * lda + blk * 256); }
    __device__ __forceinline__ const char* b_ptr(const Unit& u) const { return (const char*)(Bt + (size_t)u.pn * 256 * ldb); } };

template <int ACT> __device__ __forceinline__ float actf(float x) {
    if (ACT == 1) return gelu_tanh(x); if (ACT == 2) return tanhf_(x); if (ACT == 3) return sigmoidf_(x); if (ACT == 4) return siluf_(x); return x; }
template <int ACT> __device__ __forceinline__ void store_tile_bf16(AccRef acc, bf16_t* dst, int ld, int row0, int col0) {
#pragma unroll
    for (int ai = 0; ai < 2; ++ai)
#pragma unroll
        for (int m = 0; m < 4; ++m) { bf16_t* rowp = dst + (size_t)(row0 + ai * 128 + m * 16) * ld + col0;
#pragma unroll
            for (int bj = 0; bj < 2; ++bj) { const f32x4 v0 = acc[ai][bj][m][0], v1 = acc[ai][bj][m][1];
                u32x4 w; w.x = cvt_pk_bf16(actf<ACT>(v0[0]), actf<ACT>(v0[1])); w.y = cvt_pk_bf16(actf<ACT>(v0[2]), actf<ACT>(v0[3]));
                w.z = cvt_pk_bf16(actf<ACT>(v1[0]), actf<ACT>(v1[1])); w.w = cvt_pk_bf16(actf<ACT>(v1[2]), actf<ACT>(v1[3]));
                *(u32x4*)(rowp + bj * 128) = w; } }
}
struct EpiBf16Plain { static constexpr bool PERM = true; bf16_t* O; int ldc;
    __device__ __forceinline__ void operator()(AccRef acc, const Unit& u, int wr, int wc, int fr, int fq) const {
        store_tile_bf16<0>(acc, O, ldc, u.pm * 256 + wr * 64 + fr, u.pn * 256 + wc * 32 + 8 * fq); } };
struct EpiF32Plain { static constexpr bool PERM = false; float* C; int ldc;
    __device__ __forceinline__ void operator()(AccRef acc, const Unit& u, int wr, int wc, int fr, int fq) const {
        const int row0 = u.pm * 256 + wr * 64 + fr, col0 = u.pn * 256 + wc * 32 + 4 * fq;
#pragma unroll
        for (int ai = 0; ai < 2; ++ai)
#pragma unroll
            for (int m = 0; m < 4; ++m) { float* rowp = C + (size_t)(row0 + ai * 128 + m * 16) * ldc + col0;
#pragma unroll
                for (int bj = 0; bj < 2; ++bj)
#pragma unroll
                    for (int n = 0; n < 2; ++n) *(f32x4*)(rowp + bj * 128 + n * 16) = acc[ai][bj][m][n]; } } };
struct GSplitK { const bf16_t* A; const bf16_t* Bt; int K, lda, ldb;
    __device__ __forceinline__ const char* a_ptr(const Unit& u) const { return (const char*)(A + (size_t)u.pm * 256 * lda + (u.pn >> 3) * 512); }
    __device__ __forceinline__ const char* b_ptr(const Unit& u) const { return (const char*)(Bt + (size_t)(u.pn & 7) * 256 * ldb + (u.pn >> 3) * 512); } };
struct EpiPartial { static constexpr bool PERM = false; float* PX;
    __device__ __forceinline__ void operator()(AccRef acc, const Unit& u, int wr, int wc, int fr, int fq) const {
        const int row0 = u.pm * 256 + wr * 64 + fr, col0 = (u.pn & 7) * 256 + wc * 32 + 4 * fq; float* base = PX + (size_t)(u.pn >> 3) * NCTX * D;
#pragma unroll
        for (int ai = 0; ai < 2; ++ai)
#pragma unroll
            for (int m = 0; m < 4; ++m) { float* rowp = base + (size_t)(row0 + ai * 128 + m * 16) * D + col0;
#pragma unroll
                for (int bj = 0; bj < 2; ++bj)
#pragma unroll
                    for (int n = 0; n < 2; ++n) *(f32x4*)(rowp + bj * 128 + n * 16) = acc[ai][bj][m][n]; } } };
struct EpiResid { static constexpr bool PERM = false; float* X; const float* gate_base; float ymul;
    __device__ __forceinline__ void operator()(AccRef acc, const Unit& u, int wr, int wc, int fr, int fq) const {
        const int row0 = u.pm * 256 + wr * 64 + fr, col0 = u.pn * 256 + wc * 32 + 4 * fq;
        const float* gp = gate_base + (size_t)panel_vec(u.pm) * 6 * D + col0;
        f32x4 gv[2][2];
#pragma unroll
        for (int bj = 0; bj < 2; ++bj)
#pragma unroll
            for (int n = 0; n < 2; ++n) gv[bj][n] = *(const f32x4*)(gp + bj * 128 + n * 16);
#pragma unroll
        for (int ai = 0; ai < 2; ++ai)
#pragma unroll
            for (int m = 0; m < 4; ++m) { float* rowp = X + (size_t)(row0 + ai * 128 + m * 16) * D + col0;
#pragma unroll
                for (int bj = 0; bj < 2; ++bj)
#pragma unroll
                    for (int n = 0; n < 2; ++n) { f32x4* p = (f32x4*)(rowp + bj * 128 + n * 16); const f32x4 x = *p; *p = x * ALPHA + gv[bj][n] * (acc[ai][bj][m][n] * ymul); } } } };
struct EpiRgIn { static constexpr bool PERM = true; bf16_t* UG; bf16_t* UR;
    __device__ __forceinline__ void operator()(AccRef acc, const Unit& u, int wr, int wc, int fr, int fq) const {
        const int row0 = u.pm * 256 + wr * 64 + fr, col0 = (u.pn & 7) * 256 + wc * 32 + 8 * fq;
        if (u.pn < 8) store_tile_bf16<1>(acc, UG, D, row0, col0); else store_tile_bf16<0>(acc, UR, D, row0, col0); } };
struct EpiRgGate { static constexpr bool PERM = true; const bf16_t* XC; bf16_t* LA; bf16_t* BB; const float* gate_b; const float* spt;
    __device__ __forceinline__ void operator()(AccRef acc, const Unit& u, int wr, int wc, int fr, int fq) const {
        const int d = u.pn >> 4, ch0 = ((u.pn >> 1) & 7) * 256 + (u.pn & 1) * 128 + wc * 32 + 8 * fq;
        const int row0 = u.pm * 256 + wr * 64 + fr;
        float br[8], bi[8], sp[8];
#pragma unroll
        for (int j = 0; j < 8; ++j) { br[j] = gate_b[(d * 2 + 0) * D + ch0 + j]; bi[j] = gate_b[(d * 2 + 1) * D + ch0 + j];
            sp[j] = spt[d * D + ch0 + j]; }
#pragma unroll
        for (int ai = 0; ai < 2; ++ai)
#pragma unroll
            for (int m = 0; m < 4; ++m) { const int row = row0 + ai * 128 + m * 16;
                const u32x4 xr = *(const u32x4*)(XC + (size_t)row * D + ch0);
                float xc[8] = {bflo(xr.x), bfhi(xr.x), bflo(xr.y), bfhi(xr.y), bflo(xr.z), bfhi(xr.z), bflo(xr.w), bfhi(xr.w)};
                float la[8], bb[8];
#pragma unroll
                for (int j = 0; j < 8; ++j) { const float ar = acc[ai][0][m][j >> 2][j & 3], ai_ = acc[ai][1][m][j >> 2][j & 3];
                    const float rg = sigmoidf_(ar + br[j]), ig = sigmoidf_(ai_ + bi[j]);
                    const float l = sp[j] * rg; la[j] = l; bb[j] = sqrtf(1.0f - __expf(2.0f * l)) * (ig * xc[j]); }
                u32x4 w; w.x = cvt_pk_bf16(la[0], la[1]); w.y = cvt_pk_bf16(la[2], la[3]); w.z = cvt_pk_bf16(la[4], la[5]); w.w = cvt_pk_bf16(la[6], la[7]);
                *(u32x4*)(LA + ((size_t)row * 2 + d) * D + ch0) = w;
                w.x = cvt_pk_bf16(bb[0], bb[1]); w.y = cvt_pk_bf16(bb[2], bb[3]); w.z = cvt_pk_bf16(bb[4], bb[5]); w.w = cvt_pk_bf16(bb[6], bb[7]);
                *(u32x4*)(BB + ((size_t)row * 2 + d) * D + ch0) = w; } } };
struct EpiRw1 { static constexpr bool PERM = true; bf16_t* RKV; bf16_t* A2;
    __device__ __forceinline__ void operator()(AccRef acc, const Unit& u, int wr, int wc, int fr, int fq) const {
        const int row0 = u.pm * 256 + wr * 64 + fr, cw = wc * 32 + 8 * fq;
        if (u.pn < 24) store_tile_bf16<0>(acc, RKV + (size_t)(u.pn >> 3) * TD, D, row0, (u.pn & 7) * 256 + cw);
        else if (u.pn == 24) store_tile_bf16<2>(acc, A2, 768, row0, cw);
        else if (u.pn == 25) store_tile_bf16<0>(acc, A2, 768, row0, 256 + cw);
        else store_tile_bf16<3>(acc, A2, 768, row0, 512 + cw); } };
struct EpiRw2 { static constexpr bool PERM = true; bf16_t* W; bf16_t* AD; bf16_t* G; const float* dec0; const float* icl0;
    __device__ __forceinline__ void operator()(AccRef acc, const Unit& u, int wr, int wc, int fr, int fq) const {
        const int row0 = u.pm * 256 + wr * 64 + fr, c0 = (u.pn & 7) * 256 + wc * 32 + 8 * fq;
        if (u.pn >= 32) { store_tile_bf16<0>(acc, G, D, row0, c0); return; }
        const int isa = u.pn >= 16, d = (u.pn >> 3) & 1;
        const float* bias = (isa ? icl0 : dec0) + d * D + c0;
        bf16_t* dst = (isa ? AD : W);
        float bv[2][8];
#pragma unroll
        for (int bj = 0; bj < 2; ++bj)
#pragma unroll
            for (int j = 0; j < 8; ++j) bv[bj][j] = bias[bj * 128 + j];
#pragma unroll
        for (int ai = 0; ai < 2; ++ai)
#pragma unroll
            for (int m = 0; m < 4; ++m) { const int row = row0 + ai * 128 + m * 16;
#pragma unroll
                for (int bj = 0; bj < 2; ++bj) { float o[8];
#pragma unroll
                    for (int j = 0; j < 8; ++j) { const float s = sigmoidf_(acc[ai][bj][m][j >> 2][j & 3] + bv[bj][j]); o[j] = isa ? s : __expf(-0.6065306597126334f * s); }
                    u32x4 w; w.x = cvt_pk_bf16(o[0], o[1]); w.y = cvt_pk_bf16(o[2], o[3]); w.z = cvt_pk_bf16(o[4], o[5]); w.w = cvt_pk_bf16(o[6], o[7]);
                    *(u32x4*)(dst + ((size_t)row * 2 + d) * D + c0 + bj * 128) = w; } } } };
struct EpiRetIn { static constexpr bool PERM = true; bf16_t* Q; bf16_t* Kk; bf16_t* V; bf16_t* GF; bf16_t* GB; const float* CS;
    __device__ __forceinline__ void operator()(AccRef acc, const Unit& u, int wr, int wc, int fr, int fq) const {
        const int row0 = u.pm * 256 + wr * 64 + fr, cw = wc * 32 + 8 * fq;
        if (u.pn >= 48) { store_tile_bf16<4>(acc, GB, 4096, row0, (u.pn - 48) * 256 + cw); return; }
        if (u.pn >= 32) { store_tile_bf16<4>(acc, GF, 4096, row0, (u.pn - 32) * 256 + cw); return; }
        if (u.pn >= 16) { store_tile_bf16<0>(acc, V, 4096, row0, (u.pn - 16) * 256 + cw); return; }
        const float sc = u.pn >= 8 ? 0.0625f : 1.0f; bf16_t* dst = u.pn >= 8 ? Kk : Q; const int hc = (u.pn & 7) * 256;
#pragma unroll
        for (int ai = 0; ai < 2; ++ai)
#pragma unroll
            for (int m = 0; m < 4; ++m) { const int row = row0 + ai * 128 + m * 16; const float* cs = CS + ((size_t)row_pos(row) * 128 + cw) * 2;
                float o1[8], o2[8];
#pragma unroll
                for (int j = 0; j < 8; ++j) { const float co = cs[2 * j], si = cs[2 * j + 1]; const float t1 = acc[ai][0][m][j >> 2][j & 3], t2 = acc[ai][1][m][j >> 2][j & 3];
                    o1[j] = (t1 * co - t2 * si) * sc; o2[j] = (t1 * si + t2 * co) * sc; }
                u32x4 w; w.x = cvt_pk_bf16(o1[0], o1[1]); w.y = cvt_pk_bf16(o1[2], o1[3]); w.z = cvt_pk_bf16(o1[4], o1[5]); w.w = cvt_pk_bf16(o1[6], o1[7]);
                *(u32x4*)(dst + (size_t)row * D + hc + cw) = w;
                w.x = cvt_pk_bf16(o2[0], o2[1]); w.y = cvt_pk_bf16(o2[2], o2[3]); w.z = cvt_pk_bf16(o2[4], o2[5]); w.w = cvt_pk_bf16(o2[6], o2[7]);
                *(u32x4*)(dst + (size_t)row * D + hc + 128 + cw) = w; } } };

#define LDS_WAIT() asm volatile("s_waitcnt lgkmcnt(0)" ::: "memory")
struct Ctx { LAS unsigned char* lds; int tid, lane, wave, gw, ngw, gtid, ngt; };

__device__ __forceinline__ void transpose_item(const float* W, int ldw, bf16_t* WT, int ldt, int k0, int n0, int dst_row0, LAS float* scr, int lane) {
#pragma unroll
    for (int i = 0; i < 8; ++i) { const int kk = 8 * i + (lane >> 3), nn = (lane & 7) * 4; const f32x4 wv = *(const f32x4*)(W + (size_t)(k0 + kk) * ldw + n0 + nn);
        LAS float* d = scr + kk * 33 + nn; d[0] = wv[0]; d[1] = wv[1]; d[2] = wv[2]; d[3] = wv[3]; }
    LDS_WAIT(); asm volatile("" ::: "memory");
    const int c = lane & 7;
#pragma unroll
    for (int j = 0; j < 4; ++j) { const int n = (lane >> 3) + 8 * j; const LAS float* s = scr + (8 * c) * 33 + n;
        u32x4 o; o.x = cvt_pk_bf16(s[0 * 33], s[1 * 33]); o.y = cvt_pk_bf16(s[2 * 33], s[3 * 33]); o.z = cvt_pk_bf16(s[4 * 33], s[5 * 33]); o.w = cvt_pk_bf16(s[6 * 33], s[7 * 33]);
        *(u32x4*)(WT + (size_t)(dst_row0 + n) * ldt + k0 + 8 * c) = o; }
    LDS_WAIT(); asm volatile("" ::: "memory");
}
__device__ __forceinline__ void tr_job(const Ctx& c, int& rot, const float* W, int K, int N, int ldw, bf16_t* WT, int ldt, int row_off) {
    LAS float* scr = (LAS float*)(c.lds + c.wave * 16384);
    const int nblk = N / 32, items = (K / 64) * nblk;
    int first = c.gw - (rot % c.ngw); if (first < 0) first += c.ngw;
    int lane = c.lane; asm volatile("" : "+v"(lane));
    f32x4 r[8];
#define TR_LOAD(it_) do { const int kb_ = (it_) / nblk, nb_ = (it_) % nblk; _Pragma("unroll") for (int i = 0; i < 8; ++i) r[i] = *(const f32x4*)(W + (size_t)(kb_ * 64 + 8 * i + (lane >> 3)) * ldw + nb_ * 32 + (lane & 7) * 4); } while (0)
    if (first < items) TR_LOAD(first);
    for (int it = first; it < items; it += c.ngw) { const int kb = it / nblk, nb = it % nblk;
#pragma unroll
        for (int i = 0; i < 8; ++i) { LAS float* d = scr + (8 * i + (lane >> 3)) * 33 + (lane & 7) * 4; d[0] = r[i][0]; d[1] = r[i][1]; d[2] = r[i][2]; d[3] = r[i][3]; }
        if (it + c.ngw < items) TR_LOAD(it + c.ngw);
        LDS_WAIT(); asm volatile("" ::: "memory");
        const int cc = lane & 7;
#pragma unroll
        for (int j = 0; j < 4; ++j) { const int n = (lane >> 3) + 8 * j; const LAS float* sp = scr + (8 * cc) * 33 + n;
            u32x4 o; o.x = cvt_pk_bf16(sp[0 * 33], sp[1 * 33]); o.y = cvt_pk_bf16(sp[2 * 33], sp[3 * 33]); o.z = cvt_pk_bf16(sp[4 * 33], sp[5 * 33]); o.w = cvt_pk_bf16(sp[6 * 33], sp[7 * 33]);
            *(u32x4*)(WT + (size_t)(row_off + nb * 32 + n) * ldt + kb * 64 + 8 * cc) = o; }
        LDS_WAIT(); asm volatile("" ::: "memory"); }
#undef TR_LOAD
    rot += items;
}

__device__ __forceinline__ void peer_convert_rows(KP P, const Ctx& c, int g_lo, int g_hi, int rank, int nranks) {
    unsigned char* ws = P->ws;
    f32x4 xn[2][8];
#define CV_LOAD(g0_) do { _Pragma("unroll") for (int h = 0; h < 2; ++h) { const int g = ((g0_) + h < g_hi) ? (g0_) + h : (g0_); const int lt = g >> 14, e = g & 16383, layer = lt >> 1, t = lt & 1; \
            const float* sp = P->in[t ? I_PV : I_PU] + ((size_t)layer * 16384 + e) * D + c.lane * 16; \
            _Pragma("unroll") for (int q = 0; q < 8; ++q) xn[h][q] = *(const f32x4*)(sp + (q >> 2) * 1024 + (q & 3) * 4); } } while (0)
    { const int gf = g_lo + (rank * 8 + c.wave) * 2; if (gf < g_hi) CV_LOAD(gf); }
    for (int g0 = g_lo + (rank * 8 + c.wave) * 2; g0 < g_hi; g0 += nranks * 16) {
        f32x4 x[2][8]; float am[2] = {0.f, 0.f};
#pragma unroll
        for (int h = 0; h < 2; ++h)
#pragma unroll
            for (int q = 0; q < 8; ++q) x[h][q] = xn[h][q];
        if (g0 + nranks * 16 < g_hi) CV_LOAD(g0 + nranks * 16);
#pragma unroll
        for (int h = 0; h < 2; ++h) { if (g0 + h >= g_hi) break;
            const int g = g0 + h; const int lt = g >> 14, e = g & 16383, layer = lt >> 1, t = lt & 1;
#pragma unroll
            for (int q = 0; q < 8; ++q) am[h] = fmaxf(am[h], fmaxf(fmaxf(fabsf(x[h][q][0]), fabsf(x[h][q][1])), fmaxf(fabsf(x[h][q][2]), fabsf(x[h][q][3]))));
            const float a = wave_max(am[h]);
            const float sc = a > 0.f ? exp2f(floorf(log2f(384.0f / a))) : 1.0f;
            if (c.lane == 0) ((float*)(ws + WS_PSC))[(size_t)t * 4 * 16384 + layer * 16384 + e] = 1.0f / sc;
            unsigned char* dst = ws + (t ? WS_PV : WS_PU) + (size_t)layer * 16384 * D;
#pragma unroll
            for (int jj = 0; jj < 2; ++jj) { u32x4 o;
#pragma unroll
                for (int w = 0; w < 4; ++w) { const f32x4 v = x[h][jj * 4 + w] * sc; int p = 0; p = __builtin_amdgcn_cvt_pk_fp8_f32(v[0], v[1], p, false); p = __builtin_amdgcn_cvt_pk_fp8_f32(v[2], v[3], p, true); o[w] = (unsigned)p; }
                const int db = (c.lane >> 3) + 8 * jj;
                *(u32x4*)(dst + ((size_t)db * 16384 + e) * 128 + (c.lane & 7) * 16) = o; } } }
#undef CV_LOAD
}
__device__ __forceinline__ void phase_prologue(KP P, const Ctx& c) {
    unsigned char* ws = P->ws;
    PROBE_REP(14) {
        LAS float* sl = (LAS float*)c.lds;
        LAS float* red = sl + 1280;
        for (int un = blockIdx.x; un < 4 * 24 * 8; un += gridDim.x) {
            const int layer = un / 192, r = un % 192, nb = r / 8, kc = r % 8;
            __syncthreads();
            for (int i = c.tid; i < 5 * 256; i += 512) { const int v = i >> 8, k = kc * 256 + (i & 255); const float x = v < 4 ? P->in[I_C][v * D + k] : P->in[I_CCTX][k]; sl[i] = siluf_(x); }
            __syncthreads();
            const int cg = c.tid & 127, ks = c.tid >> 7;
            const float* w = P->in[I_ADAW] + ((size_t)layer * D + kc * 256 + ks * 64) * 12288 + nb * 512 + cg * 4;
            f32x4 a0 = (f32x4){0.f, 0.f, 0.f, 0.f}, a1 = a0, a2 = a0, a3 = a0, a4 = a0;
            f32x4 wn[8];
#pragma unroll
            for (int i = 0; i < 8; ++i) wn[i] = *(const f32x4*)(w + (size_t)i * 12288);
#pragma unroll 1
            for (int k0 = 0; k0 < 64; k0 += 8) { f32x4 wc[8];
#pragma unroll
                for (int i = 0; i < 8; ++i) wc[i] = wn[i];
                if (k0 + 8 < 64) {
#pragma unroll
                    for (int i = 0; i < 8; ++i) wn[i] = *(const f32x4*)(w + (size_t)(k0 + 8 + i) * 12288); }
#pragma unroll
                for (int i = 0; i < 8; ++i) { const f32x4 wv = wc[i]; const int kk = ks * 64 + k0 + i;
                    a0 += wv * sl[kk]; a1 += wv * sl[256 + kk]; a2 += wv * sl[512 + kk]; a3 += wv * sl[768 + kk]; a4 += wv * sl[1024 + kk]; } }
            LAS float* rp = red + (ks * 5) * 512 + cg * 4;
            *(LAS f32x4*)(rp) = a0; *(LAS f32x4*)(rp + 512) = a1; *(LAS f32x4*)(rp + 1024) = a2; *(LAS f32x4*)(rp + 1536) = a3; *(LAS f32x4*)(rp + 2048) = a4;
            __syncthreads();
            for (int i = c.tid; i < 5 * 512; i += 512) { const int v = i >> 9, n = i & 511;
                const float sum = (red[(0 * 5 + v) * 512 + n] + red[(1 * 5 + v) * 512 + n]) + (red[(2 * 5 + v) * 512 + n] + red[(3 * 5 + v) * 512 + n]);
                ((float*)(ws + WS_MODP))[((size_t)(layer * 8 + kc) * 5 + v) * 12288 + nb * 512 + n] = sum; }
        }
        __syncthreads();
    }
    PROBE_REP(16) {
    int rot = 0;
    for (int j = 0; j < 2; ++j) {
        tr_job(c, rot, P->in[I_RGWIN] + (size_t)j * D * 4096, D, 4096, 4096, (bf16_t*)(ws + WS_RGIN) + (size_t)j * 4096 * D, D, 0);
        tr_job(c, rot, P->in[I_RGWOUT] + (size_t)j * D * D, D, D, D, (bf16_t*)(ws + WS_RGOUT) + (size_t)j * D * D, D, 0);
    }
    {
        LAS float* scr = (LAS float*)(c.lds + c.wave * 16384);
        const int items = 64 * 32;
        int first = c.gw - (rot % c.ngw); if (first < 0) first += c.ngw;
        for (int it = first; it < items; it += c.ngw) {
            const int mat = it >> 5, sub = it & 31, kb = sub >> 3, nb32 = sub & 7;
            const int jl = mat >> 5, d = (mat >> 4) & 1, g = (mat >> 3) & 1, nblk = mat & 7;
            const int n0 = nb32 * 32, hf = n0 >> 7, pn = (d * 8 + nblk) * 2 + hf;
            transpose_item(P->in[I_RGGW] + (size_t)mat * 65536, 256, (bf16_t*)(ws + WS_RGGATE) + (size_t)jl * 8192 * 256, 256, kb * 64, n0, pn * 256 + g * 128 + (n0 & 127), scr, c.lane);
        }
        rot += items;
    }
    for (int m = 0; m < 3; ++m) tr_job(c, rot, P->in[I_RWRKV] + (size_t)m * D * D, D, D, D, (bf16_t*)(ws + WS_RW1), D, m * D);
    for (int d = 0; d < 2; ++d) {
        tr_job(c, rot, P->in[I_RWDEC1] + (size_t)d * D * 96, D, 96, 96, (bf16_t*)(ws + WS_RW1), D, 6144 + d * 96);
        tr_job(c, rot, P->in[I_RWICL1] + (size_t)d * D * 96, D, 96, 96, (bf16_t*)(ws + WS_RW1), D, 6400 + d * 96);
    }
    tr_job(c, rot, P->in[I_RWG1], D, 256, 256, (bf16_t*)(ws + WS_RW1), D, 6656);
    tr_job(c, rot, P->in[I_RWWO], D, D, D, (bf16_t*)(ws + WS_RWO), D, 0);
    tr_job(c, rot, P->in[I_RETWIN], D, 16384, 16384, (bf16_t*)(ws + WS_RETIN), D, 0);
    tr_job(c, rot, P->in[I_RETWOUT], 4096, D, D, (bf16_t*)(ws + WS_RETOUT), 4096, 0);
    }
    PROBE_REP(17) {
    for (size_t i0 = c.gtid; i0 < (size_t)4 * D * D / 8; i0 += 4 * (size_t)c.ngt) { f32x4 a[4], b[4];
#pragma unroll
        for (int u = 0; u < 4; ++u) { const size_t i = i0 + (size_t)u * c.ngt; if (i < (size_t)4 * D * D / 8) { a[u] = *(const f32x4*)(P->in[I_PWQ] + i * 8); b[u] = *(const f32x4*)(P->in[I_PWQ] + i * 8 + 4); } }
#pragma unroll
        for (int u = 0; u < 4; ++u) { const size_t i = i0 + (size_t)u * c.ngt; if (i < (size_t)4 * D * D / 8)
            *(u32x4*)((bf16_t*)(ws + WS_WQN) + i * 8) = (u32x4){cvt_pk_bf16(a[u][0], a[u][1]), cvt_pk_bf16(a[u][2], a[u][3]), cvt_pk_bf16(b[u][0], b[u][1]), cvt_pk_bf16(b[u][2], b[u][3])}; } }
    for (int i = c.gtid; i < 2 * 64 * (D / 8); i += c.ngt) { const int blk = i / (64 * (D / 8)), r = (i / (D / 8)) % 64, c8 = i % (D / 8);
        *(u32x4*)((bf16_t*)(ws + WS_RW1) + (size_t)(6144 + blk * 256 + 192 + r) * D + c8 * 8) = (u32x4){0u, 0u, 0u, 0u}; }
    for (int i = c.gtid; i < 4 * 2048 * 32; i += c.ngt) { const int c8 = i & 31, row = (i >> 5) & 2047, l = i >> 16; const int p = (row >> 7) & 1, col = c8 * 8;
        u32x4 o = (u32x4){0u, 0u, 0u, 0u};
        if ((col >> 7) == p) { const float* s = P->in[I_PKEYS] + ((size_t)l * 2048 + row) * 128 + (col & 127); const f32x4 a = *(const f32x4*)s, b = *(const f32x4*)(s + 4);
            o.x = cvt_pk_bf16(a[0], a[1]); o.y = cvt_pk_bf16(a[2], a[3]); o.z = cvt_pk_bf16(b[0], b[1]); o.w = cvt_pk_bf16(b[2], b[3]); }
        *(u32x4*)((bf16_t*)(ws + WS_KEYS) + ((size_t)l * 2048 + row) * 256 + col) = o; }
    for (int i0 = c.gtid; i0 < 10240 * 256; i0 += 4 * c.ngt) { float v4[4];
#pragma unroll
        for (int u = 0; u < 4; ++u) { const int i = i0 + u * c.ngt; float v = 0.f;
            if (i < 10240 * 256) { const int kc = i & 255, r = i >> 8;
                if (r < 4096) { const int d = r >> 11, cc = r & 2047, k = kc - 96 * d; if (k >= 0 && k < 96) v = P->in[I_RWDEC2][((size_t)d * 96 + k) * D + cc]; }
                else if (r < 8192) { const int rr = r - 4096, d = rr >> 11, cc = rr & 2047, k = kc - 96 * d; if (k >= 0 && k < 96) v = P->in[I_RWICL2][((size_t)d * 96 + k) * D + cc]; }
                else v = P->in[I_RWG2][(size_t)kc * D + (r - 8192)]; }
            v4[u] = v; }
#pragma unroll
        for (int u = 0; u < 4; ++u) { const int i = i0 + u * c.ngt; if (i < 10240 * 256) ((bf16_t*)(ws + WS_RW2))[i] = (bf16_t)(cvt_pk_bf16(v4[u], 0.f) & 0xffffu); } }
    }
    PROBE_REP(18)
    for (int i = c.gtid; i < 2 * 2 * D; i += c.ngt) ((float*)(ws + WS_SPT))[i] = -8.0f * log1pf(expf(-P->in[I_RGLAM][i]));
    PROBE_REP(18)
    for (int i = c.gtid; i < SLEN * 128; i += c.ngt) { const int pos = i >> 7, k = i & 127; const float theta = 1.0f / powf(10000.0f, (float)k / 127.0f); const float ang = (float)pos * theta;
        ((f32x2*)(ws + WS_CS))[i] = (f32x2){cosf(ang), sinf(ang)}; }
}
__device__ __forceinline__ void phase_modfin(KP P, const Ctx& c) {
    for (int i = c.gtid; i < 4 * 5 * 12288; i += c.ngt) { const int n = i % 12288, lv = i / 12288, l = lv / 5, v = lv % 5;
        float s = P->in[I_ADAB][l * 12288 + n];
        for (int kc = 0; kc < 8; ++kc) s += ((const float*)(P->ws + WS_MODP))[((size_t)(l * 8 + kc) * 5 + v) * 12288 + n];
        ((float*)(P->ws + WS_MOD))[i] = s; }
}
__device__ __forceinline__ void phase_xinit(KP P, const Ctx& c) {
    float* X = (float*)(P->ws + WS_X); bf16_t* A0 = (bf16_t*)(P->ws + WS_A0);
    for (size_t i0 = c.gtid; i0 < TD / 4; i0 += 4 * (size_t)c.ngt) {
        f32x4 x[4], sh[4], sc[4];
#pragma unroll
        for (int u = 0; u < 4; ++u) { const size_t i = i0 + (size_t)u * c.ngt; if (i < TD / 4) { const int row = (int)(i >> 9), c4 = (int)(i & 511) * 4;
            const float* src = row < NCTX ? P->in[I_CTX] + (size_t)row * D : P->in[I_X] + (size_t)(row - NCTX) * D; const int v = row_vec(row);
            x[u] = *(const f32x4*)(src + c4); sh[u] = *(const f32x4*)(modp(P, 0, v, 0) + c4); sc[u] = *(const f32x4*)(modp(P, 0, v, 1) + c4); } }
#pragma unroll
        for (int u = 0; u < 4; ++u) { const size_t i = i0 + (size_t)u * c.ngt; if (i < TD / 4) { const int row = (int)(i >> 9), c4 = (int)(i & 511) * 4;
            *(f32x4*)(X + (size_t)row * D + c4) = x[u];
            const f32x4 h = x[u] * (sc[u] + 1.0f) + sh[u];
            *(u32x2*)(A0 + (size_t)row * D + c4) = (u32x2){cvt_pk_bf16(h[0], h[1]), cvt_pk_bf16(h[2], h[3])}; } } }
}

__device__ __forceinline__ void phase_rg_conv(KP P, const Ctx& c, int jl) {
    const bf16_t* UR = (const bf16_t*)(P->ws + L_UR); bf16_t* XC = (bf16_t*)(P->ws + L_XC);
    const float* cw = P->in[I_RGCW] + (size_t)jl * 4 * D; const float* cb = P->in[I_RGCB] + (size_t)jl * D;
    const int c8 = (int)(c.gtid & 255) * 8;
    float w8[4][8], b8[8];
#pragma unroll
    for (int j = 0; j < 8; ++j) { b8[j] = cb[c8 + j];
#pragma unroll
        for (int tp = 0; tp < 4; ++tp) w8[tp][j] = cw[tp * D + c8 + j]; }
    for (size_t i0 = c.gtid; i0 < TD / 8; i0 += 2 * (size_t)c.ngt) {
        u32x4 u[2][4];
#pragma unroll
        for (int q = 0; q < 2; ++q) { const size_t i = i0 + (size_t)q * c.ngt; const int row = (int)(i >> 8);
            int lo, hi; if (row < NCTX) { lo = row & ~(CTX - 1); hi = lo + CTX; } else { lo = NCTX + ((row - NCTX) & ~(SEQ - 1)); hi = lo + SEQ; }
#pragma unroll
            for (int tp = 0; tp < 4; ++tp) { const int rr = row + tp - 2; u[q][tp] = (u32x4){0u, 0u, 0u, 0u};
                if (i < TD / 8 && rr >= lo && rr < hi) u[q][tp] = *(const u32x4*)(UR + (size_t)rr * D + c8); } }
#pragma unroll
        for (int q = 0; q < 2; ++q) { const size_t i = i0 + (size_t)q * c.ngt; if (i >= TD / 8) break; const int row = (int)(i >> 8);
            float a[8];
#pragma unroll
            for (int j = 0; j < 8; ++j) a[j] = b8[j];
#pragma unroll
            for (int tp = 0; tp < 4; ++tp) { const u32x4 uu = u[q][tp]; const unsigned u0 = uu.x, u1 = uu.y, u2 = uu.z, u3 = uu.w;
                a[0] += w8[tp][0] * bflo(u0); a[1] += w8[tp][1] * bfhi(u0); a[2] += w8[tp][2] * bflo(u1); a[3] += w8[tp][3] * bfhi(u1);
                a[4] += w8[tp][4] * bflo(u2); a[5] += w8[tp][5] * bfhi(u2); a[6] += w8[tp][6] * bflo(u3); a[7] += w8[tp][7] * bfhi(u3); }
            *(u32x4*)(XC + (size_t)row * D + c8) = (u32x4){cvt_pk_bf16(a[0], a[1]), cvt_pk_bf16(a[2], a[3]), cvt_pk_bf16(a[4], a[5]), cvt_pk_bf16(a[6], a[7])}; } }
}
__device__ __forceinline__ void phase_rg_scan1(KP P, const Ctx& c) {
    const bf16_t* LA = (const bf16_t*)(P->ws + L_LA); const bf16_t* BB = (const bf16_t*)(P->ws + L_BB);
    float* CA = (float*)(P->ws + WS_CA); float* CH = (float*)(P->ws + WS_CH);
    for (int u = c.gw; u < 2048; u += c.ngw) { const int b = u >> 9, dir = (u >> 8) & 1, ck = (u >> 2) & 63, ch = (u & 3) * 512 + c.lane * 8;
        float h[8], sl[8];
#pragma unroll
        for (int e = 0; e < 8; ++e) { h[e] = 0.f; sl[e] = 0.f; }
#pragma unroll 4
        for (int s_ = 0; s_ < 68; ++s_) { const int row = seq_row(b, dir, ck * 68 + s_); const size_t o = ((size_t)row * 2 + dir) * D + ch;
            float l8[8], b8[8]; unpack8(*(const u32x4*)(LA + o), l8); unpack8(*(const u32x4*)(BB + o), b8);
#pragma unroll
            for (int e = 0; e < 8; ++e) { h[e] = __expf(l8[e]) * h[e] + b8[e]; sl[e] += l8[e]; } }
        const size_t o = ((size_t)(b * 2 + dir) * 64 + ck) * D + ch;
        *(f32x4*)(CA + o) = (f32x4){sl[0], sl[1], sl[2], sl[3]}; *(f32x4*)(CA + o + 4) = (f32x4){sl[4], sl[5], sl[6], sl[7]};
        *(f32x4*)(CH + o) = (f32x4){h[0], h[1], h[2], h[3]}; *(f32x4*)(CH + o + 4) = (f32x4){h[4], h[5], h[6], h[7]}; }
}
__device__ __forceinline__ void phase_rg_scan2(KP P, const Ctx& c) {
    const float* CA = (const float*)(P->ws + WS_CA); const float* CH = (const float*)(P->ws + WS_CH); float* CIN = (float*)(P->ws + WS_CIN);
    for (int i = c.gtid; i < 4 * 2 * D; i += c.ngt) { const int ch = i & (D - 1), bd = i >> 11; float carry = 0.f;
#pragma unroll 1
        for (int c0 = 0; c0 < 64; c0 += 16) { float a[16], hh[16];
#pragma unroll
            for (int q = 0; q < 16; ++q) { const size_t o = ((size_t)bd * 64 + c0 + q) * D + ch; a[q] = CA[o]; hh[q] = CH[o]; }
#pragma unroll
            for (int q = 0; q < 16; ++q) { const size_t o = ((size_t)bd * 64 + c0 + q) * D + ch; CIN[o] = carry; carry = __expf(a[q]) * carry + hh[q]; } } }
}
template <int DIR> __device__ __forceinline__ void phase_rg_scan3(KP P, const Ctx& c) {
    const bf16_t* LA = (const bf16_t*)(P->ws + L_LA); const bf16_t* BB = (const bf16_t*)(P->ws + L_BB); const bf16_t* UG = (const bf16_t*)(P->ws + L_UG);
    const float* CIN = (const float*)(P->ws + WS_CIN); bf16_t* YIN = (bf16_t*)(P->ws + L_YIN); bf16_t* HF = (bf16_t*)(P->ws + L_XC);
    for (int u = c.gw; u < 2048; u += c.ngw) { const int b = u >> 9, ck = (u >> 3) & 63, ch = (u & 7) * 256 + c.lane * 4;
        const f32x4 h0 = *(const f32x4*)(CIN + ((size_t)(b * 2 + DIR) * 64 + ck) * D + ch); float h[4] = {h0[0], h0[1], h0[2], h0[3]};
        u32x2 nl[4], nb[4], nf[4], ng[4];
#define SC3_LOAD(s0_) do { _Pragma("unroll") for (int i_ = 0; i_ < 4; ++i_) { const int row_ = seq_row(b, DIR, ck * 68 + (s0_) + i_); const size_t o_ = ((size_t)row_ * 2 + DIR) * D + ch, q_ = (size_t)row_ * D + ch; \
            nl[i_] = *(const u32x2*)(LA + o_); nb[i_] = *(const u32x2*)(BB + o_); if (DIR == 1) { nf[i_] = *(const u32x2*)(HF + q_); ng[i_] = *(const u32x2*)(UG + q_); } } } while (0)
        SC3_LOAD(0);
#pragma unroll 1
        for (int s0 = 0; s0 < 68; s0 += 4) { u32x2 cl[4], cb[4], cf[4], cg[4];
#pragma unroll
            for (int i = 0; i < 4; ++i) { cl[i] = nl[i]; cb[i] = nb[i]; if (DIR == 1) { cf[i] = nf[i]; cg[i] = ng[i]; } }
            if (s0 + 4 < 68) SC3_LOAD(s0 + 4);
#pragma unroll
            for (int i = 0; i < 4; ++i) { const int row = seq_row(b, DIR, ck * 68 + s0 + i); const size_t q = (size_t)row * D + ch;
                const unsigned l0 = cl[i].x, l1 = cl[i].y, b0 = cb[i].x, b1 = cb[i].y;
                h[0] = __expf(bflo(l0)) * h[0] + bflo(b0); h[1] = __expf(bfhi(l0)) * h[1] + bfhi(b0); h[2] = __expf(bflo(l1)) * h[2] + bflo(b1); h[3] = __expf(bfhi(l1)) * h[3] + bfhi(b1);
                if (DIR == 0) { *(u32x2*)(HF + q) = (u32x2){cvt_pk_bf16(h[0], h[1]), cvt_pk_bf16(h[2], h[3])}; }
                else { const unsigned f0 = cf[i].x, f1 = cf[i].y, g0 = cg[i].x, g1 = cg[i].y;
                    *(u32x2*)(YIN + q) = (u32x2){cvt_pk_bf16(bflo(g0) * (bflo(f0) + h[0]), bfhi(g0) * (bfhi(f0) + h[1])), cvt_pk_bf16(bflo(g1) * (bflo(f1) + h[2]), bfhi(g1) * (bfhi(f1) + h[3]))}; } } }
#undef SC3_LOAD
    }
}

__device__ __forceinline__ void phase_ln_mid(KP P, const Ctx& c, int layer, int row_lo) {
    float* X = (float*)(P->ws + WS_X); bf16_t* H2 = (bf16_t*)(P->ws + WS_H2);
    const float* lg = P->in[I_LNG] + (size_t)(layer * 2 + 0) * D; const float* lb = P->in[I_LNB] + (size_t)(layer * 2 + 0) * D;
    f32x4 xn[8];
    const float* PB = (const float*)(P->ws + WS_S);
    f32x4 pn[8];
    { const int r0 = row_lo + c.gw; if (r0 < T) {
#pragma unroll
        for (int j = 0; j < 8; ++j) { xn[j] = *(const f32x4*)(X + (size_t)r0 * D + c.lane * 4 + 256 * j); pn[j] = *(const f32x4*)(PB + (size_t)r0 * D + c.lane * 4 + 256 * j); } } }
    for (int row = row_lo + c.gw; row < T; row += c.ngw) { float* xr = X + (size_t)row * D + c.lane * 4; const int v = row_vec(row);
        f32x4 x[8]; float s = 0.f;
        { const float* gp = modp(P, layer, v, 2) + c.lane * 4;
#pragma unroll
          for (int j = 0; j < 8; ++j) x[j] = xn[j] * ALPHA + *(const f32x4*)(gp + 256 * j) * pn[j]; }
        if (row + c.ngw < T) {
#pragma unroll
            for (int j = 0; j < 8; ++j) { xn[j] = *(const f32x4*)(X + (size_t)(row + c.ngw) * D + c.lane * 4 + 256 * j); pn[j] = *(const f32x4*)(PB + (size_t)(row + c.ngw) * D + c.lane * 4 + 256 * j); } }
#pragma unroll
        for (int j = 0; j < 8; ++j) s += (x[j][0] + x[j][1]) + (x[j][2] + x[j][3]);
        const float mean = wave_sum(s) * (1.0f / D); float q = 0.f;
#pragma unroll
        for (int j = 0; j < 8; ++j) { x[j] = x[j] - mean; q += (x[j][0] * x[j][0] + x[j][1] * x[j][1]) + (x[j][2] * x[j][2] + x[j][3] * x[j][3]); }
        const float rstd = rsqrtf(wave_sum(q) * (1.0f / D) + LN_EPS);
        const float* m3 = modp(P, layer, v, 3) + c.lane * 4; const float* m4 = modp(P, layer, v, 4) + c.lane * 4;
#pragma unroll
        for (int jh = 0; jh < 2; ++jh) { f32x4 g4[4], b4[4], p4[4], q4[4];
#pragma unroll
            for (int jj = 0; jj < 4; ++jj) { const int j = 4 * jh + jj; g4[jj] = *(const f32x4*)(lg + c.lane * 4 + 256 * j); b4[jj] = *(const f32x4*)(lb + c.lane * 4 + 256 * j);
                p4[jj] = *(const f32x4*)(m4 + 256 * j); q4[jj] = *(const f32x4*)(m3 + 256 * j); }
#pragma unroll
            for (int jj = 0; jj < 4; ++jj) { const int j = 4 * jh + jj;
                const f32x4 y = x[j] * rstd * g4[jj] + b4[jj]; *(f32x4*)(xr + 256 * j) = y;
                const f32x4 h = y * (p4[jj] + 1.0f) + q4[jj];
                *(u32x2*)(H2 + (size_t)row * D + c.lane * 4 + 256 * j) = (u32x2){cvt_pk_bf16(h[0], h[1]), cvt_pk_bf16(h[2], h[3])}; } } }
}

__device__ __forceinline__ float dot2bf(unsigned a, unsigned b, float s) { return __builtin_amdgcn_fdot2_f32_bf16(__builtin_bit_cast(bf16v2, a), __builtin_bit_cast(bf16v2, b), s, false); }
__device__ __forceinline__ float dot8(const u32x4 a, const u32x4 b, float s) {
    const unsigned a0 = a.x, a1 = a.y, a2 = a.z, a3 = a.w, b0 = b.x, b1 = b.y, b2 = b.z, b3 = b.w;
    s = dot2bf(a0, b0, s); s = dot2bf(a1, b1, s); s = dot2bf(a2, b2, s); s = dot2bf(a3, b3, s);
    return s;
}
template <int CTRL> __device__ __forceinline__ int dpp_movi(int x) { return __builtin_amdgcn_update_dpp(x, x, CTRL, 0xF, 0xF, false); }
__device__ __forceinline__ int row_max_i(int m) { m = max(m, dpp_movi<0xB1>(m)); m = max(m, dpp_movi<0x4E>(m)); m = max(m, dpp_movi<0x141>(m)); m = max(m, dpp_movi<0x140>(m)); return m; }
template <int PAT> __device__ __forceinline__ int swz(int v) { return __builtin_amdgcn_ds_swizzle(v, PAT); }
__device__ __forceinline__ int f2key(float f) { const int b = __float_as_int(f); return b ^ ((b >> 31) & 0x7fffffff); }
__device__ __forceinline__ float key2f(int k) { return __int_as_float(k ^ ((k >> 31) & 0x7fffffff)); }
__device__ __forceinline__ void row_max_i_pair(int& a, int& b) {
    asm volatile("s_nop 1\n\t"
        "v_max_i32_dpp %0, %0, %0 quad_perm:[1,0,3,2] row_mask:0xf bank_mask:0xf\n\tv_max_i32_dpp %1, %1, %1 quad_perm:[1,0,3,2] row_mask:0xf bank_mask:0xf\n\ts_nop 0\n\t"
        "v_max_i32_dpp %0, %0, %0 quad_perm:[2,3,0,1] row_mask:0xf bank_mask:0xf\n\tv_max_i32_dpp %1, %1, %1 quad_perm:[2,3,0,1] row_mask:0xf bank_mask:0xf\n\ts_nop 0\n\t"
        "v_max_i32_dpp %0, %0, %0 row_half_mirror row_mask:0xf bank_mask:0xf\n\tv_max_i32_dpp %1, %1, %1 row_half_mirror row_mask:0xf bank_mask:0xf\n\ts_nop 0\n\t"
        "v_max_i32_dpp %0, %0, %0 row_mirror row_mask:0xf bank_mask:0xf\n\tv_max_i32_dpp %1, %1, %1 row_mirror row_mask:0xf bank_mask:0xf"
        : "+v"(a), "+v"(b));
}
__device__ __forceinline__ void phase_peer_select(KP P, const Ctx& c, int row_lo) {
    const float* S = (const float*)(P->ws + WS_S); float* SW = (float*)(P->ws + WS_SELW);
    constexpr int KMIN = (int)0x80000000;
    const int nps = (2 * (T - row_lo) - c.gw + c.ngw - 1) / c.ngw;
    f32x4 sn[2][2];
#define SEL_LOAD(k) do { const int pid_ = 2 * row_lo + c.gw + (k) * c.ngw; const float* sp_ = S + (size_t)(pid_ >> 1) * D + (2 * (pid_ & 1)) * 512 + lane * 8; \
        sn[0][0] = *(const f32x4*)sp_; sn[0][1] = *(const f32x4*)(sp_ + 4); sn[1][0] = *(const f32x4*)(sp_ + 512); sn[1][1] = *(const f32x4*)(sp_ + 516); } while (0)
    { int lane = c.lane; asm volatile("" : "+v"(lane)); if (nps > 0) SEL_LOAD(0); }
    {
#pragma unroll 1
        for (int kk = 0; kk < nps; ++kk) {
            const int pid = 2 * row_lo + c.gw + kk * c.ngw, row = pid >> 1, pp = pid & 1;
            int lane = c.lane; asm volatile("" : "+v"(lane));
            const int l16 = lane & 15, isS2 = (lane >> 4) & 1;
            int k8[2][8];
#pragma unroll
            for (int q = 0; q < 2; ++q) {
#pragma unroll
                for (int e = 0; e < 8; ++e) { const float v = sn[q][e >> 2][e & 3]; k8[q][e] = (f2key(v) & ~127) | (127 - (l16 * 8 + e)); } }
            if (kk + 1 < nps) SEL_LOAD(kk + 1);
#define SEL_CE(a, b) do { const int hi_ = max(a, b), lo_ = min(a, b); a = hi_; b = lo_; } while (0)
#pragma unroll
            for (int q = 0; q < 2; ++q) { int (&k)[8] = k8[q];
                SEL_CE(k[0], k[1]); SEL_CE(k[2], k[3]); SEL_CE(k[4], k[5]); SEL_CE(k[6], k[7]); SEL_CE(k[0], k[2]); SEL_CE(k[1], k[3]); SEL_CE(k[4], k[6]); SEL_CE(k[5], k[7]);
                SEL_CE(k[1], k[2]); SEL_CE(k[5], k[6]); SEL_CE(k[0], k[4]); SEL_CE(k[3], k[7]); SEL_CE(k[1], k[5]); SEL_CE(k[2], k[6]); SEL_CE(k[1], k[4]); SEL_CE(k[3], k[6]);
                SEL_CE(k[2], k[4]); SEL_CE(k[3], k[5]); SEL_CE(k[3], k[4]); }
            int own[2] = {KMIN, KMIN};
#pragma unroll
            for (int it = 0; it < 16; ++it) {
                int m0 = k8[0][0], m1 = k8[1][0];
                row_max_i_pair(m0, m1);
                const bool p0 = k8[0][0] == m0, p1 = k8[1][0] == m1;
#pragma unroll
                for (int e = 0; e < 7; ++e) { k8[0][e] = p0 ? k8[0][e + 1] : k8[0][e]; k8[1][e] = p1 ? k8[1][e + 1] : k8[1][e]; }
                k8[0][7] = p0 ? KMIN : k8[0][7]; k8[1][7] = p1 ? KMIN : k8[1][7];
                own[0] = (l16 == it) ? m0 : own[0]; own[1] = (l16 == it) ? m1 : own[1]; }
            int ck[2][4], ownIdx[2];
#pragma unroll
            for (int q = 0; q < 2; ++q) { ownIdx[q] = 127 - (own[q] & 127); const float ownVal = key2f(own[q]);
                int pk[4]; pk[0] = swz<(0x10 << 10) | (0 << 5) | 0x10>(own[q]); pk[1] = swz<(0x10 << 10) | (1 << 5) | 0x10>(own[q]); pk[2] = swz<(0x10 << 10) | (2 << 5) | 0x10>(own[q]); pk[3] = swz<(0x10 << 10) | (3 << 5) | 0x10>(own[q]);
#pragma unroll
                for (int m = 0; m < 4; ++m) { const float pv = key2f(pk[m]);
                    const int ci = isS2 ? m : l16, cj = isS2 ? l16 : m;
                    const bool valid = (isS2 ? (m <= l16) : (m < l16)) && ((ci + 1) * (cj + 1) <= 16);
                    ck[q][m] = valid ? ((f2key(ownVal + pv) & ~255) | (255 - (ci * 16 + cj))) : KMIN; } }
#pragma unroll
            for (int q = 0; q < 2; ++q) { int (&k)[4] = ck[q]; SEL_CE(k[0], k[1]); SEL_CE(k[2], k[3]); SEL_CE(k[0], k[2]); SEL_CE(k[1], k[3]); SEL_CE(k[1], k[2]); }
#undef SEL_CE
            int win[2] = {KMIN, KMIN};
#pragma unroll
            for (int it = 0; it < 16; ++it) {
                int m0 = ck[0][0], m1 = ck[1][0];
                row_max_i_pair(m0, m1);
                m0 = max(m0, swz<(0x10 << 10) | 0x1F>(m0)); m1 = max(m1, swz<(0x10 << 10) | 0x1F>(m1));
                const bool p0 = ck[0][0] == m0, p1 = ck[1][0] == m1;
#pragma unroll
                for (int e = 0; e < 3; ++e) { ck[0][e] = p0 ? ck[0][e + 1] : ck[0][e]; ck[1][e] = p1 ? ck[1][e + 1] : ck[1][e]; }
                ck[0][3] = p0 ? KMIN : ck[0][3]; ck[1][3] = p1 ? KMIN : ck[1][3];
                win[0] = (l16 == it) ? m0 : win[0]; win[1] = (l16 == it) ? m1 : win[1]; }
#pragma unroll
            for (int q = 0; q < 2; ++q) {
                const int cidx = 255 - (win[q] & 255), ci = (cidx >> 4) & 15, cj = cidx & 15, rb = lane & 32;
                const int i1 = __builtin_amdgcn_ds_bpermute((rb + ci) << 2, ownIdx[q]), i2 = __builtin_amdgcn_ds_bpermute((rb + 16 + cj) << 2, ownIdx[q]);
                const float sc = key2f(win[q]);
                const float mxf = key2f(row_max_i(f2key(sc)));
                const float ex = __expf(sc - mxf);
                float sum = ex; sum += dpp_mov<0xB1>(sum); sum += dpp_mov<0x4E>(sum); sum += dpp_mov<0x141>(sum); sum += dpp_mov<0x140>(sum);
                if (!isS2) { const size_t o = ((size_t)row * 8 + (2 * pp + q) * 2 + (lane >> 5)) * 16 + l16; const int e_ = (i1 * 128 + i2) & 16383; ((unsigned short*)(P->ws + P_SE16))[o] = (unsigned short)e_; SW[o] = ex / sum; } }
        }
    }
#undef SEL_LOAD
}

__device__ __forceinline__ float dot2bf_init(bf16v2 a, bf16v2 b) { float r; asm("v_dot2_f32_bf16 %0, %1, %2, 0" : "=v"(r) : "v"(a), "v"(b)); return r; }
__device__ __forceinline__ void unpack16_fp8(const u32x4 a, float (&f)[16]) {
#pragma unroll
    for (int w = 0; w < 4; ++w) { const int aw = (int)a[w]; const f32x2 lo = __builtin_amdgcn_cvt_pk_f32_fp8(aw, false), hi = __builtin_amdgcn_cvt_pk_f32_fp8(aw, true);
        f[4 * w + 0] = lo.x; f[4 * w + 1] = lo.y; f[4 * w + 2] = hi.x; f[4 * w + 3] = hi.y; }
}
#define PEER_QUEUE_BEGIN(phase_id, tg_lo, tg_hi) { \
    unsigned* heads_ = (unsigned*)(P->ws + WS_CTL) + CW_PQ + (phase_id) * 16 * 64; const unsigned x_ = ((PROBE >> 19) & 1) ? ((unsigned)blockIdx.x >> 5) & 7u : (xb_xcc_id() & 7u); \
    for (int k_ = 0; k_ < 16; ++k_) { const int db = (int)((x_ + 8u * (k_ & 1) + (unsigned)(k_ >> 1)) & 15u); \
        for (;;) { unsigned t0_ = 0; if (c.lane == 0) t0_ = __hip_atomic_fetch_add(heads_ + db * 64, 2u, __ATOMIC_RELAXED, __HIP_MEMORY_SCOPE_AGENT); \
            t0_ = (unsigned)__builtin_amdgcn_readfirstlane((int)t0_) + (unsigned)(tg_lo); if (t0_ >= (unsigned)(tg_hi)) break; \
            for (unsigned tg_ = t0_; tg_ < t0_ + 2u && tg_ < (unsigned)(tg_hi); ++tg_) { const int tg = (int)tg_;
#define PEER_QUEUE_END } } } }
__device__ __forceinline__ void phase_peer_u(KP P, const Ctx& c, int layer, int row_lo, int qrep) {
    const bf16_t* H2 = (const bf16_t*)(P->ws + WS_H2); const unsigned short* SE = (const unsigned short*)(P->ws + P_SE16);
    const unsigned char* U = P->ws + WS_PU + (size_t)layer * 16384 * D; bf16_t* PART = (bf16_t*)(P->ws + P_PART);
    PEER_QUEUE_BEGIN(layer * 2 + 0 + 8 * qrep, row_lo / 8, T / 8)
        int lane = c.lane; asm volatile("" : "+v"(lane));
        const int ts = lane >> 3, seg = lane & 7, t = tg * 8 + ts;
        const bf16_t* xp = H2 + (size_t)t * D + db * 128 + seg * 16; const u32x4 xa = *(const u32x4*)xp, xb = *(const u32x4*)(xp + 8);
        const unsigned short* se = SE + (size_t)t * 128; const unsigned char* ub = U + (size_t)db * 16384 * 128; const unsigned seg16 = (unsigned)seg * 16u;
        bf16_t* pp = PART + (((size_t)t * 16 + db) * 8 + seg) * 16;
        u32x4 eA[2], eB[2], gA[16], gB[16];
#define PU_IDX(E, st) do { _Pragma("unroll") for (int i_ = 0; i_ < 2; ++i_) E[i_] = *(const u32x4*)(se + 16 * (st) + 8 * i_); } while (0)
#define PU_GATHER(G, E) do { _Pragma("unroll") for (int k_ = 0; k_ < 16; ++k_) { const unsigned w_ = E[k_ >> 3][(k_ >> 1) & 3]; const unsigned e_ = ((k_ & 1) ? (w_ >> 16) : w_) & 16383u; G[k_] = *(const u32x4*)(ub + (unsigned)((e_ << 7) | seg16)); } } while (0)
#define PU_COMPUTE(G, OUT) do { float v2_[2]; \
            _Pragma("unroll") for (int cc = 0; cc < 2; ++cc) { float sk[8]; \
                _Pragma("unroll") for (int k = 0; k < 8; ++k) { float s0; \
                    _Pragma("unroll") for (int w = 0; w < 4; ++w) { const int gw_ = (int)G[8 * cc + k][w]; const unsigned x0 = w < 2 ? xa[2 * w] : xb[2 * w - 4], x1 = w < 2 ? xa[2 * w + 1] : xb[2 * w - 3]; \
                        if (w == 0) s0 = dot2bf_init(__builtin_amdgcn_cvt_scalef32_pk_bf16_fp8(gw_, 1.0f, false), __builtin_bit_cast(bf16v2, x0)); \
                        else s0 = __builtin_amdgcn_fdot2_f32_bf16(__builtin_amdgcn_cvt_scalef32_pk_bf16_fp8(gw_, 1.0f, false), __builtin_bit_cast(bf16v2, x0), s0, false); \
                        s0 = __builtin_amdgcn_fdot2_f32_bf16(__builtin_amdgcn_cvt_scalef32_pk_bf16_fp8(gw_, 1.0f, true), __builtin_bit_cast(bf16v2, x1), s0, false); } \
                    sk[k] = s0; } \
                sum8_quad(sk[0], sk[1], sk[2], sk[3]); sum8_quad(sk[4], sk[5], sk[6], sk[7]); \
                float v = 0.f; \
                _Pragma("unroll") for (int k = 0; k < 8; ++k) v = (seg == k) ? sk[k] : v; \
                v2_[cc] = v; } \
            OUT = cvt_pk_bf16(v2_[0], v2_[1]); } while (0)
        PU_IDX(eA, 0); PU_IDX(eB, 1); PU_GATHER(gA, eA);
#pragma unroll 1
        for (int j2 = 0; j2 < 4; ++j2) {
            PU_GATHER(gB, eB);
            if (j2 < 3) PU_IDX(eA, 2 * j2 + 2);
            unsigned pw0, pw1;
            PU_COMPUTE(gA, pw0);
            if (j2 < 3) { PU_GATHER(gA, eA); PU_IDX(eB, 2 * j2 + 3); }
            PU_COMPUTE(gB, pw1);
            *(u32x2*)(pp + 4 * j2) = (u32x2){pw0, pw1};
        }
#undef PU_IDX
#undef PU_GATHER
#undef PU_COMPUTE
    PEER_QUEUE_END
}
__device__ __forceinline__ void phase_peer_c(KP P, const Ctx& c, int layer, int row_lo) {
    const bf16_t* PART = (const bf16_t*)(P->ws + P_PART); const unsigned short* SE = (const unsigned short*)(P->ws + P_SE16); const float* SW = (const float*)(P->ws + WS_SELW);
    const float* ISU = (const float*)(P->ws + WS_PSC) + (size_t)layer * 16384; const float* ISV = ISU + (size_t)4 * 16384; bf16_t* C = (bf16_t*)(P->ws + P_C);
    unsigned pw[16]; unsigned short se0, se1; float w0, w1;
#define PC_LOAD(i_) do { const size_t t_ = (i_) >> 6; const int jj_ = (int)((i_) & 7), seg_ = (int)(((i_) >> 3) & 7); const unsigned* pp_ = (const unsigned*)(PART + ((t_ * 16) * 8 + seg_) * 16 + 2 * jj_); \
        _Pragma("unroll") for (int db = 0; db < 16; ++db) pw[db] = pp_[(size_t)db * 64]; \
        const size_t o_ = t_ * 128 + 16 * jj_ + seg_; se0 = SE[o_]; se1 = SE[o_ + 8]; w0 = SW[o_]; w1 = SW[o_ + 8]; } while (0)
    const size_t ibeg = (size_t)row_lo * 64 + c.gtid, iend = (size_t)T * 64;
    if (ibeg < iend) PC_LOAD(ibeg);
    for (size_t i = ibeg; i < iend; i += c.ngt) { const size_t t = i >> 6; const int jj = (int)(i & 7), seg = (int)((i >> 3) & 7);
        const size_t o0 = t * 128 + 16 * jj + seg, o1 = o0 + 8; const int e0 = se0 & 16383, e1 = se1 & 16383; const float cw0 = w0, cw1 = w1;
        const float iu0 = ISU[e0], iv0 = ISV[e0], iu1 = ISU[e1], iv1 = ISV[e1]; float s0 = 0.f, s1 = 0.f;
#pragma unroll
        for (int db = 0; db < 16; ++db) { const unsigned w = pw[db]; s0 += __builtin_bit_cast(float, w << 16); s1 += __builtin_bit_cast(float, w & 0xffff0000u); }
        if (i + c.ngt < iend) PC_LOAD(i + c.ngt);
        C[o0] = (bf16_t)(cvt_pk_bf16(cw0 * gelu_tanh(s0 * iu0) * iv0, 0.f) & 0xffffu);
        C[o1] = (bf16_t)(cvt_pk_bf16(cw1 * gelu_tanh(s1 * iu1) * iv1, 0.f) & 0xffffu); }
#undef PC_LOAD
}
__device__ __forceinline__ void phase_peer_v(KP P, const Ctx& c, int layer, int row_lo, int qrep) {
    const unsigned short* SE = (const unsigned short*)(P->ws + P_SE16); const bf16_t* C = (const bf16_t*)(P->ws + P_C);
    const unsigned char* V = P->ws + WS_PV + (size_t)layer * 16384 * D; bf16_t* Y = (bf16_t*)(P->ws + P_Y);
    PEER_QUEUE_BEGIN(layer * 2 + 1 + 8 * qrep, row_lo / 8, T / 8)
        int lane = c.lane; asm volatile("" : "+v"(lane));
        const int ts = lane >> 3, seg = lane & 7, t = tg * 8 + ts;
        const unsigned short* se = SE + (size_t)t * 128; const bf16_t* cp = C + (size_t)t * 128; const unsigned char* vb = V + (size_t)db * 16384 * 128; const unsigned seg16 = (unsigned)seg * 16u;
        float acc[16];
#pragma unroll
        for (int e = 0; e < 16; ++e) acc[e] = 0.f;
        u32x4 en[2];
#pragma unroll
        for (int i = 0; i < 2; ++i) en[i] = *(const u32x4*)(se + 8 * i);
#pragma unroll 1
        for (int q = 0; q < 8; ++q) { u32x4 ec[2];
#pragma unroll
          for (int i = 0; i < 2; ++i) ec[i] = en[i];
          if (q < 7) {
#pragma unroll
            for (int i = 0; i < 2; ++i) en[i] = *(const u32x4*)(se + 16 * (q + 1) + 8 * i); }
          const u32x4 c0 = *(const u32x4*)(cp + 16 * q), c1 = *(const u32x4*)(cp + 16 * q + 8);
          u32x4 g[16];
#pragma unroll
          for (int k = 0; k < 16; ++k) { const unsigned w_ = ec[k >> 3][(k >> 1) & 3]; const unsigned e = ((k & 1) ? (w_ >> 16) : w_) & 16383u; g[k] = *(const u32x4*)(vb + (unsigned)((e << 7) | seg16)); }
#pragma unroll
          for (int k = 0; k < 16; k += 2) { const unsigned cwu = (k < 8 ? c0 : c1)[(k >> 1) & 3]; const bf16v2 cw = __builtin_bit_cast(bf16v2, cwu);
#pragma unroll
              for (int w = 0; w < 4; ++w) { const unsigned g0 = g[k][w], g1 = g[k + 1][w];
                  const int pa = (int)__builtin_amdgcn_perm(g1, g0, 0x05010400u), pb = (int)__builtin_amdgcn_perm(g1, g0, 0x07030602u);
                  acc[4 * w + 0] = __builtin_amdgcn_fdot2_f32_bf16(__builtin_amdgcn_cvt_scalef32_pk_bf16_fp8(pa, 1.0f, false), cw, acc[4 * w + 0], false);
                  acc[4 * w + 1] = __builtin_amdgcn_fdot2_f32_bf16(__builtin_amdgcn_cvt_scalef32_pk_bf16_fp8(pa, 1.0f, true), cw, acc[4 * w + 1], false);
                  acc[4 * w + 2] = __builtin_amdgcn_fdot2_f32_bf16(__builtin_amdgcn_cvt_scalef32_pk_bf16_fp8(pb, 1.0f, false), cw, acc[4 * w + 2], false);
                  acc[4 * w + 3] = __builtin_amdgcn_fdot2_f32_bf16(__builtin_amdgcn_cvt_scalef32_pk_bf16_fp8(pb, 1.0f, true), cw, acc[4 * w + 3], false); } } }
        bf16_t* yp = Y + (size_t)t * D + db * 128 + seg * 16;
#pragma unroll
        for (int q = 0; q < 2; ++q) *(u32x4*)(yp + 8 * q) = (u32x4){cvt_pk_bf16(acc[8 * q], acc[8 * q + 1]), cvt_pk_bf16(acc[8 * q + 2], acc[8 * q + 3]), cvt_pk_bf16(acc[8 * q + 4], acc[8 * q + 5]), cvt_pk_bf16(acc[8 * q + 6], acc[8 * q + 7])};
    PEER_QUEUE_END
}
template <bool LAST>
__device__ __forceinline__ void phase_peer_final(KP P, const Ctx& c, int layer) {
    const bf16_t* Y = (const bf16_t*)(P->ws + P_Y); float* X = (float*)(P->ws + WS_X); bf16_t* A0 = (bf16_t*)(P->ws + WS_A0);
    const float* lg = P->in[I_LNG] + (size_t)(layer * 2 + 1) * D; const float* lb = P->in[I_LNB] + (size_t)(layer * 2 + 1) * D;
    const float ymul = ((DBG_ZERO >> (2 * layer + 1)) & 1) ? 0.f : 1.f;
    f32x4 xn[8]; u32x2 yn[8];
    { const int r0 = (LAST ? NCTX : 0) + c.gw; if (r0 < T) {
#pragma unroll
        for (int j = 0; j < 8; ++j) { xn[j] = *(const f32x4*)(X + (size_t)r0 * D + c.lane * 4 + 256 * j); yn[j] = *(const u32x2*)(Y + (size_t)r0 * D + c.lane * 4 + 256 * j); } } }
    for (int row = (LAST ? NCTX : 0) + c.gw; row < T; row += c.ngw) {
        int l4 = c.lane * 4; asm volatile("" : "+v"(l4));
        const int v = row_vec(row); const float* m5 = modp(P, layer, v, 5) + l4;
        f32x4 x[8]; float s = 0.f;
#pragma unroll
        for (int j = 0; j < 8; ++j) { const u32x2 yb = yn[j]; const f32x4 yv = (f32x4){bflo(yb.x), bfhi(yb.x), bflo(yb.y), bfhi(yb.y)};
            x[j] = xn[j] * ALPHA + *(const f32x4*)(m5 + 256 * j) * (yv * ymul); s += (x[j][0] + x[j][1]) + (x[j][2] + x[j][3]); }
        if (row + c.ngw < T) {
#pragma unroll
            for (int j = 0; j < 8; ++j) { xn[j] = *(const f32x4*)(X + (size_t)(row + c.ngw) * D + l4 + 256 * j); yn[j] = *(const u32x2*)(Y + (size_t)(row + c.ngw) * D + l4 + 256 * j); } }
        const float mean = wave_sum(s) * (1.0f / D); float q = 0.f;
#pragma unroll
        for (int j = 0; j < 8; ++j) { x[j] = x[j] - mean; q += (x[j][0] * x[j][0] + x[j][1] * x[j][1]) + (x[j][2] * x[j][2] + x[j][3] * x[j][3]); }
        const float rstd = rsqrtf(wave_sum(q) * (1.0f / D) + LN_EPS);
        const bool mk_a0 = !LAST && layer != 0;
#pragma unroll
        for (int jh = 0; jh < 2; ++jh) { f32x4 g4[4], b4[4], p4[4], q4[4];
#pragma unroll
            for (int jj = 0; jj < 4; ++jj) { const int o = l4 + 256 * (4 * jh + jj); g4[jj] = *(const f32x4*)(lg + o); b4[jj] = *(const f32x4*)(lb + o);
                if (mk_a0) { p4[jj] = *(const f32x4*)(modp(P, layer + 1, v, 1) + o); q4[jj] = *(const f32x4*)(modp(P, layer + 1, v, 0) + o); } }
#pragma unroll
            for (int jj = 0; jj < 4; ++jj) { const int j = 4 * jh + jj, o = l4 + 256 * j; const f32x4 y = x[j] * rstd * g4[jj] + b4[jj];
                if (LAST) { *(f32x4*)(P->out + (size_t)(row - NCTX) * D + o) = y; }
                else { *(f32x4*)(X + (size_t)row * D + o) = y;
                    if (mk_a0) { const f32x4 hv = y * (p4[jj] + 1.0f) + q4[jj];
                        *(u32x2*)(A0 + (size_t)row * D + o) = (u32x2){cvt_pk_bf16(hv[0], hv[1]), cvt_pk_bf16(hv[2], hv[3])}; } } } }
    }
}

__device__ __forceinline__ void phase_rw_mix(KP P, const Ctx& c, int layer) {
    const float* X = (const float*)(P->ws + WS_X); bf16_t* AALL = (bf16_t*)(P->ws + L_AALL); const float* mu = P->in[I_RWMU];
    float mu8[6][8];
    { const int c8 = (int)(c.gtid & 255) * 8;
#pragma unroll
      for (int m = 0; m < 6; ++m) { const f32x4 a = *(const f32x4*)(mu + m * D + c8), b = *(const f32x4*)(mu + m * D + c8 + 4);
#pragma unroll
          for (int j = 0; j < 4; ++j) { mu8[m][j] = a[j]; mu8[m][4 + j] = b[j]; } } }
    for (size_t i = c.gtid; i < TD / 8; i += c.ngt) { const int row = (int)(i >> 8), c8 = (int)(i & 255) * 8; const int v = row_vec(row);
        int nb = -1;
        if (row < NCTX) { const int t = row & (CTX - 1); if (c8 < 1024) { if (t > 0) nb = row - 1; } else { if (t < CTX - 1) nb = row + 1; } }
        else { const int t = (row - NCTX) & (SEQ - 1), qd = c8 >> 9;
            if (qd == 0) { if ((t & 63) != 0) nb = row - 1; } else if (qd == 1) { if ((t & 63) != 63) nb = row + 1; }
            else if (qd == 2) { if (t >= 64) nb = row - 64; } else { if (t < SEQ - 64) nb = row + 64; } }
        const float* sh = modp(P, layer, v, 0) + c8; const float* sc = modp(P, layer, v, 1) + c8;
        float h[8], xx[8];
#pragma unroll
        for (int j = 0; j < 8; ++j) { h[j] = X[(size_t)row * D + c8 + j] * (1.0f + sc[j]) + sh[j]; }
#pragma unroll
        for (int j = 0; j < 8; ++j) { const float s = nb >= 0 ? X[(size_t)nb * D + c8 + j] * (1.0f + sc[j]) + sh[j] : 0.f; xx[j] = s - h[j]; }
#pragma unroll
        for (int m = 0; m < 6; ++m) { float o[8];
#pragma unroll
            for (int j = 0; j < 8; ++j) o[j] = h[j] + xx[j] * mu8[m][j];
            *(u32x4*)(AALL + (size_t)row * (6 * D) + m * D + c8) = (u32x4){cvt_pk_bf16(o[0], o[1]), cvt_pk_bf16(o[2], o[3]), cvt_pk_bf16(o[4], o[5]), cvt_pk_bf16(o[6], o[7])}; } }
}
__device__ __forceinline__ void phase_rw_scan(KP P, const Ctx& c) {
    const bf16_t* R = (const bf16_t*)(P->ws + L_RKV); const bf16_t* Kx = R + TD; const bf16_t* Vx = R + 2 * TD;
    const bf16_t* W = (const bf16_t*)(P->ws + L_W); const bf16_t* AD = (const bf16_t*)(P->ws + L_AD);
    LAS float* rL = (LAS float*)c.lds; LAS float* wL = rL + 4096; LAS float* kkL = rL + 8192; LAS float* bL = rL + 12288; LAS float* kdL = rL + 16384; LAS float* vL = rL + 20480; LAS float* yL = rL + 24576; LAS float* scL = rL + 28672;
    const int tok = c.tid >> 3, cq = c.tid & 7;
    for (int chain = blockIdx.x; chain < 256; chain += gridDim.x) {
        const int b = chain >> 6, hd = (chain >> 1) & 31, dir = chain & 1;
        bf16_t* Y = (bf16_t*)(P->ws + (dir ? L_Y1 : L_Y0));
        const int ch0 = hd * 64 + cq * 8;
        float kkw[8], kaw[8];
#pragma unroll
        for (int j = 0; j < 8; ++j) { kkw[j] = P->in[I_RWKK][ch0 + j]; kaw[j] = P->in[I_RWKA][ch0 + j]; }
        float s[8] = {0.f, 0.f, 0.f, 0.f, 0.f, 0.f, 0.f, 0.f};
        u32x4 gr, gk, gv, gw, ga;
#define RW_GLOAD(ck) do { const int row_ = seq_row(b, dir, (ck) * 64 + tok); gr = *(const u32x4*)(R + (size_t)row_ * D + ch0); gk = *(const u32x4*)(Kx + (size_t)row_ * D + ch0); gv = *(const u32x4*)(Vx + (size_t)row_ * D + ch0); \
        gw = *(const u32x4*)(W + ((size_t)row_ * 2 + dir) * D + ch0); ga = *(const u32x4*)(AD + ((size_t)row_ * 2 + dir) * D + ch0); } while (0)
        RW_GLOAD(0);
        for (int ck = 0; ck < SLEN / 64; ++ck) {
            const int row = seq_row(b, dir, ck * 64 + tok);
            float r8[8], k8[8], v8[8], w8[8], a8[8];
            unpack8(gr, r8); unpack8(gk, k8); unpack8(gv, v8); unpack8(gw, w8); unpack8(ga, a8);
            float kx[8], ss = 0.f;
#pragma unroll
            for (int j = 0; j < 8; ++j) { kx[j] = k8[j] * kkw[j]; ss += kx[j] * kx[j]; }
            ss = sum8(ss);
            const float rn = rsqrtf(ss + 1e-12f);
            __syncthreads();
            float pbr = 0.f, pkr = 0.f;
            {   float wr_[8], kk_[8], b_[8], kd_[8];
#pragma unroll
                for (int j = 0; j < 8; ++j) { kk_[j] = kx[j] * rn; b_[j] = kk_[j] * a8[j]; kd_[j] = k8[j] * (1.0f + (a8[j] - 1.0f) * kaw[j]); wr_[j] = w8[j] * r8[j]; pbr += b_[j] * r8[j]; pkr += kd_[j] * r8[j]; }
                const int o = tok * 64 + cq * 8;
#pragma unroll
                for (int hh = 0; hh < 2; ++hh) { const int q = 4 * hh;
                    *(LAS f32x4*)(rL + o + q) = (f32x4){wr_[q], wr_[q + 1], wr_[q + 2], wr_[q + 3]}; *(LAS f32x4*)(wL + o + q) = (f32x4){w8[q], w8[q + 1], w8[q + 2], w8[q + 3]};
                    *(LAS f32x4*)(kkL + o + q) = (f32x4){kk_[q], kk_[q + 1], kk_[q + 2], kk_[q + 3]}; *(LAS f32x4*)(bL + o + q) = (f32x4){b_[q], b_[q + 1], b_[q + 2], b_[q + 3]};
                    *(LAS f32x4*)(kdL + o + q) = (f32x4){kd_[q], kd_[q + 1], kd_[q + 2], kd_[q + 3]}; *(LAS f32x4*)(vL + o + q) = (f32x4){v8[q], v8[q + 1], v8[q + 2], v8[q + 3]}; } }
            pbr = sum8(pbr); pkr = sum8(pkr);
            if (cq == 0) *(LAS f32x2*)(scL + tok * 2) = (f32x2){pbr, pkr};
            __syncthreads();
            if (ck + 1 < SLEN / 64) RW_GLOAD(ck + 1);
            f32x4 kaA, kbA, waA, wbA, baA, bbA, daA, dbA, raA, rbA, kaB, kbB, waB, wbB, baB, bbB, daB, dbB, raB, rbB; float vvA, vvB; f32x2 scA, scB;
#define RW_LLOAD(X, tk_) do { const int o_ = (tk_) * 64 + cq * 8; ka##X = *(const LAS f32x4*)(kkL + o_); kb##X = *(const LAS f32x4*)(kkL + o_ + 4); wa##X = *(const LAS f32x4*)(wL + o_); wb##X = *(const LAS f32x4*)(wL + o_ + 4); \
                ba##X = *(const LAS f32x4*)(bL + o_); bb##X = *(const LAS f32x4*)(bL + o_ + 4); da##X = *(const LAS f32x4*)(kdL + o_); db##X = *(const LAS f32x4*)(kdL + o_ + 4); ra##X = *(const LAS f32x4*)(rL + o_); rb##X = *(const LAS f32x4*)(rL + o_ + 4); \
                vv##X = vL[(tk_) * 64 + tok]; sc##X = *(const LAS f32x2*)(scL + (tk_) * 2); } while (0)
#define RW_STEP(X, tk_) do { \
                float sa = (fma_s(s[0], ka##X[0], mul_s(s[1], ka##X[1])) + fma_s(s[2], ka##X[2], mul_s(s[3], ka##X[3]))) + (fma_s(s[4], kb##X[0], mul_s(s[5], kb##X[1])) + fma_s(s[6], kb##X[2], mul_s(s[7], kb##X[3]))); \
                float yd = (fma_s(s[0], ra##X[0], mul_s(s[1], ra##X[1])) + fma_s(s[2], ra##X[2], mul_s(s[3], ra##X[3]))) + (fma_s(s[4], rb##X[0], mul_s(s[5], rb##X[1])) + fma_s(s[6], rb##X[2], mul_s(s[7], rb##X[3]))); \
                sum8_pair(sa, yd); \
                const float nsa = -sa; \
                _Pragma("unroll") for (int j2 = 0; j2 < 4; ++j2) { s[j2] = fma_s(vv##X, da##X[j2], fma_s(nsa, ba##X[j2], mul_s(s[j2], wa##X[j2]))); s[4 + j2] = fma_s(vv##X, db##X[j2], fma_s(nsa, bb##X[j2], mul_s(s[4 + j2], wb##X[j2]))); } \
                if (cq == 0) yL[(tk_) * 64 + tok] = yd - sa * sc##X[0] + vv##X * sc##X[1]; } while (0)
            RW_LLOAD(A, 0);
#pragma unroll 1
            for (int tk = 0; tk < 64; tk += 2) {
                RW_LLOAD(B, tk + 1);
                RW_STEP(A, tk);
                RW_LLOAD(A, (tk + 2) & 63);
                RW_STEP(B, tk + 1);
            }
#undef RW_STEP
#undef RW_LLOAD
            __syncthreads();
            { const f32x4 ya = *(const LAS f32x4*)(yL + tok * 64 + cq * 8), yb = *(const LAS f32x4*)(yL + tok * 64 + cq * 8 + 4);
              *(u32x4*)(Y + (size_t)row * D + ch0) = (u32x4){cvt_pk_bf16(ya[0], ya[1]), cvt_pk_bf16(ya[2], ya[3]), cvt_pk_bf16(yb[0], yb[1]), cvt_pk_bf16(yb[2], yb[3])}; }
        }
#undef RW_GLOAD
        __syncthreads();
    }
}
__device__ __forceinline__ void phase_rw_finish(KP P, const Ctx& c) {
    const bf16_t* R = (const bf16_t*)(P->ws + L_RKV); const bf16_t* Kx = R + TD; const bf16_t* Vx = R + 2 * TD;
    const bf16_t* AD = (const bf16_t*)(P->ws + L_AD); const bf16_t* G = (const bf16_t*)(P->ws + L_G);
    const bf16_t* Y0 = (const bf16_t*)(P->ws + L_Y0); const bf16_t* Y1 = (const bf16_t*)(P->ws + L_Y1); bf16_t* Z = (bf16_t*)(P->ws + L_Z);
    const int ch = c.lane * 8 + 512 * (c.gw & 3);
    float ka8[8], rk8[8], gg8[8], gb8[8];
#pragma unroll
    for (int e = 0; e < 8; ++e) { ka8[e] = P->in[I_RWKA][ch + e]; rk8[e] = P->in[I_RWRK][ch + e]; gg8[e] = P->in[I_RWGNG][ch + e]; gb8[e] = P->in[I_RWGNB][ch + e]; }
    u32x4 ny0, ny1, nr, nk, nv, na0, na1, ng;
#define RF_LOAD(k_) do { const int row_ = (k_) >> 2; const size_t o_ = (size_t)row_ * D + ch; ny0 = *(const u32x4*)(Y0 + o_); ny1 = *(const u32x4*)(Y1 + o_); nr = *(const u32x4*)(R + o_); nk = *(const u32x4*)(Kx + o_); \
        nv = *(const u32x4*)(Vx + o_); na0 = *(const u32x4*)(AD + ((size_t)row_ * 2 + 0) * D + ch); na1 = *(const u32x4*)(AD + ((size_t)row_ * 2 + 1) * D + ch); ng = *(const u32x4*)(G + o_); } while (0)
    if (c.gw < T * 4) RF_LOAD(c.gw);
    for (int k = c.gw; k < T * 4; k += c.ngw) { const size_t o = (size_t)(k >> 2) * D + ch;
            float y[8]; { float ya_[8], yb_[8]; unpack8(ny0, ya_); unpack8(ny1, yb_);
#pragma unroll
                for (int e = 0; e < 8; ++e) y[e] = ya_[e] + yb_[e]; }
            float r8[8], k8[8], v8[8], a0[8], a1[8], g8[8];
            unpack8(nr, r8); unpack8(nk, k8); unpack8(nv, v8); unpack8(na0, a0); unpack8(na1, a1); unpack8(ng, g8);
            if (k + c.ngw < T * 4) RF_LOAD(k + c.ngw);
            float s = 0.f;
#pragma unroll
            for (int e = 0; e < 8; ++e) s += y[e];
            const float mean = sum8(s) * (1.0f / 64.0f); float q = 0.f;
#pragma unroll
            for (int e = 0; e < 8; ++e) { y[e] -= mean; q += y[e] * y[e]; }
            const float rstd = rsqrtf(sum8(q) * (1.0f / 64.0f) + 64e-5f);
            float bsum = 0.f;
#pragma unroll
            for (int e = 0; e < 8; ++e) { const float ka = ka8[e], rk = rk8[e];
                const float kd0 = k8[e] * (1.0f + (a0[e] - 1.0f) * ka), kd1 = k8[e] * (1.0f + (a1[e] - 1.0f) * ka); bsum += r8[e] * (kd0 + kd1) * rk; }
            bsum = sum8(bsum);
            float z[8];
#pragma unroll
            for (int e = 0; e < 8; ++e) z[e] = (y[e] * rstd * gg8[e] + gb8[e] + bsum * v8[e]) * g8[e];
            *(u32x4*)(Z + o) = (u32x4){cvt_pk_bf16(z[0], z[1]), cvt_pk_bf16(z[2], z[3]), cvt_pk_bf16(z[4], z[5]), cvt_pk_bf16(z[6], z[7])}; }
#undef RF_LOAD
}

__device__ __forceinline__ bf16x8 frag16(const LAS unsigned char* p) { return *(const LAS bf16x8*)p; }
__device__ __forceinline__ void phase_ret_scan(KP P, const Ctx& c) {
    const bf16_t* Q = (const bf16_t*)(P->ws + L_RQ); const bf16_t* Kx = (const bf16_t*)(P->ws + L_RK); const bf16_t* Vx = (const bf16_t*)(P->ws + L_RV);
    constexpr int QP = 528, TP = 144, VP = 272;
    constexpr int OFF_Q = 0, OFF_K = 33792, OFF_KT = 67584, OFF_VT = 104448, OFF_P = 122880;
    LAS unsigned char* L = c.lds;
    const int w = c.wave;
    for (int un = blockIdx.x; un < 256; un += gridDim.x) {
        const int b = un >> 6, h = (un >> 3) & 7, dir = (un >> 2) & 1, dvs = un & 3;
        bf16_t* O = (bf16_t*)(P->ws + (dir ? L_OB : L_OF));
        int tid = c.tid;
        const float gamma = 1.0f - exp2f(-5.0f - (float)h), lg2 = log2f(gamma), g63 = exp2f(63.0f * lg2);
        f32x4 Racc[16];
#pragma unroll
        for (int i = 0; i < 16; ++i) Racc[i] = (f32x4){0.f, 0.f, 0.f, 0.f};
        u32x4 pq[4], pv[2];
#define RET_LOAD_QV(ck) do { \
        _Pragma("unroll") for (int i = 0; i < 4; ++i) { const int id = tid + 512 * i, s_ = id >> 5, dc = id & 31; \
            pq[i] = *(const u32x4*)(Q + (size_t)seq_row(b, dir, (ck) * 64 + s_) * D + h * 256 + dc * 8); } \
        _Pragma("unroll") for (int i = 0; i < 2; ++i) { const int id = tid + 512 * i, s_ = id >> 4, ec = id & 15; \
            pv[i] = *(const u32x4*)(Vx + (size_t)seq_row(b, dir, (ck) * 64 + s_) * 4096 + h * 512 + dvs * 128 + ec * 8); } } while (0)
#define RET_LOAD_K(ck, dst) do { \
        _Pragma("unroll") for (int i = 0; i < 4; ++i) { const int id = tid + 512 * i, s_ = id >> 5, dc = id & 31; \
            dst[i] = *(const u32x4*)(Kx + (size_t)seq_row(b, dir, (ck) * 64 + s_) * D + h * 256 + dc * 8); } } while (0)
#define RET_STORE_K(src) do { \
        _Pragma("unroll") for (int i = 0; i < 4; ++i) { const int id = tid + 512 * i, s_ = id >> 5, dc = id & 31; *(LAS u32x4*)(L + OFF_K + s_ * QP + dc * 16) = src[i]; } } while (0)
        RET_LOAD_QV(0);
        { u32x4 pk0[4]; RET_LOAD_K(0, pk0); __syncthreads(); RET_STORE_K(pk0); }
        for (int ck = 0; ck < SLEN / 64; ++ck) {
            asm volatile("" : "+v"(tid));
            const int lane = tid & 63, r16 = lane & 15, q4 = lane >> 4;
            __syncthreads();
#pragma unroll
            for (int i = 0; i < 4; ++i) { const int id = tid + 512 * i, s_ = id >> 5, dc = id & 31; *(LAS u32x4*)(L + OFF_Q + s_ * QP + dc * 16) = pq[i]; }
#pragma unroll
            for (int i = 0; i < 2; ++i) { const int id = tid + 512 * i, s_ = id >> 4, ec = id & 15; *(LAS u32x4*)(L + OFF_P + s_ * VP + ec * 16) = pv[i]; }
            __syncthreads();
            if (ck + 1 < SLEN / 64) RET_LOAD_QV(ck + 1);
            {   const float vs = exp2f(-lg2 * (float)lane);
#pragma unroll
                for (int i = 0; i < 4; ++i) { const int dc = w + 8 * i;
                    const u32x4 raw = *(const LAS u32x4*)(L + OFF_K + lane * QP + dc * 16);
#pragma unroll
                    for (int e = 0; e < 4; ++e) { *(LAS unsigned short*)(L + OFF_KT + (dc * 8 + 2 * e) * TP + lane * 2) = (unsigned short)(raw[e] & 0xffffu); *(LAS unsigned short*)(L + OFF_KT + (dc * 8 + 2 * e + 1) * TP + lane * 2) = (unsigned short)(raw[e] >> 16); } }
#pragma unroll
                for (int i = 0; i < 2; ++i) { const int ec = w + 8 * i; float t8[8]; unpack8(*(const LAS u32x4*)(L + OFF_P + lane * VP + ec * 16), t8);
#pragma unroll
                    for (int e = 0; e < 4; ++e) { const unsigned pk2 = cvt_pk_bf16(t8[2 * e] * vs, t8[2 * e + 1] * vs);
                        *(LAS unsigned short*)(L + OFF_VT + (ec * 8 + 2 * e) * TP + lane * 2) = (unsigned short)(pk2 & 0xffffu); *(LAS unsigned short*)(L + OFF_VT + (ec * 8 + 2 * e + 1) * TP + lane * 2) = (unsigned short)(pk2 >> 16); } } }
            const int it_s = w >> 1, jt0 = 2 * (w & 1);
            f32x4 s0 = (f32x4){0.f, 0.f, 0.f, 0.f}, s1 = s0;
#pragma unroll
            for (int ks = 0; ks < 8; ++ks) { const int co = (32 * ks + 8 * q4) * 2; if ((ks & 1) == 0) asm volatile("" ::: "memory");
                const bf16x8 qf = frag16(L + OFF_Q + (16 * it_s + r16) * QP + co), k0 = frag16(L + OFF_K + (16 * jt0 + r16) * QP + co), k1 = frag16(L + OFF_K + (16 * jt0 + 16 + r16) * QP + co);
                s0 = __builtin_amdgcn_mfma_f32_16x16x32_bf16(k0, qf, s0, 0, 0, 0); s1 = __builtin_amdgcn_mfma_f32_16x16x32_bf16(k1, qf, s1, 0, 0, 0); }
            __syncthreads();
            {   const int i_ = 16 * it_s + r16; const float gi = exp2f(lg2 * (float)i_);
                const int j0 = 16 * jt0 + 4 * q4, j1 = j0 + 16; float p0[4], p1[4];
#pragma unroll
                for (int r = 0; r < 4; ++r) { p0[r] = (j0 + r <= i_) ? s0[r] * gi : 0.f; p1[r] = (j1 + r <= i_) ? s1[r] * gi : 0.f; }
                *(LAS u32x2*)(L + OFF_P + i_ * TP + j0 * 2) = (u32x2){cvt_pk_bf16(p0[0], p0[1]), cvt_pk_bf16(p0[2], p0[3])};
                *(LAS u32x2*)(L + OFF_P + i_ * TP + j1 * 2) = (u32x2){cvt_pk_bf16(p1[0], p1[1]), cvt_pk_bf16(p1[2], p1[3])}; }
            __syncthreads();
            u32x4 pkn[4]; const bool has_next = ck + 1 < SLEN / 64;
            if (has_next) RET_LOAD_K(ck + 1, pkn);
            const LAS unsigned char* vtp = L + OFF_VT + (16 * w + r16) * TP + (8 * q4) * 2;
#pragma unroll
            for (int it = 0; it < 4; ++it) { const int i_ = 16 * it + r16; f32x4 a = (f32x4){0.f, 0.f, 0.f, 0.f};
                asm volatile("" ::: "memory");
#pragma unroll
                for (int m = 0; m < 8; ++m) {
                    const u32x4 t = (u32x4){cvt_pk_bf16(Racc[2 * m][0], Racc[2 * m][1]), cvt_pk_bf16(Racc[2 * m][2], Racc[2 * m][3]), cvt_pk_bf16(Racc[2 * m + 1][0], Racc[2 * m + 1][1]), cvt_pk_bf16(Racc[2 * m + 1][2], Racc[2 * m + 1][3])};
                    const LAS unsigned char* qp = L + OFF_Q + i_ * QP + (32 * m + 4 * q4) * 2; const u32x2 lo = *(const LAS u32x2*)qp, hi = *(const LAS u32x2*)(qp + 32);
                    const u32x4 tq = (u32x4){lo.x, lo.y, hi.x, hi.y}; a = __builtin_amdgcn_mfma_f32_16x16x32_bf16(__builtin_bit_cast(bf16x8, t), __builtin_bit_cast(bf16x8, tq), a, 0, 0, 0); }
                a = a * exp2f(lg2 * (float)(i_ + 1));
#pragma unroll
                for (int ks = 0; ks < 2; ++ks) a = __builtin_amdgcn_mfma_f32_16x16x32_bf16(frag16(vtp + 64 * ks), frag16(L + OFF_P + i_ * TP + (32 * ks + 8 * q4) * 2), a, 0, 0, 0);
                *(u32x2*)(O + (size_t)seq_row(b, dir, ck * 64 + i_) * 4096 + h * 512 + dvs * 128 + 16 * w + 4 * q4) = (u32x2){cvt_pk_bf16(a[0], a[1]), cvt_pk_bf16(a[2], a[3])}; }
            if (has_next) RET_STORE_K(pkn);
#pragma unroll
            for (int dt = 0; dt < 16; ++dt) { if ((dt & 1) == 0) asm volatile("" ::: "memory");
                f32x4 u = Racc[dt] * gamma;
#pragma unroll
                for (int ks = 0; ks < 2; ++ks) u = __builtin_amdgcn_mfma_f32_16x16x32_bf16(frag16(L + OFF_KT + (16 * dt + r16) * TP + (32 * ks + 8 * q4) * 2), frag16(vtp + 64 * ks), u, 0, 0, 0);
                Racc[dt] = u * g63; }
        }
#undef RET_LOAD_QV
#undef RET_LOAD_K
#undef RET_STORE_K
        __syncthreads();
    }
}
__device__ __forceinline__ void phase_ret_merge(KP P, const Ctx& c) {
    const bf16_t* OF = (const bf16_t*)(P->ws + L_OF); const bf16_t* OB = (const bf16_t*)(P->ws + L_OB); const bf16_t* GF = (const bf16_t*)(P->ws + L_GF); const bf16_t* GB = (const bf16_t*)(P->ws + L_GB);
    bf16_t* Z = (bf16_t*)(P->ws + L_RZ);
    u32x4 nf, nb, ngf, ngb;
#define RM_LOAD(k_) do { const size_t o_ = (size_t)(k_) * 512 + c.lane * 8; nf = *(const u32x4*)(OF + o_); nb = *(const u32x4*)(OB + o_); ngf = *(const u32x4*)(GF + o_); ngb = *(const u32x4*)(GB + o_); } while (0)
    if (c.gw < T * 8) RM_LOAD(c.gw);
    for (int k = c.gw; k < T * 8; k += c.ngw) { const size_t o = (size_t)k * 512 + c.lane * 8;
            float f[8], bk[8], gf[8], gb[8]; unpack8(nf, f); unpack8(nb, bk); unpack8(ngf, gf); unpack8(ngb, gb);
            if (k + c.ngw < T * 8) RM_LOAD(k + c.ngw);
            float sf = 0.f, sb = 0.f;
#pragma unroll
            for (int e = 0; e < 8; ++e) { sf += f[e]; sb += bk[e]; }
            const float mf = wave_sum(sf) * (1.0f / 512.0f), mb = wave_sum(sb) * (1.0f / 512.0f); float qf = 0.f, qb = 0.f;
#pragma unroll
            for (int e = 0; e < 8; ++e) { f[e] -= mf; bk[e] -= mb; qf += f[e] * f[e]; qb += bk[e] * bk[e]; }
            const float rf = rsqrtf(wave_sum(qf) * (1.0f / 512.0f) + LN_EPS), rb = rsqrtf(wave_sum(qb) * (1.0f / 512.0f) + LN_EPS);
            float z[8];
#pragma unroll
            for (int e = 0; e < 8; ++e) z[e] = gf[e] * (f[e] * rf) + gb[e] * (bk[e] * rb);
            *(u32x4*)(Z + o) = (u32x4){cvt_pk_bf16(z[0], z[1]), cvt_pk_bf16(z[2], z[3]), cvt_pk_bf16(z[4], z[5]), cvt_pk_bf16(z[6], z[7])}; }
#undef RM_LOAD
}

__device__ __forceinline__ Ctx make_ctx(LAS unsigned char* lds) {
    int t = threadIdx.x; asm volatile("" : "+v"(t));
    Ctx c; c.lds = lds; c.tid = t; c.lane = t & 63; c.wave = __builtin_amdgcn_readfirstlane(t >> 6);
    c.gw = blockIdx.x * 8 + c.wave; c.ngw = gridDim.x * 8; c.gtid = blockIdx.x * 512 + t; c.ngt = gridDim.x * 512; return c;
}
#define GRID_BAR() xcd_barrier(bar)
template <class Epi, class GT> __device__ __forceinline__ void run_gemm_m(LAS unsigned char* lds, const GT& g, int M, int N, const Epi& E) {
    pg8::StaticOrder S; S.init(M, N, (int)gridDim.x, (int)blockIdx.x); pg8::gemm_phase<Epi, GT>(lds, g, S, E);
}
template <class Epi, class GT> __device__ __forceinline__ void run_gemm(LAS unsigned char* lds, const GT& g, int N, const Epi& E, int pm0 = 0) {
    pg8::StaticOrder S; S.init(T, N, (int)gridDim.x, (int)blockIdx.x, pm0); pg8::gemm_phase<Epi, GT>(lds, g, S, E);
}
template <int LAYER, bool LAST> __device__ __forceinline__ void peer_phases(LAS unsigned char* lds, const XcdBarrier& bar) {
    phase_ln_mid(kp_fresh(), make_ctx(lds), LAYER, LAST ? NCTX : 0); GRID_BAR();
    PROBE_REP(2) { KP P = kp_fresh(); unsigned char* ws = P->ws; GPlain g{(const bf16_t*)(ws + WS_H2), (const bf16_t*)(ws + WS_WQ) + (size_t)LAYER * D * D, D, D, D}; EpiF32Plain E{(float*)(ws + WS_S), D}; run_gemm(lds, g, D, E, LAST ? 4 : 0);
        if (!LAST && _rep == 0) { constexpr int NR = 8 * 16384, SH = (NR + 2) / 3; const int lo = LAYER * SH, hi = (LAYER == 2) ? NR : (LAYER + 1) * SH;
            if ((int)gridDim.x == 256) { if ((int)blockIdx.x >= 32) peer_convert_rows(kp_fresh(), make_ctx(lds), lo, hi, (int)blockIdx.x - 32, 224); }
            else peer_convert_rows(kp_fresh(), make_ctx(lds), lo, hi, (int)blockIdx.x, (int)gridDim.x); }
        GRID_BAR(); }
    PROBE_REP(1) { phase_peer_select(kp_fresh(), make_ctx(lds), LAST ? NCTX : 0); GRID_BAR(); }
    PROBE_REP(0) { phase_peer_u(kp_fresh(), make_ctx(lds), LAYER, LAST ? NCTX : 0, _rep); GRID_BAR(); }
    phase_peer_c(kp_fresh(), make_ctx(lds), LAYER, LAST ? NCTX : 0); GRID_BAR();
    PROBE_REP(9) { phase_peer_v(kp_fresh(), make_ctx(lds), LAYER, LAST ? NCTX : 0, _rep); GRID_BAR(); }
    phase_peer_final<LAST>(kp_fresh(), make_ctx(lds), LAYER); GRID_BAR();
}
template <int LAYER, int JL> __device__ __forceinline__ void rg_phases(LAS unsigned char* lds, const XcdBarrier& bar) {
    PROBE_REP(6) { KP P = kp_fresh(); unsigned char* ws = P->ws; GPlain g{(const bf16_t*)(ws + WS_A0), (const bf16_t*)(ws + WS_RGIN) + (size_t)JL * 4096 * D, D, D, D}; EpiRgIn E{(bf16_t*)(ws + L_UG), (bf16_t*)(ws + L_UR)}; run_gemm(lds, g, 4096, E); GRID_BAR(); }
    PROBE_REP(7) { phase_rg_conv(kp_fresh(), make_ctx(lds), JL); GRID_BAR(); }
    { KP P = kp_fresh(); unsigned char* ws = P->ws; GGate g{(const bf16_t*)(ws + L_XC), (const bf16_t*)(ws + WS_RGGATE) + (size_t)JL * 8192 * 256, 256, D, 256};
      EpiRgGate E{(const bf16_t*)(ws + L_XC), (bf16_t*)(ws + L_LA), (bf16_t*)(ws + L_BB), P->in[I_RGGB] + (size_t)JL * 4 * D, (const float*)(ws + WS_SPT) + (size_t)JL * 2 * D}; PROBE_REP(11) { run_gemm(lds, g, 8192, E); GRID_BAR(); } }
    PROBE_REP(3) { phase_rg_scan1(kp_fresh(), make_ctx(lds)); GRID_BAR();
    phase_rg_scan2(kp_fresh(), make_ctx(lds)); GRID_BAR();
    phase_rg_scan3<0>(kp_fresh(), make_ctx(lds)); GRID_BAR();
    phase_rg_scan3<1>(kp_fresh(), make_ctx(lds)); GRID_BAR(); }
    { KP P = kp_fresh(); unsigned char* ws = P->ws; GPlain g{(const bf16_t*)(ws + L_YIN), (const bf16_t*)(ws + WS_RGOUT) + (size_t)JL * D * D, D, D, D}; EpiF32Plain E{(float*)(ws + WS_S), D}; run_gemm(lds, g, D, E, LAYER == 3 ? 4 : 0); } GRID_BAR();
}
template <int LAYER> __device__ __forceinline__ void rw_phases(LAS unsigned char* lds, const XcdBarrier& bar) {
    PROBE_REP(7) { phase_rw_mix(kp_fresh(), make_ctx(lds), LAYER); GRID_BAR(); }
    PROBE_REP(6) { KP P = kp_fresh(); unsigned char* ws = P->ws; GRw1 g{(const bf16_t*)(ws + L_AALL), (const bf16_t*)(ws + WS_RW1), D, 6 * D, D}; EpiRw1 E{(bf16_t*)(ws + L_RKV), (bf16_t*)(ws + L_A2)}; run_gemm(lds, g, 6912, E); GRID_BAR(); }
    { KP P = kp_fresh(); unsigned char* ws = P->ws; GRw2 g{(const bf16_t*)(ws + L_A2), (const bf16_t*)(ws + WS_RW2), 256, 768, 256}; EpiRw2 E{(bf16_t*)(ws + L_W), (bf16_t*)(ws + L_AD), (bf16_t*)(ws + L_G), P->in[I_RWDEC0], P->in[I_RWICL0]}; PROBE_REP(12) { run_gemm(lds, g, 10240, E); GRID_BAR(); } }
    PROBE_REP(4) { phase_rw_scan(kp_fresh(), make_ctx(lds)); GRID_BAR(); }
    PROBE_REP(7) { phase_rw_finish(kp_fresh(), make_ctx(lds)); GRID_BAR(); }
    { KP P = kp_fresh(); unsigned char* ws = P->ws; GPlain g{(const bf16_t*)(ws + L_Z), (const bf16_t*)(ws + WS_RWO), D, D, D}; EpiF32Plain E{(float*)(ws + WS_S), D}; run_gemm(lds, g, D, E); } GRID_BAR();
}
template <int LAYER> __device__ __forceinline__ void ret_phases(LAS unsigned char* lds, const XcdBarrier& bar) {
    { KP P = kp_fresh(); unsigned char* ws = P->ws; GPlain g{(const bf16_t*)(ws + WS_A0), (const bf16_t*)(ws + WS_RETIN), D, D, D};
      EpiRetIn E{(bf16_t*)(ws + L_RQ), (bf16_t*)(ws + L_RK), (bf16_t*)(ws + L_RV), (bf16_t*)(ws + L_GF), (bf16_t*)(ws + L_GB), (const float*)(ws + WS_CS)}; PROBE_REP(10) { run_gemm(lds, g, 16384, E); GRID_BAR(); } }
    PROBE_REP(5) { phase_ret_scan(kp_fresh(), make_ctx(lds)); GRID_BAR(); }
    PROBE_REP(7) { phase_ret_merge(kp_fresh(), make_ctx(lds)); GRID_BAR(); }
    { KP P = kp_fresh(); unsigned char* ws = P->ws; GPlain g{(const bf16_t*)(ws + L_RZ), (const bf16_t*)(ws + WS_RETOUT), 4096, 4096, 4096}; EpiF32Plain E{(float*)(ws + WS_S), D}; run_gemm(lds, g, D, E); } GRID_BAR();
}

__global__ void __launch_bounds__(512, 2) hybrid_fwd(Params Pkernarg) {
    extern __shared__ __attribute__((aligned(16))) unsigned char lds_raw[];
    LAS unsigned char* lds = (LAS unsigned char*)lds_raw;
    volatile LAS unsigned* MISC = (volatile LAS unsigned*)(lds + MISC_OFF);
    if (threadIdx.x < 64) MISC[threadIdx.x] = 0u;
    __syncthreads();
    XcdBarrier bar = xcd_barrier_post((unsigned*)(kp_fresh()->ws + WS_CTL) + 4096, MISC + 8);

    if ((PROBE >> 13) & 1) { for (int i = 0; i < 64; ++i) GRID_BAR(); }
    PROBE_REP(8) { phase_prologue(kp_fresh(), make_ctx(lds)); GRID_BAR(); }
    { KP P = kp_fresh(); unsigned char* ws = P->ws; GFold g{(const bf16_t*)(ws + WS_KEYS), (const bf16_t*)(ws + WS_WQN), 256, 256, D}; EpiBf16Plain E{(bf16_t*)(ws + WS_WQ), D}; run_gemm_m(lds, g, 4 * D, D, E); }
    phase_modfin(kp_fresh(), make_ctx(lds)); GRID_BAR();
    phase_xinit(kp_fresh(), make_ctx(lds)); GRID_BAR();
    rg_phases<0, 0>(lds, bar);  peer_phases<0, false>(lds, bar);
    rw_phases<1>(lds, bar);     peer_phases<1, false>(lds, bar);
    ret_phases<2>(lds, bar);    peer_phases<2, false>(lds, bar);
    rg_phases<3, 1>(lds, bar);  peer_phases<3, true>(lds, bar);
}

extern "C" void kernel_launch(void* const* d_in, const int* in_sizes, int n_in, void* d_out, int out_size, void* d_ws, size_t ws_size, hipStream_t stream) {
    static int grid = 0;
    if (!grid) {
        if (n_in != 37 || ws_size < WS_END) { fprintf(stderr, "kernel_launch: unexpected problem (n_in %d, ws %zu)\n", n_in, ws_size); grid = -1; return; }
        int dev = 0, cus = 0, per_cu = 0;
        if (hipGetDevice(&dev) != hipSuccess || hipDeviceGetAttribute(&cus, hipDeviceAttributeMultiprocessorCount, dev) != hipSuccess) { grid = -1; return; }
        if (hipFuncSetAttribute((const void*)hybrid_fwd, hipFuncAttributeMaxDynamicSharedMemorySize, LDS_BYTES) != hipSuccess) { fprintf(stderr, "kernel_launch: hipFuncSetAttribute failed\n"); grid = -1; return; }
        if (hipOccupancyMaxActiveBlocksPerMultiprocessor(&per_cu, (const void*)hybrid_fwd, 512, LDS_BYTES) != hipSuccess || per_cu < 1) { fprintf(stderr, "kernel_launch: occupancy query says %d\n", per_cu); grid = -1; return; }
        grid = cus;
    }
    if (grid <= 0) return;
    hipMemsetAsync((char*)d_ws + WS_CTL, 0, CTL_BYTES, stream);
    Params p; memset(&p, 0, sizeof(p));
    for (int i = 0; i < 37; ++i) p.in[i] = (const float*)d_in[i];
    p.out = (float*)d_out; p.ws = (unsigned char*)d_ws;
    hipLaunchKernelGGL(hybrid_fwd, dim3(grid), dim3(512), LDS_BYTES, stream, p);
}
```

```cpp
#include <hip/hip_runtime.h>
#include <cstdio>
#include <cstring>

#define LAS __attribute__((address_space(3)))
typedef unsigned short bf16_t;
typedef short bf16x8 __attribute__((ext_vector_type(8)));
typedef float f32x4 __attribute__((ext_vector_type(4)));
typedef float f32x2 __attribute__((ext_vector_type(2)));
typedef unsigned u32x4 __attribute__((ext_vector_type(4)));
typedef unsigned u32x2 __attribute__((ext_vector_type(2)));
typedef __bf16 bf16v2 __attribute__((ext_vector_type(2)));

#ifndef DBG_ZERO
#define DBG_ZERO 0
#endif
#ifndef PROBE
#define PROBE 0
#endif
#define PROBE_REP(bit) for (int _rep = 0; _rep < (((PROBE) >> (bit)) & 1) + 1; ++_rep)
constexpr int D = 2048, NBATCH = 4, SEQ = 4096, CTX = 256;
constexpr int NCTX = NBATCH * CTX, NLAT = NBATCH * SEQ, T = NCTX + NLAT;
constexpr int SLEN = CTX + SEQ;
constexpr float ALPHA = 1.681792830507429f;
constexpr float LN_EPS = 1e-5f;
constexpr size_t TD = (size_t)T * D;

constexpr size_t MiB = 1u << 20;
constexpr size_t WS_CTL = 0, CTL_BYTES = 1 * MiB;
constexpr size_t WS_MODP = 2 * MiB;
constexpr size_t WS_MOD = 10 * MiB;
constexpr size_t WS_CS = 11 * MiB;
constexpr size_t WS_SPT = 15 * MiB + 512 * 1024;
constexpr size_t WS_CA = 16 * MiB, WS_CH = 21 * MiB, WS_CIN = 26 * MiB;
constexpr size_t WS_WQ = 32 * MiB;
constexpr size_t WS_KEYS = 64 * MiB;
constexpr size_t WS_RGIN = 68 * MiB;
constexpr size_t WS_RGGATE = 100 * MiB;
constexpr size_t WS_RGOUT = 108 * MiB;
constexpr size_t WS_RW1 = 124 * MiB;
constexpr size_t WS_RW2 = 152 * MiB;
constexpr size_t WS_RWO = 160 * MiB;
constexpr size_t WS_RETIN = 168 * MiB;
constexpr size_t WS_RETOUT = 232 * MiB;
constexpr size_t WS_PU = 256 * MiB;
constexpr size_t WS_PV = 384 * MiB;
constexpr size_t WS_PSC = 512 * MiB;
constexpr size_t WS_X = 768 * MiB;
constexpr size_t WS_A0 = 904 * MiB;
constexpr size_t WS_H2 = 972 * MiB;
constexpr size_t WS_Q = 1040 * MiB;
constexpr size_t WS_WQN = 1040 * MiB;
constexpr size_t WS_S = 1108 * MiB;
constexpr size_t WS_L = 1244 * MiB;
constexpr size_t WS_SELW = 1893 * MiB;
constexpr size_t WS_END = 1902 * MiB;
constexpr size_t P_SE16 = WS_L + 288 * MiB;
constexpr size_t P_PART = WS_L, P_Y = WS_L + 136 * MiB, P_C = WS_L + 272 * MiB;
constexpr int CW_PQ = 16384;
constexpr size_t L_UG = WS_L, L_UR = WS_L + 68 * MiB, L_XC = WS_L + 136 * MiB, L_LA = WS_L + 204 * MiB, L_BB = WS_L + 340 * MiB, L_YIN = WS_L + 476 * MiB;
constexpr size_t L_AALL = WS_L;
constexpr size_t L_W = WS_L, L_AD = WS_L + 136 * MiB, L_G = WS_L + 272 * MiB;
constexpr size_t L_RKV = WS_L + 408 * MiB;
constexpr size_t L_A2 = WS_L + 612 * MiB;
constexpr size_t L_Y0 = WS_H2, L_Y1 = WS_H2 + 136 * MiB;
constexpr size_t L_Z = WS_A0;
constexpr size_t L_RQ = WS_L, L_RK = WS_L + 68 * MiB, L_RV = WS_L + 136 * MiB, L_GF = WS_L + 272 * MiB, L_GB = WS_L + 408 * MiB;
constexpr size_t L_OF = WS_H2, L_OB = WS_H2 + 136 * MiB;
constexpr size_t L_RZ = WS_L;

__device__ __forceinline__ float bf2f(unsigned b) { return __uint_as_float(b << 16); }
__device__ __forceinline__ unsigned cvt_pk_bf16(float lo, float hi) { bf16v2 t; t.x = (__bf16)lo; t.y = (__bf16)hi; return __builtin_bit_cast(unsigned, t); }
__device__ __forceinline__ float bflo(unsigned u) { return __uint_as_float(u << 16); }
__device__ __forceinline__ float bfhi(unsigned u) { return __uint_as_float(u & 0xffff0000u); }
__device__ __forceinline__ float sigmoidf_(float x) { return 1.0f / (1.0f + __expf(-x)); }
__device__ __forceinline__ float siluf_(float x) { return x / (1.0f + __expf(-x)); }
__device__ __forceinline__ float tanhf_(float x) { return 1.0f - 2.0f / (1.0f + __expf(2.0f * x)); }
__device__ __forceinline__ float gelu_tanh(float x) { const float z = 1.5957691216057308f * (x + 0.044715f * x * x * x); return x / (1.0f + __expf(-z)); }
__device__ __forceinline__ void unpack8(const u32x4 u, float (&f)[8]) { f[0] = bflo(u.x); f[1] = bfhi(u.x); f[2] = bflo(u.y); f[3] = bfhi(u.y); f[4] = bflo(u.z); f[5] = bfhi(u.z); f[6] = bflo(u.w); f[7] = bfhi(u.w); }
template <int CTRL> __device__ __forceinline__ float dpp_mov(float v) { const int x = __builtin_bit_cast(int, v); return __builtin_bit_cast(float, __builtin_amdgcn_update_dpp(x, x, CTRL, 0xF, 0xF, false)); }
__device__ __forceinline__ float rl_f(float v, int lane) { return __builtin_bit_cast(float, __builtin_amdgcn_readlane(__builtin_bit_cast(int, v), lane)); }
__device__ __forceinline__ float sum8(float v) { v += dpp_mov<0xB1>(v); v += dpp_mov<0x4E>(v); v += dpp_mov<0x141>(v); return v; }
__device__ __forceinline__ float sum16(float v) { v = sum8(v); v += dpp_mov<0x140>(v); return v; }
__device__ __forceinline__ float fma_s(float a, float b, float c) { float d; asm("v_fma_f32 %0, %1, %2, %3" : "=v"(d) : "v"(a), "v"(b), "v"(c)); return d; }
__device__ __forceinline__ float mul_s(float a, float b) { float d; asm("v_mul_f32 %0, %1, %2" : "=v"(d) : "v"(a), "v"(b)); return d; }
__device__ __forceinline__ void sum8_pair(float& a, float& b) {
    asm volatile("s_nop 1\n\t"
        "v_add_f32_dpp %0, %0, %0 quad_perm:[1,0,3,2] row_mask:0xf bank_mask:0xf\n\tv_add_f32_dpp %1, %1, %1 quad_perm:[1,0,3,2] row_mask:0xf bank_mask:0xf\n\ts_nop 0\n\t"
        "v_add_f32_dpp %0, %0, %0 quad_perm:[2,3,0,1] row_mask:0xf bank_mask:0xf\n\tv_add_f32_dpp %1, %1, %1 quad_perm:[2,3,0,1] row_mask:0xf bank_mask:0xf\n\ts_nop 0\n\t"
        "v_add_f32_dpp %0, %0, %0 row_half_mirror row_mask:0xf bank_mask:0xf\n\tv_add_f32_dpp %1, %1, %1 row_half_mirror row_mask:0xf bank_mask:0xf"
        : "+v"(a), "+v"(b));
}
__device__ __forceinline__ void sum16_pair(float& a, float& b) {
    asm volatile("s_nop 1\n\t"
        "v_add_f32_dpp %0, %0, %0 quad_perm:[1,0,3,2] row_mask:0xf bank_mask:0xf\n\tv_add_f32_dpp %1, %1, %1 quad_perm:[1,0,3,2] row_mask:0xf bank_mask:0xf\n\ts_nop 0\n\t"
        "v_add_f32_dpp %0, %0, %0 quad_perm:[2,3,0,1] row_mask:0xf bank_mask:0xf\n\tv_add_f32_dpp %1, %1, %1 quad_perm:[2,3,0,1] row_mask:0xf bank_mask:0xf\n\ts_nop 0\n\t"
        "v_add_f32_dpp %0, %0, %0 row_half_mirror row_mask:0xf bank_mask:0xf\n\tv_add_f32_dpp %1, %1, %1 row_half_mirror row_mask:0xf bank_mask:0xf\n\ts_nop 0\n\t"
        "v_add_f32_dpp %0, %0, %0 row_mirror row_mask:0xf bank_mask:0xf\n\tv_add_f32_dpp %1, %1, %1 row_mirror row_mask:0xf bank_mask:0xf"
        : "+v"(a), "+v"(b));
}
__device__ __forceinline__ void sum16_quad(float& a, float& b, float& c, float& d) {
    asm volatile("s_nop 1\n\t"
        "v_add_f32_dpp %0, %0, %0 quad_perm:[1,0,3,2] row_mask:0xf bank_mask:0xf\n\tv_add_f32_dpp %1, %1, %1 quad_perm:[1,0,3,2] row_mask:0xf bank_mask:0xf\n\t"
        "v_add_f32_dpp %2, %2, %2 quad_perm:[1,0,3,2] row_mask:0xf bank_mask:0xf\n\tv_add_f32_dpp %3, %3, %3 quad_perm:[1,0,3,2] row_mask:0xf bank_mask:0xf\n\t"
        "v_add_f32_dpp %0, %0, %0 quad_perm:[2,3,0,1] row_mask:0xf bank_mask:0xf\n\tv_add_f32_dpp %1, %1, %1 quad_perm:[2,3,0,1] row_mask:0xf bank_mask:0xf\n\t"
        "v_add_f32_dpp %2, %2, %2 quad_perm:[2,3,0,1] row_mask:0xf bank_mask:0xf\n\tv_add_f32_dpp %3, %3, %3 quad_perm:[2,3,0,1] row_mask:0xf bank_mask:0xf\n\t"
        "v_add_f32_dpp %0, %0, %0 row_half_mirror row_mask:0xf bank_mask:0xf\n\tv_add_f32_dpp %1, %1, %1 row_half_mirror row_mask:0xf bank_mask:0xf\n\t"
        "v_add_f32_dpp %2, %2, %2 row_half_mirror row_mask:0xf bank_mask:0xf\n\tv_add_f32_dpp %3, %3, %3 row_half_mirror row_mask:0xf bank_mask:0xf\n\t"
        "v_add_f32_dpp %0, %0, %0 row_mirror row_mask:0xf bank_mask:0xf\n\tv_add_f32_dpp %1, %1, %1 row_mirror row_mask:0xf bank_mask:0xf\n\t"
        "v_add_f32_dpp %2, %2, %2 row_mirror row_mask:0xf bank_mask:0xf\n\tv_add_f32_dpp %3, %3, %3 row_mirror row_mask:0xf bank_mask:0xf"
        : "+v"(a), "+v"(b), "+v"(c), "+v"(d));
}
__device__ __forceinline__ void sum8_quad(float& a, float& b, float& c, float& d) {
    asm volatile("s_nop 1\n\t"
        "v_add_f32_dpp %0, %0, %0 quad_perm:[1,0,3,2] row_mask:0xf bank_mask:0xf\n\tv_add_f32_dpp %1, %1, %1 quad_perm:[1,0,3,2] row_mask:0xf bank_mask:0xf\n\t"
        "v_add_f32_dpp %2, %2, %2 quad_perm:[1,0,3,2] row_mask:0xf bank_mask:0xf\n\tv_add_f32_dpp %3, %3, %3 quad_perm:[1,0,3,2] row_mask:0xf bank_mask:0xf\n\t"
        "v_add_f32_dpp %0, %0, %0 quad_perm:[2,3,0,1] row_mask:0xf bank_mask:0xf\n\tv_add_f32_dpp %1, %1, %1 quad_perm:[2,3,0,1] row_mask:0xf bank_mask:0xf\n\t"
        "v_add_f32_dpp %2, %2, %2 quad_perm:[2,3,0,1] row_mask:0xf bank_mask:0xf\n\tv_add_f32_dpp %3, %3, %3 quad_perm:[2,3,0,1] row_mask:0xf bank_mask:0xf\n\t"
        "v_add_f32_dpp %0, %0, %0 row_half_mirror row_mask:0xf bank_mask:0xf\n\tv_add_f32_dpp %1, %1, %1 row_half_mirror row_mask:0xf bank_mask:0xf\n\t"
        "v_add_f32_dpp %2, %2, %2 row_half_mirror row_mask:0xf bank_mask:0xf\n\tv_add_f32_dpp %3, %3, %3 row_half_mirror row_mask:0xf bank_mask:0xf"
        : "+v"(a), "+v"(b), "+v"(c), "+v"(d));
}
__device__ __forceinline__ float wave_sum(float v) { v = sum8(v); v += dpp_mov<0x140>(v); return (rl_f(v, 0) + rl_f(v, 16)) + (rl_f(v, 32) + rl_f(v, 48)); }
__device__ __forceinline__ float wave_max(float v) {
    v = fmaxf(v, dpp_mov<0xB1>(v)); v = fmaxf(v, dpp_mov<0x4E>(v)); v = fmaxf(v, dpp_mov<0x141>(v)); v = fmaxf(v, dpp_mov<0x140>(v));
    return fmaxf(fmaxf(rl_f(v, 0), rl_f(v, 16)), fmaxf(rl_f(v, 32), rl_f(v, 48)));
}
__device__ __forceinline__ int row_vec(int row) { return row < NCTX ? 4 : ((row - NCTX) >> 12); }
__device__ __forceinline__ int panel_vec(int pm) { return pm < 4 ? 4 : ((pm - 4) >> 4); }
__device__ __forceinline__ int seq_row(int b, int dir, int s) {
    if (s < CTX) { const int t = dir ? (CTX - 1 - s) : s; return b * CTX + t; }
    int t = s - CTX; if (dir) t = SEQ - 1 - t; return NCTX + b * SEQ + t;
}
__device__ __forceinline__ int row_pos(int row) { return row < NCTX ? (row & (CTX - 1)) : CTX + ((row - NCTX) & (SEQ - 1)); }

namespace pg8 {
constexpr int BM = 256, BK = 64, HALF = 128, HTB = HALF * BK * 2, STAGE_BYTES = 8 * HTB, NXCD = 8, WGM = 8;
__host__ __device__ __forceinline__ int lds_byte(int r, int c) { const int st = (r >> 4) * 2 + (c >> 5), rr = r & 15, cc = c & 31, ob = rr * 64 + cc * 2; return st * 1024 + (ob ^ (((ob >> 9) & 1) << 5)); }
__host__ __device__ __forceinline__ void stage_rc(int b, int& R, int& C) { const int st = b / 1024, sb = b % 1024, swz = sb ^ (((sb >> 9) & 1) << 5); R = (st >> 1) * 16 + swz / 64; C = (st & 1) * 32 + (swz % 64) / 2; }
__host__ __device__ __forceinline__ int perm32(int rho) { const int n = rho >> 4, i = rho & 15; return 8 * (i >> 2) + 4 * n + (i & 3); }
struct Unit { int pm, pn; };
struct StaticOrder {
    int nM, nN, nwg, G, c, pm0;
    __device__ void init(int M, int N, int G_, int c_, int pm0_ = 0) { pm0 = pm0_; nM = M / BM - pm0_; nN = N / BM; nwg = nM * nN; G = G_; c = c_; }
    __device__ bool next(int i, Unit& u) const {
        const long L = (long)i * G + c; if (L >= nwg) return false;
        int wgid = (int)L; { const int q = nwg / NXCD, r = nwg % NXCD, xcd = wgid % NXCD, off = wgid / NXCD; wgid = (xcd < r ? xcd * (q + 1) : r * (q + 1) + (xcd - r) * q) + off; }
        const int nig = WGM * nN, gid = wgid / nig, fm = gid * WGM, gsz = (nM - fm) < WGM ? (nM - fm) : WGM;
        u.pm = pm0 + fm + ((wgid % nig) % gsz); u.pn = (wgid % nig) / gsz; return true;
    }
};
template <class Epi, class GT>
__device__ __forceinline__ void gemm_phase(LAS unsigned char* lds, const GT g, const StaticOrder& S, const Epi& E) {
    int tid_ = threadIdx.x; asm volatile("" : "+v"(tid_));
    const int tid = tid_, wid = __builtin_amdgcn_readfirstlane(tid >> 6), lane = tid & 63, wr = wid >> 2, wc = wid & 3, fr = lane & 15, fq = lane >> 4;
    const int K = g.K, nt = K / BK;
    unsigned voffA[2], voffB[2];
#pragma unroll
    for (int i = 0; i < 2; ++i) { int R, C; stage_rc(tid * 16 + i * 8192, R, C); const int Rb = Epi::PERM ? ((R & ~31) + perm32(R & 31)) : R;
        voffA[i] = (unsigned)(R * g.lda + C) * 2u; voffB[i] = (unsigned)(Rb * g.ldb + C) * 2u; }
    const size_t kstep = (size_t)(BK * 2);
    const size_t hstepA = (size_t)HALF * g.lda * 2, hstepB = (size_t)HALF * g.ldb * 2;
    const unsigned ldsw = (unsigned)wid * 1024u;
    const int aoff = lds_byte(wr * 64 + fr, fq * 8), boff = lds_byte(wc * 32 + fr, fq * 8);
#define PG8_SA(b, h) (((b) * 2 + (h)) * HTB)
#define PG8_SB(b, h) ((4 + (b) * 2 + (h)) * HTB)
#define PG8_STAGE(bufoff, gbase, voff) do { _Pragma("unroll") for (int _i = 0; _i < 2; ++_i) \
        __builtin_amdgcn_global_load_lds((const unsigned*)((const char*)(gbase) + (voff)[_i]), (LAS unsigned*)(lds + (bufoff) + ldsw + _i * 8192), 16, 0, 0); } while (0)
#define PG8_LDA(dst, b, h) do { _Pragma("unroll") for (int m = 0; m < 4; ++m) _Pragma("unroll") for (int k = 0; k < 2; ++k) dst[m][k] = *(const LAS bf16x8*)(lds + PG8_SA(b, h) + aoff + m * 2048 + k * 1024); } while (0)
#define PG8_LDB(dst, b, h) do { _Pragma("unroll") for (int n = 0; n < 2; ++n) _Pragma("unroll") for (int k = 0; k < 2; ++k) dst[n][k] = *(const LAS bf16x8*)(lds + PG8_SB(b, h) + boff + n * 2048 + k * 1024); } while (0)
#define PG8_MMA(ai, bj, At, Bt) do { __builtin_amdgcn_s_setprio(1); _Pragma("unroll") for (int m = 0; m < 4; ++m) _Pragma("unroll") for (int n = 0; n < 2; ++n) _Pragma("unroll") for (int k = 0; k < 2; ++k) \
        acc[ai][bj][m][n] = __builtin_amdgcn_mfma_f32_16x16x32_bf16(Bt[n][k], At[m][k], acc[ai][bj][m][n], 0, 0, 0); __builtin_amdgcn_s_setprio(0); } while (0)
#define PG8_WAIT_V(n) asm volatile("s_waitcnt vmcnt(" #n ")" ::: "memory")
#define PG8_WAIT_L(n) asm volatile("s_waitcnt lgkmcnt(" #n ")" ::: "memory")
#define PG8_BAR __builtin_amdgcn_s_barrier()
#define PG8_SCHED __builtin_amdgcn_sched_barrier(0)
    Unit cur, nxt; int ui = 0;
    if (!S.next(0, cur)) return;
    f32x4 acc[2][2][4][2];
#pragma unroll
    for (int a = 0; a < 2; ++a)
#pragma unroll
        for (int b = 0; b < 2; ++b)
#pragma unroll
            for (int m = 0; m < 4; ++m)
#pragma unroll
                for (int n = 0; n < 2; ++n) acc[a][b][m][n] = (f32x4){0.f, 0.f, 0.f, 0.f};
    bf16x8 At[4][2], B0[2][2], B1[2][2];
    const char* cA = g.a_ptr(cur); const char* cB = g.b_ptr(cur);
    PG8_STAGE(PG8_SB(0, 0), cB, voffB); PG8_STAGE(PG8_SA(0, 0), cA, voffA); PG8_STAGE(PG8_SB(0, 1), cB + hstepB, voffB); PG8_STAGE(PG8_SA(0, 1), cA + hstepA, voffA);
    if (wr == 1) PG8_BAR;
    PG8_WAIT_V(4); PG8_BAR;
    PG8_STAGE(PG8_SB(1, 0), cB + kstep, voffB); PG8_STAGE(PG8_SA(1, 0), cA + kstep, voffA); PG8_STAGE(PG8_SB(1, 1), cB + hstepB + kstep, voffB);
    PG8_WAIT_V(6); PG8_BAR;
    for (;;) {
        const bool has_next = S.next(ui + 1, nxt);
        const char* nA = has_next ? g.a_ptr(nxt) : cA; const char* nB = has_next ? g.b_ptr(nxt) : cB;
        for (int t = 0; t < nt; t += 2) {
            const bool last = (t == nt - 2);
            const char* a1 = cA + (size_t)(t + 1) * kstep;
            const char* a2 = last ? nA : cA + (size_t)(t + 2) * kstep; const char* b2 = last ? nB : cB + (size_t)(t + 2) * kstep;
            const char* a3 = a2 + kstep; const char* b3 = b2 + kstep;
            PG8_LDB(B0, 0, 0); PG8_SCHED; PG8_LDA(At, 0, 0); PG8_STAGE(PG8_SA(1, 1), a1 + hstepA, voffA);
            PG8_WAIT_L(8); PG8_BAR; PG8_WAIT_L(0); PG8_MMA(0, 0, At, B0); PG8_BAR; PG8_SCHED;
            PG8_LDB(B1, 0, 1); PG8_STAGE(PG8_SB(0, 0), b2, voffB);
            PG8_BAR; PG8_WAIT_L(0); PG8_MMA(0, 1, At, B1); PG8_BAR;
            PG8_LDA(At, 0, 1); PG8_STAGE(PG8_SA(0, 0), a2, voffA);
            PG8_BAR; PG8_WAIT_L(0); PG8_MMA(1, 0, At, B0); PG8_BAR; PG8_SCHED;
            PG8_STAGE(PG8_SB(0, 1), b2 + hstepB, voffB);
            PG8_WAIT_V(6); PG8_BAR; PG8_MMA(1, 1, At, B1); PG8_BAR;
            PG8_LDB(B0, 1, 0); PG8_SCHED; PG8_LDA(At, 1, 0); PG8_STAGE(PG8_SA(0, 1), a2 + hstepA, voffA);
            PG8_WAIT_L(8); PG8_BAR; PG8_WAIT_L(0); PG8_MMA(0, 0, At, B0); PG8_BAR; PG8_SCHED;
            PG8_LDB(B1, 1, 1); PG8_STAGE(PG8_SB(1, 0), b3, voffB);
            PG8_BAR; PG8_WAIT_L(0); PG8_MMA(0, 1, At, B1); PG8_BAR;
            PG8_LDA(At, 1, 1); PG8_STAGE(PG8_SA(1, 0), a3, voffA);
            PG8_BAR; PG8_WAIT_L(0); PG8_MMA(1, 0, At, B0); PG8_BAR; PG8_SCHED;
            PG8_STAGE(PG8_SB(1, 1), b3 + hstepB, voffB);
            PG8_WAIT_V(6); PG8_BAR; PG8_MMA(1, 1, At, B1); PG8_BAR;
        }
        E(acc, cur, wr, wc, fr, fq);
        if (!has_next) break;
#pragma unroll
        for (int a = 0; a < 2; ++a)
#pragma unroll
            for (int b = 0; b < 2; ++b)
#pragma unroll
                for (int m = 0; m < 4; ++m)
#pragma unroll
                    for (int n = 0; n < 2; ++n) acc[a][b][m][n] = (f32x4){0.f, 0.f, 0.f, 0.f};
        cur = nxt; cA = nA; cB = nB; ++ui;
    }
    PG8_WAIT_V(0);
    if (wr == 0) PG8_BAR;
    PG8_BAR;
#undef PG8_SA
#undef PG8_SB
#undef PG8_STAGE
#undef PG8_LDA
#undef PG8_LDB
#undef PG8_MMA
#undef PG8_WAIT_V
#undef PG8_WAIT_L
#undef PG8_BAR
#undef PG8_SCHED
}
}
using pg8::Unit;
typedef const f32x4 (&AccRef)[2][2][4][2];

#define XB_TMO      128
#define XB_XCNT(j)  (256  + 64 * (j))
#define XB_XSUB(j)  (1280 + 64 * (j))
#define XB_XGEN(j)  (2304 + 64 * (j))
#define XB_TOP      3328
#define XB_TOPGEN   3392
#define XCD_BAR_WORDS 3456
#define XB_SPIN_CAP (1u << 18)
__device__ __forceinline__ unsigned xb_ld(unsigned* p)              { return __hip_atomic_load(p, __ATOMIC_RELAXED, __HIP_MEMORY_SCOPE_AGENT); }
__device__ __forceinline__ unsigned xb_add(unsigned* p, unsigned v) { return __hip_atomic_fetch_add(p, v, __ATOMIC_RELAXED, __HIP_MEMORY_SCOPE_AGENT); }
__device__ __forceinline__ unsigned xb_xcc_id() { return (unsigned)__builtin_amdgcn_s_getreg((3 << 11) | 20) & 0xFu; }
#define XB_SPIN(cond, bar) do { unsigned _sp = 0; while (cond) { __builtin_amdgcn_s_sleep(1); \
    if ((++_sp & 255u) == 0u) { if (xb_ld(&(bar)[XB_TMO])) break; if (_sp > XB_SPIN_CAP) { atomicAdd(&(bar)[XB_TMO], 1u); break; } } } } while (0)
struct XcdBarrier { unsigned* bar; unsigned x; volatile LAS unsigned* st; };
__device__ __forceinline__ XcdBarrier xcd_barrier_post(unsigned* bar, volatile LAS unsigned* st) {
    XcdBarrier b; b.bar = bar; b.x = xb_xcc_id(); b.st = st;
    if (threadIdx.x == 0) (void)xb_add(&bar[XB_XCNT(b.x)], 1u);
    return b;
}
__device__ __forceinline__ void xcd_barrier_complete(unsigned* bar, unsigned x, unsigned& nloc, unsigned& nx) {
    const unsigned G = gridDim.x * gridDim.y * gridDim.z;
    unsigned sum, cnt, mine, sp = 0u;
    for (;;) {
        sum = 0u; cnt = 0u; mine = 0u;
#pragma unroll
        for (unsigned j = 0; j < 16; ++j) { const unsigned c = xb_ld(&bar[XB_XCNT(j)]); sum += c; cnt += (c > 0u) ? 1u : 0u; mine = (j == x) ? c : mine; }
        if (sum == G) break;
        __builtin_amdgcn_s_sleep(1);
        if ((++sp & 255u) == 0u) { if (xb_ld(&bar[XB_TMO])) break; if (sp > XB_SPIN_CAP) { atomicAdd(&bar[XB_TMO], 1u); break; } }
    }
    nloc = mine > 0u ? mine : 1u; nx = cnt > 0u ? cnt : 1u;
}
__device__ __forceinline__ void xcd_barrier(const XcdBarrier& b) {
    asm volatile("s_waitcnt vmcnt(0)" ::: "memory");
    __syncthreads();
    if (threadIdx.x == 0) {
        unsigned* bar = b.bar;
        __builtin_amdgcn_s_waitcnt(0);
        unsigned nloc = b.st[0], nx = b.st[1];
        if (nloc == 0u) { xcd_barrier_complete(bar, b.x, nloc, nx); b.st[0] = nloc; b.st[1] = nx; }
        const unsigned old = xb_add(&bar[XB_XSUB(b.x)], 1u);
        const unsigned gen = old / nloc;
        if (old + 1u == (gen + 1u) * nloc) {
            __builtin_amdgcn_fence(__ATOMIC_RELEASE, "agent");
            asm volatile("s_waitcnt vmcnt(0)" ::: "memory");
            const unsigned og = xb_add(&bar[XB_TOP], 1u);
            const unsigned tg = og / nx;
            if (og + 1u == (tg + 1u) * nx) xb_add(&bar[XB_TOPGEN], 1u);
            else XB_SPIN(xb_ld(&bar[XB_TOPGEN]) == tg, bar);
            __builtin_amdgcn_fence(__ATOMIC_ACQUIRE, "agent");
            xb_add(&bar[XB_XGEN(b.x)], 1u);
            asm volatile("s_waitcnt vmcnt(0)" ::: "memory");
        } else {
            XB_SPIN(xb_ld(&bar[XB_XGEN(b.x)]) == gen, bar);
            __builtin_amdgcn_fence(__ATOMIC_ACQUIRE, "agent");
            asm volatile("s_waitcnt vmcnt(0)" ::: "memory");
        }
    }
    __syncthreads();
}

struct Params { const float* in[37]; float* out; unsigned char* ws; };
typedef const __attribute__((address_space(4))) Params* KP;
__device__ __forceinline__ KP kp_fresh() { KP p = (KP)__builtin_amdgcn_kernarg_segment_ptr(); asm volatile("" : "+s"(p)); return p; }
enum { I_X = 0, I_C, I_CTX, I_CCTX, I_ADAW, I_ADAB, I_LNG, I_LNB, I_PWQ, I_PKEYS, I_PU, I_PV, I_RGWIN, I_RGCW, I_RGCB, I_RGGW, I_RGGB, I_RGLAM, I_RGWOUT,
       I_RWMU, I_RWRKV, I_RWWO, I_RWDEC0, I_RWDEC1, I_RWDEC2, I_RWICL0, I_RWICL1, I_RWICL2, I_RWG1, I_RWG2, I_RWKK, I_RWKA, I_RWRK, I_RWGNG, I_RWGNB, I_RETWIN, I_RETWOUT };
constexpr int LDS_BYTES = 147456;
constexpr int MISC_OFF = 147200;

__device__ __forceinline__ const float* modp(KP P, int layer, int v, int slot) { return (const float*)(P->ws + WS_MOD) + ((size_t)(layer * 5 + v) * 6 + slot) * D; }

struct GPlain { const bf16_t* A; const bf16_t* Bt; int K, lda, ldb;
    __device__ __forceinline__ const char* a_ptr(const Unit& u) const { return (const char*)(A + (size_t)u.pm * 256 * lda); }
    __device__ __forceinline__ const char* b_ptr(const Unit& u) const { return (const char*)(Bt + (size_t)u.pn * 256 * ldb); } };
struct GGate { const bf16_t* A; const bf16_t* Bt; int K, lda, ldb;
    __device__ __forceinline__ const char* a_ptr(const Unit& u) const { return (const char*)(A + (size_t)u.pm * 256 * lda + ((u.pn >> 1) & 7) * 256); }
    __device__ __forceinline__ const char* b_ptr(const Unit& u) const { return (const char*)(Bt + (size_t)u.pn * 256 * ldb); } };
struct GScore { const bf16_t* A; const bf16_t* Bt; int K, lda, ldb;
    __device__ __forceinline__ const char* a_ptr(const Unit& u) const { return (const char*)(A + (size_t)u.pm * 256 * lda + u.pn * 256); }
    __device__ __forceinline__ const char* b_ptr(const Unit& u) const { return (const char*)(Bt + (size_t)u.pn * 256 * ldb); } };
struct GFold { const bf16_t* A; const bf16_t* Bt; int K, lda, ldb;
    __device__ __forceinline__ const char* a_ptr(const Unit& u) const { return (const char*)(A + (size_t)u.pm * 256 * lda); }
    __device__ __forceinline__ const char* b_ptr(const Unit& u) const { return (const char*)(Bt + (size_t)(u.pm >> 3) * D * D + (size_t)u.pn * 256 * ldb + (u.pm & 7) * 256); } };
struct GRw1 { const bf16_t* A; const bf16_t* Bt; int K, lda, ldb;
    __device__ __forceinline__ const char* a_ptr(const Unit& u) const { const int blk = u.pn < 24 ? (u.pn >> 3) : (u.pn - 21); return (const char*)(A + (size_t)u.pm * 256 * lda + blk * 2048); }
    __device__ __forceinline__ const char* b_ptr(const Unit& u) const { return (const char*)(Bt + (size_t)u.pn * 256 * ldb); } };
struct GRw2 { const bf16_t* A; const bf16_t* Bt; int K, lda, ldb;
    __device__ __forceinline__ const char* a_ptr(const Unit& u) const { const int blk = u.pn < 16 ? 0 : (u.pn < 32 ? 1 : 2); return (const char*)(A + (size_t)u.pm * 256 * lda + blk * 256); }
    __device__ __forceinline__ const char* b_ptr(const Unit& u) const { return (const char*)(Bt + (size_t)u.pn * 256 * ldb); } };

template <int ACT> __device__ __forceinline__ float actf(float x) {
    if (ACT == 1) return gelu_tanh(x); if (ACT == 2) return tanhf_(x); if (ACT == 3) return sigmoidf_(x); if (ACT == 4) return siluf_(x); return x; }
template <int ACT> __device__ __forceinline__ void store_tile_bf16(AccRef acc, bf16_t* dst, int ld, int row0, int col0) {
#pragma unroll
    for (int ai = 0; ai < 2; ++ai)
#pragma unroll
        for (int m = 0; m < 4; ++m) { bf16_t* rowp = dst + (size_t)(row0 + ai * 128 + m * 16) * ld + col0;
#pragma unroll
            for (int bj = 0; bj < 2; ++bj) { const f32x4 v0 = acc[ai][bj][m][0], v1 = acc[ai][bj][m][1];
                u32x4 w; w.x = cvt_pk_bf16(actf<ACT>(v0[0]), actf<ACT>(v0[1])); w.y = cvt_pk_bf16(actf<ACT>(v0[2]), actf<ACT>(v0[3]));
                w.z = cvt_pk_bf16(actf<ACT>(v1[0]), actf<ACT>(v1[1])); w.w = cvt_pk_bf16(actf<ACT>(v1[2]), actf<ACT>(v1[3]));
                *(u32x4*)(rowp + bj * 128) = w; } }
}
struct EpiBf16Plain { static constexpr bool PERM = true; bf16_t* O; int ldc;
    __device__ __forceinline__ void operator()(AccRef acc, const Unit& u, int wr, int wc, int fr, int fq) const {
        store_tile_bf16<0>(acc, O, ldc, u.pm * 256 + wr * 64 + fr, u.pn * 256 + wc * 32 + 8 * fq); } };
struct EpiF32Plain { static constexpr bool PERM = false; float* C; int ldc;
    __device__ __forceinline__ void operator()(AccRef acc, const Unit& u, int wr, int wc, int fr, int fq) const {
        const int row0 = u.pm * 256 + wr * 64 + fr, col0 = u.pn * 256 + wc * 32 + 4 * fq;
#pragma unroll
        for (int ai = 0; ai < 2; ++ai)
#pragma unroll
            for (int m = 0; m < 4; ++m) { float* rowp = C + (size_t)(row0 + ai * 128 + m * 16) * ldc + col0;
#pragma unroll
                for (int bj = 0; bj < 2; ++bj)
#pragma unroll
                    for (int n = 0; n < 2; ++n) *(f32x4*)(rowp + bj * 128 + n * 16) = acc[ai][bj][m][n]; } } };
struct GSplitK { const bf16_t* A; const bf16_t* Bt; int K, lda, ldb;
    __device__ __forceinline__ const char* a_ptr(const Unit& u) const { return (const char*)(A + (size_t)u.pm * 256 * lda + (u.pn >> 3) * 512); }
    __device__ __forceinline__ const char* b_ptr(const Unit& u) const { return (const char*)(Bt + (size_t)(u.pn & 7) * 256 * ldb + (u.pn >> 3) * 512); } };
struct EpiPartial { static constexpr bool PERM = false; float* PX;
    __device__ __forceinline__ void operator()(AccRef acc, const Unit& u, int wr, int wc, int fr, int fq) const {
        const int row0 = u.pm * 256 + wr * 64 + fr, col0 = (u.pn & 7) * 256 + wc * 32 + 4 * fq; float* base = PX + (size_t)(u.pn >> 3) * NCTX * D;
#pragma unroll
        for (int ai = 0; ai < 2; ++ai)
#pragma unroll
            for (int m = 0; m < 4; ++m) { float* rowp = base + (size_t)(row0 + ai * 128 + m * 16) * D + col0;
#pragma unroll
                for (int bj = 0; bj < 2; ++bj)
#pragma unroll
                    for (int n = 0; n < 2; ++n) *(f32x4*)(rowp + bj * 128 + n * 16) = acc[ai][bj][m][n]; } } };
struct EpiResid { static constexpr bool PERM = false; float* X; const float* gate_base; float ymul;
    __device__ __forceinline__ void operator()(AccRef acc, const Unit& u, int wr, int wc, int fr, int fq) const {
        const int row0 = u.pm * 256 + wr * 64 + fr, col0 = u.pn * 256 + wc * 32 + 4 * fq;
        const float* gp = gate_base + (size_t)panel_vec(u.pm) * 6 * D + col0;
        f32x4 gv[2][2];
#pragma unroll
        for (int bj = 0; bj < 2; ++bj)
#pragma unroll
            for (int n = 0; n < 2; ++n) gv[bj][n] = *(const f32x4*)(gp + bj * 128 + n * 16);
#pragma unroll
        for (int ai = 0; ai < 2; ++ai)
#pragma unroll
            for (int m = 0; m < 4; ++m) { float* rowp = X + (size_t)(row0 + ai * 128 + m * 16) * D + col0;
#pragma unroll
                for (int bj = 0; bj < 2; ++bj)
#pragma unroll
                    for (int n = 0; n < 2; ++n) { f32x4* p = (f32x4*)(rowp + bj * 128 + n * 16); const f32x4 x = *p; *p = x * ALPHA + gv[bj][n] * (acc[ai][bj][m][n] * ymul); } } } };
struct EpiRgIn { static constexpr bool PERM = true; bf16_t* UG; bf16_t* UR;
    __device__ __forceinline__ void operator()(AccRef acc, const Unit& u, int wr, int wc, int fr, int fq) const {
        const int row0 = u.pm * 256 + wr * 64 + fr, col0 = (u.pn & 7) * 256 + wc * 32 + 8 * fq;
        if (u.pn < 8) store_tile_bf16<1>(acc, UG, D, row0, col0); else store_tile_bf16<0>(acc, UR, D, row0, col0); } };
struct EpiRgGate { static constexpr bool PERM = true; const bf16_t* XC; bf16_t* LA; bf16_t* BB; const float* gate_b; const float* spt;
    __device__ __forceinline__ void operator()(AccRef acc, const Unit& u, int wr, int wc, int fr, int fq) const {
        const int d = u.pn >> 4, ch0 = ((u.pn >> 1) & 7) * 256 + (u.pn & 1) * 128 + wc * 32 + 8 * fq;
        const int row0 = u.pm * 256 + wr * 64 + fr;
        float br[8], bi[8], sp[8];
#pragma unroll
        for (int j = 0; j < 8; ++j) { br[j] = gate_b[(d * 2 + 0) * D + ch0 + j]; bi[j] = gate_b[(d * 2 + 1) * D + ch0 + j];
            sp[j] = spt[d * D + ch0 + j]; }
        u32x4 xr8[8];
#pragma unroll
        for (int q = 0; q < 8; ++q) xr8[q] = *(const u32x4*)(XC + (size_t)(row0 + (q >> 2) * 128 + (q & 3) * 16) * D + ch0);
#pragma unroll
        for (int ai = 0; ai < 2; ++ai)
#pragma unroll
            for (int m = 0; m < 4; ++m) { const int row = row0 + ai * 128 + m * 16;
                const u32x4 xr = xr8[ai * 4 + m];
                float xc[8] = {bflo(xr.x), bfhi(xr.x), bflo(xr.y), bfhi(xr.y), bflo(xr.z), bfhi(xr.z), bflo(xr.w), bfhi(xr.w)};
                float la[8], bb[8];
#pragma unroll
                for (int j = 0; j < 8; ++j) { const float ar = acc[ai][0][m][j >> 2][j & 3], ai_ = acc[ai][1][m][j >> 2][j & 3];
                    const float rg = sigmoidf_(ar + br[j]), ig = sigmoidf_(ai_ + bi[j]);
                    const float l = sp[j] * rg; la[j] = l; bb[j] = sqrtf(1.0f - __expf(2.0f * l)) * (ig * xc[j]); }
                u32x4 w; w.x = cvt_pk_bf16(la[0], la[1]); w.y = cvt_pk_bf16(la[2], la[3]); w.z = cvt_pk_bf16(la[4], la[5]); w.w = cvt_pk_bf16(la[6], la[7]);
                *(u32x4*)(LA + ((size_t)row * 2 + d) * D + ch0) = w;
                w.x = cvt_pk_bf16(bb[0], bb[1]); w.y = cvt_pk_bf16(bb[2], bb[3]); w.z = cvt_pk_bf16(bb[4], bb[5]); w.w = cvt_pk_bf16(bb[6], bb[7]);
                *(u32x4*)(BB + ((size_t)row * 2 + d) * D + ch0) = w; } } };
struct EpiRw1 { static constexpr bool PERM = true; bf16_t* RKV; bf16_t* A2;
    __device__ __forceinline__ void operator()(AccRef acc, const Unit& u, int wr, int wc, int fr, int fq) const {
        const int row0 = u.pm * 256 + wr * 64 + fr, cw = wc * 32 + 8 * fq;
        if (u.pn < 24) store_tile_bf16<0>(acc, RKV + (size_t)(u.pn >> 3) * TD, D, row0, (u.pn & 7) * 256 + cw);
        else if (u.pn == 24) store_tile_bf16<2>(acc, A2, 768, row0, cw);
        else if (u.pn == 25) store_tile_bf16<0>(acc, A2, 768, row0, 256 + cw);
        else store_tile_bf16<3>(acc, A2, 768, row0, 512 + cw); } };
struct EpiRw2 { static constexpr bool PERM = true; bf16_t* W; bf16_t* AD; bf16_t* G; const float* dec0; const float* icl0;
    __device__ __forceinline__ void operator()(AccRef acc, const Unit& u, int wr, int wc, int fr, int fq) const {
        const int row0 = u.pm * 256 + wr * 64 + fr, c0 = (u.pn & 7) * 256 + wc * 32 + 8 * fq;
        if (u.pn >= 32) { store_tile_bf16<0>(acc, G, D, row0, c0); return; }
        const int isa = u.pn >= 16, d = (u.pn >> 3) & 1;
        const float* bias = (isa ? icl0 : dec0) + d * D + c0;
        bf16_t* dst = (isa ? AD : W);
        float bv[2][8];
#pragma unroll
        for (int bj = 0; bj < 2; ++bj)
#pragma unroll
            for (int j = 0; j < 8; ++j) bv[bj][j] = bias[bj * 128 + j];
#pragma unroll
        for (int ai = 0; ai < 2; ++ai)
#pragma unroll
            for (int m = 0; m < 4; ++m) { const int row = row0 + ai * 128 + m * 16;
#pragma unroll
                for (int bj = 0; bj < 2; ++bj) { float o[8];
#pragma unroll
                    for (int j = 0; j < 8; ++j) { const float s = sigmoidf_(acc[ai][bj][m][j >> 2][j & 3] + bv[bj][j]); o[j] = isa ? s : __expf(-0.6065306597126334f * s); }
                    u32x4 w; w.x = cvt_pk_bf16(o[0], o[1]); w.y = cvt_pk_bf16(o[2], o[3]); w.z = cvt_pk_bf16(o[4], o[5]); w.w = cvt_pk_bf16(o[6], o[7]);
                    *(u32x4*)(dst + ((size_t)row * 2 + d) * D + c0 + bj * 128) = w; } } } };
struct EpiRetIn { static constexpr bool PERM = true; bf16_t* Q; bf16_t* Kk; bf16_t* V; bf16_t* GF; bf16_t* GB; const float* CS;
    __device__ __forceinline__ void operator()(AccRef acc, const Unit& u, int wr, int wc, int fr, int fq) const {
        const int row0 = u.pm * 256 + wr * 64 + fr, cw = wc * 32 + 8 * fq;
        if (u.pn >= 48) { store_tile_bf16<4>(acc, GB, 4096, row0, (u.pn - 48) * 256 + cw); return; }
        if (u.pn >= 32) { store_tile_bf16<4>(acc, GF, 4096, row0, (u.pn - 32) * 256 + cw); return; }
        if (u.pn >= 16) { store_tile_bf16<0>(acc, V, 4096, row0, (u.pn - 16) * 256 + cw); return; }
        const float sc = u.pn >= 8 ? 0.0625f : 1.0f; bf16_t* dst = u.pn >= 8 ? Kk : Q; const int hc = (u.pn & 7) * 256;
#pragma unroll
        for (int ai = 0; ai < 2; ++ai) { f32x4 cs4[4][4];
#pragma unroll
            for (int m = 0; m < 4; ++m) { const float* cs_ = CS + ((size_t)row_pos(row0 + ai * 128 + m * 16) * 128 + cw) * 2;
#pragma unroll
                for (int q = 0; q < 4; ++q) cs4[m][q] = *(const f32x4*)(cs_ + 4 * q); }
#pragma unroll
            for (int m = 0; m < 4; ++m) { const int row = row0 + ai * 128 + m * 16;
                float o1[8], o2[8];
#pragma unroll
                for (int j = 0; j < 8; ++j) { const float co = cs4[m][j >> 1][(2 * j) & 3], si = cs4[m][j >> 1][(2 * j + 1) & 3]; const float t1 = acc[ai][0][m][j >> 2][j & 3], t2 = acc[ai][1][m][j >> 2][j & 3];
                    o1[j] = (t1 * co - t2 * si) * sc; o2[j] = (t1 * si + t2 * co) * sc; }
                u32x4 w; w.x = cvt_pk_bf16(o1[0], o1[1]); w.y = cvt_pk_bf16(o1[2], o1[3]); w.z = cvt_pk_bf16(o1[4], o1[5]); w.w = cvt_pk_bf16(o1[6], o1[7]);
                *(u32x4*)(dst + (size_t)row * D + hc + cw) = w;
                w.x = cvt_pk_bf16(o2[0], o2[1]); w.y = cvt_pk_bf16(o2[2], o2[3]); w.z = cvt_pk_bf16(o2[4], o2[5]); w.w = cvt_pk_bf16(o2[6], o2[7]);
                *(u32x4*)(dst + (size_t)row * D + hc + 128 + cw) = w; } } } };

#define LDS_WAIT() asm volatile("s_waitcnt lgkmcnt(0)" ::: "memory")
struct Ctx { LAS unsigned char* lds; int tid, lane, wave, gw, ngw, gtid, ngt; };

__device__ __forceinline__ void transpose_item(const float* W, int ldw, bf16_t* WT, int ldt, int k0, int n0, int dst_row0, LAS float* scr, int lane) {
#pragma unroll
    for (int i = 0; i < 8; ++i) { const int kk = 8 * i + (lane >> 3), nn = (lane & 7) * 4; const f32x4 wv = *(const f32x4*)(W + (size_t)(k0 + kk) * ldw + n0 + nn);
        LAS float* d = scr + kk * 33 + nn; d[0] = wv[0]; d[1] = wv[1]; d[2] = wv[2]; d[3] = wv[3]; }
    LDS_WAIT(); asm volatile("" ::: "memory");
    const int c = lane & 7;
#pragma unroll
    for (int j = 0; j < 4; ++j) { const int n = (lane >> 3) + 8 * j; const LAS float* s = scr + (8 * c) * 33 + n;
        u32x4 o; o.x = cvt_pk_bf16(s[0 * 33], s[1 * 33]); o.y = cvt_pk_bf16(s[2 * 33], s[3 * 33]); o.z = cvt_pk_bf16(s[4 * 33], s[5 * 33]); o.w = cvt_pk_bf16(s[6 * 33], s[7 * 33]);
        *(u32x4*)(WT + (size_t)(dst_row0 + n) * ldt + k0 + 8 * c) = o; }
    LDS_WAIT(); asm volatile("" ::: "memory");
}
__device__ __forceinline__ void tr_job(const Ctx& c, int& rot, const float* W, int K, int N, int ldw, bf16_t* WT, int ldt, int row_off) {
    LAS float* scr = (LAS float*)(c.lds + c.wave * 16384);
    const int nblk = N / 32, items = (K / 64) * nblk;
    int first = c.gw - (rot % c.ngw); if (first < 0) first += c.ngw;
    int lane = c.lane; asm volatile("" : "+v"(lane));
    f32x4 r[8];
#define TR_LOAD(it_) do { const int kb_ = (it_) / nblk, nb_ = (it_) % nblk; _Pragma("unroll") for (int i = 0; i < 8; ++i) r[i] = *(const f32x4*)(W + (size_t)(kb_ * 64 + 8 * i + (lane >> 3)) * ldw + nb_ * 32 + (lane & 7) * 4); } while (0)
    if (first < items) TR_LOAD(first);
    for (int it = first; it < items; it += c.ngw) { const int kb = it / nblk, nb = it % nblk;
#pragma unroll
        for (int i = 0; i < 8; ++i) { LAS float* d = scr + (8 * i + (lane >> 3)) * 33 + (lane & 7) * 4; d[0] = r[i][0]; d[1] = r[i][1]; d[2] = r[i][2]; d[3] = r[i][3]; }
        if (it + c.ngw < items) TR_LOAD(it + c.ngw);
        LDS_WAIT(); asm volatile("" ::: "memory");
        const int cc = lane & 7;
#pragma unroll
        for (int j = 0; j < 4; ++j) { const int n = (lane >> 3) + 8 * j; const LAS float* sp = scr + (8 * cc) * 33 + n;
            u32x4 o; o.x = cvt_pk_bf16(sp[0 * 33], sp[1 * 33]); o.y = cvt_pk_bf16(sp[2 * 33], sp[3 * 33]); o.z = cvt_pk_bf16(sp[4 * 33], sp[5 * 33]); o.w = cvt_pk_bf16(sp[6 * 33], sp[7 * 33]);
            *(u32x4*)(WT + (size_t)(row_off + nb * 32 + n) * ldt + kb * 64 + 8 * cc) = o; }
        LDS_WAIT(); asm volatile("" ::: "memory"); }
#undef TR_LOAD
    rot += items;
}

__device__ __forceinline__ void peer_convert_rows(KP P, const Ctx& c, int g_lo, int g_hi, int rank, int nranks) {
    unsigned char* ws = P->ws;
    f32x4 xn[2][8];
#define CV_LOAD(g0_) do { _Pragma("unroll") for (int h = 0; h < 2; ++h) { const int g = ((g0_) + h < g_hi) ? (g0_) + h : (g0_); const int lt = g >> 14, e = g & 16383, layer = lt >> 1, t = lt & 1; \
            const float* sp = P->in[t ? I_PV : I_PU] + ((size_t)layer * 16384 + e) * D + c.lane * 16; \
            _Pragma("unroll") for (int q = 0; q < 8; ++q) xn[h][q] = *(const f32x4*)(sp + (q >> 2) * 1024 + (q & 3) * 4); } } while (0)
    { const int gf = g_lo + (rank * 8 + c.wave) * 2; if (gf < g_hi) CV_LOAD(gf); }
    for (int g0 = g_lo + (rank * 8 + c.wave) * 2; g0 < g_hi; g0 += nranks * 16) {
        f32x4 x[2][8]; float am[2] = {0.f, 0.f};
#pragma unroll
        for (int h = 0; h < 2; ++h)
#pragma unroll
            for (int q = 0; q < 8; ++q) x[h][q] = xn[h][q];
        if (g0 + nranks * 16 < g_hi) CV_LOAD(g0 + nranks * 16);
#pragma unroll
        for (int h = 0; h < 2; ++h) { if (g0 + h >= g_hi) break;
            const int g = g0 + h; const int lt = g >> 14, e = g & 16383, layer = lt >> 1, t = lt & 1;
#pragma unroll
            for (int q = 0; q < 8; ++q) am[h] = fmaxf(am[h], fmaxf(fmaxf(fabsf(x[h][q][0]), fabsf(x[h][q][1])), fmaxf(fabsf(x[h][q][2]), fabsf(x[h][q][3]))));
            const float a = wave_max(am[h]);
            const float sc = a > 0.f ? exp2f(floorf(log2f(384.0f / a))) : 1.0f;
            if (c.lane == 0) ((float*)(ws + WS_PSC))[(size_t)t * 4 * 16384 + layer * 16384 + e] = 1.0f / sc;
            unsigned char* dst = ws + (t ? WS_PV : WS_PU) + (size_t)layer * 16384 * D;
#pragma unroll
            for (int jj = 0; jj < 2; ++jj) { u32x4 o;
#pragma unroll
                for (int w = 0; w < 4; ++w) { const f32x4 v = x[h][jj * 4 + w] * sc; int p = 0; p = __builtin_amdgcn_cvt_pk_fp8_f32(v[0], v[1], p, false); p = __builtin_amdgcn_cvt_pk_fp8_f32(v[2], v[3], p, true); o[w] = (unsigned)p; }
                const int db = (c.lane >> 3) + 8 * jj;
                *(u32x4*)(dst + ((size_t)db * 16384 + e) * 128 + (c.lane & 7) * 16) = o; } } }
#undef CV_LOAD
}
__device__ __forceinline__ void phase_prologue(KP P, const Ctx& c) {
    unsigned char* ws = P->ws;
    PROBE_REP(14) {
        LAS float* sl = (LAS float*)c.lds;
        LAS float* red = sl + 1280;
        for (int un = blockIdx.x; un < 4 * 24 * 8; un += gridDim.x) {
            const int layer = un / 192, r = un % 192, nb = r / 8, kc = r % 8;
            __syncthreads();
            for (int i = c.tid; i < 5 * 256; i += 512) { const int v = i >> 8, k = kc * 256 + (i & 255); const float x = v < 4 ? P->in[I_C][v * D + k] : P->in[I_CCTX][k]; sl[i] = siluf_(x); }
            __syncthreads();
            const int cg = c.tid & 127, ks = c.tid >> 7;
            const float* w = P->in[I_ADAW] + ((size_t)layer * D + kc * 256 + ks * 64) * 12288 + nb * 512 + cg * 4;
            f32x4 a0 = (f32x4){0.f, 0.f, 0.f, 0.f}, a1 = a0, a2 = a0, a3 = a0, a4 = a0;
            f32x4 wn[8];
#pragma unroll
            for (int i = 0; i < 8; ++i) wn[i] = *(const f32x4*)(w + (size_t)i * 12288);
#pragma unroll 1
            for (int k0 = 0; k0 < 64; k0 += 8) { f32x4 wc[8];
#pragma unroll
                for (int i = 0; i < 8; ++i) wc[i] = wn[i];
                if (k0 + 8 < 64) {
#pragma unroll
                    for (int i = 0; i < 8; ++i) wn[i] = *(const f32x4*)(w + (size_t)(k0 + 8 + i) * 12288); }
#pragma unroll
                for (int i = 0; i < 8; ++i) { const f32x4 wv = wc[i]; const int kk = ks * 64 + k0 + i;
                    a0 += wv * sl[kk]; a1 += wv * sl[256 + kk]; a2 += wv * sl[512 + kk]; a3 += wv * sl[768 + kk]; a4 += wv * sl[1024 + kk]; } }
            LAS float* rp = red + (ks * 5) * 512 + cg * 4;
            *(LAS f32x4*)(rp) = a0; *(LAS f32x4*)(rp + 512) = a1; *(LAS f32x4*)(rp + 1024) = a2; *(LAS f32x4*)(rp + 1536) = a3; *(LAS f32x4*)(rp + 2048) = a4;
            __syncthreads();
            for (int i = c.tid; i < 5 * 512; i += 512) { const int v = i >> 9, n = i & 511;
                const float sum = (red[(0 * 5 + v) * 512 + n] + red[(1 * 5 + v) * 512 + n]) + (red[(2 * 5 + v) * 512 + n] + red[(3 * 5 + v) * 512 + n]);
                ((float*)(ws + WS_MODP))[((size_t)(layer * 8 + kc) * 5 + v) * 12288 + nb * 512 + n] = sum; }
        }
        __syncthreads();
    }
    PROBE_REP(16) {
    int rot = 0;
    for (int j = 0; j < 2; ++j) {
        tr_job(c, rot, P->in[I_RGWIN] + (size_t)j * D * 4096, D, 4096, 4096, (bf16_t*)(ws + WS_RGIN) + (size_t)j * 4096 * D, D, 0);
        tr_job(c, rot, P->in[I_RGWOUT] + (size_t)j * D * D, D, D, D, (bf16_t*)(ws + WS_RGOUT) + (size_t)j * D * D, D, 0);
    }
    {
        LAS float* scr = (LAS float*)(c.lds + c.wave * 16384);
        const int items = 64 * 32;
        int first = c.gw - (rot % c.ngw); if (first < 0) first += c.ngw;
        for (int it = first; it < items; it += c.ngw) {
            const int mat = it >> 5, sub = it & 31, kb = sub >> 3, nb32 = sub & 7;
            const int jl = mat >> 5, d = (mat >> 4) & 1, g = (mat >> 3) & 1, nblk = mat & 7;
            const int n0 = nb32 * 32, hf = n0 >> 7, pn = (d * 8 + nblk) * 2 + hf;
            transpose_item(P->in[I_RGGW] + (size_t)mat * 65536, 256, (bf16_t*)(ws + WS_RGGATE) + (size_t)jl * 8192 * 256, 256, kb * 64, n0, pn * 256 + g * 128 + (n0 & 127), scr, c.lane);
        }
        rot += items;
    }
    for (int m = 0; m < 3; ++m) tr_job(c, rot, P->in[I_RWRKV] + (size_t)m * D * D, D, D, D, (bf16_t*)(ws + WS_RW1), D, m * D);
    for (int d = 0; d < 2; ++d) {
        tr_job(c, rot, P->in[I_RWDEC1] + (size_t)d * D * 96, D, 96, 96, (bf16_t*)(ws + WS_RW1), D, 6144 + d * 96);
        tr_job(c, rot, P->in[I_RWICL1] + (size_t)d * D * 96, D, 96, 96, (bf16_t*)(ws + WS_RW1), D, 6400 + d * 96);
    }
    tr_job(c, rot, P->in[I_RWG1], D, 256, 256, (bf16_t*)(ws + WS_RW1), D, 6656);
    tr_job(c, rot, P->in[I_RWWO], D, D, D, (bf16_t*)(ws + WS_RWO), D, 0);
    tr_job(c, rot, P->in[I_RETWIN], D, 16384, 16384, (bf16_t*)(ws + WS_RETIN), D, 0);
    tr_job(c, rot, P->in[I_RETWOUT], 4096, D, D, (bf16_t*)(ws + WS_RETOUT), 4096, 0);
    }
    PROBE_REP(17) {
    for (size_t i0 = c.gtid; i0 < (size_t)4 * D * D / 8; i0 += 4 * (size_t)c.ngt) { f32x4 a[4], b[4];
#pragma unroll
        for (int u = 0; u < 4; ++u) { const size_t i = i0 + (size_t)u * c.ngt; if (i < (size_t)4 * D * D / 8) { a[u] = *(const f32x4*)(P->in[I_PWQ] + i * 8); b[u] = *(const f32x4*)(P->in[I_PWQ] + i * 8 + 4); } }
#pragma unroll
        for (int u = 0; u < 4; ++u) { const size_t i = i0 + (size_t)u * c.ngt; if (i < (size_t)4 * D * D / 8)
            *(u32x4*)((bf16_t*)(ws + WS_WQN) + i * 8) = (u32x4){cvt_pk_bf16(a[u][0], a[u][1]), cvt_pk_bf16(a[u][2], a[u][3]), cvt_pk_bf16(b[u][0], b[u][1]), cvt_pk_bf16(b[u][2], b[u][3])}; } }
    for (int i = c.gtid; i < 2 * 64 * (D / 8); i += c.ngt) { const int blk = i / (64 * (D / 8)), r = (i / (D / 8)) % 64, c8 = i % (D / 8);
        *(u32x4*)((bf16_t*)(ws + WS_RW1) + (size_t)(6144 + blk * 256 + 192 + r) * D + c8 * 8) = (u32x4){0u, 0u, 0u, 0u}; }
    for (int i = c.gtid; i < 4 * 2048 * 32; i += c.ngt) { const int c8 = i & 31, row = (i >> 5) & 2047, l = i >> 16; const int p = (row >> 7) & 1, col = c8 * 8;
        u32x4 o = (u32x4){0u, 0u, 0u, 0u};
        if ((col >> 7) == p) { const float* s = P->in[I_PKEYS] + ((size_t)l * 2048 + row) * 128 + (col & 127); const f32x4 a = *(const f32x4*)s, b = *(const f32x4*)(s + 4);
            o.x = cvt_pk_bf16(a[0], a[1]); o.y = cvt_pk_bf16(a[2], a[3]); o.z = cvt_pk_bf16(b[0], b[1]); o.w = cvt_pk_bf16(b[2], b[3]); }
        *(u32x4*)((bf16_t*)(ws + WS_KEYS) + ((size_t)l * 2048 + row) * 256 + col) = o; }
    for (int i0 = c.gtid; i0 < 10240 * 256; i0 += 4 * c.ngt) { float v4[4];
#pragma unroll
        for (int u = 0; u < 4; ++u) { const int i = i0 + u * c.ngt; float v = 0.f;
            if (i < 10240 * 256) { const int kc = i & 255, r = i >> 8;
                if (r < 4096) { const int d = r >> 11, cc = r & 2047, k = kc - 96 * d; if (k >= 0 && k < 96) v = P->in[I_RWDEC2][((size_t)d * 96 + k) * D + cc]; }
                else if (r < 8192) { const int rr = r - 4096, d = rr >> 11, cc = rr & 2047, k = kc - 96 * d; if (k >= 0 && k < 96) v = P->in[I_RWICL2][((size_t)d * 96 + k) * D + cc]; }
                else v = P->in[I_RWG2][(size_t)kc * D + (r - 8192)]; }
            v4[u] = v; }
#pragma unroll
        for (int u = 0; u < 4; ++u) { const int i = i0 + u * c.ngt; if (i < 10240 * 256) ((bf16_t*)(ws + WS_RW2))[i] = (bf16_t)(cvt_pk_bf16(v4[u], 0.f) & 0xffffu); } }
    }
    PROBE_REP(18)
    for (int i = c.gtid; i < 2 * 2 * D; i += c.ngt) ((float*)(ws + WS_SPT))[i] = -8.0f * log1pf(expf(-P->in[I_RGLAM][i]));
    PROBE_REP(18)
    for (int i = c.gtid; i < SLEN * 128; i += c.ngt) { const int pos = i >> 7, k = i & 127; const float theta = 1.0f / powf(10000.0f, (float)k / 127.0f); const float ang = (float)pos * theta;
        ((f32x2*)(ws + WS_CS))[i] = (f32x2){cosf(ang), sinf(ang)}; }
}
__device__ __forceinline__ void phase_modfin(KP P, const Ctx& c) {
    for (int i = c.gtid; i < 4 * 5 * 12288; i += c.ngt) { const int n = i % 12288, lv = i / 12288, l = lv / 5, v = lv % 5;
        float s = P->in[I_ADAB][l * 12288 + n];
        for (int kc = 0; kc < 8; ++kc) s += ((const float*)(P->ws + WS_MODP))[((size_t)(l * 8 + kc) * 5 + v) * 12288 + n];
        ((float*)(P->ws + WS_MOD))[i] = s; }
}
__device__ __forceinline__ void phase_xinit(KP P, const Ctx& c) {
    float* X = (float*)(P->ws + WS_X); bf16_t* A0 = (bf16_t*)(P->ws + WS_A0);
    for (size_t i0 = c.gtid; i0 < TD / 4; i0 += 4 * (size_t)c.ngt) {
        f32x4 x[4], sh[4], sc[4];
#pragma unroll
        for (int u = 0; u < 4; ++u) { const size_t i = i0 + (size_t)u * c.ngt; if (i < TD / 4) { const int row = (int)(i >> 9), c4 = (int)(i & 511) * 4;
            const float* src = row < NCTX ? P->in[I_CTX] + (size_t)row * D : P->in[I_X] + (size_t)(row - NCTX) * D; const int v = row_vec(row);
            x[u] = *(const f32x4*)(src + c4); sh[u] = *(const f32x4*)(modp(P, 0, v, 0) + c4); sc[u] = *(const f32x4*)(modp(P, 0, v, 1) + c4); } }
#pragma unroll
        for (int u = 0; u < 4; ++u) { const size_t i = i0 + (size_t)u * c.ngt; if (i < TD / 4) { const int row = (int)(i >> 9), c4 = (int)(i & 511) * 4;
            *(f32x4*)(X + (size_t)row * D + c4) = x[u];
            const f32x4 h = x[u] * (sc[u] + 1.0f) + sh[u];
            *(u32x2*)(A0 + (size_t)row * D + c4) = (u32x2){cvt_pk_bf16(h[0], h[1]), cvt_pk_bf16(h[2], h[3])}; } } }
}

__device__ __forceinline__ void phase_rg_conv(KP P, const Ctx& c, int jl) {
    const bf16_t* UR = (const bf16_t*)(P->ws + L_UR); bf16_t* XC = (bf16_t*)(P->ws + L_XC);
    const float* cw = P->in[I_RGCW] + (size_t)jl * 4 * D; const float* cb = P->in[I_RGCB] + (size_t)jl * D;
    const int c8 = (int)(c.gtid & 255) * 8;
    float w8[4][8], b8[8];
#pragma unroll
    for (int j = 0; j < 8; ++j) { b8[j] = cb[c8 + j];
#pragma unroll
        for (int tp = 0; tp < 4; ++tp) w8[tp][j] = cw[tp * D + c8 + j]; }
    for (size_t i0 = c.gtid; i0 < TD / 8; i0 += 2 * (size_t)c.ngt) {
        u32x4 u[2][4];
#pragma unroll
        for (int q = 0; q < 2; ++q) { const size_t i = i0 + (size_t)q * c.ngt; const int row = (int)(i >> 8);
            int lo, hi; if (row < NCTX) { lo = row & ~(CTX - 1); hi = lo + CTX; } else { lo = NCTX + ((row - NCTX) & ~(SEQ - 1)); hi = lo + SEQ; }
#pragma unroll
            for (int tp = 0; tp < 4; ++tp) { const int rr = row + tp - 2; u[q][tp] = (u32x4){0u, 0u, 0u, 0u};
                if (i < TD / 8 && rr >= lo && rr < hi) u[q][tp] = *(const u32x4*)(UR + (size_t)rr * D + c8); } }
#pragma unroll
        for (int q = 0; q < 2; ++q) { const size_t i = i0 + (size_t)q * c.ngt; if (i >= TD / 8) break; const int row = (int)(i >> 8);
            float a[8];
#pragma unroll
            for (int j = 0; j < 8; ++j) a[j] = b8[j];
#pragma unroll
            for (int tp = 0; tp < 4; ++tp) { const u32x4 uu = u[q][tp]; const unsigned u0 = uu.x, u1 = uu.y, u2 = uu.z, u3 = uu.w;
                a[0] += w8[tp][0] * bflo(u0); a[1] += w8[tp][1] * bfhi(u0); a[2] += w8[tp][2] * bflo(u1); a[3] += w8[tp][3] * bfhi(u1);
                a[4] += w8[tp][4] * bflo(u2); a[5] += w8[tp][5] * bfhi(u2); a[6] += w8[tp][6] * bflo(u3); a[7] += w8[tp][7] * bfhi(u3); }
            *(u32x4*)(XC + (size_t)row * D + c8) = (u32x4){cvt_pk_bf16(a[0], a[1]), cvt_pk_bf16(a[2], a[3]), cvt_pk_bf16(a[4], a[5]), cvt_pk_bf16(a[6], a[7])}; } }
}
__device__ __forceinline__ void phase_rg_scan1(KP P, const Ctx& c) {
    const bf16_t* LA = (const bf16_t*)(P->ws + L_LA); const bf16_t* BB = (const bf16_t*)(P->ws + L_BB);
    float* CA = (float*)(P->ws + WS_CA); float* CH = (float*)(P->ws + WS_CH);
    for (int u = c.gw; u < 2048; u += c.ngw) { const int b = u >> 9, dir = (u >> 8) & 1, ck = (u >> 2) & 63, ch = (u & 3) * 512 + c.lane * 8;
        float h[8], sl[8];
#pragma unroll
        for (int e = 0; e < 8; ++e) { h[e] = 0.f; sl[e] = 0.f; }
        u32x4 nl[4], nb[4];
#define SC1_LOAD(s0_) do { _Pragma("unroll") for (int i_ = 0; i_ < 4; ++i_) { const int row_ = seq_row(b, dir, ck * 68 + (s0_) + i_); const size_t o_ = ((size_t)row_ * 2 + dir) * D + ch; nl[i_] = *(const u32x4*)(LA + o_); nb[i_] = *(const u32x4*)(BB + o_); } } while (0)
        SC1_LOAD(0);
#pragma unroll 1
        for (int s0 = 0; s0 < 68; s0 += 4) { u32x4 cl[4], cb[4];
#pragma unroll
            for (int i = 0; i < 4; ++i) { cl[i] = nl[i]; cb[i] = nb[i]; }
            if (s0 + 4 < 68) SC1_LOAD(s0 + 4);
#pragma unroll
            for (int i = 0; i < 4; ++i) { float l8[8], b8[8]; unpack8(cl[i], l8); unpack8(cb[i], b8);
#pragma unroll
                for (int e = 0; e < 8; ++e) { h[e] = __expf(l8[e]) * h[e] + b8[e]; sl[e] += l8[e]; } } }
#undef SC1_LOAD
        const size_t o = ((size_t)(b * 2 + dir) * 64 + ck) * D + ch;
        *(f32x4*)(CA + o) = (f32x4){sl[0], sl[1], sl[2], sl[3]}; *(f32x4*)(CA + o + 4) = (f32x4){sl[4], sl[5], sl[6], sl[7]};
        *(f32x4*)(CH + o) = (f32x4){h[0], h[1], h[2], h[3]}; *(f32x4*)(CH + o + 4) = (f32x4){h[4], h[5], h[6], h[7]}; }
}
__device__ __forceinline__ void phase_rg_scan2(KP P, const Ctx& c) {
    const float* CA = (const float*)(P->ws + WS_CA); const float* CH = (const float*)(P->ws + WS_CH); float* CIN = (float*)(P->ws + WS_CIN);
    for (int i = c.gtid; i < 4 * 2 * D; i += c.ngt) { const int ch = i & (D - 1), bd = i >> 11; float carry = 0.f;
#pragma unroll 1
        for (int c0 = 0; c0 < 64; c0 += 16) { float a[16], hh[16];
#pragma unroll
            for (int q = 0; q < 16; ++q) { const size_t o = ((size_t)bd * 64 + c0 + q) * D + ch; a[q] = CA[o]; hh[q] = CH[o]; }
#pragma unroll
            for (int q = 0; q < 16; ++q) { const size_t o = ((size_t)bd * 64 + c0 + q) * D + ch; CIN[o] = carry; carry = __expf(a[q]) * carry + hh[q]; } } }
}
template <int DIR> __device__ __forceinline__ void phase_rg_scan3(KP P, const Ctx& c) {
    const bf16_t* LA = (const bf16_t*)(P->ws + L_LA); const bf16_t* BB = (const bf16_t*)(P->ws + L_BB); const bf16_t* UG = (const bf16_t*)(P->ws + L_UG);
    const float* CIN = (const float*)(P->ws + WS_CIN); bf16_t* YIN = (bf16_t*)(P->ws + L_YIN); bf16_t* HF = (bf16_t*)(P->ws + L_XC);
    for (int u = c.gw; u < 2048; u += c.ngw) { const int b = u >> 9, ck = (u >> 3) & 63, ch = (u & 7) * 256 + c.lane * 4;
        const f32x4 h0 = *(const f32x4*)(CIN + ((size_t)(b * 2 + DIR) * 64 + ck) * D + ch); float h[4] = {h0[0], h0[1], h0[2], h0[3]};
        u32x2 nl[4], nb[4], nf[4], ng[4];
#define SC3_LOAD(s0_) do { _Pragma("unroll") for (int i_ = 0; i_ < 4; ++i_) { const int row_ = seq_row(b, DIR, ck * 68 + (s0_) + i_); const size_t o_ = ((size_t)row_ * 2 + DIR) * D + ch, q_ = (size_t)row_ * D + ch; \
            nl[i_] = *(const u32x2*)(LA + o_); nb[i_] = *(const u32x2*)(BB + o_); if (DIR == 1) { nf[i_] = *(const u32x2*)(HF + q_); ng[i_] = *(const u32x2*)(UG + q_); } } } while (0)
        SC3_LOAD(0);
#pragma unroll 1
        for (int s0 = 0; s0 < 68; s0 += 4) { u32x2 cl[4], cb[4], cf[4], cg[4];
#pragma unroll
            for (int i = 0; i < 4; ++i) { cl[i] = nl[i]; cb[i] = nb[i]; if (DIR == 1) { cf[i] = nf[i]; cg[i] = ng[i]; } }
            if (s0 + 4 < 68) SC3_LOAD(s0 + 4);
#pragma unroll
            for (int i = 0; i < 4; ++i) { const int row = seq_row(b, DIR, ck * 68 + s0 + i); const size_t q = (size_t)row * D + ch;
                const unsigned l0 = cl[i].x, l1 = cl[i].y, b0 = cb[i].x, b1 = cb[i].y;
                h[0] = __expf(bflo(l0)) * h[0] + bflo(b0); h[1] = __expf(bfhi(l0)) * h[1] + bfhi(b0); h[2] = __expf(bflo(l1)) * h[2] + bflo(b1); h[3] = __expf(bfhi(l1)) * h[3] + bfhi(b1);
                if (DIR == 0) { *(u32x2*)(HF + q) = (u32x2){cvt_pk_bf16(h[0], h[1]), cvt_pk_bf16(h[2], h[3])}; }
                else { const unsigned f0 = cf[i].x, f1 = cf[i].y, g0 = cg[i].x, g1 = cg[i].y;
                    *(u32x2*)(YIN + q) = (u32x2){cvt_pk_bf16(bflo(g0) * (bflo(f0) + h[0]), bfhi(g0) * (bfhi(f0) + h[1])), cvt_pk_bf16(bflo(g1) * (bflo(f1) + h[2]), bfhi(g1) * (bfhi(f1) + h[3]))}; } } }
#undef SC3_LOAD
    }
}

__device__ __forceinline__ void phase_ln_mid(KP P, const Ctx& c, int layer, int row_lo) {
    float* X = (float*)(P->ws + WS_X); bf16_t* H2 = (bf16_t*)(P->ws + WS_H2);
    const float* lg = P->in[I_LNG] + (size_t)(layer * 2 + 0) * D; const float* lb = P->in[I_LNB] + (size_t)(layer * 2 + 0) * D;
    f32x4 xn[8];
    const float* PB = (const float*)(P->ws + WS_S);
    f32x4 pn[8];
    { const int r0 = row_lo + c.gw; if (r0 < T) {
#pragma unroll
        for (int j = 0; j < 8; ++j) { xn[j] = *(const f32x4*)(X + (size_t)r0 * D + c.lane * 4 + 256 * j); pn[j] = *(const f32x4*)(PB + (size_t)r0 * D + c.lane * 4 + 256 * j); } } }
    for (int row = row_lo + c.gw; row < T; row += c.ngw) { float* xr = X + (size_t)row * D + c.lane * 4; const int v = row_vec(row);
        f32x4 x[8]; float s = 0.f;
        { const float* gp = modp(P, layer, v, 2) + c.lane * 4;
#pragma unroll
          for (int j = 0; j < 8; ++j) x[j] = xn[j] * ALPHA + *(const f32x4*)(gp + 256 * j) * pn[j]; }
        if (row + c.ngw < T) {
#pragma unroll
            for (int j = 0; j < 8; ++j) { xn[j] = *(const f32x4*)(X + (size_t)(row + c.ngw) * D + c.lane * 4 + 256 * j); pn[j] = *(const f32x4*)(PB + (size_t)(row + c.ngw) * D + c.lane * 4 + 256 * j); } }
#pragma unroll
        for (int j = 0; j < 8; ++j) s += (x[j][0] + x[j][1]) + (x[j][2] + x[j][3]);
        const float mean = wave_sum(s) * (1.0f / D); float q = 0.f;
#pragma unroll
        for (int j = 0; j < 8; ++j) { x[j] = x[j] - mean; q += (x[j][0] * x[j][0] + x[j][1] * x[j][1]) + (x[j][2] * x[j][2] + x[j][3] * x[j][3]); }
        const float rstd = rsqrtf(wave_sum(q) * (1.0f / D) + LN_EPS);
        const float* m3 = modp(P, layer, v, 3) + c.lane * 4; const float* m4 = modp(P, layer, v, 4) + c.lane * 4;
#pragma unroll
        for (int jh = 0; jh < 2; ++jh) { f32x4 g4[4], b4[4], p4[4], q4[4];
#pragma unroll
            for (int jj = 0; jj < 4; ++jj) { const int j = 4 * jh + jj; g4[jj] = *(const f32x4*)(lg + c.lane * 4 + 256 * j); b4[jj] = *(const f32x4*)(lb + c.lane * 4 + 256 * j);
                p4[jj] = *(const f32x4*)(m4 + 256 * j); q4[jj] = *(const f32x4*)(m3 + 256 * j); }
#pragma unroll
            for (int jj = 0; jj < 4; ++jj) { const int j = 4 * jh + jj;
                const f32x4 y = x[j] * rstd * g4[jj] + b4[jj]; *(f32x4*)(xr + 256 * j) = y;
                const f32x4 h = y * (p4[jj] + 1.0f) + q4[jj];
                *(u32x2*)(H2 + (size_t)row * D + c.lane * 4 + 256 * j) = (u32x2){cvt_pk_bf16(h[0], h[1]), cvt_pk_bf16(h[2], h[3])}; } } }
}

__device__ __forceinline__ float dot2bf(unsigned a, unsigned b, float s) { return __builtin_amdgcn_fdot2_f32_bf16(__builtin_bit_cast(bf16v2, a), __builtin_bit_cast(bf16v2, b), s, false); }
__device__ __forceinline__ float dot8(const u32x4 a, const u32x4 b, float s) {
    const unsigned a0 = a.x, a1 = a.y, a2 = a.z, a3 = a.w, b0 = b.x, b1 = b.y, b2 = b.z, b3 = b.w;
    s = dot2bf(a0, b0, s); s = dot2bf(a1, b1, s); s = dot2bf(a2, b2, s); s = dot2bf(a3, b3, s);
    return s;
}
template <int CTRL> __device__ __forceinline__ int dpp_movi(int x) { return __builtin_amdgcn_update_dpp(x, x, CTRL, 0xF, 0xF, false); }
__device__ __forceinline__ int row_max_i(int m) { m = max(m, dpp_movi<0xB1>(m)); m = max(m, dpp_movi<0x4E>(m)); m = max(m, dpp_movi<0x141>(m)); m = max(m, dpp_movi<0x140>(m)); return m; }
template <int PAT> __device__ __forceinline__ int swz(int v) { return __builtin_amdgcn_ds_swizzle(v, PAT); }
__device__ __forceinline__ int f2key(float f) { const int b = __float_as_int(f); return b ^ ((b >> 31) & 0x7fffffff); }
__device__ __forceinline__ float key2f(int k) { return __int_as_float(k ^ ((k >> 31) & 0x7fffffff)); }
__device__ __forceinline__ void row_max_i_pair(int& a, int& b) {
    asm volatile("s_nop 1\n\t"
        "v_max_i32_dpp %0, %0, %0 quad_perm:[1,0,3,2] row_mask:0xf bank_mask:0xf\n\tv_max_i32_dpp %1, %1, %1 quad_perm:[1,0,3,2] row_mask:0xf bank_mask:0xf\n\ts_nop 0\n\t"
        "v_max_i32_dpp %0, %0, %0 quad_perm:[2,3,0,1] row_mask:0xf bank_mask:0xf\n\tv_max_i32_dpp %1, %1, %1 quad_perm:[2,3,0,1] row_mask:0xf bank_mask:0xf\n\ts_nop 0\n\t"
        "v_max_i32_dpp %0, %0, %0 row_half_mirror row_mask:0xf bank_mask:0xf\n\tv_max_i32_dpp %1, %1, %1 row_half_mirror row_mask:0xf bank_mask:0xf\n\ts_nop 0\n\t"
        "v_max_i32_dpp %0, %0, %0 row_mirror row_mask:0xf bank_mask:0xf\n\tv_max_i32_dpp %1, %1, %1 row_mirror row_mask:0xf bank_mask:0xf"
        : "+v"(a), "+v"(b));
}
__device__ __forceinline__ void phase_peer_select(KP P, const Ctx& c, int row_lo) {
    const float* S = (const float*)(P->ws + WS_S); float* SW = (float*)(P->ws + WS_SELW);
    constexpr int KMIN = (int)0x80000000;
    const int nps = (2 * (T - row_lo) - c.gw + c.ngw - 1) / c.ngw;
    f32x4 sn[2][2];
#define SEL_LOAD(k) do { const int pid_ = 2 * row_lo + c.gw + (k) * c.ngw; const float* sp_ = S + (size_t)(pid_ >> 1) * D + (2 * (pid_ & 1)) * 512 + lane * 8; \
        sn[0][0] = *(const f32x4*)sp_; sn[0][1] = *(const f32x4*)(sp_ + 4); sn[1][0] = *(const f32x4*)(sp_ + 512); sn[1][1] = *(const f32x4*)(sp_ + 516); } while (0)
    { int lane = c.lane; asm volatile("" : "+v"(lane)); if (nps > 0) SEL_LOAD(0); }
    {
#pragma unroll 1
        for (int kk = 0; kk < nps; ++kk) {
            const int pid = 2 * row_lo + c.gw + kk * c.ngw, row = pid >> 1, pp = pid & 1;
            int lane = c.lane; asm volatile("" : "+v"(lane));
            const int l16 = lane & 15, isS2 = (lane >> 4) & 1;
            int k8[2][8];
#pragma unroll
            for (int q = 0; q < 2; ++q) {
#pragma unroll
                for (int e = 0; e < 8; ++e) { const float v = sn[q][e >> 2][e & 3]; k8[q][e] = (f2key(v) & ~127) | (127 - (l16 * 8 + e)); } }
            if (kk + 1 < nps) SEL_LOAD(kk + 1);
#define SEL_CE(a, b) do { const int hi_ = max(a, b), lo_ = min(a, b); a = hi_; b = lo_; } while (0)
#pragma unroll
            for (int q = 0; q < 2; ++q) { int (&k)[8] = k8[q];
                SEL_CE(k[0], k[1]); SEL_CE(k[2], k[3]); SEL_CE(k[4], k[5]); SEL_CE(k[6], k[7]); SEL_CE(k[0], k[2]); SEL_CE(k[1], k[3]); SEL_CE(k[4], k[6]); SEL_CE(k[5], k[7]);
                SEL_CE(k[1], k[2]); SEL_CE(k[5], k[6]); SEL_CE(k[0], k[4]); SEL_CE(k[3], k[7]); SEL_CE(k[1], k[5]); SEL_CE(k[2], k[6]); SEL_CE(k[1], k[4]); SEL_CE(k[3], k[6]);
                SEL_CE(k[2], k[4]); SEL_CE(k[3], k[5]); SEL_CE(k[3], k[4]); }
            int own[2] = {KMIN, KMIN};
#pragma unroll
            for (int it = 0; it < 16; ++it) {
                int m0 = k8[0][0], m1 = k8[1][0];
                row_max_i_pair(m0, m1);
                const bool p0 = k8[0][0] == m0, p1 = k8[1][0] == m1;
#pragma unroll
                for (int e = 0; e < 7; ++e) { k8[0][e] = p0 ? k8[0][e + 1] : k8[0][e]; k8[1][e] = p1 ? k8[1][e + 1] : k8[1][e]; }
                k8[0][7] = p0 ? KMIN : k8[0][7]; k8[1][7] = p1 ? KMIN : k8[1][7];
                own[0] = (l16 == it) ? m0 : own[0]; own[1] = (l16 == it) ? m1 : own[1]; }
            int ck[2][4], ownIdx[2];
#pragma unroll
            for (int q = 0; q < 2; ++q) { ownIdx[q] = 127 - (own[q] & 127); const float ownVal = key2f(own[q]);
                int pk[4]; pk[0] = swz<(0x10 << 10) | (0 << 5) | 0x10>(own[q]); pk[1] = swz<(0x10 << 10) | (1 << 5) | 0x10>(own[q]); pk[2] = swz<(0x10 << 10) | (2 << 5) | 0x10>(own[q]); pk[3] = swz<(0x10 << 10) | (3 << 5) | 0x10>(own[q]);
#pragma unroll
                for (int m = 0; m < 4; ++m) { const float pv = key2f(pk[m]);
                    const int ci = isS2 ? m : l16, cj = isS2 ? l16 : m;
                    const bool valid = (isS2 ? (m <= l16) : (m < l16)) && ((ci + 1) * (cj + 1) <= 16);
                    ck[q][m] = valid ? ((f2key(ownVal + pv) & ~255) | (255 - (ci * 16 + cj))) : KMIN; } }
#pragma unroll
            for (int q = 0; q < 2; ++q) { int (&k)[4] = ck[q]; SEL_CE(k[0], k[1]); SEL_CE(k[2], k[3]); SEL_CE(k[0], k[2]); SEL_CE(k[1], k[3]); SEL_CE(k[1], k[2]); }
#undef SEL_CE
            int win[2] = {KMIN, KMIN};
#pragma unroll
            for (int it = 0; it < 16; ++it) {
                int m0 = ck[0][0], m1 = ck[1][0];
                row_max_i_pair(m0, m1);
                m0 = max(m0, swz<(0x10 << 10) | 0x1F>(m0)); m1 = max(m1, swz<(0x10 << 10) | 0x1F>(m1));
                const bool p0 = ck[0][0] == m0, p1 = ck[1][0] == m1;
#pragma unroll
                for (int e = 0; e < 3; ++e) { ck[0][e] = p0 ? ck[0][e + 1] : ck[0][e]; ck[1][e] = p1 ? ck[1][e + 1] : ck[1][e]; }
                ck[0][3] = p0 ? KMIN : ck[0][3]; ck[1][3] = p1 ? KMIN : ck[1][3];
                win[0] = (l16 == it) ? m0 : win[0]; win[1] = (l16 == it) ? m1 : win[1]; }
#pragma unroll
            for (int q = 0; q < 2; ++q) {
                const int cidx = 255 - (win[q] & 255), ci = (cidx >> 4) & 15, cj = cidx & 15, rb = lane & 32;
                const int i1 = __builtin_amdgcn_ds_bpermute((rb + ci) << 2, ownIdx[q]), i2 = __builtin_amdgcn_ds_bpermute((rb + 16 + cj) << 2, ownIdx[q]);
                const float sc = key2f(win[q]);
                const float mxf = key2f(row_max_i(f2key(sc)));
                const float ex = __expf(sc - mxf);
                float sum = ex; sum += dpp_mov<0xB1>(sum); sum += dpp_mov<0x4E>(sum); sum += dpp_mov<0x141>(sum); sum += dpp_mov<0x140>(sum);
                if (!isS2) { const size_t o = ((size_t)row * 8 + (2 * pp + q) * 2 + (lane >> 5)) * 16 + l16; const int e_ = (i1 * 128 + i2) & 16383; ((unsigned short*)(P->ws + P_SE16))[o] = (unsigned short)e_; SW[o] = ex / sum; } }
        }
    }
#undef SEL_LOAD
}

__device__ __forceinline__ float dot2bf_init(bf16v2 a, bf16v2 b) { float r; asm("v_dot2_f32_bf16 %0, %1, %2, 0" : "=v"(r) : "v"(a), "v"(b)); return r; }
__device__ __forceinline__ void unpack16_fp8(const u32x4 a, float (&f)[16]) {
#pragma unroll
    for (int w = 0; w < 4; ++w) { const int aw = (int)a[w]; const f32x2 lo = __builtin_amdgcn_cvt_pk_f32_fp8(aw, false), hi = __builtin_amdgcn_cvt_pk_f32_fp8(aw, true);
        f[4 * w + 0] = lo.x; f[4 * w + 1] = lo.y; f[4 * w + 2] = hi.x; f[4 * w + 3] = hi.y; }
}
#define PEER_QUEUE_BEGIN(phase_id, tg_lo, tg_hi) { \
    unsigned* heads_ = (unsigned*)(P->ws + WS_CTL) + CW_PQ + (phase_id) * 16 * 64; const unsigned x_ = ((PROBE >> 19) & 1) ? ((unsigned)blockIdx.x >> 5) & 7u : (xb_xcc_id() & 7u); \
    for (int k_ = 0; k_ < 16; ++k_) { const int db = (int)((x_ + 8u * (k_ & 1) + (unsigned)(k_ >> 1)) & 15u); \
        for (;;) { unsigned t0_ = 0; if (c.lane == 0) t0_ = __hip_atomic_fetch_add(heads_ + db * 64, 2u, __ATOMIC_RELAXED, __HIP_MEMORY_SCOPE_AGENT); \
            t0_ = (unsigned)__builtin_amdgcn_readfirstlane((int)t0_) + (unsigned)(tg_lo); if (t0_ >= (unsigned)(tg_hi)) break; \
            for (unsigned tg_ = t0_; tg_ < t0_ + 2u && tg_ < (unsigned)(tg_hi); ++tg_) { const int tg = (int)tg_;
#define PEER_QUEUE_END } } } }
__device__ __forceinline__ void phase_peer_u(KP P, const Ctx& c, int layer, int row_lo, int qrep) {
    const bf16_t* H2 = (const bf16_t*)(P->ws + WS_H2); const unsigned short* SE = (const unsigned short*)(P->ws + P_SE16);
    const unsigned char* U = P->ws + WS_PU + (size_t)layer * 16384 * D; bf16_t* PART = (bf16_t*)(P->ws + P_PART);
    PEER_QUEUE_BEGIN(layer * 2 + 0 + 8 * qrep, row_lo / 8, T / 8)
        int lane = c.lane; asm volatile("" : "+v"(lane));
        const int ts = lane >> 3, seg = lane & 7, t = tg * 8 + ts;
        const bf16_t* xp = H2 + (size_t)t * D + db * 128 + seg * 16; const u32x4 xa = *(const u32x4*)xp, xb = *(const u32x4*)(xp + 8);
        const unsigned short* se = SE + (size_t)t * 128; const unsigned char* ub = U + (size_t)db * 16384 * 128; const unsigned seg16 = (unsigned)seg * 16u;
        bf16_t* pp = PART + (((size_t)t * 16 + db) * 8 + seg) * 16;
        u32x4 eA[2], eB[2], gA[16], gB[16];
#define PU_IDX(E, st) do { _Pragma("unroll") for (int i_ = 0; i_ < 2; ++i_) E[i_] = *(const u32x4*)(se + 16 * (st) + 8 * i_); } while (0)
#define PU_GATHER(G, E) do { _Pragma("unroll") for (int k_ = 0; k_ < 16; ++k_) { const unsigned w_ = E[k_ >> 3][(k_ >> 1) & 3]; const unsigned e_ = ((k_ & 1) ? (w_ >> 16) : w_) & 16383u; G[k_] = *(const u32x4*)(ub + (unsigned)((e_ << 7) | seg16)); } } while (0)
#define PU_COMPUTE(G, OUT) do { float v2_[2]; \
            _Pragma("unroll") for (int cc = 0; cc < 2; ++cc) { float sk[8]; \
                _Pragma("unroll") for (int k = 0; k < 8; ++k) { float s0; \
                    _Pragma("unroll") for (int w = 0; w < 4; ++w) { const int gw_ = (int)G[8 * cc + k][w]; const unsigned x0 = w < 2 ? xa[2 * w] : xb[2 * w - 4], x1 = w < 2 ? xa[2 * w + 1] : xb[2 * w - 3]; \
                        if (w == 0) s0 = dot2bf_init(__builtin_amdgcn_cvt_scalef32_pk_bf16_fp8(gw_, 1.0f, false), __builtin_bit_cast(bf16v2, x0)); \
                        else s0 = __builtin_amdgcn_fdot2_f32_bf16(__builtin_amdgcn_cvt_scalef32_pk_bf16_fp8(gw_, 1.0f, false), __builtin_bit_cast(bf16v2, x0), s0, false); \
                        s0 = __builtin_amdgcn_fdot2_f32_bf16(__builtin_amdgcn_cvt_scalef32_pk_bf16_fp8(gw_, 1.0f, true), __builtin_bit_cast(bf16v2, x1), s0, false); } \
                    sk[k] = s0; } \
                sum8_quad(sk[0], sk[1], sk[2], sk[3]); sum8_quad(sk[4], sk[5], sk[6], sk[7]); \
                float v = 0.f; \
                _Pragma("unroll") for (int k = 0; k < 8; ++k) v = (seg == k) ? sk[k] : v; \
                v2_[cc] = v; } \
            OUT = cvt_pk_bf16(v2_[0], v2_[1]); } while (0)
        PU_IDX(eA, 0); PU_IDX(eB, 1); PU_GATHER(gA, eA);
#pragma unroll 1
        for (int j2 = 0; j2 < 4; ++j2) {
            PU_GATHER(gB, eB);
            if (j2 < 3) PU_IDX(eA, 2 * j2 + 2);
            unsigned pw0, pw1;
            PU_COMPUTE(gA, pw0);
            if (j2 < 3) { PU_GATHER(gA, eA); PU_IDX(eB, 2 * j2 + 3); }
            PU_COMPUTE(gB, pw1);
            *(u32x2*)(pp + 4 * j2) = (u32x2){pw0, pw1};
        }
#undef PU_IDX
#undef PU_GATHER
#undef PU_COMPUTE
    PEER_QUEUE_END
}
__device__ __forceinline__ void phase_peer_c(KP P, const Ctx& c, int layer, int row_lo) {
    const bf16_t* PART = (const bf16_t*)(P->ws + P_PART); const unsigned short* SE = (const unsigned short*)(P->ws + P_SE16); const float* SW = (const float*)(P->ws + WS_SELW);
    const float* ISU = (const float*)(P->ws + WS_PSC) + (size_t)layer * 16384; const float* ISV = ISU + (size_t)4 * 16384; bf16_t* C = (bf16_t*)(P->ws + P_C);
    unsigned pw[16]; unsigned short se0, se1; float w0, w1;
#define PC_LOAD(i_) do { const size_t t_ = (i_) >> 6; const int jj_ = (int)((i_) & 7), seg_ = (int)(((i_) >> 3) & 7); const unsigned* pp_ = (const unsigned*)(PART + ((t_ * 16) * 8 + seg_) * 16 + 2 * jj_); \
        _Pragma("unroll") for (int db = 0; db < 16; ++db) pw[db] = pp_[(size_t)db * 64]; \
        const size_t o_ = t_ * 128 + 16 * jj_ + seg_; se0 = SE[o_]; se1 = SE[o_ + 8]; w0 = SW[o_]; w1 = SW[o_ + 8]; } while (0)
    const size_t ibeg = (size_t)row_lo * 64 + c.gtid, iend = (size_t)T * 64;
    if (ibeg < iend) PC_LOAD(ibeg);
    for (size_t i = ibeg; i < iend; i += c.ngt) { const size_t t = i >> 6; const int jj = (int)(i & 7), seg = (int)((i >> 3) & 7);
        const size_t o0 = t * 128 + 16 * jj + seg, o1 = o0 + 8; const int e0 = se0 & 16383, e1 = se1 & 16383; const float cw0 = w0, cw1 = w1;
        const float iu0 = ISU[e0], iv0 = ISV[e0], iu1 = ISU[e1], iv1 = ISV[e1]; float s0 = 0.f, s1 = 0.f;
#pragma unroll
        for (int db = 0; db < 16; ++db) { const unsigned w = pw[db]; s0 += __builtin_bit_cast(float, w << 16); s1 += __builtin_bit_cast(float, w & 0xffff0000u); }
        if (i + c.ngt < iend) PC_LOAD(i + c.ngt);
        C[o0] = (bf16_t)(cvt_pk_bf16(cw0 * gelu_tanh(s0 * iu0) * iv0, 0.f) & 0xffffu);
        C[o1] = (bf16_t)(cvt_pk_bf16(cw1 * gelu_tanh(s1 * iu1) * iv1, 0.f) & 0xffffu); }
#undef PC_LOAD
}
__device__ __forceinline__ void phase_peer_v(KP P, const Ctx& c, int layer, int row_lo, int qrep) {
    const unsigned short* SE = (const unsigned short*)(P->ws + P_SE16); const bf16_t* C = (const bf16_t*)(P->ws + P_C);
    const unsigned char* V = P->ws + WS_PV + (size_t)layer * 16384 * D; bf16_t* Y = (bf16_t*)(P->ws + P_Y);
    PEER_QUEUE_BEGIN(layer * 2 + 1 + 8 * qrep, row_lo / 8, T / 8)
        int lane = c.lane; asm volatile("" : "+v"(lane));
        const int ts = lane >> 3, seg = lane & 7, t = tg * 8 + ts;
        const unsigned short* se = SE + (size_t)t * 128; const bf16_t* cp = C + (size_t)t * 128; const unsigned char* vb = V + (size_t)db * 16384 * 128; const unsigned seg16 = (unsigned)seg * 16u;
        float acc[16];
#pragma unroll
        for (int e = 0; e < 16; ++e) acc[e] = 0.f;
        u32x4 en[2];
#pragma unroll
        for (int i = 0; i < 2; ++i) en[i] = *(const u32x4*)(se + 8 * i);
#pragma unroll 1
        for (int q = 0; q < 8; ++q) { u32x4 ec[2];
#pragma unroll
          for (int i = 0; i < 2; ++i) ec[i] = en[i];
          if (q < 7) {
#pragma unroll
            for (int i = 0; i < 2; ++i) en[i] = *(const u32x4*)(se + 16 * (q + 1) + 8 * i); }
          const u32x4 c0 = *(const u32x4*)(cp + 16 * q), c1 = *(const u32x4*)(cp + 16 * q + 8);
          u32x4 g[16];
#pragma unroll
          for (int k = 0; k < 16; ++k) { const unsigned w_ = ec[k >> 3][(k >> 1) & 3]; const unsigned e = ((k & 1) ? (w_ >> 16) : w_) & 16383u; g[k] = *(const u32x4*)(vb + (unsigned)((e << 7) | seg16)); }
#pragma unroll
          for (int k = 0; k < 16; k += 2) { const unsigned cwu = (k < 8 ? c0 : c1)[(k >> 1) & 3]; const bf16v2 cw = __builtin_bit_cast(bf16v2, cwu);
#pragma unroll
              for (int w = 0; w < 4; ++w) { const unsigned g0 = g[k][w], g1 = g[k + 1][w];
                  const int pa = (int)__builtin_amdgcn_perm(g1, g0, 0x05010400u), pb = (int)__builtin_amdgcn_perm(g1, g0, 0x07030602u);
                  acc[4 * w + 0] = __builtin_amdgcn_fdot2_f32_bf16(__builtin_amdgcn_cvt_scalef32_pk_bf16_fp8(pa, 1.0f, false), cw, acc[4 * w + 0], false);
                  acc[4 * w + 1] = __builtin_amdgcn_fdot2_f32_bf16(__builtin_amdgcn_cvt_scalef32_pk_bf16_fp8(pa, 1.0f, true), cw, acc[4 * w + 1], false);
                  acc[4 * w + 2] = __builtin_amdgcn_fdot2_f32_bf16(__builtin_amdgcn_cvt_scalef32_pk_bf16_fp8(pb, 1.0f, false), cw, acc[4 * w + 2], false);
                  acc[4 * w + 3] = __builtin_amdgcn_fdot2_f32_bf16(__builtin_amdgcn_cvt_scalef32_pk_bf16_fp8(pb, 1.0f, true), cw, acc[4 * w + 3], false); } } }
        bf16_t* yp = Y + (size_t)t * D + db * 128 + seg * 16;
#pragma unroll
        for (int q = 0; q < 2; ++q) *(u32x4*)(yp + 8 * q) = (u32x4){cvt_pk_bf16(acc[8 * q], acc[8 * q + 1]), cvt_pk_bf16(acc[8 * q + 2], acc[8 * q + 3]), cvt_pk_bf16(acc[8 * q + 4], acc[8 * q + 5]), cvt_pk_bf16(acc[8 * q + 6], acc[8 * q + 7])};
    PEER_QUEUE_END
}
template <bool LAST>
__device__ __forceinline__ void phase_peer_final(KP P, const Ctx& c, int layer) {
    const bf16_t* Y = (const bf16_t*)(P->ws + P_Y); float* X = (float*)(P->ws + WS_X); bf16_t* A0 = (bf16_t*)(P->ws + WS_A0);
    const float* lg = P->in[I_LNG] + (size_t)(layer * 2 + 1) * D; const float* lb = P->in[I_LNB] + (size_t)(layer * 2 + 1) * D;
    const float ymul = ((DBG_ZERO >> (2 * layer + 1)) & 1) ? 0.f : 1.f;
    f32x4 xn[8]; u32x2 yn[8];
    { const int r0 = (LAST ? NCTX : 0) + c.gw; if (r0 < T) {
#pragma unroll
        for (int j = 0; j < 8; ++j) { xn[j] = *(const f32x4*)(X + (size_t)r0 * D + c.lane * 4 + 256 * j); yn[j] = *(const u32x2*)(Y + (size_t)r0 * D + c.lane * 4 + 256 * j); } } }
    for (int row = (LAST ? NCTX : 0) + c.gw; row < T; row += c.ngw) {
        int l4 = c.lane * 4; asm volatile("" : "+v"(l4));
        const int v = row_vec(row); const float* m5 = modp(P, layer, v, 5) + l4;
        f32x4 x[8]; float s = 0.f;
#pragma unroll
        for (int j = 0; j < 8; ++j) { const u32x2 yb = yn[j]; const f32x4 yv = (f32x4){bflo(yb.x), bfhi(yb.x), bflo(yb.y), bfhi(yb.y)};
            x[j] = xn[j] * ALPHA + *(const f32x4*)(m5 + 256 * j) * (yv * ymul); s += (x[j][0] + x[j][1]) + (x[j][2] + x[j][3]); }
        if (row + c.ngw < T) {
#pragma unroll
            for (int j = 0; j < 8; ++j) { xn[j] = *(const f32x4*)(X + (size_t)(row + c.ngw) * D + l4 + 256 * j); yn[j] = *(const u32x2*)(Y + (size_t)(row + c.ngw) * D + l4 + 256 * j); } }
        const float mean = wave_sum(s) * (1.0f / D); float q = 0.f;
#pragma unroll
        for (int j = 0; j < 8; ++j) { x[j] = x[j] - mean; q += (x[j][0] * x[j][0] + x[j][1] * x[j][1]) + (x[j][2] * x[j][2] + x[j][3] * x[j][3]); }
        const float rstd = rsqrtf(wave_sum(q) * (1.0f / D) + LN_EPS);
        const bool mk_a0 = !LAST && layer != 0;
#pragma unroll
        for (int jh = 0; jh < 2; ++jh) { f32x4 g4[4], b4[4], p4[4], q4[4];
#pragma unroll
            for (int jj = 0; jj < 4; ++jj) { const int o = l4 + 256 * (4 * jh + jj); g4[jj] = *(const f32x4*)(lg + o); b4[jj] = *(const f32x4*)(lb + o);
                if (mk_a0) { p4[jj] = *(const f32x4*)(modp(P, layer + 1, v, 1) + o); q4[jj] = *(const f32x4*)(modp(P, layer + 1, v, 0) + o); } }
#pragma unroll
            for (int jj = 0; jj < 4; ++jj) { const int j = 4 * jh + jj, o = l4 + 256 * j; const f32x4 y = x[j] * rstd * g4[jj] + b4[jj];
                if (LAST) { *(f32x4*)(P->out + (size_t)(row - NCTX) * D + o) = y; }
                else { *(f32x4*)(X + (size_t)row * D + o) = y;
                    if (mk_a0) { const f32x4 hv = y * (p4[jj] + 1.0f) + q4[jj];
                        *(u32x2*)(A0 + (size_t)row * D + o) = (u32x2){cvt_pk_bf16(hv[0], hv[1]), cvt_pk_bf16(hv[2], hv[3])}; } } } }
    }
}

__device__ __forceinline__ void phase_rw_mix(KP P, const Ctx& c, int layer) {
    const float* X = (const float*)(P->ws + WS_X); bf16_t* AALL = (bf16_t*)(P->ws + L_AALL); const float* mu = P->in[I_RWMU];
    float mu8[6][8];
    { const int c8 = (int)(c.gtid & 255) * 8;
#pragma unroll
      for (int m = 0; m < 6; ++m) { const f32x4 a = *(const f32x4*)(mu + m * D + c8), b = *(const f32x4*)(mu + m * D + c8 + 4);
#pragma unroll
          for (int j = 0; j < 4; ++j) { mu8[m][j] = a[j]; mu8[m][4 + j] = b[j]; } } }
    const int c8 = (int)(c.gtid & 255) * 8;
    f32x4 nx0, nx1, nn0, nn1, nsh0, nsh1, nsc0, nsc1; int nnb;
#define MX_LOAD(i_) do { const int row_ = (int)((i_) >> 8); const int v_ = row_vec(row_); int nb_ = -1;     \
        if (row_ < NCTX) { const int t_ = row_ & (CTX - 1); if (c8 < 1024) { if (t_ > 0) nb_ = row_ - 1; } else { if (t_ < CTX - 1) nb_ = row_ + 1; } } \
        else { const int t_ = (row_ - NCTX) & (SEQ - 1), qd_ = c8 >> 9; \
            if (qd_ == 0) { if ((t_ & 63) != 0) nb_ = row_ - 1; } else if (qd_ == 1) { if ((t_ & 63) != 63) nb_ = row_ + 1; } \
            else if (qd_ == 2) { if (t_ >= 64) nb_ = row_ - 64; } else { if (t_ < SEQ - 64) nb_ = row_ + 64; } } \
        const float* xp_ = X + (size_t)row_ * D + c8; nx0 = *(const f32x4*)xp_; nx1 = *(const f32x4*)(xp_ + 4); nnb = nb_; \
        if (nb_ >= 0) { const float* np_ = X + (size_t)nb_ * D + c8; nn0 = *(const f32x4*)np_; nn1 = *(const f32x4*)(np_ + 4); } \
        const float* sh_ = modp(P, layer, v_, 0) + c8; const float* sc_ = modp(P, layer, v_, 1) + c8; \
        nsh0 = *(const f32x4*)sh_; nsh1 = *(const f32x4*)(sh_ + 4); nsc0 = *(const f32x4*)sc_; nsc1 = *(const f32x4*)(sc_ + 4); } while (0)
    if ((size_t)c.gtid < TD / 8) MX_LOAD((size_t)c.gtid);
    for (size_t i = c.gtid; i < TD / 8; i += c.ngt) { const int row = (int)(i >> 8);
        float h[8], xx[8];
        { const int nb = nnb;
#pragma unroll
          for (int j = 0; j < 8; ++j) { const float scj = 1.0f + (j < 4 ? nsc0[j & 3] : nsc1[j & 3]), shj = j < 4 ? nsh0[j & 3] : nsh1[j & 3];
              h[j] = (j < 4 ? nx0[j & 3] : nx1[j & 3]) * scj + shj;
              const float sv = nb >= 0 ? (j < 4 ? nn0[j & 3] : nn1[j & 3]) * scj + shj : 0.f; xx[j] = sv - h[j]; } }
        if (i + c.ngt < TD / 8) MX_LOAD(i + c.ngt);
#pragma unroll
        for (int m = 0; m < 6; ++m) { float o[8];
#pragma unroll
            for (int j = 0; j < 8; ++j) o[j] = h[j] + xx[j] * mu8[m][j];
            *(u32x4*)(AALL + (size_t)row * (6 * D) + m * D + c8) = (u32x4){cvt_pk_bf16(o[0], o[1]), cvt_pk_bf16(o[2], o[3]), cvt_pk_bf16(o[4], o[5]), cvt_pk_bf16(o[6], o[7])}; } }
#undef MX_LOAD
}
__device__ __forceinline__ void phase_rw_scan(KP P, const Ctx& c) {
    const bf16_t* R = (const bf16_t*)(P->ws + L_RKV); const bf16_t* Kx = R + TD; const bf16_t* Vx = R + 2 * TD;
    const bf16_t* W = (const bf16_t*)(P->ws + L_W); const bf16_t* AD = (const bf16_t*)(P->ws + L_AD);
    LAS float* rL = (LAS float*)c.lds; LAS float* wL = rL + 4096; LAS float* kkL = rL + 8192; LAS float* bL = rL + 12288; LAS float* kdL = rL + 16384; LAS float* vL = rL + 20480; LAS float* yL = rL + 24576; LAS float* scL = rL + 28672;
    const int tok = c.tid >> 3, cq = c.tid & 7;
    for (int chain = blockIdx.x; chain < 256; chain += gridDim.x) {
        const int b = chain >> 6, hd = (chain >> 1) & 31, dir = chain & 1;
        bf16_t* Y = (bf16_t*)(P->ws + (dir ? L_Y1 : L_Y0));
        const int ch0 = hd * 64 + cq * 8;
        float kkw[8], kaw[8];
#pragma unroll
        for (int j = 0; j < 8; ++j) { kkw[j] = P->in[I_RWKK][ch0 + j]; kaw[j] = P->in[I_RWKA][ch0 + j]; }
        float s[8] = {0.f, 0.f, 0.f, 0.f, 0.f, 0.f, 0.f, 0.f};
        u32x4 gr, gk, gv, gw, ga;
#define RW_GLOAD(ck) do { const int row_ = seq_row(b, dir, (ck) * 64 + tok); gr = *(const u32x4*)(R + (size_t)row_ * D + ch0); gk = *(const u32x4*)(Kx + (size_t)row_ * D + ch0); gv = *(const u32x4*)(Vx + (size_t)row_ * D + ch0); \
        gw = *(const u32x4*)(W + ((size_t)row_ * 2 + dir) * D + ch0); ga = *(const u32x4*)(AD + ((size_t)row_ * 2 + dir) * D + ch0); } while (0)
        RW_GLOAD(0);
        for (int ck = 0; ck < SLEN / 64; ++ck) {
            const int row = seq_row(b, dir, ck * 64 + tok);
            float r8[8], k8[8], v8[8], w8[8], a8[8];
            unpack8(gr, r8); unpack8(gk, k8); unpack8(gv, v8); unpack8(gw, w8); unpack8(ga, a8);
            float kx[8], ss = 0.f;
#pragma unroll
            for (int j = 0; j < 8; ++j) { kx[j] = k8[j] * kkw[j]; ss += kx[j] * kx[j]; }
            ss = sum8(ss);
            const float rn = rsqrtf(ss + 1e-12f);
            __syncthreads();
            float pbr = 0.f, pkr = 0.f;
            {   float wr_[8], kk_[8], b_[8], kd_[8];
#pragma unroll
                for (int j = 0; j < 8; ++j) { kk_[j] = kx[j] * rn; b_[j] = kk_[j] * a8[j]; kd_[j] = k8[j] * (1.0f + (a8[j] - 1.0f) * kaw[j]); wr_[j] = w8[j] * r8[j]; pbr += b_[j] * r8[j]; pkr += kd_[j] * r8[j]; }
                const int o = tok * 64 + cq * 8;
#pragma unroll
                for (int hh = 0; hh < 2; ++hh) { const int q = 4 * hh;
                    *(LAS f32x4*)(rL + o + q) = (f32x4){wr_[q], wr_[q + 1], wr_[q + 2], wr_[q + 3]}; *(LAS f32x4*)(wL + o + q) = (f32x4){w8[q], w8[q + 1], w8[q + 2], w8[q + 3]};
                    *(LAS f32x4*)(kkL + o + q) = (f32x4){kk_[q], kk_[q + 1], kk_[q + 2], kk_[q + 3]}; *(LAS f32x4*)(bL + o + q) = (f32x4){b_[q], b_[q + 1], b_[q + 2], b_[q + 3]};
                    *(LAS f32x4*)(kdL + o + q) = (f32x4){kd_[q], kd_[q + 1], kd_[q + 2], kd_[q + 3]}; *(LAS f32x4*)(vL + o + q) = (f32x4){v8[q], v8[q + 1], v8[q + 2], v8[q + 3]}; } }
            pbr = sum8(pbr); pkr = sum8(pkr);
            if (cq == 0) *(LAS f32x2*)(scL + tok * 2) = (f32x2){pbr, pkr};
            __syncthreads();
            if (ck + 1 < SLEN / 64) RW_GLOAD(ck + 1);
            f32x4 kaA, kbA, waA, wbA, baA, bbA, daA, dbA, raA, rbA, kaB, kbB, waB, wbB, baB, bbB, daB, dbB, raB, rbB; float vvA, vvB; f32x2 scA, scB;
#define RW_LLOAD(X, tk_) do { const int o_ = (tk_) * 64 + cq * 8; ka##X = *(const LAS f32x4*)(kkL + o_); kb##X = *(const LAS f32x4*)(kkL + o_ + 4); wa##X = *(const LAS f32x4*)(wL + o_); wb##X = *(const LAS f32x4*)(wL + o_ + 4); \
                ba##X = *(const LAS f32x4*)(bL + o_); bb##X = *(const LAS f32x4*)(bL + o_ + 4); da##X = *(const LAS f32x4*)(kdL + o_); db##X = *(const LAS f32x4*)(kdL + o_ + 4); ra##X = *(const LAS f32x4*)(rL + o_); rb##X = *(const LAS f32x4*)(rL + o_ + 4); \
                vv##X = vL[(tk_) * 64 + tok]; sc##X = *(const LAS f32x2*)(scL + (tk_) * 2); } while (0)
#define RW_STEP(X, tk_) do { \
                float sa = (fma_s(s[0], ka##X[0], mul_s(s[1], ka##X[1])) + fma_s(s[2], ka##X[2], mul_s(s[3], ka##X[3]))) + (fma_s(s[4], kb##X[0], mul_s(s[5], kb##X[1])) + fma_s(s[6], kb##X[2], mul_s(s[7], kb##X[3]))); \
                float yd = (fma_s(s[0], ra##X[0], mul_s(s[1], ra##X[1])) + fma_s(s[2], ra##X[2], mul_s(s[3], ra##X[3]))) + (fma_s(s[4], rb##X[0], mul_s(s[5], rb##X[1])) + fma_s(s[6], rb##X[2], mul_s(s[7], rb##X[3]))); \
                sum8_pair(sa, yd); \
                const float nsa = -sa; \
                _Pragma("unroll") for (int j2 = 0; j2 < 4; ++j2) { s[j2] = fma_s(vv##X, da##X[j2], fma_s(nsa, ba##X[j2], mul_s(s[j2], wa##X[j2]))); s[4 + j2] = fma_s(vv##X, db##X[j2], fma_s(nsa, bb##X[j2], mul_s(s[4 + j2], wb##X[j2]))); } \
                if (cq == 0) yL[(tk_) * 64 + tok] = yd - sa * sc##X[0] + vv##X * sc##X[1]; } while (0)
            RW_LLOAD(A, 0);
#pragma unroll 1
            for (int tk = 0; tk < 64; tk += 2) {
                RW_LLOAD(B, tk + 1);
                RW_STEP(A, tk);
                RW_LLOAD(A, (tk + 2) & 63);
                RW_STEP(B, tk + 1);
            }
#undef RW_STEP
#undef RW_LLOAD
            __syncthreads();
            { const f32x4 ya = *(const LAS f32x4*)(yL + tok * 64 + cq * 8), yb = *(const LAS f32x4*)(yL + tok * 64 + cq * 8 + 4);
              *(u32x4*)(Y + (size_t)row * D + ch0) = (u32x4){cvt_pk_bf16(ya[0], ya[1]), cvt_pk_bf16(ya[2], ya[3]), cvt_pk_bf16(yb[0], yb[1]), cvt_pk_bf16(yb[2], yb[3])}; }
        }
#undef RW_GLOAD
        __syncthreads();
    }
}
__device__ __forceinline__ void phase_rw_finish(KP P, const Ctx& c) {
    const bf16_t* R = (const bf16_t*)(P->ws + L_RKV); const bf16_t* Kx = R + TD; const bf16_t* Vx = R + 2 * TD;
    const bf16_t* AD = (const bf16_t*)(P->ws + L_AD); const bf16_t* G = (const bf16_t*)(P->ws + L_G);
    const bf16_t* Y0 = (const bf16_t*)(P->ws + L_Y0); const bf16_t* Y1 = (const bf16_t*)(P->ws + L_Y1); bf16_t* Z = (bf16_t*)(P->ws + L_Z);
    const int ch = c.lane * 8 + 512 * (c.gw & 3);
    float ka8[8], rk8[8], gg8[8], gb8[8];
#pragma unroll
    for (int e = 0; e < 8; ++e) { ka8[e] = P->in[I_RWKA][ch + e]; rk8[e] = P->in[I_RWRK][ch + e]; gg8[e] = P->in[I_RWGNG][ch + e]; gb8[e] = P->in[I_RWGNB][ch + e]; }
    u32x4 ny0, ny1, nr, nk, nv, na0, na1, ng;
#define RF_LOAD(k_) do { const int row_ = (k_) >> 2; const size_t o_ = (size_t)row_ * D + ch; ny0 = *(const u32x4*)(Y0 + o_); ny1 = *(const u32x4*)(Y1 + o_); nr = *(const u32x4*)(R + o_); nk = *(const u32x4*)(Kx + o_); \
        nv = *(const u32x4*)(Vx + o_); na0 = *(const u32x4*)(AD + ((size_t)row_ * 2 + 0) * D + ch); na1 = *(const u32x4*)(AD + ((size_t)row_ * 2 + 1) * D + ch); ng = *(const u32x4*)(G + o_); } while (0)
    if (c.gw < T * 4) RF_LOAD(c.gw);
    for (int k = c.gw; k < T * 4; k += c.ngw) { const size_t o = (size_t)(k >> 2) * D + ch;
            float y[8]; { float ya_[8], yb_[8]; unpack8(ny0, ya_); unpack8(ny1, yb_);
#pragma unroll
                for (int e = 0; e < 8; ++e) y[e] = ya_[e] + yb_[e]; }
            float r8[8], k8[8], v8[8], a0[8], a1[8], g8[8];
            unpack8(nr, r8); unpack8(nk, k8); unpack8(nv, v8); unpack8(na0, a0); unpack8(na1, a1); unpack8(ng, g8);
            if (k + c.ngw < T * 4) RF_LOAD(k + c.ngw);
            float s = 0.f;
#pragma unroll
            for (int e = 0; e < 8; ++e) s += y[e];
            const float mean = sum8(s) * (1.0f / 64.0f); float q = 0.f;
#pragma unroll
            for (int e = 0; e < 8; ++e) { y[e] -= mean; q += y[e] * y[e]; }
            const float rstd = rsqrtf(sum8(q) * (1.0f / 64.0f) + 64e-5f);
            float bsum = 0.f;
#pragma unroll
            for (int e = 0; e < 8; ++e) { const float ka = ka8[e], rk = rk8[e];
                const float kd0 = k8[e] * (1.0f + (a0[e] - 1.0f) * ka), kd1 = k8[e] * (1.0f + (a1[e] - 1.0f) * ka); bsum += r8[e] * (kd0 + kd1) * rk; }
            bsum = sum8(bsum);
            float z[8];
#pragma unroll
            for (int e = 0; e < 8; ++e) z[e] = (y[e] * rstd * gg8[e] + gb8[e] + bsum * v8[e]) * g8[e];
            *(u32x4*)(Z + o) = (u32x4){cvt_pk_bf16(z[0], z[1]), cvt_pk_bf16(z[2], z[3]), cvt_pk_bf16(z[4], z[5]), cvt_pk_bf16(z[6], z[7])}; }
#undef RF_LOAD
}

__device__ __forceinline__ bf16x8 frag16(const LAS unsigned char* p) { return *(const LAS bf16x8*)p; }
__device__ __forceinline__ void phase_ret_scan(KP P, const Ctx& c) {
    const bf16_t* Q = (const bf16_t*)(P->ws + L_RQ); const bf16_t* Kx = (const bf16_t*)(P->ws + L_RK); const bf16_t* Vx = (const bf16_t*)(P->ws + L_RV);
    constexpr int QP = 528, TP = 144, VP = 272;
    constexpr int OFF_Q = 0, OFF_K = 33792, OFF_KT = 67584, OFF_VT = 104448, OFF_P = 122880;
    LAS unsigned char* L = c.lds;
    const int w = c.wave;
    for (int un = blockIdx.x; un < 256; un += gridDim.x) {
        const int b = un >> 6, h = (un >> 3) & 7, dir = (un >> 2) & 1, dvs = un & 3;
        bf16_t* O = (bf16_t*)(P->ws + (dir ? L_OB : L_OF));
        int tid = c.tid;
        const float gamma = 1.0f - exp2f(-5.0f - (float)h), lg2 = log2f(gamma), g63 = exp2f(63.0f * lg2);
        f32x4 Racc[16];
#pragma unroll
        for (int i = 0; i < 16; ++i) Racc[i] = (f32x4){0.f, 0.f, 0.f, 0.f};
        u32x4 pq[4], pv[2];
#define RET_LOAD_QV(ck) do { \
        _Pragma("unroll") for (int i = 0; i < 4; ++i) { const int id = tid + 512 * i, s_ = id >> 5, dc = id & 31; \
            pq[i] = *(const u32x4*)(Q + (size_t)seq_row(b, dir, (ck) * 64 + s_) * D + h * 256 + dc * 8); } \
        _Pragma("unroll") for (int i = 0; i < 2; ++i) { const int id = tid + 512 * i, s_ = id >> 4, ec = id & 15; \
            pv[i] = *(const u32x4*)(Vx + (size_t)seq_row(b, dir, (ck) * 64 + s_) * 4096 + h * 512 + dvs * 128 + ec * 8); } } while (0)
#define RET_LOAD_K(ck, dst) do { \
        _Pragma("unroll") for (int i = 0; i < 4; ++i) { const int id = tid + 512 * i, s_ = id >> 5, dc = id & 31; \
            dst[i] = *(const u32x4*)(Kx + (size_t)seq_row(b, dir, (ck) * 64 + s_) * D + h * 256 + dc * 8); } } while (0)
#define RET_STORE_K(src) do { \
        _Pragma("unroll") for (int i = 0; i < 4; ++i) { const int id = tid + 512 * i, s_ = id >> 5, dc = id & 31; *(LAS u32x4*)(L + OFF_K + s_ * QP + dc * 16) = src[i]; } } while (0)
        RET_LOAD_QV(0);
        { u32x4 pk0[4]; RET_LOAD_K(0, pk0); __syncthreads(); RET_STORE_K(pk0); }
        for (int ck = 0; ck < SLEN / 64; ++ck) {
            asm volatile("" : "+v"(tid));
            const int lane = tid & 63, r16 = lane & 15, q4 = lane >> 4;
            __syncthreads();
#pragma unroll
            for (int i = 0; i < 4; ++i) { const int id = tid + 512 * i, s_ = id >> 5, dc = id & 31; *(LAS u32x4*)(L + OFF_Q + s_ * QP + dc * 16) = pq[i]; }
#pragma unroll
            for (int i = 0; i < 2; ++i) { const int id = tid + 512 * i, s_ = id >> 4, ec = id & 15; *(LAS u32x4*)(L + OFF_P + s_ * VP + ec * 16) = pv[i]; }
            __syncthreads();
            if (ck + 1 < SLEN / 64) RET_LOAD_QV(ck + 1);
            {   const float vs = exp2f(-lg2 * (float)lane);
#pragma unroll
                for (int i = 0; i < 4; ++i) { const int dc = w + 8 * i;
                    const u32x4 raw = *(const LAS u32x4*)(L + OFF_K + lane * QP + dc * 16);
#pragma unroll
                    for (int e = 0; e < 4; ++e) { *(LAS unsigned short*)(L + OFF_KT + (dc * 8 + 2 * e) * TP + lane * 2) = (unsigned short)(raw[e] & 0xffffu); *(LAS unsigned short*)(L + OFF_KT + (dc * 8 + 2 * e + 1) * TP + lane * 2) = (unsigned short)(raw[e] >> 16); } }
#pragma unroll
                for (int i = 0; i < 2; ++i) { const int ec = w + 8 * i; float t8[8]; unpack8(*(const LAS u32x4*)(L + OFF_P + lane * VP + ec * 16), t8);
#pragma unroll
                    for (int e = 0; e < 4; ++e) { const unsigned pk2 = cvt_pk_bf16(t8[2 * e] * vs, t8[2 * e + 1] * vs);
                        *(LAS unsigned short*)(L + OFF_VT + (ec * 8 + 2 * e) * TP + lane * 2) = (unsigned short)(pk2 & 0xffffu); *(LAS unsigned short*)(L + OFF_VT + (ec * 8 + 2 * e + 1) * TP + lane * 2) = (unsigned short)(pk2 >> 16); } } }
            const int it_s = w >> 1, jt0 = 2 * (w & 1);
            f32x4 s0 = (f32x4){0.f, 0.f, 0.f, 0.f}, s1 = s0;
#pragma unroll
            for (int ks = 0; ks < 8; ++ks) { const int co = (32 * ks + 8 * q4) * 2; if ((ks & 1) == 0) asm volatile("" ::: "memory");
                const bf16x8 qf = frag16(L + OFF_Q + (16 * it_s + r16) * QP + co), k0 = frag16(L + OFF_K + (16 * jt0 + r16) * QP + co), k1 = frag16(L + OFF_K + (16 * jt0 + 16 + r16) * QP + co);
                s0 = __builtin_amdgcn_mfma_f32_16x16x32_bf16(k0, qf, s0, 0, 0, 0); s1 = __builtin_amdgcn_mfma_f32_16x16x32_bf16(k1, qf, s1, 0, 0, 0); }
            __syncthreads();
            {   const int i_ = 16 * it_s + r16; const float gi = exp2f(lg2 * (float)i_);
                const int j0 = 16 * jt0 + 4 * q4, j1 = j0 + 16; float p0[4], p1[4];
#pragma unroll
                for (int r = 0; r < 4; ++r) { p0[r] = (j0 + r <= i_) ? s0[r] * gi : 0.f; p1[r] = (j1 + r <= i_) ? s1[r] * gi : 0.f; }
                *(LAS u32x2*)(L + OFF_P + i_ * TP + j0 * 2) = (u32x2){cvt_pk_bf16(p0[0], p0[1]), cvt_pk_bf16(p0[2], p0[3])};
                *(LAS u32x2*)(L + OFF_P + i_ * TP + j1 * 2) = (u32x2){cvt_pk_bf16(p1[0], p1[1]), cvt_pk_bf16(p1[2], p1[3])}; }
            __syncthreads();
            u32x4 pkn[4]; const bool has_next = ck + 1 < SLEN / 64;
            if (has_next) RET_LOAD_K(ck + 1, pkn);
            const LAS unsigned char* vtp = L + OFF_VT + (16 * w + r16) * TP + (8 * q4) * 2;
#pragma unroll
            for (int it = 0; it < 4; ++it) { const int i_ = 16 * it + r16; f32x4 a = (f32x4){0.f, 0.f, 0.f, 0.f};
                asm volatile("" ::: "memory");
#pragma unroll
                for (int m = 0; m < 8; ++m) {
                    const u32x4 t = (u32x4){cvt_pk_bf16(Racc[2 * m][0], Racc[2 * m][1]), cvt_pk_bf16(Racc[2 * m][2], Racc[2 * m][3]), cvt_pk_bf16(Racc[2 * m + 1][0], Racc[2 * m + 1][1]), cvt_pk_bf16(Racc[2 * m + 1][2], Racc[2 * m + 1][3])};
                    const LAS unsigned char* qp = L + OFF_Q + i_ * QP + (32 * m + 4 * q4) * 2; const u32x2 lo = *(const LAS u32x2*)qp, hi = *(const LAS u32x2*)(qp + 32);
                    const u32x4 tq = (u32x4){lo.x, lo.y, hi.x, hi.y}; a = __builtin_amdgcn_mfma_f32_16x16x32_bf16(__builtin_bit_cast(bf16x8, t), __builtin_bit_cast(bf16x8, tq), a, 0, 0, 0); }
                a = a * exp2f(lg2 * (float)(i_ + 1));
#pragma unroll
                for (int ks = 0; ks < 2; ++ks) a = __builtin_amdgcn_mfma_f32_16x16x32_bf16(frag16(vtp + 64 * ks), frag16(L + OFF_P + i_ * TP + (32 * ks + 8 * q4) * 2), a, 0, 0, 0);
                *(u32x2*)(O + (size_t)seq_row(b, dir, ck * 64 + i_) * 4096 + h * 512 + dvs * 128 + 16 * w + 4 * q4) = (u32x2){cvt_pk_bf16(a[0], a[1]), cvt_pk_bf16(a[2], a[3])}; }
            if (has_next) RET_STORE_K(pkn);
#pragma unroll
            for (int dt = 0; dt < 16; ++dt) { if ((dt & 1) == 0) asm volatile("" ::: "memory");
                f32x4 u = Racc[dt] * gamma;
#pragma unroll
                for (int ks = 0; ks < 2; ++ks) u = __builtin_amdgcn_mfma_f32_16x16x32_bf16(frag16(L + OFF_KT + (16 * dt + r16) * TP + (32 * ks + 8 * q4) * 2), frag16(vtp + 64 * ks), u, 0, 0, 0);
                Racc[dt] = u * g63; }
        }
#undef RET_LOAD_QV
#undef RET_LOAD_K
#undef RET_STORE_K
        __syncthreads();
    }
}
__device__ __forceinline__ void phase_ret_merge(KP P, const Ctx& c) {
    const bf16_t* OF = (const bf16_t*)(P->ws + L_OF); const bf16_t* OB = (const bf16_t*)(P->ws + L_OB); const bf16_t* GF = (const bf16_t*)(P->ws + L_GF); const bf16_t* GB = (const bf16_t*)(P->ws + L_GB);
    bf16_t* Z = (bf16_t*)(P->ws + L_RZ);
    u32x4 nf, nb, ngf, ngb;
#define RM_LOAD(k_) do { const size_t o_ = (size_t)(k_) * 512 + c.lane * 8; nf = *(const u32x4*)(OF + o_); nb = *(const u32x4*)(OB + o_); ngf = *(const u32x4*)(GF + o_); ngb = *(const u32x4*)(GB + o_); } while (0)
    if (c.gw < T * 8) RM_LOAD(c.gw);
    for (int k = c.gw; k < T * 8; k += c.ngw) { const size_t o = (size_t)k * 512 + c.lane * 8;
            float f[8], bk[8], gf[8], gb[8]; unpack8(nf, f); unpack8(nb, bk); unpack8(ngf, gf); unpack8(ngb, gb);
            if (k + c.ngw < T * 8) RM_LOAD(k + c.ngw);
            float sf = 0.f, sb = 0.f;
#pragma unroll
            for (int e = 0; e < 8; ++e) { sf += f[e]; sb += bk[e]; }
            const float mf = wave_sum(sf) * (1.0f / 512.0f), mb = wave_sum(sb) * (1.0f / 512.0f); float qf = 0.f, qb = 0.f;
#pragma unroll
            for (int e = 0; e < 8; ++e) { f[e] -= mf; bk[e] -= mb; qf += f[e] * f[e]; qb += bk[e] * bk[e]; }
            const float rf = rsqrtf(wave_sum(qf) * (1.0f / 512.0f) + LN_EPS), rb = rsqrtf(wave_sum(qb) * (1.0f / 512.0f) + LN_EPS);
            float z[8];
#pragma unroll
            for (int e = 0; e < 8; ++e) z[e] = gf[e] * (f[e] * rf) + gb[e] * (bk[e] * rb);
            *(u32x4*)(Z + o) = (u32x4){cvt_pk_bf16(z[0], z[1]), cvt_pk_bf16(z[2], z[3]), cvt_pk_bf16(z[4], z[5]), cvt_pk_bf16(z[6], z[7])}; }
#undef RM_LOAD
}

__device__ __forceinline__ Ctx make_ctx(LAS unsigned char* lds) {
    int t = threadIdx.x; asm volatile("" : "+v"(t));
    Ctx c; c.lds = lds; c.tid = t; c.lane = t & 63; c.wave = __builtin_amdgcn_readfirstlane(t >> 6);
    c.gw = blockIdx.x * 8 + c.wave; c.ngw = gridDim.x * 8; c.gtid = blockIdx.x * 512 + t; c.ngt = gridDim.x * 512; return c;
}
#define GRID_BAR() xcd_barrier(bar)
template <class Epi, class GT> __device__ __forceinline__ void run_gemm_m(LAS unsigned char* lds, const GT& g, int M, int N, const Epi& E) {
    pg8::StaticOrder S; S.init(M, N, (int)gridDim.x, (int)blockIdx.x); pg8::gemm_phase<Epi, GT>(lds, g, S, E);
}
template <class Epi, class GT> __device__ __forceinline__ void run_gemm(LAS unsigned char* lds, const GT& g, int N, const Epi& E, int pm0 = 0) {
    pg8::StaticOrder S; S.init(T, N, (int)gridDim.x, (int)blockIdx.x, pm0); pg8::gemm_phase<Epi, GT>(lds, g, S, E);
}
template <int LAYER, bool LAST> __device__ __forceinline__ void peer_phases(LAS unsigned char* lds, const XcdBarrier& bar) {
    phase_ln_mid(kp_fresh(), make_ctx(lds), LAYER, LAST ? NCTX : 0); GRID_BAR();
    PROBE_REP(2) { KP P = kp_fresh(); unsigned char* ws = P->ws; GPlain g{(const bf16_t*)(ws + WS_H2), (const bf16_t*)(ws + WS_WQ) + (size_t)LAYER * D * D, D, D, D}; EpiF32Plain E{(float*)(ws + WS_S), D}; run_gemm(lds, g, D, E, LAST ? 4 : 0);
        if (!LAST && _rep == 0) { constexpr int NR = 8 * 16384, SH = (NR + 2) / 3; const int lo = LAYER * SH, hi = (LAYER == 2) ? NR : (LAYER + 1) * SH;
            if ((int)gridDim.x == 256) { if ((int)blockIdx.x >= 32) peer_convert_rows(kp_fresh(), make_ctx(lds), lo, hi, (int)blockIdx.x - 32, 224); }
            else peer_convert_rows(kp_fresh(), make_ctx(lds), lo, hi, (int)blockIdx.x, (int)gridDim.x); }
        GRID_BAR(); }
    PROBE_REP(1) { phase_peer_select(kp_fresh(), make_ctx(lds), LAST ? NCTX : 0); GRID_BAR(); }
    PROBE_REP(0) { phase_peer_u(kp_fresh(), make_ctx(lds), LAYER, LAST ? NCTX : 0, _rep); GRID_BAR(); }
    phase_peer_c(kp_fresh(), make_ctx(lds), LAYER, LAST ? NCTX : 0); GRID_BAR();
    PROBE_REP(9) { phase_peer_v(kp_fresh(), make_ctx(lds), LAYER, LAST ? NCTX : 0, _rep); GRID_BAR(); }
    phase_peer_final<LAST>(kp_fresh(), make_ctx(lds), LAYER); GRID_BAR();
}
template <int LAYER, int JL> __device__ __forceinline__ void rg_phases(LAS unsigned char* lds, const XcdBarrier& bar) {
    PROBE_REP(6) { KP P = kp_fresh(); unsigned char* ws = P->ws; GPlain g{(const bf16_t*)(ws + WS_A0), (const bf16_t*)(ws + WS_RGIN) + (size_t)JL * 4096 * D, D, D, D}; EpiRgIn E{(bf16_t*)(ws + L_UG), (bf16_t*)(ws + L_UR)}; run_gemm(lds, g, 4096, E); GRID_BAR(); }
    PROBE_REP(7) { phase_rg_conv(kp_fresh(), make_ctx(lds), JL); GRID_BAR(); }
    { KP P = kp_fresh(); unsigned char* ws = P->ws; GGate g{(const bf16_t*)(ws + L_XC), (const bf16_t*)(ws + WS_RGGATE) + (size_t)JL * 8192 * 256, 256, D, 256};
      EpiRgGate E{(const bf16_t*)(ws + L_XC), (bf16_t*)(ws + L_LA), (bf16_t*)(ws + L_BB), P->in[I_RGGB] + (size_t)JL * 4 * D, (const float*)(ws + WS_SPT) + (size_t)JL * 2 * D}; PROBE_REP(11) { run_gemm(lds, g, 8192, E); GRID_BAR(); } }
    PROBE_REP(3) { phase_rg_scan1(kp_fresh(), make_ctx(lds)); GRID_BAR();
    phase_rg_scan2(kp_fresh(), make_ctx(lds)); GRID_BAR();
    phase_rg_scan3<0>(kp_fresh(), make_ctx(lds)); GRID_BAR();
    phase_rg_scan3<1>(kp_fresh(), make_ctx(lds)); GRID_BAR(); }
    { KP P = kp_fresh(); unsigned char* ws = P->ws; GPlain g{(const bf16_t*)(ws + L_YIN), (const bf16_t*)(ws + WS_RGOUT) + (size_t)JL * D * D, D, D, D}; EpiF32Plain E{(float*)(ws + WS_S), D}; run_gemm(lds, g, D, E, LAYER == 3 ? 4 : 0); } GRID_BAR();
}
template <int LAYER> __device__ __forceinline__ void rw_phases(LAS unsigned char* lds, const XcdBarrier& bar) {
    PROBE_REP(7) { phase_rw_mix(kp_fresh(), make_ctx(lds), LAYER); GRID_BAR(); }
    PROBE_REP(6) { KP P = kp_fresh(); unsigned char* ws = P->ws; GRw1 g{(const bf16_t*)(ws + L_AALL), (const bf16_t*)(ws + WS_RW1), D, 6 * D, D}; EpiRw1 E{(bf16_t*)(ws + L_RKV), (bf16_t*)(ws + L_A2)}; run_gemm(lds, g, 6912, E); GRID_BAR(); }
    { KP P = kp_fresh(); unsigned char* ws = P->ws; GRw2 g{(const bf16_t*)(ws + L_A2), (const bf16_t*)(ws + WS_RW2), 256, 768, 256}; EpiRw2 E{(bf16_t*)(ws + L_W), (bf16_t*)(ws + L_AD), (bf16_t*)(ws + L_G), P->in[I_RWDEC0], P->in[I_RWICL0]}; PROBE_REP(12) { run_gemm(lds, g, 10240, E); GRID_BAR(); } }
    PROBE_REP(4) { phase_rw_scan(kp_fresh(), make_ctx(lds)); GRID_BAR(); }
    PROBE_REP(7) { phase_rw_finish(kp_fresh(), make_ctx(lds)); GRID_BAR(); }
    { KP P = kp_fresh(); unsigned char* ws = P->ws; GPlain g{(const bf16_t*)(ws + L_Z), (const bf16_t*)(ws + WS_RWO), D, D, D}; EpiF32Plain E{(float*)(ws + WS_S), D}; run_gemm(lds, g, D, E); } GRID_BAR();
}
template <int LAYER> __device__ __forceinline__ void ret_phases(LAS unsigned char* lds, const XcdBarrier& bar) {
    { KP P = kp_fresh(); unsigned char* ws = P->ws; GPlain g{(const bf16_t*)(ws + WS_A0), (const bf16_t*)(ws + WS_RETIN), D, D, D};
      EpiRetIn E{(bf16_t*)(ws + L_RQ), (bf16_t*)(ws + L_RK), (bf16_t*)(ws + L_RV), (bf16_t*)(ws + L_GF), (bf16_t*)(ws + L_GB), (const float*)(ws + WS_CS)}; PROBE_REP(10) { run_gemm(lds, g, 16384, E); GRID_BAR(); } }
    PROBE_REP(5) { phase_ret_scan(kp_fresh(), make_ctx(lds)); GRID_BAR(); }
    PROBE_REP(7) { phase_ret_merge(kp_fresh(), make_ctx(lds)); GRID_BAR(); }
    { KP P = kp_fresh(); unsigned char* ws = P->ws; GPlain g{(const bf16_t*)(ws + L_RZ), (const bf16_t*)(ws + WS_RETOUT), 4096, 4096, 4096}; EpiF32Plain E{(float*)(ws + WS_S), D}; run_gemm(lds, g, D, E); } GRID_BAR();
}

__global__ void __launch_bounds__(512, 2) hybrid_fwd(Params Pkernarg) {
    extern __shared__ __attribute__((aligned(16))) unsigned char lds_raw[];
    LAS unsigned char* lds = (LAS unsigned char*)lds_raw;
    volatile LAS unsigned* MISC = (volatile LAS unsigned*)(lds + MISC_OFF);
    if (threadIdx.x < 64) MISC[threadIdx.x] = 0u;
    __syncthreads();
    XcdBarrier bar = xcd_barrier_post((unsigned*)(kp_fresh()->ws + WS_CTL) + 4096, MISC + 8);

    if ((PROBE >> 13) & 1) { for (int i = 0; i < 64; ++i) GRID_BAR(); }
    PROBE_REP(8) { phase_prologue(kp_fresh(), make_ctx(lds)); GRID_BAR(); }
    { KP P = kp_fresh(); unsigned char* ws = P->ws; GFold g{(const bf16_t*)(ws + WS_KEYS), (const bf16_t*)(ws + WS_WQN), 256, 256, D}; EpiBf16Plain E{(bf16_t*)(ws + WS_WQ), D}; run_gemm_m(lds, g, 4 * D, D, E); }
    phase_modfin(kp_fresh(), make_ctx(lds)); GRID_BAR();
    phase_xinit(kp_fresh(), make_ctx(lds)); GRID_BAR();
    rg_phases<0, 0>(lds, bar);  peer_phases<0, false>(lds, bar);
    rw_phases<1>(lds, bar);     peer_phases<1, false>(lds, bar);
    ret_phases<2>(lds, bar);    peer_phases<2, false>(lds, bar);
    rg_phases<3, 1>(lds, bar);  peer_phases<3, true>(lds, bar);
}

extern "C" void kernel_launch(void* const* d_in, const int* in_sizes, int n_in, void* d_out, int out_size, void* d_ws, size_t ws_size, hipStream_t stream) {
    static int grid = 0;
    if (!grid) {
        if (n_in != 37 || ws_size < WS_END) { fprintf(stderr, "kernel_launch: unexpected problem (n_in %d, ws %zu)\n", n_in, ws_size); grid = -1; return; }
        int dev = 0, cus = 0, per_cu = 0;
        if (hipGetDevice(&dev) != hipSuccess || hipDeviceGetAttribute(&cus, hipDeviceAttributeMultiprocessorCount, dev) != hipSuccess) { grid = -1; return; }
        if (hipFuncSetAttribute((const void*)hybrid_fwd, hipFuncAttributeMaxDynamicSharedMemorySize, LDS_BYTES) != hipSuccess) { fprintf(stderr, "kernel_launch: hipFuncSetAttribute failed\n"); grid = -1; return; }
        if (hipOccupancyMaxActiveBlocksPerMultiprocessor(&per_cu, (const void*)hybrid_fwd, 512, LDS_BYTES) != hipSuccess || per_cu < 1) { fprintf(stderr, "kernel_launch: occupancy query says %d\n", per_cu); grid = -1; return; }
        grid = cus;
    }
    if (grid <= 0) return;
    hipMemsetAsync((char*)d_ws + WS_CTL, 0, CTL_BYTES, stream);
    Params p; memset(&p, 0, sizeof(p));
    for (int i = 0; i < 37; ++i) p.in[i] = (const float*)d_in[i];
    p.out = (float*)d_out; p.ws = (unsigned char*)d_ws;
    hipLaunchKernelGGL(hybrid_fwd, dim3(grid), dim3(512), LDS_BYTES, stream, p);
}
```

```cpp
#include <hip/hip_runtime.h>
#include <cstdio>
#include <cstring>

#define LAS __attribute__((address_space(3)))
typedef unsigned short bf16_t;
typedef short bf16x8 __attribute__((ext_vector_type(8)));
typedef float f32x4 __attribute__((ext_vector_type(4)));
typedef float f32x2 __attribute__((ext_vector_type(2)));
typedef unsigned u32x4 __attribute__((ext_vector_type(4)));
typedef unsigned u32x2 __attribute__((ext_vector_type(2)));
typedef __bf16 bf16v2 __attribute__((ext_vector_type(2)));

#ifndef DBG_ZERO
#define DBG_ZERO 0
#endif
#ifndef PROBE
#define PROBE 0
#endif
#define PROBE_REP(bit) for (int _rep = 0; _rep < (((PROBE) >> (bit)) & 1) + 1; ++_rep)
constexpr int D = 2048, NBATCH = 4, SEQ = 4096, CTX = 256;
constexpr int NCTX = NBATCH * CTX, NLAT = NBATCH * SEQ, T = NCTX + NLAT;
constexpr int SLEN = CTX + SEQ;
constexpr float ALPHA = 1.681792830507429f;
constexpr float LN_EPS = 1e-5f;
constexpr size_t TD = (size_t)T * D;

constexpr size_t MiB = 1u << 20;
constexpr size_t WS_CTL = 0, CTL_BYTES = 1 * MiB;
constexpr size_t WS_MODP = 2 * MiB;
constexpr size_t WS_MOD = 10 * MiB;
constexpr size_t WS_CS = 11 * MiB;
constexpr size_t WS_SPT = 15 * MiB + 512 * 1024;
constexpr size_t WS_CA = 16 * MiB, WS_CH = 21 * MiB, WS_CIN = 26 * MiB;
constexpr size_t WS_WQ = 32 * MiB;
constexpr size_t WS_KEYS = 64 * MiB;
constexpr size_t WS_RGIN = 68 * MiB;
constexpr size_t WS_RGGATE = 100 * MiB;
constexpr size_t WS_RGOUT = 108 * MiB;
constexpr size_t WS_RW1 = 124 * MiB;
constexpr size_t WS_RW2 = 152 * MiB;
constexpr size_t WS_RWO = 160 * MiB;
constexpr size_t WS_RETIN = 168 * MiB;
constexpr size_t WS_RETOUT = 232 * MiB;
constexpr size_t WS_PU = 256 * MiB;
constexpr size_t WS_PV = 384 * MiB;
constexpr size_t WS_PSC = 512 * MiB;
constexpr size_t WS_X = 768 * MiB;
constexpr size_t WS_A0 = 904 * MiB;
constexpr size_t WS_H2 = 972 * MiB;
constexpr size_t WS_Q = 1040 * MiB;
constexpr size_t WS_WQN = 1040 * MiB;
constexpr size_t WS_S = 1108 * MiB;
constexpr size_t WS_L = 1244 * MiB;
constexpr size_t WS_SELW = 1893 * MiB;
constexpr size_t WS_END = 1902 * MiB;
constexpr size_t P_SE16 = WS_L + 288 * MiB;
constexpr size_t P_PART = WS_L, P_Y = WS_L + 136 * MiB, P_C = WS_L + 272 * MiB;
constexpr int CW_PQ = 16384;
constexpr size_t L_UG = WS_L, L_UR = WS_L + 68 * MiB, L_XC = WS_L + 136 * MiB, L_LA = WS_L + 204 * MiB, L_BB = WS_L + 340 * MiB, L_YIN = WS_L + 476 * MiB;
constexpr size_t L_AALL = WS_L;
constexpr size_t L_W = WS_L, L_AD = WS_L + 136 * MiB, L_G = WS_L + 272 * MiB;
constexpr size_t L_RKV = WS_L + 408 * MiB;
constexpr size_t L_A2 = WS_L + 612 * MiB;
constexpr size_t L_Y0 = WS_H2, L_Y1 = WS_H2 + 136 * MiB;
constexpr size_t L_Z = WS_A0;
constexpr size_t L_RQ = WS_L, L_RK = WS_L + 68 * MiB, L_RV = WS_L + 136 * MiB, L_GF = WS_L + 272 * MiB, L_GB = WS_L + 408 * MiB;
constexpr size_t L_OF = WS_H2, L_OB = WS_H2 + 136 * MiB;
constexpr size_t L_RZ = WS_L;

__device__ __forceinline__ float bf2f(unsigned b) { return __uint_as_float(b << 16); }
__device__ __forceinline__ unsigned cvt_pk_bf16(float lo, float hi) { bf16v2 t; t.x = (__bf16)lo; t.y = (__bf16)hi; return __builtin_bit_cast(unsigned, t); }
__device__ __forceinline__ float bflo(unsigned u) { return __uint_as_float(u << 16); }
__device__ __forceinline__ float bfhi(unsigned u) { return __uint_as_float(u & 0xffff0000u); }
__device__ __forceinline__ float sigmoidf_(float x) { return 1.0f / (1.0f + __expf(-x)); }
__device__ __forceinline__ float siluf_(float x) { return x / (1.0f + __expf(-x)); }
__device__ __forceinline__ float tanhf_(float x) { return 1.0f - 2.0f / (1.0f + __expf(2.0f * x)); }
__device__ __forceinline__ float gelu_tanh(float x) { const float z = 1.5957691216057308f * (x + 0.044715f * x * x * x); return x / (1.0f + __expf(-z)); }
__device__ __forceinline__ void unpack8(const u32x4 u, float (&f)[8]) { f[0] = bflo(u.x); f[1] = bfhi(u.x); f[2] = bflo(u.y); f[3] = bfhi(u.y); f[4] = bflo(u.z); f[5] = bfhi(u.z); f[6] = bflo(u.w); f[7] = bfhi(u.w); }
template <int CTRL> __device__ __forceinline__ float dpp_mov(float v) { const int x = __builtin_bit_cast(int, v); return __builtin_bit_cast(float, __builtin_amdgcn_update_dpp(x, x, CTRL, 0xF, 0xF, false)); }
__device__ __forceinline__ float rl_f(float v, int lane) { return __builtin_bit_cast(float, __builtin_amdgcn_readlane(__builtin_bit_cast(int, v), lane)); }
__device__ __forceinline__ float sum8(float v) { v += dpp_mov<0xB1>(v); v += dpp_mov<0x4E>(v); v += dpp_mov<0x141>(v); return v; }
__device__ __forceinline__ float sum16(float v) { v = sum8(v); v += dpp_mov<0x140>(v); return v; }
__device__ __forceinline__ float fma_s(float a, float b, float c) { float d; asm("v_fma_f32 %0, %1, %2, %3" : "=v"(d) : "v"(a), "v"(b), "v"(c)); return d; }
__device__ __forceinline__ float mul_s(float a, float b) { float d; asm("v_mul_f32 %0, %1, %2" : "=v"(d) : "v"(a), "v"(b)); return d; }
__device__ __forceinline__ void sum8_pair(float& a, float& b) {
    asm volatile("s_nop 1\n\t"
        "v_add_f32_dpp %0, %0, %0 quad_perm:[1,0,3,2] row_mask:0xf bank_mask:0xf\n\tv_add_f32_dpp %1, %1, %1 quad_perm:[1,0,3,2] row_mask:0xf bank_mask:0xf\n\ts_nop 0\n\t"
        "v_add_f32_dpp %0, %0, %0 quad_perm:[2,3,0,1] row_mask:0xf bank_mask:0xf\n\tv_add_f32_dpp %1, %1, %1 quad_perm:[2,3,0,1] row_mask:0xf bank_mask:0xf\n\ts_nop 0\n\t"
        "v_add_f32_dpp %0, %0, %0 row_half_mirror row_mask:0xf bank_mask:0xf\n\tv_add_f32_dpp %1, %1, %1 row_half_mirror row_mask:0xf bank_mask:0xf"
        : "+v"(a), "+v"(b));
}
__device__ __forceinline__ void sum16_pair(float& a, float& b) {
    asm volatile("s_nop 1\n\t"
        "v_add_f32_dpp %0, %0, %0 quad_perm:[1,0,3,2] row_mask:0xf bank_mask:0xf\n\tv_add_f32_dpp %1, %1, %1 quad_perm:[1,0,3,2] row_mask:0xf bank_mask:0xf\n\ts_nop 0\n\t"
        "v_add_f32_dpp %0, %0, %0 quad_perm:[2,3,0,1] row_mask:0xf bank_mask:0xf\n\tv_add_f32_dpp %1, %1, %1 quad_perm:[2,3,0,1] row_mask:0xf bank_mask:0xf\n\ts_nop 0\n\t"
        "v_add_f32_dpp %0, %0, %0 row_half_mirror row_mask:0xf bank_mask:0xf\n\tv_add_f32_dpp %1, %1, %1 row_half_mirror row_mask:0xf bank_mask:0xf\n\ts_nop 0\n\t"
        "v_add_f32_dpp %0, %0, %0 row_mirror row_mask:0xf bank_mask:0xf\n\tv_add_f32_dpp %1, %1, %1 row_mirror row_mask:0xf bank_mask:0xf"
        : "+v"(a), "+v"(b));
}
__device__ __forceinline__ void sum16_quad(float& a, float& b, float& c, float& d) {
    asm volatile("s_nop 1\n\t"
        "v_add_f32_dpp %0, %0, %0 quad_perm:[1,0,3,2] row_mask:0xf bank_mask:0xf\n\tv_add_f32_dpp %1, %1, %1 quad_perm:[1,0,3,2] row_mask:0xf bank_mask:0xf\n\t"
        "v_add_f32_dpp %2, %2, %2 quad_perm:[1,0,3,2] row_mask:0xf bank_mask:0xf\n\tv_add_f32_dpp %3, %3, %3 quad_perm:[1,0,3,2] row_mask:0xf bank_mask:0xf\n\t"
        "v_add_f32_dpp %0, %0, %0 quad_perm:[2,3,0,1] row_mask:0xf bank_mask:0xf\n\tv_add_f32_dpp %1, %1, %1 quad_perm:[2,3,0,1] row_mask:0xf bank_mask:0xf\n\t"
        "v_add_f32_dpp %2, %2, %2 quad_perm:[2,3,0,1] row_mask:0xf bank_mask:0xf\n\tv_add_f32_dpp %3, %3, %3 quad_perm:[2,3,0,1] row_mask:0xf bank_mask:0xf\n\t"
        "v_add_f32_dpp %0, %0, %0 row_half_mirror row_mask:0xf bank_mask:0xf\n\tv_add_f32_dpp %1, %1, %1 row_half_mirror row_mask:0xf bank_mask:0xf\n\t"
        "v_add_f32_dpp %2, %2, %2 row_half_mirror row_mask:0xf bank_mask:0xf\n\tv_add_f32_dpp %3, %3, %3 row_half_mirror row_mask:0xf bank_mask:0xf\n\t"
        "v_add_f32_dpp %0, %0, %0 row_mirror row_mask:0xf bank_mask:0xf\n\tv_add_f32_dpp %1, %1, %1 row_mirror row_mask:0xf bank_mask:0xf\n\t"
        "v_add_f32_dpp %2, %2, %2 row_mirror row_mask:0xf bank_mask:0xf\n\tv_add_f32_dpp %3, %3, %3 row_mirror row_mask:0xf bank_mask:0xf"
        : "+v"(a), "+v"(b), "+v"(c), "+v"(d));
}
__device__ __forceinline__ void sum8_quad(float& a, float& b, float& c, float& d) {
    asm volatile("s_nop 1\n\t"
        "v_add_f32_dpp %0, %0, %0 quad_perm:[1,0,3,2] row_mask:0xf bank_mask:0xf\n\tv_add_f32_dpp %1, %1, %1 quad_perm:[1,0,3,2] row_mask:0xf bank_mask:0xf\n\t"
        "v_add_f32_dpp %2, %2, %2 quad_perm:[1,0,3,2] row_mask:0xf bank_mask:0xf\n\tv_add_f32_dpp %3, %3, %3 quad_perm:[1,0,3,2] row_mask:0xf bank_mask:0xf\n\t"
        "v_add_f32_dpp %0, %0, %0 quad_perm:[2,3,0,1] row_mask:0xf bank_mask:0xf\n\tv_add_f32_dpp %1, %1, %1 quad_perm:[2,3,0,1] row_mask:0xf bank_mask:0xf\n\t"
        "v_add_f32_dpp %2, %2, %2 quad_perm:[2,3,0,1] row_mask:0xf bank_mask:0xf\n\tv_add_f32_dpp %3, %3, %3 quad_perm:[2,3,0,1] row_mask:0xf bank_mask:0xf\n\t"
        "v_add_f32_dpp %0, %0, %0 row_half_mirror row_mask:0xf bank_mask:0xf\n\tv_add_f32_dpp %1, %1, %1 row_half_mirror row_mask:0xf bank_mask:0xf\n\t"
        "v_add_f32_dpp %2, %2, %2 row_half_mirror row_mask:0xf bank_mask:0xf\n\tv_add_f32_dpp %3, %3, %3 row_half_mirror row_mask:0xf bank_mask:0xf"
        : "+v"(a), "+v"(b), "+v"(c), "+v"(d));
}
__device__ __forceinline__ float wave_sum(float v) { v = sum8(v); v += dpp_mov<0x140>(v); return (rl_f(v, 0) + rl_f(v, 16)) + (rl_f(v, 32) + rl_f(v, 48)); }
__device__ __forceinline__ float wave_max(float v) {
    v = fmaxf(v, dpp_mov<0xB1>(v)); v = fmaxf(v, dpp_mov<0x4E>(v)); v = fmaxf(v, dpp_mov<0x141>(v)); v = fmaxf(v, dpp_mov<0x140>(v));
    return fmaxf(fmaxf(rl_f(v, 0), rl_f(v, 16)), fmaxf(rl_f(v, 32), rl_f(v, 48)));
}
__device__ __forceinline__ int row_vec(int row) { return row < NCTX ? 4 : ((row - NCTX) >> 12); }
__device__ __forceinline__ int panel_vec(int pm) { return pm < 4 ? 4 : ((pm - 4) >> 4); }
__device__ __forceinline__ int seq_row(int b, int dir, int s) {
    if (s < CTX) { const int t = dir ? (CTX - 1 - s) : s; return b * CTX + t; }
    int t = s - CTX; if (dir) t = SEQ - 1 - t; return NCTX + b * SEQ + t;
}
__device__ __forceinline__ int row_pos(int row) { return row < NCTX ? (row & (CTX - 1)) : CTX + ((row - NCTX) & (SEQ - 1)); }

namespace pg8 {
constexpr int BM = 256, BK = 64, HALF = 128, HTB = HALF * BK * 2, STAGE_BYTES = 8 * HTB, NXCD = 8, WGM = 8;
__host__ __device__ __forceinline__ int lds_byte(int r, int c) { const int st = (r >> 4) * 2 + (c >> 5), rr = r & 15, cc = c & 31, ob = rr * 64 + cc * 2; return st * 1024 + (ob ^ (((ob >> 9) & 1) << 5)); }
__host__ __device__ __forceinline__ void stage_rc(int b, int& R, int& C) { const int st = b / 1024, sb = b % 1024, swz = sb ^ (((sb >> 9) & 1) << 5); R = (st >> 1) * 16 + swz / 64; C = (st & 1) * 32 + (swz % 64) / 2; }
__host__ __device__ __forceinline__ int perm32(int rho) { const int n = rho >> 4, i = rho & 15; return 8 * (i >> 2) + 4 * n + (i & 3); }
struct Unit { int pm, pn; };
struct StaticOrder {
    int nM, nN, nwg, G, c, pm0;
    __device__ void init(int M, int N, int G_, int c_, int pm0_ = 0) { pm0 = pm0_; nM = M / BM - pm0_; nN = N / BM; nwg = nM * nN; G = G_; c = c_; }
    __device__ bool next(int i, Unit& u) const {
        const long L = (long)i * G + c; if (L >= nwg) return false;
        int wgid = (int)L; { const int q = nwg / NXCD, r = nwg % NXCD, xcd = wgid % NXCD, off = wgid / NXCD; wgid = (xcd < r ? xcd * (q + 1) : r * (q + 1) + (xcd - r) * q) + off; }
        const int nig = WGM * nN, gid = wgid / nig, fm = gid * WGM, gsz = (nM - fm) < WGM ? (nM - fm) : WGM;
        u.pm = pm0 + fm + ((wgid % nig) % gsz); u.pn = (wgid % nig) / gsz; return true;
    }
};
template <class Epi, class GT>
__device__ __forceinline__ void gemm_phase(LAS unsigned char* lds, const GT g, const StaticOrder& S, const Epi& E) {
    int tid_ = threadIdx.x; asm volatile("" : "+v"(tid_));
    const int tid = tid_, wid = __builtin_amdgcn_readfirstlane(tid >> 6), lane = tid & 63, wr = wid >> 2, wc = wid & 3, fr = lane & 15, fq = lane >> 4;
    const int K = g.K, nt = K / BK;
    unsigned voffA[2], voffB[2];
#pragma unroll
    for (int i = 0; i < 2; ++i) { int R, C; stage_rc(tid * 16 + i * 8192, R, C); const int Rb = Epi::PERM ? ((R & ~31) + perm32(R & 31)) : R;
        voffA[i] = (unsigned)(R * g.lda + C) * 2u; voffB[i] = (unsigned)(Rb * g.ldb + C) * 2u; }
    const size_t kstep = (size_t)(BK * 2);
    const size_t hstepA = (size_t)HALF * g.lda * 2, hstepB = (size_t)HALF * g.ldb * 2;
    const unsigned ldsw = (unsigned)wid * 1024u;
    const int aoff = lds_byte(wr * 64 + fr, fq * 8), boff = lds_byte(wc * 32 + fr, fq * 8);
#define PG8_SA(b, h) (((b) * 2 + (h)) * HTB)
#define PG8_SB(b, h) ((4 + (b) * 2 + (h)) * HTB)
#define PG8_STAGE(bufoff, gbase, voff) do { _Pragma("unroll") for (int _i = 0; _i < 2; ++_i) \
        __builtin_amdgcn_global_load_lds((const unsigned*)((const char*)(gbase) + (voff)[_i]), (LAS unsigned*)(lds + (bufoff) + ldsw + _i * 8192), 16, 0, 0); } while (0)
#define PG8_LDA(dst, b, h) do { _Pragma("unroll") for (int m = 0; m < 4; ++m) _Pragma("unroll") for (int k = 0; k < 2; ++k) dst[m][k] = *(const LAS bf16x8*)(lds + PG8_SA(b, h) + aoff + m * 2048 + k * 1024); } while (0)
#define PG8_LDB(dst, b, h) do { _Pragma("unroll") for (int n = 0; n < 2; ++n) _Pragma("unroll") for (int k = 0; k < 2; ++k) dst[n][k] = *(const LAS bf16x8*)(lds + PG8_SB(b, h) + boff + n * 2048 + k * 1024); } while (0)
#define PG8_MMA(ai, bj, At, Bt) do { __builtin_amdgcn_s_setprio(1); _Pragma("unroll") for (int m = 0; m < 4; ++m) _Pragma("unroll") for (int n = 0; n < 2; ++n) _Pragma("unroll") for (int k = 0; k < 2; ++k) \
        acc[ai][bj][m][n] = __builtin_amdgcn_mfma_f32_16x16x32_bf16(Bt[n][k], At[m][k], acc[ai][bj][m][n], 0, 0, 0); __builtin_amdgcn_s_setprio(0); } while (0)
#define PG8_WAIT_V(n) asm volatile("s_waitcnt vmcnt(" #n ")" ::: "memory")
#define PG8_WAIT_L(n) asm volatile("s_waitcnt lgkmcnt(" #n ")" ::: "memory")
#define PG8_BAR __builtin_amdgcn_s_barrier()
#define PG8_SCHED __builtin_amdgcn_sched_barrier(0)
    Unit cur, nxt; int ui = 0;
    if (!S.next(0, cur)) return;
    f32x4 acc[2][2][4][2];
#pragma unroll
    for (int a = 0; a < 2; ++a)
#pragma unroll
        for (int b = 0; b < 2; ++b)
#pragma unroll
            for (int m = 0; m < 4; ++m)
#pragma unroll
                for (int n = 0; n < 2; ++n) acc[a][b][m][n] = (f32x4){0.f, 0.f, 0.f, 0.f};
    bf16x8 At[4][2], B0[2][2], B1[2][2];
    const char* cA = g.a_ptr(cur); const char* cB = g.b_ptr(cur);
    PG8_STAGE(PG8_SB(0, 0), cB, voffB); PG8_STAGE(PG8_SA(0, 0), cA, voffA); PG8_STAGE(PG8_SB(0, 1), cB + hstepB, voffB); PG8_STAGE(PG8_SA(0, 1), cA + hstepA, voffA);
    if (wr == 1) PG8_BAR;
    PG8_WAIT_V(4); PG8_BAR;
    PG8_STAGE(PG8_SB(1, 0), cB + kstep, voffB); PG8_STAGE(PG8_SA(1, 0), cA + kstep, voffA); PG8_STAGE(PG8_SB(1, 1), cB + hstepB + kstep, voffB);
    PG8_WAIT_V(6); PG8_BAR;
    for (;;) {
        const bool has_next = S.next(ui + 1, nxt);
        const char* nA = has_next ? g.a_ptr(nxt) : cA; const char* nB = has_next ? g.b_ptr(nxt) : cB;
        for (int t = 0; t < nt; t += 2) {
            const bool last = (t == nt - 2);
            const char* a1 = cA + (size_t)(t + 1) * kstep;
            const char* a2 = last ? nA : cA + (size_t)(t + 2) * kstep; const char* b2 = last ? nB : cB + (size_t)(t + 2) * kstep;
            const char* a3 = a2 + kstep; const char* b3 = b2 + kstep;
            PG8_LDB(B0, 0, 0); PG8_SCHED; PG8_LDA(At, 0, 0); PG8_STAGE(PG8_SA(1, 1), a1 + hstepA, voffA);
            PG8_WAIT_L(8); PG8_BAR; PG8_WAIT_L(0); PG8_MMA(0, 0, At, B0); PG8_BAR; PG8_SCHED;
            PG8_LDB(B1, 0, 1); PG8_STAGE(PG8_SB(0, 0), b2, voffB);
            PG8_BAR; PG8_WAIT_L(0); PG8_MMA(0, 1, At, B1); PG8_BAR;
            PG8_LDA(At, 0, 1); PG8_STAGE(PG8_SA(0, 0), a2, voffA);
            PG8_BAR; PG8_WAIT_L(0); PG8_MMA(1, 0, At, B0); PG8_BAR; PG8_SCHED;
            PG8_STAGE(PG8_SB(0, 1), b2 + hstepB, voffB);
            PG8_WAIT_V(6); PG8_BAR; PG8_MMA(1, 1, At, B1); PG8_BAR;
            PG8_LDB(B0, 1, 0); PG8_SCHED; PG8_LDA(At, 1, 0); PG8_STAGE(PG8_SA(0, 1), a2 + hstepA, voffA);
            PG8_WAIT_L(8); PG8_BAR; PG8_WAIT_L(0); PG8_MMA(0, 0, At, B0); PG8_BAR; PG8_SCHED;
            PG8_LDB(B1, 1, 1); PG8_STAGE(PG8_SB(1, 0), b3, voffB);
            PG8_BAR; PG8_WAIT_L(0); PG8_MMA(0, 1, At, B1); PG8_BAR;
            PG8_LDA(At, 1, 1); PG8_STAGE(PG8_SA(1, 0), a3, voffA);
            PG8_BAR; PG8_WAIT_L(0); PG8_MMA(1, 0, At, B0); PG8_BAR; PG8_SCHED;
            PG8_STAGE(PG8_SB(1, 1), b3 + hstepB, voffB);
            PG8_WAIT_V(6); PG8_BAR; PG8_MMA(1, 1, At, B1); PG8_BAR;
        }
        E(acc, cur, wr, wc, fr, fq);
        if (!has_next) break;
#pragma unroll
        for (int a = 0; a < 2; ++a)
#pragma unroll
            for (int b = 0; b < 2; ++b)
#pragma unroll
                for (int m = 0; m < 4; ++m)
#pragma unroll
                    for (int n = 0; n < 2; ++n) acc[a][b][m][n] = (f32x4){0.f, 0.f, 0.f, 0.f};
        cur = nxt; cA = nA; cB = nB; ++ui;
    }
    PG8_WAIT_V(0);
    if (wr == 0) PG8_BAR;
    PG8_BAR;
#undef PG8_SA
#undef PG8_SB
#undef PG8_STAGE
#undef PG8_LDA
#undef PG8_LDB
#undef PG8_MMA
#undef PG8_WAIT_V
#undef PG8_WAIT_L
#undef PG8_BAR
#undef PG8_SCHED
}
}
using pg8::Unit;
typedef const f32x4 (&AccRef)[2][2][4][2];

#define XB_TMO      128
#define XB_XCNT(j)  (256  + 64 * (j))
#define XB_XSUB(j)  (1280 + 64 * (j))
#define XB_XGEN(j)  (2304 + 64 * (j))
#define XB_TOP      3328
#define XB_TOPGEN   3392
#define XCD_BAR_WORDS 3456
#define XB_SPIN_CAP (1u << 18)
__device__ __forceinline__ unsigned xb_ld(unsigned* p)              { return __hip_atomic_load(p, __ATOMIC_RELAXED, __HIP_MEMORY_SCOPE_AGENT); }
__device__ __forceinline__ unsigned xb_add(unsigned* p, unsigned v) { return __hip_atomic_fetch_add(p, v, __ATOMIC_RELAXED, __HIP_MEMORY_SCOPE_AGENT); }
__device__ __forceinline__ unsigned xb_xcc_id() { return (unsigned)__builtin_amdgcn_s_getreg((3 << 11) | 20) & 0xFu; }
#define XB_SPIN(cond, bar) do { unsigned _sp = 0; while (cond) { __builtin_amdgcn_s_sleep(1); \
    if ((++_sp & 255u) == 0u) { if (xb_ld(&(bar)[XB_TMO])) break; if (_sp > XB_SPIN_CAP) { atomicAdd(&(bar)[XB_TMO], 1u); break; } } } } while (0)
struct XcdBarrier { unsigned* bar; unsigned x; volatile LAS unsigned* st; };
__device__ __forceinline__ XcdBarrier xcd_barrier_post(unsigned* bar, volatile LAS unsigned* st) {
    XcdBarrier b; b.bar = bar; b.x = xb_xcc_id(); b.st = st;
    if (threadIdx.x == 0) (void)xb_add(&bar[XB_XCNT(b.x)], 1u);
    return b;
}
__device__ __forceinline__ void xcd_barrier_complete(unsigned* bar, unsigned x, unsigned& nloc, unsigned& nx) {
    const unsigned G = gridDim.x * gridDim.y * gridDim.z;
    unsigned sum, cnt, mine, sp = 0u;
    for (;;) {
        sum = 0u; cnt = 0u; mine = 0u;
#pragma unroll
        for (unsigned j = 0; j < 16; ++j) { const unsigned c = xb_ld(&bar[XB_XCNT(j)]); sum += c; cnt += (c > 0u) ? 1u : 0u; mine = (j == x) ? c : mine; }
        if (sum == G) break;
        __builtin_amdgcn_s_sleep(1);
        if ((++sp & 255u) == 0u) { if (xb_ld(&bar[XB_TMO])) break; if (sp > XB_SPIN_CAP) { atomicAdd(&bar[XB_TMO], 1u); break; } }
    }
    nloc = mine > 0u ? mine : 1u; nx = cnt > 0u ? cnt : 1u;
}
__device__ __forceinline__ void xcd_barrier(const XcdBarrier& b) {
    asm volatile("s_waitcnt vmcnt(0)" ::: "memory");
    __syncthreads();
    if (threadIdx.x == 0) {
        unsigned* bar = b.bar;
        __builtin_amdgcn_s_waitcnt(0);
        unsigned nloc = b.st[0], nx = b.st[1];
        if (nloc == 0u) { xcd_barrier_complete(bar, b.x, nloc, nx); b.st[0] = nloc; b.st[1] = nx; }
        const unsigned old = xb_add(&bar[XB_XSUB(b.x)], 1u);
        const unsigned gen = old / nloc;
        if (old + 1u == (gen + 1u) * nloc) {
            __builtin_amdgcn_fence(__ATOMIC_RELEASE, "agent");
            asm volatile("s_waitcnt vmcnt(0)" ::: "memory");
            const unsigned og = xb_add(&bar[XB_TOP], 1u);
            const unsigned tg = og / nx;
            if (og + 1u == (tg + 1u) * nx) xb_add(&bar[XB_TOPGEN], 1u);
            else XB_SPIN(xb_ld(&bar[XB_TOPGEN]) == tg, bar);
            __builtin_amdgcn_fence(__ATOMIC_ACQUIRE, "agent");
            xb_add(&bar[XB_XGEN(b.x)], 1u);
            asm volatile("s_waitcnt vmcnt(0)" ::: "memory");
        } else {
            XB_SPIN(xb_ld(&bar[XB_XGEN(b.x)]) == gen, bar);
            __builtin_amdgcn_fence(__ATOMIC_ACQUIRE, "agent");
            asm volatile("s_waitcnt vmcnt(0)" ::: "memory");
        }
    }
    __syncthreads();
}

struct Params { const float* in[37]; float* out; unsigned char* ws; };
typedef const __attribute__((address_space(4))) Params* KP;
__device__ __forceinline__ KP kp_fresh() { KP p = (KP)__builtin_amdgcn_kernarg_segment_ptr(); asm volatile("" : "+s"(p)); return p; }
enum { I_X = 0, I_C, I_CTX, I_CCTX, I_ADAW, I_ADAB, I_LNG, I_LNB, I_PWQ, I_PKEYS, I_PU, I_PV, I_RGWIN, I_RGCW, I_RGCB, I_RGGW, I_RGGB, I_RGLAM, I_RGWOUT,
       I_RWMU, I_RWRKV, I_RWWO, I_RWDEC0, I_RWDEC1, I_RWDEC2, I_RWICL0, I_RWICL1, I_RWICL2, I_RWG1, I_RWG2, I_RWKK, I_RWKA, I_RWRK, I_RWGNG, I_RWGNB, I_RETWIN, I_RETWOUT };
constexpr int LDS_BYTES = 147456;
constexpr int MISC_OFF = 147200;

__device__ __forceinline__ const float* modp(KP P, int layer, int v, int slot) { return (const float*)(P->ws + WS_MOD) + ((size_t)(layer * 5 + v) * 6 + slot) * D; }

struct GPlain { const bf16_t* A; const bf16_t* Bt; int K, lda, ldb;
    __device__ __forceinline__ const char* a_ptr(const Unit& u) const { return (const char*)(A + (size_t)u.pm * 256 * lda); }
    __device__ __forceinline__ const char* b_ptr(const Unit& u) const { return (const char*)(Bt + (size_t)u.pn * 256 * ldb); } };
struct GGate { const bf16_t* A; const bf16_t* Bt; int K, lda, ldb;
    __device__ __forceinline__ const char* a_ptr(const Unit& u) const { return (const char*)(A + (size_t)u.pm * 256 * lda + ((u.pn >> 1) & 7) * 256); }
    __device__ __forceinline__ const char* b_ptr(const Unit& u) const { return (const char*)(Bt + (size_t)u.pn * 256 * ldb); } };
struct GScore { const bf16_t* A; const bf16_t* Bt; int K, lda, ldb;
    __device__ __forceinline__ const char* a_ptr(const Unit& u) const { return (const char*)(A + (size_t)u.pm * 256 * lda + u.pn * 256); }
    __device__ __forceinline__ const char* b_ptr(const Unit& u) const { return (const char*)(Bt + (size_t)u.pn * 256 * ldb); } };
struct GFold { const bf16_t* A; const bf16_t* Bt; int K, lda, ldb;
    __device__ __forceinline__ const char* a_ptr(const Unit& u) const { return (const char*)(A + (size_t)u.pm * 256 * lda); }
    __device__ __forceinline__ const char* b_ptr(const Unit& u) const { return (const char*)(Bt + (size_t)(u.pm >> 3) * D * D + (size_t)u.pn * 256 * ldb + (u.pm & 7) * 256); } };
struct GRw1 { const bf16_t* A; const bf16_t* Bt; int K, lda, ldb;
    __device__ __forceinline__ const char* a_ptr(const Unit& u) const { const int blk = u.pn < 24 ? (u.pn >> 3) : (u.pn - 21); return (const char*)(A + (size_t)u.pm * 256 * lda + blk * 2048); }
    __device__ __forceinline__ const char* b_ptr(const Unit& u) const { return (const char*)(Bt + (size_t)u.pn * 256 * ldb); } };
struct GRw2 { const bf16_t* A; const bf16_t* Bt; int K, lda, ldb;
    __device__ __forceinline__ const char* a_ptr(const Unit& u) const { const int blk = u.pn < 16 ? 0 : (u.pn < 32 ? 1 : 2); return (const char*)(A + (size_t)u.pm * 256 * lda + blk * 256); }
    __device__ __forceinline__ const char* b_ptr(const Unit& u) const { return (const char*)(Bt + (size_t)u.pn * 256 * ldb); } };

template <int ACT> __device__ __forceinline__ float actf(float x) {
    if (ACT == 1) return gelu_tanh(x); if (ACT == 2) return tanhf_(x); if (ACT == 3) return sigmoidf_(x); if (ACT == 4) return siluf_(x); return x; }
template <int ACT> __device__ __forceinline__ void store_tile_bf16(AccRef acc, bf16_t* dst, int ld, int row0, int col0) {
#pragma unroll
    for (int ai = 0; ai < 2; ++ai)
#pragma unroll
        for (int m = 0; m < 4; ++m) { bf16_t* rowp = dst + (size_t)(row0 + ai * 128 + m * 16) * ld + col0;
#pragma unroll
            for (int bj = 0; bj < 2; ++bj) { const f32x4 v0 = acc[ai][bj][m][0], v1 = acc[ai][bj][m][1];
                u32x4 w; w.x = cvt_pk_bf16(actf<ACT>(v0[0]), actf<ACT>(v0[1])); w.y = cvt_pk_bf16(actf<ACT>(v0[2]), actf<ACT>(v0[3]));
                w.z = cvt_pk_bf16(actf<ACT>(v1[0]), actf<ACT>(v1[1])); w.w = cvt_pk_bf16(actf<ACT>(v1[2]), actf<ACT>(v1[3]));
                *(u32x4*)(rowp + bj * 128) = w; } }
}
struct EpiBf16Plain { static constexpr bool PERM = true; bf16_t* O; int ldc;
    __device__ __forceinline__ void operator()(AccRef acc, const Unit& u, int wr, int wc, int fr, int fq) const {
        store_tile_bf16<0>(acc, O, ldc, u.pm * 256 + wr * 64 + fr, u.pn * 256 + wc * 32 + 8 * fq); } };
struct EpiF32Plain { static constexpr bool PERM = false; float* C; int ldc;
    __device__ __forceinline__ void operator()(AccRef acc, const Unit& u, int wr, int wc, int fr, int fq) const {
        const int row0 = u.pm * 256 + wr * 64 + fr, col0 = u.pn * 256 + wc * 32 + 4 * fq;
#pragma unroll
        for (int ai = 0; ai < 2; ++ai)
#pragma unroll
            for (int m = 0; m < 4; ++m) { float* rowp = C + (size_t)(row0 + ai * 128 + m * 16) * ldc + col0;
#pragma unroll
                for (int bj = 0; bj < 2; ++bj)
#pragma unroll
                    for (int n = 0; n < 2; ++n) *(f32x4*)(rowp + bj * 128 + n * 16) = acc[ai][bj][m][n]; } } };
struct GSplitK { const bf16_t* A; const bf16_t* Bt; int K, lda, ldb;
    __device__ __forceinline__ const char* a_ptr(const Unit& u) const { return (const char*)(A + (size_t)u.pm * 256 * lda + (u.pn >> 3) * 512); }
    __device__ __forceinline__ const char* b_ptr(const Unit& u) const { return (const char*)(Bt + (size_t)(u.pn & 7) * 256 * ldb + (u.pn >> 3) * 512); } };
struct EpiPartial { static constexpr bool PERM = false; float* PX;
    __device__ __forceinline__ void operator()(AccRef acc, const Unit& u, int wr, int wc, int fr, int fq) const {
        const int row0 = u.pm * 256 + wr * 64 + fr, col0 = (u.pn & 7) * 256 + wc * 32 + 4 * fq; float* base = PX + (size_t)(u.pn >> 3) * NCTX * D;
#pragma unroll
        for (int ai = 0; ai < 2; ++ai)
#pragma unroll
            for (int m = 0; m < 4; ++m) { float* rowp = base + (size_t)(row0 + ai * 128 + m * 16) * D + col0;
#pragma unroll
                for (int bj = 0; bj < 2; ++bj)
#pragma unroll
                    for (int n = 0; n < 2; ++n) *(f32x4*)(rowp + bj * 128 + n * 16) = acc[ai][bj][m][n]; } } };
struct EpiResid { static constexpr bool PERM = false; float* X; const float* gate_base; float ymul;
    __device__ __forceinline__ void operator()(AccRef acc, const Unit& u, int wr, int wc, int fr, int fq) const {
        const int row0 = u.pm * 256 + wr * 64 + fr, col0 = u.pn * 256 + wc * 32 + 4 * fq;
        const float* gp = gate_base + (size_t)panel_vec(u.pm) * 6 * D + col0;
        f32x4 gv[2][2];
#pragma unroll
        for (int bj = 0; bj < 2; ++bj)
#pragma unroll
            for (int n = 0; n < 2; ++n) gv[bj][n] = *(const f32x4*)(gp + bj * 128 + n * 16);
#pragma unroll
        for (int ai = 0; ai < 2; ++ai)
#pragma unroll
            for (int m = 0; m < 4; ++m) { float* rowp = X + (size_t)(row0 + ai * 128 + m * 16) * D + col0;
#pragma unroll
                for (int bj = 0; bj < 2; ++bj)
#pragma unroll
                    for (int n = 0; n < 2; ++n) { f32x4* p = (f32x4*)(rowp + bj * 128 + n * 16); const f32x4 x = *p; *p = x * ALPHA + gv[bj][n] * (acc[ai][bj][m][n] * ymul); } } } };
struct EpiRgIn { static constexpr bool PERM = true; bf16_t* UG; bf16_t* UR;
    __device__ __forceinline__ void operator()(AccRef acc, const Unit& u, int wr, int wc, int fr, int fq) const {
        const int row0 = u.pm * 256 + wr * 64 + fr, col0 = (u.pn & 7) * 256 + wc * 32 + 8 * fq;
        if (u.pn < 8) store_tile_bf16<1>(acc, UG, D, row0, col0); else store_tile_bf16<0>(acc, UR, D, row0, col0); } };
struct EpiRgGate { static constexpr bool PERM = true; const bf16_t* XC; bf16_t* LA; bf16_t* BB; const float* gate_b; const float* spt;
    __device__ __forceinline__ void operator()(AccRef acc, const Unit& u, int wr, int wc, int fr, int fq) const {
        const int d = u.pn >> 4, ch0 = ((u.pn >> 1) & 7) * 256 + (u.pn & 1) * 128 + wc * 32 + 8 * fq;
        const int row0 = u.pm * 256 + wr * 64 + fr;
        float br[8], bi[8], sp[8];
#pragma unroll
        for (int j = 0; j < 8; ++j) { br[j] = gate_b[(d * 2 + 0) * D + ch0 + j]; bi[j] = gate_b[(d * 2 + 1) * D + ch0 + j];
            sp[j] = spt[d * D + ch0 + j]; }
        u32x4 xr8[8];
#pragma unroll
        for (int q = 0; q < 8; ++q) xr8[q] = *(const u32x4*)(XC + (size_t)(row0 + (q >> 2) * 128 + (q & 3) * 16) * D + ch0);
#pragma unroll
        for (int ai = 0; ai < 2; ++ai)
#pragma unroll
            for (int m = 0; m < 4; ++m) { const int row = row0 + ai * 128 + m * 16;
                const u32x4 xr = xr8[ai * 4 + m];
                float xc[8] = {bflo(xr.x), bfhi(xr.x), bflo(xr.y), bfhi(xr.y), bflo(xr.z), bfhi(xr.z), bflo(xr.w), bfhi(xr.w)};
                float la[8], bb[8];
#pragma unroll
                for (int j = 0; j < 8; ++j) { const float ar = acc[ai][0][m][j >> 2][j & 3], ai_ = acc[ai][1][m][j >> 2][j & 3];
                    const float rg = sigmoidf_(ar + br[j]), ig = sigmoidf_(ai_ + bi[j]);
                    const float l = sp[j] * rg; la[j] = l; bb[j] = sqrtf(1.0f - __expf(2.0f * l)) * (ig * xc[j]); }
                u32x4 w; w.x = cvt_pk_bf16(la[0], la[1]); w.y = cvt_pk_bf16(la[2], la[3]); w.z = cvt_pk_bf16(la[4], la[5]); w.w = cvt_pk_bf16(la[6], la[7]);
                *(u32x4*)(LA + ((size_t)row * 2 + d) * D + ch0) = w;
                w.x = cvt_pk_bf16(bb[0], bb[1]); w.y = cvt_pk_bf16(bb[2], bb[3]); w.z = cvt_pk_bf16(bb[4], bb[5]); w.w = cvt_pk_bf16(bb[6], bb[7]);
                *(u32x4*)(BB + ((size_t)row * 2 + d) * D + ch0) = w; } } };
struct EpiRw1 { static constexpr bool PERM = true; bf16_t* RKV; bf16_t* A2;
    __device__ __forceinline__ void operator()(AccRef acc, const Unit& u, int wr, int wc, int fr, int fq) const {
        const int row0 = u.pm * 256 + wr * 64 + fr, cw = wc * 32 + 8 * fq;
        if (u.pn < 24) store_tile_bf16<0>(acc, RKV + (size_t)(u.pn >> 3) * TD, D, row0, (u.pn & 7) * 256 + cw);
        else if (u.pn == 24) store_tile_bf16<2>(acc, A2, 768, row0, cw);
        else if (u.pn == 25) store_tile_bf16<0>(acc, A2, 768, row0, 256 + cw);
        else store_tile_bf16<3>(acc, A2, 768, row0, 512 + cw); } };
struct EpiRw2 { static constexpr bool PERM = true; bf16_t* W; bf16_t* AD; bf16_t* G; const float* dec0; const float* icl0;
    __device__ __forceinline__ void operator()(AccRef acc, const Unit& u, int wr, int wc, int fr, int fq) const {
        const int row0 = u.pm * 256 + wr * 64 + fr, c0 = (u.pn & 7) * 256 + wc * 32 + 8 * fq;
        if (u.pn >= 32) { store_tile_bf16<0>(acc, G, D, row0, c0); return; }
        const int isa = u.pn >= 16, d = (u.pn >> 3) & 1;
        const float* bias = (isa ? icl0 : dec0) + d * D + c0;
        bf16_t* dst = (isa ? AD : W);
        float bv[2][8];
#pragma unroll
        for (int bj = 0; bj < 2; ++bj)
#pragma unroll
            for (int j = 0; j < 8; ++j) bv[bj][j] = bias[bj * 128 + j];
#pragma unroll
        for (int ai = 0; ai < 2; ++ai)
#pragma unroll
            for (int m = 0; m < 4; ++m) { const int row = row0 + ai * 128 + m * 16;
#pragma unroll
                for (int bj = 0; bj < 2; ++bj) { float o[8];
#pragma unroll
                    for (int j = 0; j < 8; ++j) { const float s = sigmoidf_(acc[ai][bj][m][j >> 2][j & 3] + bv[bj][j]); o[j] = isa ? s : __expf(-0.6065306597126334f * s); }
                    u32x4 w; w.x = cvt_pk_bf16(o[0], o[1]); w.y = cvt_pk_bf16(o[2], o[3]); w.z = cvt_pk_bf16(o[4], o[5]); w.w = cvt_pk_bf16(o[6], o[7]);
                    *(u32x4*)(dst + ((size_t)row * 2 + d) * D + c0 + bj * 128) = w; } } } };
struct EpiRetIn { static constexpr bool PERM = true; bf16_t* Q; bf16_t* Kk; bf16_t* V; bf16_t* GF; bf16_t* GB; const float* CS;
    __device__ __forceinline__ void operator()(AccRef acc, const Unit& u, int wr, int wc, int fr, int fq) const {
        const int row0 = u.pm * 256 + wr * 64 + fr, cw = wc * 32 + 8 * fq;
        if (u.pn >= 48) { store_tile_bf16<4>(acc, GB, 4096, row0, (u.pn - 48) * 256 + cw); return; }
        if (u.pn >= 32) { store_tile_bf16<4>(acc, GF, 4096, row0, (u.pn - 32) * 256 + cw); return; }
        if (u.pn >= 16) { store_tile_bf16<0>(acc, V, 4096, row0, (u.pn - 16) * 256 + cw); return; }
        const float sc = u.pn >= 8 ? 0.0625f : 1.0f; bf16_t* dst = u.pn >= 8 ? Kk : Q; const int hc = (u.pn & 7) * 256;
#pragma unroll
        for (int ai = 0; ai < 2; ++ai) { f32x4 cs4[4][4];
#pragma unroll
            for (int m = 0; m < 4; ++m) { const float* cs_ = CS + ((size_t)row_pos(row0 + ai * 128 + m * 16) * 128 + cw) * 2;
#pragma unroll
                for (int q = 0; q < 4; ++q) cs4[m][q] = *(const f32x4*)(cs_ + 4 * q); }
#pragma unroll
            for (int m = 0; m < 4; ++m) { const int row = row0 + ai * 128 + m * 16;
                float o1[8], o2[8];
#pragma unroll
                for (int j = 0; j < 8; ++j) { const float co = cs4[m][j >> 1][(2 * j) & 3], si = cs4[m][j >> 1][(2 * j + 1) & 3]; const float t1 = acc[ai][0][m][j >> 2][j & 3], t2 = acc[ai][1][m][j >> 2][j & 3];
                    o1[j] = (t1 * co - t2 * si) * sc; o2[j] = (t1 * si + t2 * co) * sc; }
                u32x4 w; w.x = cvt_pk_bf16(o1[0], o1[1]); w.y = cvt_pk_bf16(o1[2], o1[3]); w.z = cvt_pk_bf16(o1[4], o1[5]); w.w = cvt_pk_bf16(o1[6], o1[7]);
                *(u32x4*)(dst + (size_t)row * D + hc + cw) = w;
                w.x = cvt_pk_bf16(o2[0], o2[1]); w.y = cvt_pk_bf16(o2[2], o2[3]); w.z = cvt_pk_bf16(o2[4], o2[5]); w.w = cvt_pk_bf16(o2[6], o2[7]);
                *(u32x4*)(dst + (size_t)row * D + hc + 128 + cw) = w; } } } };

#define LDS_WAIT() asm volatile("s_waitcnt lgkmcnt(0)" ::: "memory")
struct Ctx { LAS unsigned char* lds; int tid, lane, wave, gw, ngw, gtid, ngt; };

__device__ __forceinline__ void transpose_item(const float* W, int ldw, bf16_t* WT, int ldt, int k0, int n0, int dst_row0, LAS float* scr, int lane) {
#pragma unroll
    for (int i = 0; i < 8; ++i) { const int kk = 8 * i + (lane >> 3), nn = (lane & 7) * 4; const f32x4 wv = *(const f32x4*)(W + (size_t)(k0 + kk) * ldw + n0 + nn);
        LAS float* d = scr + kk * 33 + nn; d[0] = wv[0]; d[1] = wv[1]; d[2] = wv[2]; d[3] = wv[3]; }
    LDS_WAIT(); asm volatile("" ::: "memory");
    const int c = lane & 7;
#pragma unroll
    for (int j = 0; j < 4; ++j) { const int n = (lane >> 3) + 8 * j; const LAS float* s = scr + (8 * c) * 33 + n;
        u32x4 o; o.x = cvt_pk_bf16(s[0 * 33], s[1 * 33]); o.y = cvt_pk_bf16(s[2 * 33], s[3 * 33]); o.z = cvt_pk_bf16(s[4 * 33], s[5 * 33]); o.w = cvt_pk_bf16(s[6 * 33], s[7 * 33]);
        *(u32x4*)(WT + (size_t)(dst_row0 + n) * ldt + k0 + 8 * c) = o; }
    LDS_WAIT(); asm volatile("" ::: "memory");
}
__device__ __forceinline__ void tr_job(const Ctx& c, int& rot, const float* W, int K, int N, int ldw, bf16_t* WT, int ldt, int row_off) {
    LAS float* scr = (LAS float*)(c.lds + c.wave * 16384);
    const int nblk = N / 32, items = (K / 64) * nblk;
    int first = c.gw - (rot % c.ngw); if (first < 0) first += c.ngw;
    int lane = c.lane; asm volatile("" : "+v"(lane));
    f32x4 r[8];
#define TR_LOAD(it_) do { const int kb_ = (it_) / nblk, nb_ = (it_) % nblk; _Pragma("unroll") for (int i = 0; i < 8; ++i) r[i] = *(const f32x4*)(W + (size_t)(kb_ * 64 + 8 * i + (lane >> 3)) * ldw + nb_ * 32 + (lane & 7) * 4); } while (0)
    if (first < items) TR_LOAD(first);
    for (int it = first; it < items; it += c.ngw) { const int kb = it / nblk, nb = it % nblk;
#pragma unroll
        for (int i = 0; i < 8; ++i) { LAS float* d = scr + (8 * i + (lane >> 3)) * 33 + (lane & 7) * 4; d[0] = r[i][0]; d[1] = r[i][1]; d[2] = r[i][2]; d[3] = r[i][3]; }
        if (it + c.ngw < items) TR_LOAD(it + c.ngw);
        LDS_WAIT(); asm volatile("" ::: "memory");
        const int cc = lane & 7;
#pragma unroll
        for (int j = 0; j < 4; ++j) { const int n = (lane >> 3) + 8 * j; const LAS float* sp = scr + (8 * cc) * 33 + n;
            u32x4 o; o.x = cvt_pk_bf16(sp[0 * 33], sp[1 * 33]); o.y = cvt_pk_bf16(sp[2 * 33], sp[3 * 33]); o.z = cvt_pk_bf16(sp[4 * 33], sp[5 * 33]); o.w = cvt_pk_bf16(sp[6 * 33], sp[7 * 33]);
            *(u32x4*)(WT + (size_t)(row_off + nb * 32 + n) * ldt + kb * 64 + 8 * cc) = o; }
        LDS_WAIT(); asm volatile("" ::: "memory"); }
#undef TR_LOAD
    rot += items;
}

__device__ __forceinline__ void peer_convert_rows(KP P, const Ctx& c, int g_lo, int g_hi, int rank, int nranks) {
    unsigned char* ws = P->ws;
    f32x4 xn[2][8];
#define CV_LOAD(g0_) do { _Pragma("unroll") for (int h = 0; h < 2; ++h) { const int g = ((g0_) + h < g_hi) ? (g0_) + h : (g0_); const int lt = g >> 14, e = g & 16383, layer = lt >> 1, t = lt & 1; \
            const float* sp = P->in[t ? I_PV : I_PU] + ((size_t)layer * 16384 + e) * D + c.lane * 16; \
            _Pragma("unroll") for (int q = 0; q < 8; ++q) xn[h][q] = *(const f32x4*)(sp + (q >> 2) * 1024 + (q & 3) * 4); } } while (0)
    { const int gf = g_lo + (rank * 8 + c.wave) * 2; if (gf < g_hi) CV_LOAD(gf); }
    for (int g0 = g_lo + (rank * 8 + c.wave) * 2; g0 < g_hi; g0 += nranks * 16) {
        f32x4 x[2][8]; float am[2] = {0.f, 0.f};
#pragma unroll
        for (int h = 0; h < 2; ++h)
#pragma unroll
            for (int q = 0; q < 8; ++q) x[h][q] = xn[h][q];
        if (g0 + nranks * 16 < g_hi) CV_LOAD(g0 + nranks * 16);
#pragma unroll
        for (int h = 0; h < 2; ++h) { if (g0 + h >= g_hi) break;
            const int g = g0 + h; const int lt = g >> 14, e = g & 16383, layer = lt >> 1, t = lt & 1;
#pragma unroll
            for (int q = 0; q < 8; ++q) am[h] = fmaxf(am[h], fmaxf(fmaxf(fabsf(x[h][q][0]), fabsf(x[h][q][1])), fmaxf(fabsf(x[h][q][2]), fabsf(x[h][q][3]))));
            const float a = wave_max(am[h]);
            const float sc = a > 0.f ? exp2f(floorf(log2f(384.0f / a))) : 1.0f;
            if (c.lane == 0) ((float*)(ws + WS_PSC))[(size_t)t * 4 * 16384 + layer * 16384 + e] = 1.0f / sc;
            unsigned char* dst = ws + (t ? WS_PV : WS_PU) + (size_t)layer * 16384 * D;
#pragma unroll
            for (int jj = 0; jj < 2; ++jj) { u32x4 o;
#pragma unroll
                for (int w = 0; w < 4; ++w) { const f32x4 v = x[h][jj * 4 + w] * sc; int p = 0; p = __builtin_amdgcn_cvt_pk_fp8_f32(v[0], v[1], p, false); p = __builtin_amdgcn_cvt_pk_fp8_f32(v[2], v[3], p, true); o[w] = (unsigned)p; }
                const int db = (c.lane >> 3) + 8 * jj;
                *(u32x4*)(dst + ((size_t)db * 16384 + e) * 128 + (c.lane & 7) * 16) = o; } } }
#undef CV_LOAD
}
__device__ __forceinline__ void phase_prologue(KP P, const Ctx& c) {
    unsigned char* ws = P->ws;
    PROBE_REP(14) {
        LAS float* sl = (LAS float*)c.lds;
        LAS float* red = sl + 1280;
        for (int un = blockIdx.x; un < 4 * 24 * 8; un += gridDim.x) {
            const int layer = un / 192, r = un % 192, nb = r / 8, kc = r % 8;
            __syncthreads();
            for (int i = c.tid; i < 5 * 256; i += 512) { const int v = i >> 8, k = kc * 256 + (i & 255); const float x = v < 4 ? P->in[I_C][v * D + k] : P->in[I_CCTX][k]; sl[i] = siluf_(x); }
            __syncthreads();
            const int cg = c.tid & 127, ks = c.tid >> 7;
            const float* w = P->in[I_ADAW] + ((size_t)layer * D + kc * 256 + ks * 64) * 12288 + nb * 512 + cg * 4;
            f32x4 a0 = (f32x4){0.f, 0.f, 0.f, 0.f}, a1 = a0, a2 = a0, a3 = a0, a4 = a0;
            f32x4 wn[8];
#pragma unroll
            for (int i = 0; i < 8; ++i) wn[i] = *(const f32x4*)(w + (size_t)i * 12288);
#pragma unroll 1
            for (int k0 = 0; k0 < 64; k0 += 8) { f32x4 wc[8];
#pragma unroll
                for (int i = 0; i < 8; ++i) wc[i] = wn[i];
                if (k0 + 8 < 64) {
#pragma unroll
                    for (int i = 0; i < 8; ++i) wn[i] = *(const f32x4*)(w + (size_t)(k0 + 8 + i) * 12288); }
#pragma unroll
                for (int i = 0; i < 8; ++i) { const f32x4 wv = wc[i]; const int kk = ks * 64 + k0 + i;
                    a0 += wv * sl[kk]; a1 += wv * sl[256 + kk]; a2 += wv * sl[512 + kk]; a3 += wv * sl[768 + kk]; a4 += wv * sl[1024 + kk]; } }
            LAS float* rp = red + (ks * 5) * 512 + cg * 4;
            *(LAS f32x4*)(rp) = a0; *(LAS f32x4*)(rp + 512) = a1; *(LAS f32x4*)(rp + 1024) = a2; *(LAS f32x4*)(rp + 1536) = a3; *(LAS f32x4*)(rp + 2048) = a4;
            __syncthreads();
            for (int i = c.tid; i < 5 * 512; i += 512) { const int v = i >> 9, n = i & 511;
                const float sum = (red[(0 * 5 + v) * 512 + n] + red[(1 * 5 + v) * 512 + n]) + (red[(2 * 5 + v) * 512 + n] + red[(3 * 5 + v) * 512 + n]);
                ((float*)(ws + WS_MODP))[((size_t)(layer * 8 + kc) * 5 + v) * 12288 + nb * 512 + n] = sum; }
        }
        __syncthreads();
    }
    PROBE_REP(16) {
    int rot = 0;
    for (int j = 0; j < 2; ++j) {
        tr_job(c, rot, P->in[I_RGWIN] + (size_t)j * D * 4096, D, 4096, 4096, (bf16_t*)(ws + WS_RGIN) + (size_t)j * 4096 * D, D, 0);
        tr_job(c, rot, P->in[I_RGWOUT] + (size_t)j * D * D, D, D, D, (bf16_t*)(ws + WS_RGOUT) + (size_t)j * D * D, D, 0);
    }
    {
        LAS float* scr = (LAS float*)(c.lds + c.wave * 16384);
        const int items = 64 * 32;
        int first = c.gw - (rot % c.ngw); if (first < 0) first += c.ngw;
        for (int it = first; it < items; it += c.ngw) {
            const int mat = it >> 5, sub = it & 31, kb = sub >> 3, nb32 = sub & 7;
            const int jl = mat >> 5, d = (mat >> 4) & 1, g = (mat >> 3) & 1, nblk = mat & 7;
            const int n0 = nb32 * 32, hf = n0 >> 7, pn = (d * 8 + nblk) * 2 + hf;
            transpose_item(P->in[I_RGGW] + (size_t)mat * 65536, 256, (bf16_t*)(ws + WS_RGGATE) + (size_t)jl * 8192 * 256, 256, kb * 64, n0, pn * 256 + g * 128 + (n0 & 127), scr, c.lane);
        }
        rot += items;
    }
    for (int m = 0; m < 3; ++m) tr_job(c, rot, P->in[I_RWRKV] + (size_t)m * D * D, D, D, D, (bf16_t*)(ws + WS_RW1), D, m * D);
    for (int d = 0; d < 2; ++d) {
        tr_job(c, rot, P->in[I_RWDEC1] + (size_t)d * D * 96, D, 96, 96, (bf16_t*)(ws + WS_RW1), D, 6144 + d * 96);
        tr_job(c, rot, P->in[I_RWICL1] + (size_t)d * D * 96, D, 96, 96, (bf16_t*)(ws + WS_RW1), D, 6400 + d * 96);
    }
    tr_job(c, rot, P->in[I_RWG1], D, 256, 256, (bf16_t*)(ws + WS_RW1), D, 6656);
    tr_job(c, rot, P->in[I_RWWO], D, D, D, (bf16_t*)(ws + WS_RWO), D, 0);
    tr_job(c, rot, P->in[I_RETWIN], D, 16384, 16384, (bf16_t*)(ws + WS_RETIN), D, 0);
    tr_job(c, rot, P->in[I_RETWOUT], 4096, D, D, (bf16_t*)(ws + WS_RETOUT), 4096, 0);
    }
    PROBE_REP(17) {
    for (size_t i0 = c.gtid; i0 < (size_t)4 * D * D / 8; i0 += 4 * (size_t)c.ngt) { f32x4 a[4], b[4];
#pragma unroll
        for (int u = 0; u < 4; ++u) { const size_t i = i0 + (size_t)u * c.ngt; if (i < (size_t)4 * D * D / 8) { a[u] = *(const f32x4*)(P->in[I_PWQ] + i * 8); b[u] = *(const f32x4*)(P->in[I_PWQ] + i * 8 + 4); } }
#pragma unroll
        for (int u = 0; u < 4; ++u) { const size_t i = i0 + (size_t)u * c.ngt; if (i < (size_t)4 * D * D / 8)
            *(u32x4*)((bf16_t*)(ws + WS_WQN) + i * 8) = (u32x4){cvt_pk_bf16(a[u][0], a[u][1]), cvt_pk_bf16(a[u][2], a[u][3]), cvt_pk_bf16(b[u][0], b[u][1]), cvt_pk_bf16(b[u][2], b[u][3])}; } }
    for (int i = c.gtid; i < 2 * 64 * (D / 8); i += c.ngt) { const int blk = i / (64 * (D / 8)), r = (i / (D / 8)) % 64, c8 = i % (D / 8);
        *(u32x4*)((bf16_t*)(ws + WS_RW1) + (size_t)(6144 + blk * 256 + 192 + r) * D + c8 * 8) = (u32x4){0u, 0u, 0u, 0u}; }
    for (int i = c.gtid; i < 4 * 2048 * 32; i += c.ngt) { const int c8 = i & 31, row = (i >> 5) & 2047, l = i >> 16; const int p = (row >> 7) & 1, col = c8 * 8;
        u32x4 o = (u32x4){0u, 0u, 0u, 0u};
        if ((col >> 7) == p) { const float* s = P->in[I_PKEYS] + ((size_t)l * 2048 + row) * 128 + (col & 127); const f32x4 a = *(const f32x4*)s, b = *(const f32x4*)(s + 4);
            o.x = cvt_pk_bf16(a[0], a[1]); o.y = cvt_pk_bf16(a[2], a[3]); o.z = cvt_pk_bf16(b[0], b[1]); o.w = cvt_pk_bf16(b[2], b[3]); }
        *(u32x4*)((bf16_t*)(ws + WS_KEYS) + ((size_t)l * 2048 + row) * 256 + col) = o; }
    for (int i0 = c.gtid; i0 < 10240 * 256; i0 += 4 * c.ngt) { float v4[4];
#pragma unroll
        for (int u = 0; u < 4; ++u) { const int i = i0 + u * c.ngt; float v = 0.f;
            if (i < 10240 * 256) { const int kc = i & 255, r = i >> 8;
                if (r < 4096) { const int d = r >> 11, cc = r & 2047, k = kc - 96 * d; if (k >= 0 && k < 96) v = P->in[I_RWDEC2][((size_t)d * 96 + k) * D + cc]; }
                else if (r < 8192) { const int rr = r - 4096, d = rr >> 11, cc = rr & 2047, k = kc - 96 * d; if (k >= 0 && k < 96) v = P->in[I_RWICL2][((size_t)d * 96 + k) * D + cc]; }
                else v = P->in[I_RWG2][(size_t)kc * D + (r - 8192)]; }
            v4[u] = v; }
#pragma unroll
        for (int u = 0; u < 4; ++u) { const int i = i0 + u * c.ngt; if (i < 10240 * 256) ((bf16_t*)(ws + WS_RW2))[i] = (bf16_t)(cvt_pk_bf16(v4[u], 0.f) & 0xffffu); } }
    }
    PROBE_REP(18)
    for (int i = c.gtid; i < 2 * 2 * D; i += c.ngt) ((float*)(ws + WS_SPT))[i] = -8.0f * log1pf(expf(-P->in[I_RGLAM][i]));
    PROBE_REP(18)
    for (int i = c.gtid; i < SLEN * 128; i += c.ngt) { const int pos = i >> 7, k = i & 127; const float theta = 1.0f / powf(10000.0f, (float)k / 127.0f); const float ang = (float)pos * theta;
        ((f32x2*)(ws + WS_CS))[i] = (f32x2){cosf(ang), sinf(ang)}; }
}
__device__ __forceinline__ void phase_modfin(KP P, const Ctx& c) {
    for (int i = c.gtid; i < 4 * 5 * 12288; i += c.ngt) { const int n = i % 12288, lv = i / 12288, l = lv / 5, v = lv % 5;
        float s = P->in[I_ADAB][l * 12288 + n];
        for (int kc = 0; kc < 8; ++kc) s += ((const float*)(P->ws + WS_MODP))[((size_t)(l * 8 + kc) * 5 + v) * 12288 + n];
        ((float*)(P->ws + WS_MOD))[i] = s; }
}
__device__ __forceinline__ void phase_xinit(KP P, const Ctx& c) {
    float* X = (float*)(P->ws + WS_X); bf16_t* A0 = (bf16_t*)(P->ws + WS_A0);
    for (size_t i0 = c.gtid; i0 < TD / 4; i0 += 4 * (size_t)c.ngt) {
        f32x4 x[4], sh[4], sc[4];
#pragma unroll
        for (int u = 0; u < 4; ++u) { const size_t i = i0 + (size_t)u * c.ngt; if (i < TD / 4) { const int row = (int)(i >> 9), c4 = (int)(i & 511) * 4;
            const float* src = row < NCTX ? P->in[I_CTX] + (size_t)row * D : P->in[I_X] + (size_t)(row - NCTX) * D; const int v = row_vec(row);
            x[u] = *(const f32x4*)(src + c4); sh[u] = *(const f32x4*)(modp(P, 0, v, 0) + c4); sc[u] = *(const f32x4*)(modp(P, 0, v, 1) + c4); } }
#pragma unroll
        for (int u = 0; u < 4; ++u) { const size_t i = i0 + (size_t)u * c.ngt; if (i < TD / 4) { const int row = (int)(i >> 9), c4 = (int)(i & 511) * 4;
            *(f32x4*)(X + (size_t)row * D + c4) = x[u];
            const f32x4 h = x[u] * (sc[u] + 1.0f) + sh[u];
            *(u32x2*)(A0 + (size_t)row * D + c4) = (u32x2){cvt_pk_bf16(h[0], h[1]), cvt_pk_bf16(h[2], h[3])}; } } }
}

__device__ __forceinline__ void phase_rg_conv(KP P, const Ctx& c, int jl) {
    const bf16_t* UR = (const bf16_t*)(P->ws + L_UR); bf16_t* XC = (bf16_t*)(P->ws + L_XC);
    const float* cw = P->in[I_RGCW] + (size_t)jl * 4 * D; const float* cb = P->in[I_RGCB] + (size_t)jl * D;
    const int c8 = (int)(c.gtid & 255) * 8;
    float w8[4][8], b8[8];
#pragma unroll
    for (int j = 0; j < 8; ++j) { b8[j] = cb[c8 + j];
#pragma unroll
        for (int tp = 0; tp < 4; ++tp) w8[tp][j] = cw[tp * D + c8 + j]; }
    for (size_t i0 = c.gtid; i0 < TD / 8; i0 += 2 * (size_t)c.ngt) {
        u32x4 u[2][4];
#pragma unroll
        for (int q = 0; q < 2; ++q) { const size_t i = i0 + (size_t)q * c.ngt; const int row = (int)(i >> 8);
            int lo, hi; if (row < NCTX) { lo = row & ~(CTX - 1); hi = lo + CTX; } else { lo = NCTX + ((row - NCTX) & ~(SEQ - 1)); hi = lo + SEQ; }
#pragma unroll
            for (int tp = 0; tp < 4; ++tp) { const int rr = row + tp - 2; u[q][tp] = (u32x4){0u, 0u, 0u, 0u};
                if (i < TD / 8 && rr >= lo && rr < hi) u[q][tp] = *(const u32x4*)(UR + (size_t)rr * D + c8); } }
#pragma unroll
        for (int q = 0; q < 2; ++q) { const size_t i = i0 + (size_t)q * c.ngt; if (i >= TD / 8) break; const int row = (int)(i >> 8);
            float a[8];
#pragma unroll
            for (int j = 0; j < 8; ++j) a[j] = b8[j];
#pragma unroll
            for (int tp = 0; tp < 4; ++tp) { const u32x4 uu = u[q][tp]; const unsigned u0 = uu.x, u1 = uu.y, u2 = uu.z, u3 = uu.w;
                a[0] += w8[tp][0] * bflo(u0); a[1] += w8[tp][1] * bfhi(u0); a[2] += w8[tp][2] * bflo(u1); a[3] += w8[tp][3] * bfhi(u1);
                a[4] += w8[tp][4] * bflo(u2); a[5] += w8[tp][5] * bfhi(u2); a[6] += w8[tp][6] * bflo(u3); a[7] += w8[tp][7] * bfhi(u3); }
            *(u32x4*)(XC + (size_t)row * D + c8) = (u32x4){cvt_pk_bf16(a[0], a[1]), cvt_pk_bf16(a[2], a[3]), cvt_pk_bf16(a[4], a[5]), cvt_pk_bf16(a[6], a[7])}; } }
}
__device__ __forceinline__ void phase_rg_scan1(KP P, const Ctx& c) {
    const bf16_t* LA = (const bf16_t*)(P->ws + L_LA); const bf16_t* BB = (const bf16_t*)(P->ws + L_BB);
    float* CA = (float*)(P->ws + WS_CA); float* CH = (float*)(P->ws + WS_CH);
    for (int u = c.gw; u < 2048; u += c.ngw) { const int b = u >> 9, dir = (u >> 8) & 1, ck = (u >> 2) & 63, ch = (u & 3) * 512 + c.lane * 8;
        float h[8], sl[8];
#pragma unroll
        for (int e = 0; e < 8; ++e) { h[e] = 0.f; sl[e] = 0.f; }
        u32x4 nl[4], nb[4];
#define SC1_LOAD(s0_) do { _Pragma("unroll") for (int i_ = 0; i_ < 4; ++i_) { const int row_ = seq_row(b, dir, ck * 68 + (s0_) + i_); const size_t o_ = ((size_t)row_ * 2 + dir) * D + ch; nl[i_] = *(const u32x4*)(LA + o_); nb[i_] = *(const u32x4*)(BB + o_); } } while (0)
        SC1_LOAD(0);
#pragma unroll 1
        for (int s0 = 0; s0 < 68; s0 += 4) { u32x4 cl[4], cb[4];
#pragma unroll
            for (int i = 0; i < 4; ++i) { cl[i] = nl[i]; cb[i] = nb[i]; }
            if (s0 + 4 < 68) SC1_LOAD(s0 + 4);
#pragma unroll
            for (int i = 0; i < 4; ++i) { float l8[8], b8[8]; unpack8(cl[i], l8); unpack8(cb[i], b8);
#pragma unroll
                for (int e = 0; e < 8; ++e) { h[e] = __expf(l8[e]) * h[e] + b8[e]; sl[e] += l8[e]; } } }
#undef SC1_LOAD
        const size_t o = ((size_t)(b * 2 + dir) * 64 + ck) * D + ch;
        *(f32x4*)(CA + o) = (f32x4){sl[0], sl[1], sl[2], sl[3]}; *(f32x4*)(CA + o + 4) = (f32x4){sl[4], sl[5], sl[6], sl[7]};
        *(f32x4*)(CH + o) = (f32x4){h[0], h[1], h[2], h[3]}; *(f32x4*)(CH + o + 4) = (f32x4){h[4], h[5], h[6], h[7]}; }
}
__device__ __forceinline__ void phase_rg_scan2(KP P, const Ctx& c) {
    const float* CA = (const float*)(P->ws + WS_CA); const float* CH = (const float*)(P->ws + WS_CH); float* CIN = (float*)(P->ws + WS_CIN);
    for (int i = c.gtid; i < 4 * 2 * D; i += c.ngt) { const int ch = i & (D - 1), bd = i >> 11; float carry = 0.f;
#pragma unroll 1
        for (int c0 = 0; c0 < 64; c0 += 16) { float a[16], hh[16];
#pragma unroll
            for (int q = 0; q < 16; ++q) { const size_t o = ((size_t)bd * 64 + c0 + q) * D + ch; a[q] = CA[o]; hh[q] = CH[o]; }
#pragma unroll
            for (int q = 0; q < 16; ++q) { const size_t o = ((size_t)bd * 64 + c0 + q) * D + ch; CIN[o] = carry; carry = __expf(a[q]) * carry + hh[q]; } } }
}
template <int DIR> __device__ __forceinline__ void phase_rg_scan3(KP P, const Ctx& c) {
    const bf16_t* LA = (const bf16_t*)(P->ws + L_LA); const bf16_t* BB = (const bf16_t*)(P->ws + L_BB); const bf16_t* UG = (const bf16_t*)(P->ws + L_UG);
    const float* CIN = (const float*)(P->ws + WS_CIN); bf16_t* YIN = (bf16_t*)(P->ws + L_YIN); bf16_t* HF = (bf16_t*)(P->ws + L_XC);
    for (int u = c.gw; u < 2048; u += c.ngw) { const int b = u >> 9, ck = (u >> 3) & 63, ch = (u & 7) * 256 + c.lane * 4;
        const f32x4 h0 = *(const f32x4*)(CIN + ((size_t)(b * 2 + DIR) * 64 + ck) * D + ch); float h[4] = {h0[0], h0[1], h0[2], h0[3]};
        u32x2 nl[4], nb[4], nf[4], ng[4];
#define SC3_LOAD(s0_) do { _Pragma("unroll") for (int i_ = 0; i_ < 4; ++i_) { const int row_ = seq_row(b, DIR, ck * 68 + (s0_) + i_); const size_t o_ = ((size_t)row_ * 2 + DIR) * D + ch, q_ = (size_t)row_ * D + ch; \
            nl[i_] = *(const u32x2*)(LA + o_); nb[i_] = *(const u32x2*)(BB + o_); if (DIR == 1) { nf[i_] = *(const u32x2*)(HF + q_); ng[i_] = *(const u32x2*)(UG + q_); } } } while (0)
        SC3_LOAD(0);
#pragma unroll 1
        for (int s0 = 0; s0 < 68; s0 += 4) { u32x2 cl[4], cb[4], cf[4], cg[4];
#pragma unroll
            for (int i = 0; i < 4; ++i) { cl[i] = nl[i]; cb[i] = nb[i]; if (DIR == 1) { cf[i] = nf[i]; cg[i] = ng[i]; } }
            if (s0 + 4 < 68) SC3_LOAD(s0 + 4);
#pragma unroll
            for (int i = 0; i < 4; ++i) { const int row = seq_row(b, DIR, ck * 68 + s0 + i); const size_t q = (size_t)row * D + ch;
                const unsigned l0 = cl[i].x, l1 = cl[i].y, b0 = cb[i].x, b1 = cb[i].y;
                h[0] = __expf(bflo(l0)) * h[0] + bflo(b0); h[1] = __expf(bfhi(l0)) * h[1] + bfhi(b0); h[2] = __expf(bflo(l1)) * h[2] + bflo(b1); h[3] = __expf(bfhi(l1)) * h[3] + bfhi(b1);
                if (DIR == 0) { *(u32x2*)(HF + q) = (u32x2){cvt_pk_bf16(h[0], h[1]), cvt_pk_bf16(h[2], h[3])}; }
                else { const unsigned f0 = cf[i].x, f1 = cf[i].y, g0 = cg[i].x, g1 = cg[i].y;
                    *(u32x2*)(YIN + q) = (u32x2){cvt_pk_bf16(bflo(g0) * (bflo(f0) + h[0]), bfhi(g0) * (bfhi(f0) + h[1])), cvt_pk_bf16(bflo(g1) * (bflo(f1) + h[2]), bfhi(g1) * (bfhi(f1) + h[3]))}; } } }
#undef SC3_LOAD
    }
}

__device__ __forceinline__ void phase_ln_mid(KP P, const Ctx& c, int layer, int row_lo) {
    float* X = (float*)(P->ws + WS_X); bf16_t* H2 = (bf16_t*)(P->ws + WS_H2);
    const float* lg = P->in[I_LNG] + (size_t)(layer * 2 + 0) * D; const float* lb = P->in[I_LNB] + (size_t)(layer * 2 + 0) * D;
    f32x4 xn[8];
    const bf16_t* PB = (const bf16_t*)(P->ws + WS_S);
    u32x2 pn[8];
    { const int r0 = row_lo + c.gw; if (r0 < T) {
#pragma unroll
        for (int j = 0; j < 8; ++j) { xn[j] = *(const f32x4*)(X + (size_t)r0 * D + c.lane * 4 + 256 * j); pn[j] = *(const u32x2*)(PB + (size_t)r0 * D + c.lane * 4 + 256 * j); } } }
    for (int row = row_lo + c.gw; row < T; row += c.ngw) { float* xr = X + (size_t)row * D + c.lane * 4; const int v = row_vec(row);
        f32x4 x[8]; float s = 0.f;
        { const float* gp = modp(P, layer, v, 2) + c.lane * 4;
#pragma unroll
          for (int j = 0; j < 8; ++j) { const unsigned p0 = pn[j].x, p1 = pn[j].y; x[j] = xn[j] * ALPHA + *(const f32x4*)(gp + 256 * j) * (f32x4){bflo(p0), bfhi(p0), bflo(p1), bfhi(p1)}; } }
        if (row + c.ngw < T) {
#pragma unroll
            for (int j = 0; j < 8; ++j) { xn[j] = *(const f32x4*)(X + (size_t)(row + c.ngw) * D + c.lane * 4 + 256 * j); pn[j] = *(const u32x2*)(PB + (size_t)(row + c.ngw) * D + c.lane * 4 + 256 * j); } }
#pragma unroll
        for (int j = 0; j < 8; ++j) s += (x[j][0] + x[j][1]) + (x[j][2] + x[j][3]);
        const float mean = wave_sum(s) * (1.0f / D); float q = 0.f;
#pragma unroll
        for (int j = 0; j < 8; ++j) { x[j] = x[j] - mean; q += (x[j][0] * x[j][0] + x[j][1] * x[j][1]) + (x[j][2] * x[j][2] + x[j][3] * x[j][3]); }
        const float rstd = rsqrtf(wave_sum(q) * (1.0f / D) + LN_EPS);
        const float* m3 = modp(P, layer, v, 3) + c.lane * 4; const float* m4 = modp(P, layer, v, 4) + c.lane * 4;
#pragma unroll
        for (int jh = 0; jh < 2; ++jh) { f32x4 g4[4], b4[4], p4[4], q4[4];
#pragma unroll
            for (int jj = 0; jj < 4; ++jj) { const int j = 4 * jh + jj; g4[jj] = *(const f32x4*)(lg + c.lane * 4 + 256 * j); b4[jj] = *(const f32x4*)(lb + c.lane * 4 + 256 * j);
                p4[jj] = *(const f32x4*)(m4 + 256 * j); q4[jj] = *(const f32x4*)(m3 + 256 * j); }
#pragma unroll
            for (int jj = 0; jj < 4; ++jj) { const int j = 4 * jh + jj;
                const f32x4 y = x[j] * rstd * g4[jj] + b4[jj]; *(f32x4*)(xr + 256 * j) = y;
                const f32x4 h = y * (p4[jj] + 1.0f) + q4[jj];
                *(u32x2*)(H2 + (size_t)row * D + c.lane * 4 + 256 * j) = (u32x2){cvt_pk_bf16(h[0], h[1]), cvt_pk_bf16(h[2], h[3])}; } } }
}

__device__ __forceinline__ float dot2bf(unsigned a, unsigned b, float s) { return __builtin_amdgcn_fdot2_f32_bf16(__builtin_bit_cast(bf16v2, a), __builtin_bit_cast(bf16v2, b), s, false); }
__device__ __forceinline__ float dot8(const u32x4 a, const u32x4 b, float s) {
    const unsigned a0 = a.x, a1 = a.y, a2 = a.z, a3 = a.w, b0 = b.x, b1 = b.y, b2 = b.z, b3 = b.w;
    s = dot2bf(a0, b0, s); s = dot2bf(a1, b1, s); s = dot2bf(a2, b2, s); s = dot2bf(a3, b3, s);
    return s;
}
template <int CTRL> __device__ __forceinline__ int dpp_movi(int x) { return __builtin_amdgcn_update_dpp(x, x, CTRL, 0xF, 0xF, false); }
__device__ __forceinline__ int row_max_i(int m) { m = max(m, dpp_movi<0xB1>(m)); m = max(m, dpp_movi<0x4E>(m)); m = max(m, dpp_movi<0x141>(m)); m = max(m, dpp_movi<0x140>(m)); return m; }
template <int PAT> __device__ __forceinline__ int swz(int v) { return __builtin_amdgcn_ds_swizzle(v, PAT); }
__device__ __forceinline__ int f2key(float f) { const int b = __float_as_int(f); return b ^ ((b >> 31) & 0x7fffffff); }
__device__ __forceinline__ float key2f(int k) { return __int_as_float(k ^ ((k >> 31) & 0x7fffffff)); }
__device__ __forceinline__ void row_max_i_pair(int& a, int& b) {
    asm volatile("s_nop 1\n\t"
        "v_max_i32_dpp %0, %0, %0 quad_perm:[1,0,3,2] row_mask:0xf bank_mask:0xf\n\tv_max_i32_dpp %1, %1, %1 quad_perm:[1,0,3,2] row_mask:0xf bank_mask:0xf\n\ts_nop 0\n\t"
        "v_max_i32_dpp %0, %0, %0 quad_perm:[2,3,0,1] row_mask:0xf bank_mask:0xf\n\tv_max_i32_dpp %1, %1, %1 quad_perm:[2,3,0,1] row_mask:0xf bank_mask:0xf\n\ts_nop 0\n\t"
        "v_max_i32_dpp %0, %0, %0 row_half_mirror row_mask:0xf bank_mask:0xf\n\tv_max_i32_dpp %1, %1, %1 row_half_mirror row_mask:0xf bank_mask:0xf\n\ts_nop 0\n\t"
        "v_max_i32_dpp %0, %0, %0 row_mirror row_mask:0xf bank_mask:0xf\n\tv_max_i32_dpp %1, %1, %1 row_mirror row_mask:0xf bank_mask:0xf"
        : "+v"(a), "+v"(b));
}
__device__ __forceinline__ void phase_peer_select(KP P, const Ctx& c, int row_lo) {
    const float* S = (const float*)(P->ws + WS_S); float* SW = (float*)(P->ws + WS_SELW);
    constexpr int KMIN = (int)0x80000000;
    const int nps = (2 * (T - row_lo) - c.gw + c.ngw - 1) / c.ngw;
    f32x4 sn[2][2];
#define SEL_LOAD(k) do { const int pid_ = 2 * row_lo + c.gw + (k) * c.ngw; const float* sp_ = S + (size_t)(pid_ >> 1) * D + (2 * (pid_ & 1)) * 512 + lane * 8; \
        sn[0][0] = *(const f32x4*)sp_; sn[0][1] = *(const f32x4*)(sp_ + 4); sn[1][0] = *(const f32x4*)(sp_ + 512); sn[1][1] = *(const f32x4*)(sp_ + 516); } while (0)
    { int lane = c.lane; asm volatile("" : "+v"(lane)); if (nps > 0) SEL_LOAD(0); }
    {
#pragma unroll 1
        for (int kk = 0; kk < nps; ++kk) {
            const int pid = 2 * row_lo + c.gw + kk * c.ngw, row = pid >> 1, pp = pid & 1;
            int lane = c.lane; asm volatile("" : "+v"(lane));
            const int l16 = lane & 15, isS2 = (lane >> 4) & 1;
            int k8[2][8];
#pragma unroll
            for (int q = 0; q < 2; ++q) {
#pragma unroll
                for (int e = 0; e < 8; ++e) { const float v = sn[q][e >> 2][e & 3]; k8[q][e] = (f2key(v) & ~127) | (127 - (l16 * 8 + e)); } }
            if (kk + 1 < nps) SEL_LOAD(kk + 1);
#define SEL_CE(a, b) do { const int hi_ = max(a, b), lo_ = min(a, b); a = hi_; b = lo_; } while (0)
#pragma unroll
            for (int q = 0; q < 2; ++q) { int (&k)[8] = k8[q];
                SEL_CE(k[0], k[1]); SEL_CE(k[2], k[3]); SEL_CE(k[4], k[5]); SEL_CE(k[6], k[7]); SEL_CE(k[0], k[2]); SEL_CE(k[1], k[3]); SEL_CE(k[4], k[6]); SEL_CE(k[5], k[7]);
                SEL_CE(k[1], k[2]); SEL_CE(k[5], k[6]); SEL_CE(k[0], k[4]); SEL_CE(k[3], k[7]); SEL_CE(k[1], k[5]); SEL_CE(k[2], k[6]); SEL_CE(k[1], k[4]); SEL_CE(k[3], k[6]);
                SEL_CE(k[2], k[4]); SEL_CE(k[3], k[5]); SEL_CE(k[3], k[4]); }
            int own[2] = {KMIN, KMIN};
#pragma unroll
            for (int it = 0; it < 16; ++it) {
                int m0 = k8[0][0], m1 = k8[1][0];
                row_max_i_pair(m0, m1);
                const bool p0 = k8[0][0] == m0, p1 = k8[1][0] == m1;
#pragma unroll
                for (int e = 0; e < 7; ++e) { k8[0][e] = p0 ? k8[0][e + 1] : k8[0][e]; k8[1][e] = p1 ? k8[1][e + 1] : k8[1][e]; }
                k8[0][7] = p0 ? KMIN : k8[0][7]; k8[1][7] = p1 ? KMIN : k8[1][7];
                own[0] = (l16 == it) ? m0 : own[0]; own[1] = (l16 == it) ? m1 : own[1]; }
            int ck[2][4], ownIdx[2];
#pragma unroll
            for (int q = 0; q < 2; ++q) { ownIdx[q] = 127 - (own[q] & 127); const float ownVal = key2f(own[q]);
                int pk[4]; pk[0] = swz<(0x10 << 10) | (0 << 5) | 0x10>(own[q]); pk[1] = swz<(0x10 << 10) | (1 << 5) | 0x10>(own[q]); pk[2] = swz<(0x10 << 10) | (2 << 5) | 0x10>(own[q]); pk[3] = swz<(0x10 << 10) | (3 << 5) | 0x10>(own[q]);
#pragma unroll
                for (int m = 0; m < 4; ++m) { const float pv = key2f(pk[m]);
                    const int ci = isS2 ? m : l16, cj = isS2 ? l16 : m;
                    const bool valid = (isS2 ? (m <= l16) : (m < l16)) && ((ci + 1) * (cj + 1) <= 16);
                    ck[q][m] = valid ? ((f2key(ownVal + pv) & ~255) | (255 - (ci * 16 + cj))) : KMIN; } }
#pragma unroll
            for (int q = 0; q < 2; ++q) { int (&k)[4] = ck[q]; SEL_CE(k[0], k[1]); SEL_CE(k[2], k[3]); SEL_CE(k[0], k[2]); SEL_CE(k[1], k[3]); SEL_CE(k[1], k[2]); }
#undef SEL_CE
            int win[2] = {KMIN, KMIN};
#pragma unroll
            for (int it = 0; it < 16; ++it) {
                int m0 = ck[0][0], m1 = ck[1][0];
                row_max_i_pair(m0, m1);
                m0 = max(m0, swz<(0x10 << 10) | 0x1F>(m0)); m1 = max(m1, swz<(0x10 << 10) | 0x1F>(m1));
                const bool p0 = ck[0][0] == m0, p1 = ck[1][0] == m1;
#pragma unroll
                for (int e = 0; e < 3; ++e) { ck[0][e] = p0 ? ck[0][e + 1] : ck[0][e]; ck[1][e] = p1 ? ck[1][e + 1] : ck[1][e]; }
                ck[0][3] = p0 ? KMIN : ck[0][3]; ck[1][3] = p1 ? KMIN : ck[1][3];
                win[0] = (l16 == it) ? m0 : win[0]; win[1] = (l16 == it) ? m1 : win[1]; }
#pragma unroll
            for (int q = 0; q < 2; ++q) {
                const int cidx = 255 - (win[q] & 255), ci = (cidx >> 4) & 15, cj = cidx & 15, rb = lane & 32;
                const int i1 = __builtin_amdgcn_ds_bpermute((rb + ci) << 2, ownIdx[q]), i2 = __builtin_amdgcn_ds_bpermute((rb + 16 + cj) << 2, ownIdx[q]);
                const float sc = key2f(win[q]);
                const float mxf = key2f(row_max_i(f2key(sc)));
                const float ex = __expf(sc - mxf);
                float sum = ex; sum += dpp_mov<0xB1>(sum); sum += dpp_mov<0x4E>(sum); sum += dpp_mov<0x141>(sum); sum += dpp_mov<0x140>(sum);
                if (!isS2) { const size_t o = ((size_t)row * 8 + (2 * pp + q) * 2 + (lane >> 5)) * 16 + l16; const int e_ = (i1 * 128 + i2) & 16383; ((unsigned short*)(P->ws + P_SE16))[o] = (unsigned short)e_; SW[o] = ex / sum; } }
        }
    }
#undef SEL_LOAD
}

__device__ __forceinline__ float dot2bf_init(bf16v2 a, bf16v2 b) { float r; asm("v_dot2_f32_bf16 %0, %1, %2, 0" : "=v"(r) : "v"(a), "v"(b)); return r; }
__device__ __forceinline__ void unpack16_fp8(const u32x4 a, float (&f)[16]) {
#pragma unroll
    for (int w = 0; w < 4; ++w) { const int aw = (int)a[w]; const f32x2 lo = __builtin_amdgcn_cvt_pk_f32_fp8(aw, false), hi = __builtin_amdgcn_cvt_pk_f32_fp8(aw, true);
        f[4 * w + 0] = lo.x; f[4 * w + 1] = lo.y; f[4 * w + 2] = hi.x; f[4 * w + 3] = hi.y; }
}
#define PEER_QUEUE_BEGIN(phase_id, tg_lo, tg_hi) { \
    unsigned* heads_ = (unsigned*)(P->ws + WS_CTL) + CW_PQ + (phase_id) * 16 * 64; const unsigned x_ = ((PROBE >> 19) & 1) ? ((unsigned)blockIdx.x >> 5) & 7u : (xb_xcc_id() & 7u); \
    for (int k_ = 0; k_ < 16; ++k_) { const int db = (int)((x_ + 8u * (k_ & 1) + (unsigned)(k_ >> 1)) & 15u); \
        for (;;) { unsigned t0_ = 0; if (c.lane == 0) t0_ = __hip_atomic_fetch_add(heads_ + db * 64, 2u, __ATOMIC_RELAXED, __HIP_MEMORY_SCOPE_AGENT); \
            t0_ = (unsigned)__builtin_amdgcn_readfirstlane((int)t0_) + (unsigned)(tg_lo); if (t0_ >= (unsigned)(tg_hi)) break; \
            for (unsigned tg_ = t0_; tg_ < t0_ + 2u && tg_ < (unsigned)(tg_hi); ++tg_) { const int tg = (int)tg_;
#define PEER_QUEUE_END } } } }
__device__ __forceinline__ void phase_peer_u(KP P, const Ctx& c, int layer, int row_lo, int qrep) {
    const bf16_t* H2 = (const bf16_t*)(P->ws + WS_H2); const unsigned short* SE = (const unsigned short*)(P->ws + P_SE16);
    const unsigned char* U = P->ws + WS_PU + (size_t)layer * 16384 * D; bf16_t* PART = (bf16_t*)(P->ws + P_PART);
    PEER_QUEUE_BEGIN(layer * 2 + 0 + 8 * qrep, row_lo / 8, T / 8)
        int lane = c.lane; asm volatile("" : "+v"(lane));
        const int ts = lane >> 3, seg = lane & 7, t = tg * 8 + ts;
        const bf16_t* xp = H2 + (size_t)t * D + db * 128 + seg * 16; const u32x4 xa = *(const u32x4*)xp, xb = *(const u32x4*)(xp + 8);
        const unsigned short* se = SE + (size_t)t * 128; const unsigned char* ub = U + (size_t)db * 16384 * 128; const unsigned seg16 = (unsigned)seg * 16u;
        bf16_t* pp = PART + (((size_t)t * 16 + db) * 8 + seg) * 16;
        u32x4 eA[2], eB[2], gA[16], gB[16];
#define PU_IDX(E, st) do { _Pragma("unroll") for (int i_ = 0; i_ < 2; ++i_) E[i_] = *(const u32x4*)(se + 16 * (st) + 8 * i_); } while (0)
#define PU_GATHER(G, E) do { _Pragma("unroll") for (int k_ = 0; k_ < 16; ++k_) { const unsigned w_ = E[k_ >> 3][(k_ >> 1) & 3]; const unsigned e_ = ((k_ & 1) ? (w_ >> 16) : w_) & 16383u; G[k_] = *(const u32x4*)(ub + (unsigned)((e_ << 7) | seg16)); } } while (0)
#define PU_COMPUTE(G, OUT) do { float v2_[2]; \
            _Pragma("unroll") for (int cc = 0; cc < 2; ++cc) { float sk[8]; \
                _Pragma("unroll") for (int k = 0; k < 8; ++k) { float s0; \
                    _Pragma("unroll") for (int w = 0; w < 4; ++w) { const int gw_ = (int)G[8 * cc + k][w]; const unsigned x0 = w < 2 ? xa[2 * w] : xb[2 * w - 4], x1 = w < 2 ? xa[2 * w + 1] : xb[2 * w - 3]; \
                        if (w == 0) s0 = dot2bf_init(__builtin_amdgcn_cvt_scalef32_pk_bf16_fp8(gw_, 1.0f, false), __builtin_bit_cast(bf16v2, x0)); \
                        else s0 = __builtin_amdgcn_fdot2_f32_bf16(__builtin_amdgcn_cvt_scalef32_pk_bf16_fp8(gw_, 1.0f, false), __builtin_bit_cast(bf16v2, x0), s0, false); \
                        s0 = __builtin_amdgcn_fdot2_f32_bf16(__builtin_amdgcn_cvt_scalef32_pk_bf16_fp8(gw_, 1.0f, true), __builtin_bit_cast(bf16v2, x1), s0, false); } \
                    sk[k] = s0; } \
                sum8_quad(sk[0], sk[1], sk[2], sk[3]); sum8_quad(sk[4], sk[5], sk[6], sk[7]); \
                float v = 0.f; \
                _Pragma("unroll") for (int k = 0; k < 8; ++k) v = (seg == k) ? sk[k] : v; \
                v2_[cc] = v; } \
            OUT = cvt_pk_bf16(v2_[0], v2_[1]); } while (0)
        PU_IDX(eA, 0); PU_IDX(eB, 1); PU_GATHER(gA, eA);
#pragma unroll 1
        for (int j2 = 0; j2 < 4; ++j2) {
            PU_GATHER(gB, eB);
            if (j2 < 3) PU_IDX(eA, 2 * j2 + 2);
            unsigned pw0, pw1;
            PU_COMPUTE(gA, pw0);
            if (j2 < 3) { PU_GATHER(gA, eA); PU_IDX(eB, 2 * j2 + 3); }
            PU_COMPUTE(gB, pw1);
            *(u32x2*)(pp + 4 * j2) = (u32x2){pw0, pw1};
        }
#undef PU_IDX
#undef PU_GATHER
#undef PU_COMPUTE
    PEER_QUEUE_END
}
__device__ __forceinline__ void phase_peer_c(KP P, const Ctx& c, int layer, int row_lo) {
    const bf16_t* PART = (const bf16_t*)(P->ws + P_PART); const unsigned short* SE = (const unsigned short*)(P->ws + P_SE16); const float* SW = (const float*)(P->ws + WS_SELW);
    const float* ISU = (const float*)(P->ws + WS_PSC) + (size_t)layer * 16384; const float* ISV = ISU + (size_t)4 * 16384; bf16_t* C = (bf16_t*)(P->ws + P_C);
    unsigned pw[16]; unsigned short se0, se1; float w0, w1;
#define PC_LOAD(i_) do { const size_t t_ = (i_) >> 6; const int jj_ = (int)((i_) & 7), seg_ = (int)(((i_) >> 3) & 7); const unsigned* pp_ = (const unsigned*)(PART + ((t_ * 16) * 8 + seg_) * 16 + 2 * jj_); \
        _Pragma("unroll") for (int db = 0; db < 16; ++db) pw[db] = pp_[(size_t)db * 64]; \
        const size_t o_ = t_ * 128 + 16 * jj_ + seg_; se0 = SE[o_]; se1 = SE[o_ + 8]; w0 = SW[o_]; w1 = SW[o_ + 8]; } while (0)
    const size_t ibeg = (size_t)row_lo * 64 + c.gtid, iend = (size_t)T * 64;
    if (ibeg < iend) PC_LOAD(ibeg);
    for (size_t i = ibeg; i < iend; i += c.ngt) { const size_t t = i >> 6; const int jj = (int)(i & 7), seg = (int)((i >> 3) & 7);
        const size_t o0 = t * 128 + 16 * jj + seg, o1 = o0 + 8; const int e0 = se0 & 16383, e1 = se1 & 16383; const float cw0 = w0, cw1 = w1;
        const float iu0 = ISU[e0], iv0 = ISV[e0], iu1 = ISU[e1], iv1 = ISV[e1]; float s0 = 0.f, s1 = 0.f;
#pragma unroll
        for (int db = 0; db < 16; ++db) { const unsigned w = pw[db]; s0 += __builtin_bit_cast(float, w << 16); s1 += __builtin_bit_cast(float, w & 0xffff0000u); }
        if (i + c.ngt < iend) PC_LOAD(i + c.ngt);
        C[o0] = (bf16_t)(cvt_pk_bf16(cw0 * gelu_tanh(s0 * iu0) * iv0, 0.f) & 0xffffu);
        C[o1] = (bf16_t)(cvt_pk_bf16(cw1 * gelu_tanh(s1 * iu1) * iv1, 0.f) & 0xffffu); }
#undef PC_LOAD
}
__device__ __forceinline__ void phase_peer_v(KP P, const Ctx& c, int layer, int row_lo, int qrep) {
    const unsigned short* SE = (const unsigned short*)(P->ws + P_SE16); const bf16_t* C = (const bf16_t*)(P->ws + P_C);
    const unsigned char* V = P->ws + WS_PV + (size_t)layer * 16384 * D; bf16_t* Y = (bf16_t*)(P->ws + P_Y);
    PEER_QUEUE_BEGIN(layer * 2 + 1 + 8 * qrep, row_lo / 8, T / 8)
        int lane = c.lane; asm volatile("" : "+v"(lane));
        const int ts = lane >> 3, seg = lane & 7, t = tg * 8 + ts;
        const unsigned short* se = SE + (size_t)t * 128; const bf16_t* cp = C + (size_t)t * 128; const unsigned char* vb = V + (size_t)db * 16384 * 128; const unsigned seg16 = (unsigned)seg * 16u;
        float acc[16];
#pragma unroll
        for (int e = 0; e < 16; ++e) acc[e] = 0.f;
        u32x4 en[2];
#pragma unroll
        for (int i = 0; i < 2; ++i) en[i] = *(const u32x4*)(se + 8 * i);
#pragma unroll 1
        for (int q = 0; q < 8; ++q) { u32x4 ec[2];
#pragma unroll
          for (int i = 0; i < 2; ++i) ec[i] = en[i];
          if (q < 7) {
#pragma unroll
            for (int i = 0; i < 2; ++i) en[i] = *(const u32x4*)(se + 16 * (q + 1) + 8 * i); }
          const u32x4 c0 = *(const u32x4*)(cp + 16 * q), c1 = *(const u32x4*)(cp + 16 * q + 8);
          u32x4 g[16];
#pragma unroll
          for (int k = 0; k < 16; ++k) { const unsigned w_ = ec[k >> 3][(k >> 1) & 3]; const unsigned e = ((k & 1) ? (w_ >> 16) : w_) & 16383u; g[k] = *(const u32x4*)(vb + (unsigned)((e << 7) | seg16)); }
#pragma unroll
          for (int k = 0; k < 16; k += 2) { const unsigned cwu = (k < 8 ? c0 : c1)[(k >> 1) & 3]; const bf16v2 cw = __builtin_bit_cast(bf16v2, cwu);
#pragma unroll
              for (int w = 0; w < 4; ++w) { const unsigned g0 = g[k][w], g1 = g[k + 1][w];
                  const int pa = (int)__builtin_amdgcn_perm(g1, g0, 0x05010400u), pb = (int)__builtin_amdgcn_perm(g1, g0, 0x07030602u);
                  acc[4 * w + 0] = __builtin_amdgcn_fdot2_f32_bf16(__builtin_amdgcn_cvt_scalef32_pk_bf16_fp8(pa, 1.0f, false), cw, acc[4 * w + 0], false);
                  acc[4 * w + 1] = __builtin_amdgcn_fdot2_f32_bf16(__builtin_amdgcn_cvt_scalef32_pk_bf16_fp8(pa, 1.0f, true), cw, acc[4 * w + 1], false);
                  acc[4 * w + 2] = __builtin_amdgcn_fdot2_f32_bf16(__builtin_amdgcn_cvt_scalef32_pk_bf16_fp8(pb, 1.0f, false), cw, acc[4 * w + 2], false);
                  acc[4 * w + 3] = __builtin_amdgcn_fdot2_f32_bf16(__builtin_amdgcn_cvt_scalef32_pk_bf16_fp8(pb, 1.0f, true), cw, acc[4 * w + 3], false); } } }
        bf16_t* yp = Y + (size_t)t * D + db * 128 + seg * 16;
#pragma unroll
        for (int q = 0; q < 2; ++q) *(u32x4*)(yp + 8 * q) = (u32x4){cvt_pk_bf16(acc[8 * q], acc[8 * q + 1]), cvt_pk_bf16(acc[8 * q + 2], acc[8 * q + 3]), cvt_pk_bf16(acc[8 * q + 4], acc[8 * q + 5]), cvt_pk_bf16(acc[8 * q + 6], acc[8 * q + 7])};
    PEER_QUEUE_END
}
template <bool LAST>
__device__ __forceinline__ void phase_peer_final(KP P, const Ctx& c, int layer) {
    const bf16_t* Y = (const bf16_t*)(P->ws + P_Y); float* X = (float*)(P->ws + WS_X); bf16_t* A0 = (bf16_t*)(P->ws + WS_A0);
    const float* lg = P->in[I_LNG] + (size_t)(layer * 2 + 1) * D; const float* lb = P->in[I_LNB] + (size_t)(layer * 2 + 1) * D;
    const float ymul = ((DBG_ZERO >> (2 * layer + 1)) & 1) ? 0.f : 1.f;
    f32x4 xn[8]; u32x2 yn[8];
    { const int r0 = (LAST ? NCTX : 0) + c.gw; if (r0 < T) {
#pragma unroll
        for (int j = 0; j < 8; ++j) { xn[j] = *(const f32x4*)(X + (size_t)r0 * D + c.lane * 4 + 256 * j); yn[j] = *(const u32x2*)(Y + (size_t)r0 * D + c.lane * 4 + 256 * j); } } }
    for (int row = (LAST ? NCTX : 0) + c.gw; row < T; row += c.ngw) {
        int l4 = c.lane * 4; asm volatile("" : "+v"(l4));
        const int v = row_vec(row); const float* m5 = modp(P, layer, v, 5) + l4;
        f32x4 x[8]; float s = 0.f;
#pragma unroll
        for (int j = 0; j < 8; ++j) { const u32x2 yb = yn[j]; const f32x4 yv = (f32x4){bflo(yb.x), bfhi(yb.x), bflo(yb.y), bfhi(yb.y)};
            x[j] = xn[j] * ALPHA + *(const f32x4*)(m5 + 256 * j) * (yv * ymul); s += (x[j][0] + x[j][1]) + (x[j][2] + x[j][3]); }
        if (row + c.ngw < T) {
#pragma unroll
            for (int j = 0; j < 8; ++j) { xn[j] = *(const f32x4*)(X + (size_t)(row + c.ngw) * D + l4 + 256 * j); yn[j] = *(const u32x2*)(Y + (size_t)(row + c.ngw) * D + l4 + 256 * j); } }
        const float mean = wave_sum(s) * (1.0f / D); float q = 0.f;
#pragma unroll
        for (int j = 0; j < 8; ++j) { x[j] = x[j] - mean; q += (x[j][0] * x[j][0] + x[j][1] * x[j][1]) + (x[j][2] * x[j][2] + x[j][3] * x[j][3]); }
        const float rstd = rsqrtf(wave_sum(q) * (1.0f / D) + LN_EPS);
        const bool mk_a0 = !LAST && layer != 0;
#pragma unroll
        for (int jh = 0; jh < 2; ++jh) { f32x4 g4[4], b4[4], p4[4], q4[4];
#pragma unroll
            for (int jj = 0; jj < 4; ++jj) { const int o = l4 + 256 * (4 * jh + jj); g4[jj] = *(const f32x4*)(lg + o); b4[jj] = *(const f32x4*)(lb + o);
                if (mk_a0) { p4[jj] = *(const f32x4*)(modp(P, layer + 1, v, 1) + o); q4[jj] = *(const f32x4*)(modp(P, layer + 1, v, 0) + o); } }
#pragma unroll
            for (int jj = 0; jj < 4; ++jj) { const int j = 4 * jh + jj, o = l4 + 256 * j; const f32x4 y = x[j] * rstd * g4[jj] + b4[jj];
                if (LAST) { *(f32x4*)(P->out + (size_t)(row - NCTX) * D + o) = y; }
                else { *(f32x4*)(X + (size_t)row * D + o) = y;
                    if (mk_a0) { const f32x4 hv = y * (p4[jj] + 1.0f) + q4[jj];
                        *(u32x2*)(A0 + (size_t)row * D + o) = (u32x2){cvt_pk_bf16(hv[0], hv[1]), cvt_pk_bf16(hv[2], hv[3])}; } } } }
    }
}

__device__ __forceinline__ void phase_rw_mix(KP P, const Ctx& c, int layer) {
    const float* X = (const float*)(P->ws + WS_X); bf16_t* AALL = (bf16_t*)(P->ws + L_AALL); const float* mu = P->in[I_RWMU];
    float mu8[6][8];
    { const int c8 = (int)(c.gtid & 255) * 8;
#pragma unroll
      for (int m = 0; m < 6; ++m) { const f32x4 a = *(const f32x4*)(mu + m * D + c8), b = *(const f32x4*)(mu + m * D + c8 + 4);
#pragma unroll
          for (int j = 0; j < 4; ++j) { mu8[m][j] = a[j]; mu8[m][4 + j] = b[j]; } } }
    const int c8 = (int)(c.gtid & 255) * 8;
    f32x4 nx0, nx1, nn0, nn1, nsh0, nsh1, nsc0, nsc1; int nnb;
#define MX_LOAD(i_) do { const int row_ = (int)((i_) >> 8); const int v_ = row_vec(row_); int nb_ = -1;     \
        if (row_ < NCTX) { const int t_ = row_ & (CTX - 1); if (c8 < 1024) { if (t_ > 0) nb_ = row_ - 1; } else { if (t_ < CTX - 1) nb_ = row_ + 1; } } \
        else { const int t_ = (row_ - NCTX) & (SEQ - 1), qd_ = c8 >> 9; \
            if (qd_ == 0) { if ((t_ & 63) != 0) nb_ = row_ - 1; } else if (qd_ == 1) { if ((t_ & 63) != 63) nb_ = row_ + 1; } \
            else if (qd_ == 2) { if (t_ >= 64) nb_ = row_ - 64; } else { if (t_ < SEQ - 64) nb_ = row_ + 64; } } \
        const float* xp_ = X + (size_t)row_ * D + c8; nx0 = *(const f32x4*)xp_; nx1 = *(const f32x4*)(xp_ + 4); nnb = nb_; \
        if (nb_ >= 0) { const float* np_ = X + (size_t)nb_ * D + c8; nn0 = *(const f32x4*)np_; nn1 = *(const f32x4*)(np_ + 4); } \
        const float* sh_ = modp(P, layer, v_, 0) + c8; const float* sc_ = modp(P, layer, v_, 1) + c8; \
        nsh0 = *(const f32x4*)sh_; nsh1 = *(const f32x4*)(sh_ + 4); nsc0 = *(const f32x4*)sc_; nsc1 = *(const f32x4*)(sc_ + 4); } while (0)
    if ((size_t)c.gtid < TD / 8) MX_LOAD((size_t)c.gtid);
    for (size_t i = c.gtid; i < TD / 8; i += c.ngt) { const int row = (int)(i >> 8);
        float h[8], xx[8];
        { const int nb = nnb;
#pragma unroll
          for (int j = 0; j < 8; ++j) { const float scj = 1.0f + (j < 4 ? nsc0[j & 3] : nsc1[j & 3]), shj = j < 4 ? nsh0[j & 3] : nsh1[j & 3];
              h[j] = (j < 4 ? nx0[j & 3] : nx1[j & 3]) * scj + shj;
              const float sv = nb >= 0 ? (j < 4 ? nn0[j & 3] : nn1[j & 3]) * scj + shj : 0.f; xx[j] = sv - h[j]; } }
        if (i + c.ngt < TD / 8) MX_LOAD(i + c.ngt);
#pragma unroll
        for (int m = 0; m < 6; ++m) { float o[8];
#pragma unroll
            for (int j = 0; j < 8; ++j) o[j] = h[j] + xx[j] * mu8[m][j];
            *(u32x4*)(AALL + (size_t)row * (6 * D) + m * D + c8) = (u32x4){cvt_pk_bf16(o[0], o[1]), cvt_pk_bf16(o[2], o[3]), cvt_pk_bf16(o[4], o[5]), cvt_pk_bf16(o[6], o[7])}; } }
#undef MX_LOAD
}
__device__ __forceinline__ void phase_rw_scan(KP P, const Ctx& c) {
    const bf16_t* R = (const bf16_t*)(P->ws + L_RKV); const bf16_t* Kx = R + TD; const bf16_t* Vx = R + 2 * TD;
    const bf16_t* W = (const bf16_t*)(P->ws + L_W); const bf16_t* AD = (const bf16_t*)(P->ws + L_AD);
    LAS float* rL = (LAS float*)c.lds; LAS float* wL = rL + 4096; LAS float* kkL = rL + 8192; LAS float* bL = rL + 12288; LAS float* kdL = rL + 16384; LAS float* vL = rL + 20480; LAS float* yL = rL + 24576; LAS float* scL = rL + 28672;
    const int tok = c.tid >> 3, cq = c.tid & 7;
    for (int chain = blockIdx.x; chain < 256; chain += gridDim.x) {
        const int b = chain >> 6, hd = (chain >> 1) & 31, dir = chain & 1;
        bf16_t* Y = (bf16_t*)(P->ws + (dir ? L_Y1 : L_Y0));
        const int ch0 = hd * 64 + cq * 8;
        float kkw[8], kaw[8];
#pragma unroll
        for (int j = 0; j < 8; ++j) { kkw[j] = P->in[I_RWKK][ch0 + j]; kaw[j] = P->in[I_RWKA][ch0 + j]; }
        float s[8] = {0.f, 0.f, 0.f, 0.f, 0.f, 0.f, 0.f, 0.f};
        u32x4 gr, gk, gv, gw, ga;
#define RW_GLOAD(ck) do { const int row_ = seq_row(b, dir, (ck) * 64 + tok); gr = *(const u32x4*)(R + (size_t)row_ * D + ch0); gk = *(const u32x4*)(Kx + (size_t)row_ * D + ch0); gv = *(const u32x4*)(Vx + (size_t)row_ * D + ch0); \
        gw = *(const u32x4*)(W + ((size_t)row_ * 2 + dir) * D + ch0); ga = *(const u32x4*)(AD + ((size_t)row_ * 2 + dir) * D + ch0); } while (0)
        RW_GLOAD(0);
        for (int ck = 0; ck < SLEN / 64; ++ck) {
            const int row = seq_row(b, dir, ck * 64 + tok);
            float r8[8], k8[8], v8[8], w8[8], a8[8];
            unpack8(gr, r8); unpack8(gk, k8); unpack8(gv, v8); unpack8(gw, w8); unpack8(ga, a8);
            float kx[8], ss = 0.f;
#pragma unroll
            for (int j = 0; j < 8; ++j) { kx[j] = k8[j] * kkw[j]; ss += kx[j] * kx[j]; }
            ss = sum8(ss);
            const float rn = rsqrtf(ss + 1e-12f);
            __syncthreads();
            float pbr = 0.f, pkr = 0.f;
            {   float wr_[8], kk_[8], b_[8], kd_[8];
#pragma unroll
                for (int j = 0; j < 8; ++j) { kk_[j] = kx[j] * rn; b_[j] = kk_[j] * a8[j]; kd_[j] = k8[j] * (1.0f + (a8[j] - 1.0f) * kaw[j]); wr_[j] = w8[j] * r8[j]; pbr += b_[j] * r8[j]; pkr += kd_[j] * r8[j]; }
                const int o = tok * 64 + cq * 8;
#pragma unroll
                for (int hh = 0; hh < 2; ++hh) { const int q = 4 * hh;
                    *(LAS f32x4*)(rL + o + q) = (f32x4){wr_[q], wr_[q + 1], wr_[q + 2], wr_[q + 3]}; *(LAS f32x4*)(wL + o + q) = (f32x4){w8[q], w8[q + 1], w8[q + 2], w8[q + 3]};
                    *(LAS f32x4*)(kkL + o + q) = (f32x4){kk_[q], kk_[q + 1], kk_[q + 2], kk_[q + 3]}; *(LAS f32x4*)(bL + o + q) = (f32x4){b_[q], b_[q + 1], b_[q + 2], b_[q + 3]};
                    *(LAS f32x4*)(kdL + o + q) = (f32x4){kd_[q], kd_[q + 1], kd_[q + 2], kd_[q + 3]}; *(LAS f32x4*)(vL + o + q) = (f32x4){v8[q], v8[q + 1], v8[q + 2], v8[q + 3]}; } }
            pbr = sum8(pbr); pkr = sum8(pkr);
            if (cq == 0) *(LAS f32x2*)(scL + tok * 2) = (f32x2){pbr, pkr};
            __syncthreads();
            if (ck + 1 < SLEN / 64) RW_GLOAD(ck + 1);
            f32x4 kaA, kbA, waA, wbA, baA, bbA, daA, dbA, raA, rbA, kaB, kbB, waB, wbB, baB, bbB, daB, dbB, raB, rbB; float vvA, vvB; f32x2 scA, scB;
#define RW_LLOAD(X, tk_) do { const int o_ = (tk_) * 64 + cq * 8; ka##X = *(const LAS f32x4*)(kkL + o_); kb##X = *(const LAS f32x4*)(kkL + o_ + 4); wa##X = *(const LAS f32x4*)(wL + o_); wb##X = *(const LAS f32x4*)(wL + o_ + 4); \
                ba##X = *(const LAS f32x4*)(bL + o_); bb##X = *(const LAS f32x4*)(bL + o_ + 4); da##X = *(const LAS f32x4*)(kdL + o_); db##X = *(const LAS f32x4*)(kdL + o_ + 4); ra##X = *(const LAS f32x4*)(rL + o_); rb##X = *(const LAS f32x4*)(rL + o_ + 4); \
                vv##X = vL[(tk_) * 64 + tok]; sc##X = *(const LAS f32x2*)(scL + (tk_) * 2); } while (0)
#define RW_STEP(X, tk_) do { \
                float sa = (fma_s(s[0], ka##X[0], mul_s(s[1], ka##X[1])) + fma_s(s[2], ka##X[2], mul_s(s[3], ka##X[3]))) + (fma_s(s[4], kb##X[0], mul_s(s[5], kb##X[1])) + fma_s(s[6], kb##X[2], mul_s(s[7], kb##X[3]))); \
                float yd = (fma_s(s[0], ra##X[0], mul_s(s[1], ra##X[1])) + fma_s(s[2], ra##X[2], mul_s(s[3], ra##X[3]))) + (fma_s(s[4], rb##X[0], mul_s(s[5], rb##X[1])) + fma_s(s[6], rb##X[2], mul_s(s[7], rb##X[3]))); \
                sum8_pair(sa, yd); \
                const float nsa = -sa; \
                _Pragma("unroll") for (int j2 = 0; j2 < 4; ++j2) { s[j2] = fma_s(vv##X, da##X[j2], fma_s(nsa, ba##X[j2], mul_s(s[j2], wa##X[j2]))); s[4 + j2] = fma_s(vv##X, db##X[j2], fma_s(nsa, bb##X[j2], mul_s(s[4 + j2], wb##X[j2]))); } \
                if (cq == 0) yL[(tk_) * 64 + tok] = yd - sa * sc##X[0] + vv##X * sc##X[1]; } while (0)
            RW_LLOAD(A, 0);
#pragma unroll 1
            for (int tk = 0; tk < 64; tk += 2) {
                RW_LLOAD(B, tk + 1);
                RW_STEP(A, tk);
                RW_LLOAD(A, (tk + 2) & 63);
                RW_STEP(B, tk + 1);
            }
#undef RW_STEP
#undef RW_LLOAD
            __syncthreads();
            { const f32x4 ya = *(const LAS f32x4*)(yL + tok * 64 + cq * 8), yb = *(const LAS f32x4*)(yL + tok * 64 + cq * 8 + 4);
              *(u32x4*)(Y + (size_t)row * D + ch0) = (u32x4){cvt_pk_bf16(ya[0], ya[1]), cvt_pk_bf16(ya[2], ya[3]), cvt_pk_bf16(yb[0], yb[1]), cvt_pk_bf16(yb[2], yb[3])}; }
        }
#undef RW_GLOAD
        __syncthreads();
    }
}
__device__ __forceinline__ void phase_rw_finish(KP P, const Ctx& c) {
    const bf16_t* R = (const bf16_t*)(P->ws + L_RKV); const bf16_t* Kx = R + TD; const bf16_t* Vx = R + 2 * TD;
    const bf16_t* AD = (const bf16_t*)(P->ws + L_AD); const bf16_t* G = (const bf16_t*)(P->ws + L_G);
    const bf16_t* Y0 = (const bf16_t*)(P->ws + L_Y0); const bf16_t* Y1 = (const bf16_t*)(P->ws + L_Y1); bf16_t* Z = (bf16_t*)(P->ws + L_Z);
    const int ch = c.lane * 8 + 512 * (c.gw & 3);
    float ka8[8], rk8[8], gg8[8], gb8[8];
#pragma unroll
    for (int e = 0; e < 8; ++e) { ka8[e] = P->in[I_RWKA][ch + e]; rk8[e] = P->in[I_RWRK][ch + e]; gg8[e] = P->in[I_RWGNG][ch + e]; gb8[e] = P->in[I_RWGNB][ch + e]; }
    u32x4 ny0, ny1, nr, nk, nv, na0, na1, ng;
#define RF_LOAD(k_) do { const int row_ = (k_) >> 2; const size_t o_ = (size_t)row_ * D + ch; ny0 = *(const u32x4*)(Y0 + o_); ny1 = *(const u32x4*)(Y1 + o_); nr = *(const u32x4*)(R + o_); nk = *(const u32x4*)(Kx + o_); \
        nv = *(const u32x4*)(Vx + o_); na0 = *(const u32x4*)(AD + ((size_t)row_ * 2 + 0) * D + ch); na1 = *(const u32x4*)(AD + ((size_t)row_ * 2 + 1) * D + ch); ng = *(const u32x4*)(G + o_); } while (0)
    if (c.gw < T * 4) RF_LOAD(c.gw);
    for (int k = c.gw; k < T * 4; k += c.ngw) { const size_t o = (size_t)(k >> 2) * D + ch;
            float y[8]; { float ya_[8], yb_[8]; unpack8(ny0, ya_); unpack8(ny1, yb_);
#pragma unroll
                for (int e = 0; e < 8; ++e) y[e] = ya_[e] + yb_[e]; }
            float r8[8], k8[8], v8[8], a0[8], a1[8], g8[8];
            unpack8(nr, r8); unpack8(nk, k8); unpack8(nv, v8); unpack8(na0, a0); unpack8(na1, a1); unpack8(ng, g8);
            if (k + c.ngw < T * 4) RF_LOAD(k + c.ngw);
            float s = 0.f;
#pragma unroll
            for (int e = 0; e < 8; ++e) s += y[e];
            const float mean = sum8(s) * (1.0f / 64.0f); float q = 0.f;
#pragma unroll
            for (int e = 0; e < 8; ++e) { y[e] -= mean; q += y[e] * y[e]; }
            const float rstd = rsqrtf(sum8(q) * (1.0f / 64.0f) + 64e-5f);
            float bsum = 0.f;
#pragma unroll
            for (int e = 0; e < 8; ++e) { const float ka = ka8[e], rk = rk8[e];
                const float kd0 = k8[e] * (1.0f + (a0[e] - 1.0f) * ka), kd1 = k8[e] * (1.0f + (a1[e] - 1.0f) * ka); bsum += r8[e] * (kd0 + kd1) * rk; }
            bsum = sum8(bsum);
            float z[8];
#pragma unroll
            for (int e = 0; e < 8; ++e) z[e] = (y[e] * rstd * gg8[e] + gb8[e] + bsum * v8[e]) * g8[e];
            *(u32x4*)(Z + o) = (u32x4){cvt_pk_bf16(z[0], z[1]), cvt_pk_bf16(z[2], z[3]), cvt_pk_bf16(z[4], z[5]), cvt_pk_bf16(z[6], z[7])}; }
#undef RF_LOAD
}

__device__ __forceinline__ bf16x8 frag16(const LAS unsigned char* p) { return *(const LAS bf16x8*)p; }
__device__ __forceinline__ void phase_ret_scan(KP P, const Ctx& c) {
    const bf16_t* Q = (const bf16_t*)(P->ws + L_RQ); const bf16_t* Kx = (const bf16_t*)(P->ws + L_RK); const bf16_t* Vx = (const bf16_t*)(P->ws + L_RV);
    constexpr int QP = 528, TP = 144, VP = 272;
    constexpr int OFF_Q = 0, OFF_K = 33792, OFF_KT = 67584, OFF_VT = 104448, OFF_P = 122880;
    LAS unsigned char* L = c.lds;
    const int w = c.wave;
    for (int un = blockIdx.x; un < 256; un += gridDim.x) {
        const int b = un >> 6, h = (un >> 3) & 7, dir = (un >> 2) & 1, dvs = un & 3;
        bf16_t* O = (bf16_t*)(P->ws + (dir ? L_OB : L_OF));
        int tid = c.tid;
        const float gamma = 1.0f - exp2f(-5.0f - (float)h), lg2 = log2f(gamma), g63 = exp2f(63.0f * lg2);
        f32x4 Racc[16];
#pragma unroll
        for (int i = 0; i < 16; ++i) Racc[i] = (f32x4){0.f, 0.f, 0.f, 0.f};
        u32x4 pq[4], pv[2];
#define RET_LOAD_QV(ck) do { \
        _Pragma("unroll") for (int i = 0; i < 4; ++i) { const int id = tid + 512 * i, s_ = id >> 5, dc = id & 31; \
            pq[i] = *(const u32x4*)(Q + (size_t)seq_row(b, dir, (ck) * 64 + s_) * D + h * 256 + dc * 8); } \
        _Pragma("unroll") for (int i = 0; i < 2; ++i) { const int id = tid + 512 * i, s_ = id >> 4, ec = id & 15; \
            pv[i] = *(const u32x4*)(Vx + (size_t)seq_row(b, dir, (ck) * 64 + s_) * 4096 + h * 512 + dvs * 128 + ec * 8); } } while (0)
#define RET_LOAD_K(ck, dst) do { \
        _Pragma("unroll") for (int i = 0; i < 4; ++i) { const int id = tid + 512 * i, s_ = id >> 5, dc = id & 31; \
            dst[i] = *(const u32x4*)(Kx + (size_t)seq_row(b, dir, (ck) * 64 + s_) * D + h * 256 + dc * 8); } } while (0)
#define RET_STORE_K(src) do { \
        _Pragma("unroll") for (int i = 0; i < 4; ++i) { const int id = tid + 512 * i, s_ = id >> 5, dc = id & 31; *(LAS u32x4*)(L + OFF_K + s_ * QP + dc * 16) = src[i]; } } while (0)
        RET_LOAD_QV(0);
        { u32x4 pk0[4]; RET_LOAD_K(0, pk0); __syncthreads(); RET_STORE_K(pk0); }
        for (int ck = 0; ck < SLEN / 64; ++ck) {
            asm volatile("" : "+v"(tid));
            const int lane = tid & 63, r16 = lane & 15, q4 = lane >> 4;
            __syncthreads();
#pragma unroll
            for (int i = 0; i < 4; ++i) { const int id = tid + 512 * i, s_ = id >> 5, dc = id & 31; *(LAS u32x4*)(L + OFF_Q + s_ * QP + dc * 16) = pq[i]; }
#pragma unroll
            for (int i = 0; i < 2; ++i) { const int id = tid + 512 * i, s_ = id >> 4, ec = id & 15; *(LAS u32x4*)(L + OFF_P + s_ * VP + ec * 16) = pv[i]; }
            __syncthreads();
            if (ck + 1 < SLEN / 64) RET_LOAD_QV(ck + 1);
            {   const float vs = exp2f(-lg2 * (float)lane);
#pragma unroll
                for (int i = 0; i < 4; ++i) { const int dc = w + 8 * i;
                    const u32x4 raw = *(const LAS u32x4*)(L + OFF_K + lane * QP + dc * 16);
#pragma unroll
                    for (int e = 0; e < 4; ++e) { *(LAS unsigned short*)(L + OFF_KT + (dc * 8 + 2 * e) * TP + lane * 2) = (unsigned short)(raw[e] & 0xffffu); *(LAS unsigned short*)(L + OFF_KT + (dc * 8 + 2 * e + 1) * TP + lane * 2) = (unsigned short)(raw[e] >> 16); } }
#pragma unroll
                for (int i = 0; i < 2; ++i) { const int ec = w + 8 * i; float t8[8]; unpack8(*(const LAS u32x4*)(L + OFF_P + lane * VP + ec * 16), t8);
#pragma unroll
                    for (int e = 0; e < 4; ++e) { const unsigned pk2 = cvt_pk_bf16(t8[2 * e] * vs, t8[2 * e + 1] * vs);
                        *(LAS unsigned short*)(L + OFF_VT + (ec * 8 + 2 * e) * TP + lane * 2) = (unsigned short)(pk2 & 0xffffu); *(LAS unsigned short*)(L + OFF_VT + (ec * 8 + 2 * e + 1) * TP + lane * 2) = (unsigned short)(pk2 >> 16); } } }
            const int it_s = w >> 1, jt0 = 2 * (w & 1);
            f32x4 s0 = (f32x4){0.f, 0.f, 0.f, 0.f}, s1 = s0;
#pragma unroll
            for (int ks = 0; ks < 8; ++ks) { const int co = (32 * ks + 8 * q4) * 2; if ((ks & 1) == 0) asm volatile("" ::: "memory");
                const bf16x8 qf = frag16(L + OFF_Q + (16 * it_s + r16) * QP + co), k0 = frag16(L + OFF_K + (16 * jt0 + r16) * QP + co), k1 = frag16(L + OFF_K + (16 * jt0 + 16 + r16) * QP + co);
                s0 = __builtin_amdgcn_mfma_f32_16x16x32_bf16(k0, qf, s0, 0, 0, 0); s1 = __builtin_amdgcn_mfma_f32_16x16x32_bf16(k1, qf, s1, 0, 0, 0); }
            __syncthreads();
            {   const int i_ = 16 * it_s + r16; const float gi = exp2f(lg2 * (float)i_);
                const int j0 = 16 * jt0 + 4 * q4, j1 = j0 + 16; float p0[4], p1[4];
#pragma unroll
                for (int r = 0; r < 4; ++r) { p0[r] = (j0 + r <= i_) ? s0[r] * gi : 0.f; p1[r] = (j1 + r <= i_) ? s1[r] * gi : 0.f; }
                *(LAS u32x2*)(L + OFF_P + i_ * TP + j0 * 2) = (u32x2){cvt_pk_bf16(p0[0], p0[1]), cvt_pk_bf16(p0[2], p0[3])};
                *(LAS u32x2*)(L + OFF_P + i_ * TP + j1 * 2) = (u32x2){cvt_pk_bf16(p1[0], p1[1]), cvt_pk_bf16(p1[2], p1[3])}; }
            __syncthreads();
            u32x4 pkn[4]; const bool has_next = ck + 1 < SLEN / 64;
            if (has_next) RET_LOAD_K(ck + 1, pkn);
            const LAS unsigned char* vtp = L + OFF_VT + (16 * w + r16) * TP + (8 * q4) * 2;
#pragma unroll
            for (int it = 0; it < 4; ++it) { const int i_ = 16 * it + r16; f32x4 a = (f32x4){0.f, 0.f, 0.f, 0.f};
                asm volatile("" ::: "memory");
#pragma unroll
                for (int m = 0; m < 8; ++m) {
                    const u32x4 t = (u32x4){cvt_pk_bf16(Racc[2 * m][0], Racc[2 * m][1]), cvt_pk_bf16(Racc[2 * m][2], Racc[2 * m][3]), cvt_pk_bf16(Racc[2 * m + 1][0], Racc[2 * m + 1][1]), cvt_pk_bf16(Racc[2 * m + 1][2], Racc[2 * m + 1][3])};
                    const LAS unsigned char* qp = L + OFF_Q + i_ * QP + (32 * m + 4 * q4) * 2; const u32x2 lo = *(const LAS u32x2*)qp, hi = *(const LAS u32x2*)(qp + 32);
                    const u32x4 tq = (u32x4){lo.x, lo.y, hi.x, hi.y}; a = __builtin_amdgcn_mfma_f32_16x16x32_bf16(__builtin_bit_cast(bf16x8, t), __builtin_bit_cast(bf16x8, tq), a, 0, 0, 0); }
                a = a * exp2f(lg2 * (float)(i_ + 1));
#pragma unroll
                for (int ks = 0; ks < 2; ++ks) a = __builtin_amdgcn_mfma_f32_16x16x32_bf16(frag16(vtp + 64 * ks), frag16(L + OFF_P + i_ * TP + (32 * ks + 8 * q4) * 2), a, 0, 0, 0);
                *(u32x2*)(O + (size_t)seq_row(b, dir, ck * 64 + i_) * 4096 + h * 512 + dvs * 128 + 16 * w + 4 * q4) = (u32x2){cvt_pk_bf16(a[0], a[1]), cvt_pk_bf16(a[2], a[3])}; }
            if (has_next) RET_STORE_K(pkn);
#pragma unroll
            for (int dt = 0; dt < 16; ++dt) { if ((dt & 1) == 0) asm volatile("" ::: "memory");
                f32x4 u = Racc[dt] * gamma;
#pragma unroll
                for (int ks = 0; ks < 2; ++ks) u = __builtin_amdgcn_mfma_f32_16x16x32_bf16(frag16(L + OFF_KT + (16 * dt + r16) * TP + (32 * ks + 8 * q4) * 2), frag16(vtp + 64 * ks), u, 0, 0, 0);
                Racc[dt] = u * g63; }
        }
#undef RET_LOAD_QV
#undef RET_LOAD_K
#undef RET_STORE_K
        __syncthreads();
    }
}
__device__ __forceinline__ void phase_ret_merge(KP P, const Ctx& c) {
    const bf16_t* OF = (const bf16_t*)(P->ws + L_OF); const bf16_t* OB = (const bf16_t*)(P->ws + L_OB); const bf16_t* GF = (const bf16_t*)(P->ws + L_GF); const bf16_t* GB = (const bf16_t*)(P->ws + L_GB);
    bf16_t* Z = (bf16_t*)(P->ws + L_RZ);
    u32x4 nf, nb, ngf, ngb;
#define RM_LOAD(k_) do { const size_t o_ = (size_t)(k_) * 512 + c.lane * 8; nf = *(const u32x4*)(OF + o_); nb = *(const u32x4*)(OB + o_); ngf = *(const u32x4*)(GF + o_); ngb = *(const u32x4*)(GB + o_); } while (0)
    if (c.gw < T * 8) RM_LOAD(c.gw);
    for (int k = c.gw; k < T * 8; k += c.ngw) { const size_t o = (size_t)k * 512 + c.lane * 8;
            float f[8], bk[8], gf[8], gb[8]; unpack8(nf, f); unpack8(nb, bk); unpack8(ngf, gf); unpack8(ngb, gb);
            if (k + c.ngw < T * 8) RM_LOAD(k + c.ngw);
            float sf = 0.f, sb = 0.f;
#pragma unroll
            for (int e = 0; e < 8; ++e) { sf += f[e]; sb += bk[e]; }
            const float mf = wave_sum(sf) * (1.0f / 512.0f), mb = wave_sum(sb) * (1.0f / 512.0f); float qf = 0.f, qb = 0.f;
#pragma unroll
            for (int e = 0; e < 8; ++e) { f[e] -= mf; bk[e] -= mb; qf += f[e] * f[e]; qb += bk[e] * bk[e]; }
            const float rf = rsqrtf(wave_sum(qf) * (1.0f / 512.0f) + LN_EPS), rb = rsqrtf(wave_sum(qb) * (1.0f / 512.0f) + LN_EPS);
            float z[8];
#pragma unroll
            for (int e = 0; e < 8; ++e) z[e] = gf[e] * (f[e] * rf) + gb[e] * (bk[e] * rb);
            *(u32x4*)(Z + o) = (u32x4){cvt_pk_bf16(z[0], z[1]), cvt_pk_bf16(z[2], z[3]), cvt_pk_bf16(z[4], z[5]), cvt_pk_bf16(z[6], z[7])}; }
#undef RM_LOAD
}

__device__ __forceinline__ Ctx make_ctx(LAS unsigned char* lds) {
    int t = threadIdx.x; asm volatile("" : "+v"(t));
    Ctx c; c.lds = lds; c.tid = t; c.lane = t & 63; c.wave = __builtin_amdgcn_readfirstlane(t >> 6);
    c.gw = blockIdx.x * 8 + c.wave; c.ngw = gridDim.x * 8; c.gtid = blockIdx.x * 512 + t; c.ngt = gridDim.x * 512; return c;
}
#define GRID_BAR() xcd_barrier(bar)
template <class Epi, class GT> __device__ __forceinline__ void run_gemm_m(LAS unsigned char* lds, const GT& g, int M, int N, const Epi& E) {
    pg8::StaticOrder S; S.init(M, N, (int)gridDim.x, (int)blockIdx.x); pg8::gemm_phase<Epi, GT>(lds, g, S, E);
}
template <class Epi, class GT> __device__ __forceinline__ void run_gemm(LAS unsigned char* lds, const GT& g, int N, const Epi& E, int pm0 = 0) {
    pg8::StaticOrder S; S.init(T, N, (int)gridDim.x, (int)blockIdx.x, pm0); pg8::gemm_phase<Epi, GT>(lds, g, S, E);
}
template <int LAYER, bool LAST> __device__ __forceinline__ void peer_phases(LAS unsigned char* lds, const XcdBarrier& bar) {
    phase_ln_mid(kp_fresh(), make_ctx(lds), LAYER, LAST ? NCTX : 0); GRID_BAR();
    PROBE_REP(2) { KP P = kp_fresh(); unsigned char* ws = P->ws; GPlain g{(const bf16_t*)(ws + WS_H2), (const bf16_t*)(ws + WS_WQ) + (size_t)LAYER * D * D, D, D, D}; EpiF32Plain E{(float*)(ws + WS_S), D}; run_gemm(lds, g, D, E, LAST ? 4 : 0);
        if (!LAST && _rep == 0) { constexpr int NR = 8 * 16384, SH = (NR + 2) / 3; const int lo = LAYER * SH, hi = (LAYER == 2) ? NR : (LAYER + 1) * SH;
            if ((int)gridDim.x == 256) { if ((int)blockIdx.x >= 32) peer_convert_rows(kp_fresh(), make_ctx(lds), lo, hi, (int)blockIdx.x - 32, 224); }
            else peer_convert_rows(kp_fresh(), make_ctx(lds), lo, hi, (int)blockIdx.x, (int)gridDim.x); }
        GRID_BAR(); }
    PROBE_REP(1) { phase_peer_select(kp_fresh(), make_ctx(lds), LAST ? NCTX : 0); GRID_BAR(); }
    PROBE_REP(0) { phase_peer_u(kp_fresh(), make_ctx(lds), LAYER, LAST ? NCTX : 0, _rep); GRID_BAR(); }
    phase_peer_c(kp_fresh(), make_ctx(lds), LAYER, LAST ? NCTX : 0); GRID_BAR();
    PROBE_REP(9) { phase_peer_v(kp_fresh(), make_ctx(lds), LAYER, LAST ? NCTX : 0, _rep); GRID_BAR(); }
    phase_peer_final<LAST>(kp_fresh(), make_ctx(lds), LAYER); GRID_BAR();
}
template <int LAYER, int JL> __device__ __forceinline__ void rg_phases(LAS unsigned char* lds, const XcdBarrier& bar) {
    PROBE_REP(6) { KP P = kp_fresh(); unsigned char* ws = P->ws; GPlain g{(const bf16_t*)(ws + WS_A0), (const bf16_t*)(ws + WS_RGIN) + (size_t)JL * 4096 * D, D, D, D}; EpiRgIn E{(bf16_t*)(ws + L_UG), (bf16_t*)(ws + L_UR)}; run_gemm(lds, g, 4096, E); GRID_BAR(); }
    PROBE_REP(7) { phase_rg_conv(kp_fresh(), make_ctx(lds), JL); GRID_BAR(); }
    { KP P = kp_fresh(); unsigned char* ws = P->ws; GGate g{(const bf16_t*)(ws + L_XC), (const bf16_t*)(ws + WS_RGGATE) + (size_t)JL * 8192 * 256, 256, D, 256};
      EpiRgGate E{(const bf16_t*)(ws + L_XC), (bf16_t*)(ws + L_LA), (bf16_t*)(ws + L_BB), P->in[I_RGGB] + (size_t)JL * 4 * D, (const float*)(ws + WS_SPT) + (size_t)JL * 2 * D}; PROBE_REP(11) { run_gemm(lds, g, 8192, E); GRID_BAR(); } }
    PROBE_REP(3) { phase_rg_scan1(kp_fresh(), make_ctx(lds)); GRID_BAR();
    phase_rg_scan2(kp_fresh(), make_ctx(lds)); GRID_BAR();
    phase_rg_scan3<0>(kp_fresh(), make_ctx(lds)); GRID_BAR();
    phase_rg_scan3<1>(kp_fresh(), make_ctx(lds)); GRID_BAR(); }
    { KP P = kp_fresh(); unsigned char* ws = P->ws; GPlain g{(const bf16_t*)(ws + L_YIN), (const bf16_t*)(ws + WS_RGOUT) + (size_t)JL * D * D, D, D, D}; EpiBf16Plain E{(bf16_t*)(ws + WS_S), D}; run_gemm(lds, g, D, E, LAYER == 3 ? 4 : 0); } GRID_BAR();
}
template <int LAYER> __device__ __forceinline__ void rw_phases(LAS unsigned char* lds, const XcdBarrier& bar) {
    PROBE_REP(7) { phase_rw_mix(kp_fresh(), make_ctx(lds), LAYER); GRID_BAR(); }
    PROBE_REP(6) { KP P = kp_fresh(); unsigned char* ws = P->ws; GRw1 g{(const bf16_t*)(ws + L_AALL), (const bf16_t*)(ws + WS_RW1), D, 6 * D, D}; EpiRw1 E{(bf16_t*)(ws + L_RKV), (bf16_t*)(ws + L_A2)}; run_gemm(lds, g, 6912, E); GRID_BAR(); }
    { KP P = kp_fresh(); unsigned char* ws = P->ws; GRw2 g{(const bf16_t*)(ws + L_A2), (const bf16_t*)(ws + WS_RW2), 256, 768, 256}; EpiRw2 E{(bf16_t*)(ws + L_W), (bf16_t*)(ws + L_AD), (bf16_t*)(ws + L_G), P->in[I_RWDEC0], P->in[I_RWICL0]}; PROBE_REP(12) { run_gemm(lds, g, 10240, E); GRID_BAR(); } }
    PROBE_REP(4) { phase_rw_scan(kp_fresh(), make_ctx(lds)); GRID_BAR(); }
    PROBE_REP(7) { phase_rw_finish(kp_fresh(), make_ctx(lds)); GRID_BAR(); }
    { KP P = kp_fresh(); unsigned char* ws = P->ws; GPlain g{(const bf16_t*)(ws + L_Z), (const bf16_t*)(ws + WS_RWO), D, D, D}; EpiBf16Plain E{(bf16_t*)(ws + WS_S), D}; run_gemm(lds, g, D, E); } GRID_BAR();
}
template <int LAYER> __device__ __forceinline__ void ret_phases(LAS unsigned char* lds, const XcdBarrier& bar) {
    { KP P = kp_fresh(); unsigned char* ws = P->ws; GPlain g{(const bf16_t*)(ws + WS_A0), (const bf16_t*)(ws + WS_RETIN), D, D, D};
      EpiRetIn E{(bf16_t*)(ws + L_RQ), (bf16_t*)(ws + L_RK), (bf16_t*)(ws + L_RV), (bf16_t*)(ws + L_GF), (bf16_t*)(ws + L_GB), (const float*)(ws + WS_CS)}; PROBE_REP(10) { run_gemm(lds, g, 16384, E); GRID_BAR(); } }
    PROBE_REP(5) { phase_ret_scan(kp_fresh(), make_ctx(lds)); GRID_BAR(); }
    PROBE_REP(7) { phase_ret_merge(kp_fresh(), make_ctx(lds)); GRID_BAR(); }
    { KP P = kp_fresh(); unsigned char* ws = P->ws; GPlain g{(const bf16_t*)(ws + L_RZ), (const bf16_t*)(ws + WS_RETOUT), 4096, 4096, 4096}; EpiBf16Plain E{(bf16_t*)(ws + WS_S), D}; run_gemm(lds, g, D, E); } GRID_BAR();
}

__global__ void __launch_bounds__(512, 2) hybrid_fwd(Params Pkernarg) {
    extern __shared__ __attribute__((aligned(16))) unsigned char lds_raw[];
    LAS unsigned char* lds = (LAS unsigned char*)lds_raw;
    volatile LAS unsigned* MISC = (volatile LAS unsigned*)(lds + MISC_OFF);
    if (threadIdx.x < 64) MISC[threadIdx.x] = 0u;
    __syncthreads();
    XcdBarrier bar = xcd_barrier_post((unsigned*)(kp_fresh()->ws + WS_CTL) + 4096, MISC + 8);

    if ((PROBE >> 13) & 1) { for (int i = 0; i < 64; ++i) GRID_BAR(); }
    PROBE_REP(8) { phase_prologue(kp_fresh(), make_ctx(lds)); GRID_BAR(); }
    { KP P = kp_fresh(); unsigned char* ws = P->ws; GFold g{(const bf16_t*)(ws + WS_KEYS), (const bf16_t*)(ws + WS_WQN), 256, 256, D}; EpiBf16Plain E{(bf16_t*)(ws + WS_WQ), D}; run_gemm_m(lds, g, 4 * D, D, E); }
    phase_modfin(kp_fresh(), make_ctx(lds)); GRID_BAR();
    phase_xinit(kp_fresh(), make_ctx(lds)); GRID_BAR();
    rg_phases<0, 0>(lds, bar);  peer_phases<0, false>(lds, bar);
    rw_phases<1>(lds, bar);     peer_phases<1, false>(lds, bar);
    ret_phases<2>(lds, bar);    peer_phases<2, false>(lds, bar);
    rg_phases<3, 1>(lds, bar);  peer_phases<3, true>(lds, bar);
}

extern "C" void kernel_launch(void* const* d_in, const int* in_sizes, int n_in, void* d_out, int out_size, void* d_ws, size_t ws_size, hipStream_t stream) {
    static int grid = 0;
    if (!grid) {
        if (n_in != 37 || ws_size < WS_END) { fprintf(stderr, "kernel_launch: unexpected problem (n_in %d, ws %zu)\n", n_in, ws_size); grid = -1; return; }
        int dev = 0, cus = 0, per_cu = 0;
        if (hipGetDevice(&dev) != hipSuccess || hipDeviceGetAttribute(&cus, hipDeviceAttributeMultiprocessorCount, dev) != hipSuccess) { grid = -1; return; }
        if (hipFuncSetAttribute((const void*)hybrid_fwd, hipFuncAttributeMaxDynamicSharedMemorySize, LDS_BYTES) != hipSuccess) { fprintf(stderr, "kernel_launch: hipFuncSetAttribute failed\n"); grid = -1; return; }
        if (hipOccupancyMaxActiveBlocksPerMultiprocessor(&per_cu, (const void*)hybrid_fwd, 512, LDS_BYTES) != hipSuccess || per_cu < 1) { fprintf(stderr, "kernel_launch: occupancy query says %d\n", per_cu); grid = -1; return; }
        grid = cus;
    }
    if (grid <= 0) return;
    hipMemsetAsync((char*)d_ws + WS_CTL, 0, CTL_BYTES, stream);
    Params p; memset(&p, 0, sizeof(p));
    for (int i = 0; i < 37; ++i) p.in[i] = (const float*)d_in[i];
    p.out = (float*)d_out; p.ws = (unsigned char*)d_ws;
    hipLaunchKernelGGL(hybrid_fwd, dim3(grid), dim3(512), LDS_BYTES, stream, p);
}
```

```cpp
#include <hip/hip_runtime.h>
#include <cstdio>
#include <cstring>

#define LAS __attribute__((address_space(3)))
typedef unsigned short bf16_t;
typedef short bf16x8 __attribute__((ext_vector_type(8)));
typedef float f32x4 __attribute__((ext_vector_type(4)));
typedef float f32x2 __attribute__((ext_vector_type(2)));
typedef unsigned u32x4 __attribute__((ext_vector_type(4)));
typedef unsigned u32x2 __attribute__((ext_vector_type(2)));
typedef __bf16 bf16v2 __attribute__((ext_vector_type(2)));

#ifndef DBG_ZERO
#define DBG_ZERO 0
#endif
#ifndef PROBE
#define PROBE 0
#endif
#define PROBE_REP(bit) for (int _rep = 0; _rep < (((PROBE) >> (bit)) & 1) + 1; ++_rep)
constexpr int D = 2048, NBATCH = 4, SEQ = 4096, CTX = 256;
constexpr int NCTX = NBATCH * CTX, NLAT = NBATCH * SEQ, T = NCTX + NLAT;
constexpr int SLEN = CTX + SEQ;
constexpr float ALPHA = 1.681792830507429f;
constexpr float LN_EPS = 1e-5f;
constexpr size_t TD = (size_t)T * D;

constexpr size_t MiB = 1u << 20;
constexpr size_t WS_CTL = 0, CTL_BYTES = 1 * MiB;
constexpr size_t WS_MODP = 2 * MiB;
constexpr size_t WS_MOD = 10 * MiB;
constexpr size_t WS_CS = 11 * MiB;
constexpr size_t WS_SPT = 15 * MiB + 512 * 1024;
constexpr size_t WS_CA = 16 * MiB, WS_CH = 21 * MiB, WS_CIN = 26 * MiB;
constexpr size_t WS_WQ = 32 * MiB;
constexpr size_t WS_KEYS = 64 * MiB;
constexpr size_t WS_RGIN = 68 * MiB;
constexpr size_t WS_RGGATE = 100 * MiB;
constexpr size_t WS_RGOUT = 108 * MiB;
constexpr size_t WS_RW1 = 124 * MiB;
constexpr size_t WS_RW2 = 152 * MiB;
constexpr size_t WS_RWO = 160 * MiB;
constexpr size_t WS_RETIN = 168 * MiB;
constexpr size_t WS_RETOUT = 232 * MiB;
constexpr size_t WS_PU = 256 * MiB;
constexpr size_t WS_PV = 384 * MiB;
constexpr size_t WS_PSC = 512 * MiB;
constexpr size_t WS_X = 768 * MiB;
constexpr size_t WS_A0 = 904 * MiB;
constexpr size_t WS_H2 = 972 * MiB;
constexpr size_t WS_Q = 1040 * MiB;
constexpr size_t WS_WQN = 1040 * MiB;
constexpr size_t WS_S = 1108 * MiB;
constexpr size_t WS_L = 1244 * MiB;
constexpr size_t WS_SELW = 1893 * MiB;
constexpr size_t WS_END = 1902 * MiB;
constexpr size_t P_SE16 = WS_L + 288 * MiB;
constexpr size_t P_PART = WS_L, P_Y = WS_L + 136 * MiB, P_C = WS_L + 272 * MiB;
constexpr int CW_PQ = 16384;
constexpr size_t L_UG = WS_L, L_UR = WS_L + 68 * MiB, L_XC = WS_L + 136 * MiB, L_LA = WS_L + 204 * MiB, L_BB = WS_L + 340 * MiB, L_YIN = WS_L + 476 * MiB;
constexpr size_t L_AALL = WS_L;
constexpr size_t L_W = WS_L, L_AD = WS_L + 136 * MiB, L_G = WS_L + 272 * MiB;
constexpr size_t L_RKV = WS_L + 408 * MiB;
constexpr size_t L_A2 = WS_L + 612 * MiB;
constexpr size_t L_Y0 = WS_H2, L_Y1 = WS_H2 + 136 * MiB;
constexpr size_t L_Z = WS_A0;
constexpr size_t L_RQ = WS_L, L_RK = WS_L + 68 * MiB, L_RV = WS_L + 136 * MiB, L_GF = WS_L + 272 * MiB, L_GB = WS_L + 408 * MiB;
constexpr size_t L_OF = WS_H2, L_OB = WS_H2 + 136 * MiB;
constexpr size_t L_RZ = WS_L;

__device__ __forceinline__ float bf2f(unsigned b) { return __uint_as_float(b << 16); }
__device__ __forceinline__ unsigned cvt_pk_bf16(float lo, float hi) { bf16v2 t; t.x = (__bf16)lo; t.y = (__bf16)hi; return __builtin_bit_cast(unsigned, t); }
__device__ __forceinline__ float bflo(unsigned u) { return __uint_as_float(u << 16); }
__device__ __forceinline__ float bfhi(unsigned u) { return __uint_as_float(u & 0xffff0000u); }
__device__ __forceinline__ float sigmoidf_(float x) { return 1.0f / (1.0f + __expf(-x)); }
__device__ __forceinline__ float siluf_(float x) { return x / (1.0f + __expf(-x)); }
__device__ __forceinline__ float tanhf_(float x) { return 1.0f - 2.0f / (1.0f + __expf(2.0f * x)); }
__device__ __forceinline__ float gelu_tanh(float x) { const float z = 1.5957691216057308f * (x + 0.044715f * x * x * x); return x / (1.0f + __expf(-z)); }
__device__ __forceinline__ void unpack8(const u32x4 u, float (&f)[8]) { f[0] = bflo(u.x); f[1] = bfhi(u.x); f[2] = bflo(u.y); f[3] = bfhi(u.y); f[4] = bflo(u.z); f[5] = bfhi(u.z); f[6] = bflo(u.w); f[7] = bfhi(u.w); }
template <int CTRL> __device__ __forceinline__ float dpp_mov(float v) { const int x = __builtin_bit_cast(int, v); return __builtin_bit_cast(float, __builtin_amdgcn_update_dpp(x, x, CTRL, 0xF, 0xF, false)); }
__device__ __forceinline__ float rl_f(float v, int lane) { return __builtin_bit_cast(float, __builtin_amdgcn_readlane(__builtin_bit_cast(int, v), lane)); }
__device__ __forceinline__ float sum8(float v) { v += dpp_mov<0xB1>(v); v += dpp_mov<0x4E>(v); v += dpp_mov<0x141>(v); return v; }
__device__ __forceinline__ float sum16(float v) { v = sum8(v); v += dpp_mov<0x140>(v); return v; }
__device__ __forceinline__ float fma_s(float a, float b, float c) { float d; asm("v_fma_f32 %0, %1, %2, %3" : "=v"(d) : "v"(a), "v"(b), "v"(c)); return d; }
__device__ __forceinline__ float mul_s(float a, float b) { float d; asm("v_mul_f32 %0, %1, %2" : "=v"(d) : "v"(a), "v"(b)); return d; }
__device__ __forceinline__ void sum8_pair(float& a, float& b) {
    asm volatile("s_nop 1\n\t"
        "v_add_f32_dpp %0, %0, %0 quad_perm:[1,0,3,2] row_mask:0xf bank_mask:0xf\n\tv_add_f32_dpp %1, %1, %1 quad_perm:[1,0,3,2] row_mask:0xf bank_mask:0xf\n\ts_nop 0\n\t"
        "v_add_f32_dpp %0, %0, %0 quad_perm:[2,3,0,1] row_mask:0xf bank_mask:0xf\n\tv_add_f32_dpp %1, %1, %1 quad_perm:[2,3,0,1] row_mask:0xf bank_mask:0xf\n\ts_nop 0\n\t"
        "v_add_f32_dpp %0, %0, %0 row_half_mirror row_mask:0xf bank_mask:0xf\n\tv_add_f32_dpp %1, %1, %1 row_half_mirror row_mask:0xf bank_mask:0xf"
        : "+v"(a), "+v"(b));
}
__device__ __forceinline__ void sum16_pair(float& a, float& b) {
    asm volatile("s_nop 1\n\t"
        "v_add_f32_dpp %0, %0, %0 quad_perm:[1,0,3,2] row_mask:0xf bank_mask:0xf\n\tv_add_f32_dpp %1, %1, %1 quad_perm:[1,0,3,2] row_mask:0xf bank_mask:0xf\n\ts_nop 0\n\t"
        "v_add_f32_dpp %0, %0, %0 quad_perm:[2,3,0,1] row_mask:0xf bank_mask:0xf\n\tv_add_f32_dpp %1, %1, %1 quad_perm:[2,3,0,1] row_mask:0xf bank_mask:0xf\n\ts_nop 0\n\t"
        "v_add_f32_dpp %0, %0, %0 row_half_mirror row_mask:0xf bank_mask:0xf\n\tv_add_f32_dpp %1, %1, %1 row_half_mirror row_mask:0xf bank_mask:0xf\n\ts_nop 0\n\t"
        "v_add_f32_dpp %0, %0, %0 row_mirror row_mask:0xf bank_mask:0xf\n\tv_add_f32_dpp %1, %1, %1 row_mirror row_mask:0xf bank_mask:0xf"
        : "+v"(a), "+v"(b));
}
__device__ __forceinline__ void sum16_quad(float& a, float& b, float& c, float& d) {
    asm volatile("s_nop 1\n\t"
        "v_add_f32_dpp %0, %0, %0 quad_perm:[1,0,3,2] row_mask:0xf bank_mask:0xf\n\tv_add_f32_dpp %1, %1, %1 quad_perm:[1,0,3,2] row_mask:0xf bank_mask:0xf\n\t"
        "v_add_f32_dpp %2, %2, %2 quad_perm:[1,0,3,2] row_mask:0xf bank_mask:0xf\n\tv_add_f32_dpp %3, %3, %3 quad_perm:[1,0,3,2] row_mask:0xf bank_mask:0xf\n\t"
        "v_add_f32_dpp %0, %0, %0 quad_perm:[2,3,0,1] row_mask:0xf bank_mask:0xf\n\tv_add_f32_dpp %1, %1, %1 quad_perm:[2,3,0,1] row_mask:0xf bank_mask:0xf\n\t"
        "v_add_f32_dpp %2, %2, %2 quad_perm:[2,3,0,1] row_mask:0xf bank_mask:0xf\n\tv_add_f32_dpp %3, %3, %3 quad_perm:[2,3,0,1] row_mask:0xf bank_mask:0xf\n\t"
        "v_add_f32_dpp %0, %0, %0 row_half_mirror row_mask:0xf bank_mask:0xf\n\tv_add_f32_dpp %1, %1, %1 row_half_mirror row_mask:0xf bank_mask:0xf\n\t"
        "v_add_f32_dpp %2, %2, %2 row_half_mirror row_mask:0xf bank_mask:0xf\n\tv_add_f32_dpp %3, %3, %3 row_half_mirror row_mask:0xf bank_mask:0xf\n\t"
        "v_add_f32_dpp %0, %0, %0 row_mirror row_mask:0xf bank_mask:0xf\n\tv_add_f32_dpp %1, %1, %1 row_mirror row_mask:0xf bank_mask:0xf\n\t"
        "v_add_f32_dpp %2, %2, %2 row_mirror row_mask:0xf bank_mask:0xf\n\tv_add_f32_dpp %3, %3, %3 row_mirror row_mask:0xf bank_mask:0xf"
        : "+v"(a), "+v"(b), "+v"(c), "+v"(d));
}
__device__ __forceinline__ void sum8_quad(float& a, float& b, float& c, float& d) {
    asm volatile("s_nop 1\n\t"
        "v_add_f32_dpp %0, %0, %0 quad_perm:[1,0,3,2] row_mask:0xf bank_mask:0xf\n\tv_add_f32_dpp %1, %1, %1 quad_perm:[1,0,3,2] row_mask:0xf bank_mask:0xf\n\t"
        "v_add_f32_dpp %2, %2, %2 quad_perm:[1,0,3,2] row_mask:0xf bank_mask:0xf\n\tv_add_f32_dpp %3, %3, %3 quad_perm:[1,0,3,2] row_mask:0xf bank_mask:0xf\n\t"
        "v_add_f32_dpp %0, %0, %0 quad_perm:[2,3,0,1] row_mask:0xf bank_mask:0xf\n\tv_add_f32_dpp %1, %1, %1 quad_perm:[2,3,0,1] row_mask:0xf bank_mask:0xf\n\t"
        "v_add_f32_dpp %2, %2, %2 quad_perm:[2,3,0,1] row_mask:0xf bank_mask:0xf\n\tv_add_f32_dpp %3, %3, %3 quad_perm:[2,3,0,1] row_mask:0xf bank_mask:0xf\n\t"
        "v_add_f32_dpp %0, %0, %0 row_half_mirror row_mask:0xf bank_mask:0xf\n\tv_add_f32_dpp %1, %1, %1 row_half_mirror row_mask:0xf bank_mask:0xf\n\t"
        "v_add_f32_dpp %2, %2, %2 row_half_mirror row_mask:0xf bank_mask:0xf\n\tv_add_f32_dpp %3, %3, %3 row_half_mirror row_mask:0xf bank_mask:0xf"
        : "+v"(a), "+v"(b), "+v"(c), "+v"(d));
}
__device__ __forceinline__ float wave_sum(float v) { v = sum8(v); v += dpp_mov<0x140>(v); return (rl_f(v, 0) + rl_f(v, 16)) + (rl_f(v, 32) + rl_f(v, 48)); }
__device__ __forceinline__ float wave_max(float v) {
    v = fmaxf(v, dpp_mov<0xB1>(v)); v = fmaxf(v, dpp_mov<0x4E>(v)); v = fmaxf(v, dpp_mov<0x141>(v)); v = fmaxf(v, dpp_mov<0x140>(v));
    return fmaxf(fmaxf(rl_f(v, 0), rl_f(v, 16)), fmaxf(rl_f(v, 32), rl_f(v, 48)));
}
__device__ __forceinline__ int row_vec(int row) { return row < NCTX ? 4 : ((row - NCTX) >> 12); }
__device__ __forceinline__ int panel_vec(int pm) { return pm < 4 ? 4 : ((pm - 4) >> 4); }
__device__ __forceinline__ int seq_row(int b, int dir, int s) {
    if (s < CTX) { const int t = dir ? (CTX - 1 - s) : s; return b * CTX + t; }
    int t = s - CTX; if (dir) t = SEQ - 1 - t; return NCTX + b * SEQ + t;
}
__device__ __forceinline__ int row_pos(int row) { return row < NCTX ? (row & (CTX - 1)) : CTX + ((row - NCTX) & (SEQ - 1)); }

namespace pg8 {
constexpr int BM = 256, BK = 64, HALF = 128, HTB = HALF * BK * 2, STAGE_BYTES = 8 * HTB, NXCD = 8, WGM = 8;
__host__ __device__ __forceinline__ int lds_byte(int r, int c) { const int st = (r >> 4) * 2 + (c >> 5), rr = r & 15, cc = c & 31, ob = rr * 64 + cc * 2; return st * 1024 + (ob ^ (((ob >> 9) & 1) << 5)); }
__host__ __device__ __forceinline__ void stage_rc(int b, int& R, int& C) { const int st = b / 1024, sb = b % 1024, swz = sb ^ (((sb >> 9) & 1) << 5); R = (st >> 1) * 16 + swz / 64; C = (st & 1) * 32 + (swz % 64) / 2; }
__host__ __device__ __forceinline__ int perm32(int rho) { const int n = rho >> 4, i = rho & 15; return 8 * (i >> 2) + 4 * n + (i & 3); }
struct Unit { int pm, pn; };
struct StaticOrder {
    int nM, nN, nwg, G, c, pm0;
    __device__ void init(int M, int N, int G_, int c_, int pm0_ = 0) { pm0 = pm0_; nM = M / BM - pm0_; nN = N / BM; nwg = nM * nN; G = G_; c = c_; }
    __device__ bool next(int i, Unit& u) const {
        const long L = (long)i * G + c; if (L >= nwg) return false;
        int wgid = (int)L; { const int q = nwg / NXCD, r = nwg % NXCD, xcd = wgid % NXCD, off = wgid / NXCD; wgid = (xcd < r ? xcd * (q + 1) : r * (q + 1) + (xcd - r) * q) + off; }
        const int nig = WGM * nN, gid = wgid / nig, fm = gid * WGM, gsz = (nM - fm) < WGM ? (nM - fm) : WGM;
        u.pm = pm0 + fm + ((wgid % nig) % gsz); u.pn = (wgid % nig) / gsz; return true;
    }
};
template <class Epi, class GT>
__device__ __forceinline__ void gemm_phase(LAS unsigned char* lds, const GT g, const StaticOrder& S, const Epi& E) {
    int tid_ = threadIdx.x; asm volatile("" : "+v"(tid_));
    const int tid = tid_, wid = __builtin_amdgcn_readfirstlane(tid >> 6), lane = tid & 63, wr = wid >> 2, wc = wid & 3, fr = lane & 15, fq = lane >> 4;
    const int K = g.K, nt = K / BK;
    unsigned voffA[2], voffB[2];
#pragma unroll
    for (int i = 0; i < 2; ++i) { int R, C; stage_rc(tid * 16 + i * 8192, R, C); const int Rb = Epi::PERM ? ((R & ~31) + perm32(R & 31)) : R;
        voffA[i] = (unsigned)(R * g.lda + C) * 2u; voffB[i] = (unsigned)(Rb * g.ldb + C) * 2u; }
    const size_t kstep = (size_t)(BK * 2);
    const size_t hstepA = (size_t)HALF * g.lda * 2, hstepB = (size_t)HALF * g.ldb * 2;
    const unsigned ldsw = (unsigned)wid * 1024u;
    const int aoff = lds_byte(wr * 64 + fr, fq * 8), boff = lds_byte(wc * 32 + fr, fq * 8);
#define PG8_SA(b, h) (((b) * 2 + (h)) * HTB)
#define PG8_SB(b, h) ((4 + (b) * 2 + (h)) * HTB)
#define PG8_STAGE(bufoff, gbase, voff) do { _Pragma("unroll") for (int _i = 0; _i < 2; ++_i) \
        __builtin_amdgcn_global_load_lds((const unsigned*)((const char*)(gbase) + (voff)[_i]), (LAS unsigned*)(lds + (bufoff) + ldsw + _i * 8192), 16, 0, 0); } while (0)
#define PG8_LDA(dst, b, h) do { _Pragma("unroll") for (int m = 0; m < 4; ++m) _Pragma("unroll") for (int k = 0; k < 2; ++k) dst[m][k] = *(const LAS bf16x8*)(lds + PG8_SA(b, h) + aoff + m * 2048 + k * 1024); } while (0)
#define PG8_LDB(dst, b, h) do { _Pragma("unroll") for (int n = 0; n < 2; ++n) _Pragma("unroll") for (int k = 0; k < 2; ++k) dst[n][k] = *(const LAS bf16x8*)(lds + PG8_SB(b, h) + boff + n * 2048 + k * 1024); } while (0)
#define PG8_MMA(ai, bj, At, Bt) do { __builtin_amdgcn_s_setprio(1); _Pragma("unroll") for (int m = 0; m < 4; ++m) _Pragma("unroll") for (int n = 0; n < 2; ++n) _Pragma("unroll") for (int k = 0; k < 2; ++k) \
        acc[ai][bj][m][n] = __builtin_amdgcn_mfma_f32_16x16x32_bf16(Bt[n][k], At[m][k], acc[ai][bj][m][n], 0, 0, 0); __builtin_amdgcn_s_setprio(0); } while (0)
#define PG8_WAIT_V(n) asm volatile("s_waitcnt vmcnt(" #n ")" ::: "memory")
#define PG8_WAIT_L(n) asm volatile("s_waitcnt lgkmcnt(" #n ")" ::: "memory")
#define PG8_BAR __builtin_amdgcn_s_barrier()
#define PG8_SCHED __builtin_amdgcn_sched_barrier(0)
    Unit cur, nxt; int ui = 0;
    if (!S.next(0, cur)) return;
    f32x4 acc[2][2][4][2];
#pragma unroll
    for (int a = 0; a < 2; ++a)
#pragma unroll
        for (int b = 0; b < 2; ++b)
#pragma unroll
            for (int m = 0; m < 4; ++m)
#pragma unroll
                for (int n = 0; n < 2; ++n) acc[a][b][m][n] = (f32x4){0.f, 0.f, 0.f, 0.f};
    bf16x8 At[4][2], B0[2][2], B1[2][2];
    const char* cA = g.a_ptr(cur); const char* cB = g.b_ptr(cur);
    PG8_STAGE(PG8_SB(0, 0), cB, voffB); PG8_STAGE(PG8_SA(0, 0), cA, voffA); PG8_STAGE(PG8_SB(0, 1), cB + hstepB, voffB); PG8_STAGE(PG8_SA(0, 1), cA + hstepA, voffA);
    if (wr == 1) PG8_BAR;
    PG8_WAIT_V(4); PG8_BAR;
    PG8_STAGE(PG8_SB(1, 0), cB + kstep, voffB); PG8_STAGE(PG8_SA(1, 0), cA + kstep, voffA); PG8_STAGE(PG8_SB(1, 1), cB + hstepB + kstep, voffB);
    PG8_WAIT_V(6); PG8_BAR;
    for (;;) {
        const bool has_next = S.next(ui + 1, nxt);
        const char* nA = has_next ? g.a_ptr(nxt) : cA; const char* nB = has_next ? g.b_ptr(nxt) : cB;
        for (int t = 0; t < nt; t += 2) {
            const bool last = (t == nt - 2);
            const char* a1 = cA + (size_t)(t + 1) * kstep;
            const char* a2 = last ? nA : cA + (size_t)(t + 2) * kstep; const char* b2 = last ? nB : cB + (size_t)(t + 2) * kstep;
            const char* a3 = a2 + kstep; const char* b3 = b2 + kstep;
            PG8_LDB(B0, 0, 0); PG8_SCHED; PG8_LDA(At, 0, 0); PG8_STAGE(PG8_SA(1, 1), a1 + hstepA, voffA);
            PG8_WAIT_L(8); PG8_BAR; PG8_WAIT_L(0); PG8_MMA(0, 0, At, B0); PG8_BAR; PG8_SCHED;
            PG8_LDB(B1, 0, 1); PG8_STAGE(PG8_SB(0, 0), b2, voffB);
            PG8_BAR; PG8_WAIT_L(0); PG8_MMA(0, 1, At, B1); PG8_BAR;
            PG8_LDA(At, 0, 1); PG8_STAGE(PG8_SA(0, 0), a2, voffA);
            PG8_BAR; PG8_WAIT_L(0); PG8_MMA(1, 0, At, B0); PG8_BAR; PG8_SCHED;
            PG8_STAGE(PG8_SB(0, 1), b2 + hstepB, voffB);
            PG8_WAIT_V(6); PG8_BAR; PG8_MMA(1, 1, At, B1); PG8_BAR;
            PG8_LDB(B0, 1, 0); PG8_SCHED; PG8_LDA(At, 1, 0); PG8_STAGE(PG8_SA(0, 1), a2 + hstepA, voffA);
            PG8_WAIT_L(8); PG8_BAR; PG8_WAIT_L(0); PG8_MMA(0, 0, At, B0); PG8_BAR; PG8_SCHED;
            PG8_LDB(B1, 1, 1); PG8_STAGE(PG8_SB(1, 0), b3, voffB);
            PG8_BAR; PG8_WAIT_L(0); PG8_MMA(0, 1, At, B1); PG8_BAR;
            PG8_LDA(At, 1, 1); PG8_STAGE(PG8_SA(1, 0), a3, voffA);
            PG8_BAR; PG8_WAIT_L(0); PG8_MMA(1, 0, At, B0); PG8_BAR; PG8_SCHED;
            PG8_STAGE(PG8_SB(1, 1), b3 + hstepB, voffB);
            PG8_WAIT_V(6); PG8_BAR; PG8_MMA(1, 1, At, B1); PG8_BAR;
        }
        E(acc, cur, wr, wc, fr, fq);
        if (!has_next) break;
#pragma unroll
        for (int a = 0; a < 2; ++a)
#pragma unroll
            for (int b = 0; b < 2; ++b)
#pragma unroll
                for (int m = 0; m < 4; ++m)
#pragma unroll
                    for (int n = 0; n < 2; ++n) acc[a][b][m][n] = (f32x4){0.f, 0.f, 0.f, 0.f};
        cur = nxt; cA = nA; cB = nB; ++ui;
    }
    PG8_WAIT_V(0);
    if (wr == 0) PG8_BAR;
    PG8_BAR;
#undef PG8_SA
#undef PG8_SB
#undef PG8_STAGE
#undef PG8_LDA
#undef PG8_LDB
#undef PG8_MMA
#undef PG8_WAIT_V
#undef PG8_WAIT_L
#undef PG8_BAR
#undef PG8_SCHED
}
}
using pg8::Unit;
typedef const f32x4 (&AccRef)[2][2][4][2];

#define XB_TMO      128
#define XB_XCNT(j)  (256  + 64 * (j))
#define XB_XSUB(j)  (1280 + 64 * (j))
#define XB_XGEN(j)  (2304 + 64 * (j))
#define XB_TOP      3328
#define XB_TOPGEN   3392
#define XCD_BAR_WORDS 3456
#define XB_SPIN_CAP (1u << 18)
__device__ __forceinline__ unsigned xb_ld(unsigned* p)              { return __hip_atomic_load(p, __ATOMIC_RELAXED, __HIP_MEMORY_SCOPE_AGENT); }
__device__ __forceinline__ unsigned xb_add(unsigned* p, unsigned v) { return __hip_atomic_fetch_add(p, v, __ATOMIC_RELAXED, __HIP_MEMORY_SCOPE_AGENT); }
__device__ __forceinline__ unsigned xb_xcc_id() { return (unsigned)__builtin_amdgcn_s_getreg((3 << 11) | 20) & 0xFu; }
#define XB_SPIN(cond, bar) do { unsigned _sp = 0; while (cond) { __builtin_amdgcn_s_sleep(1); \
    if ((++_sp & 255u) == 0u) { if (xb_ld(&(bar)[XB_TMO])) break; if (_sp > XB_SPIN_CAP) { atomicAdd(&(bar)[XB_TMO], 1u); break; } } } } while (0)
struct XcdBarrier { unsigned* bar; unsigned x; volatile LAS unsigned* st; };
__device__ __forceinline__ XcdBarrier xcd_barrier_post(unsigned* bar, volatile LAS unsigned* st) {
    XcdBarrier b; b.bar = bar; b.x = xb_xcc_id(); b.st = st;
    if (threadIdx.x == 0) (void)xb_add(&bar[XB_XCNT(b.x)], 1u);
    return b;
}
__device__ __forceinline__ void xcd_barrier_complete(unsigned* bar, unsigned x, unsigned& nloc, unsigned& nx) {
    const unsigned G = gridDim.x * gridDim.y * gridDim.z;
    unsigned sum, cnt, mine, sp = 0u;
    for (;;) {
        sum = 0u; cnt = 0u; mine = 0u;
#pragma unroll
        for (unsigned j = 0; j < 16; ++j) { const unsigned c = xb_ld(&bar[XB_XCNT(j)]); sum += c; cnt += (c > 0u) ? 1u : 0u; mine = (j == x) ? c : mine; }
        if (sum == G) break;
        __builtin_amdgcn_s_sleep(1);
        if ((++sp & 255u) == 0u) { if (xb_ld(&bar[XB_TMO])) break; if (sp > XB_SPIN_CAP) { atomicAdd(&bar[XB_TMO], 1u); break; } }
    }
    nloc = mine > 0u ? mine : 1u; nx = cnt > 0u ? cnt : 1u;
}
__device__ __forceinline__ void xcd_barrier(const XcdBarrier& b) {
    asm volatile("s_waitcnt vmcnt(0)" ::: "memory");
    __syncthreads();
    if (threadIdx.x == 0) {
        unsigned* bar = b.bar;
        __builtin_amdgcn_s_waitcnt(0);
        unsigned nloc = b.st[0], nx = b.st[1];
        if (nloc == 0u) { xcd_barrier_complete(bar, b.x, nloc, nx); b.st[0] = nloc; b.st[1] = nx; }
        const unsigned old = xb_add(&bar[XB_XSUB(b.x)], 1u);
        const unsigned gen = old / nloc;
        if (old + 1u == (gen + 1u) * nloc) {
            __builtin_amdgcn_fence(__ATOMIC_RELEASE, "agent");
            asm volatile("s_waitcnt vmcnt(0)" ::: "memory");
            const unsigned og = xb_add(&bar[XB_TOP], 1u);
            const unsigned tg = og / nx;
            if (og + 1u == (tg + 1u) * nx) xb_add(&bar[XB_TOPGEN], 1u);
            else XB_SPIN(xb_ld(&bar[XB_TOPGEN]) == tg, bar);
            __builtin_amdgcn_fence(__ATOMIC_ACQUIRE, "agent");
            xb_add(&bar[XB_XGEN(b.x)], 1u);
            asm volatile("s_waitcnt vmcnt(0)" ::: "memory");
        } else {
            XB_SPIN(xb_ld(&bar[XB_XGEN(b.x)]) == gen, bar);
            __builtin_amdgcn_fence(__ATOMIC_ACQUIRE, "agent");
            asm volatile("s_waitcnt vmcnt(0)" ::: "memory");
        }
    }
    __syncthreads();
}

struct Params { const float* in[37]; float* out; unsigned char* ws; };
typedef const __attribute__((address_space(4))) Params* KP;
__device__ __forceinline__ KP kp_fresh() { KP p = (KP)__builtin_amdgcn_kernarg_segment_ptr(); asm volatile("" : "+s"(p)); return p; }
enum { I_X = 0, I_C, I_CTX, I_CCTX, I_ADAW, I_ADAB, I_LNG, I_LNB, I_PWQ, I_PKEYS, I_PU, I_PV, I_RGWIN, I_RGCW, I_RGCB, I_RGGW, I_RGGB, I_RGLAM, I_RGWOUT,
       I_RWMU, I_RWRKV, I_RWWO, I_RWDEC0, I_RWDEC1, I_RWDEC2, I_RWICL0, I_RWICL1, I_RWICL2, I_RWG1, I_RWG2, I_RWKK, I_RWKA, I_RWRK, I_RWGNG, I_RWGNB, I_RETWIN, I_RETWOUT };
constexpr int LDS_BYTES = 147456;
constexpr int MISC_OFF = 147200;

__device__ __forceinline__ const float* modp(KP P, int layer, int v, int slot) { return (const float*)(P->ws + WS_MOD) + ((size_t)(layer * 5 + v) * 6 + slot) * D; }

struct GPlain { const bf16_t* A; const bf16_t* Bt; int K, lda, ldb;
    __device__ __forceinline__ const char* a_ptr(const Unit& u) const { return (const char*)(A + (size_t)u.pm * 256 * lda); }
    __device__ __forceinline__ const char* b_ptr(const Unit& u) const { return (const char*)(Bt + (size_t)u.pn * 256 * ldb); } };
struct GGate { const bf16_t* A; const bf16_t* Bt; int K, lda, ldb;
    __device__ __forceinline__ const char* a_ptr(const Unit& u) const { return (const char*)(A + (size_t)u.pm * 256 * lda + ((u.pn >> 1) & 7) * 256); }
    __device__ __forceinline__ const char* b_ptr(const Unit& u) const { return (const char*)(Bt + (size_t)u.pn * 256 * ldb); } };
struct GScore { const bf16_t* A; const bf16_t* Bt; int K, lda, ldb;
    __device__ __forceinline__ const char* a_ptr(const Unit& u) const { return (const char*)(A + (size_t)u.pm * 256 * lda + u.pn * 256); }
    __device__ __forceinline__ const char* b_ptr(const Unit& u) const { return (const char*)(Bt + (size_t)u.pn * 256 * ldb); } };
struct GFold { const bf16_t* A; const bf16_t* Bt; int K, lda, ldb;
    __device__ __forceinline__ const char* a_ptr(const Unit& u) const { return (const char*)(A + (size_t)u.pm * 256 * lda); }
    __device__ __forceinline__ const char* b_ptr(const Unit& u) const { return (const char*)(Bt + (size_t)(u.pm >> 3) * D * D + (size_t)u.pn * 256 * ldb + (u.pm & 7) * 256); } };
struct GRw1 { const bf16_t* A; const bf16_t* Bt; int K, lda, ldb;
    __device__ __forceinline__ const char* a_ptr(const Unit& u) const { const int blk = u.pn < 24 ? (u.pn >> 3) : (u.pn - 21); return (const char*)(A + (size_t)u.pm * 256 * lda + blk * 2048); }
    __device__ __forceinline__ const char* b_ptr(const Unit& u) const { return (const char*)(Bt + (size_t)u.pn * 256 * ldb); } };
struct GRw2 { const bf16_t* A; const bf16_t* Bt; int K, lda, ldb;
    __device__ __forceinline__ const char* a_ptr(const Unit& u) const { const int blk = u.pn < 16 ? 0 : (u.pn < 32 ? 1 : 2); return (const char*)(A + (size_t)u.pm * 256 * lda + blk * 256); }
    __device__ __forceinline__ const char* b_ptr(const Unit& u) const { return (const char*)(Bt + (size_t)u.pn * 256 * ldb); } };

template <int ACT> __device__ __forceinline__ float actf(float x) {
    if (ACT == 1) return gelu_tanh(x); if (ACT == 2) return tanhf_(x); if (ACT == 3) return sigmoidf_(x); if (ACT == 4) return siluf_(x); return x; }
template <int ACT> __device__ __forceinline__ void store_tile_bf16(AccRef acc, bf16_t* dst, int ld, int row0, int col0) {
#pragma unroll
    for (int ai = 0; ai < 2; ++ai)
#pragma unroll
        for (int m = 0; m < 4; ++m) { bf16_t* rowp = dst + (size_t)(row0 + ai * 128 + m * 16) * ld + col0;
#pragma unroll
            for (int bj = 0; bj < 2; ++bj) { const f32x4 v0 = acc[ai][bj][m][0], v1 = acc[ai][bj][m][1];
                u32x4 w; w.x = cvt_pk_bf16(actf<ACT>(v0[0]), actf<ACT>(v0[1])); w.y = cvt_pk_bf16(actf<ACT>(v0[2]), actf<ACT>(v0[3]));
                w.z = cvt_pk_bf16(actf<ACT>(v1[0]), actf<ACT>(v1[1])); w.w = cvt_pk_bf16(actf<ACT>(v1[2]), actf<ACT>(v1[3]));
                *(u32x4*)(rowp + bj * 128) = w; } }
}
struct EpiBf16Plain { static constexpr bool PERM = true; bf16_t* O; int ldc;
    __device__ __forceinline__ void operator()(AccRef acc, const Unit& u, int wr, int wc, int fr, int fq) const {
        store_tile_bf16<0>(acc, O, ldc, u.pm * 256 + wr * 64 + fr, u.pn * 256 + wc * 32 + 8 * fq); } };
struct EpiF32Plain { static constexpr bool PERM = false; float* C; int ldc;
    __device__ __forceinline__ void operator()(AccRef acc, const Unit& u, int wr, int wc, int fr, int fq) const {
        const int row0 = u.pm * 256 + wr * 64 + fr, col0 = u.pn * 256 + wc * 32 + 4 * fq;
#pragma unroll
        for (int ai = 0; ai < 2; ++ai)
#pragma unroll
            for (int m = 0; m < 4; ++m) { float* rowp = C + (size_t)(row0 + ai * 128 + m * 16) * ldc + col0;
#pragma unroll
                for (int bj = 0; bj < 2; ++bj)
#pragma unroll
                    for (int n = 0; n < 2; ++n) *(f32x4*)(rowp + bj * 128 + n * 16) = acc[ai][bj][m][n]; } } };
struct GSplitK { const bf16_t* A; const bf16_t* Bt; int K, lda, ldb;
    __device__ __forceinline__ const char* a_ptr(const Unit& u) const { return (const char*)(A + (size_t)u.pm * 256 * lda + (u.pn >> 3) * 512); }
    __device__ __forceinline__ const char* b_ptr(const Unit& u) const { return (const char*)(Bt + (size_t)(u.pn & 7) * 256 * ldb + (u.pn >> 3) * 512); } };
struct EpiPartial { static constexpr bool PERM = false; float* PX;
    __device__ __forceinline__ void operator()(AccRef acc, const Unit& u, int wr, int wc, int fr, int fq) const {
        const int row0 = u.pm * 256 + wr * 64 + fr, col0 = (u.pn & 7) * 256 + wc * 32 + 4 * fq; float* base = PX + (size_t)(u.pn >> 3) * NCTX * D;
#pragma unroll
        for (int ai = 0; ai < 2; ++ai)
#pragma unroll
            for (int m = 0; m < 4; ++m) { float* rowp = base + (size_t)(row0 + ai * 128 + m * 16) * D + col0;
#pragma unroll
                for (int bj = 0; bj < 2; ++bj)
#pragma unroll
                    for (int n = 0; n < 2; ++n) *(f32x4*)(rowp + bj * 128 + n * 16) = acc[ai][bj][m][n]; } } };
struct EpiResid { static constexpr bool PERM = false; float* X; const float* gate_base; float ymul;
    __device__ __forceinline__ void operator()(AccRef acc, const Unit& u, int wr, int wc, int fr, int fq) const {
        const int row0 = u.pm * 256 + wr * 64 + fr, col0 = u.pn * 256 + wc * 32 + 4 * fq;
        const float* gp = gate_base + (size_t)panel_vec(u.pm) * 6 * D + col0;
        f32x4 gv[2][2];
#pragma unroll
        for (int bj = 0; bj < 2; ++bj)
#pragma unroll
            for (int n = 0; n < 2; ++n) gv[bj][n] = *(const f32x4*)(gp + bj * 128 + n * 16);
#pragma unroll
        for (int ai = 0; ai < 2; ++ai)
#pragma unroll
            for (int m = 0; m < 4; ++m) { float* rowp = X + (size_t)(row0 + ai * 128 + m * 16) * D + col0;
#pragma unroll
                for (int bj = 0; bj < 2; ++bj)
#pragma unroll
                    for (int n = 0; n < 2; ++n) { f32x4* p = (f32x4*)(rowp + bj * 128 + n * 16); const f32x4 x = *p; *p = x * ALPHA + gv[bj][n] * (acc[ai][bj][m][n] * ymul); } } } };
struct EpiRgIn { static constexpr bool PERM = true; bf16_t* UG; bf16_t* UR;
    __device__ __forceinline__ void operator()(AccRef acc, const Unit& u, int wr, int wc, int fr, int fq) const {
        const int row0 = u.pm * 256 + wr * 64 + fr, col0 = (u.pn & 7) * 256 + wc * 32 + 8 * fq;
        if (u.pn < 8) store_tile_bf16<1>(acc, UG, D, row0, col0); else store_tile_bf16<0>(acc, UR, D, row0, col0); } };
struct EpiRgGate { static constexpr bool PERM = true; const bf16_t* XC; bf16_t* LA; bf16_t* BB; const float* gate_b; const float* spt;
    __device__ __forceinline__ void operator()(AccRef acc, const Unit& u, int wr, int wc, int fr, int fq) const {
        const int d = u.pn >> 4, ch0 = ((u.pn >> 1) & 7) * 256 + (u.pn & 1) * 128 + wc * 32 + 8 * fq;
        const int row0 = u.pm * 256 + wr * 64 + fr;
        float br[8], bi[8], sp[8];
#pragma unroll
        for (int j = 0; j < 8; ++j) { br[j] = gate_b[(d * 2 + 0) * D + ch0 + j]; bi[j] = gate_b[(d * 2 + 1) * D + ch0 + j];
            sp[j] = spt[d * D + ch0 + j]; }
        u32x4 xr8[8];
#pragma unroll
        for (int q = 0; q < 8; ++q) xr8[q] = *(const u32x4*)(XC + (size_t)(row0 + (q >> 2) * 128 + (q & 3) * 16) * D + ch0);
#pragma unroll
        for (int ai = 0; ai < 2; ++ai)
#pragma unroll
            for (int m = 0; m < 4; ++m) { const int row = row0 + ai * 128 + m * 16;
                const u32x4 xr = xr8[ai * 4 + m];
                float xc[8] = {bflo(xr.x), bfhi(xr.x), bflo(xr.y), bfhi(xr.y), bflo(xr.z), bfhi(xr.z), bflo(xr.w), bfhi(xr.w)};
                float la[8], bb[8];
#pragma unroll
                for (int j = 0; j < 8; ++j) { const float ar = acc[ai][0][m][j >> 2][j & 3], ai_ = acc[ai][1][m][j >> 2][j & 3];
                    const float rg = sigmoidf_(ar + br[j]), ig = sigmoidf_(ai_ + bi[j]);
                    const float l = sp[j] * rg; la[j] = l; bb[j] = sqrtf(1.0f - __expf(2.0f * l)) * (ig * xc[j]); }
                u32x4 w; w.x = cvt_pk_bf16(la[0], la[1]); w.y = cvt_pk_bf16(la[2], la[3]); w.z = cvt_pk_bf16(la[4], la[5]); w.w = cvt_pk_bf16(la[6], la[7]);
                *(u32x4*)(LA + ((size_t)row * 2 + d) * D + ch0) = w;
                w.x = cvt_pk_bf16(bb[0], bb[1]); w.y = cvt_pk_bf16(bb[2], bb[3]); w.z = cvt_pk_bf16(bb[4], bb[5]); w.w = cvt_pk_bf16(bb[6], bb[7]);
                *(u32x4*)(BB + ((size_t)row * 2 + d) * D + ch0) = w; } } };
struct EpiRw1 { static constexpr bool PERM = true; bf16_t* RKV; bf16_t* A2;
    __device__ __forceinline__ void operator()(AccRef acc, const Unit& u, int wr, int wc, int fr, int fq) const {
        const int row0 = u.pm * 256 + wr * 64 + fr, cw = wc * 32 + 8 * fq;
        if (u.pn < 24) store_tile_bf16<0>(acc, RKV + (size_t)(u.pn >> 3) * TD, D, row0, (u.pn & 7) * 256 + cw);
        else if (u.pn == 24) store_tile_bf16<2>(acc, A2, 768, row0, cw);
        else if (u.pn == 25) store_tile_bf16<0>(acc, A2, 768, row0, 256 + cw);
        else store_tile_bf16<3>(acc, A2, 768, row0, 512 + cw); } };
struct EpiRw2 { static constexpr bool PERM = true; bf16_t* W; bf16_t* AD; bf16_t* G; const float* dec0; const float* icl0;
    __device__ __forceinline__ void operator()(AccRef acc, const Unit& u, int wr, int wc, int fr, int fq) const {
        const int row0 = u.pm * 256 + wr * 64 + fr, c0 = (u.pn & 7) * 256 + wc * 32 + 8 * fq;
        if (u.pn >= 32) { store_tile_bf16<0>(acc, G, D, row0, c0); return; }
        const int isa = u.pn >= 16, d = (u.pn >> 3) & 1;
        const float* bias = (isa ? icl0 : dec0) + d * D + c0;
        bf16_t* dst = (isa ? AD : W);
        float bv[2][8];
#pragma unroll
        for (int bj = 0; bj < 2; ++bj)
#pragma unroll
            for (int j = 0; j < 8; ++j) bv[bj][j] = bias[bj * 128 + j];
#pragma unroll
        for (int ai = 0; ai < 2; ++ai)
#pragma unroll
            for (int m = 0; m < 4; ++m) { const int row = row0 + ai * 128 + m * 16;
#pragma unroll
                for (int bj = 0; bj < 2; ++bj) { float o[8];
#pragma unroll
                    for (int j = 0; j < 8; ++j) { const float s = sigmoidf_(acc[ai][bj][m][j >> 2][j & 3] + bv[bj][j]); o[j] = isa ? s : __expf(-0.6065306597126334f * s); }
                    u32x4 w; w.x = cvt_pk_bf16(o[0], o[1]); w.y = cvt_pk_bf16(o[2], o[3]); w.z = cvt_pk_bf16(o[4], o[5]); w.w = cvt_pk_bf16(o[6], o[7]);
                    *(u32x4*)(dst + ((size_t)row * 2 + d) * D + c0 + bj * 128) = w; } } } };
struct EpiRetIn { static constexpr bool PERM = true; bf16_t* Q; bf16_t* Kk; bf16_t* V; bf16_t* GF; bf16_t* GB; const float* CS;
    __device__ __forceinline__ void operator()(AccRef acc, const Unit& u, int wr, int wc, int fr, int fq) const {
        const int row0 = u.pm * 256 + wr * 64 + fr, cw = wc * 32 + 8 * fq;
        if (u.pn >= 48) { store_tile_bf16<4>(acc, GB, 4096, row0, (u.pn - 48) * 256 + cw); return; }
        if (u.pn >= 32) { store_tile_bf16<4>(acc, GF, 4096, row0, (u.pn - 32) * 256 + cw); return; }
        if (u.pn >= 16) { store_tile_bf16<0>(acc, V, 4096, row0, (u.pn - 16) * 256 + cw); return; }
        const float sc = u.pn >= 8 ? 0.0625f : 1.0f; bf16_t* dst = u.pn >= 8 ? Kk : Q; const int hc = (u.pn & 7) * 256;
#pragma unroll
        for (int ai = 0; ai < 2; ++ai) { f32x4 cs4[4][4];
#pragma unroll
            for (int m = 0; m < 4; ++m) { const float* cs_ = CS + ((size_t)row_pos(row0 + ai * 128 + m * 16) * 128 + cw) * 2;
#pragma unroll
                for (int q = 0; q < 4; ++q) cs4[m][q] = *(const f32x4*)(cs_ + 4 * q); }
#pragma unroll
            for (int m = 0; m < 4; ++m) { const int row = row0 + ai * 128 + m * 16;
                float o1[8], o2[8];
#pragma unroll
                for (int j = 0; j < 8; ++j) { const float co = cs4[m][j >> 1][(2 * j) & 3], si = cs4[m][j >> 1][(2 * j + 1) & 3]; const float t1 = acc[ai][0][m][j >> 2][j & 3], t2 = acc[ai][1][m][j >> 2][j & 3];
                    o1[j] = (t1 * co - t2 * si) * sc; o2[j] = (t1 * si + t2 * co) * sc; }
                u32x4 w; w.x = cvt_pk_bf16(o1[0], o1[1]); w.y = cvt_pk_bf16(o1[2], o1[3]); w.z = cvt_pk_bf16(o1[4], o1[5]); w.w = cvt_pk_bf16(o1[6], o1[7]);
                *(u32x4*)(dst + (size_t)row * D + hc + cw) = w;
                w.x = cvt_pk_bf16(o2[0], o2[1]); w.y = cvt_pk_bf16(o2[2], o2[3]); w.z = cvt_pk_bf16(o2[4], o2[5]); w.w = cvt_pk_bf16(o2[6], o2[7]);
                *(u32x4*)(dst + (size_t)row * D + hc + 128 + cw) = w; } } } };

#define LDS_WAIT() asm volatile("s_waitcnt lgkmcnt(0)" ::: "memory")
struct Ctx { LAS unsigned char* lds; int tid, lane, wave, gw, ngw, gtid, ngt; };

__device__ __forceinline__ void transpose_item(const float* W, int ldw, bf16_t* WT, int ldt, int k0, int n0, int dst_row0, LAS float* scr, int lane) {
#pragma unroll
    for (int i = 0; i < 8; ++i) { const int kk = 8 * i + (lane >> 3), nn = (lane & 7) * 4; const f32x4 wv = *(const f32x4*)(W + (size_t)(k0 + kk) * ldw + n0 + nn);
        LAS float* d = scr + kk * 33 + nn; d[0] = wv[0]; d[1] = wv[1]; d[2] = wv[2]; d[3] = wv[3]; }
    LDS_WAIT(); asm volatile("" ::: "memory");
    const int c = lane & 7;
#pragma unroll
    for (int j = 0; j < 4; ++j) { const int n = (lane >> 3) + 8 * j; const LAS float* s = scr + (8 * c) * 33 + n;
        u32x4 o; o.x = cvt_pk_bf16(s[0 * 33], s[1 * 33]); o.y = cvt_pk_bf16(s[2 * 33], s[3 * 33]); o.z = cvt_pk_bf16(s[4 * 33], s[5 * 33]); o.w = cvt_pk_bf16(s[6 * 33], s[7 * 33]);
        *(u32x4*)(WT + (size_t)(dst_row0 + n) * ldt + k0 + 8 * c) = o; }
    LDS_WAIT(); asm volatile("" ::: "memory");
}
__device__ __forceinline__ void tr_job(const Ctx& c, int& rot, const float* W, int K, int N, int ldw, bf16_t* WT, int ldt, int row_off) {
    LAS float* scr = (LAS float*)(c.lds + c.wave * 16384);
    const int nblk = N / 32, items = (K / 64) * nblk;
    int first = c.gw - (rot % c.ngw); if (first < 0) first += c.ngw;
    int lane = c.lane; asm volatile("" : "+v"(lane));
    f32x4 r[8];
#define TR_LOAD(it_) do { const int kb_ = (it_) / nblk, nb_ = (it_) % nblk; _Pragma("unroll") for (int i = 0; i < 8; ++i) r[i] = *(const f32x4*)(W + (size_t)(kb_ * 64 + 8 * i + (lane >> 3)) * ldw + nb_ * 32 + (lane & 7) * 4); } while (0)
    if (first < items) TR_LOAD(first);
    for (int it = first; it < items; it += c.ngw) { const int kb = it / nblk, nb = it % nblk;
#pragma unroll
        for (int i = 0; i < 8; ++i) { LAS float* d = scr + (8 * i + (lane >> 3)) * 33 + (lane & 7) * 4; d[0] = r[i][0]; d[1] = r[i][1]; d[2] = r[i][2]; d[3] = r[i][3]; }
        if (it + c.ngw < items) TR_LOAD(it + c.ngw);
        LDS_WAIT(); asm volatile("" ::: "memory");
        const int cc = lane & 7;
#pragma unroll
        for (int j = 0; j < 4; ++j) { const int n = (lane >> 3) + 8 * j; const LAS float* sp = scr + (8 * cc) * 33 + n;
            u32x4 o; o.x = cvt_pk_bf16(sp[0 * 33], sp[1 * 33]); o.y = cvt_pk_bf16(sp[2 * 33], sp[3 * 33]); o.z = cvt_pk_bf16(sp[4 * 33], sp[5 * 33]); o.w = cvt_pk_bf16(sp[6 * 33], sp[7 * 33]);
            *(u32x4*)(WT + (size_t)(row_off + nb * 32 + n) * ldt + kb * 64 + 8 * cc) = o; }
        LDS_WAIT(); asm volatile("" ::: "memory"); }
#undef TR_LOAD
    rot += items;
}

__device__ __forceinline__ void peer_convert_rows(KP P, const Ctx& c, int g_lo, int g_hi, int rank, int nranks) {
    unsigned char* ws = P->ws;
    f32x4 xn[2][8];
#define CV_LOAD(g0_) do { _Pragma("unroll") for (int h = 0; h < 2; ++h) { const int g = ((g0_) + h < g_hi) ? (g0_) + h : (g0_); const int lt = g >> 14, e = g & 16383, layer = lt >> 1, t = lt & 1; \
            const float* sp = P->in[t ? I_PV : I_PU] + ((size_t)layer * 16384 + e) * D + c.lane * 16; \
            _Pragma("unroll") for (int q = 0; q < 8; ++q) xn[h][q] = *(const f32x4*)(sp + (q >> 2) * 1024 + (q & 3) * 4); } } while (0)
    { const int gf = g_lo + (rank * 8 + c.wave) * 2; if (gf < g_hi) CV_LOAD(gf); }
    for (int g0 = g_lo + (rank * 8 + c.wave) * 2; g0 < g_hi; g0 += nranks * 16) {
        f32x4 x[2][8]; float am[2] = {0.f, 0.f};
#pragma unroll
        for (int h = 0; h < 2; ++h)
#pragma unroll
            for (int q = 0; q < 8; ++q) x[h][q] = xn[h][q];
        if (g0 + nranks * 16 < g_hi) CV_LOAD(g0 + nranks * 16);
#pragma unroll
        for (int h = 0; h < 2; ++h) { if (g0 + h >= g_hi) break;
            const int g = g0 + h; const int lt = g >> 14, e = g & 16383, layer = lt >> 1, t = lt & 1;
#pragma unroll
            for (int q = 0; q < 8; ++q) am[h] = fmaxf(am[h], fmaxf(fmaxf(fabsf(x[h][q][0]), fabsf(x[h][q][1])), fmaxf(fabsf(x[h][q][2]), fabsf(x[h][q][3]))));
            const float a = wave_max(am[h]);
            const float sc = a > 0.f ? exp2f(floorf(log2f(384.0f / a))) : 1.0f;
            if (c.lane == 0) ((float*)(ws + WS_PSC))[(size_t)t * 4 * 16384 + layer * 16384 + e] = 1.0f / sc;
            unsigned char* dst = ws + (t ? WS_PV : WS_PU) + (size_t)layer * 16384 * D;
#pragma unroll
            for (int jj = 0; jj < 2; ++jj) { u32x4 o;
#pragma unroll
                for (int w = 0; w < 4; ++w) { const f32x4 v = x[h][jj * 4 + w] * sc; int p = 0; p = __builtin_amdgcn_cvt_pk_fp8_f32(v[0], v[1], p, false); p = __builtin_amdgcn_cvt_pk_fp8_f32(v[2], v[3], p, true); o[w] = (unsigned)p; }
                const int db = (c.lane >> 3) + 8 * jj;
                *(u32x4*)(dst + ((size_t)db * 16384 + e) * 128 + (c.lane & 7) * 16) = o; } } }
#undef CV_LOAD
}
__device__ __forceinline__ void phase_prologue(KP P, const Ctx& c) {
    unsigned char* ws = P->ws;
    PROBE_REP(14) {
        LAS float* sl = (LAS float*)c.lds;
        LAS float* red = sl + 1280;
        for (int un = blockIdx.x; un < 4 * 24 * 8; un += gridDim.x) {
            const int layer = un / 192, r = un % 192, nb = r / 8, kc = r % 8;
            __syncthreads();
            for (int i = c.tid; i < 5 * 256; i += 512) { const int v = i >> 8, k = kc * 256 + (i & 255); const float x = v < 4 ? P->in[I_C][v * D + k] : P->in[I_CCTX][k]; sl[i] = siluf_(x); }
            __syncthreads();
            const int cg = c.tid & 127, ks = c.tid >> 7;
            const float* w = P->in[I_ADAW] + ((size_t)layer * D + kc * 256 + ks * 64) * 12288 + nb * 512 + cg * 4;
            f32x4 a0 = (f32x4){0.f, 0.f, 0.f, 0.f}, a1 = a0, a2 = a0, a3 = a0, a4 = a0;
            f32x4 wn[8];
#pragma unroll
            for (int i = 0; i < 8; ++i) wn[i] = *(const f32x4*)(w + (size_t)i * 12288);
#pragma unroll 1
            for (int k0 = 0; k0 < 64; k0 += 8) { f32x4 wc[8];
#pragma unroll
                for (int i = 0; i < 8; ++i) wc[i] = wn[i];
                if (k0 + 8 < 64) {
#pragma unroll
                    for (int i = 0; i < 8; ++i) wn[i] = *(const f32x4*)(w + (size_t)(k0 + 8 + i) * 12288); }
#pragma unroll
                for (int i = 0; i < 8; ++i) { const f32x4 wv = wc[i]; const int kk = ks * 64 + k0 + i;
                    a0 += wv * sl[kk]; a1 += wv * sl[256 + kk]; a2 += wv * sl[512 + kk]; a3 += wv * sl[768 + kk]; a4 += wv * sl[1024 + kk]; } }
            LAS float* rp = red + (ks * 5) * 512 + cg * 4;
            *(LAS f32x4*)(rp) = a0; *(LAS f32x4*)(rp + 512) = a1; *(LAS f32x4*)(rp + 1024) = a2; *(LAS f32x4*)(rp + 1536) = a3; *(LAS f32x4*)(rp + 2048) = a4;
            __syncthreads();
            for (int i = c.tid; i < 5 * 512; i += 512) { const int v = i >> 9, n = i & 511;
                const float sum = (red[(0 * 5 + v) * 512 + n] + red[(1 * 5 + v) * 512 + n]) + (red[(2 * 5 + v) * 512 + n] + red[(3 * 5 + v) * 512 + n]);
                ((float*)(ws + WS_MODP))[((size_t)(layer * 8 + kc) * 5 + v) * 12288 + nb * 512 + n] = sum; }
        }
        __syncthreads();
    }
    PROBE_REP(16) {
    int rot = 0;
    for (int j = 0; j < 2; ++j) {
        tr_job(c, rot, P->in[I_RGWIN] + (size_t)j * D * 4096, D, 4096, 4096, (bf16_t*)(ws + WS_RGIN) + (size_t)j * 4096 * D, D, 0);
        tr_job(c, rot, P->in[I_RGWOUT] + (size_t)j * D * D, D, D, D, (bf16_t*)(ws + WS_RGOUT) + (size_t)j * D * D, D, 0);
    }
    {
        LAS float* scr = (LAS float*)(c.lds + c.wave * 16384);
        const int items = 64 * 32;
        int first = c.gw - (rot % c.ngw); if (first < 0) first += c.ngw;
        for (int it = first; it < items; it += c.ngw) {
            const int mat = it >> 5, sub = it & 31, kb = sub >> 3, nb32 = sub & 7;
            const int jl = mat >> 5, d = (mat >> 4) & 1, g = (mat >> 3) & 1, nblk = mat & 7;
            const int n0 = nb32 * 32, hf = n0 >> 7, pn = (d * 8 + nblk) * 2 + hf;
            transpose_item(P->in[I_RGGW] + (size_t)mat * 65536, 256, (bf16_t*)(ws + WS_RGGATE) + (size_t)jl * 8192 * 256, 256, kb * 64, n0, pn * 256 + g * 128 + (n0 & 127), scr, c.lane);
        }
        rot += items;
    }
    for (int m = 0; m < 3; ++m) tr_job(c, rot, P->in[I_RWRKV] + (size_t)m * D * D, D, D, D, (bf16_t*)(ws + WS_RW1), D, m * D);
    for (int d = 0; d < 2; ++d) {
        tr_job(c, rot, P->in[I_RWDEC1] + (size_t)d * D * 96, D, 96, 96, (bf16_t*)(ws + WS_RW1), D, 6144 + d * 96);
        tr_job(c, rot, P->in[I_RWICL1] + (size_t)d * D * 96, D, 96, 96, (bf16_t*)(ws + WS_RW1), D, 6400 + d * 96);
    }
    tr_job(c, rot, P->in[I_RWG1], D, 256, 256, (bf16_t*)(ws + WS_RW1), D, 6656);
    tr_job(c, rot, P->in[I_RWWO], D, D, D, (bf16_t*)(ws + WS_RWO), D, 0);
    tr_job(c, rot, P->in[I_RETWIN], D, 16384, 16384, (bf16_t*)(ws + WS_RETIN), D, 0);
    tr_job(c, rot, P->in[I_RETWOUT], 4096, D, D, (bf16_t*)(ws + WS_RETOUT), 4096, 0);
    }
    PROBE_REP(17) {
    for (size_t i0 = c.gtid; i0 < (size_t)4 * D * D / 8; i0 += 4 * (size_t)c.ngt) { f32x4 a[4], b[4];
#pragma unroll
        for (int u = 0; u < 4; ++u) { const size_t i = i0 + (size_t)u * c.ngt; if (i < (size_t)4 * D * D / 8) { a[u] = *(const f32x4*)(P->in[I_PWQ] + i * 8); b[u] = *(const f32x4*)(P->in[I_PWQ] + i * 8 + 4); } }
#pragma unroll
        for (int u = 0; u < 4; ++u) { const size_t i = i0 + (size_t)u * c.ngt; if (i < (size_t)4 * D * D / 8)
            *(u32x4*)((bf16_t*)(ws + WS_WQN) + i * 8) = (u32x4){cvt_pk_bf16(a[u][0], a[u][1]), cvt_pk_bf16(a[u][2], a[u][3]), cvt_pk_bf16(b[u][0], b[u][1]), cvt_pk_bf16(b[u][2], b[u][3])}; } }
    for (int i = c.gtid; i < 2 * 64 * (D / 8); i += c.ngt) { const int blk = i / (64 * (D / 8)), r = (i / (D / 8)) % 64, c8 = i % (D / 8);
        *(u32x4*)((bf16_t*)(ws + WS_RW1) + (size_t)(6144 + blk * 256 + 192 + r) * D + c8 * 8) = (u32x4){0u, 0u, 0u, 0u}; }
    for (int i = c.gtid; i < 4 * 2048 * 32; i += c.ngt) { const int c8 = i & 31, row = (i >> 5) & 2047, l = i >> 16; const int p = (row >> 7) & 1, col = c8 * 8;
        u32x4 o = (u32x4){0u, 0u, 0u, 0u};
        if ((col >> 7) == p) { const float* s = P->in[I_PKEYS] + ((size_t)l * 2048 + row) * 128 + (col & 127); const f32x4 a = *(const f32x4*)s, b = *(const f32x4*)(s + 4);
            o.x = cvt_pk_bf16(a[0], a[1]); o.y = cvt_pk_bf16(a[2], a[3]); o.z = cvt_pk_bf16(b[0], b[1]); o.w = cvt_pk_bf16(b[2], b[3]); }
        *(u32x4*)((bf16_t*)(ws + WS_KEYS) + ((size_t)l * 2048 + row) * 256 + col) = o; }
    for (int i0 = c.gtid; i0 < 10240 * 256; i0 += 4 * c.ngt) { float v4[4];
#pragma unroll
        for (int u = 0; u < 4; ++u) { const int i = i0 + u * c.ngt; float v = 0.f;
            if (i < 10240 * 256) { const int kc = i & 255, r = i >> 8;
                if (r < 4096) { const int d = r >> 11, cc = r & 2047, k = kc - 96 * d; if (k >= 0 && k < 96) v = P->in[I_RWDEC2][((size_t)d * 96 + k) * D + cc]; }
                else if (r < 8192) { const int rr = r - 4096, d = rr >> 11, cc = rr & 2047, k = kc - 96 * d; if (k >= 0 && k < 96) v = P->in[I_RWICL2][((size_t)d * 96 + k) * D + cc]; }
                else v = P->in[I_RWG2][(size_t)kc * D + (r - 8192)]; }
            v4[u] = v; }
#pragma unroll
        for (int u = 0; u < 4; ++u) { const int i = i0 + u * c.ngt; if (i < 10240 * 256) ((bf16_t*)(ws + WS_RW2))[i] = (bf16_t)(cvt_pk_bf16(v4[u], 0.f) & 0xffffu); } }
    }
    PROBE_REP(18)
    for (int i = c.gtid; i < 2 * 2 * D; i += c.ngt) ((float*)(ws + WS_SPT))[i] = -8.0f * log1pf(expf(-P->in[I_RGLAM][i]));
    PROBE_REP(18)
    for (int i = c.gtid; i < SLEN * 128; i += c.ngt) { const int pos = i >> 7, k = i & 127; const float theta = 1.0f / powf(10000.0f, (float)k / 127.0f); const float ang = (float)pos * theta;
        ((f32x2*)(ws + WS_CS))[i] = (f32x2){cosf(ang), sinf(ang)}; }
}
__device__ __forceinline__ void phase_modfin(KP P, const Ctx& c) {
    for (int i = c.gtid; i < 4 * 5 * 12288; i += c.ngt) { const int n = i % 12288, lv = i / 12288, l = lv / 5, v = lv % 5;
        float s = P->in[I_ADAB][l * 12288 + n];
        for (int kc = 0; kc < 8; ++kc) s += ((const float*)(P->ws + WS_MODP))[((size_t)(l * 8 + kc) * 5 + v) * 12288 + n];
        ((float*)(P->ws + WS_MOD))[i] = s; }
}
__device__ __forceinline__ void phase_xinit(KP P, const Ctx& c) {
    bf16_t* X = (bf16_t*)(P->ws + WS_X); bf16_t* A0 = (bf16_t*)(P->ws + WS_A0);
    for (size_t i0 = c.gtid; i0 < TD / 4; i0 += 4 * (size_t)c.ngt) {
        f32x4 x[4], sh[4], sc[4];
#pragma unroll
        for (int u = 0; u < 4; ++u) { const size_t i = i0 + (size_t)u * c.ngt; if (i < TD / 4) { const int row = (int)(i >> 9), c4 = (int)(i & 511) * 4;
            const float* src = row < NCTX ? P->in[I_CTX] + (size_t)row * D : P->in[I_X] + (size_t)(row - NCTX) * D; const int v = row_vec(row);
            x[u] = *(const f32x4*)(src + c4); sh[u] = *(const f32x4*)(modp(P, 0, v, 0) + c4); sc[u] = *(const f32x4*)(modp(P, 0, v, 1) + c4); } }
#pragma unroll
        for (int u = 0; u < 4; ++u) { const size_t i = i0 + (size_t)u * c.ngt; if (i < TD / 4) { const int row = (int)(i >> 9), c4 = (int)(i & 511) * 4;
            *(u32x2*)(X + (size_t)row * D + c4) = (u32x2){cvt_pk_bf16(x[u][0], x[u][1]), cvt_pk_bf16(x[u][2], x[u][3])};
            const f32x4 h = x[u] * (sc[u] + 1.0f) + sh[u];
            *(u32x2*)(A0 + (size_t)row * D + c4) = (u32x2){cvt_pk_bf16(h[0], h[1]), cvt_pk_bf16(h[2], h[3])}; } } }
}

__device__ __forceinline__ void phase_rg_conv(KP P, const Ctx& c, int jl) {
    const bf16_t* UR = (const bf16_t*)(P->ws + L_UR); bf16_t* XC = (bf16_t*)(P->ws + L_XC);
    const float* cw = P->in[I_RGCW] + (size_t)jl * 4 * D; const float* cb = P->in[I_RGCB] + (size_t)jl * D;
    const int c8 = (int)(c.gtid & 255) * 8;
    float w8[4][8], b8[8];
#pragma unroll
    for (int j = 0; j < 8; ++j) { b8[j] = cb[c8 + j];
#pragma unroll
        for (int tp = 0; tp < 4; ++tp) w8[tp][j] = cw[tp * D + c8 + j]; }
    for (size_t i0 = c.gtid; i0 < TD / 8; i0 += 2 * (size_t)c.ngt) {
        u32x4 u[2][4];
#pragma unroll
        for (int q = 0; q < 2; ++q) { const size_t i = i0 + (size_t)q * c.ngt; const int row = (int)(i >> 8);
            int lo, hi; if (row < NCTX) { lo = row & ~(CTX - 1); hi = lo + CTX; } else { lo = NCTX + ((row - NCTX) & ~(SEQ - 1)); hi = lo + SEQ; }
#pragma unroll
            for (int tp = 0; tp < 4; ++tp) { const int rr = row + tp - 2; u[q][tp] = (u32x4){0u, 0u, 0u, 0u};
                if (i < TD / 8 && rr >= lo && rr < hi) u[q][tp] = *(const u32x4*)(UR + (size_t)rr * D + c8); } }
#pragma unroll
        for (int q = 0; q < 2; ++q) { const size_t i = i0 + (size_t)q * c.ngt; if (i >= TD / 8) break; const int row = (int)(i >> 8);
            float a[8];
#pragma unroll
            for (int j = 0; j < 8; ++j) a[j] = b8[j];
#pragma unroll
            for (int tp = 0; tp < 4; ++tp) { const u32x4 uu = u[q][tp]; const unsigned u0 = uu.x, u1 = uu.y, u2 = uu.z, u3 = uu.w;
                a[0] += w8[tp][0] * bflo(u0); a[1] += w8[tp][1] * bfhi(u0); a[2] += w8[tp][2] * bflo(u1); a[3] += w8[tp][3] * bfhi(u1);
                a[4] += w8[tp][4] * bflo(u2); a[5] += w8[tp][5] * bfhi(u2); a[6] += w8[tp][6] * bflo(u3); a[7] += w8[tp][7] * bfhi(u3); }
            *(u32x4*)(XC + (size_t)row * D + c8) = (u32x4){cvt_pk_bf16(a[0], a[1]), cvt_pk_bf16(a[2], a[3]), cvt_pk_bf16(a[4], a[5]), cvt_pk_bf16(a[6], a[7])}; } }
}
__device__ __forceinline__ void phase_rg_scan1(KP P, const Ctx& c) {
    const bf16_t* LA = (const bf16_t*)(P->ws + L_LA); const bf16_t* BB = (const bf16_t*)(P->ws + L_BB);
    float* CA = (float*)(P->ws + WS_CA); float* CH = (float*)(P->ws + WS_CH);
    for (int u = c.gw; u < 2048; u += c.ngw) { const int b = u >> 9, dir = (u >> 8) & 1, ck = (u >> 2) & 63, ch = (u & 3) * 512 + c.lane * 8;
        float h[8], sl[8];
#pragma unroll
        for (int e = 0; e < 8; ++e) { h[e] = 0.f; sl[e] = 0.f; }
        u32x4 nl[4], nb[4];
#define SC1_LOAD(s0_) do { _Pragma("unroll") for (int i_ = 0; i_ < 4; ++i_) { const int row_ = seq_row(b, dir, ck * 68 + (s0_) + i_); const size_t o_ = ((size_t)row_ * 2 + dir) * D + ch; nl[i_] = *(const u32x4*)(LA + o_); nb[i_] = *(const u32x4*)(BB + o_); } } while (0)
        SC1_LOAD(0);
#pragma unroll 1
        for (int s0 = 0; s0 < 68; s0 += 4) { u32x4 cl[4], cb[4];
#pragma unroll
            for (int i = 0; i < 4; ++i) { cl[i] = nl[i]; cb[i] = nb[i]; }
            if (s0 + 4 < 68) SC1_LOAD(s0 + 4);
#pragma unroll
            for (int i = 0; i < 4; ++i) { float l8[8], b8[8]; unpack8(cl[i], l8); unpack8(cb[i], b8);
#pragma unroll
                for (int e = 0; e < 8; ++e) { h[e] = __expf(l8[e]) * h[e] + b8[e]; sl[e] += l8[e]; } } }
#undef SC1_LOAD
        const size_t o = ((size_t)(b * 2 + dir) * 64 + ck) * D + ch;
        *(f32x4*)(CA + o) = (f32x4){sl[0], sl[1], sl[2], sl[3]}; *(f32x4*)(CA + o + 4) = (f32x4){sl[4], sl[5], sl[6], sl[7]};
        *(f32x4*)(CH + o) = (f32x4){h[0], h[1], h[2], h[3]}; *(f32x4*)(CH + o + 4) = (f32x4){h[4], h[5], h[6], h[7]}; }
}
__device__ __forceinline__ void phase_rg_scan2(KP P, const Ctx& c) {
    const float* CA = (const float*)(P->ws + WS_CA); const float* CH = (const float*)(P->ws + WS_CH); float* CIN = (float*)(P->ws + WS_CIN);
    for (int i = c.gtid; i < 4 * 2 * D; i += c.ngt) { const int ch = i & (D - 1), bd = i >> 11; float carry = 0.f;
#pragma unroll 1
        for (int c0 = 0; c0 < 64; c0 += 16) { float a[16], hh[16];
#pragma unroll
            for (int q = 0; q < 16; ++q) { const size_t o = ((size_t)bd * 64 + c0 + q) * D + ch; a[q] = CA[o]; hh[q] = CH[o]; }
#pragma unroll
            for (int q = 0; q < 16; ++q) { const size_t o = ((size_t)bd * 64 + c0 + q) * D + ch; CIN[o] = carry; carry = __expf(a[q]) * carry + hh[q]; } } }
}
template <int DIR> __device__ __forceinline__ void phase_rg_scan3(KP P, const Ctx& c) {
    const bf16_t* LA = (const bf16_t*)(P->ws + L_LA); const bf16_t* BB = (const bf16_t*)(P->ws + L_BB); const bf16_t* UG = (const bf16_t*)(P->ws + L_UG);
    const float* CIN = (const float*)(P->ws + WS_CIN); bf16_t* YIN = (bf16_t*)(P->ws + L_YIN); bf16_t* HF = (bf16_t*)(P->ws + L_XC);
    for (int u = c.gw; u < 2048; u += c.ngw) { const int b = u >> 9, ck = (u >> 3) & 63, ch = (u & 7) * 256 + c.lane * 4;
        const f32x4 h0 = *(const f32x4*)(CIN + ((size_t)(b * 2 + DIR) * 64 + ck) * D + ch); float h[4] = {h0[0], h0[1], h0[2], h0[3]};
        u32x2 nl[4], nb[4], nf[4], ng[4];
#define SC3_LOAD(s0_) do { _Pragma("unroll") for (int i_ = 0; i_ < 4; ++i_) { const int row_ = seq_row(b, DIR, ck * 68 + (s0_) + i_); const size_t o_ = ((size_t)row_ * 2 + DIR) * D + ch, q_ = (size_t)row_ * D + ch; \
            nl[i_] = *(const u32x2*)(LA + o_); nb[i_] = *(const u32x2*)(BB + o_); if (DIR == 1) { nf[i_] = *(const u32x2*)(HF + q_); ng[i_] = *(const u32x2*)(UG + q_); } } } while (0)
        SC3_LOAD(0);
#pragma unroll 1
        for (int s0 = 0; s0 < 68; s0 += 4) { u32x2 cl[4], cb[4], cf[4], cg[4];
#pragma unroll
            for (int i = 0; i < 4; ++i) { cl[i] = nl[i]; cb[i] = nb[i]; if (DIR == 1) { cf[i] = nf[i]; cg[i] = ng[i]; } }
            if (s0 + 4 < 68) SC3_LOAD(s0 + 4);
#pragma unroll
            for (int i = 0; i < 4; ++i) { const int row = seq_row(b, DIR, ck * 68 + s0 + i); const size_t q = (size_t)row * D + ch;
                const unsigned l0 = cl[i].x, l1 = cl[i].y, b0 = cb[i].x, b1 = cb[i].y;
                h[0] = __expf(bflo(l0)) * h[0] + bflo(b0); h[1] = __expf(bfhi(l0)) * h[1] + bfhi(b0); h[2] = __expf(bflo(l1)) * h[2] + bflo(b1); h[3] = __expf(bfhi(l1)) * h[3] + bfhi(b1);
                if (DIR == 0) { *(u32x2*)(HF + q) = (u32x2){cvt_pk_bf16(h[0], h[1]), cvt_pk_bf16(h[2], h[3])}; }
                else { const unsigned f0 = cf[i].x, f1 = cf[i].y, g0 = cg[i].x, g1 = cg[i].y;
                    *(u32x2*)(YIN + q) = (u32x2){cvt_pk_bf16(bflo(g0) * (bflo(f0) + h[0]), bfhi(g0) * (bfhi(f0) + h[1])), cvt_pk_bf16(bflo(g1) * (bflo(f1) + h[2]), bfhi(g1) * (bfhi(f1) + h[3]))}; } } }
#undef SC3_LOAD
    }
}

__device__ __forceinline__ void phase_ln_mid(KP P, const Ctx& c, int layer, int row_lo) {
    bf16_t* X = (bf16_t*)(P->ws + WS_X); bf16_t* H2 = (bf16_t*)(P->ws + WS_H2);
    const float* lg = P->in[I_LNG] + (size_t)(layer * 2 + 0) * D; const float* lb = P->in[I_LNB] + (size_t)(layer * 2 + 0) * D;
    u32x2 xn[8];
    const bf16_t* PB = (const bf16_t*)(P->ws + WS_S);
    u32x2 pn[8];
    { const int r0 = row_lo + c.gw; if (r0 < T) {
#pragma unroll
        for (int j = 0; j < 8; ++j) { xn[j] = *(const u32x2*)(X + (size_t)r0 * D + c.lane * 4 + 256 * j); pn[j] = *(const u32x2*)(PB + (size_t)r0 * D + c.lane * 4 + 256 * j); } } }
    for (int row = row_lo + c.gw; row < T; row += c.ngw) { bf16_t* xr = X + (size_t)row * D + c.lane * 4; const int v = row_vec(row);
        f32x4 x[8]; float s = 0.f;
        { const float* gp = modp(P, layer, v, 2) + c.lane * 4;
#pragma unroll
          for (int j = 0; j < 8; ++j) { const unsigned p0 = pn[j].x, p1 = pn[j].y, x0 = xn[j].x, x1 = xn[j].y;
              x[j] = (f32x4){bflo(x0), bfhi(x0), bflo(x1), bfhi(x1)} * ALPHA + *(const f32x4*)(gp + 256 * j) * (f32x4){bflo(p0), bfhi(p0), bflo(p1), bfhi(p1)}; } }
        if (row + c.ngw < T) {
#pragma unroll
            for (int j = 0; j < 8; ++j) { xn[j] = *(const u32x2*)(X + (size_t)(row + c.ngw) * D + c.lane * 4 + 256 * j); pn[j] = *(const u32x2*)(PB + (size_t)(row + c.ngw) * D + c.lane * 4 + 256 * j); } }
#pragma unroll
        for (int j = 0; j < 8; ++j) s += (x[j][0] + x[j][1]) + (x[j][2] + x[j][3]);
        const float mean = wave_sum(s) * (1.0f / D); float q = 0.f;
#pragma unroll
        for (int j = 0; j < 8; ++j) { x[j] = x[j] - mean; q += (x[j][0] * x[j][0] + x[j][1] * x[j][1]) + (x[j][2] * x[j][2] + x[j][3] * x[j][3]); }
        const float rstd = rsqrtf(wave_sum(q) * (1.0f / D) + LN_EPS);
        const float* m3 = modp(P, layer, v, 3) + c.lane * 4; const float* m4 = modp(P, layer, v, 4) + c.lane * 4;
#pragma unroll
        for (int jh = 0; jh < 2; ++jh) { f32x4 g4[4], b4[4], p4[4], q4[4];
#pragma unroll
            for (int jj = 0; jj < 4; ++jj) { const int j = 4 * jh + jj; g4[jj] = *(const f32x4*)(lg + c.lane * 4 + 256 * j); b4[jj] = *(const f32x4*)(lb + c.lane * 4 + 256 * j);
                p4[jj] = *(const f32x4*)(m4 + 256 * j); q4[jj] = *(const f32x4*)(m3 + 256 * j); }
#pragma unroll
            for (int jj = 0; jj < 4; ++jj) { const int j = 4 * jh + jj;
                const f32x4 y = x[j] * rstd * g4[jj] + b4[jj]; *(u32x2*)(xr + 256 * j) = (u32x2){cvt_pk_bf16(y[0], y[1]), cvt_pk_bf16(y[2], y[3])};
                const f32x4 h = y * (p4[jj] + 1.0f) + q4[jj];
                *(u32x2*)(H2 + (size_t)row * D + c.lane * 4 + 256 * j) = (u32x2){cvt_pk_bf16(h[0], h[1]), cvt_pk_bf16(h[2], h[3])}; } } }
}

__device__ __forceinline__ float dot2bf(unsigned a, unsigned b, float s) { return __builtin_amdgcn_fdot2_f32_bf16(__builtin_bit_cast(bf16v2, a), __builtin_bit_cast(bf16v2, b), s, false); }
__device__ __forceinline__ float dot8(const u32x4 a, const u32x4 b, float s) {
    const unsigned a0 = a.x, a1 = a.y, a2 = a.z, a3 = a.w, b0 = b.x, b1 = b.y, b2 = b.z, b3 = b.w;
    s = dot2bf(a0, b0, s); s = dot2bf(a1, b1, s); s = dot2bf(a2, b2, s); s = dot2bf(a3, b3, s);
    return s;
}
template <int CTRL> __device__ __forceinline__ int dpp_movi(int x) { return __builtin_amdgcn_update_dpp(x, x, CTRL, 0xF, 0xF, false); }
__device__ __forceinline__ int row_max_i(int m) { m = max(m, dpp_movi<0xB1>(m)); m = max(m, dpp_movi<0x4E>(m)); m = max(m, dpp_movi<0x141>(m)); m = max(m, dpp_movi<0x140>(m)); return m; }
template <int PAT> __device__ __forceinline__ int swz(int v) { return __builtin_amdgcn_ds_swizzle(v, PAT); }
__device__ __forceinline__ int f2key(float f) { const int b = __float_as_int(f); return b ^ ((b >> 31) & 0x7fffffff); }
__device__ __forceinline__ float key2f(int k) { return __int_as_float(k ^ ((k >> 31) & 0x7fffffff)); }
__device__ __forceinline__ void row_max_i_pair(int& a, int& b) {
    asm volatile("s_nop 1\n\t"
        "v_max_i32_dpp %0, %0, %0 quad_perm:[1,0,3,2] row_mask:0xf bank_mask:0xf\n\tv_max_i32_dpp %1, %1, %1 quad_perm:[1,0,3,2] row_mask:0xf bank_mask:0xf\n\ts_nop 0\n\t"
        "v_max_i32_dpp %0, %0, %0 quad_perm:[2,3,0,1] row_mask:0xf bank_mask:0xf\n\tv_max_i32_dpp %1, %1, %1 quad_perm:[2,3,0,1] row_mask:0xf bank_mask:0xf\n\ts_nop 0\n\t"
        "v_max_i32_dpp %0, %0, %0 row_half_mirror row_mask:0xf bank_mask:0xf\n\tv_max_i32_dpp %1, %1, %1 row_half_mirror row_mask:0xf bank_mask:0xf\n\ts_nop 0\n\t"
        "v_max_i32_dpp %0, %0, %0 row_mirror row_mask:0xf bank_mask:0xf\n\tv_max_i32_dpp %1, %1, %1 row_mirror row_mask:0xf bank_mask:0xf"
        : "+v"(a), "+v"(b));
}
__device__ __forceinline__ void phase_peer_select(KP P, const Ctx& c, int row_lo) {
    const float* S = (const float*)(P->ws + WS_S); float* SW = (float*)(P->ws + WS_SELW);
    constexpr int KMIN = (int)0x80000000;
    const int nps = (2 * (T - row_lo) - c.gw + c.ngw - 1) / c.ngw;
    f32x4 sn[2][2];
#define SEL_LOAD(k) do { const int pid_ = 2 * row_lo + c.gw + (k) * c.ngw; const float* sp_ = S + (size_t)(pid_ >> 1) * D + (2 * (pid_ & 1)) * 512 + lane * 8; \
        sn[0][0] = *(const f32x4*)sp_; sn[0][1] = *(const f32x4*)(sp_ + 4); sn[1][0] = *(const f32x4*)(sp_ + 512); sn[1][1] = *(const f32x4*)(sp_ + 516); } while (0)
    { int lane = c.lane; asm volatile("" : "+v"(lane)); if (nps > 0) SEL_LOAD(0); }
    {
#pragma unroll 1
        for (int kk = 0; kk < nps; ++kk) {
            const int pid = 2 * row_lo + c.gw + kk * c.ngw, row = pid >> 1, pp = pid & 1;
            int lane = c.lane; asm volatile("" : "+v"(lane));
            const int l16 = lane & 15, isS2 = (lane >> 4) & 1;
            int k8[2][8];
#pragma unroll
            for (int q = 0; q < 2; ++q) {
#pragma unroll
                for (int e = 0; e < 8; ++e) { const float v = sn[q][e >> 2][e & 3]; k8[q][e] = (f2key(v) & ~127) | (127 - (l16 * 8 + e)); } }
            if (kk + 1 < nps) SEL_LOAD(kk + 1);
#define SEL_CE(a, b) do { const int hi_ = max(a, b), lo_ = min(a, b); a = hi_; b = lo_; } while (0)
#pragma unroll
            for (int q = 0; q < 2; ++q) { int (&k)[8] = k8[q];
                SEL_CE(k[0], k[1]); SEL_CE(k[2], k[3]); SEL_CE(k[4], k[5]); SEL_CE(k[6], k[7]); SEL_CE(k[0], k[2]); SEL_CE(k[1], k[3]); SEL_CE(k[4], k[6]); SEL_CE(k[5], k[7]);
                SEL_CE(k[1], k[2]); SEL_CE(k[5], k[6]); SEL_CE(k[0], k[4]); SEL_CE(k[3], k[7]); SEL_CE(k[1], k[5]); SEL_CE(k[2], k[6]); SEL_CE(k[1], k[4]); SEL_CE(k[3], k[6]);
                SEL_CE(k[2], k[4]); SEL_CE(k[3], k[5]); SEL_CE(k[3], k[4]); }
            int own[2] = {KMIN, KMIN};
#pragma unroll
            for (int it = 0; it < 16; ++it) {
                int m0 = k8[0][0], m1 = k8[1][0];
                row_max_i_pair(m0, m1);
                const bool p0 = k8[0][0] == m0, p1 = k8[1][0] == m1;
#pragma unroll
                for (int e = 0; e < 7; ++e) { k8[0][e] = p0 ? k8[0][e + 1] : k8[0][e]; k8[1][e] = p1 ? k8[1][e + 1] : k8[1][e]; }
                k8[0][7] = p0 ? KMIN : k8[0][7]; k8[1][7] = p1 ? KMIN : k8[1][7];
                own[0] = (l16 == it) ? m0 : own[0]; own[1] = (l16 == it) ? m1 : own[1]; }
            int ck[2][4], ownIdx[2];
#pragma unroll
            for (int q = 0; q < 2; ++q) { ownIdx[q] = 127 - (own[q] & 127); const float ownVal = key2f(own[q]);
                int pk[4]; pk[0] = swz<(0x10 << 10) | (0 << 5) | 0x10>(own[q]); pk[1] = swz<(0x10 << 10) | (1 << 5) | 0x10>(own[q]); pk[2] = swz<(0x10 << 10) | (2 << 5) | 0x10>(own[q]); pk[3] = swz<(0x10 << 10) | (3 << 5) | 0x10>(own[q]);
#pragma unroll
                for (int m = 0; m < 4; ++m) { const float pv = key2f(pk[m]);
                    const int ci = isS2 ? m : l16, cj = isS2 ? l16 : m;
                    const bool valid = (isS2 ? (m <= l16) : (m < l16)) && ((ci + 1) * (cj + 1) <= 16);
                    ck[q][m] = valid ? ((f2key(ownVal + pv) & ~255) | (255 - (ci * 16 + cj))) : KMIN; } }
#pragma unroll
            for (int q = 0; q < 2; ++q) { int (&k)[4] = ck[q]; SEL_CE(k[0], k[1]); SEL_CE(k[2], k[3]); SEL_CE(k[0], k[2]); SEL_CE(k[1], k[3]); SEL_CE(k[1], k[2]); }
#undef SEL_CE
            int win[2] = {KMIN, KMIN};
#pragma unroll
            for (int it = 0; it < 16; ++it) {
                int m0 = ck[0][0], m1 = ck[1][0];
                row_max_i_pair(m0, m1);
                m0 = max(m0, swz<(0x10 << 10) | 0x1F>(m0)); m1 = max(m1, swz<(0x10 << 10) | 0x1F>(m1));
                const bool p0 = ck[0][0] == m0, p1 = ck[1][0] == m1;
#pragma unroll
                for (int e = 0; e < 3; ++e) { ck[0][e] = p0 ? ck[0][e + 1] : ck[0][e]; ck[1][e] = p1 ? ck[1][e + 1] : ck[1][e]; }
                ck[0][3] = p0 ? KMIN : ck[0][3]; ck[1][3] = p1 ? KMIN : ck[1][3];
                win[0] = (l16 == it) ? m0 : win[0]; win[1] = (l16 == it) ? m1 : win[1]; }
#pragma unroll
            for (int q = 0; q < 2; ++q) {
                const int cidx = 255 - (win[q] & 255), ci = (cidx >> 4) & 15, cj = cidx & 15, rb = lane & 32;
                const int i1 = __builtin_amdgcn_ds_bpermute((rb + ci) << 2, ownIdx[q]), i2 = __builtin_amdgcn_ds_bpermute((rb + 16 + cj) << 2, ownIdx[q]);
                const float sc = key2f(win[q]);
                const float mxf = key2f(row_max_i(f2key(sc)));
                const float ex = __expf(sc - mxf);
                float sum = ex; sum += dpp_mov<0xB1>(sum); sum += dpp_mov<0x4E>(sum); sum += dpp_mov<0x141>(sum); sum += dpp_mov<0x140>(sum);
                if (!isS2) { const size_t o = ((size_t)row * 8 + (2 * pp + q) * 2 + (lane >> 5)) * 16 + l16; const int e_ = (i1 * 128 + i2) & 16383; ((unsigned short*)(P->ws + P_SE16))[o] = (unsigned short)e_; SW[o] = ex / sum; } }
        }
    }
#undef SEL_LOAD
}

__device__ __forceinline__ float dot2bf_init(bf16v2 a, bf16v2 b) { float r; asm("v_dot2_f32_bf16 %0, %1, %2, 0" : "=v"(r) : "v"(a), "v"(b)); return r; }
__device__ __forceinline__ void unpack16_fp8(const u32x4 a, float (&f)[16]) {
#pragma unroll
    for (int w = 0; w < 4; ++w) { const int aw = (int)a[w]; const f32x2 lo = __builtin_amdgcn_cvt_pk_f32_fp8(aw, false), hi = __builtin_amdgcn_cvt_pk_f32_fp8(aw, true);
        f[4 * w + 0] = lo.x; f[4 * w + 1] = lo.y; f[4 * w + 2] = hi.x; f[4 * w + 3] = hi.y; }
}
#define PEER_QUEUE_BEGIN(phase_id, tg_lo, tg_hi) { \
    unsigned* heads_ = (unsigned*)(P->ws + WS_CTL) + CW_PQ + (phase_id) * 16 * 64; const unsigned x_ = ((PROBE >> 19) & 1) ? ((unsigned)blockIdx.x >> 5) & 7u : (xb_xcc_id() & 7u); \
    for (int k_ = 0; k_ < 16; ++k_) { const int db = (int)((x_ + 8u * (k_ & 1) + (unsigned)(k_ >> 1)) & 15u); \
        for (;;) { unsigned t0_ = 0; if (c.lane == 0) t0_ = __hip_atomic_fetch_add(heads_ + db * 64, 2u, __ATOMIC_RELAXED, __HIP_MEMORY_SCOPE_AGENT); \
            t0_ = (unsigned)__builtin_amdgcn_readfirstlane((int)t0_) + (unsigned)(tg_lo); if (t0_ >= (unsigned)(tg_hi)) break; \
            for (unsigned tg_ = t0_; tg_ < t0_ + 2u && tg_ < (unsigned)(tg_hi); ++tg_) { const int tg = (int)tg_;
#define PEER_QUEUE_END } } } }
__device__ __forceinline__ void phase_peer_u(KP P, const Ctx& c, int layer, int row_lo, int qrep) {
    const bf16_t* H2 = (const bf16_t*)(P->ws + WS_H2); const unsigned short* SE = (const unsigned short*)(P->ws + P_SE16);
    const unsigned char* U = P->ws + WS_PU + (size_t)layer * 16384 * D; bf16_t* PART = (bf16_t*)(P->ws + P_PART);
    PEER_QUEUE_BEGIN(layer * 2 + 0 + 8 * qrep, row_lo / 8, T / 8)
        int lane = c.lane; asm volatile("" : "+v"(lane));
        const int ts = lane >> 3, seg = lane & 7, t = tg * 8 + ts;
        const bf16_t* xp = H2 + (size_t)t * D + db * 128 + seg * 16; const u32x4 xa = *(const u32x4*)xp, xb = *(const u32x4*)(xp + 8);
        const unsigned short* se = SE + (size_t)t * 128; const unsigned char* ub = U + (size_t)db * 16384 * 128; const unsigned seg16 = (unsigned)seg * 16u;
        bf16_t* pp = PART + (((size_t)t * 16 + db) * 8 + seg) * 16;
        u32x4 eA[2], eB[2], gA[16], gB[16];
#define PU_IDX(E, st) do { _Pragma("unroll") for (int i_ = 0; i_ < 2; ++i_) E[i_] = *(const u32x4*)(se + 16 * (st) + 8 * i_); } while (0)
#define PU_GATHER(G, E) do { _Pragma("unroll") for (int k_ = 0; k_ < 16; ++k_) { const unsigned w_ = E[k_ >> 3][(k_ >> 1) & 3]; const unsigned e_ = ((k_ & 1) ? (w_ >> 16) : w_) & 16383u; G[k_] = *(const u32x4*)(ub + (unsigned)((e_ << 7) | seg16)); } } while (0)
#define PU_COMPUTE(G, OUT) do { float v2_[2]; \
            _Pragma("unroll") for (int cc = 0; cc < 2; ++cc) { float sk[8]; \
                _Pragma("unroll") for (int k = 0; k < 8; ++k) { float s0; \
                    _Pragma("unroll") for (int w = 0; w < 4; ++w) { const int gw_ = (int)G[8 * cc + k][w]; const unsigned x0 = w < 2 ? xa[2 * w] : xb[2 * w - 4], x1 = w < 2 ? xa[2 * w + 1] : xb[2 * w - 3]; \
                        if (w == 0) s0 = dot2bf_init(__builtin_amdgcn_cvt_scalef32_pk_bf16_fp8(gw_, 1.0f, false), __builtin_bit_cast(bf16v2, x0)); \
                        else s0 = __builtin_amdgcn_fdot2_f32_bf16(__builtin_amdgcn_cvt_scalef32_pk_bf16_fp8(gw_, 1.0f, false), __builtin_bit_cast(bf16v2, x0), s0, false); \
                        s0 = __builtin_amdgcn_fdot2_f32_bf16(__builtin_amdgcn_cvt_scalef32_pk_bf16_fp8(gw_, 1.0f, true), __builtin_bit_cast(bf16v2, x1), s0, false); } \
                    sk[k] = s0; } \
                sum8_quad(sk[0], sk[1], sk[2], sk[3]); sum8_quad(sk[4], sk[5], sk[6], sk[7]); \
                float v = 0.f; \
                _Pragma("unroll") for (int k = 0; k < 8; ++k) v = (seg == k) ? sk[k] : v; \
                v2_[cc] = v; } \
            OUT = cvt_pk_bf16(v2_[0], v2_[1]); } while (0)
        PU_IDX(eA, 0); PU_IDX(eB, 1); PU_GATHER(gA, eA);
#pragma unroll 1
        for (int j2 = 0; j2 < 4; ++j2) {
            PU_GATHER(gB, eB);
            if (j2 < 3) PU_IDX(eA, 2 * j2 + 2);
            unsigned pw0, pw1;
            PU_COMPUTE(gA, pw0);
            if (j2 < 3) { PU_GATHER(gA, eA); PU_IDX(eB, 2 * j2 + 3); }
            PU_COMPUTE(gB, pw1);
            *(u32x2*)(pp + 4 * j2) = (u32x2){pw0, pw1};
        }
#undef PU_IDX
#undef PU_GATHER
#undef PU_COMPUTE
    PEER_QUEUE_END
}
__device__ __forceinline__ void phase_peer_c(KP P, const Ctx& c, int layer, int row_lo) {
    const bf16_t* PART = (const bf16_t*)(P->ws + P_PART); const unsigned short* SE = (const unsigned short*)(P->ws + P_SE16); const float* SW = (const float*)(P->ws + WS_SELW);
    const float* ISU = (const float*)(P->ws + WS_PSC) + (size_t)layer * 16384; const float* ISV = ISU + (size_t)4 * 16384; bf16_t* C = (bf16_t*)(P->ws + P_C);
    unsigned pw[16]; unsigned short se0, se1; float w0, w1;
#define PC_LOAD(i_) do { const size_t t_ = (i_) >> 6; const int jj_ = (int)((i_) & 7), seg_ = (int)(((i_) >> 3) & 7); const unsigned* pp_ = (const unsigned*)(PART + ((t_ * 16) * 8 + seg_) * 16 + 2 * jj_); \
        _Pragma("unroll") for (int db = 0; db < 16; ++db) pw[db] = pp_[(size_t)db * 64]; \
        const size_t o_ = t_ * 128 + 16 * jj_ + seg_; se0 = SE[o_]; se1 = SE[o_ + 8]; w0 = SW[o_]; w1 = SW[o_ + 8]; } while (0)
    const size_t ibeg = (size_t)row_lo * 64 + c.gtid, iend = (size_t)T * 64;
    if (ibeg < iend) PC_LOAD(ibeg);
    for (size_t i = ibeg; i < iend; i += c.ngt) { const size_t t = i >> 6; const int jj = (int)(i & 7), seg = (int)((i >> 3) & 7);
        const size_t o0 = t * 128 + 16 * jj + seg, o1 = o0 + 8; const int e0 = se0 & 16383, e1 = se1 & 16383; const float cw0 = w0, cw1 = w1;
        const float iu0 = ISU[e0], iv0 = ISV[e0], iu1 = ISU[e1], iv1 = ISV[e1]; float s0 = 0.f, s1 = 0.f;
#pragma unroll
        for (int db = 0; db < 16; ++db) { const unsigned w = pw[db]; s0 += __builtin_bit_cast(float, w << 16); s1 += __builtin_bit_cast(float, w & 0xffff0000u); }
        if (i + c.ngt < iend) PC_LOAD(i + c.ngt);
        C[o0] = (bf16_t)(cvt_pk_bf16(cw0 * gelu_tanh(s0 * iu0) * iv0, 0.f) & 0xffffu);
        C[o1] = (bf16_t)(cvt_pk_bf16(cw1 * gelu_tanh(s1 * iu1) * iv1, 0.f) & 0xffffu); }
#undef PC_LOAD
}
__device__ __forceinline__ void phase_peer_v(KP P, const Ctx& c, int layer, int row_lo, int qrep) {
    const unsigned short* SE = (const unsigned short*)(P->ws + P_SE16); const bf16_t* C = (const bf16_t*)(P->ws + P_C);
    const unsigned char* V = P->ws + WS_PV + (size_t)layer * 16384 * D; bf16_t* Y = (bf16_t*)(P->ws + P_Y);
    PEER_QUEUE_BEGIN(layer * 2 + 1 + 8 * qrep, row_lo / 8, T / 8)
        int lane = c.lane; asm volatile("" : "+v"(lane));
        const int ts = lane >> 3, seg = lane & 7, t = tg * 8 + ts;
        const unsigned short* se = SE + (size_t)t * 128; const bf16_t* cp = C + (size_t)t * 128; const unsigned char* vb = V + (size_t)db * 16384 * 128; const unsigned seg16 = (unsigned)seg * 16u;
        float acc[16];
#pragma unroll
        for (int e = 0; e < 16; ++e) acc[e] = 0.f;
        u32x4 en[2];
#pragma unroll
        for (int i = 0; i < 2; ++i) en[i] = *(const u32x4*)(se + 8 * i);
#pragma unroll 1
        for (int q = 0; q < 8; ++q) { u32x4 ec[2];
#pragma unroll
          for (int i = 0; i < 2; ++i) ec[i] = en[i];
          if (q < 7) {
#pragma unroll
            for (int i = 0; i < 2; ++i) en[i] = *(const u32x4*)(se + 16 * (q + 1) + 8 * i); }
          const u32x4 c0 = *(const u32x4*)(cp + 16 * q), c1 = *(const u32x4*)(cp + 16 * q + 8);
          u32x4 g[16];
#pragma unroll
          for (int k = 0; k < 16; ++k) { const unsigned w_ = ec[k >> 3][(k >> 1) & 3]; const unsigned e = ((k & 1) ? (w_ >> 16) : w_) & 16383u; g[k] = *(const u32x4*)(vb + (unsigned)((e << 7) | seg16)); }
#pragma unroll
          for (int k = 0; k < 16; k += 2) { const unsigned cwu = (k < 8 ? c0 : c1)[(k >> 1) & 3]; const bf16v2 cw = __builtin_bit_cast(bf16v2, cwu);
#pragma unroll
              for (int w = 0; w < 4; ++w) { const unsigned g0 = g[k][w], g1 = g[k + 1][w];
                  const int pa = (int)__builtin_amdgcn_perm(g1, g0, 0x05010400u), pb = (int)__builtin_amdgcn_perm(g1, g0, 0x07030602u);
                  acc[4 * w + 0] = __builtin_amdgcn_fdot2_f32_bf16(__builtin_amdgcn_cvt_scalef32_pk_bf16_fp8(pa, 1.0f, false), cw, acc[4 * w + 0], false);
                  acc[4 * w + 1] = __builtin_amdgcn_fdot2_f32_bf16(__builtin_amdgcn_cvt_scalef32_pk_bf16_fp8(pa, 1.0f, true), cw, acc[4 * w + 1], false);
                  acc[4 * w + 2] = __builtin_amdgcn_fdot2_f32_bf16(__builtin_amdgcn_cvt_scalef32_pk_bf16_fp8(pb, 1.0f, false), cw, acc[4 * w + 2], false);
                  acc[4 * w + 3] = __builtin_amdgcn_fdot2_f32_bf16(__builtin_amdgcn_cvt_scalef32_pk_bf16_fp8(pb, 1.0f, true), cw, acc[4 * w + 3], false); } } }
        bf16_t* yp = Y + (size_t)t * D + db * 128 + seg * 16;
#pragma unroll
        for (int q = 0; q < 2; ++q) *(u32x4*)(yp + 8 * q) = (u32x4){cvt_pk_bf16(acc[8 * q], acc[8 * q + 1]), cvt_pk_bf16(acc[8 * q + 2], acc[8 * q + 3]), cvt_pk_bf16(acc[8 * q + 4], acc[8 * q + 5]), cvt_pk_bf16(acc[8 * q + 6], acc[8 * q + 7])};
    PEER_QUEUE_END
}
template <bool LAST>
__device__ __forceinline__ void phase_peer_final(KP P, const Ctx& c, int layer) {
    const bf16_t* Y = (const bf16_t*)(P->ws + P_Y); bf16_t* X = (bf16_t*)(P->ws + WS_X); bf16_t* A0 = (bf16_t*)(P->ws + WS_A0);
    const float* lg = P->in[I_LNG] + (size_t)(layer * 2 + 1) * D; const float* lb = P->in[I_LNB] + (size_t)(layer * 2 + 1) * D;
    const float ymul = ((DBG_ZERO >> (2 * layer + 1)) & 1) ? 0.f : 1.f;
    u32x2 xn[8]; u32x2 yn[8];
    { const int r0 = (LAST ? NCTX : 0) + c.gw; if (r0 < T) {
#pragma unroll
        for (int j = 0; j < 8; ++j) { xn[j] = *(const u32x2*)(X + (size_t)r0 * D + c.lane * 4 + 256 * j); yn[j] = *(const u32x2*)(Y + (size_t)r0 * D + c.lane * 4 + 256 * j); } } }
    for (int row = (LAST ? NCTX : 0) + c.gw; row < T; row += c.ngw) {
        int l4 = c.lane * 4; asm volatile("" : "+v"(l4));
        const int v = row_vec(row); const float* m5 = modp(P, layer, v, 5) + l4;
        f32x4 x[8]; float s = 0.f;
#pragma unroll
        for (int j = 0; j < 8; ++j) { const u32x2 yb = yn[j]; const f32x4 yv = (f32x4){bflo(yb.x), bfhi(yb.x), bflo(yb.y), bfhi(yb.y)};
            const unsigned x0 = xn[j].x, x1 = xn[j].y;
            x[j] = (f32x4){bflo(x0), bfhi(x0), bflo(x1), bfhi(x1)} * ALPHA + *(const f32x4*)(m5 + 256 * j) * (yv * ymul); s += (x[j][0] + x[j][1]) + (x[j][2] + x[j][3]); }
        if (row + c.ngw < T) {
#pragma unroll
            for (int j = 0; j < 8; ++j) { xn[j] = *(const u32x2*)(X + (size_t)(row + c.ngw) * D + l4 + 256 * j); yn[j] = *(const u32x2*)(Y + (size_t)(row + c.ngw) * D + l4 + 256 * j); } }
        const float mean = wave_sum(s) * (1.0f / D); float q = 0.f;
#pragma unroll
        for (int j = 0; j < 8; ++j) { x[j] = x[j] - mean; q += (x[j][0] * x[j][0] + x[j][1] * x[j][1]) + (x[j][2] * x[j][2] + x[j][3] * x[j][3]); }
        const float rstd = rsqrtf(wave_sum(q) * (1.0f / D) + LN_EPS);
        const bool mk_a0 = !LAST && layer != 0;
#pragma unroll
        for (int jh = 0; jh < 2; ++jh) { f32x4 g4[4], b4[4], p4[4], q4[4];
#pragma unroll
            for (int jj = 0; jj < 4; ++jj) { const int o = l4 + 256 * (4 * jh + jj); g4[jj] = *(const f32x4*)(lg + o); b4[jj] = *(const f32x4*)(lb + o);
                if (mk_a0) { p4[jj] = *(const f32x4*)(modp(P, layer + 1, v, 1) + o); q4[jj] = *(const f32x4*)(modp(P, layer + 1, v, 0) + o); } }
#pragma unroll
            for (int jj = 0; jj < 4; ++jj) { const int j = 4 * jh + jj, o = l4 + 256 * j; const f32x4 y = x[j] * rstd * g4[jj] + b4[jj];
                if (LAST) { *(f32x4*)(P->out + (size_t)(row - NCTX) * D + o) = y; }
                else { *(u32x2*)(X + (size_t)row * D + o) = (u32x2){cvt_pk_bf16(y[0], y[1]), cvt_pk_bf16(y[2], y[3])};
                    if (mk_a0) { const f32x4 hv = y * (p4[jj] + 1.0f) + q4[jj];
                        *(u32x2*)(A0 + (size_t)row * D + o) = (u32x2){cvt_pk_bf16(hv[0], hv[1]), cvt_pk_bf16(hv[2], hv[3])}; } } } }
    }
}

__device__ __forceinline__ void phase_rw_mix(KP P, const Ctx& c, int layer) {
    const bf16_t* X = (const bf16_t*)(P->ws + WS_X); bf16_t* AALL = (bf16_t*)(P->ws + L_AALL); const float* mu = P->in[I_RWMU];
    float mu8[6][8];
    { const int c8 = (int)(c.gtid & 255) * 8;
#pragma unroll
      for (int m = 0; m < 6; ++m) { const f32x4 a = *(const f32x4*)(mu + m * D + c8), b = *(const f32x4*)(mu + m * D + c8 + 4);
#pragma unroll
          for (int j = 0; j < 4; ++j) { mu8[m][j] = a[j]; mu8[m][4 + j] = b[j]; } } }
    const int c8 = (int)(c.gtid & 255) * 8;
    u32x4 nx, nn; f32x4 nsh0, nsh1, nsc0, nsc1; int nnb;
#define MX_LOAD(i_) do { const int row_ = (int)((i_) >> 8); const int v_ = row_vec(row_); int nb_ = -1;     \
        if (row_ < NCTX) { const int t_ = row_ & (CTX - 1); if (c8 < 1024) { if (t_ > 0) nb_ = row_ - 1; } else { if (t_ < CTX - 1) nb_ = row_ + 1; } } \
        else { const int t_ = (row_ - NCTX) & (SEQ - 1), qd_ = c8 >> 9; \
            if (qd_ == 0) { if ((t_ & 63) != 0) nb_ = row_ - 1; } else if (qd_ == 1) { if ((t_ & 63) != 63) nb_ = row_ + 1; } \
            else if (qd_ == 2) { if (t_ >= 64) nb_ = row_ - 64; } else { if (t_ < SEQ - 64) nb_ = row_ + 64; } } \
        nx = *(const u32x4*)(X + (size_t)row_ * D + c8); nnb = nb_; \
        if (nb_ >= 0) nn = *(const u32x4*)(X + (size_t)nb_ * D + c8); \
        const float* sh_ = modp(P, layer, v_, 0) + c8; const float* sc_ = modp(P, layer, v_, 1) + c8; \
        nsh0 = *(const f32x4*)sh_; nsh1 = *(const f32x4*)(sh_ + 4); nsc0 = *(const f32x4*)sc_; nsc1 = *(const f32x4*)(sc_ + 4); } while (0)
    if ((size_t)c.gtid < TD / 8) MX_LOAD((size_t)c.gtid);
    for (size_t i = c.gtid; i < TD / 8; i += c.ngt) { const int row = (int)(i >> 8);
        float h[8], xx[8];
        { const int nb = nnb; float xv[8], nv[8]; unpack8(nx, xv); unpack8(nn, nv);
#pragma unroll
          for (int j = 0; j < 8; ++j) { const float scj = 1.0f + (j < 4 ? nsc0[j & 3] : nsc1[j & 3]), shj = j < 4 ? nsh0[j & 3] : nsh1[j & 3];
              h[j] = xv[j] * scj + shj;
              const float sv = nb >= 0 ? nv[j] * scj + shj : 0.f; xx[j] = sv - h[j]; } }
        if (i + c.ngt < TD / 8) MX_LOAD(i + c.ngt);
#pragma unroll
        for (int m = 0; m < 6; ++m) { float o[8];
#pragma unroll
            for (int j = 0; j < 8; ++j) o[j] = h[j] + xx[j] * mu8[m][j];
            *(u32x4*)(AALL + (size_t)row * (6 * D) + m * D + c8) = (u32x4){cvt_pk_bf16(o[0], o[1]), cvt_pk_bf16(o[2], o[3]), cvt_pk_bf16(o[4], o[5]), cvt_pk_bf16(o[6], o[7])}; } }
#undef MX_LOAD
}
__device__ __forceinline__ void phase_rw_scan(KP P, const Ctx& c) {
    const bf16_t* R = (const bf16_t*)(P->ws + L_RKV); const bf16_t* Kx = R + TD; const bf16_t* Vx = R + 2 * TD;
    const bf16_t* W = (const bf16_t*)(P->ws + L_W); const bf16_t* AD = (const bf16_t*)(P->ws + L_AD);
    LAS float* rL = (LAS float*)c.lds; LAS float* wL = rL + 4096; LAS float* kkL = rL + 8192; LAS float* bL = rL + 12288; LAS float* kdL = rL + 16384; LAS float* vL = rL + 20480; LAS float* yL = rL + 24576; LAS float* scL = rL + 28672;
    const int tok = c.tid >> 3, cq = c.tid & 7;
    for (int chain = blockIdx.x; chain < 256; chain += gridDim.x) {
        const int b = chain >> 6, hd = (chain >> 1) & 31, dir = chain & 1;
        bf16_t* Y = (bf16_t*)(P->ws + (dir ? L_Y1 : L_Y0));
        const int ch0 = hd * 64 + cq * 8;
        float kkw[8], kaw[8];
#pragma unroll
        for (int j = 0; j < 8; ++j) { kkw[j] = P->in[I_RWKK][ch0 + j]; kaw[j] = P->in[I_RWKA][ch0 + j]; }
        float s[8] = {0.f, 0.f, 0.f, 0.f, 0.f, 0.f, 0.f, 0.f};
        u32x4 gr, gk, gv, gw, ga;
#define RW_GLOAD(ck) do { const int row_ = seq_row(b, dir, (ck) * 64 + tok); gr = *(const u32x4*)(R + (size_t)row_ * D + ch0); gk = *(const u32x4*)(Kx + (size_t)row_ * D + ch0); gv = *(const u32x4*)(Vx + (size_t)row_ * D + ch0); \
        gw = *(const u32x4*)(W + ((size_t)row_ * 2 + dir) * D + ch0); ga = *(const u32x4*)(AD + ((size_t)row_ * 2 + dir) * D + ch0); } while (0)
        RW_GLOAD(0);
        for (int ck = 0; ck < SLEN / 64; ++ck) {
            const int row = seq_row(b, dir, ck * 64 + tok);
            float r8[8], k8[8], v8[8], w8[8], a8[8];
            unpack8(gr, r8); unpack8(gk, k8); unpack8(gv, v8); unpack8(gw, w8); unpack8(ga, a8);
            float kx[8], ss = 0.f;
#pragma unroll
            for (int j = 0; j < 8; ++j) { kx[j] = k8[j] * kkw[j]; ss += kx[j] * kx[j]; }
            ss = sum8(ss);
            const float rn = rsqrtf(ss + 1e-12f);
            __syncthreads();
            float pbr = 0.f, pkr = 0.f;
            {   float wr_[8], kk_[8], b_[8], kd_[8];
#pragma unroll
                for (int j = 0; j < 8; ++j) { kk_[j] = kx[j] * rn; b_[j] = kk_[j] * a8[j]; kd_[j] = k8[j] * (1.0f + (a8[j] - 1.0f) * kaw[j]); wr_[j] = w8[j] * r8[j]; pbr += b_[j] * r8[j]; pkr += kd_[j] * r8[j]; }
                const int o = tok * 64 + cq * 8;
#pragma unroll
                for (int hh = 0; hh < 2; ++hh) { const int q = 4 * hh;
                    *(LAS f32x4*)(rL + o + q) = (f32x4){wr_[q], wr_[q + 1], wr_[q + 2], wr_[q + 3]}; *(LAS f32x4*)(wL + o + q) = (f32x4){w8[q], w8[q + 1], w8[q + 2], w8[q + 3]};
                    *(LAS f32x4*)(kkL + o + q) = (f32x4){kk_[q], kk_[q + 1], kk_[q + 2], kk_[q + 3]}; *(LAS f32x4*)(bL + o + q) = (f32x4){b_[q], b_[q + 1], b_[q + 2], b_[q + 3]};
                    *(LAS f32x4*)(kdL + o + q) = (f32x4){kd_[q], kd_[q + 1], kd_[q + 2], kd_[q + 3]}; *(LAS f32x4*)(vL + o + q) = (f32x4){v8[q], v8[q + 1], v8[q + 2], v8[q + 3]}; } }
            pbr = sum8(pbr); pkr = sum8(pkr);
            if (cq == 0) *(LAS f32x2*)(scL + tok * 2) = (f32x2){pbr, pkr};
            __syncthreads();
            if (ck + 1 < SLEN / 64) RW_GLOAD(ck + 1);
            f32x4 kaA, kbA, waA, wbA, baA, bbA, daA, dbA, raA, rbA, kaB, kbB, waB, wbB, baB, bbB, daB, dbB, raB, rbB; float vvA, vvB; f32x2 scA, scB;
#define RW_LLOAD(X, tk_) do { const int o_ = (tk_) * 64 + cq * 8; ka##X = *(const LAS f32x4*)(kkL + o_); kb##X = *(const LAS f32x4*)(kkL + o_ + 4); wa##X = *(const LAS f32x4*)(wL + o_); wb##X = *(const LAS f32x4*)(wL + o_ + 4); \
                ba##X = *(const LAS f32x4*)(bL + o_); bb##X = *(const LAS f32x4*)(bL + o_ + 4); da##X = *(const LAS f32x4*)(kdL + o_); db##X = *(const LAS f32x4*)(kdL + o_ + 4); ra##X = *(const LAS f32x4*)(rL + o_); rb##X = *(const LAS f32x4*)(rL + o_ + 4); \
                vv##X = vL[(tk_) * 64 + tok]; sc##X = *(const LAS f32x2*)(scL + (tk_) * 2); } while (0)
#define RW_STEP(X, tk_) do { \
                float sa = (fma_s(s[0], ka##X[0], mul_s(s[1], ka##X[1])) + fma_s(s[2], ka##X[2], mul_s(s[3], ka##X[3]))) + (fma_s(s[4], kb##X[0], mul_s(s[5], kb##X[1])) + fma_s(s[6], kb##X[2], mul_s(s[7], kb##X[3]))); \
                float yd = (fma_s(s[0], ra##X[0], mul_s(s[1], ra##X[1])) + fma_s(s[2], ra##X[2], mul_s(s[3], ra##X[3]))) + (fma_s(s[4], rb##X[0], mul_s(s[5], rb##X[1])) + fma_s(s[6], rb##X[2], mul_s(s[7], rb##X[3]))); \
                sum8_pair(sa, yd); \
                const float nsa = -sa; \
                _Pragma("unroll") for (int j2 = 0; j2 < 4; ++j2) { s[j2] = fma_s(vv##X, da##X[j2], fma_s(nsa, ba##X[j2], mul_s(s[j2], wa##X[j2]))); s[4 + j2] = fma_s(vv##X, db##X[j2], fma_s(nsa, bb##X[j2], mul_s(s[4 + j2], wb##X[j2]))); } \
                if (cq == 0) yL[(tk_) * 64 + tok] = yd - sa * sc##X[0] + vv##X * sc##X[1]; } while (0)
            RW_LLOAD(A, 0);
#pragma unroll 1
            for (int tk = 0; tk < 64; tk += 2) {
                RW_LLOAD(B, tk + 1);
                RW_STEP(A, tk);
                RW_LLOAD(A, (tk + 2) & 63);
                RW_STEP(B, tk + 1);
            }
#undef RW_STEP
#undef RW_LLOAD
            __syncthreads();
            { const f32x4 ya = *(const LAS f32x4*)(yL + tok * 64 + cq * 8), yb = *(const LAS f32x4*)(yL + tok * 64 + cq * 8 + 4);
              *(u32x4*)(Y + (size_t)row * D + ch0) = (u32x4){cvt_pk_bf16(ya[0], ya[1]), cvt_pk_bf16(ya[2], ya[3]), cvt_pk_bf16(yb[0], yb[1]), cvt_pk_bf16(yb[2], yb[3])}; }
        }
#undef RW_GLOAD
        __syncthreads();
    }
}
__device__ __forceinline__ void phase_rw_finish(KP P, const Ctx& c) {
    const bf16_t* R = (const bf16_t*)(P->ws + L_RKV); const bf16_t* Kx = R + TD; const bf16_t* Vx = R + 2 * TD;
    const bf16_t* AD = (const bf16_t*)(P->ws + L_AD); const bf16_t* G = (const bf16_t*)(P->ws + L_G);
    const bf16_t* Y0 = (const bf16_t*)(P->ws + L_Y0); const bf16_t* Y1 = (const bf16_t*)(P->ws + L_Y1); bf16_t* Z = (bf16_t*)(P->ws + L_Z);
    const int ch = c.lane * 8 + 512 * (c.gw & 3);
    float ka8[8], rk8[8], gg8[8], gb8[8];
#pragma unroll
    for (int e = 0; e < 8; ++e) { ka8[e] = P->in[I_RWKA][ch + e]; rk8[e] = P->in[I_RWRK][ch + e]; gg8[e] = P->in[I_RWGNG][ch + e]; gb8[e] = P->in[I_RWGNB][ch + e]; }
    u32x4 ny0, ny1, nr, nk, nv, na0, na1, ng;
#define RF_LOAD(k_) do { const int row_ = (k_) >> 2; const size_t o_ = (size_t)row_ * D + ch; ny0 = *(const u32x4*)(Y0 + o_); ny1 = *(const u32x4*)(Y1 + o_); nr = *(const u32x4*)(R + o_); nk = *(const u32x4*)(Kx + o_); \
        nv = *(const u32x4*)(Vx + o_); na0 = *(const u32x4*)(AD + ((size_t)row_ * 2 + 0) * D + ch); na1 = *(const u32x4*)(AD + ((size_t)row_ * 2 + 1) * D + ch); ng = *(const u32x4*)(G + o_); } while (0)
    if (c.gw < T * 4) RF_LOAD(c.gw);
    for (int k = c.gw; k < T * 4; k += c.ngw) { const size_t o = (size_t)(k >> 2) * D + ch;
            float y[8]; { float ya_[8], yb_[8]; unpack8(ny0, ya_); unpack8(ny1, yb_);
#pragma unroll
                for (int e = 0; e < 8; ++e) y[e] = ya_[e] + yb_[e]; }
            float r8[8], k8[8], v8[8], a0[8], a1[8], g8[8];
            unpack8(nr, r8); unpack8(nk, k8); unpack8(nv, v8); unpack8(na0, a0); unpack8(na1, a1); unpack8(ng, g8);
            if (k + c.ngw < T * 4) RF_LOAD(k + c.ngw);
            float s = 0.f;
#pragma unroll
            for (int e = 0; e < 8; ++e) s += y[e];
            const float mean = sum8(s) * (1.0f / 64.0f); float q = 0.f;
#pragma unroll
            for (int e = 0; e < 8; ++e) { y[e] -= mean; q += y[e] * y[e]; }
            const float rstd = rsqrtf(sum8(q) * (1.0f / 64.0f) + 64e-5f);
            float bsum = 0.f;
#pragma unroll
            for (int e = 0; e < 8; ++e) { const float ka = ka8[e], rk = rk8[e];
                const float kd0 = k8[e] * (1.0f + (a0[e] - 1.0f) * ka), kd1 = k8[e] * (1.0f + (a1[e] - 1.0f) * ka); bsum += r8[e] * (kd0 + kd1) * rk; }
            bsum = sum8(bsum);
            float z[8];
#pragma unroll
            for (int e = 0; e < 8; ++e) z[e] = (y[e] * rstd * gg8[e] + gb8[e] + bsum * v8[e]) * g8[e];
            *(u32x4*)(Z + o) = (u32x4){cvt_pk_bf16(z[0], z[1]), cvt_pk_bf16(z[2], z[3]), cvt_pk_bf16(z[4], z[5]), cvt_pk_bf16(z[6], z[7])}; }
#undef RF_LOAD
}

__device__ __forceinline__ bf16x8 frag16(const LAS unsigned char* p) { return *(const LAS bf16x8*)p; }
__device__ __forceinline__ void phase_ret_scan(KP P, const Ctx& c) {
    const bf16_t* Q = (const bf16_t*)(P->ws + L_RQ); const bf16_t* Kx = (const bf16_t*)(P->ws + L_RK); const bf16_t* Vx = (const bf16_t*)(P->ws + L_RV);
    constexpr int QP = 528, TP = 144, VP = 272;
    constexpr int OFF_Q = 0, OFF_K = 33792, OFF_KT = 67584, OFF_VT = 104448, OFF_P = 122880;
    LAS unsigned char* L = c.lds;
    const int w = c.wave;
    for (int un = blockIdx.x; un < 256; un += gridDim.x) {
        const int b = un >> 6, h = (un >> 3) & 7, dir = (un >> 2) & 1, dvs = un & 3;
        bf16_t* O = (bf16_t*)(P->ws + (dir ? L_OB : L_OF));
        int tid = c.tid;
        const float gamma = 1.0f - exp2f(-5.0f - (float)h), lg2 = log2f(gamma), g63 = exp2f(63.0f * lg2);
        f32x4 Racc[16];
#pragma unroll
        for (int i = 0; i < 16; ++i) Racc[i] = (f32x4){0.f, 0.f, 0.f, 0.f};
        u32x4 pq[4], pv[2];
#define RET_LOAD_QV(ck) do { \
        _Pragma("unroll") for (int i = 0; i < 4; ++i) { const int id = tid + 512 * i, s_ = id >> 5, dc = id & 31; \
            pq[i] = *(const u32x4*)(Q + (size_t)seq_row(b, dir, (ck) * 64 + s_) * D + h * 256 + dc * 8); } \
        _Pragma("unroll") for (int i = 0; i < 2; ++i) { const int id = tid + 512 * i, s_ = id >> 4, ec = id & 15; \
            pv[i] = *(const u32x4*)(Vx + (size_t)seq_row(b, dir, (ck) * 64 + s_) * 4096 + h * 512 + dvs * 128 + ec * 8); } } while (0)
#define RET_LOAD_K(ck, dst) do { \
        _Pragma("unroll") for (int i = 0; i < 4; ++i) { const int id = tid + 512 * i, s_ = id >> 5, dc = id & 31; \
            dst[i] = *(const u32x4*)(Kx + (size_t)seq_row(b, dir, (ck) * 64 + s_) * D + h * 256 + dc * 8); } } while (0)
#define RET_STORE_K(src) do { \
        _Pragma("unroll") for (int i = 0; i < 4; ++i) { const int id = tid + 512 * i, s_ = id >> 5, dc = id & 31; *(LAS u32x4*)(L + OFF_K + s_ * QP + dc * 16) = src[i]; } } while (0)
        RET_LOAD_QV(0);
        { u32x4 pk0[4]; RET_LOAD_K(0, pk0); __syncthreads(); RET_STORE_K(pk0); }
        for (int ck = 0; ck < SLEN / 64; ++ck) {
            asm volatile("" : "+v"(tid));
            const int lane = tid & 63, r16 = lane & 15, q4 = lane >> 4;
            __syncthreads();
#pragma unroll
            for (int i = 0; i < 4; ++i) { const int id = tid + 512 * i, s_ = id >> 5, dc = id & 31; *(LAS u32x4*)(L + OFF_Q + s_ * QP + dc * 16) = pq[i]; }
#pragma unroll
            for (int i = 0; i < 2; ++i) { const int id = tid + 512 * i, s_ = id >> 4, ec = id & 15; *(LAS u32x4*)(L + OFF_P + s_ * VP + ec * 16) = pv[i]; }
            __syncthreads();
            if (ck + 1 < SLEN / 64) RET_LOAD_QV(ck + 1);
            {   const float vs = exp2f(-lg2 * (float)lane);
#pragma unroll
                for (int i = 0; i < 4; ++i) { const int dc = w + 8 * i;
                    const u32x4 raw = *(const LAS u32x4*)(L + OFF_K + lane * QP + dc * 16);
#pragma unroll
                    for (int e = 0; e < 4; ++e) { *(LAS unsigned short*)(L + OFF_KT + (dc * 8 + 2 * e) * TP + lane * 2) = (unsigned short)(raw[e] & 0xffffu); *(LAS unsigned short*)(L + OFF_KT + (dc * 8 + 2 * e + 1) * TP + lane * 2) = (unsigned short)(raw[e] >> 16); } }
#pragma unroll
                for (int i = 0; i < 2; ++i) { const int ec = w + 8 * i; float t8[8]; unpack8(*(const LAS u32x4*)(L + OFF_P + lane * VP + ec * 16), t8);
#pragma unroll
                    for (int e = 0; e < 4; ++e) { const unsigned pk2 = cvt_pk_bf16(t8[2 * e] * vs, t8[2 * e + 1] * vs);
                        *(LAS unsigned short*)(L + OFF_VT + (ec * 8 + 2 * e) * TP + lane * 2) = (unsigned short)(pk2 & 0xffffu); *(LAS unsigned short*)(L + OFF_VT + (ec * 8 + 2 * e + 1) * TP + lane * 2) = (unsigned short)(pk2 >> 16); } } }
            const int it_s = w >> 1, jt0 = 2 * (w & 1);
            f32x4 s0 = (f32x4){0.f, 0.f, 0.f, 0.f}, s1 = s0;
#pragma unroll
            for (int ks = 0; ks < 8; ++ks) { const int co = (32 * ks + 8 * q4) * 2; if ((ks & 1) == 0) asm volatile("" ::: "memory");
                const bf16x8 qf = frag16(L + OFF_Q + (16 * it_s + r16) * QP + co), k0 = frag16(L + OFF_K + (16 * jt0 + r16) * QP + co), k1 = frag16(L + OFF_K + (16 * jt0 + 16 + r16) * QP + co);
                s0 = __builtin_amdgcn_mfma_f32_16x16x32_bf16(k0, qf, s0, 0, 0, 0); s1 = __builtin_amdgcn_mfma_f32_16x16x32_bf16(k1, qf, s1, 0, 0, 0); }
            __syncthreads();
            {   const int i_ = 16 * it_s + r16; const float gi = exp2f(lg2 * (float)i_);
                const int j0 = 16 * jt0 + 4 * q4, j1 = j0 + 16; float p0[4], p1[4];
#pragma unroll
                for (int r = 0; r < 4; ++r) { p0[r] = (j0 + r <= i_) ? s0[r] * gi : 0.f; p1[r] = (j1 + r <= i_) ? s1[r] * gi : 0.f; }
                *(LAS u32x2*)(L + OFF_P + i_ * TP + j0 * 2) = (u32x2){cvt_pk_bf16(p0[0], p0[1]), cvt_pk_bf16(p0[2], p0[3])};
                *(LAS u32x2*)(L + OFF_P + i_ * TP + j1 * 2) = (u32x2){cvt_pk_bf16(p1[0], p1[1]), cvt_pk_bf16(p1[2], p1[3])}; }
            __syncthreads();
            u32x4 pkn[4]; const bool has_next = ck + 1 < SLEN / 64;
            if (has_next) RET_LOAD_K(ck + 1, pkn);
            const LAS unsigned char* vtp = L + OFF_VT + (16 * w + r16) * TP + (8 * q4) * 2;
#pragma unroll
            for (int it = 0; it < 4; ++it) { const int i_ = 16 * it + r16; f32x4 a = (f32x4){0.f, 0.f, 0.f, 0.f};
                asm volatile("" ::: "memory");
#pragma unroll
                for (int m = 0; m < 8; ++m) {
                    const u32x4 t = (u32x4){cvt_pk_bf16(Racc[2 * m][0], Racc[2 * m][1]), cvt_pk_bf16(Racc[2 * m][2], Racc[2 * m][3]), cvt_pk_bf16(Racc[2 * m + 1][0], Racc[2 * m + 1][1]), cvt_pk_bf16(Racc[2 * m + 1][2], Racc[2 * m + 1][3])};
                    const LAS unsigned char* qp = L + OFF_Q + i_ * QP + (32 * m + 4 * q4) * 2; const u32x2 lo = *(const LAS u32x2*)qp, hi = *(const LAS u32x2*)(qp + 32);
                    const u32x4 tq = (u32x4){lo.x, lo.y, hi.x, hi.y}; a = __builtin_amdgcn_mfma_f32_16x16x32_bf16(__builtin_bit_cast(bf16x8, t), __builtin_bit_cast(bf16x8, tq), a, 0, 0, 0); }
                a = a * exp2f(lg2 * (float)(i_ + 1));
#pragma unroll
                for (int ks = 0; ks < 2; ++ks) a = __builtin_amdgcn_mfma_f32_16x16x32_bf16(frag16(vtp + 64 * ks), frag16(L + OFF_P + i_ * TP + (32 * ks + 8 * q4) * 2), a, 0, 0, 0);
                *(u32x2*)(O + (size_t)seq_row(b, dir, ck * 64 + i_) * 4096 + h * 512 + dvs * 128 + 16 * w + 4 * q4) = (u32x2){cvt_pk_bf16(a[0], a[1]), cvt_pk_bf16(a[2], a[3])}; }
            if (has_next) RET_STORE_K(pkn);
#pragma unroll
            for (int dt = 0; dt < 16; ++dt) { if ((dt & 1) == 0) asm volatile("" ::: "memory");
                f32x4 u = Racc[dt] * gamma;
#pragma unroll
                for (int ks = 0; ks < 2; ++ks) u = __builtin_amdgcn_mfma_f32_16x16x32_bf16(frag16(L + OFF_KT + (16 * dt + r16) * TP + (32 * ks + 8 * q4) * 2), frag16(vtp + 64 * ks), u, 0, 0, 0);
                Racc[dt] = u * g63; }
        }
#undef RET_LOAD_QV
#undef RET_LOAD_K
#undef RET_STORE_K
        __syncthreads();
    }
}
__device__ __forceinline__ void phase_ret_merge(KP P, const Ctx& c) {
    const bf16_t* OF = (const bf16_t*)(P->ws + L_OF); const bf16_t* OB = (const bf16_t*)(P->ws + L_OB); const bf16_t* GF = (const bf16_t*)(P->ws + L_GF); const bf16_t* GB = (const bf16_t*)(P->ws + L_GB);
    bf16_t* Z = (bf16_t*)(P->ws + L_RZ);
    u32x4 nf, nb, ngf, ngb;
#define RM_LOAD(k_) do { const size_t o_ = (size_t)(k_) * 512 + c.lane * 8; nf = *(const u32x4*)(OF + o_); nb = *(const u32x4*)(OB + o_); ngf = *(const u32x4*)(GF + o_); ngb = *(const u32x4*)(GB + o_); } while (0)
    if (c.gw < T * 8) RM_LOAD(c.gw);
    for (int k = c.gw; k < T * 8; k += c.ngw) { const size_t o = (size_t)k * 512 + c.lane * 8;
            float f[8], bk[8], gf[8], gb[8]; unpack8(nf, f); unpack8(nb, bk); unpack8(ngf, gf); unpack8(ngb, gb);
            if (k + c.ngw < T * 8) RM_LOAD(k + c.ngw);
            float sf = 0.f, sb = 0.f;
#pragma unroll
            for (int e = 0; e < 8; ++e) { sf += f[e]; sb += bk[e]; }
            const float mf = wave_sum(sf) * (1.0f / 512.0f), mb = wave_sum(sb) * (1.0f / 512.0f); float qf = 0.f, qb = 0.f;
#pragma unroll
            for (int e = 0; e < 8; ++e) { f[e] -= mf; bk[e] -= mb; qf += f[e] * f[e]; qb += bk[e] * bk[e]; }
            const float rf = rsqrtf(wave_sum(qf) * (1.0f / 512.0f) + LN_EPS), rb = rsqrtf(wave_sum(qb) * (1.0f / 512.0f) + LN_EPS);
            float z[8];
#pragma unroll
            for (int e = 0; e < 8; ++e) z[e] = gf[e] * (f[e] * rf) + gb[e] * (bk[e] * rb);
            *(u32x4*)(Z + o) = (u32x4){cvt_pk_bf16(z[0], z[1]), cvt_pk_bf16(z[2], z[3]), cvt_pk_bf16(z[4], z[5]), cvt_pk_bf16(z[6], z[7])}; }
#undef RM_LOAD
}

__device__ __forceinline__ Ctx make_ctx(LAS unsigned char* lds) {
    int t = threadIdx.x; asm volatile("" : "+v"(t));
    Ctx c; c.lds = lds; c.tid = t; c.lane = t & 63; c.wave = __builtin_amdgcn_readfirstlane(t >> 6);
    c.gw = blockIdx.x * 8 + c.wave; c.ngw = gridDim.x * 8; c.gtid = blockIdx.x * 512 + t; c.ngt = gridDim.x * 512; return c;
}
#define GRID_BAR() xcd_barrier(bar)
template <class Epi, class GT> __device__ __forceinline__ void run_gemm_m(LAS unsigned char* lds, const GT& g, int M, int N, const Epi& E) {
    pg8::StaticOrder S; S.init(M, N, (int)gridDim.x, (int)blockIdx.x); pg8::gemm_phase<Epi, GT>(lds, g, S, E);
}
template <class Epi, class GT> __device__ __forceinline__ void run_gemm(LAS unsigned char* lds, const GT& g, int N, const Epi& E, int pm0 = 0) {
    pg8::StaticOrder S; S.init(T, N, (int)gridDim.x, (int)blockIdx.x, pm0); pg8::gemm_phase<Epi, GT>(lds, g, S, E);
}
template <int LAYER, bool LAST> __device__ __forceinline__ void peer_phases(LAS unsigned char* lds, const XcdBarrier& bar) {
    phase_ln_mid(kp_fresh(), make_ctx(lds), LAYER, LAST ? NCTX : 0); GRID_BAR();
    PROBE_REP(2) { KP P = kp_fresh(); unsigned char* ws = P->ws; GPlain g{(const bf16_t*)(ws + WS_H2), (const bf16_t*)(ws + WS_WQ) + (size_t)LAYER * D * D, D, D, D}; EpiF32Plain E{(float*)(ws + WS_S), D}; run_gemm(lds, g, D, E, LAST ? 4 : 0);
        if (!LAST && _rep == 0) { constexpr int NR = 8 * 16384, SH = (NR + 2) / 3; const int lo = LAYER * SH, hi = (LAYER == 2) ? NR : (LAYER + 1) * SH;
            if ((int)gridDim.x == 256) { if ((int)blockIdx.x >= 32) peer_convert_rows(kp_fresh(), make_ctx(lds), lo, hi, (int)blockIdx.x - 32, 224); }
            else peer_convert_rows(kp_fresh(), make_ctx(lds), lo, hi, (int)blockIdx.x, (int)gridDim.x); }
        GRID_BAR(); }
    PROBE_REP(1) { phase_peer_select(kp_fresh(), make_ctx(lds), LAST ? NCTX : 0); GRID_BAR(); }
    PROBE_REP(0) { phase_peer_u(kp_fresh(), make_ctx(lds), LAYER, LAST ? NCTX : 0, _rep); GRID_BAR(); }
    phase_peer_c(kp_fresh(), make_ctx(lds), LAYER, LAST ? NCTX : 0); GRID_BAR();
    PROBE_REP(9) { phase_peer_v(kp_fresh(), make_ctx(lds), LAYER, LAST ? NCTX : 0, _rep); GRID_BAR(); }
    phase_peer_final<LAST>(kp_fresh(), make_ctx(lds), LAYER); GRID_BAR();
}
template <int LAYER, int JL> __device__ __forceinline__ void rg_phases(LAS unsigned char* lds, const XcdBarrier& bar) {
    PROBE_REP(6) { KP P = kp_fresh(); unsigned char* ws = P->ws; GPlain g{(const bf16_t*)(ws + WS_A0), (const bf16_t*)(ws + WS_RGIN) + (size_t)JL * 4096 * D, D, D, D}; EpiRgIn E{(bf16_t*)(ws + L_UG), (bf16_t*)(ws + L_UR)}; run_gemm(lds, g, 4096, E); GRID_BAR(); }
    PROBE_REP(7) { phase_rg_conv(kp_fresh(), make_ctx(lds), JL); GRID_BAR(); }
    { KP P = kp_fresh(); unsigned char* ws = P->ws; GGate g{(const bf16_t*)(ws + L_XC), (const bf16_t*)(ws + WS_RGGATE) + (size_t)JL * 8192 * 256, 256, D, 256};
      EpiRgGate E{(const bf16_t*)(ws + L_XC), (bf16_t*)(ws + L_LA), (bf16_t*)(ws + L_BB), P->in[I_RGGB] + (size_t)JL * 4 * D, (const float*)(ws + WS_SPT) + (size_t)JL * 2 * D}; PROBE_REP(11) { run_gemm(lds, g, 8192, E); GRID_BAR(); } }
    PROBE_REP(3) { phase_rg_scan1(kp_fresh(), make_ctx(lds)); GRID_BAR();
    phase_rg_scan2(kp_fresh(), make_ctx(lds)); GRID_BAR();
    phase_rg_scan3<0>(kp_fresh(), make_ctx(lds)); GRID_BAR();
    phase_rg_scan3<1>(kp_fresh(), make_ctx(lds)); GRID_BAR(); }
    { KP P = kp_fresh(); unsigned char* ws = P->ws; GPlain g{(const bf16_t*)(ws + L_YIN), (const bf16_t*)(ws + WS_RGOUT) + (size_t)JL * D * D, D, D, D}; EpiBf16Plain E{(bf16_t*)(ws + WS_S), D}; run_gemm(lds, g, D, E, LAYER == 3 ? 4 : 0); } GRID_BAR();
}
template <int LAYER> __device__ __forceinline__ void rw_phases(LAS unsigned char* lds, const XcdBarrier& bar) {
    PROBE_REP(7) { phase_rw_mix(kp_fresh(), make_ctx(lds), LAYER); GRID_BAR(); }
    PROBE_REP(6) { KP P = kp_fresh(); unsigned char* ws = P->ws; GRw1 g{(const bf16_t*)(ws + L_AALL), (const bf16_t*)(ws + WS_RW1), D, 6 * D, D}; EpiRw1 E{(bf16_t*)(ws + L_RKV), (bf16_t*)(ws + L_A2)}; run_gemm(lds, g, 6912, E); GRID_BAR(); }
    { KP P = kp_fresh(); unsigned char* ws = P->ws; GRw2 g{(const bf16_t*)(ws + L_A2), (const bf16_t*)(ws + WS_RW2), 256, 768, 256}; EpiRw2 E{(bf16_t*)(ws + L_W), (bf16_t*)(ws + L_AD), (bf16_t*)(ws + L_G), P->in[I_RWDEC0], P->in[I_RWICL0]}; PROBE_REP(12) { run_gemm(lds, g, 10240, E); GRID_BAR(); } }
    PROBE_REP(4) { phase_rw_scan(kp_fresh(), make_ctx(lds)); GRID_BAR(); }
    PROBE_REP(7) { phase_rw_finish(kp_fresh(), make_ctx(lds)); GRID_BAR(); }
    { KP P = kp_fresh(); unsigned char* ws = P->ws; GPlain g{(const bf16_t*)(ws + L_Z), (const bf16_t*)(ws + WS_RWO), D, D, D}; EpiBf16Plain E{(bf16_t*)(ws + WS_S), D}; run_gemm(lds, g, D, E); } GRID_BAR();
}
template <int LAYER> __device__ __forceinline__ void ret_phases(LAS unsigned char* lds, const XcdBarrier& bar) {
    { KP P = kp_fresh(); unsigned char* ws = P->ws; GPlain g{(const bf16_t*)(ws + WS_A0), (const bf16_t*)(ws + WS_RETIN), D, D, D};
      EpiRetIn E{(bf16_t*)(ws + L_RQ), (bf16_t*)(ws + L_RK), (bf16_t*)(ws + L_RV), (bf16_t*)(ws + L_GF), (bf16_t*)(ws + L_GB), (const float*)(ws + WS_CS)}; PROBE_REP(10) { run_gemm(lds, g, 16384, E); GRID_BAR(); } }
    PROBE_REP(5) { phase_ret_scan(kp_fresh(), make_ctx(lds)); GRID_BAR(); }
    PROBE_REP(7) { phase_ret_merge(kp_fresh(), make_ctx(lds)); GRID_BAR(); }
    { KP P = kp_fresh(); unsigned char* ws = P->ws; GPlain g{(const bf16_t*)(ws + L_RZ), (const bf16_t*)(ws + WS_RETOUT), 4096, 4096, 4096}; EpiBf16Plain E{(bf16_t*)(ws + WS_S), D}; run_gemm(lds, g, D, E); } GRID_BAR();
}

__global__ void __launch_bounds__(512, 2) hybrid_fwd(Params Pkernarg) {
    extern __shared__ __attribute__((aligned(16))) unsigned char lds_raw[];
    LAS unsigned char* lds = (LAS unsigned char*)lds_raw;
    volatile LAS unsigned* MISC = (volatile LAS unsigned*)(lds + MISC_OFF);
    if (threadIdx.x < 64) MISC[threadIdx.x] = 0u;
    __syncthreads();
    XcdBarrier bar = xcd_barrier_post((unsigned*)(kp_fresh()->ws + WS_CTL) + 4096, MISC + 8);

    if ((PROBE >> 13) & 1) { for (int i = 0; i < 64; ++i) GRID_BAR(); }
    PROBE_REP(8) { phase_prologue(kp_fresh(), make_ctx(lds)); GRID_BAR(); }
    { KP P = kp_fresh(); unsigned char* ws = P->ws; GFold g{(const bf16_t*)(ws + WS_KEYS), (const bf16_t*)(ws + WS_WQN), 256, 256, D}; EpiBf16Plain E{(bf16_t*)(ws + WS_WQ), D}; run_gemm_m(lds, g, 4 * D, D, E); }
    phase_modfin(kp_fresh(), make_ctx(lds)); GRID_BAR();
    phase_xinit(kp_fresh(), make_ctx(lds)); GRID_BAR();
    rg_phases<0, 0>(lds, bar);  peer_phases<0, false>(lds, bar);
    rw_phases<1>(lds, bar);     peer_phases<1, false>(lds, bar);
    ret_phases<2>(lds, bar);    peer_phases<2, false>(lds, bar);
    rg_phases<3, 1>(lds, bar);  peer_phases<3, true>(lds, bar);
}

extern "C" void kernel_launch(void* const* d_in, const int* in_sizes, int n_in, void* d_out, int out_size, void* d_ws, size_t ws_size, hipStream_t stream) {
    static int grid = 0;
    if (!grid) {
        if (n_in != 37 || ws_size < WS_END) { fprintf(stderr, "kernel_launch: unexpected problem (n_in %d, ws %zu)\n", n_in, ws_size); grid = -1; return; }
        int dev = 0, cus = 0, per_cu = 0;
        if (hipGetDevice(&dev) != hipSuccess || hipDeviceGetAttribute(&cus, hipDeviceAttributeMultiprocessorCount, dev) != hipSuccess) { grid = -1; return; }
        if (hipFuncSetAttribute((const void*)hybrid_fwd, hipFuncAttributeMaxDynamicSharedMemorySize, LDS_BYTES) != hipSuccess) { fprintf(stderr, "kernel_launch: hipFuncSetAttribute failed\n"); grid = -1; return; }
        if (hipOccupancyMaxActiveBlocksPerMultiprocessor(&per_cu, (const void*)hybrid_fwd, 512, LDS_BYTES) != hipSuccess || per_cu < 1) { fprintf(stderr, "kernel_launch: occupancy query says %d\n", per_cu); grid = -1; return; }
        grid = cus;
    }
    if (grid <= 0) return;
    hipMemsetAsync((char*)d_ws + WS_CTL, 0, CTL_BYTES, stream);
    Params p; memset(&p, 0, sizeof(p));
    for (int i = 0; i < 37; ++i) p.in[i] = (const float*)d_in[i];
    p.out = (float*)d_out; p.ws = (unsigned char*)d_ws;
    hipLaunchKernelGGL(hybrid_fwd, dim3(grid), dim3(512), LDS_BYTES, stream, p);
}
```

```cpp
#include <hip/hip_runtime.h>
#include <cstdio>
#include <cstring>

#define LAS __attribute__((address_space(3)))
typedef unsigned short bf16_t;
typedef short bf16x8 __attribute__((ext_vector_type(8)));
typedef float f32x4 __attribute__((ext_vector_type(4)));
typedef float f32x2 __attribute__((ext_vector_type(2)));
typedef unsigned u32x4 __attribute__((ext_vector_type(4)));
typedef unsigned u32x2 __attribute__((ext_vector_type(2)));
typedef __bf16 bf16v2 __attribute__((ext_vector_type(2)));

#ifndef DBG_ZERO
#define DBG_ZERO 0
#endif
#ifndef PROBE
#define PROBE 0
#endif
#define PROBE_REP(bit) for (int _rep = 0; _rep < (((PROBE) >> (bit)) & 1) + 1; ++_rep)
constexpr int D = 2048, NBATCH = 4, SEQ = 4096, CTX = 256;
constexpr int NCTX = NBATCH * CTX, NLAT = NBATCH * SEQ, T = NCTX + NLAT;
constexpr int SLEN = CTX + SEQ;
constexpr float ALPHA = 1.681792830507429f;
constexpr float LN_EPS = 1e-5f;
constexpr size_t TD = (size_t)T * D;

constexpr size_t MiB = 1u << 20;
constexpr size_t WS_CTL = 0, CTL_BYTES = 1 * MiB;
constexpr size_t WS_MODP = 2 * MiB;
constexpr size_t WS_MOD = 10 * MiB;
constexpr size_t WS_CS = 11 * MiB;
constexpr size_t WS_SPT = 15 * MiB + 512 * 1024;
constexpr size_t WS_CA = 16 * MiB, WS_CH = 21 * MiB, WS_CIN = 26 * MiB;
constexpr size_t WS_WQ = 32 * MiB;
constexpr size_t WS_KEYS = 64 * MiB;
constexpr size_t WS_RGIN = 68 * MiB;
constexpr size_t WS_RGGATE = 100 * MiB;
constexpr size_t WS_RGOUT = 108 * MiB;
constexpr size_t WS_RW1 = 124 * MiB;
constexpr size_t WS_RW2 = 152 * MiB;
constexpr size_t WS_RWO = 160 * MiB;
constexpr size_t WS_RETIN = 168 * MiB;
constexpr size_t WS_RETOUT = 232 * MiB;
constexpr size_t WS_PU = 256 * MiB;
constexpr size_t WS_PV = 384 * MiB;
constexpr size_t WS_PSC = 512 * MiB;
constexpr size_t WS_X = 768 * MiB;
constexpr size_t WS_A0 = 904 * MiB;
constexpr size_t WS_H2 = 972 * MiB;
constexpr size_t WS_Q = 1040 * MiB;
constexpr size_t WS_WQN = 1040 * MiB;
constexpr size_t WS_S = 1108 * MiB;
constexpr size_t WS_L = 1244 * MiB;
constexpr size_t WS_SELW = 1893 * MiB;
constexpr size_t WS_END = 1902 * MiB;
constexpr size_t P_SE16 = WS_L + 288 * MiB;
constexpr size_t P_PART = WS_L, P_Y = WS_L + 136 * MiB, P_C = WS_L + 272 * MiB;
constexpr int CW_PQ = 16384;
constexpr size_t L_UG = WS_L, L_UR = WS_L + 68 * MiB, L_XC = WS_L + 136 * MiB, L_LA = WS_L + 204 * MiB, L_BB = WS_L + 340 * MiB, L_YIN = WS_L + 476 * MiB;
constexpr size_t L_AALL = WS_L;
constexpr size_t L_W = WS_L, L_AD = WS_L + 136 * MiB, L_G = WS_L + 272 * MiB;
constexpr size_t L_RKV = WS_L + 408 * MiB;
constexpr size_t L_A2 = WS_L + 612 * MiB;
constexpr size_t L_Y0 = WS_H2, L_Y1 = WS_H2 + 136 * MiB;
constexpr size_t L_Z = WS_A0;
constexpr size_t L_RQ = WS_L, L_RK = WS_L + 68 * MiB, L_RV = WS_L + 136 * MiB, L_GF = WS_L + 272 * MiB, L_GB = WS_L + 408 * MiB;
constexpr size_t L_OF = WS_H2, L_OB = WS_H2 + 136 * MiB;
constexpr size_t L_RZ = WS_L;

__device__ __forceinline__ float bf2f(unsigned b) { return __uint_as_float(b << 16); }
__device__ __forceinline__ unsigned cvt_pk_bf16(float lo, float hi) { bf16v2 t; t.x = (__bf16)lo; t.y = (__bf16)hi; return __builtin_bit_cast(unsigned, t); }
__device__ __forceinline__ float bflo(unsigned u) { return __uint_as_float(u << 16); }
__device__ __forceinline__ float bfhi(unsigned u) { return __uint_as_float(u & 0xffff0000u); }
__device__ __forceinline__ float sigmoidf_(float x) { return 1.0f / (1.0f + __expf(-x)); }
__device__ __forceinline__ float siluf_(float x) { return x / (1.0f + __expf(-x)); }
__device__ __forceinline__ float tanhf_(float x) { return 1.0f - 2.0f / (1.0f + __expf(2.0f * x)); }
__device__ __forceinline__ float gelu_tanh(float x) { const float z = 1.5957691216057308f * (x + 0.044715f * x * x * x); return x / (1.0f + __expf(-z)); }
__device__ __forceinline__ void unpack8(const u32x4 u, float (&f)[8]) { f[0] = bflo(u.x); f[1] = bfhi(u.x); f[2] = bflo(u.y); f[3] = bfhi(u.y); f[4] = bflo(u.z); f[5] = bfhi(u.z); f[6] = bflo(u.w); f[7] = bfhi(u.w); }
template <int CTRL> __device__ __forceinline__ float dpp_mov(float v) { const int x = __builtin_bit_cast(int, v); return __builtin_bit_cast(float, __builtin_amdgcn_update_dpp(x, x, CTRL, 0xF, 0xF, false)); }
__device__ __forceinline__ float rl_f(float v, int lane) { return __builtin_bit_cast(float, __builtin_amdgcn_readlane(__builtin_bit_cast(int, v), lane)); }
__device__ __forceinline__ float sum8(float v) { v += dpp_mov<0xB1>(v); v += dpp_mov<0x4E>(v); v += dpp_mov<0x141>(v); return v; }
__device__ __forceinline__ float sum16(float v) { v = sum8(v); v += dpp_mov<0x140>(v); return v; }
__device__ __forceinline__ float fma_s(float a, float b, float c) { float d; asm("v_fma_f32 %0, %1, %2, %3" : "=v"(d) : "v"(a), "v"(b), "v"(c)); return d; }
__device__ __forceinline__ float mul_s(float a, float b) { float d; asm("v_mul_f32 %0, %1, %2" : "=v"(d) : "v"(a), "v"(b)); return d; }
__device__ __forceinline__ void sum8_pair(float& a, float& b) {
    asm volatile("s_nop 1\n\t"
        "v_add_f32_dpp %0, %0, %0 quad_perm:[1,0,3,2] row_mask:0xf bank_mask:0xf\n\tv_add_f32_dpp %1, %1, %1 quad_perm:[1,0,3,2] row_mask:0xf bank_mask:0xf\n\ts_nop 0\n\t"
        "v_add_f32_dpp %0, %0, %0 quad_perm:[2,3,0,1] row_mask:0xf bank_mask:0xf\n\tv_add_f32_dpp %1, %1, %1 quad_perm:[2,3,0,1] row_mask:0xf bank_mask:0xf\n\ts_nop 0\n\t"
        "v_add_f32_dpp %0, %0, %0 row_half_mirror row_mask:0xf bank_mask:0xf\n\tv_add_f32_dpp %1, %1, %1 row_half_mirror row_mask:0xf bank_mask:0xf"
        : "+v"(a), "+v"(b));
}
__device__ __forceinline__ void sum16_pair(float& a, float& b) {
    asm volatile("s_nop 1\n\t"
        "v_add_f32_dpp %0, %0, %0 quad_perm:[1,0,3,2] row_mask:0xf bank_mask:0xf\n\tv_add_f32_dpp %1, %1, %1 quad_perm:[1,0,3,2] row_mask:0xf bank_mask:0xf\n\ts_nop 0\n\t"
        "v_add_f32_dpp %0, %0, %0 quad_perm:[2,3,0,1] row_mask:0xf bank_mask:0xf\n\tv_add_f32_dpp %1, %1, %1 quad_perm:[2,3,0,1] row_mask:0xf bank_mask:0xf\n\ts_nop 0\n\t"
        "v_add_f32_dpp %0, %0, %0 row_half_mirror row_mask:0xf bank_mask:0xf\n\tv_add_f32_dpp %1, %1, %1 row_half_mirror row_mask:0xf bank_mask:0xf\n\ts_nop 0\n\t"
        "v_add_f32_dpp %0, %0, %0 row_mirror row_mask:0xf bank_mask:0xf\n\tv_add_f32_dpp %1, %1, %1 row_mirror row_mask:0xf bank_mask:0xf"
        : "+v"(a), "+v"(b));
}
__device__ __forceinline__ void sum16_quad(float& a, float& b, float& c, float& d) {
    asm volatile("s_nop 1\n\t"
        "v_add_f32_dpp %0, %0, %0 quad_perm:[1,0,3,2] row_mask:0xf bank_mask:0xf\n\tv_add_f32_dpp %1, %1, %1 quad_perm:[1,0,3,2] row_mask:0xf bank_mask:0xf\n\t"
        "v_add_f32_dpp %2, %2, %2 quad_perm:[1,0,3,2] row_mask:0xf bank_mask:0xf\n\tv_add_f32_dpp %3, %3, %3 quad_perm:[1,0,3,2] row_mask:0xf bank_mask:0xf\n\t"
        "v_add_f32_dpp %0, %0, %0 quad_perm:[2,3,0,1] row_mask:0xf bank_mask:0xf\n\tv_add_f32_dpp %1, %1, %1 quad_perm:[2,3,0,1] row_mask:0xf bank_mask:0xf\n\t"
        "v_add_f32_dpp %2, %2, %2 quad_perm:[2,3,0,1] row_mask:0xf bank_mask:0xf\n\tv_add_f32_dpp %3, %3, %3 quad_perm:[2,3,0,1] row_mask:0xf bank_mask:0xf\n\t"
        "v_add_f32_dpp %0, %0, %0 row_half_mirror row_mask:0xf bank_mask:0xf\n\tv_add_f32_dpp %1, %1, %1 row_half_mirror row_mask:0xf bank_mask:0xf\n\t"
        "v_add_f32_dpp %2, %2, %2 row_half_mirror row_mask:0xf bank_mask:0xf\n\tv_add_f32_dpp %3, %3, %3 row_half_mirror row_mask:0xf bank_mask:0xf\n\t"
        "v_add_f32_dpp %0, %0, %0 row_mirror row_mask:0xf bank_mask:0xf\n\tv_add_f32_dpp %1, %1, %1 row_mirror row_mask:0xf bank_mask:0xf\n\t"
        "v_add_f32_dpp %2, %2, %2 row_mirror row_mask:0xf bank_mask:0xf\n\tv_add_f32_dpp %3, %3, %3 row_mirror row_mask:0xf bank_mask:0xf"
        : "+v"(a), "+v"(b), "+v"(c), "+v"(d));
}
__device__ __forceinline__ void sum8_quad(float& a, float& b, float& c, float& d) {
    asm volatile("s_nop 1\n\t"
        "v_add_f32_dpp %0, %0, %0 quad_perm:[1,0,3,2] row_mask:0xf bank_mask:0xf\n\tv_add_f32_dpp %1, %1, %1 quad_perm:[1,0,3,2] row_mask:0xf bank_mask:0xf\n\t"
        "v_add_f32_dpp %2, %2, %2 quad_perm:[1,0,3,2] row_mask:0xf bank_mask:0xf\n\tv_add_f32_dpp %3, %3, %3 quad_perm:[1,0,3,2] row_mask:0xf bank_mask:0xf\n\t"
        "v_add_f32_dpp %0, %0, %0 quad_perm:[2,3,0,1] row_mask:0xf bank_mask:0xf\n\tv_add_f32_dpp %1, %1, %1 quad_perm:[2,3,0,1] row_mask:0xf bank_mask:0xf\n\t"
        "v_add_f32_dpp %2, %2, %2 quad_perm:[2,3,0,1] row_mask:0xf bank_mask:0xf\n\tv_add_f32_dpp %3, %3, %3 quad_perm:[2,3,0,1] row_mask:0xf bank_mask:0xf\n\t"
        "v_add_f32_dpp %0, %0, %0 row_half_mirror row_mask:0xf bank_mask:0xf\n\tv_add_f32_dpp %1, %1, %1 row_half_mirror row_mask:0xf bank_mask:0xf\n\t"
        "v_add_f32_dpp %2, %2, %2 row_half_mirror row_mask:0xf bank_mask:0xf\n\tv_add_f32_dpp %3, %3, %3 row_half_mirror row_mask:0xf bank_mask:0xf"
        : "+v"(a), "+v"(b), "+v"(c), "+v"(d));
}
__device__ __forceinline__ float wave_sum(float v) { v = sum8(v); v += dpp_mov<0x140>(v); return (rl_f(v, 0) + rl_f(v, 16)) + (rl_f(v, 32) + rl_f(v, 48)); }
__device__ __forceinline__ float wave_max(float v) {
    v = fmaxf(v, dpp_mov<0xB1>(v)); v = fmaxf(v, dpp_mov<0x4E>(v)); v = fmaxf(v, dpp_mov<0x141>(v)); v = fmaxf(v, dpp_mov<0x140>(v));
    return fmaxf(fmaxf(rl_f(v, 0), rl_f(v, 16)), fmaxf(rl_f(v, 32), rl_f(v, 48)));
}
__device__ __forceinline__ int row_vec(int row) { return row < NCTX ? 4 : ((row - NCTX) >> 12); }
__device__ __forceinline__ int panel_vec(int pm) { return pm < 4 ? 4 : ((pm - 4) >> 4); }
__device__ __forceinline__ int seq_row(int b, int dir, int s) {
    if (s < CTX) { const int t = dir ? (CTX - 1 - s) : s; return b * CTX + t; }
    int t = s - CTX; if (dir) t = SEQ - 1 - t; return NCTX + b * SEQ + t;
}
__device__ __forceinline__ int row_pos(int row) { return row < NCTX ? (row & (CTX - 1)) : CTX + ((row - NCTX) & (SEQ - 1)); }

namespace pg8 {
constexpr int BM = 256, BK = 64, HALF = 128, HTB = HALF * BK * 2, STAGE_BYTES = 8 * HTB, NXCD = 8, WGM = 8;
__host__ __device__ __forceinline__ int lds_byte(int r, int c) { const int st = (r >> 4) * 2 + (c >> 5), rr = r & 15, cc = c & 31, ob = rr * 64 + cc * 2; return st * 1024 + (ob ^ (((ob >> 9) & 1) << 5)); }
__host__ __device__ __forceinline__ void stage_rc(int b, int& R, int& C) { const int st = b / 1024, sb = b % 1024, swz = sb ^ (((sb >> 9) & 1) << 5); R = (st >> 1) * 16 + swz / 64; C = (st & 1) * 32 + (swz % 64) / 2; }
__host__ __device__ __forceinline__ int perm32(int rho) { const int n = rho >> 4, i = rho & 15; return 8 * (i >> 2) + 4 * n + (i & 3); }
struct Unit { int pm, pn; };
struct StaticOrder {
    int nM, nN, nwg, G, c, pm0;
    __device__ void init(int M, int N, int G_, int c_, int pm0_ = 0) { pm0 = pm0_; nM = M / BM - pm0_; nN = N / BM; nwg = nM * nN; G = G_; c = c_; }
    __device__ bool next(int i, Unit& u) const {
        const long L = (long)i * G + c; if (L >= nwg) return false;
        int wgid = (int)L; { const int q = nwg / NXCD, r = nwg % NXCD, xcd = wgid % NXCD, off = wgid / NXCD; wgid = (xcd < r ? xcd * (q + 1) : r * (q + 1) + (xcd - r) * q) + off; }
        const int nig = WGM * nN, gid = wgid / nig, fm = gid * WGM, gsz = (nM - fm) < WGM ? (nM - fm) : WGM;
        u.pm = pm0 + fm + ((wgid % nig) % gsz); u.pn = (wgid % nig) / gsz; return true;
    }
};
template <class Epi, class GT>
__device__ __forceinline__ void gemm_phase(LAS unsigned char* lds, const GT g, const StaticOrder& S, const Epi& E) {
    int tid_ = threadIdx.x; asm volatile("" : "+v"(tid_));
    const int tid = tid_, wid = __builtin_amdgcn_readfirstlane(tid >> 6), lane = tid & 63, wr = wid >> 2, wc = wid & 3, fr = lane & 15, fq = lane >> 4;
    const int K = g.K, nt = K / BK;
    unsigned voffA[2], voffB[2];
#pragma unroll
    for (int i = 0; i < 2; ++i) { int R, C; stage_rc(tid * 16 + i * 8192, R, C); const int Rb = Epi::PERM ? ((R & ~31) + perm32(R & 31)) : R;
        voffA[i] = (unsigned)(R * g.lda + C) * 2u; voffB[i] = (unsigned)(Rb * g.ldb + C) * 2u; }
    const size_t kstep = (size_t)(BK * 2);
    const size_t hstepA = (size_t)HALF * g.lda * 2, hstepB = (size_t)HALF * g.ldb * 2;
    const unsigned ldsw = (unsigned)wid * 1024u;
    const int aoff = lds_byte(wr * 64 + fr, fq * 8), boff = lds_byte(wc * 32 + fr, fq * 8);
#define PG8_SA(b, h) (((b) * 2 + (h)) * HTB)
#define PG8_SB(b, h) ((4 + (b) * 2 + (h)) * HTB)
#define PG8_STAGE(bufoff, gbase, voff) do { _Pragma("unroll") for (int _i = 0; _i < 2; ++_i) \
        __builtin_amdgcn_global_load_lds((const unsigned*)((const char*)(gbase) + (voff)[_i]), (LAS unsigned*)(lds + (bufoff) + ldsw + _i * 8192), 16, 0, 0); } while (0)
#define PG8_LDA(dst, b, h) do { _Pragma("unroll") for (int m = 0; m < 4; ++m) _Pragma("unroll") for (int k = 0; k < 2; ++k) dst[m][k] = *(const LAS bf16x8*)(lds + PG8_SA(b, h) + aoff + m * 2048 + k * 1024); } while (0)
#define PG8_LDB(dst, b, h) do { _Pragma("unroll") for (int n = 0; n < 2; ++n) _Pragma("unroll") for (int k = 0; k < 2; ++k) dst[n][k] = *(const LAS bf16x8*)(lds + PG8_SB(b, h) + boff + n * 2048 + k * 1024); } while (0)
#define PG8_MMA(ai, bj, At, Bt) do { __builtin_amdgcn_s_setprio(1); _Pragma("unroll") for (int m = 0; m < 4; ++m) _Pragma("unroll") for (int n = 0; n < 2; ++n) _Pragma("unroll") for (int k = 0; k < 2; ++k) \
        acc[ai][bj][m][n] = __builtin_amdgcn_mfma_f32_16x16x32_bf16(Bt[n][k], At[m][k], acc[ai][bj][m][n], 0, 0, 0); __builtin_amdgcn_s_setprio(0); } while (0)
#define PG8_WAIT_V(n) asm volatile("s_waitcnt vmcnt(" #n ")" ::: "memory")
#define PG8_WAIT_L(n) asm volatile("s_waitcnt lgkmcnt(" #n ")" ::: "memory")
#define PG8_BAR __builtin_amdgcn_s_barrier()
#define PG8_SCHED __builtin_amdgcn_sched_barrier(0)
    Unit cur, nxt; int ui = 0;
    if (!S.next(0, cur)) return;
    f32x4 acc[2][2][4][2];
#pragma unroll
    for (int a = 0; a < 2; ++a)
#pragma unroll
        for (int b = 0; b < 2; ++b)
#pragma unroll
            for (int m = 0; m < 4; ++m)
#pragma unroll
                for (int n = 0; n < 2; ++n) acc[a][b][m][n] = (f32x4){0.f, 0.f, 0.f, 0.f};
    bf16x8 At[4][2], B0[2][2], B1[2][2];
    const char* cA = g.a_ptr(cur); const char* cB = g.b_ptr(cur);
    PG8_STAGE(PG8_SB(0, 0), cB, voffB); PG8_STAGE(PG8_SA(0, 0), cA, voffA); PG8_STAGE(PG8_SB(0, 1), cB + hstepB, voffB); PG8_STAGE(PG8_SA(0, 1), cA + hstepA, voffA);
    if (wr == 1) PG8_BAR;
    PG8_WAIT_V(4); PG8_BAR;
    PG8_STAGE(PG8_SB(1, 0), cB + kstep, voffB); PG8_STAGE(PG8_SA(1, 0), cA + kstep, voffA); PG8_STAGE(PG8_SB(1, 1), cB + hstepB + kstep, voffB);
    PG8_WAIT_V(6); PG8_BAR;
    for (;;) {
        const bool has_next = S.next(ui + 1, nxt);
        const char* nA = has_next ? g.a_ptr(nxt) : cA; const char* nB = has_next ? g.b_ptr(nxt) : cB;
        for (int t = 0; t < nt; t += 2) {
            const bool last = (t == nt - 2);
            const char* a1 = cA + (size_t)(t + 1) * kstep;
            const char* a2 = last ? nA : cA + (size_t)(t + 2) * kstep; const char* b2 = last ? nB : cB + (size_t)(t + 2) * kstep;
            const char* a3 = a2 + kstep; const char* b3 = b2 + kstep;
            PG8_LDB(B0, 0, 0); PG8_SCHED; PG8_LDA(At, 0, 0); PG8_STAGE(PG8_SA(1, 1), a1 + hstepA, voffA);
            PG8_WAIT_L(8); PG8_BAR; PG8_WAIT_L(0); PG8_MMA(0, 0, At, B0); PG8_BAR; PG8_SCHED;
            PG8_LDB(B1, 0, 1); PG8_STAGE(PG8_SB(0, 0), b2, voffB);
            PG8_BAR; PG8_WAIT_L(0); PG8_MMA(0, 1, At, B1); PG8_BAR;
            PG8_LDA(At, 0, 1); PG8_STAGE(PG8_SA(0, 0), a2, voffA);
            PG8_BAR; PG8_WAIT_L(0); PG8_MMA(1, 0, At, B0); PG8_BAR; PG8_SCHED;
            PG8_STAGE(PG8_SB(0, 1), b2 + hstepB, voffB);
            PG8_WAIT_V(6); PG8_BAR; PG8_MMA(1, 1, At, B1); PG8_BAR;
            PG8_LDB(B0, 1, 0); PG8_SCHED; PG8_LDA(At, 1, 0); PG8_STAGE(PG8_SA(0, 1), a2 + hstepA, voffA);
            PG8_WAIT_L(8); PG8_BAR; PG8_WAIT_L(0); PG8_MMA(0, 0, At, B0); PG8_BAR; PG8_SCHED;
            PG8_LDB(B1, 1, 1); PG8_STAGE(PG8_SB(1, 0), b3, voffB);
            PG8_BAR; PG8_WAIT_L(0); PG8_MMA(0, 1, At, B1); PG8_BAR;
            PG8_LDA(At, 1, 1); PG8_STAGE(PG8_SA(1, 0), a3, voffA);
            PG8_BAR; PG8_WAIT_L(0); PG8_MMA(1, 0, At, B0); PG8_BAR; PG8_SCHED;
            PG8_STAGE(PG8_SB(1, 1), b3 + hstepB, voffB);
            PG8_WAIT_V(6); PG8_BAR; PG8_MMA(1, 1, At, B1); PG8_BAR;
        }
        E(acc, cur, wr, wc, fr, fq);
        if (!has_next) break;
#pragma unroll
        for (int a = 0; a < 2; ++a)
#pragma unroll
            for (int b = 0; b < 2; ++b)
#pragma unroll
                for (int m = 0; m < 4; ++m)
#pragma unroll
                    for (int n = 0; n < 2; ++n) acc[a][b][m][n] = (f32x4){0.f, 0.f, 0.f, 0.f};
        cur = nxt; cA = nA; cB = nB; ++ui;
    }
    PG8_WAIT_V(0);
    if (wr == 0) PG8_BAR;
    PG8_BAR;
#undef PG8_SA
#undef PG8_SB
#undef PG8_STAGE
#undef PG8_LDA
#undef PG8_LDB
#undef PG8_MMA
#undef PG8_WAIT_V
#undef PG8_WAIT_L
#undef PG8_BAR
#undef PG8_SCHED
}
}
using pg8::Unit;
typedef const f32x4 (&AccRef)[2][2][4][2];

#define XB_TMO      128
#define XB_XCNT(j)  (256  + 64 * (j))
#define XB_XSUB(j)  (1280 + 64 * (j))
#define XB_XGEN(j)  (2304 + 64 * (j))
#define XB_TOP      3328
#define XB_TOPGEN   3392
#define XCD_BAR_WORDS 3456
#define XB_SPIN_CAP (1u << 18)
__device__ __forceinline__ unsigned xb_ld(unsigned* p)              { return __hip_atomic_load(p, __ATOMIC_RELAXED, __HIP_MEMORY_SCOPE_AGENT); }
__device__ __forceinline__ unsigned xb_add(unsigned* p, unsigned v) { return __hip_atomic_fetch_add(p, v, __ATOMIC_RELAXED, __HIP_MEMORY_SCOPE_AGENT); }
__device__ __forceinline__ unsigned xb_xcc_id() { return (unsigned)__builtin_amdgcn_s_getreg((3 << 11) | 20) & 0xFu; }
#define XB_SPIN(cond, bar) do { unsigned _sp = 0; while (cond) { __builtin_amdgcn_s_sleep(1); \
    if ((++_sp & 255u) == 0u) { if (xb_ld(&(bar)[XB_TMO])) break; if (_sp > XB_SPIN_CAP) { atomicAdd(&(bar)[XB_TMO], 1u); break; } } } } while (0)
struct XcdBarrier { unsigned* bar; unsigned x; volatile LAS unsigned* st; };
__device__ __forceinline__ XcdBarrier xcd_barrier_post(unsigned* bar, volatile LAS unsigned* st) {
    XcdBarrier b; b.bar = bar; b.x = xb_xcc_id(); b.st = st;
    if (threadIdx.x == 0) (void)xb_add(&bar[XB_XCNT(b.x)], 1u);
    return b;
}
__device__ __forceinline__ void xcd_barrier_complete(unsigned* bar, unsigned x, unsigned& nloc, unsigned& nx) {
    const unsigned G = gridDim.x * gridDim.y * gridDim.z;
    unsigned sum, cnt, mine, sp = 0u;
    for (;;) {
        sum = 0u; cnt = 0u; mine = 0u;
#pragma unroll
        for (unsigned j = 0; j < 16; ++j) { const unsigned c = xb_ld(&bar[XB_XCNT(j)]); sum += c; cnt += (c > 0u) ? 1u : 0u; mine = (j == x) ? c : mine; }
        if (sum == G) break;
        __builtin_amdgcn_s_sleep(1);
        if ((++sp & 255u) == 0u) { if (xb_ld(&bar[XB_TMO])) break; if (sp > XB_SPIN_CAP) { atomicAdd(&bar[XB_TMO], 1u); break; } }
    }
    nloc = mine > 0u ? mine : 1u; nx = cnt > 0u ? cnt : 1u;
}
__device__ __forceinline__ void xcd_barrier(const XcdBarrier& b) {
    asm volatile("s_waitcnt vmcnt(0)" ::: "memory");
    __syncthreads();
    if (threadIdx.x == 0) {
        unsigned* bar = b.bar;
        __builtin_amdgcn_s_waitcnt(0);
        unsigned nloc = b.st[0], nx = b.st[1];
        if (nloc == 0u) { xcd_barrier_complete(bar, b.x, nloc, nx); b.st[0] = nloc; b.st[1] = nx; }
        const unsigned old = xb_add(&bar[XB_XSUB(b.x)], 1u);
        const unsigned gen = old / nloc;
        if (old + 1u == (gen + 1u) * nloc) {
            __builtin_amdgcn_fence(__ATOMIC_RELEASE, "agent");
            asm volatile("s_waitcnt vmcnt(0)" ::: "memory");
            const unsigned og = xb_add(&bar[XB_TOP], 1u);
            const unsigned tg = og / nx;
            if (og + 1u == (tg + 1u) * nx) xb_add(&bar[XB_TOPGEN], 1u);
            else XB_SPIN(xb_ld(&bar[XB_TOPGEN]) == tg, bar);
            __builtin_amdgcn_fence(__ATOMIC_ACQUIRE, "agent");
            xb_add(&bar[XB_XGEN(b.x)], 1u);
            asm volatile("s_waitcnt vmcnt(0)" ::: "memory");
        } else {
            XB_SPIN(xb_ld(&bar[XB_XGEN(b.x)]) == gen, bar);
            __builtin_amdgcn_fence(__ATOMIC_ACQUIRE, "agent");
            asm volatile("s_waitcnt vmcnt(0)" ::: "memory");
        }
    }
    __syncthreads();
}

struct Params { const float* in[37]; float* out; unsigned char* ws; };
typedef const __attribute__((address_space(4))) Params* KP;
__device__ __forceinline__ KP kp_fresh() { KP p = (KP)__builtin_amdgcn_kernarg_segment_ptr(); asm volatile("" : "+s"(p)); return p; }
enum { I_X = 0, I_C, I_CTX, I_CCTX, I_ADAW, I_ADAB, I_LNG, I_LNB, I_PWQ, I_PKEYS, I_PU, I_PV, I_RGWIN, I_RGCW, I_RGCB, I_RGGW, I_RGGB, I_RGLAM, I_RGWOUT,
       I_RWMU, I_RWRKV, I_RWWO, I_RWDEC0, I_RWDEC1, I_RWDEC2, I_RWICL0, I_RWICL1, I_RWICL2, I_RWG1, I_RWG2, I_RWKK, I_RWKA, I_RWRK, I_RWGNG, I_RWGNB, I_RETWIN, I_RETWOUT };
constexpr int LDS_BYTES = 147456;
constexpr int MISC_OFF = 147200;

__device__ __forceinline__ const float* modp(KP P, int layer, int v, int slot) { return (const float*)(P->ws + WS_MOD) + ((size_t)(layer * 5 + v) * 6 + slot) * D; }

struct GPlain { const bf16_t* A; const bf16_t* Bt; int K, lda, ldb;
    __device__ __forceinline__ const char* a_ptr(const Unit& u) const { return (const char*)(A + (size_t)u.pm * 256 * lda); }
    __device__ __forceinline__ const char* b_ptr(const Unit& u) const { return (const char*)(Bt + (size_t)u.pn * 256 * ldb); } };
struct GGate { const bf16_t* A; const bf16_t* Bt; int K, lda, ldb;
    __device__ __forceinline__ const char* a_ptr(const Unit& u) const { return (const char*)(A + (size_t)u.pm * 256 * lda + ((u.pn >> 1) & 7) * 256); }
    __device__ __forceinline__ const char* b_ptr(const Unit& u) const { return (const char*)(Bt + (size_t)u.pn * 256 * ldb); } };
struct GScore { const bf16_t* A; const bf16_t* Bt; int K, lda, ldb;
    __device__ __forceinline__ const char* a_ptr(const Unit& u) const { return (const char*)(A + (size_t)u.pm * 256 * lda + u.pn * 256); }
    __device__ __forceinline__ const char* b_ptr(const Unit& u) const { return (const char*)(Bt + (size_t)u.pn * 256 * ldb); } };
struct GFold { const bf16_t* A; const bf16_t* Bt; int K, lda, ldb;
    __device__ __forceinline__ const char* a_ptr(const Unit& u) const { return (const char*)(A + (size_t)u.pm * 256 * lda); }
    __device__ __forceinline__ const char* b_ptr(const Unit& u) const { return (const char*)(Bt + (size_t)(u.pm >> 3) * D * D + (size_t)u.pn * 256 * ldb + (u.pm & 7) * 256); } };
struct GRw1 { const bf16_t* A; const bf16_t* Bt; int K, lda, ldb;
    __device__ __forceinline__ const char* a_ptr(const Unit& u) const { const int blk = u.pn < 24 ? (u.pn >> 3) : (u.pn - 21); return (const char*)(A + (size_t)u.pm * 256 * lda + blk * 2048); }
    __device__ __forceinline__ const char* b_ptr(const Unit& u) const { return (const char*)(Bt + (size_t)u.pn * 256 * ldb); } };
struct GRw2 { const bf16_t* A; const bf16_t* Bt; int K, lda, ldb;
    __device__ __forceinline__ const char* a_ptr(const Unit& u) const { const int blk = u.pn < 16 ? 0 : (u.pn < 32 ? 1 : 2); return (const char*)(A + (size_t)u.pm * 256 * lda + blk * 256); }
    __device__ __forceinline__ const char* b_ptr(const Unit& u) const { return (const char*)(Bt + (size_t)u.pn * 256 * ldb); } };

template <int ACT> __device__ __forceinline__ float actf(float x) {
    if (ACT == 1) return gelu_tanh(x); if (ACT == 2) return tanhf_(x); if (ACT == 3) return sigmoidf_(x); if (ACT == 4) return siluf_(x); return x; }
template <int ACT> __device__ __forceinline__ void store_tile_bf16(AccRef acc, bf16_t* dst, int ld, int row0, int col0) {
#pragma unroll
    for (int ai = 0; ai < 2; ++ai)
#pragma unroll
        for (int m = 0; m < 4; ++m) { bf16_t* rowp = dst + (size_t)(row0 + ai * 128 + m * 16) * ld + col0;
#pragma unroll
            for (int bj = 0; bj < 2; ++bj) { const f32x4 v0 = acc[ai][bj][m][0], v1 = acc[ai][bj][m][1];
                u32x4 w; w.x = cvt_pk_bf16(actf<ACT>(v0[0]), actf<ACT>(v0[1])); w.y = cvt_pk_bf16(actf<ACT>(v0[2]), actf<ACT>(v0[3]));
                w.z = cvt_pk_bf16(actf<ACT>(v1[0]), actf<ACT>(v1[1])); w.w = cvt_pk_bf16(actf<ACT>(v1[2]), actf<ACT>(v1[3]));
                *(u32x4*)(rowp + bj * 128) = w; } }
}
struct EpiBf16Plain { static constexpr bool PERM = true; bf16_t* O; int ldc;
    __device__ __forceinline__ void operator()(AccRef acc, const Unit& u, int wr, int wc, int fr, int fq) const {
        store_tile_bf16<0>(acc, O, ldc, u.pm * 256 + wr * 64 + fr, u.pn * 256 + wc * 32 + 8 * fq); } };
struct EpiF32Plain { static constexpr bool PERM = false; float* C; int ldc;
    __device__ __forceinline__ void operator()(AccRef acc, const Unit& u, int wr, int wc, int fr, int fq) const {
        const int row0 = u.pm * 256 + wr * 64 + fr, col0 = u.pn * 256 + wc * 32 + 4 * fq;
#pragma unroll
        for (int ai = 0; ai < 2; ++ai)
#pragma unroll
            for (int m = 0; m < 4; ++m) { float* rowp = C + (size_t)(row0 + ai * 128 + m * 16) * ldc + col0;
#pragma unroll
                for (int bj = 0; bj < 2; ++bj)
#pragma unroll
                    for (int n = 0; n < 2; ++n) *(f32x4*)(rowp + bj * 128 + n * 16) = acc[ai][bj][m][n]; } } };
struct GSplitK { const bf16_t* A; const bf16_t* Bt; int K, lda, ldb;
    __device__ __forceinline__ const char* a_ptr(const Unit& u) const { return (const char*)(A + (size_t)u.pm * 256 * lda + (u.pn >> 3) * 512); }
    __device__ __forceinline__ const char* b_ptr(const Unit& u) const { return (const char*)(Bt + (size_t)(u.pn & 7) * 256 * ldb + (u.pn >> 3) * 512); } };
struct EpiPartial { static constexpr bool PERM = false; float* PX;
    __device__ __forceinline__ void operator()(AccRef acc, const Unit& u, int wr, int wc, int fr, int fq) const {
        const int row0 = u.pm * 256 + wr * 64 + fr, col0 = (u.pn & 7) * 256 + wc * 32 + 4 * fq; float* base = PX + (size_t)(u.pn >> 3) * NCTX * D;
#pragma unroll
        for (int ai = 0; ai < 2; ++ai)
#pragma unroll
            for (int m = 0; m < 4; ++m) { float* rowp = base + (size_t)(row0 + ai * 128 + m * 16) * D + col0;
#pragma unroll
                for (int bj = 0; bj < 2; ++bj)
#pragma unroll
                    for (int n = 0; n < 2; ++n) *(f32x4*)(rowp + bj * 128 + n * 16) = acc[ai][bj][m][n]; } } };
struct EpiResid { static constexpr bool PERM = false; float* X; const float* gate_base; float ymul;
    __device__ __forceinline__ void operator()(AccRef acc, const Unit& u, int wr, int wc, int fr, int fq) const {
        const int row0 = u.pm * 256 + wr * 64 + fr, col0 = u.pn * 256 + wc * 32 + 4 * fq;
        const float* gp = gate_base + (size_t)panel_vec(u.pm) * 6 * D + col0;
        f32x4 gv[2][2];
#pragma unroll
        for (int bj = 0; bj < 2; ++bj)
#pragma unroll
            for (int n = 0; n < 2; ++n) gv[bj][n] = *(const f32x4*)(gp + bj * 128 + n * 16);
#pragma unroll
        for (int ai = 0; ai < 2; ++ai)
#pragma unroll
            for (int m = 0; m < 4; ++m) { float* rowp = X + (size_t)(row0 + ai * 128 + m * 16) * D + col0;
#pragma unroll
                for (int bj = 0; bj < 2; ++bj)
#pragma unroll
                    for (int n = 0; n < 2; ++n) { f32x4* p = (f32x4*)(rowp + bj * 128 + n * 16); const f32x4 x = *p; *p = x * ALPHA + gv[bj][n] * (acc[ai][bj][m][n] * ymul); } } } };
struct EpiRgIn { static constexpr bool PERM = true; bf16_t* UG; bf16_t* UR;
    __device__ __forceinline__ void operator()(AccRef acc, const Unit& u, int wr, int wc, int fr, int fq) const {
        const int row0 = u.pm * 256 + wr * 64 + fr, col0 = (u.pn & 7) * 256 + wc * 32 + 8 * fq;
        if (u.pn < 8) store_tile_bf16<1>(acc, UG, D, row0, col0); else store_tile_bf16<0>(acc, UR, D, row0, col0); } };
struct EpiRgGate { static constexpr bool PERM = true; const bf16_t* XC; bf16_t* LA; bf16_t* BB; const float* gate_b; const float* spt;
    __device__ __forceinline__ void operator()(AccRef acc, const Unit& u, int wr, int wc, int fr, int fq) const {
        const int d = u.pn >> 4, ch0 = ((u.pn >> 1) & 7) * 256 + (u.pn & 1) * 128 + wc * 32 + 8 * fq;
        const int row0 = u.pm * 256 + wr * 64 + fr;
        float br[8], bi[8], sp[8];
#pragma unroll
        for (int j = 0; j < 8; ++j) { br[j] = gate_b[(d * 2 + 0) * D + ch0 + j]; bi[j] = gate_b[(d * 2 + 1) * D + ch0 + j];
            sp[j] = spt[d * D + ch0 + j]; }
        u32x4 xr8[8];
#pragma unroll
        for (int q = 0; q < 8; ++q) xr8[q] = *(const u32x4*)(XC + (size_t)(row0 + (q >> 2) * 128 + (q & 3) * 16) * D + ch0);
#pragma unroll
        for (int ai = 0; ai < 2; ++ai)
#pragma unroll
            for (int m = 0; m < 4; ++m) { const int row = row0 + ai * 128 + m * 16;
                const u32x4 xr = xr8[ai * 4 + m];
                float xc[8] = {bflo(xr.x), bfhi(xr.x), bflo(xr.y), bfhi(xr.y), bflo(xr.z), bfhi(xr.z), bflo(xr.w), bfhi(xr.w)};
                float la[8], bb[8];
#pragma unroll
                for (int j = 0; j < 8; ++j) { const float ar = acc[ai][0][m][j >> 2][j & 3], ai_ = acc[ai][1][m][j >> 2][j & 3];
                    const float rg = sigmoidf_(ar + br[j]), ig = sigmoidf_(ai_ + bi[j]);
                    const float l = sp[j] * rg; la[j] = l; bb[j] = sqrtf(1.0f - __expf(2.0f * l)) * (ig * xc[j]); }
                u32x4 w; w.x = cvt_pk_bf16(la[0], la[1]); w.y = cvt_pk_bf16(la[2], la[3]); w.z = cvt_pk_bf16(la[4], la[5]); w.w = cvt_pk_bf16(la[6], la[7]);
                *(u32x4*)(LA + ((size_t)row * 2 + d) * D + ch0) = w;
                w.x = cvt_pk_bf16(bb[0], bb[1]); w.y = cvt_pk_bf16(bb[2], bb[3]); w.z = cvt_pk_bf16(bb[4], bb[5]); w.w = cvt_pk_bf16(bb[6], bb[7]);
                *(u32x4*)(BB + ((size_t)row * 2 + d) * D + ch0) = w; } } };
struct EpiRw1 { static constexpr bool PERM = true; bf16_t* RKV; bf16_t* A2;
    __device__ __forceinline__ void operator()(AccRef acc, const Unit& u, int wr, int wc, int fr, int fq) const {
        const int row0 = u.pm * 256 + wr * 64 + fr, cw = wc * 32 + 8 * fq;
        if (u.pn < 24) store_tile_bf16<0>(acc, RKV + (size_t)(u.pn >> 3) * TD, D, row0, (u.pn & 7) * 256 + cw);
        else if (u.pn == 24) store_tile_bf16<2>(acc, A2, 768, row0, cw);
        else if (u.pn == 25) store_tile_bf16<0>(acc, A2, 768, row0, 256 + cw);
        else store_tile_bf16<3>(acc, A2, 768, row0, 512 + cw); } };
struct EpiRw2 { static constexpr bool PERM = true; bf16_t* W; bf16_t* AD; bf16_t* G; const float* dec0; const float* icl0;
    __device__ __forceinline__ void operator()(AccRef acc, const Unit& u, int wr, int wc, int fr, int fq) const {
        const int row0 = u.pm * 256 + wr * 64 + fr, c0 = (u.pn & 7) * 256 + wc * 32 + 8 * fq;
        if (u.pn >= 32) { store_tile_bf16<0>(acc, G, D, row0, c0); return; }
        const int isa = u.pn >= 16, d = (u.pn >> 3) & 1;
        const float* bias = (isa ? icl0 : dec0) + d * D + c0;
        bf16_t* dst = (isa ? AD : W);
        float bv[2][8];
#pragma unroll
        for (int bj = 0; bj < 2; ++bj)
#pragma unroll
            for (int j = 0; j < 8; ++j) bv[bj][j] = bias[bj * 128 + j];
#pragma unroll
        for (int ai = 0; ai < 2; ++ai)
#pragma unroll
            for (int m = 0; m < 4; ++m) { const int row = row0 + ai * 128 + m * 16;
#pragma unroll
                for (int bj = 0; bj < 2; ++bj) { float o[8];
#pragma unroll
                    for (int j = 0; j < 8; ++j) { const float s = sigmoidf_(acc[ai][bj][m][j >> 2][j & 3] + bv[bj][j]); o[j] = isa ? s : __expf(-0.6065306597126334f * s); }
                    u32x4 w; w.x = cvt_pk_bf16(o[0], o[1]); w.y = cvt_pk_bf16(o[2], o[3]); w.z = cvt_pk_bf16(o[4], o[5]); w.w = cvt_pk_bf16(o[6], o[7]);
                    *(u32x4*)(dst + ((size_t)row * 2 + d) * D + c0 + bj * 128) = w; } } } };
struct EpiRetIn { static constexpr bool PERM = true; bf16_t* Q; bf16_t* Kk; bf16_t* V; bf16_t* GF; bf16_t* GB; const float* CS;
    __device__ __forceinline__ void operator()(AccRef acc, const Unit& u, int wr, int wc, int fr, int fq) const {
        const int row0 = u.pm * 256 + wr * 64 + fr, cw = wc * 32 + 8 * fq;
        if (u.pn >= 48) { store_tile_bf16<4>(acc, GB, 4096, row0, (u.pn - 48) * 256 + cw); return; }
        if (u.pn >= 32) { store_tile_bf16<4>(acc, GF, 4096, row0, (u.pn - 32) * 256 + cw); return; }
        if (u.pn >= 16) { store_tile_bf16<0>(acc, V, 4096, row0, (u.pn - 16) * 256 + cw); return; }
        const float sc = u.pn >= 8 ? 0.0625f : 1.0f; bf16_t* dst = u.pn >= 8 ? Kk : Q; const int hc = (u.pn & 7) * 256;
#pragma unroll
        for (int ai = 0; ai < 2; ++ai) { f32x4 cs4[4][4];
#pragma unroll
            for (int m = 0; m < 4; ++m) { const float* cs_ = CS + ((size_t)row_pos(row0 + ai * 128 + m * 16) * 128 + cw) * 2;
#pragma unroll
                for (int q = 0; q < 4; ++q) cs4[m][q] = *(const f32x4*)(cs_ + 4 * q); }
#pragma unroll
            for (int m = 0; m < 4; ++m) { const int row = row0 + ai * 128 + m * 16;
                float o1[8], o2[8];
#pragma unroll
                for (int j = 0; j < 8; ++j) { const float co = cs4[m][j >> 1][(2 * j) & 3], si = cs4[m][j >> 1][(2 * j + 1) & 3]; const float t1 = acc[ai][0][m][j >> 2][j & 3], t2 = acc[ai][1][m][j >> 2][j & 3];
                    o1[j] = (t1 * co - t2 * si) * sc; o2[j] = (t1 * si + t2 * co) * sc; }
                u32x4 w; w.x = cvt_pk_bf16(o1[0], o1[1]); w.y = cvt_pk_bf16(o1[2], o1[3]); w.z = cvt_pk_bf16(o1[4], o1[5]); w.w = cvt_pk_bf16(o1[6], o1[7]);
                *(u32x4*)(dst + (size_t)row * D + hc + cw) = w;
                w.x = cvt_pk_bf16(o2[0], o2[1]); w.y = cvt_pk_bf16(o2[2], o2[3]); w.z = cvt_pk_bf16(o2[4], o2[5]); w.w = cvt_pk_bf16(o2[6], o2[7]);
                *(u32x4*)(dst + (size_t)row * D + hc + 128 + cw) = w; } } } };

#define LDS_WAIT() asm volatile("s_waitcnt lgkmcnt(0)" ::: "memory")
struct Ctx { LAS unsigned char* lds; int tid, lane, wave, gw, ngw, gtid, ngt; };

__device__ __forceinline__ void transpose_item(const float* W, int ldw, bf16_t* WT, int ldt, int k0, int n0, int dst_row0, LAS float* scr, int lane) {
#pragma unroll
    for (int i = 0; i < 8; ++i) { const int kk = 8 * i + (lane >> 3), nn = (lane & 7) * 4; const f32x4 wv = *(const f32x4*)(W + (size_t)(k0 + kk) * ldw + n0 + nn);
        LAS float* d = scr + kk * 33 + nn; d[0] = wv[0]; d[1] = wv[1]; d[2] = wv[2]; d[3] = wv[3]; }
    LDS_WAIT(); asm volatile("" ::: "memory");
    const int c = lane & 7;
#pragma unroll
    for (int j = 0; j < 4; ++j) { const int n = (lane >> 3) + 8 * j; const LAS float* s = scr + (8 * c) * 33 + n;
        u32x4 o; o.x = cvt_pk_bf16(s[0 * 33], s[1 * 33]); o.y = cvt_pk_bf16(s[2 * 33], s[3 * 33]); o.z = cvt_pk_bf16(s[4 * 33], s[5 * 33]); o.w = cvt_pk_bf16(s[6 * 33], s[7 * 33]);
        *(u32x4*)(WT + (size_t)(dst_row0 + n) * ldt + k0 + 8 * c) = o; }
    LDS_WAIT(); asm volatile("" ::: "memory");
}
__device__ __forceinline__ void tr_job(const Ctx& c, int& rot, const float* W, int K, int N, int ldw, bf16_t* WT, int ldt, int row_off) {
    LAS float* scr = (LAS float*)(c.lds + c.wave * 16384);
    const int nblk = N / 32, items = (K / 64) * nblk;
    int first = c.gw - (rot % c.ngw); if (first < 0) first += c.ngw;
    int lane = c.lane; asm volatile("" : "+v"(lane));
    f32x4 r[8];
#define TR_LOAD(it_) do { const int kb_ = (it_) / nblk, nb_ = (it_) % nblk; _Pragma("unroll") for (int i = 0; i < 8; ++i) r[i] = *(const f32x4*)(W + (size_t)(kb_ * 64 + 8 * i + (lane >> 3)) * ldw + nb_ * 32 + (lane & 7) * 4); } while (0)
    if (first < items) TR_LOAD(first);
    for (int it = first; it < items; it += c.ngw) { const int kb = it / nblk, nb = it % nblk;
#pragma unroll
        for (int i = 0; i < 8; ++i) { LAS float* d = scr + (8 * i + (lane >> 3)) * 33 + (lane & 7) * 4; d[0] = r[i][0]; d[1] = r[i][1]; d[2] = r[i][2]; d[3] = r[i][3]; }
        if (it + c.ngw < items) TR_LOAD(it + c.ngw);
        LDS_WAIT(); asm volatile("" ::: "memory");
        const int cc = lane & 7;
#pragma unroll
        for (int j = 0; j < 4; ++j) { const int n = (lane >> 3) + 8 * j; const LAS float* sp = scr + (8 * cc) * 33 + n;
            u32x4 o; o.x = cvt_pk_bf16(sp[0 * 33], sp[1 * 33]); o.y = cvt_pk_bf16(sp[2 * 33], sp[3 * 33]); o.z = cvt_pk_bf16(sp[4 * 33], sp[5 * 33]); o.w = cvt_pk_bf16(sp[6 * 33], sp[7 * 33]);
            *(u32x4*)(WT + (size_t)(row_off + nb * 32 + n) * ldt + kb * 64 + 8 * cc) = o; }
        LDS_WAIT(); asm volatile("" ::: "memory"); }
#undef TR_LOAD
    rot += items;
}

__device__ __forceinline__ void peer_convert_rows(KP P, const Ctx& c, int g_lo, int g_hi, int rank, int nranks) {
    unsigned char* ws = P->ws;
    f32x4 xn[2][8];
#define CV_LOAD(g0_) do { _Pragma("unroll") for (int h = 0; h < 2; ++h) { const int g = ((g0_) + h < g_hi) ? (g0_) + h : (g0_); const int lt = g >> 14, e = g & 16383, layer = lt >> 1, t = lt & 1; \
            const float* sp = P->in[t ? I_PV : I_PU] + ((size_t)layer * 16384 + e) * D + c.lane * 16; \
            _Pragma("unroll") for (int q = 0; q < 8; ++q) xn[h][q] = *(const f32x4*)(sp + (q >> 2) * 1024 + (q & 3) * 4); } } while (0)
    { const int gf = g_lo + (rank * 8 + c.wave) * 2; if (gf < g_hi) CV_LOAD(gf); }
    for (int g0 = g_lo + (rank * 8 + c.wave) * 2; g0 < g_hi; g0 += nranks * 16) {
        f32x4 x[2][8]; float am[2] = {0.f, 0.f};
#pragma unroll
        for (int h = 0; h < 2; ++h)
#pragma unroll
            for (int q = 0; q < 8; ++q) x[h][q] = xn[h][q];
        if (g0 + nranks * 16 < g_hi) CV_LOAD(g0 + nranks * 16);
#pragma unroll
        for (int h = 0; h < 2; ++h) { if (g0 + h >= g_hi) break;
            const int g = g0 + h; const int lt = g >> 14, e = g & 16383, layer = lt >> 1, t = lt & 1;
#pragma unroll
            for (int q = 0; q < 8; ++q) am[h] = fmaxf(am[h], fmaxf(fmaxf(fabsf(x[h][q][0]), fabsf(x[h][q][1])), fmaxf(fabsf(x[h][q][2]), fabsf(x[h][q][3]))));
            const float a = wave_max(am[h]);
            const float sc = a > 0.f ? exp2f(floorf(log2f(384.0f / a))) : 1.0f;
            if (c.lane == 0) ((float*)(ws + WS_PSC))[(size_t)t * 4 * 16384 + layer * 16384 + e] = 1.0f / sc;
            unsigned char* dst = ws + (t ? WS_PV : WS_PU) + (size_t)layer * 16384 * D;
#pragma unroll
            for (int jj = 0; jj < 2; ++jj) { u32x4 o;
#pragma unroll
                for (int w = 0; w < 4; ++w) { const f32x4 v = x[h][jj * 4 + w] * sc; int p = 0; p = __builtin_amdgcn_cvt_pk_fp8_f32(v[0], v[1], p, false); p = __builtin_amdgcn_cvt_pk_fp8_f32(v[2], v[3], p, true); o[w] = (unsigned)p; }
                const int db = (c.lane >> 3) + 8 * jj;
                *(u32x4*)(dst + ((size_t)db * 16384 + e) * 128 + (c.lane & 7) * 16) = o; } } }
#undef CV_LOAD
}
__device__ __forceinline__ void phase_prologue(KP P, const Ctx& c) {
    unsigned char* ws = P->ws;
    PROBE_REP(14) {
        LAS float* sl = (LAS float*)c.lds;
        LAS float* red = sl + 1280;
        for (int un = blockIdx.x; un < 4 * 24 * 8; un += gridDim.x) {
            const int layer = un / 192, r = un % 192, nb = r / 8, kc = r % 8;
            __syncthreads();
            for (int i = c.tid; i < 5 * 256; i += 512) { const int v = i >> 8, k = kc * 256 + (i & 255); const float x = v < 4 ? P->in[I_C][v * D + k] : P->in[I_CCTX][k]; sl[i] = siluf_(x); }
            __syncthreads();
            const int cg = c.tid & 127, ks = c.tid >> 7;
            const float* w = P->in[I_ADAW] + ((size_t)layer * D + kc * 256 + ks * 64) * 12288 + nb * 512 + cg * 4;
            f32x4 a0 = (f32x4){0.f, 0.f, 0.f, 0.f}, a1 = a0, a2 = a0, a3 = a0, a4 = a0;
            f32x4 wn[8];
#pragma unroll
            for (int i = 0; i < 8; ++i) wn[i] = *(const f32x4*)(w + (size_t)i * 12288);
#pragma unroll 1
            for (int k0 = 0; k0 < 64; k0 += 8) { f32x4 wc[8];
#pragma unroll
                for (int i = 0; i < 8; ++i) wc[i] = wn[i];
                if (k0 + 8 < 64) {
#pragma unroll
                    for (int i = 0; i < 8; ++i) wn[i] = *(const f32x4*)(w + (size_t)(k0 + 8 + i) * 12288); }
#pragma unroll
                for (int i = 0; i < 8; ++i) { const f32x4 wv = wc[i]; const int kk = ks * 64 + k0 + i;
                    a0 += wv * sl[kk]; a1 += wv * sl[256 + kk]; a2 += wv * sl[512 + kk]; a3 += wv * sl[768 + kk]; a4 += wv * sl[1024 + kk]; } }
            LAS float* rp = red + (ks * 5) * 512 + cg * 4;
            *(LAS f32x4*)(rp) = a0; *(LAS f32x4*)(rp + 512) = a1; *(LAS f32x4*)(rp + 1024) = a2; *(LAS f32x4*)(rp + 1536) = a3; *(LAS f32x4*)(rp + 2048) = a4;
            __syncthreads();
            for (int i = c.tid; i < 5 * 512; i += 512) { const int v = i >> 9, n = i & 511;
                const float sum = (red[(0 * 5 + v) * 512 + n] + red[(1 * 5 + v) * 512 + n]) + (red[(2 * 5 + v) * 512 + n] + red[(3 * 5 + v) * 512 + n]);
                ((float*)(ws + WS_MODP))[((size_t)(layer * 8 + kc) * 5 + v) * 12288 + nb * 512 + n] = sum; }
        }
        __syncthreads();
    }
    PROBE_REP(16) {
    int rot = 0;
    for (int j = 0; j < 2; ++j) {
        tr_job(c, rot, P->in[I_RGWIN] + (size_t)j * D * 4096, D, 4096, 4096, (bf16_t*)(ws + WS_RGIN) + (size_t)j * 4096 * D, D, 0);
        tr_job(c, rot, P->in[I_RGWOUT] + (size_t)j * D * D, D, D, D, (bf16_t*)(ws + WS_RGOUT) + (size_t)j * D * D, D, 0);
    }
    {
        LAS float* scr = (LAS float*)(c.lds + c.wave * 16384);
        const int items = 64 * 32;
        int first = c.gw - (rot % c.ngw); if (first < 0) first += c.ngw;
        for (int it = first; it < items; it += c.ngw) {
            const int mat = it >> 5, sub = it & 31, kb = sub >> 3, nb32 = sub & 7;
            const int jl = mat >> 5, d = (mat >> 4) & 1, g = (mat >> 3) & 1, nblk = mat & 7;
            const int n0 = nb32 * 32, hf = n0 >> 7, pn = (d * 8 + nblk) * 2 + hf;
            transpose_item(P->in[I_RGGW] + (size_t)mat * 65536, 256, (bf16_t*)(ws + WS_RGGATE) + (size_t)jl * 8192 * 256, 256, kb * 64, n0, pn * 256 + g * 128 + (n0 & 127), scr, c.lane);
        }
        rot += items;
    }
    for (int m = 0; m < 3; ++m) tr_job(c, rot, P->in[I_RWRKV] + (size_t)m * D * D, D, D, D, (bf16_t*)(ws + WS_RW1), D, m * D);
    for (int d = 0; d < 2; ++d) {
        tr_job(c, rot, P->in[I_RWDEC1] + (size_t)d * D * 96, D, 96, 96, (bf16_t*)(ws + WS_RW1), D, 6144 + d * 96);
        tr_job(c, rot, P->in[I_RWICL1] + (size_t)d * D * 96, D, 96, 96, (bf16_t*)(ws + WS_RW1), D, 6400 + d * 96);
    }
    tr_job(c, rot, P->in[I_RWG1], D, 256, 256, (bf16_t*)(ws + WS_RW1), D, 6656);
    tr_job(c, rot, P->in[I_RWWO], D, D, D, (bf16_t*)(ws + WS_RWO), D, 0);
    tr_job(c, rot, P->in[I_RETWIN], D, 16384, 16384, (bf16_t*)(ws + WS_RETIN), D, 0);
    tr_job(c, rot, P->in[I_RETWOUT], 4096, D, D, (bf16_t*)(ws + WS_RETOUT), 4096, 0);
    }
    PROBE_REP(17) {
    for (size_t i0 = c.gtid; i0 < (size_t)4 * D * D / 8; i0 += 4 * (size_t)c.ngt) { f32x4 a[4], b[4];
#pragma unroll
        for (int u = 0; u < 4; ++u) { const size_t i = i0 + (size_t)u * c.ngt; if (i < (size_t)4 * D * D / 8) { a[u] = *(const f32x4*)(P->in[I_PWQ] + i * 8); b[u] = *(const f32x4*)(P->in[I_PWQ] + i * 8 + 4); } }
#pragma unroll
        for (int u = 0; u < 4; ++u) { const size_t i = i0 + (size_t)u * c.ngt; if (i < (size_t)4 * D * D / 8)
            *(u32x4*)((bf16_t*)(ws + WS_WQN) + i * 8) = (u32x4){cvt_pk_bf16(a[u][0], a[u][1]), cvt_pk_bf16(a[u][2], a[u][3]), cvt_pk_bf16(b[u][0], b[u][1]), cvt_pk_bf16(b[u][2], b[u][3])}; } }
    for (int i = c.gtid; i < 2 * 64 * (D / 8); i += c.ngt) { const int blk = i / (64 * (D / 8)), r = (i / (D / 8)) % 64, c8 = i % (D / 8);
        *(u32x4*)((bf16_t*)(ws + WS_RW1) + (size_t)(6144 + blk * 256 + 192 + r) * D + c8 * 8) = (u32x4){0u, 0u, 0u, 0u}; }
    for (int i = c.gtid; i < 4 * 2048 * 32; i += c.ngt) { const int c8 = i & 31, row = (i >> 5) & 2047, l = i >> 16; const int p = (row >> 7) & 1, col = c8 * 8;
        u32x4 o = (u32x4){0u, 0u, 0u, 0u};
        if ((col >> 7) == p) { const float* s = P->in[I_PKEYS] + ((size_t)l * 2048 + row) * 128 + (col & 127); const f32x4 a = *(const f32x4*)s, b = *(const f32x4*)(s + 4);
            o.x = cvt_pk_bf16(a[0], a[1]); o.y = cvt_pk_bf16(a[2], a[3]); o.z = cvt_pk_bf16(b[0], b[1]); o.w = cvt_pk_bf16(b[2], b[3]); }
        *(u32x4*)((bf16_t*)(ws + WS_KEYS) + ((size_t)l * 2048 + row) * 256 + col) = o; }
    for (int i0 = c.gtid; i0 < 10240 * 256; i0 += 4 * c.ngt) { float v4[4];
#pragma unroll
        for (int u = 0; u < 4; ++u) { const int i = i0 + u * c.ngt; float v = 0.f;
            if (i < 10240 * 256) { const int kc = i & 255, r = i >> 8;
                if (r < 4096) { const int d = r >> 11, cc = r & 2047, k = kc - 96 * d; if (k >= 0 && k < 96) v = P->in[I_RWDEC2][((size_t)d * 96 + k) * D + cc]; }
                else if (r < 8192) { const int rr = r - 4096, d = rr >> 11, cc = rr & 2047, k = kc - 96 * d; if (k >= 0 && k < 96) v = P->in[I_RWICL2][((size_t)d * 96 + k) * D + cc]; }
                else v = P->in[I_RWG2][(size_t)kc * D + (r - 8192)]; }
            v4[u] = v; }
#pragma unroll
        for (int u = 0; u < 4; ++u) { const int i = i0 + u * c.ngt; if (i < 10240 * 256) ((bf16_t*)(ws + WS_RW2))[i] = (bf16_t)(cvt_pk_bf16(v4[u], 0.f) & 0xffffu); } }
    }
    PROBE_REP(18)
    for (int i = c.gtid; i < 2 * 2 * D; i += c.ngt) ((float*)(ws + WS_SPT))[i] = -8.0f * log1pf(expf(-P->in[I_RGLAM][i]));
    PROBE_REP(18)
    for (int i = c.gtid; i < SLEN * 128; i += c.ngt) { const int pos = i >> 7, k = i & 127; const float theta = 1.0f / powf(10000.0f, (float)k / 127.0f); const float ang = (float)pos * theta;
        ((f32x2*)(ws + WS_CS))[i] = (f32x2){cosf(ang), sinf(ang)}; }
}
__device__ __forceinline__ void phase_modfin(KP P, const Ctx& c) {
    for (int i = c.gtid; i < 4 * 5 * 12288; i += c.ngt) { const int n = i % 12288, lv = i / 12288, l = lv / 5, v = lv % 5;
        float s = P->in[I_ADAB][l * 12288 + n];
        for (int kc = 0; kc < 8; ++kc) s += ((const float*)(P->ws + WS_MODP))[((size_t)(l * 8 + kc) * 5 + v) * 12288 + n];
        ((float*)(P->ws + WS_MOD))[i] = s; }
}
__device__ __forceinline__ void phase_xinit(KP P, const Ctx& c) {
    bf16_t* X = (bf16_t*)(P->ws + WS_X); bf16_t* A0 = (bf16_t*)(P->ws + WS_A0);
    for (size_t i0 = c.gtid; i0 < TD / 4; i0 += 4 * (size_t)c.ngt) {
        f32x4 x[4], sh[4], sc[4];
#pragma unroll
        for (int u = 0; u < 4; ++u) { const size_t i = i0 + (size_t)u * c.ngt; if (i < TD / 4) { const int row = (int)(i >> 9), c4 = (int)(i & 511) * 4;
            const float* src = row < NCTX ? P->in[I_CTX] + (size_t)row * D : P->in[I_X] + (size_t)(row - NCTX) * D; const int v = row_vec(row);
            x[u] = *(const f32x4*)(src + c4); sh[u] = *(const f32x4*)(modp(P, 0, v, 0) + c4); sc[u] = *(const f32x4*)(modp(P, 0, v, 1) + c4); } }
#pragma unroll
        for (int u = 0; u < 4; ++u) { const size_t i = i0 + (size_t)u * c.ngt; if (i < TD / 4) { const int row = (int)(i >> 9), c4 = (int)(i & 511) * 4;
            *(u32x2*)(X + (size_t)row * D + c4) = (u32x2){cvt_pk_bf16(x[u][0], x[u][1]), cvt_pk_bf16(x[u][2], x[u][3])};
            const f32x4 h = x[u] * (sc[u] + 1.0f) + sh[u];
            *(u32x2*)(A0 + (size_t)row * D + c4) = (u32x2){cvt_pk_bf16(h[0], h[1]), cvt_pk_bf16(h[2], h[3])}; } } }
}

__device__ __forceinline__ void phase_rg_conv(KP P, const Ctx& c, int jl) {
    const bf16_t* UR = (const bf16_t*)(P->ws + L_UR); bf16_t* XC = (bf16_t*)(P->ws + L_XC);
    const float* cw = P->in[I_RGCW] + (size_t)jl * 4 * D; const float* cb = P->in[I_RGCB] + (size_t)jl * D;
    const int c8 = (int)(c.gtid & 255) * 8;
    float w8[4][8], b8[8];
#pragma unroll
    for (int j = 0; j < 8; ++j) { b8[j] = cb[c8 + j];
#pragma unroll
        for (int tp = 0; tp < 4; ++tp) w8[tp][j] = cw[tp * D + c8 + j]; }
    for (size_t i0 = c.gtid; i0 < TD / 8; i0 += 2 * (size_t)c.ngt) {
        u32x4 u[2][4];
#pragma unroll
        for (int q = 0; q < 2; ++q) { const size_t i = i0 + (size_t)q * c.ngt; const int row = (int)(i >> 8);
            int lo, hi; if (row < NCTX) { lo = row & ~(CTX - 1); hi = lo + CTX; } else { lo = NCTX + ((row - NCTX) & ~(SEQ - 1)); hi = lo + SEQ; }
#pragma unroll
            for (int tp = 0; tp < 4; ++tp) { const int rr = row + tp - 2; u[q][tp] = (u32x4){0u, 0u, 0u, 0u};
                if (i < TD / 8 && rr >= lo && rr < hi) u[q][tp] = *(const u32x4*)(UR + (size_t)rr * D + c8); } }
#pragma unroll
        for (int q = 0; q < 2; ++q) { const size_t i = i0 + (size_t)q * c.ngt; if (i >= TD / 8) break; const int row = (int)(i >> 8);
            float a[8];
#pragma unroll
            for (int j = 0; j < 8; ++j) a[j] = b8[j];
#pragma unroll
            for (int tp = 0; tp < 4; ++tp) { const u32x4 uu = u[q][tp]; const unsigned u0 = uu.x, u1 = uu.y, u2 = uu.z, u3 = uu.w;
                a[0] += w8[tp][0] * bflo(u0); a[1] += w8[tp][1] * bfhi(u0); a[2] += w8[tp][2] * bflo(u1); a[3] += w8[tp][3] * bfhi(u1);
                a[4] += w8[tp][4] * bflo(u2); a[5] += w8[tp][5] * bfhi(u2); a[6] += w8[tp][6] * bflo(u3); a[7] += w8[tp][7] * bfhi(u3); }
            *(u32x4*)(XC + (size_t)row * D + c8) = (u32x4){cvt_pk_bf16(a[0], a[1]), cvt_pk_bf16(a[2], a[3]), cvt_pk_bf16(a[4], a[5]), cvt_pk_bf16(a[6], a[7])}; } }
}
__device__ __forceinline__ void phase_rg_scan1(KP P, const Ctx& c) {
    const bf16_t* LA = (const bf16_t*)(P->ws + L_LA); const bf16_t* BB = (const bf16_t*)(P->ws + L_BB);
    float* CA = (float*)(P->ws + WS_CA); float* CH = (float*)(P->ws + WS_CH);
    for (int u = c.gw; u < 2048; u += c.ngw) { const int b = u >> 9, dir = (u >> 8) & 1, ck = (u >> 2) & 63, ch = (u & 3) * 512 + c.lane * 8;
        float h[8], sl[8];
#pragma unroll
        for (int e = 0; e < 8; ++e) { h[e] = 0.f; sl[e] = 0.f; }
        u32x4 nl[4], nb[4];
#define SC1_LOAD(s0_) do { _Pragma("unroll") for (int i_ = 0; i_ < 4; ++i_) { const int row_ = seq_row(b, dir, ck * 68 + (s0_) + i_); const size_t o_ = ((size_t)row_ * 2 + dir) * D + ch; nl[i_] = *(const u32x4*)(LA + o_); nb[i_] = *(const u32x4*)(BB + o_); } } while (0)
        SC1_LOAD(0);
#pragma unroll 1
        for (int s0 = 0; s0 < 68; s0 += 4) { u32x4 cl[4], cb[4];
#pragma unroll
            for (int i = 0; i < 4; ++i) { cl[i] = nl[i]; cb[i] = nb[i]; }
            if (s0 + 4 < 68) SC1_LOAD(s0 + 4);
#pragma unroll
            for (int i = 0; i < 4; ++i) { float l8[8], b8[8]; unpack8(cl[i], l8); unpack8(cb[i], b8);
#pragma unroll
                for (int e = 0; e < 8; ++e) { h[e] = __expf(l8[e]) * h[e] + b8[e]; sl[e] += l8[e]; } } }
#undef SC1_LOAD
        const size_t o = ((size_t)(b * 2 + dir) * 64 + ck) * D + ch;
        *(f32x4*)(CA + o) = (f32x4){sl[0], sl[1], sl[2], sl[3]}; *(f32x4*)(CA + o + 4) = (f32x4){sl[4], sl[5], sl[6], sl[7]};
        *(f32x4*)(CH + o) = (f32x4){h[0], h[1], h[2], h[3]}; *(f32x4*)(CH + o + 4) = (f32x4){h[4], h[5], h[6], h[7]}; }
}
__device__ __forceinline__ void phase_rg_scan2(KP P, const Ctx& c) {
    const float* CA = (const float*)(P->ws + WS_CA); const float* CH = (const float*)(P->ws + WS_CH); float* CIN = (float*)(P->ws + WS_CIN);
    for (int i = c.gtid; i < 4 * 2 * D; i += c.ngt) { const int ch = i & (D - 1), bd = i >> 11; float carry = 0.f;
#pragma unroll 1
        for (int c0 = 0; c0 < 64; c0 += 16) { float a[16], hh[16];
#pragma unroll
            for (int q = 0; q < 16; ++q) { const size_t o = ((size_t)bd * 64 + c0 + q) * D + ch; a[q] = CA[o]; hh[q] = CH[o]; }
#pragma unroll
            for (int q = 0; q < 16; ++q) { const size_t o = ((size_t)bd * 64 + c0 + q) * D + ch; CIN[o] = carry; carry = __expf(a[q]) * carry + hh[q]; } } }
}
template <int DIR> __device__ __forceinline__ void phase_rg_scan3(KP P, const Ctx& c) {
    const bf16_t* LA = (const bf16_t*)(P->ws + L_LA); const bf16_t* BB = (const bf16_t*)(P->ws + L_BB); const bf16_t* UG = (const bf16_t*)(P->ws + L_UG);
    const float* CIN = (const float*)(P->ws + WS_CIN); bf16_t* YIN = (bf16_t*)(P->ws + L_YIN); bf16_t* HF = (bf16_t*)(P->ws + L_XC);
    for (int u = c.gw; u < 2048; u += c.ngw) { const int b = u >> 9, ck = (u >> 3) & 63, ch = (u & 7) * 256 + c.lane * 4;
        const f32x4 h0 = *(const f32x4*)(CIN + ((size_t)(b * 2 + DIR) * 64 + ck) * D + ch); float h[4] = {h0[0], h0[1], h0[2], h0[3]};
        u32x2 nl[4], nb[4], nf[4], ng[4];
#define SC3_LOAD(s0_) do { _Pragma("unroll") for (int i_ = 0; i_ < 4; ++i_) { const int row_ = seq_row(b, DIR, ck * 68 + (s0_) + i_); const size_t o_ = ((size_t)row_ * 2 + DIR) * D + ch, q_ = (size_t)row_ * D + ch; \
            nl[i_] = *(const u32x2*)(LA + o_); nb[i_] = *(const u32x2*)(BB + o_); if (DIR == 1) { nf[i_] = *(const u32x2*)(HF + q_); ng[i_] = *(const u32x2*)(UG + q_); } } } while (0)
        SC3_LOAD(0);
#pragma unroll 1
        for (int s0 = 0; s0 < 68; s0 += 4) { u32x2 cl[4], cb[4], cf[4], cg[4];
#pragma unroll
            for (int i = 0; i < 4; ++i) { cl[i] = nl[i]; cb[i] = nb[i]; if (DIR == 1) { cf[i] = nf[i]; cg[i] = ng[i]; } }
            if (s0 + 4 < 68) SC3_LOAD(s0 + 4);
#pragma unroll
            for (int i = 0; i < 4; ++i) { const int row = seq_row(b, DIR, ck * 68 + s0 + i); const size_t q = (size_t)row * D + ch;
                const unsigned l0 = cl[i].x, l1 = cl[i].y, b0 = cb[i].x, b1 = cb[i].y;
                h[0] = __expf(bflo(l0)) * h[0] + bflo(b0); h[1] = __expf(bfhi(l0)) * h[1] + bfhi(b0); h[2] = __expf(bflo(l1)) * h[2] + bflo(b1); h[3] = __expf(bfhi(l1)) * h[3] + bfhi(b1);
                if (DIR == 0) { *(u32x2*)(HF + q) = (u32x2){cvt_pk_bf16(h[0], h[1]), cvt_pk_bf16(h[2], h[3])}; }
                else { const unsigned f0 = cf[i].x, f1 = cf[i].y, g0 = cg[i].x, g1 = cg[i].y;
                    *(u32x2*)(YIN + q) = (u32x2){cvt_pk_bf16(bflo(g0) * (bflo(f0) + h[0]), bfhi(g0) * (bfhi(f0) + h[1])), cvt_pk_bf16(bflo(g1) * (bflo(f1) + h[2]), bfhi(g1) * (bfhi(f1) + h[3]))}; } } }
#undef SC3_LOAD
    }
}

__device__ __forceinline__ void phase_ln_mid(KP P, const Ctx& c, int layer, int row_lo) {
    bf16_t* X = (bf16_t*)(P->ws + WS_X); bf16_t* H2 = (bf16_t*)(P->ws + WS_H2);
    const float* lg = P->in[I_LNG] + (size_t)(layer * 2 + 0) * D; const float* lb = P->in[I_LNB] + (size_t)(layer * 2 + 0) * D;
    u32x2 xn[8];
    f32x4 lg8[8], lb8[8];
#pragma unroll
    for (int j = 0; j < 8; ++j) { lg8[j] = *(const f32x4*)(lg + c.lane * 4 + 256 * j); lb8[j] = *(const f32x4*)(lb + c.lane * 4 + 256 * j); }
    const bf16_t* PB = (const bf16_t*)(P->ws + WS_S);
    u32x2 pn[8];
    { const int r0 = row_lo + c.gw; if (r0 < T) {
#pragma unroll
        for (int j = 0; j < 8; ++j) { xn[j] = *(const u32x2*)(X + (size_t)r0 * D + c.lane * 4 + 256 * j); pn[j] = *(const u32x2*)(PB + (size_t)r0 * D + c.lane * 4 + 256 * j); } } }
    for (int row = row_lo + c.gw; row < T; row += c.ngw) { bf16_t* xr = X + (size_t)row * D + c.lane * 4; const int v = row_vec(row);
        f32x4 x[8]; float s = 0.f;
        { const float* gp = modp(P, layer, v, 2) + c.lane * 4;
#pragma unroll
          for (int j = 0; j < 8; ++j) { const unsigned p0 = pn[j].x, p1 = pn[j].y, x0 = xn[j].x, x1 = xn[j].y;
              x[j] = (f32x4){bflo(x0), bfhi(x0), bflo(x1), bfhi(x1)} * ALPHA + *(const f32x4*)(gp + 256 * j) * (f32x4){bflo(p0), bfhi(p0), bflo(p1), bfhi(p1)}; } }
        if (row + c.ngw < T) {
#pragma unroll
            for (int j = 0; j < 8; ++j) { xn[j] = *(const u32x2*)(X + (size_t)(row + c.ngw) * D + c.lane * 4 + 256 * j); pn[j] = *(const u32x2*)(PB + (size_t)(row + c.ngw) * D + c.lane * 4 + 256 * j); } }
#pragma unroll
        for (int j = 0; j < 8; ++j) s += (x[j][0] + x[j][1]) + (x[j][2] + x[j][3]);
        const float mean = wave_sum(s) * (1.0f / D); float q = 0.f;
#pragma unroll
        for (int j = 0; j < 8; ++j) { x[j] = x[j] - mean; q += (x[j][0] * x[j][0] + x[j][1] * x[j][1]) + (x[j][2] * x[j][2] + x[j][3] * x[j][3]); }
        const float rstd = rsqrtf(wave_sum(q) * (1.0f / D) + LN_EPS);
        const float* m3 = modp(P, layer, v, 3) + c.lane * 4; const float* m4 = modp(P, layer, v, 4) + c.lane * 4;
#pragma unroll
        for (int jh = 0; jh < 2; ++jh) { f32x4 g4[4], b4[4], p4[4], q4[4];
#pragma unroll
            for (int jj = 0; jj < 4; ++jj) { const int j = 4 * jh + jj; g4[jj] = lg8[j]; b4[jj] = lb8[j];
                p4[jj] = *(const f32x4*)(m4 + 256 * j); q4[jj] = *(const f32x4*)(m3 + 256 * j); }
#pragma unroll
            for (int jj = 0; jj < 4; ++jj) { const int j = 4 * jh + jj;
                const f32x4 y = x[j] * rstd * g4[jj] + b4[jj]; *(u32x2*)(xr + 256 * j) = (u32x2){cvt_pk_bf16(y[0], y[1]), cvt_pk_bf16(y[2], y[3])};
                const f32x4 h = y * (p4[jj] + 1.0f) + q4[jj];
                *(u32x2*)(H2 + (size_t)row * D + c.lane * 4 + 256 * j) = (u32x2){cvt_pk_bf16(h[0], h[1]), cvt_pk_bf16(h[2], h[3])}; } } }
}

__device__ __forceinline__ float dot2bf(unsigned a, unsigned b, float s) { return __builtin_amdgcn_fdot2_f32_bf16(__builtin_bit_cast(bf16v2, a), __builtin_bit_cast(bf16v2, b), s, false); }
__device__ __forceinline__ float dot8(const u32x4 a, const u32x4 b, float s) {
    const unsigned a0 = a.x, a1 = a.y, a2 = a.z, a3 = a.w, b0 = b.x, b1 = b.y, b2 = b.z, b3 = b.w;
    s = dot2bf(a0, b0, s); s = dot2bf(a1, b1, s); s = dot2bf(a2, b2, s); s = dot2bf(a3, b3, s);
    return s;
}
template <int CTRL> __device__ __forceinline__ int dpp_movi(int x) { return __builtin_amdgcn_update_dpp(x, x, CTRL, 0xF, 0xF, false); }
__device__ __forceinline__ int row_max_i(int m) { m = max(m, dpp_movi<0xB1>(m)); m = max(m, dpp_movi<0x4E>(m)); m = max(m, dpp_movi<0x141>(m)); m = max(m, dpp_movi<0x140>(m)); return m; }
template <int PAT> __device__ __forceinline__ int swz(int v) { return __builtin_amdgcn_ds_swizzle(v, PAT); }
__device__ __forceinline__ int f2key(float f) { const int b = __float_as_int(f); return b ^ ((b >> 31) & 0x7fffffff); }
__device__ __forceinline__ float key2f(int k) { return __int_as_float(k ^ ((k >> 31) & 0x7fffffff)); }
__device__ __forceinline__ void row_max_i_pair(int& a, int& b) {
    asm volatile("s_nop 1\n\t"
        "v_max_i32_dpp %0, %0, %0 quad_perm:[1,0,3,2] row_mask:0xf bank_mask:0xf\n\tv_max_i32_dpp %1, %1, %1 quad_perm:[1,0,3,2] row_mask:0xf bank_mask:0xf\n\ts_nop 0\n\t"
        "v_max_i32_dpp %0, %0, %0 quad_perm:[2,3,0,1] row_mask:0xf bank_mask:0xf\n\tv_max_i32_dpp %1, %1, %1 quad_perm:[2,3,0,1] row_mask:0xf bank_mask:0xf\n\ts_nop 0\n\t"
        "v_max_i32_dpp %0, %0, %0 row_half_mirror row_mask:0xf bank_mask:0xf\n\tv_max_i32_dpp %1, %1, %1 row_half_mirror row_mask:0xf bank_mask:0xf\n\ts_nop 0\n\t"
        "v_max_i32_dpp %0, %0, %0 row_mirror row_mask:0xf bank_mask:0xf\n\tv_max_i32_dpp %1, %1, %1 row_mirror row_mask:0xf bank_mask:0xf"
        : "+v"(a), "+v"(b));
}
__device__ __forceinline__ void phase_peer_select(KP P, const Ctx& c, int row_lo) {
    const float* S = (const float*)(P->ws + WS_S); float* SW = (float*)(P->ws + WS_SELW);
    constexpr int KMIN = (int)0x80000000;
    const int nps = (2 * (T - row_lo) - c.gw + c.ngw - 1) / c.ngw;
    f32x4 sn[2][2];
#define SEL_LOAD(k) do { const int pid_ = 2 * row_lo + c.gw + (k) * c.ngw; const float* sp_ = S + (size_t)(pid_ >> 1) * D + (2 * (pid_ & 1)) * 512 + lane * 8; \
        sn[0][0] = *(const f32x4*)sp_; sn[0][1] = *(const f32x4*)(sp_ + 4); sn[1][0] = *(const f32x4*)(sp_ + 512); sn[1][1] = *(const f32x4*)(sp_ + 516); } while (0)
    { int lane = c.lane; asm volatile("" : "+v"(lane)); if (nps > 0) SEL_LOAD(0); }
    {
#pragma unroll 1
        for (int kk = 0; kk < nps; ++kk) {
            const int pid = 2 * row_lo + c.gw + kk * c.ngw, row = pid >> 1, pp = pid & 1;
            int lane = c.lane; asm volatile("" : "+v"(lane));
            const int l16 = lane & 15, isS2 = (lane >> 4) & 1;
            int k8[2][8];
#pragma unroll
            for (int q = 0; q < 2; ++q) {
#pragma unroll
                for (int e = 0; e < 8; ++e) { const float v = sn[q][e >> 2][e & 3]; k8[q][e] = (f2key(v) & ~127) | (127 - (l16 * 8 + e)); } }
            if (kk + 1 < nps) SEL_LOAD(kk + 1);
#define SEL_CE(a, b) do { const int hi_ = max(a, b), lo_ = min(a, b); a = hi_; b = lo_; } while (0)
#pragma unroll
            for (int q = 0; q < 2; ++q) { int (&k)[8] = k8[q];
                SEL_CE(k[0], k[1]); SEL_CE(k[2], k[3]); SEL_CE(k[4], k[5]); SEL_CE(k[6], k[7]); SEL_CE(k[0], k[2]); SEL_CE(k[1], k[3]); SEL_CE(k[4], k[6]); SEL_CE(k[5], k[7]);
                SEL_CE(k[1], k[2]); SEL_CE(k[5], k[6]); SEL_CE(k[0], k[4]); SEL_CE(k[3], k[7]); SEL_CE(k[1], k[5]); SEL_CE(k[2], k[6]); SEL_CE(k[1], k[4]); SEL_CE(k[3], k[6]);
                SEL_CE(k[2], k[4]); SEL_CE(k[3], k[5]); SEL_CE(k[3], k[4]); }
            int own[2] = {KMIN, KMIN};
#pragma unroll
            for (int it = 0; it < 16; ++it) {
                int m0 = k8[0][0], m1 = k8[1][0];
                row_max_i_pair(m0, m1);
                const bool p0 = k8[0][0] == m0, p1 = k8[1][0] == m1;
#pragma unroll
                for (int e = 0; e < 7; ++e) { k8[0][e] = p0 ? k8[0][e + 1] : k8[0][e]; k8[1][e] = p1 ? k8[1][e + 1] : k8[1][e]; }
                k8[0][7] = p0 ? KMIN : k8[0][7]; k8[1][7] = p1 ? KMIN : k8[1][7];
                own[0] = (l16 == it) ? m0 : own[0]; own[1] = (l16 == it) ? m1 : own[1]; }
            int ck[2][4], ownIdx[2];
#pragma unroll
            for (int q = 0; q < 2; ++q) { ownIdx[q] = 127 - (own[q] & 127); const float ownVal = key2f(own[q]);
                int pk[4]; pk[0] = swz<(0x10 << 10) | (0 << 5) | 0x10>(own[q]); pk[1] = swz<(0x10 << 10) | (1 << 5) | 0x10>(own[q]); pk[2] = swz<(0x10 << 10) | (2 << 5) | 0x10>(own[q]); pk[3] = swz<(0x10 << 10) | (3 << 5) | 0x10>(own[q]);
#pragma unroll
                for (int m = 0; m < 4; ++m) { const float pv = key2f(pk[m]);
                    const int ci = isS2 ? m : l16, cj = isS2 ? l16 : m;
                    const bool valid = (isS2 ? (m <= l16) : (m < l16)) && ((ci + 1) * (cj + 1) <= 16);
                    ck[q][m] = valid ? ((f2key(ownVal + pv) & ~255) | (255 - (ci * 16 + cj))) : KMIN; } }
#pragma unroll
            for (int q = 0; q < 2; ++q) { int (&k)[4] = ck[q]; SEL_CE(k[0], k[1]); SEL_CE(k[2], k[3]); SEL_CE(k[0], k[2]); SEL_CE(k[1], k[3]); SEL_CE(k[1], k[2]); }
#undef SEL_CE
            int win[2] = {KMIN, KMIN};
#pragma unroll
            for (int it = 0; it < 16; ++it) {
                int m0 = ck[0][0], m1 = ck[1][0];
                row_max_i_pair(m0, m1);
                m0 = max(m0, swz<(0x10 << 10) | 0x1F>(m0)); m1 = max(m1, swz<(0x10 << 10) | 0x1F>(m1));
                const bool p0 = ck[0][0] == m0, p1 = ck[1][0] == m1;
#pragma unroll
                for (int e = 0; e < 3; ++e) { ck[0][e] = p0 ? ck[0][e + 1] : ck[0][e]; ck[1][e] = p1 ? ck[1][e + 1] : ck[1][e]; }
                ck[0][3] = p0 ? KMIN : ck[0][3]; ck[1][3] = p1 ? KMIN : ck[1][3];
                win[0] = (l16 == it) ? m0 : win[0]; win[1] = (l16 == it) ? m1 : win[1]; }
#pragma unroll
            for (int q = 0; q < 2; ++q) {
                const int cidx = 255 - (win[q] & 255), ci = (cidx >> 4) & 15, cj = cidx & 15, rb = lane & 32;
                const int i1 = __builtin_amdgcn_ds_bpermute((rb + ci) << 2, ownIdx[q]), i2 = __builtin_amdgcn_ds_bpermute((rb + 16 + cj) << 2, ownIdx[q]);
                const float sc = key2f(win[q]);
                const float mxf = key2f(row_max_i(f2key(sc)));
                const float ex = __expf(sc - mxf);
                float sum = ex; sum += dpp_mov<0xB1>(sum); sum += dpp_mov<0x4E>(sum); sum += dpp_mov<0x141>(sum); sum += dpp_mov<0x140>(sum);
                if (!isS2) { const size_t o = ((size_t)row * 8 + (2 * pp + q) * 2 + (lane >> 5)) * 16 + l16; const int e_ = (i1 * 128 + i2) & 16383; ((unsigned short*)(P->ws + P_SE16))[o] = (unsigned short)e_; SW[o] = ex / sum; } }
        }
    }
#undef SEL_LOAD
}

__device__ __forceinline__ float dot2bf_init(bf16v2 a, bf16v2 b) { float r; asm("v_dot2_f32_bf16 %0, %1, %2, 0" : "=v"(r) : "v"(a), "v"(b)); return r; }
__device__ __forceinline__ void unpack16_fp8(const u32x4 a, float (&f)[16]) {
#pragma unroll
    for (int w = 0; w < 4; ++w) { const int aw = (int)a[w]; const f32x2 lo = __builtin_amdgcn_cvt_pk_f32_fp8(aw, false), hi = __builtin_amdgcn_cvt_pk_f32_fp8(aw, true);
        f[4 * w + 0] = lo.x; f[4 * w + 1] = lo.y; f[4 * w + 2] = hi.x; f[4 * w + 3] = hi.y; }
}
#define PEER_QUEUE_BEGIN(phase_id, tg_lo, tg_hi) { \
    unsigned* heads_ = (unsigned*)(P->ws + WS_CTL) + CW_PQ + (phase_id) * 16 * 64; const unsigned x_ = ((PROBE >> 19) & 1) ? ((unsigned)blockIdx.x >> 5) & 7u : (xb_xcc_id() & 7u); \
    for (int k_ = 0; k_ < 16; ++k_) { const int db = (int)((x_ + 8u * (k_ & 1) + (unsigned)(k_ >> 1)) & 15u); \
        for (;;) { unsigned t0_ = 0; if (c.lane == 0) t0_ = __hip_atomic_fetch_add(heads_ + db * 64, 2u, __ATOMIC_RELAXED, __HIP_MEMORY_SCOPE_AGENT); \
            t0_ = (unsigned)__builtin_amdgcn_readfirstlane((int)t0_) + (unsigned)(tg_lo); if (t0_ >= (unsigned)(tg_hi)) break; \
            for (unsigned tg_ = t0_; tg_ < t0_ + 2u && tg_ < (unsigned)(tg_hi); ++tg_) { const int tg = (int)tg_;
#define PEER_QUEUE_END } } } }
__device__ __forceinline__ void phase_peer_u(KP P, const Ctx& c, int layer, int row_lo, int qrep) {
    const bf16_t* H2 = (const bf16_t*)(P->ws + WS_H2); const unsigned short* SE = (const unsigned short*)(P->ws + P_SE16);
    const unsigned char* U = P->ws + WS_PU + (size_t)layer * 16384 * D; bf16_t* PART = (bf16_t*)(P->ws + P_PART);
    PEER_QUEUE_BEGIN(layer * 2 + 0 + 8 * qrep, row_lo / 8, T / 8)
        int lane = c.lane; asm volatile("" : "+v"(lane));
        const int ts = lane >> 3, seg = lane & 7, t = tg * 8 + ts;
        const bf16_t* xp = H2 + (size_t)t * D + db * 128 + seg * 16; const u32x4 xa = *(const u32x4*)xp, xb = *(const u32x4*)(xp + 8);
        const unsigned short* se = SE + (size_t)t * 128; const unsigned char* ub = U + (size_t)db * 16384 * 128; const unsigned seg16 = (unsigned)seg * 16u;
        bf16_t* pp = PART + (((size_t)t * 16 + db) * 8 + seg) * 16;
        u32x4 eA[2], eB[2], gA[16], gB[16];
#define PU_IDX(E, st) do { _Pragma("unroll") for (int i_ = 0; i_ < 2; ++i_) E[i_] = *(const u32x4*)(se + 16 * (st) + 8 * i_); } while (0)
#define PU_GATHER(G, E) do { _Pragma("unroll") for (int k_ = 0; k_ < 16; ++k_) { const unsigned w_ = E[k_ >> 3][(k_ >> 1) & 3]; const unsigned e_ = ((k_ & 1) ? (w_ >> 16) : w_) & 16383u; G[k_] = *(const u32x4*)(ub + (unsigned)((e_ << 7) | seg16)); } } while (0)
#define PU_COMPUTE(G, OUT) do { float v2_[2]; \
            _Pragma("unroll") for (int cc = 0; cc < 2; ++cc) { float sk[8]; \
                _Pragma("unroll") for (int k = 0; k < 8; ++k) { float s0; \
                    _Pragma("unroll") for (int w = 0; w < 4; ++w) { const int gw_ = (int)G[8 * cc + k][w]; const unsigned x0 = w < 2 ? xa[2 * w] : xb[2 * w - 4], x1 = w < 2 ? xa[2 * w + 1] : xb[2 * w - 3]; \
                        if (w == 0) s0 = dot2bf_init(__builtin_amdgcn_cvt_scalef32_pk_bf16_fp8(gw_, 1.0f, false), __builtin_bit_cast(bf16v2, x0)); \
                        else s0 = __builtin_amdgcn_fdot2_f32_bf16(__builtin_amdgcn_cvt_scalef32_pk_bf16_fp8(gw_, 1.0f, false), __builtin_bit_cast(bf16v2, x0), s0, false); \
                        s0 = __builtin_amdgcn_fdot2_f32_bf16(__builtin_amdgcn_cvt_scalef32_pk_bf16_fp8(gw_, 1.0f, true), __builtin_bit_cast(bf16v2, x1), s0, false); } \
                    sk[k] = s0; } \
                sum8_quad(sk[0], sk[1], sk[2], sk[3]); sum8_quad(sk[4], sk[5], sk[6], sk[7]); \
                float v = 0.f; \
                _Pragma("unroll") for (int k = 0; k < 8; ++k) v = (seg == k) ? sk[k] : v; \
                v2_[cc] = v; } \
            OUT = cvt_pk_bf16(v2_[0], v2_[1]); } while (0)
        PU_IDX(eA, 0); PU_IDX(eB, 1); PU_GATHER(gA, eA);
#pragma unroll 1
        for (int j2 = 0; j2 < 4; ++j2) {
            PU_GATHER(gB, eB);
            if (j2 < 3) PU_IDX(eA, 2 * j2 + 2);
            unsigned pw0, pw1;
            PU_COMPUTE(gA, pw0);
            if (j2 < 3) { PU_GATHER(gA, eA); PU_IDX(eB, 2 * j2 + 3); }
            PU_COMPUTE(gB, pw1);
            *(u32x2*)(pp + 4 * j2) = (u32x2){pw0, pw1};
        }
#undef PU_IDX
#undef PU_GATHER
#undef PU_COMPUTE
    PEER_QUEUE_END
}
__device__ __forceinline__ void phase_peer_c(KP P, const Ctx& c, int layer, int row_lo) {
    const bf16_t* PART = (const bf16_t*)(P->ws + P_PART); const unsigned short* SE = (const unsigned short*)(P->ws + P_SE16); const float* SW = (const float*)(P->ws + WS_SELW);
    const float* ISU = (const float*)(P->ws + WS_PSC) + (size_t)layer * 16384; const float* ISV = ISU + (size_t)4 * 16384; bf16_t* C = (bf16_t*)(P->ws + P_C);
    unsigned pw[16]; unsigned short se0, se1; float w0, w1;
#define PC_LOAD(i_) do { const size_t t_ = (i_) >> 6; const int jj_ = (int)((i_) & 7), seg_ = (int)(((i_) >> 3) & 7); const unsigned* pp_ = (const unsigned*)(PART + ((t_ * 16) * 8 + seg_) * 16 + 2 * jj_); \
        _Pragma("unroll") for (int db = 0; db < 16; ++db) pw[db] = pp_[(size_t)db * 64]; \
        const size_t o_ = t_ * 128 + 16 * jj_ + seg_; se0 = SE[o_]; se1 = SE[o_ + 8]; w0 = SW[o_]; w1 = SW[o_ + 8]; } while (0)
    const size_t ibeg = (size_t)row_lo * 64 + c.gtid, iend = (size_t)T * 64;
    if (ibeg < iend) PC_LOAD(ibeg);
    for (size_t i = ibeg; i < iend; i += c.ngt) { const size_t t = i >> 6; const int jj = (int)(i & 7), seg = (int)((i >> 3) & 7);
        const size_t o0 = t * 128 + 16 * jj + seg, o1 = o0 + 8; const int e0 = se0 & 16383, e1 = se1 & 16383; const float cw0 = w0, cw1 = w1;
        const float iu0 = ISU[e0], iv0 = ISV[e0], iu1 = ISU[e1], iv1 = ISV[e1]; float s0 = 0.f, s1 = 0.f;
#pragma unroll
        for (int db = 0; db < 16; ++db) { const unsigned w = pw[db]; s0 += __builtin_bit_cast(float, w << 16); s1 += __builtin_bit_cast(float, w & 0xffff0000u); }
        if (i + c.ngt < iend) PC_LOAD(i + c.ngt);
        C[o0] = (bf16_t)(cvt_pk_bf16(cw0 * gelu_tanh(s0 * iu0) * iv0, 0.f) & 0xffffu);
        C[o1] = (bf16_t)(cvt_pk_bf16(cw1 * gelu_tanh(s1 * iu1) * iv1, 0.f) & 0xffffu); }
#undef PC_LOAD
}
__device__ __forceinline__ void phase_peer_v(KP P, const Ctx& c, int layer, int row_lo, int qrep) {
    const unsigned short* SE = (const unsigned short*)(P->ws + P_SE16); const bf16_t* C = (const bf16_t*)(P->ws + P_C);
    const unsigned char* V = P->ws + WS_PV + (size_t)layer * 16384 * D; bf16_t* Y = (bf16_t*)(P->ws + P_Y);
    PEER_QUEUE_BEGIN(layer * 2 + 1 + 8 * qrep, row_lo / 8, T / 8)
        int lane = c.lane; asm volatile("" : "+v"(lane));
        const int ts = lane >> 3, seg = lane & 7, t = tg * 8 + ts;
        const unsigned short* se = SE + (size_t)t * 128; const bf16_t* cp = C + (size_t)t * 128; const unsigned char* vb = V + (size_t)db * 16384 * 128; const unsigned seg16 = (unsigned)seg * 16u;
        float acc[16];
#pragma unroll
        for (int e = 0; e < 16; ++e) acc[e] = 0.f;
        u32x4 en[2];
#pragma unroll
        for (int i = 0; i < 2; ++i) en[i] = *(const u32x4*)(se + 8 * i);
#pragma unroll 1
        for (int q = 0; q < 8; ++q) { u32x4 ec[2];
#pragma unroll
          for (int i = 0; i < 2; ++i) ec[i] = en[i];
          if (q < 7) {
#pragma unroll
            for (int i = 0; i < 2; ++i) en[i] = *(const u32x4*)(se + 16 * (q + 1) + 8 * i); }
          const u32x4 c0 = *(const u32x4*)(cp + 16 * q), c1 = *(const u32x4*)(cp + 16 * q + 8);
          u32x4 g[16];
#pragma unroll
          for (int k = 0; k < 16; ++k) { const unsigned w_ = ec[k >> 3][(k >> 1) & 3]; const unsigned e = ((k & 1) ? (w_ >> 16) : w_) & 16383u; g[k] = *(const u32x4*)(vb + (unsigned)((e << 7) | seg16)); }
#pragma unroll
          for (int k = 0; k < 16; k += 2) { const unsigned cwu = (k < 8 ? c0 : c1)[(k >> 1) & 3]; const bf16v2 cw = __builtin_bit_cast(bf16v2, cwu);
#pragma unroll
              for (int w = 0; w < 4; ++w) { const unsigned g0 = g[k][w], g1 = g[k + 1][w];
                  const int pa = (int)__builtin_amdgcn_perm(g1, g0, 0x05010400u), pb = (int)__builtin_amdgcn_perm(g1, g0, 0x07030602u);
                  acc[4 * w + 0] = __builtin_amdgcn_fdot2_f32_bf16(__builtin_amdgcn_cvt_scalef32_pk_bf16_fp8(pa, 1.0f, false), cw, acc[4 * w + 0], false);
                  acc[4 * w + 1] = __builtin_amdgcn_fdot2_f32_bf16(__builtin_amdgcn_cvt_scalef32_pk_bf16_fp8(pa, 1.0f, true), cw, acc[4 * w + 1], false);
                  acc[4 * w + 2] = __builtin_amdgcn_fdot2_f32_bf16(__builtin_amdgcn_cvt_scalef32_pk_bf16_fp8(pb, 1.0f, false), cw, acc[4 * w + 2], false);
                  acc[4 * w + 3] = __builtin_amdgcn_fdot2_f32_bf16(__builtin_amdgcn_cvt_scalef32_pk_bf16_fp8(pb, 1.0f, true), cw, acc[4 * w + 3], false); } } }
        bf16_t* yp = Y + (size_t)t * D + db * 128 + seg * 16;
#pragma unroll
        for (int q = 0; q < 2; ++q) *(u32x4*)(yp + 8 * q) = (u32x4){cvt_pk_bf16(acc[8 * q], acc[8 * q + 1]), cvt_pk_bf16(acc[8 * q + 2], acc[8 * q + 3]), cvt_pk_bf16(acc[8 * q + 4], acc[8 * q + 5]), cvt_pk_bf16(acc[8 * q + 6], acc[8 * q + 7])};
    PEER_QUEUE_END
}
template <bool LAST>
__device__ __forceinline__ void phase_peer_final(KP P, const Ctx& c, int layer) {
    const bf16_t* Y = (const bf16_t*)(P->ws + P_Y); bf16_t* X = (bf16_t*)(P->ws + WS_X); bf16_t* A0 = (bf16_t*)(P->ws + WS_A0);
    const float* lg = P->in[I_LNG] + (size_t)(layer * 2 + 1) * D; const float* lb = P->in[I_LNB] + (size_t)(layer * 2 + 1) * D;
    const float ymul = ((DBG_ZERO >> (2 * layer + 1)) & 1) ? 0.f : 1.f;
    u32x2 xn[8]; u32x2 yn[8];
    f32x4 lg8[8], lb8[8];
#pragma unroll
    for (int j = 0; j < 8; ++j) { lg8[j] = *(const f32x4*)(lg + c.lane * 4 + 256 * j); lb8[j] = *(const f32x4*)(lb + c.lane * 4 + 256 * j); }
    { const int r0 = (LAST ? NCTX : 0) + c.gw; if (r0 < T) {
#pragma unroll
        for (int j = 0; j < 8; ++j) { xn[j] = *(const u32x2*)(X + (size_t)r0 * D + c.lane * 4 + 256 * j); yn[j] = *(const u32x2*)(Y + (size_t)r0 * D + c.lane * 4 + 256 * j); } } }
    for (int row = (LAST ? NCTX : 0) + c.gw; row < T; row += c.ngw) {
        int l4 = c.lane * 4; asm volatile("" : "+v"(l4));
        const int v = row_vec(row); const float* m5 = modp(P, layer, v, 5) + l4;
        f32x4 x[8]; float s = 0.f;
#pragma unroll
        for (int j = 0; j < 8; ++j) { const u32x2 yb = yn[j]; const f32x4 yv = (f32x4){bflo(yb.x), bfhi(yb.x), bflo(yb.y), bfhi(yb.y)};
            const unsigned x0 = xn[j].x, x1 = xn[j].y;
            x[j] = (f32x4){bflo(x0), bfhi(x0), bflo(x1), bfhi(x1)} * ALPHA + *(const f32x4*)(m5 + 256 * j) * (yv * ymul); s += (x[j][0] + x[j][1]) + (x[j][2] + x[j][3]); }
        if (row + c.ngw < T) {
#pragma unroll
            for (int j = 0; j < 8; ++j) { xn[j] = *(const u32x2*)(X + (size_t)(row + c.ngw) * D + l4 + 256 * j); yn[j] = *(const u32x2*)(Y + (size_t)(row + c.ngw) * D + l4 + 256 * j); } }
        const float mean = wave_sum(s) * (1.0f / D); float q = 0.f;
#pragma unroll
        for (int j = 0; j < 8; ++j) { x[j] = x[j] - mean; q += (x[j][0] * x[j][0] + x[j][1] * x[j][1]) + (x[j][2] * x[j][2] + x[j][3] * x[j][3]); }
        const float rstd = rsqrtf(wave_sum(q) * (1.0f / D) + LN_EPS);
        const bool mk_a0 = !LAST && layer != 0;
#pragma unroll
        for (int jh = 0; jh < 2; ++jh) { f32x4 g4[4], b4[4], p4[4], q4[4];
#pragma unroll
            for (int jj = 0; jj < 4; ++jj) { const int o = l4 + 256 * (4 * jh + jj); g4[jj] = lg8[4 * jh + jj]; b4[jj] = lb8[4 * jh + jj];
                if (mk_a0) { p4[jj] = *(const f32x4*)(modp(P, layer + 1, v, 1) + o); q4[jj] = *(const f32x4*)(modp(P, layer + 1, v, 0) + o); } }
#pragma unroll
            for (int jj = 0; jj < 4; ++jj) { const int j = 4 * jh + jj, o = l4 + 256 * j; const f32x4 y = x[j] * rstd * g4[jj] + b4[jj];
                if (LAST) { *(f32x4*)(P->out + (size_t)(row - NCTX) * D + o) = y; }
                else { *(u32x2*)(X + (size_t)row * D + o) = (u32x2){cvt_pk_bf16(y[0], y[1]), cvt_pk_bf16(y[2], y[3])};
                    if (mk_a0) { const f32x4 hv = y * (p4[jj] + 1.0f) + q4[jj];
                        *(u32x2*)(A0 + (size_t)row * D + o) = (u32x2){cvt_pk_bf16(hv[0], hv[1]), cvt_pk_bf16(hv[2], hv[3])}; } } } }
    }
}

__device__ __forceinline__ void phase_rw_mix(KP P, const Ctx& c, int layer) {
    const bf16_t* X = (const bf16_t*)(P->ws + WS_X); bf16_t* AALL = (bf16_t*)(P->ws + L_AALL); const float* mu = P->in[I_RWMU];
    float mu8[6][8];
    { const int c8 = (int)(c.gtid & 255) * 8;
#pragma unroll
      for (int m = 0; m < 6; ++m) { const f32x4 a = *(const f32x4*)(mu + m * D + c8), b = *(const f32x4*)(mu + m * D + c8 + 4);
#pragma unroll
          for (int j = 0; j < 4; ++j) { mu8[m][j] = a[j]; mu8[m][4 + j] = b[j]; } } }
    const int c8 = (int)(c.gtid & 255) * 8;
    u32x4 nx, nn; f32x4 nsh0, nsh1, nsc0, nsc1; int nnb;
#define MX_LOAD(i_) do { const int row_ = (int)((i_) >> 8); const int v_ = row_vec(row_); int nb_ = -1;     \
        if (row_ < NCTX) { const int t_ = row_ & (CTX - 1); if (c8 < 1024) { if (t_ > 0) nb_ = row_ - 1; } else { if (t_ < CTX - 1) nb_ = row_ + 1; } } \
        else { const int t_ = (row_ - NCTX) & (SEQ - 1), qd_ = c8 >> 9; \
            if (qd_ == 0) { if ((t_ & 63) != 0) nb_ = row_ - 1; } else if (qd_ == 1) { if ((t_ & 63) != 63) nb_ = row_ + 1; } \
            else if (qd_ == 2) { if (t_ >= 64) nb_ = row_ - 64; } else { if (t_ < SEQ - 64) nb_ = row_ + 64; } } \
        nx = *(const u32x4*)(X + (size_t)row_ * D + c8); nnb = nb_; \
        if (nb_ >= 0) nn = *(const u32x4*)(X + (size_t)nb_ * D + c8); \
        const float* sh_ = modp(P, layer, v_, 0) + c8; const float* sc_ = modp(P, layer, v_, 1) + c8; \
        nsh0 = *(const f32x4*)sh_; nsh1 = *(const f32x4*)(sh_ + 4); nsc0 = *(const f32x4*)sc_; nsc1 = *(const f32x4*)(sc_ + 4); } while (0)
    if ((size_t)c.gtid < TD / 8) MX_LOAD((size_t)c.gtid);
    for (size_t i = c.gtid; i < TD / 8; i += c.ngt) { const int row = (int)(i >> 8);
        float h[8], xx[8];
        { const int nb = nnb; float xv[8], nv[8]; unpack8(nx, xv); unpack8(nn, nv);
#pragma unroll
          for (int j = 0; j < 8; ++j) { const float scj = 1.0f + (j < 4 ? nsc0[j & 3] : nsc1[j & 3]), shj = j < 4 ? nsh0[j & 3] : nsh1[j & 3];
              h[j] = xv[j] * scj + shj;
              const float sv = nb >= 0 ? nv[j] * scj + shj : 0.f; xx[j] = sv - h[j]; } }
        if (i + c.ngt < TD / 8) MX_LOAD(i + c.ngt);
#pragma unroll
        for (int m = 0; m < 6; ++m) { float o[8];
#pragma unroll
            for (int j = 0; j < 8; ++j) o[j] = h[j] + xx[j] * mu8[m][j];
            *(u32x4*)(AALL + (size_t)row * (6 * D) + m * D + c8) = (u32x4){cvt_pk_bf16(o[0], o[1]), cvt_pk_bf16(o[2], o[3]), cvt_pk_bf16(o[4], o[5]), cvt_pk_bf16(o[6], o[7])}; } }
#undef MX_LOAD
}
__device__ __forceinline__ void phase_rw_scan(KP P, const Ctx& c) {
    const bf16_t* R = (const bf16_t*)(P->ws + L_RKV); const bf16_t* Kx = R + TD; const bf16_t* Vx = R + 2 * TD;
    const bf16_t* W = (const bf16_t*)(P->ws + L_W); const bf16_t* AD = (const bf16_t*)(P->ws + L_AD);
    LAS float* rL = (LAS float*)c.lds; LAS float* wL = rL + 4096; LAS float* kkL = rL + 8192; LAS float* bL = rL + 12288; LAS float* kdL = rL + 16384; LAS float* vL = rL + 20480; LAS float* yL = rL + 24576; LAS float* scL = rL + 28672;
    const int tok = c.tid >> 3, cq = c.tid & 7;
    for (int chain = blockIdx.x; chain < 256; chain += gridDim.x) {
        const int b = chain >> 6, hd = (chain >> 1) & 31, dir = chain & 1;
        bf16_t* Y = (bf16_t*)(P->ws + (dir ? L_Y1 : L_Y0));
        const int ch0 = hd * 64 + cq * 8;
        float kkw[8], kaw[8];
#pragma unroll
        for (int j = 0; j < 8; ++j) { kkw[j] = P->in[I_RWKK][ch0 + j]; kaw[j] = P->in[I_RWKA][ch0 + j]; }
        float s[8] = {0.f, 0.f, 0.f, 0.f, 0.f, 0.f, 0.f, 0.f};
        u32x4 gr, gk, gv, gw, ga;
#define RW_GLOAD(ck) do { const int row_ = seq_row(b, dir, (ck) * 64 + tok); gr = *(const u32x4*)(R + (size_t)row_ * D + ch0); gk = *(const u32x4*)(Kx + (size_t)row_ * D + ch0); gv = *(const u32x4*)(Vx + (size_t)row_ * D + ch0); \
        gw = *(const u32x4*)(W + ((size_t)row_ * 2 + dir) * D + ch0); ga = *(const u32x4*)(AD + ((size_t)row_ * 2 + dir) * D + ch0); } while (0)
        RW_GLOAD(0);
        for (int ck = 0; ck < SLEN / 64; ++ck) {
            const int row = seq_row(b, dir, ck * 64 + tok);
            float r8[8], k8[8], v8[8], w8[8], a8[8];
            unpack8(gr, r8); unpack8(gk, k8); unpack8(gv, v8); unpack8(gw, w8); unpack8(ga, a8);
            float kx[8], ss = 0.f;
#pragma unroll
            for (int j = 0; j < 8; ++j) { kx[j] = k8[j] * kkw[j]; ss += kx[j] * kx[j]; }
            ss = sum8(ss);
            const float rn = rsqrtf(ss + 1e-12f);
            __syncthreads();
            float pbr = 0.f, pkr = 0.f;
            {   float wr_[8], kk_[8], b_[8], kd_[8];
#pragma unroll
                for (int j = 0; j < 8; ++j) { kk_[j] = kx[j] * rn; b_[j] = kk_[j] * a8[j]; kd_[j] = k8[j] * (1.0f + (a8[j] - 1.0f) * kaw[j]); wr_[j] = w8[j] * r8[j]; pbr += b_[j] * r8[j]; pkr += kd_[j] * r8[j]; }
                const int o = tok * 64 + cq * 8;
#pragma unroll
                for (int hh = 0; hh < 2; ++hh) { const int q = 4 * hh;
                    *(LAS f32x4*)(rL + o + q) = (f32x4){wr_[q], wr_[q + 1], wr_[q + 2], wr_[q + 3]}; *(LAS f32x4*)(wL + o + q) = (f32x4){w8[q], w8[q + 1], w8[q + 2], w8[q + 3]};
                    *(LAS f32x4*)(kkL + o + q) = (f32x4){kk_[q], kk_[q + 1], kk_[q + 2], kk_[q + 3]}; *(LAS f32x4*)(bL + o + q) = (f32x4){b_[q], b_[q + 1], b_[q + 2], b_[q + 3]};
                    *(LAS f32x4*)(kdL + o + q) = (f32x4){kd_[q], kd_[q + 1], kd_[q + 2], kd_[q + 3]}; *(LAS f32x4*)(vL + o + q) = (f32x4){v8[q], v8[q + 1], v8[q + 2], v8[q + 3]}; } }
            pbr = sum8(pbr); pkr = sum8(pkr);
            if (cq == 0) *(LAS f32x2*)(scL + tok * 2) = (f32x2){pbr, pkr};
            __syncthreads();
            if (ck + 1 < SLEN / 64) RW_GLOAD(ck + 1);
            f32x4 kaA, kbA, waA, wbA, baA, bbA, daA, dbA, raA, rbA, kaB, kbB, waB, wbB, baB, bbB, daB, dbB, raB, rbB; float vvA, vvB; f32x2 scA, scB;
#define RW_LLOAD(X, tk_) do { const int o_ = (tk_) * 64 + cq * 8; ka##X = *(const LAS f32x4*)(kkL + o_); kb##X = *(const LAS f32x4*)(kkL + o_ + 4); wa##X = *(const LAS f32x4*)(wL + o_); wb##X = *(const LAS f32x4*)(wL + o_ + 4); \
                ba##X = *(const LAS f32x4*)(bL + o_); bb##X = *(const LAS f32x4*)(bL + o_ + 4); da##X = *(const LAS f32x4*)(kdL + o_); db##X = *(const LAS f32x4*)(kdL + o_ + 4); ra##X = *(const LAS f32x4*)(rL + o_); rb##X = *(const LAS f32x4*)(rL + o_ + 4); \
                vv##X = vL[(tk_) * 64 + tok]; sc##X = *(const LAS f32x2*)(scL + (tk_) * 2); } while (0)
#define RW_STEP(X, tk_) do { \
                float sa = (fma_s(s[0], ka##X[0], mul_s(s[1], ka##X[1])) + fma_s(s[2], ka##X[2], mul_s(s[3], ka##X[3]))) + (fma_s(s[4], kb##X[0], mul_s(s[5], kb##X[1])) + fma_s(s[6], kb##X[2], mul_s(s[7], kb##X[3]))); \
                float yd = (fma_s(s[0], ra##X[0], mul_s(s[1], ra##X[1])) + fma_s(s[2], ra##X[2], mul_s(s[3], ra##X[3]))) + (fma_s(s[4], rb##X[0], mul_s(s[5], rb##X[1])) + fma_s(s[6], rb##X[2], mul_s(s[7], rb##X[3]))); \
                sum8_pair(sa, yd); \
                const float nsa = -sa; \
                _Pragma("unroll") for (int j2 = 0; j2 < 4; ++j2) { s[j2] = fma_s(vv##X, da##X[j2], fma_s(nsa, ba##X[j2], mul_s(s[j2], wa##X[j2]))); s[4 + j2] = fma_s(vv##X, db##X[j2], fma_s(nsa, bb##X[j2], mul_s(s[4 + j2], wb##X[j2]))); } \
                if (cq == 0) yL[(tk_) * 64 + tok] = yd - sa * sc##X[0] + vv##X * sc##X[1]; } while (0)
            RW_LLOAD(A, 0);
#pragma unroll 1
            for (int tk = 0; tk < 64; tk += 2) {
                RW_LLOAD(B, tk + 1);
                RW_STEP(A, tk);
                RW_LLOAD(A, (tk + 2) & 63);
                RW_STEP(B, tk + 1);
            }
#undef RW_STEP
#undef RW_LLOAD
            __syncthreads();
            { const f32x4 ya = *(const LAS f32x4*)(yL + tok * 64 + cq * 8), yb = *(const LAS f32x4*)(yL + tok * 64 + cq * 8 + 4);
              *(u32x4*)(Y + (size_t)row * D + ch0) = (u32x4){cvt_pk_bf16(ya[0], ya[1]), cvt_pk_bf16(ya[2], ya[3]), cvt_pk_bf16(yb[0], yb[1]), cvt_pk_bf16(yb[2], yb[3])}; }
        }
#undef RW_GLOAD
        __syncthreads();
    }
}
__device__ __forceinline__ void phase_rw_finish(KP P, const Ctx& c) {
    const bf16_t* R = (const bf16_t*)(P->ws + L_RKV); const bf16_t* Kx = R + TD; const bf16_t* Vx = R + 2 * TD;
    const bf16_t* AD = (const bf16_t*)(P->ws + L_AD); const bf16_t* G = (const bf16_t*)(P->ws + L_G);
    const bf16_t* Y0 = (const bf16_t*)(P->ws + L_Y0); const bf16_t* Y1 = (const bf16_t*)(P->ws + L_Y1); bf16_t* Z = (bf16_t*)(P->ws + L_Z);
    const int ch = c.lane * 8 + 512 * (c.gw & 3);
    float ka8[8], rk8[8], gg8[8], gb8[8];
#pragma unroll
    for (int e = 0; e < 8; ++e) { ka8[e] = P->in[I_RWKA][ch + e]; rk8[e] = P->in[I_RWRK][ch + e]; gg8[e] = P->in[I_RWGNG][ch + e]; gb8[e] = P->in[I_RWGNB][ch + e]; }
    u32x4 ny0, ny1, nr, nk, nv, na0, na1, ng;
#define RF_LOAD(k_) do { const int row_ = (k_) >> 2; const size_t o_ = (size_t)row_ * D + ch; ny0 = *(const u32x4*)(Y0 + o_); ny1 = *(const u32x4*)(Y1 + o_); nr = *(const u32x4*)(R + o_); nk = *(const u32x4*)(Kx + o_); \
        nv = *(const u32x4*)(Vx + o_); na0 = *(const u32x4*)(AD + ((size_t)row_ * 2 + 0) * D + ch); na1 = *(const u32x4*)(AD + ((size_t)row_ * 2 + 1) * D + ch); ng = *(const u32x4*)(G + o_); } while (0)
    if (c.gw < T * 4) RF_LOAD(c.gw);
    for (int k = c.gw; k < T * 4; k += c.ngw) { const size_t o = (size_t)(k >> 2) * D + ch;
            float y[8]; { float ya_[8], yb_[8]; unpack8(ny0, ya_); unpack8(ny1, yb_);
#pragma unroll
                for (int e = 0; e < 8; ++e) y[e] = ya_[e] + yb_[e]; }
            float r8[8], k8[8], v8[8], a0[8], a1[8], g8[8];
            unpack8(nr, r8); unpack8(nk, k8); unpack8(nv, v8); unpack8(na0, a0); unpack8(na1, a1); unpack8(ng, g8);
            if (k + c.ngw < T * 4) RF_LOAD(k + c.ngw);
            float s = 0.f;
#pragma unroll
            for (int e = 0; e < 8; ++e) s += y[e];
            const float mean = sum8(s) * (1.0f / 64.0f); float q = 0.f;
#pragma unroll
            for (int e = 0; e < 8; ++e) { y[e] -= mean; q += y[e] * y[e]; }
            const float rstd = rsqrtf(sum8(q) * (1.0f / 64.0f) + 64e-5f);
            float bsum = 0.f;
#pragma unroll
            for (int e = 0; e < 8; ++e) { const float ka = ka8[e], rk = rk8[e];
                const float kd0 = k8[e] * (1.0f + (a0[e] - 1.0f) * ka), kd1 = k8[e] * (1.0f + (a1[e] - 1.0f) * ka); bsum += r8[e] * (kd0 + kd1) * rk; }
            bsum = sum8(bsum);
            float z[8];
#pragma unroll
            for (int e = 0; e < 8; ++e) z[e] = (y[e] * rstd * gg8[e] + gb8[e] + bsum * v8[e]) * g8[e];
            *(u32x4*)(Z + o) = (u32x4){cvt_pk_bf16(z[0], z[1]), cvt_pk_bf16(z[2], z[3]), cvt_pk_bf16(z[4], z[5]), cvt_pk_bf16(z[6], z[7])}; }
#undef RF_LOAD
}

__device__ __forceinline__ bf16x8 frag16(const LAS unsigned char* p) { return *(const LAS bf16x8*)p; }
__device__ __forceinline__ void phase_ret_scan(KP P, const Ctx& c) {
    const bf16_t* Q = (const bf16_t*)(P->ws + L_RQ); const bf16_t* Kx = (const bf16_t*)(P->ws + L_RK); const bf16_t* Vx = (const bf16_t*)(P->ws + L_RV);
    constexpr int QP = 528, TP = 144, VP = 272;
    constexpr int OFF_Q = 0, OFF_K = 33792, OFF_KT = 67584, OFF_VT = 104448, OFF_P = 122880;
    LAS unsigned char* L = c.lds;
    const int w = c.wave;
    for (int un = blockIdx.x; un < 256; un += gridDim.x) {
        const int b = un >> 6, h = (un >> 3) & 7, dir = (un >> 2) & 1, dvs = un & 3;
        bf16_t* O = (bf16_t*)(P->ws + (dir ? L_OB : L_OF));
        int tid = c.tid;
        const float gamma = 1.0f - exp2f(-5.0f - (float)h), lg2 = log2f(gamma), g63 = exp2f(63.0f * lg2);
        f32x4 Racc[16];
#pragma unroll
        for (int i = 0; i < 16; ++i) Racc[i] = (f32x4){0.f, 0.f, 0.f, 0.f};
        u32x4 pq[4], pv[2];
#define RET_LOAD_QV(ck) do { \
        _Pragma("unroll") for (int i = 0; i < 4; ++i) { const int id = tid + 512 * i, s_ = id >> 5, dc = id & 31; \
            pq[i] = *(const u32x4*)(Q + (size_t)seq_row(b, dir, (ck) * 64 + s_) * D + h * 256 + dc * 8); } \
        _Pragma("unroll") for (int i = 0; i < 2; ++i) { const int id = tid + 512 * i, s_ = id >> 4, ec = id & 15; \
            pv[i] = *(const u32x4*)(Vx + (size_t)seq_row(b, dir, (ck) * 64 + s_) * 4096 + h * 512 + dvs * 128 + ec * 8); } } while (0)
#define RET_LOAD_K(ck, dst) do { \
        _Pragma("unroll") for (int i = 0; i < 4; ++i) { const int id = tid + 512 * i, s_ = id >> 5, dc = id & 31; \
            dst[i] = *(const u32x4*)(Kx + (size_t)seq_row(b, dir, (ck) * 64 + s_) * D + h * 256 + dc * 8); } } while (0)
#define RET_STORE_K(src) do { \
        _Pragma("unroll") for (int i = 0; i < 4; ++i) { const int id = tid + 512 * i, s_ = id >> 5, dc = id & 31; *(LAS u32x4*)(L + OFF_K + s_ * QP + dc * 16) = src[i]; } } while (0)
        RET_LOAD_QV(0);
        { u32x4 pk0[4]; RET_LOAD_K(0, pk0); __syncthreads(); RET_STORE_K(pk0); }
        for (int ck = 0; ck < SLEN / 64; ++ck) {
            asm volatile("" : "+v"(tid));
            const int lane = tid & 63, r16 = lane & 15, q4 = lane >> 4;
            __syncthreads();
#pragma unroll
            for (int i = 0; i < 4; ++i) { const int id = tid + 512 * i, s_ = id >> 5, dc = id & 31; *(LAS u32x4*)(L + OFF_Q + s_ * QP + dc * 16) = pq[i]; }
#pragma unroll
            for (int i = 0; i < 2; ++i) { const int id = tid + 512 * i, s_ = id >> 4, ec = id & 15; *(LAS u32x4*)(L + OFF_P + s_ * VP + ec * 16) = pv[i]; }
            __syncthreads();
            if (ck + 1 < SLEN / 64) RET_LOAD_QV(ck + 1);
            {   const float vs = exp2f(-lg2 * (float)lane);
#pragma unroll
                for (int i = 0; i < 4; ++i) { const int dc = w + 8 * i;
                    const u32x4 raw = *(const LAS u32x4*)(L + OFF_K + lane * QP + dc * 16);
#pragma unroll
                    for (int e = 0; e < 4; ++e) { *(LAS unsigned short*)(L + OFF_KT + (dc * 8 + 2 * e) * TP + lane * 2) = (unsigned short)(raw[e] & 0xffffu); *(LAS unsigned short*)(L + OFF_KT + (dc * 8 + 2 * e + 1) * TP + lane * 2) = (unsigned short)(raw[e] >> 16); } }
#pragma unroll
                for (int i = 0; i < 2; ++i) { const int ec = w + 8 * i; float t8[8]; unpack8(*(const LAS u32x4*)(L + OFF_P + lane * VP + ec * 16), t8);
#pragma unroll
                    for (int e = 0; e < 4; ++e) { const unsigned pk2 = cvt_pk_bf16(t8[2 * e] * vs, t8[2 * e + 1] * vs);
                        *(LAS unsigned short*)(L + OFF_VT + (ec * 8 + 2 * e) * TP + lane * 2) = (unsigned short)(pk2 & 0xffffu); *(LAS unsigned short*)(L + OFF_VT + (ec * 8 + 2 * e + 1) * TP + lane * 2) = (unsigned short)(pk2 >> 16); } } }
            const int it_s = w >> 1, jt0 = 2 * (w & 1);
            f32x4 s0 = (f32x4){0.f, 0.f, 0.f, 0.f}, s1 = s0;
#pragma unroll
            for (int ks = 0; ks < 8; ++ks) { const int co = (32 * ks + 8 * q4) * 2; if ((ks & 1) == 0) asm volatile("" ::: "memory");
                const bf16x8 qf = frag16(L + OFF_Q + (16 * it_s + r16) * QP + co), k0 = frag16(L + OFF_K + (16 * jt0 + r16) * QP + co), k1 = frag16(L + OFF_K + (16 * jt0 + 16 + r16) * QP + co);
                s0 = __builtin_amdgcn_mfma_f32_16x16x32_bf16(k0, qf, s0, 0, 0, 0); s1 = __builtin_amdgcn_mfma_f32_16x16x32_bf16(k1, qf, s1, 0, 0, 0); }
            __syncthreads();
            {   const int i_ = 16 * it_s + r16; const float gi = exp2f(lg2 * (float)i_);
                const int j0 = 16 * jt0 + 4 * q4, j1 = j0 + 16; float p0[4], p1[4];
#pragma unroll
                for (int r = 0; r < 4; ++r) { p0[r] = (j0 + r <= i_) ? s0[r] * gi : 0.f; p1[r] = (j1 + r <= i_) ? s1[r] * gi : 0.f; }
                *(LAS u32x2*)(L + OFF_P + i_ * TP + j0 * 2) = (u32x2){cvt_pk_bf16(p0[0], p0[1]), cvt_pk_bf16(p0[2], p0[3])};
                *(LAS u32x2*)(L + OFF_P + i_ * TP + j1 * 2) = (u32x2){cvt_pk_bf16(p1[0], p1[1]), cvt_pk_bf16(p1[2], p1[3])}; }
            __syncthreads();
            u32x4 pkn[4]; const bool has_next = ck + 1 < SLEN / 64;
            if (has_next) RET_LOAD_K(ck + 1, pkn);
            const LAS unsigned char* vtp = L + OFF_VT + (16 * w + r16) * TP + (8 * q4) * 2;
#pragma unroll
            for (int it = 0; it < 4; ++it) { const int i_ = 16 * it + r16; f32x4 a = (f32x4){0.f, 0.f, 0.f, 0.f};
                asm volatile("" ::: "memory");
#pragma unroll
                for (int m = 0; m < 8; ++m) {
                    const u32x4 t = (u32x4){cvt_pk_bf16(Racc[2 * m][0], Racc[2 * m][1]), cvt_pk_bf16(Racc[2 * m][2], Racc[2 * m][3]), cvt_pk_bf16(Racc[2 * m + 1][0], Racc[2 * m + 1][1]), cvt_pk_bf16(Racc[2 * m + 1][2], Racc[2 * m + 1][3])};
                    const LAS unsigned char* qp = L + OFF_Q + i_ * QP + (32 * m + 4 * q4) * 2; const u32x2 lo = *(const LAS u32x2*)qp, hi = *(const LAS u32x2*)(qp + 32);
                    const u32x4 tq = (u32x4){lo.x, lo.y, hi.x, hi.y}; a = __builtin_amdgcn_mfma_f32_16x16x32_bf16(__builtin_bit_cast(bf16x8, t), __builtin_bit_cast(bf16x8, tq), a, 0, 0, 0); }
                a = a * exp2f(lg2 * (float)(i_ + 1));
#pragma unroll
                for (int ks = 0; ks < 2; ++ks) a = __builtin_amdgcn_mfma_f32_16x16x32_bf16(frag16(vtp + 64 * ks), frag16(L + OFF_P + i_ * TP + (32 * ks + 8 * q4) * 2), a, 0, 0, 0);
                *(u32x2*)(O + (size_t)seq_row(b, dir, ck * 64 + i_) * 4096 + h * 512 + dvs * 128 + 16 * w + 4 * q4) = (u32x2){cvt_pk_bf16(a[0], a[1]), cvt_pk_bf16(a[2], a[3])}; }
            if (has_next) RET_STORE_K(pkn);
#pragma unroll
            for (int dt = 0; dt < 16; ++dt) { if ((dt & 1) == 0) asm volatile("" ::: "memory");
                f32x4 u = Racc[dt] * gamma;
#pragma unroll
                for (int ks = 0; ks < 2; ++ks) u = __builtin_amdgcn_mfma_f32_16x16x32_bf16(frag16(L + OFF_KT + (16 * dt + r16) * TP + (32 * ks + 8 * q4) * 2), frag16(vtp + 64 * ks), u, 0, 0, 0);
                Racc[dt] = u * g63; }
        }
#undef RET_LOAD_QV
#undef RET_LOAD_K
#undef RET_STORE_K
        __syncthreads();
    }
}
__device__ __forceinline__ void phase_ret_merge(KP P, const Ctx& c) {
    const bf16_t* OF = (const bf16_t*)(P->ws + L_OF); const bf16_t* OB = (const bf16_t*)(P->ws + L_OB); const bf16_t* GF = (const bf16_t*)(P->ws + L_GF); const bf16_t* GB = (const bf16_t*)(P->ws + L_GB);
    bf16_t* Z = (bf16_t*)(P->ws + L_RZ);
    u32x4 nf, nb, ngf, ngb;
#define RM_LOAD(k_) do { const size_t o_ = (size_t)(k_) * 512 + c.lane * 8; nf = *(const u32x4*)(OF + o_); nb = *(const u32x4*)(OB + o_); ngf = *(const u32x4*)(GF + o_); ngb = *(const u32x4*)(GB + o_); } while (0)
    if (c.gw < T * 8) RM_LOAD(c.gw);
    for (int k = c.gw; k < T * 8; k += c.ngw) { const size_t o = (size_t)k * 512 + c.lane * 8;
            float f[8], bk[8], gf[8], gb[8]; unpack8(nf, f); unpack8(nb, bk); unpack8(ngf, gf); unpack8(ngb, gb);
            if (k + c.ngw < T * 8) RM_LOAD(k + c.ngw);
            float sf = 0.f, sb = 0.f;
#pragma unroll
            for (int e = 0; e < 8; ++e) { sf += f[e]; sb += bk[e]; }
            const float mf = wave_sum(sf) * (1.0f / 512.0f), mb = wave_sum(sb) * (1.0f / 512.0f); float qf = 0.f, qb = 0.f;
#pragma unroll
            for (int e = 0; e < 8; ++e) { f[e] -= mf; bk[e] -= mb; qf += f[e] * f[e]; qb += bk[e] * bk[e]; }
            const float rf = rsqrtf(wave_sum(qf) * (1.0f / 512.0f) + LN_EPS), rb = rsqrtf(wave_sum(qb) * (1.0f / 512.0f) + LN_EPS);
            float z[8];
#pragma unroll
            for (int e = 0; e < 8; ++e) z[e] = gf[e] * (f[e] * rf) + gb[e] * (bk[e] * rb);
            *(u32x4*)(Z + o) = (u32x4){cvt_pk_bf16(z[0], z[1]), cvt_pk_bf16(z[2], z[3]), cvt_pk_bf16(z[4], z[5]), cvt_pk_bf16(z[6], z[7])}; }
#undef RM_LOAD
}

__device__ __forceinline__ Ctx make_ctx(LAS unsigned char* lds) {
    int t = threadIdx.x; asm volatile("" : "+v"(t));
    Ctx c; c.lds = lds; c.tid = t; c.lane = t & 63; c.wave = __builtin_amdgcn_readfirstlane(t >> 6);
    c.gw = blockIdx.x * 8 + c.wave; c.ngw = gridDim.x * 8; c.gtid = blockIdx.x * 512 + t; c.ngt = gridDim.x * 512; return c;
}
#define GRID_BAR() xcd_barrier(bar)
template <class Epi, class GT> __device__ __forceinline__ void run_gemm_m(LAS unsigned char* lds, const GT& g, int M, int N, const Epi& E) {
    pg8::StaticOrder S; S.init(M, N, (int)gridDim.x, (int)blockIdx.x); pg8::gemm_phase<Epi, GT>(lds, g, S, E);
}
template <class Epi, class GT> __device__ __forceinline__ void run_gemm(LAS unsigned char* lds, const GT& g, int N, const Epi& E, int pm0 = 0) {
    pg8::StaticOrder S; S.init(T, N, (int)gridDim.x, (int)blockIdx.x, pm0); pg8::gemm_phase<Epi, GT>(lds, g, S, E);
}
template <int LAYER, bool LAST> __device__ __forceinline__ void peer_phases(LAS unsigned char* lds, const XcdBarrier& bar) {
    phase_ln_mid(kp_fresh(), make_ctx(lds), LAYER, LAST ? NCTX : 0); GRID_BAR();
    PROBE_REP(2) { KP P = kp_fresh(); unsigned char* ws = P->ws; GPlain g{(const bf16_t*)(ws + WS_H2), (const bf16_t*)(ws + WS_WQ) + (size_t)LAYER * D * D, D, D, D}; EpiF32Plain E{(float*)(ws + WS_S), D}; run_gemm(lds, g, D, E, LAST ? 4 : 0);
        if (!LAST && _rep == 0) { constexpr int NR = 8 * 16384, SH = (NR + 2) / 3; const int lo = LAYER * SH, hi = (LAYER == 2) ? NR : (LAYER + 1) * SH;
            if ((int)gridDim.x == 256) { if ((int)blockIdx.x >= 32) peer_convert_rows(kp_fresh(), make_ctx(lds), lo, hi, (int)blockIdx.x - 32, 224); }
            else peer_convert_rows(kp_fresh(), make_ctx(lds), lo, hi, (int)blockIdx.x, (int)gridDim.x); }
        GRID_BAR(); }
    PROBE_REP(1) { phase_peer_select(kp_fresh(), make_ctx(lds), LAST ? NCTX : 0); GRID_BAR(); }
    PROBE_REP(0) { phase_peer_u(kp_fresh(), make_ctx(lds), LAYER, LAST ? NCTX : 0, _rep); GRID_BAR(); }
    phase_peer_c(kp_fresh(), make_ctx(lds), LAYER, LAST ? NCTX : 0); GRID_BAR();
    PROBE_REP(9) { phase_peer_v(kp_fresh(), make_ctx(lds), LAYER, LAST ? NCTX : 0, _rep); GRID_BAR(); }
    phase_peer_final<LAST>(kp_fresh(), make_ctx(lds), LAYER); GRID_BAR();
}
template <int LAYER, int JL> __device__ __forceinline__ void rg_phases(LAS unsigned char* lds, const XcdBarrier& bar) {
    PROBE_REP(6) { KP P = kp_fresh(); unsigned char* ws = P->ws; GPlain g{(const bf16_t*)(ws + WS_A0), (const bf16_t*)(ws + WS_RGIN) + (size_t)JL * 4096 * D, D, D, D}; EpiRgIn E{(bf16_t*)(ws + L_UG), (bf16_t*)(ws + L_UR)}; run_gemm(lds, g, 4096, E); GRID_BAR(); }
    PROBE_REP(7) { phase_rg_conv(kp_fresh(), make_ctx(lds), JL); GRID_BAR(); }
    { KP P = kp_fresh(); unsigned char* ws = P->ws; GGate g{(const bf16_t*)(ws + L_XC), (const bf16_t*)(ws + WS_RGGATE) + (size_t)JL * 8192 * 256, 256, D, 256};
      EpiRgGate E{(const bf16_t*)(ws + L_XC), (bf16_t*)(ws + L_LA), (bf16_t*)(ws + L_BB), P->in[I_RGGB] + (size_t)JL * 4 * D, (const float*)(ws + WS_SPT) + (size_t)JL * 2 * D}; PROBE_REP(11) { run_gemm(lds, g, 8192, E); GRID_BAR(); } }
    PROBE_REP(3) { phase_rg_scan1(kp_fresh(), make_ctx(lds)); GRID_BAR();
    phase_rg_scan2(kp_fresh(), make_ctx(lds)); GRID_BAR();
    phase_rg_scan3<0>(kp_fresh(), make_ctx(lds)); GRID_BAR();
    phase_rg_scan3<1>(kp_fresh(), make_ctx(lds)); GRID_BAR(); }
    { KP P = kp_fresh(); unsigned char* ws = P->ws; GPlain g{(const bf16_t*)(ws + L_YIN), (const bf16_t*)(ws + WS_RGOUT) + (size_t)JL * D * D, D, D, D}; EpiBf16Plain E{(bf16_t*)(ws + WS_S), D}; run_gemm(lds, g, D, E, LAYER == 3 ? 4 : 0); } GRID_BAR();
}
template <int LAYER> __device__ __forceinline__ void rw_phases(LAS unsigned char* lds, const XcdBarrier& bar) {
    PROBE_REP(7) { phase_rw_mix(kp_fresh(), make_ctx(lds), LAYER); GRID_BAR(); }
    PROBE_REP(6) { KP P = kp_fresh(); unsigned char* ws = P->ws; GRw1 g{(const bf16_t*)(ws + L_AALL), (const bf16_t*)(ws + WS_RW1), D, 6 * D, D}; EpiRw1 E{(bf16_t*)(ws + L_RKV), (bf16_t*)(ws + L_A2)}; run_gemm(lds, g, 6912, E); GRID_BAR(); }
    { KP P = kp_fresh(); unsigned char* ws = P->ws; GRw2 g{(const bf16_t*)(ws + L_A2), (const bf16_t*)(ws + WS_RW2), 256, 768, 256}; EpiRw2 E{(bf16_t*)(ws + L_W), (bf16_t*)(ws + L_AD), (bf16_t*)(ws + L_G), P->in[I_RWDEC0], P->in[I_RWICL0]}; PROBE_REP(12) { run_gemm(lds, g, 10240, E); GRID_BAR(); } }
    PROBE_REP(4) { phase_rw_scan(kp_fresh(), make_ctx(lds)); GRID_BAR(); }
    PROBE_REP(7) { phase_rw_finish(kp_fresh(), make_ctx(lds)); GRID_BAR(); }
    { KP P = kp_fresh(); unsigned char* ws = P->ws; GPlain g{(const bf16_t*)(ws + L_Z), (const bf16_t*)(ws + WS_RWO), D, D, D}; EpiBf16Plain E{(bf16_t*)(ws + WS_S), D}; run_gemm(lds, g, D, E); } GRID_BAR();
}
template <int LAYER> __device__ __forceinline__ void ret_phases(LAS unsigned char* lds, const XcdBarrier& bar) {
    { KP P = kp_fresh(); unsigned char* ws = P->ws; GPlain g{(const bf16_t*)(ws + WS_A0), (const bf16_t*)(ws + WS_RETIN), D, D, D};
      EpiRetIn E{(bf16_t*)(ws + L_RQ), (bf16_t*)(ws + L_RK), (bf16_t*)(ws + L_RV), (bf16_t*)(ws + L_GF), (bf16_t*)(ws + L_GB), (const float*)(ws + WS_CS)}; PROBE_REP(10) { run_gemm(lds, g, 16384, E); GRID_BAR(); } }
    PROBE_REP(5) { phase_ret_scan(kp_fresh(), make_ctx(lds)); GRID_BAR(); }
    PROBE_REP(7) { phase_ret_merge(kp_fresh(), make_ctx(lds)); GRID_BAR(); }
    { KP P = kp_fresh(); unsigned char* ws = P->ws; GPlain g{(const bf16_t*)(ws + L_RZ), (const bf16_t*)(ws + WS_RETOUT), 4096, 4096, 4096}; EpiBf16Plain E{(bf16_t*)(ws + WS_S), D}; run_gemm(lds, g, D, E); } GRID_BAR();
}

__global__ void __launch_bounds__(512, 2) hybrid_fwd(Params Pkernarg) {
    extern __shared__ __attribute__((aligned(16))) unsigned char lds_raw[];
    LAS unsigned char* lds = (LAS unsigned char*)lds_raw;
    volatile LAS unsigned* MISC = (volatile LAS unsigned*)(lds + MISC_OFF);
    if (threadIdx.x < 64) MISC[threadIdx.x] = 0u;
    __syncthreads();
    XcdBarrier bar = xcd_barrier_post((unsigned*)(kp_fresh()->ws + WS_CTL) + 4096, MISC + 8);

    if ((PROBE >> 13) & 1) { for (int i = 0; i < 64; ++i) GRID_BAR(); }
    PROBE_REP(8) { phase_prologue(kp_fresh(), make_ctx(lds)); GRID_BAR(); }
    { KP P = kp_fresh(); unsigned char* ws = P->ws; GFold g{(const bf16_t*)(ws + WS_KEYS), (const bf16_t*)(ws + WS_WQN), 256, 256, D}; EpiBf16Plain E{(bf16_t*)(ws + WS_WQ), D}; run_gemm_m(lds, g, 4 * D, D, E); }
    phase_modfin(kp_fresh(), make_ctx(lds)); GRID_BAR();
    phase_xinit(kp_fresh(), make_ctx(lds)); GRID_BAR();
    rg_phases<0, 0>(lds, bar);  peer_phases<0, false>(lds, bar);
    rw_phases<1>(lds, bar);     peer_phases<1, false>(lds, bar);
    ret_phases<2>(lds, bar);    peer_phases<2, false>(lds, bar);
    rg_phases<3, 1>(lds, bar);  peer_phases<3, true>(lds, bar);
}

extern "C" void kernel_launch(void* const* d_in, const int* in_sizes, int n_in, void* d_out, int out_size, void* d_ws, size_t ws_size, hipStream_t stream) {
    static int grid = 0;
    if (!grid) {
        if (n_in != 37 || ws_size < WS_END) { fprintf(stderr, "kernel_launch: unexpected problem (n_in %d, ws %zu)\n", n_in, ws_size); grid = -1; return; }
        int dev = 0, cus = 0, per_cu = 0;
        if (hipGetDevice(&dev) != hipSuccess || hipDeviceGetAttribute(&cus, hipDeviceAttributeMultiprocessorCount, dev) != hipSuccess) { grid = -1; return; }
        if (hipFuncSetAttribute((const void*)hybrid_fwd, hipFuncAttributeMaxDynamicSharedMemorySize, LDS_BYTES) != hipSuccess) { fprintf(stderr, "kernel_launch: hipFuncSetAttribute failed\n"); grid = -1; return; }
        if (hipOccupancyMaxActiveBlocksPerMultiprocessor(&per_cu, (const void*)hybrid_fwd, 512, LDS_BYTES) != hipSuccess || per_cu < 1) { fprintf(stderr, "kernel_launch: occupancy query says %d\n", per_cu); grid = -1; return; }
        grid = cus;
    }
    if (grid <= 0) return;
    hipMemsetAsync((char*)d_ws + WS_CTL, 0, CTL_BYTES, stream);
    Params p; memset(&p, 0, sizeof(p));
    for (int i = 0; i < 37; ++i) p.in[i] = (const float*)d_in[i];
    p.out = (float*)d_out; p.ws = (unsigned char*)d_ws;
    hipLaunchKernelGGL(hybrid_fwd, dim3(grid), dim3(512), LDS_BYTES, stream, p);
}
```

```cpp
#include <hip/hip_runtime.h>
#include <cstdio>
#include <cstring>

#define LAS __attribute__((address_space(3)))
typedef unsigned short bf16_t;
typedef short bf16x8 __attribute__((ext_vector_type(8)));
typedef float f32x4 __attribute__((ext_vector_type(4)));
typedef float f32x2 __attribute__((ext_vector_type(2)));
typedef unsigned u32x4 __attribute__((ext_vector_type(4)));
typedef unsigned u32x2 __attribute__((ext_vector_type(2)));
typedef __bf16 bf16v2 __attribute__((ext_vector_type(2)));

#ifndef DBG_ZERO
#define DBG_ZERO 0
#endif
#ifndef PROBE
#define PROBE 0
#endif
#define PROBE_REP(bit) for (int _rep = 0; _rep < (((PROBE) >> (bit)) & 1) + 1; ++_rep)
constexpr int D = 2048, NBATCH = 4, SEQ = 4096, CTX = 256;
constexpr int NCTX = NBATCH * CTX, NLAT = NBATCH * SEQ, T = NCTX + NLAT;
constexpr int SLEN = CTX + SEQ;
constexpr float ALPHA = 1.681792830507429f;
constexpr float LN_EPS = 1e-5f;
constexpr size_t TD = (size_t)T * D;

constexpr size_t MiB = 1u << 20;
constexpr size_t WS_CTL = 0, CTL_BYTES = 1 * MiB;
constexpr size_t WS_MODP = 2 * MiB;
constexpr size_t WS_MOD = 10 * MiB;
constexpr size_t WS_CS = 11 * MiB;
constexpr size_t WS_SPT = 15 * MiB + 512 * 1024;
constexpr size_t WS_CA = 16 * MiB, WS_CH = 21 * MiB, WS_CIN = 26 * MiB;
constexpr size_t WS_WQ = 32 * MiB;
constexpr size_t WS_KEYS = 64 * MiB;
constexpr size_t WS_RGIN = 68 * MiB;
constexpr size_t WS_RGGATE = 100 * MiB;
constexpr size_t WS_RGOUT = 108 * MiB;
constexpr size_t WS_RW1 = 124 * MiB;
constexpr size_t WS_RW2 = 152 * MiB;
constexpr size_t WS_RWO = 160 * MiB;
constexpr size_t WS_RETIN = 168 * MiB;
constexpr size_t WS_RETOUT = 232 * MiB;
constexpr size_t WS_PU = 256 * MiB;
constexpr size_t WS_PV = 384 * MiB;
constexpr size_t WS_PSC = 512 * MiB;
constexpr size_t WS_X = 768 * MiB;
constexpr size_t WS_A0 = 904 * MiB;
constexpr size_t WS_H2 = 972 * MiB;
constexpr size_t WS_Q = 1040 * MiB;
constexpr size_t WS_WQN = 1040 * MiB;
constexpr size_t WS_S = 1108 * MiB;
constexpr size_t WS_L = 1244 * MiB;
constexpr size_t WS_SELW = 1893 * MiB;
constexpr size_t WS_END = 1902 * MiB;
constexpr size_t P_SE16 = WS_L + 288 * MiB;
constexpr size_t P_PART = WS_L, P_Y = WS_L + 136 * MiB, P_C = WS_L + 272 * MiB;
constexpr int CW_PQ = 16384;
constexpr size_t L_UG = WS_L, L_UR = WS_L + 68 * MiB, L_XC = WS_L + 136 * MiB, L_LA = WS_L + 204 * MiB, L_BB = WS_L + 340 * MiB, L_YIN = WS_L + 476 * MiB;
constexpr size_t L_AALL = WS_L;
constexpr size_t L_W = WS_L, L_AD = WS_L + 136 * MiB, L_G = WS_L + 272 * MiB;
constexpr size_t L_RKV = WS_L + 408 * MiB;
constexpr size_t L_A2 = WS_L + 612 * MiB;
constexpr size_t L_Y0 = WS_H2, L_Y1 = WS_H2 + 136 * MiB;
constexpr size_t L_Z = WS_A0;
constexpr size_t L_RQ = WS_L, L_RK = WS_L + 68 * MiB, L_RV = WS_L + 136 * MiB, L_GF = WS_L + 272 * MiB, L_GB = WS_L + 408 * MiB;
constexpr size_t L_OF = WS_H2, L_OB = WS_H2 + 136 * MiB;
constexpr size_t L_RZ = WS_L;

__device__ __forceinline__ float bf2f(unsigned b) { return __uint_as_float(b << 16); }
__device__ __forceinline__ unsigned cvt_pk_bf16(float lo, float hi) { bf16v2 t; t.x = (__bf16)lo; t.y = (__bf16)hi; return __builtin_bit_cast(unsigned, t); }
__device__ __forceinline__ float bflo(unsigned u) { return __uint_as_float(u << 16); }
__device__ __forceinline__ float bfhi(unsigned u) { return __uint_as_float(u & 0xffff0000u); }
__device__ __forceinline__ float sigmoidf_(float x) { return 1.0f / (1.0f + __expf(-x)); }
__device__ __forceinline__ float siluf_(float x) { return x / (1.0f + __expf(-x)); }
__device__ __forceinline__ float tanhf_(float x) { return 1.0f - 2.0f / (1.0f + __expf(2.0f * x)); }
__device__ __forceinline__ float gelu_tanh(float x) { const float z = 1.5957691216057308f * (x + 0.044715f * x * x * x); return x / (1.0f + __expf(-z)); }
__device__ __forceinline__ void unpack8(const u32x4 u, float (&f)[8]) { f[0] = bflo(u.x); f[1] = bfhi(u.x); f[2] = bflo(u.y); f[3] = bfhi(u.y); f[4] = bflo(u.z); f[5] = bfhi(u.z); f[6] = bflo(u.w); f[7] = bfhi(u.w); }
template <int CTRL> __device__ __forceinline__ float dpp_mov(float v) { const int x = __builtin_bit_cast(int, v); return __builtin_bit_cast(float, __builtin_amdgcn_update_dpp(x, x, CTRL, 0xF, 0xF, false)); }
__device__ __forceinline__ float rl_f(float v, int lane) { return __builtin_bit_cast(float, __builtin_amdgcn_readlane(__builtin_bit_cast(int, v), lane)); }
__device__ __forceinline__ float sum8(float v) { v += dpp_mov<0xB1>(v); v += dpp_mov<0x4E>(v); v += dpp_mov<0x141>(v); return v; }
__device__ __forceinline__ float sum16(float v) { v = sum8(v); v += dpp_mov<0x140>(v); return v; }
__device__ __forceinline__ float fma_s(float a, float b, float c) { float d; asm("v_fma_f32 %0, %1, %2, %3" : "=v"(d) : "v"(a), "v"(b), "v"(c)); return d; }
__device__ __forceinline__ float mul_s(float a, float b) { float d; asm("v_mul_f32 %0, %1, %2" : "=v"(d) : "v"(a), "v"(b)); return d; }
__device__ __forceinline__ void sum8_pair(float& a, float& b) {
    asm volatile("s_nop 1\n\t"
        "v_add_f32_dpp %0, %0, %0 quad_perm:[1,0,3,2] row_mask:0xf bank_mask:0xf\n\tv_add_f32_dpp %1, %1, %1 quad_perm:[1,0,3,2] row_mask:0xf bank_mask:0xf\n\ts_nop 0\n\t"
        "v_add_f32_dpp %0, %0, %0 quad_perm:[2,3,0,1] row_mask:0xf bank_mask:0xf\n\tv_add_f32_dpp %1, %1, %1 quad_perm:[2,3,0,1] row_mask:0xf bank_mask:0xf\n\ts_nop 0\n\t"
        "v_add_f32_dpp %0, %0, %0 row_half_mirror row_mask:0xf bank_mask:0xf\n\tv_add_f32_dpp %1, %1, %1 row_half_mirror row_mask:0xf bank_mask:0xf"
        : "+v"(a), "+v"(b));
}
__device__ __forceinline__ void sum16_pair(float& a, float& b) {
    asm volatile("s_nop 1\n\t"
        "v_add_f32_dpp %0, %0, %0 quad_perm:[1,0,3,2] row_mask:0xf bank_mask:0xf\n\tv_add_f32_dpp %1, %1, %1 quad_perm:[1,0,3,2] row_mask:0xf bank_mask:0xf\n\ts_nop 0\n\t"
        "v_add_f32_dpp %0, %0, %0 quad_perm:[2,3,0,1] row_mask:0xf bank_mask:0xf\n\tv_add_f32_dpp %1, %1, %1 quad_perm:[2,3,0,1] row_mask:0xf bank_mask:0xf\n\ts_nop 0\n\t"
        "v_add_f32_dpp %0, %0, %0 row_half_mirror row_mask:0xf bank_mask:0xf\n\tv_add_f32_dpp %1, %1, %1 row_half_mirror row_mask:0xf bank_mask:0xf\n\ts_nop 0\n\t"
        "v_add_f32_dpp %0, %0, %0 row_mirror row_mask:0xf bank_mask:0xf\n\tv_add_f32_dpp %1, %1, %1 row_mirror row_mask:0xf bank_mask:0xf"
        : "+v"(a), "+v"(b));
}
__device__ __forceinline__ void sum16_quad(float& a, float& b, float& c, float& d) {
    asm volatile("s_nop 1\n\t"
        "v_add_f32_dpp %0, %0, %0 quad_perm:[1,0,3,2] row_mask:0xf bank_mask:0xf\n\tv_add_f32_dpp %1, %1, %1 quad_perm:[1,0,3,2] row_mask:0xf bank_mask:0xf\n\t"
        "v_add_f32_dpp %2, %2, %2 quad_perm:[1,0,3,2] row_mask:0xf bank_mask:0xf\n\tv_add_f32_dpp %3, %3, %3 quad_perm:[1,0,3,2] row_mask:0xf bank_mask:0xf\n\t"
        "v_add_f32_dpp %0, %0, %0 quad_perm:[2,3,0,1] row_mask:0xf bank_mask:0xf\n\tv_add_f32_dpp %1, %1, %1 quad_perm:[2,3,0,1] row_mask:0xf bank_mask:0xf\n\t"
        "v_add_f32_dpp %2, %2, %2 quad_perm:[2,3,0,1] row_mask:0xf bank_mask:0xf\n\tv_add_f32_dpp %3, %3, %3 quad_perm:[2,3,0,1] row_mask:0xf bank_mask:0xf\n\t"
        "v_add_f32_dpp %0, %0, %0 row_half_mirror row_mask:0xf bank_mask:0xf\n\tv_add_f32_dpp %1, %1, %1 row_half_mirror row_mask:0xf bank_mask:0xf\n\t"
        "v_add_f32_dpp %2, %2, %2 row_half_mirror row_mask:0xf bank_mask:0xf\n\tv_add_f32_dpp %3, %3, %3 row_half_mirror row_mask:0xf bank_mask:0xf\n\t"
        "v_add_f32_dpp %0, %0, %0 row_mirror row_mask:0xf bank_mask:0xf\n\tv_add_f32_dpp %1, %1, %1 row_mirror row_mask:0xf bank_mask:0xf\n\t"
        "v_add_f32_dpp %2, %2, %2 row_mirror row_mask:0xf bank_mask:0xf\n\tv_add_f32_dpp %3, %3, %3 row_mirror row_mask:0xf bank_mask:0xf"
        : "+v"(a), "+v"(b), "+v"(c), "+v"(d));
}
__device__ __forceinline__ void sum8_quad(float& a, float& b, float& c, float& d) {
    asm volatile("s_nop 1\n\t"
        "v_add_f32_dpp %0, %0, %0 quad_perm:[1,0,3,2] row_mask:0xf bank_mask:0xf\n\tv_add_f32_dpp %1, %1, %1 quad_perm:[1,0,3,2] row_mask:0xf bank_mask:0xf\n\t"
        "v_add_f32_dpp %2, %2, %2 quad_perm:[1,0,3,2] row_mask:0xf bank_mask:0xf\n\tv_add_f32_dpp %3, %3, %3 quad_perm:[1,0,3,2] row_mask:0xf bank_mask:0xf\n\t"
        "v_add_f32_dpp %0, %0, %0 quad_perm:[2,3,0,1] row_mask:0xf bank_mask:0xf\n\tv_add_f32_dpp %1, %1, %1 quad_perm:[2,3,0,1] row_mask:0xf bank_mask:0xf\n\t"
        "v_add_f32_dpp %2, %2, %2 quad_perm:[2,3,0,1] row_mask:0xf bank_mask:0xf\n\tv_add_f32_dpp %3, %3, %3 quad_perm:[2,3,0,1] row_mask:0xf bank_mask:0xf\n\t"
        "v_add_f32_dpp %0, %0, %0 row_half_mirror row_mask:0xf bank_mask:0xf\n\tv_add_f32_dpp %1, %1, %1 row_half_mirror row_mask:0xf bank_mask:0xf\n\t"
        "v_add_f32_dpp %2, %2, %2 row_half_mirror row_mask:0xf bank_mask:0xf\n\tv_add_f32_dpp %3, %3, %3 row_half_mirror row_mask:0xf bank_mask:0xf"
        : "+v"(a), "+v"(b), "+v"(c), "+v"(d));
}
__device__ __forceinline__ float wave_sum(float v) { v = sum8(v); v += dpp_mov<0x140>(v); return (rl_f(v, 0) + rl_f(v, 16)) + (rl_f(v, 32) + rl_f(v, 48)); }
__device__ __forceinline__ float wave_max(float v) {
    v = fmaxf(v, dpp_mov<0xB1>(v)); v = fmaxf(v, dpp_mov<0x4E>(v)); v = fmaxf(v, dpp_mov<0x141>(v)); v = fmaxf(v, dpp_mov<0x140>(v));
    return fmaxf(fmaxf(rl_f(v, 0), rl_f(v, 16)), fmaxf(rl_f(v, 32), rl_f(v, 48)));
}
__device__ __forceinline__ int row_vec(int row) { return row < NCTX ? 4 : ((row - NCTX) >> 12); }
__device__ __forceinline__ int panel_vec(int pm) { return pm < 4 ? 4 : ((pm - 4) >> 4); }
__device__ __forceinline__ int seq_row(int b, int dir, int s) {
    if (s < CTX) { const int t = dir ? (CTX - 1 - s) : s; return b * CTX + t; }
    int t = s - CTX; if (dir) t = SEQ - 1 - t; return NCTX + b * SEQ + t;
}
__device__ __forceinline__ int row_pos(int row) { return row < NCTX ? (row & (CTX - 1)) : CTX + ((row - NCTX) & (SEQ - 1)); }

namespace pg8 {
constexpr int BM = 256, BK = 64, HALF = 128, HTB = HALF * BK * 2, STAGE_BYTES = 8 * HTB, NXCD = 8, WGM = 8;
__host__ __device__ __forceinline__ int lds_byte(int r, int c) { const int st = (r >> 4) * 2 + (c >> 5), rr = r & 15, cc = c & 31, ob = rr * 64 + cc * 2; return st * 1024 + (ob ^ (((ob >> 9) & 1) << 5)); }
__host__ __device__ __forceinline__ void stage_rc(int b, int& R, int& C) { const int st = b / 1024, sb = b % 1024, swz = sb ^ (((sb >> 9) & 1) << 5); R = (st >> 1) * 16 + swz / 64; C = (st & 1) * 32 + (swz % 64) / 2; }
__host__ __device__ __forceinline__ int perm32(int rho) { const int n = rho >> 4, i = rho & 15; return 8 * (i >> 2) + 4 * n + (i & 3); }
struct Unit { int pm, pn; };
struct StaticOrder {
    int nM, nN, nwg, G, c, pm0;
    __device__ void init(int M, int N, int G_, int c_, int pm0_ = 0) { pm0 = pm0_; nM = M / BM - pm0_; nN = N / BM; nwg = nM * nN; G = G_; c = c_; }
    __device__ bool next(int i, Unit& u) const {
        const long L = (long)i * G + c; if (L >= nwg) return false;
        int wgid = (int)L; { const int q = nwg / NXCD, r = nwg % NXCD, xcd = wgid % NXCD, off = wgid / NXCD; wgid = (xcd < r ? xcd * (q + 1) : r * (q + 1) + (xcd - r) * q) + off; }
        const int nig = WGM * nN, gid = wgid / nig, fm = gid * WGM, gsz = (nM - fm) < WGM ? (nM - fm) : WGM;
        u.pm = pm0 + fm + ((wgid % nig) % gsz); u.pn = (wgid % nig) / gsz; return true;
    }
};
template <class Epi, class GT>
__device__ __forceinline__ void gemm_phase(LAS unsigned char* lds, const GT g, const StaticOrder& S, const Epi& E) {
    int tid_ = threadIdx.x; asm volatile("" : "+v"(tid_));
    const int tid = tid_, wid = __builtin_amdgcn_readfirstlane(tid >> 6), lane = tid & 63, wr = wid >> 2, wc = wid & 3, fr = lane & 15, fq = lane >> 4;
    const int K = g.K, nt = K / BK;
    unsigned voffA[2], voffB[2];
#pragma unroll
    for (int i = 0; i < 2; ++i) { int R, C; stage_rc(tid * 16 + i * 8192, R, C); const int Rb = Epi::PERM ? ((R & ~31) + perm32(R & 31)) : R;
        voffA[i] = (unsigned)(R * g.lda + C) * 2u; voffB[i] = (unsigned)(Rb * g.ldb + C) * 2u; }
    const size_t kstep = (size_t)(BK * 2);
    const size_t hstepA = (size_t)HALF * g.lda * 2, hstepB = (size_t)HALF * g.ldb * 2;
    const unsigned ldsw = (unsigned)wid * 1024u;
    const int aoff = lds_byte(wr * 64 + fr, fq * 8), boff = lds_byte(wc * 32 + fr, fq * 8);
#define PG8_SA(b, h) (((b) * 2 + (h)) * HTB)
#define PG8_SB(b, h) ((4 + (b) * 2 + (h)) * HTB)
#define PG8_STAGE(bufoff, gbase, voff) do { _Pragma("unroll") for (int _i = 0; _i < 2; ++_i) \
        __builtin_amdgcn_global_load_lds((const unsigned*)((const char*)(gbase) + (voff)[_i]), (LAS unsigned*)(lds + (bufoff) + ldsw + _i * 8192), 16, 0, 0); } while (0)
#define PG8_LDA(dst, b, h) do { _Pragma("unroll") for (int m = 0; m < 4; ++m) _Pragma("unroll") for (int k = 0; k < 2; ++k) dst[m][k] = *(const LAS bf16x8*)(lds + PG8_SA(b, h) + aoff + m * 2048 + k * 1024); } while (0)
#define PG8_LDB(dst, b, h) do { _Pragma("unroll") for (int n = 0; n < 2; ++n) _Pragma("unroll") for (int k = 0; k < 2; ++k) dst[n][k] = *(const LAS bf16x8*)(lds + PG8_SB(b, h) + boff + n * 2048 + k * 1024); } while (0)
#define PG8_MMA(ai, bj, At, Bt) do { __builtin_amdgcn_s_setprio(1); _Pragma("unroll") for (int m = 0; m < 4; ++m) _Pragma("unroll") for (int n = 0; n < 2; ++n) _Pragma("unroll") for (int k = 0; k < 2; ++k) \
        acc[ai][bj][m][n] = __builtin_amdgcn_mfma_f32_16x16x32_bf16(Bt[n][k], At[m][k], acc[ai][bj][m][n], 0, 0, 0); __builtin_amdgcn_s_setprio(0); } while (0)
#define PG8_WAIT_V(n) asm volatile("s_waitcnt vmcnt(" #n ")" ::: "memory")
#define PG8_WAIT_L(n) asm volatile("s_waitcnt lgkmcnt(" #n ")" ::: "memory")
#define PG8_BAR __builtin_amdgcn_s_barrier()
#define PG8_SCHED __builtin_amdgcn_sched_barrier(0)
    Unit cur, nxt; int ui = 0;
    if (!S.next(0, cur)) return;
    f32x4 acc[2][2][4][2];
#pragma unroll
    for (int a = 0; a < 2; ++a)
#pragma unroll
        for (int b = 0; b < 2; ++b)
#pragma unroll
            for (int m = 0; m < 4; ++m)
#pragma unroll
                for (int n = 0; n < 2; ++n) acc[a][b][m][n] = (f32x4){0.f, 0.f, 0.f, 0.f};
    bf16x8 At[4][2], B0[2][2], B1[2][2];
    const char* cA = g.a_ptr(cur); const char* cB = g.b_ptr(cur);
    PG8_STAGE(PG8_SB(0, 0), cB, voffB); PG8_STAGE(PG8_SA(0, 0), cA, voffA); PG8_STAGE(PG8_SB(0, 1), cB + hstepB, voffB); PG8_STAGE(PG8_SA(0, 1), cA + hstepA, voffA);
    if (wr == 1) PG8_BAR;
    PG8_WAIT_V(4); PG8_BAR;
    PG8_STAGE(PG8_SB(1, 0), cB + kstep, voffB); PG8_STAGE(PG8_SA(1, 0), cA + kstep, voffA); PG8_STAGE(PG8_SB(1, 1), cB + hstepB + kstep, voffB);
    PG8_WAIT_V(6); PG8_BAR;
    for (;;) {
        const bool has_next = S.next(ui + 1, nxt);
        const char* nA = has_next ? g.a_ptr(nxt) : cA; const char* nB = has_next ? g.b_ptr(nxt) : cB;
        for (int t = 0; t < nt; t += 2) {
            const bool last = (t == nt - 2);
            const char* a1 = cA + (size_t)(t + 1) * kstep;
            const char* a2 = last ? nA : cA + (size_t)(t + 2) * kstep; const char* b2 = last ? nB : cB + (size_t)(t + 2) * kstep;
            const char* a3 = a2 + kstep; const char* b3 = b2 + kstep;
            PG8_LDB(B0, 0, 0); PG8_SCHED; PG8_LDA(At, 0, 0); PG8_STAGE(PG8_SA(1, 1), a1 + hstepA, voffA);
            PG8_WAIT_L(8); PG8_BAR; PG8_WAIT_L(0); PG8_MMA(0, 0, At, B0); PG8_BAR; PG8_SCHED;
            PG8_LDB(B1, 0, 1); PG8_STAGE(PG8_SB(0, 0), b2, voffB);
            PG8_BAR; PG8_WAIT_L(0); PG8_MMA(0, 1, At, B1); PG8_BAR;
            PG8_LDA(At, 0, 1); PG8_STAGE(PG8_SA(0, 0), a2, voffA);
            PG8_BAR; PG8_WAIT_L(0); PG8_MMA(1, 0, At, B0); PG8_BAR; PG8_SCHED;
            PG8_STAGE(PG8_SB(0, 1), b2 + hstepB, voffB);
            PG8_WAIT_V(6); PG8_BAR; PG8_MMA(1, 1, At, B1); PG8_BAR;
            PG8_LDB(B0, 1, 0); PG8_SCHED; PG8_LDA(At, 1, 0); PG8_STAGE(PG8_SA(0, 1), a2 + hstepA, voffA);
            PG8_WAIT_L(8); PG8_BAR; PG8_WAIT_L(0); PG8_MMA(0, 0, At, B0); PG8_BAR; PG8_SCHED;
            PG8_LDB(B1, 1, 1); PG8_STAGE(PG8_SB(1, 0), b3, voffB);
            PG8_BAR; PG8_WAIT_L(0); PG8_MMA(0, 1, At, B1); PG8_BAR;
            PG8_LDA(At, 1, 1); PG8_STAGE(PG8_SA(1, 0), a3, voffA);
            PG8_BAR; PG8_WAIT_L(0); PG8_MMA(1, 0, At, B0); PG8_BAR; PG8_SCHED;
            PG8_STAGE(PG8_SB(1, 1), b3 + hstepB, voffB);
            PG8_WAIT_V(6); PG8_BAR; PG8_MMA(1, 1, At, B1); PG8_BAR;
        }
        E(acc, cur, wr, wc, fr, fq);
        if (!has_next) break;
#pragma unroll
        for (int a = 0; a < 2; ++a)
#pragma unroll
            for (int b = 0; b < 2; ++b)
#pragma unroll
                for (int m = 0; m < 4; ++m)
#pragma unroll
                    for (int n = 0; n < 2; ++n) acc[a][b][m][n] = (f32x4){0.f, 0.f, 0.f, 0.f};
        cur = nxt; cA = nA; cB = nB; ++ui;
    }
    PG8_WAIT_V(0);
    if (wr == 0) PG8_BAR;
    PG8_BAR;
#undef PG8_SA
#undef PG8_SB
#undef PG8_STAGE
#undef PG8_LDA
#undef PG8_LDB
#undef PG8_MMA
#undef PG8_WAIT_V
#undef PG8_WAIT_L
#undef PG8_BAR
#undef PG8_SCHED
}
}
using pg8::Unit;
typedef const f32x4 (&AccRef)[2][2][4][2];

#define XB_TMO      128
#define XB_XCNT(j)  (256  + 64 * (j))
#define XB_XSUB(j)  (1280 + 64 * (j))
#define XB_XGEN(j)  (2304 + 64 * (j))
#define XB_TOP      3328
#define XB_TOPGEN   3392
#define XCD_BAR_WORDS 3456
#define XB_SPIN_CAP (1u << 18)
__device__ __forceinline__ unsigned xb_ld(unsigned* p)              { return __hip_atomic_load(p, __ATOMIC_RELAXED, __HIP_MEMORY_SCOPE_AGENT); }
__device__ __forceinline__ unsigned xb_add(unsigned* p, unsigned v) { return __hip_atomic_fetch_add(p, v, __ATOMIC_RELAXED, __HIP_MEMORY_SCOPE_AGENT); }
__device__ __forceinline__ unsigned xb_xcc_id() { return (unsigned)__builtin_amdgcn_s_getreg((3 << 11) | 20) & 0xFu; }
#define XB_SPIN(cond, bar) do { unsigned _sp = 0; while (cond) { __builtin_amdgcn_s_sleep(1); \
    if ((++_sp & 255u) == 0u) { if (xb_ld(&(bar)[XB_TMO])) break; if (_sp > XB_SPIN_CAP) { atomicAdd(&(bar)[XB_TMO], 1u); break; } } } } while (0)
struct XcdBarrier { unsigned* bar; unsigned x; volatile LAS unsigned* st; };
__device__ __forceinline__ XcdBarrier xcd_barrier_post(unsigned* bar, volatile LAS unsigned* st) {
    XcdBarrier b; b.bar = bar; b.x = xb_xcc_id(); b.st = st;
    if (threadIdx.x == 0) (void)xb_add(&bar[XB_XCNT(b.x)], 1u);
    return b;
}
__device__ __forceinline__ void xcd_barrier_complete(unsigned* bar, unsigned x, unsigned& nloc, unsigned& nx) {
    const unsigned G = gridDim.x * gridDim.y * gridDim.z;
    unsigned sum, cnt, mine, sp = 0u;
    for (;;) {
        sum = 0u; cnt = 0u; mine = 0u;
#pragma unroll
        for (unsigned j = 0; j < 16; ++j) { const unsigned c = xb_ld(&bar[XB_XCNT(j)]); sum += c; cnt += (c > 0u) ? 1u : 0u; mine = (j == x) ? c : mine; }
        if (sum == G) break;
        __builtin_amdgcn_s_sleep(1);
        if ((++sp & 255u) == 0u) { if (xb_ld(&bar[XB_TMO])) break; if (sp > XB_SPIN_CAP) { atomicAdd(&bar[XB_TMO], 1u); break; } }
    }
    nloc = mine > 0u ? mine : 1u; nx = cnt > 0u ? cnt : 1u;
}
__device__ __forceinline__ void xcd_barrier(const XcdBarrier& b) {
    asm volatile("s_waitcnt vmcnt(0)" ::: "memory");
    __syncthreads();
    if (threadIdx.x == 0) {
        unsigned* bar = b.bar;
        __builtin_amdgcn_s_waitcnt(0);
        unsigned nloc = b.st[0], nx = b.st[1];
        if (nloc == 0u) { xcd_barrier_complete(bar, b.x, nloc, nx); b.st[0] = nloc; b.st[1] = nx; }
        const unsigned old = xb_add(&bar[XB_XSUB(b.x)], 1u);
        const unsigned gen = old / nloc;
        if (old + 1u == (gen + 1u) * nloc) {
            __builtin_amdgcn_fence(__ATOMIC_RELEASE, "agent");
            asm volatile("s_waitcnt vmcnt(0)" ::: "memory");
            const unsigned og = xb_add(&bar[XB_TOP], 1u);
            const unsigned tg = og / nx;
            if (og + 1u == (tg + 1u) * nx) xb_add(&bar[XB_TOPGEN], 1u);
            else XB_SPIN(xb_ld(&bar[XB_TOPGEN]) == tg, bar);
            __builtin_amdgcn_fence(__ATOMIC_ACQUIRE, "agent");
            xb_add(&bar[XB_XGEN(b.x)], 1u);
            asm volatile("s_waitcnt vmcnt(0)" ::: "memory");
        } else {
            XB_SPIN(xb_ld(&bar[XB_XGEN(b.x)]) == gen, bar);
            __builtin_amdgcn_fence(__ATOMIC_ACQUIRE, "agent");
            asm volatile("s_waitcnt vmcnt(0)" ::: "memory");
        }
    }
    __syncthreads();
}

struct Params { const float* in[37]; float* out; unsigned char* ws; };
typedef const __attribute__((address_space(4))) Params* KP;
__device__ __forceinline__ KP kp_fresh() { KP p = (KP)__builtin_amdgcn_kernarg_segment_ptr(); asm volatile("" : "+s"(p)); return p; }
enum { I_X = 0, I_C, I_CTX, I_CCTX, I_ADAW, I_ADAB, I_LNG, I_LNB, I_PWQ, I_PKEYS, I_PU, I_PV, I_RGWIN, I_RGCW, I_RGCB, I_RGGW, I_RGGB, I_RGLAM, I_RGWOUT,
       I_RWMU, I_RWRKV, I_RWWO, I_RWDEC0, I_RWDEC1, I_RWDEC2, I_RWICL0, I_RWICL1, I_RWICL2, I_RWG1, I_RWG2, I_RWKK, I_RWKA, I_RWRK, I_RWGNG, I_RWGNB, I_RETWIN, I_RETWOUT };
constexpr int LDS_BYTES = 147456;
constexpr int MISC_OFF = 147200;

__device__ __forceinline__ const float* modp(KP P, int layer, int v, int slot) { return (const float*)(P->ws + WS_MOD) + ((size_t)(layer * 5 + v) * 6 + slot) * D; }

struct GPlain { const bf16_t* A; const bf16_t* Bt; int K, lda, ldb;
    __device__ __forceinline__ const char* a_ptr(const Unit& u) const { return (const char*)(A + (size_t)u.pm * 256 * lda); }
    __device__ __forceinline__ const char* b_ptr(const Unit& u) const { return (const char*)(Bt + (size_t)u.pn * 256 * ldb); } };
struct GGate { const bf16_t* A; const bf16_t* Bt; int K, lda, ldb;
    __device__ __forceinline__ const char* a_ptr(const Unit& u) const { return (const char*)(A + (size_t)u.pm * 256 * lda + ((u.pn >> 1) & 7) * 256); }
    __device__ __forceinline__ const char* b_ptr(const Unit& u) const { return (const char*)(Bt + (size_t)u.pn * 256 * ldb); } };
struct GScore { const bf16_t* A; const bf16_t* Bt; int K, lda, ldb;
    __device__ __forceinline__ const char* a_ptr(const Unit& u) const { return (const char*)(A + (size_t)u.pm * 256 * lda + u.pn * 256); }
    __device__ __forceinline__ const char* b_ptr(const Unit& u) const { return (const char*)(Bt + (size_t)u.pn * 256 * ldb); } };
struct GFold { const bf16_t* A; const bf16_t* Bt; int K, lda, ldb;
    __device__ __forceinline__ const char* a_ptr(const Unit& u) const { return (const char*)(A + (size_t)u.pm * 256 * lda); }
    __device__ __forceinline__ const char* b_ptr(const Unit& u) const { return (const char*)(Bt + (size_t)(u.pm >> 3) * D * D + (size_t)u.pn * 256 * ldb + (u.pm & 7) * 256); } };
struct GRw1 { const bf16_t* A; const bf16_t* Bt; int K, lda, ldb;
    __device__ __forceinline__ const char* a_ptr(const Unit& u) const { const int blk = u.pn < 24 ? (u.pn >> 3) : (u.pn - 21); return (const char*)(A + (size_t)u.pm * 256 * lda + blk * 2048); }
    __device__ __forceinline__ const char* b_ptr(const Unit& u) const { return (const char*)(Bt + (size_t)u.pn * 256 * ldb); } };
struct GRw2 { const bf16_t* A; const bf16_t* Bt; int K, lda, ldb;
    __device__ __forceinline__ const char* a_ptr(const Unit& u) const { const int blk = u.pn < 16 ? 0 : (u.pn < 32 ? 1 : 2); return (const char*)(A + (size_t)u.pm * 256 * lda + blk * 256); }
    __device__ __forceinline__ const char* b_ptr(const Unit& u) const { return (const char*)(Bt + (size_t)u.pn * 256 * ldb); } };

template <int ACT> __device__ __forceinline__ float actf(float x) {
    if (ACT == 1) return gelu_tanh(x); if (ACT == 2) return tanhf_(x); if (ACT == 3) return sigmoidf_(x); if (ACT == 4) return siluf_(x); return x; }
template <int ACT> __device__ __forceinline__ void store_tile_bf16(AccRef acc, bf16_t* dst, int ld, int row0, int col0) {
#pragma unroll
    for (int ai = 0; ai < 2; ++ai)
#pragma unroll
        for (int m = 0; m < 4; ++m) { bf16_t* rowp = dst + (size_t)(row0 + ai * 128 + m * 16) * ld + col0;
#pragma unroll
            for (int bj = 0; bj < 2; ++bj) { const f32x4 v0 = acc[ai][bj][m][0], v1 = acc[ai][bj][m][1];
                u32x4 w; w.x = cvt_pk_bf16(actf<ACT>(v0[0]), actf<ACT>(v0[1])); w.y = cvt_pk_bf16(actf<ACT>(v0[2]), actf<ACT>(v0[3]));
                w.z = cvt_pk_bf16(actf<ACT>(v1[0]), actf<ACT>(v1[1])); w.w = cvt_pk_bf16(actf<ACT>(v1[2]), actf<ACT>(v1[3]));
                *(u32x4*)(rowp + bj * 128) = w; } }
}
struct EpiBf16Plain { static constexpr bool PERM = true; bf16_t* O; int ldc;
    __device__ __forceinline__ void operator()(AccRef acc, const Unit& u, int wr, int wc, int fr, int fq) const {
        store_tile_bf16<0>(acc, O, ldc, u.pm * 256 + wr * 64 + fr, u.pn * 256 + wc * 32 + 8 * fq); } };
struct EpiF32Plain { static constexpr bool PERM = false; float* C; int ldc;
    __device__ __forceinline__ void operator()(AccRef acc, const Unit& u, int wr, int wc, int fr, int fq) const {
        const int row0 = u.pm * 256 + wr * 64 + fr, col0 = u.pn * 256 + wc * 32 + 4 * fq;
#pragma unroll
        for (int ai = 0; ai < 2; ++ai)
#pragma unroll
            for (int m = 0; m < 4; ++m) { float* rowp = C + (size_t)(row0 + ai * 128 + m * 16) * ldc + col0;
#pragma unroll
                for (int bj = 0; bj < 2; ++bj)
#pragma unroll
                    for (int n = 0; n < 2; ++n) *(f32x4*)(rowp + bj * 128 + n * 16) = acc[ai][bj][m][n]; } } };
struct GSplitK { const bf16_t* A; const bf16_t* Bt; int K, lda, ldb;
    __device__ __forceinline__ const char* a_ptr(const Unit& u) const { return (const char*)(A + (size_t)u.pm * 256 * lda + (u.pn >> 3) * 512); }
    __device__ __forceinline__ const char* b_ptr(const Unit& u) const { return (const char*)(Bt + (size_t)(u.pn & 7) * 256 * ldb + (u.pn >> 3) * 512); } };
struct EpiPartial { static constexpr bool PERM = false; float* PX;
    __device__ __forceinline__ void operator()(AccRef acc, const Unit& u, int wr, int wc, int fr, int fq) const {
        const int row0 = u.pm * 256 + wr * 64 + fr, col0 = (u.pn & 7) * 256 + wc * 32 + 4 * fq; float* base = PX + (size_t)(u.pn >> 3) * NCTX * D;
#pragma unroll
        for (int ai = 0; ai < 2; ++ai)
#pragma unroll
            for (int m = 0; m < 4; ++m) { float* rowp = base + (size_t)(row0 + ai * 128 + m * 16) * D + col0;
#pragma unroll
                for (int bj = 0; bj < 2; ++bj)
#pragma unroll
                    for (int n = 0; n < 2; ++n) *(f32x4*)(rowp + bj * 128 + n * 16) = acc[ai][bj][m][n]; } } };
struct EpiResid { static constexpr bool PERM = false; float* X; const float* gate_base; float ymul;
    __device__ __forceinline__ void operator()(AccRef acc, const Unit& u, int wr, int wc, int fr, int fq) const {
        const int row0 = u.pm * 256 + wr * 64 + fr, col0 = u.pn * 256 + wc * 32 + 4 * fq;
        const float* gp = gate_base + (size_t)panel_vec(u.pm) * 6 * D + col0;
        f32x4 gv[2][2];
#pragma unroll
        for (int bj = 0; bj < 2; ++bj)
#pragma unroll
            for (int n = 0; n < 2; ++n) gv[bj][n] = *(const f32x4*)(gp + bj * 128 + n * 16);
#pragma unroll
        for (int ai = 0; ai < 2; ++ai)
#pragma unroll
            for (int m = 0; m < 4; ++m) { float* rowp = X + (size_t)(row0 + ai * 128 + m * 16) * D + col0;
#pragma unroll
                for (int bj = 0; bj < 2; ++bj)
#pragma unroll
                    for (int n = 0; n < 2; ++n) { f32x4* p = (f32x4*)(rowp + bj * 128 + n * 16); const f32x4 x = *p; *p = x * ALPHA + gv[bj][n] * (acc[ai][bj][m][n] * ymul); } } } };
struct EpiRgIn { static constexpr bool PERM = true; bf16_t* UG; bf16_t* UR;
    __device__ __forceinline__ void operator()(AccRef acc, const Unit& u, int wr, int wc, int fr, int fq) const {
        const int row0 = u.pm * 256 + wr * 64 + fr, col0 = (u.pn & 7) * 256 + wc * 32 + 8 * fq;
        if (u.pn < 8) store_tile_bf16<1>(acc, UG, D, row0, col0); else store_tile_bf16<0>(acc, UR, D, row0, col0); } };
struct EpiRgGate { static constexpr bool PERM = true; const bf16_t* XC; bf16_t* LA; bf16_t* BB; const float* gate_b; const float* spt;
    __device__ __forceinline__ void operator()(AccRef acc, const Unit& u, int wr, int wc, int fr, int fq) const {
        const int d = u.pn >> 4, ch0 = ((u.pn >> 1) & 7) * 256 + (u.pn & 1) * 128 + wc * 32 + 8 * fq;
        const int row0 = u.pm * 256 + wr * 64 + fr;
        float br[8], bi[8], sp[8];
#pragma unroll
        for (int j = 0; j < 8; ++j) { br[j] = gate_b[(d * 2 + 0) * D + ch0 + j]; bi[j] = gate_b[(d * 2 + 1) * D + ch0 + j];
            sp[j] = spt[d * D + ch0 + j]; }
        u32x4 xr8[8];
#pragma unroll
        for (int q = 0; q < 8; ++q) xr8[q] = *(const u32x4*)(XC + (size_t)(row0 + (q >> 2) * 128 + (q & 3) * 16) * D + ch0);
#pragma unroll
        for (int ai = 0; ai < 2; ++ai)
#pragma unroll
            for (int m = 0; m < 4; ++m) { const int row = row0 + ai * 128 + m * 16;
                const u32x4 xr = xr8[ai * 4 + m];
                float xc[8] = {bflo(xr.x), bfhi(xr.x), bflo(xr.y), bfhi(xr.y), bflo(xr.z), bfhi(xr.z), bflo(xr.w), bfhi(xr.w)};
                float la[8], bb[8];
#pragma unroll
                for (int j = 0; j < 8; ++j) { const float ar = acc[ai][0][m][j >> 2][j & 3], ai_ = acc[ai][1][m][j >> 2][j & 3];
                    const float rg = sigmoidf_(ar + br[j]), ig = sigmoidf_(ai_ + bi[j]);
                    const float l = sp[j] * rg; la[j] = l; bb[j] = sqrtf(1.0f - __expf(2.0f * l)) * (ig * xc[j]); }
                u32x4 w; w.x = cvt_pk_bf16(la[0], la[1]); w.y = cvt_pk_bf16(la[2], la[3]); w.z = cvt_pk_bf16(la[4], la[5]); w.w = cvt_pk_bf16(la[6], la[7]);
                *(u32x4*)(LA + ((size_t)row * 2 + d) * D + ch0) = w;
                w.x = cvt_pk_bf16(bb[0], bb[1]); w.y = cvt_pk_bf16(bb[2], bb[3]); w.z = cvt_pk_bf16(bb[4], bb[5]); w.w = cvt_pk_bf16(bb[6], bb[7]);
                *(u32x4*)(BB + ((size_t)row * 2 + d) * D + ch0) = w; } } };
struct EpiRw1 { static constexpr bool PERM = true; bf16_t* RKV; bf16_t* A2;
    __device__ __forceinline__ void operator()(AccRef acc, const Unit& u, int wr, int wc, int fr, int fq) const {
        const int row0 = u.pm * 256 + wr * 64 + fr, cw = wc * 32 + 8 * fq;
        if (u.pn < 24) store_tile_bf16<0>(acc, RKV + (size_t)(u.pn >> 3) * TD, D, row0, (u.pn & 7) * 256 + cw);
        else if (u.pn == 24) store_tile_bf16<2>(acc, A2, 768, row0, cw);
        else if (u.pn == 25) store_tile_bf16<0>(acc, A2, 768, row0, 256 + cw);
        else store_tile_bf16<3>(acc, A2, 768, row0, 512 + cw); } };
struct EpiRw2 { static constexpr bool PERM = true; bf16_t* W; bf16_t* AD; bf16_t* G; const float* dec0; const float* icl0;
    __device__ __forceinline__ void operator()(AccRef acc, const Unit& u, int wr, int wc, int fr, int fq) const {
        const int row0 = u.pm * 256 + wr * 64 + fr, c0 = (u.pn & 7) * 256 + wc * 32 + 8 * fq;
        if (u.pn >= 32) { store_tile_bf16<0>(acc, G, D, row0, c0); return; }
        const int isa = u.pn >= 16, d = (u.pn >> 3) & 1;
        const float* bias = (isa ? icl0 : dec0) + d * D + c0;
        bf16_t* dst = (isa ? AD : W);
        float bv[2][8];
#pragma unroll
        for (int bj = 0; bj < 2; ++bj)
#pragma unroll
            for (int j = 0; j < 8; ++j) bv[bj][j] = bias[bj * 128 + j];
#pragma unroll
        for (int ai = 0; ai < 2; ++ai)
#pragma unroll
            for (int m = 0; m < 4; ++m) { const int row = row0 + ai * 128 + m * 16;
#pragma unroll
                for (int bj = 0; bj < 2; ++bj) { float o[8];
#pragma unroll
                    for (int j = 0; j < 8; ++j) { const float s = sigmoidf_(acc[ai][bj][m][j >> 2][j & 3] + bv[bj][j]); o[j] = isa ? s : __expf(-0.6065306597126334f * s); }
                    u32x4 w; w.x = cvt_pk_bf16(o[0], o[1]); w.y = cvt_pk_bf16(o[2], o[3]); w.z = cvt_pk_bf16(o[4], o[5]); w.w = cvt_pk_bf16(o[6], o[7]);
                    *(u32x4*)(dst + ((size_t)row * 2 + d) * D + c0 + bj * 128) = w; } } } };
struct EpiRetIn { static constexpr bool PERM = true; bf16_t* Q; bf16_t* Kk; bf16_t* V; bf16_t* GF; bf16_t* GB; const float* CS;
    __device__ __forceinline__ void operator()(AccRef acc, const Unit& u, int wr, int wc, int fr, int fq) const {
        const int row0 = u.pm * 256 + wr * 64 + fr, cw = wc * 32 + 8 * fq;
        if (u.pn >= 48) { store_tile_bf16<4>(acc, GB, 4096, row0, (u.pn - 48) * 256 + cw); return; }
        if (u.pn >= 32) { store_tile_bf16<4>(acc, GF, 4096, row0, (u.pn - 32) * 256 + cw); return; }
        if (u.pn >= 16) { store_tile_bf16<0>(acc, V, 4096, row0, (u.pn - 16) * 256 + cw); return; }
        const float sc = u.pn >= 8 ? 0.0625f : 1.0f; bf16_t* dst = u.pn >= 8 ? Kk : Q; const int hc = (u.pn & 7) * 256;
#pragma unroll
        for (int ai = 0; ai < 2; ++ai) { f32x4 cs4[4][4];
#pragma unroll
            for (int m = 0; m < 4; ++m) { const float* cs_ = CS + ((size_t)row_pos(row0 + ai * 128 + m * 16) * 128 + cw) * 2;
#pragma unroll
                for (int q = 0; q < 4; ++q) cs4[m][q] = *(const f32x4*)(cs_ + 4 * q); }
#pragma unroll
            for (int m = 0; m < 4; ++m) { const int row = row0 + ai * 128 + m * 16;
                float o1[8], o2[8];
#pragma unroll
                for (int j = 0; j < 8; ++j) { const float co = cs4[m][j >> 1][(2 * j) & 3], si = cs4[m][j >> 1][(2 * j + 1) & 3]; const float t1 = acc[ai][0][m][j >> 2][j & 3], t2 = acc[ai][1][m][j >> 2][j & 3];
                    o1[j] = (t1 * co - t2 * si) * sc; o2[j] = (t1 * si + t2 * co) * sc; }
                u32x4 w; w.x = cvt_pk_bf16(o1[0], o1[1]); w.y = cvt_pk_bf16(o1[2], o1[3]); w.z = cvt_pk_bf16(o1[4], o1[5]); w.w = cvt_pk_bf16(o1[6], o1[7]);
                *(u32x4*)(dst + (size_t)row * D + hc + cw) = w;
                w.x = cvt_pk_bf16(o2[0], o2[1]); w.y = cvt_pk_bf16(o2[2], o2[3]); w.z = cvt_pk_bf16(o2[4], o2[5]); w.w = cvt_pk_bf16(o2[6], o2[7]);
                *(u32x4*)(dst + (size_t)row * D + hc + 128 + cw) = w; } } } };

#define LDS_WAIT() asm volatile("s_waitcnt lgkmcnt(0)" ::: "memory")
struct Ctx { LAS unsigned char* lds; int tid, lane, wave, gw, ngw, gtid, ngt; };

__device__ __forceinline__ void transpose_item(const float* W, int ldw, bf16_t* WT, int ldt, int k0, int n0, int dst_row0, LAS float* scr, int lane) {
#pragma unroll
    for (int i = 0; i < 8; ++i) { const int kk = 8 * i + (lane >> 3), nn = (lane & 7) * 4; const f32x4 wv = *(const f32x4*)(W + (size_t)(k0 + kk) * ldw + n0 + nn);
        LAS float* d = scr + kk * 33 + nn; d[0] = wv[0]; d[1] = wv[1]; d[2] = wv[2]; d[3] = wv[3]; }
    LDS_WAIT(); asm volatile("" ::: "memory");
    const int c = lane & 7;
#pragma unroll
    for (int j = 0; j < 4; ++j) { const int n = (lane >> 3) + 8 * j; const LAS float* s = scr + (8 * c) * 33 + n;
        u32x4 o; o.x = cvt_pk_bf16(s[0 * 33], s[1 * 33]); o.y = cvt_pk_bf16(s[2 * 33], s[3 * 33]); o.z = cvt_pk_bf16(s[4 * 33], s[5 * 33]); o.w = cvt_pk_bf16(s[6 * 33], s[7 * 33]);
        *(u32x4*)(WT + (size_t)(dst_row0 + n) * ldt + k0 + 8 * c) = o; }
    LDS_WAIT(); asm volatile("" ::: "memory");
}
__device__ __forceinline__ void tr_job(const Ctx& c, int& rot, const float* W, int K, int N, int ldw, bf16_t* WT, int ldt, int row_off) {
    LAS float* scr = (LAS float*)(c.lds + c.wave * 16384);
    const int nblk = N / 32, items = (K / 64) * nblk;
    int first = c.gw - (rot % c.ngw); if (first < 0) first += c.ngw;
    int lane = c.lane; asm volatile("" : "+v"(lane));
    f32x4 r[8];
#define TR_LOAD(it_) do { const int kb_ = (it_) / nblk, nb_ = (it_) % nblk; _Pragma("unroll") for (int i = 0; i < 8; ++i) r[i] = *(const f32x4*)(W + (size_t)(kb_ * 64 + 8 * i + (lane >> 3)) * ldw + nb_ * 32 + (lane & 7) * 4); } while (0)
    if (first < items) TR_LOAD(first);
    for (int it = first; it < items; it += c.ngw) { const int kb = it / nblk, nb = it % nblk;
#pragma unroll
        for (int i = 0; i < 8; ++i) { LAS float* d = scr + (8 * i + (lane >> 3)) * 33 + (lane & 7) * 4; d[0] = r[i][0]; d[1] = r[i][1]; d[2] = r[i][2]; d[3] = r[i][3]; }
        if (it + c.ngw < items) TR_LOAD(it + c.ngw);
        LDS_WAIT(); asm volatile("" ::: "memory");
        const int cc = lane & 7;
#pragma unroll
        for (int j = 0; j < 4; ++j) { const int n = (lane >> 3) + 8 * j; const LAS float* sp = scr + (8 * cc) * 33 + n;
            u32x4 o; o.x = cvt_pk_bf16(sp[0 * 33], sp[1 * 33]); o.y = cvt_pk_bf16(sp[2 * 33], sp[3 * 33]); o.z = cvt_pk_bf16(sp[4 * 33], sp[5 * 33]); o.w = cvt_pk_bf16(sp[6 * 33], sp[7 * 33]);
            *(u32x4*)(WT + (size_t)(row_off + nb * 32 + n) * ldt + kb * 64 + 8 * cc) = o; }
        LDS_WAIT(); asm volatile("" ::: "memory"); }
#undef TR_LOAD
    rot += items;
}

__device__ __forceinline__ void peer_convert_rows(KP P, const Ctx& c, int g_lo, int g_hi, int rank, int nranks) {
    unsigned char* ws = P->ws;
    f32x4 xn[2][8];
#define CV_LOAD(g0_) do { _Pragma("unroll") for (int h = 0; h < 2; ++h) { const int g = ((g0_) + h < g_hi) ? (g0_) + h : (g0_); const int lt = g >> 14, e = g & 16383, layer = lt >> 1, t = lt & 1; \
            const float* sp = P->in[t ? I_PV : I_PU] + ((size_t)layer * 16384 + e) * D + c.lane * 16; \
            _Pragma("unroll") for (int q = 0; q < 8; ++q) xn[h][q] = *(const f32x4*)(sp + (q >> 2) * 1024 + (q & 3) * 4); } } while (0)
    { const int gf = g_lo + (rank * 8 + c.wave) * 2; if (gf < g_hi) CV_LOAD(gf); }
    for (int g0 = g_lo + (rank * 8 + c.wave) * 2; g0 < g_hi; g0 += nranks * 16) {
        f32x4 x[2][8]; float am[2] = {0.f, 0.f};
#pragma unroll
        for (int h = 0; h < 2; ++h)
#pragma unroll
            for (int q = 0; q < 8; ++q) x[h][q] = xn[h][q];
        if (g0 + nranks * 16 < g_hi) CV_LOAD(g0 + nranks * 16);
#pragma unroll
        for (int h = 0; h < 2; ++h) { if (g0 + h >= g_hi) break;
            const int g = g0 + h; const int lt = g >> 14, e = g & 16383, layer = lt >> 1, t = lt & 1;
#pragma unroll
            for (int q = 0; q < 8; ++q) am[h] = fmaxf(am[h], fmaxf(fmaxf(fabsf(x[h][q][0]), fabsf(x[h][q][1])), fmaxf(fabsf(x[h][q][2]), fabsf(x[h][q][3]))));
            const float a = wave_max(am[h]);
            const float sc = a > 0.f ? exp2f(floorf(log2f(384.0f / a))) : 1.0f;
            if (c.lane == 0) ((float*)(ws + WS_PSC))[(size_t)t * 4 * 16384 + layer * 16384 + e] = 1.0f / sc;
            unsigned char* dst = ws + (t ? WS_PV : WS_PU) + (size_t)layer * 16384 * D;
#pragma unroll
            for (int jj = 0; jj < 2; ++jj) { u32x4 o;
#pragma unroll
                for (int w = 0; w < 4; ++w) { const f32x4 v = x[h][jj * 4 + w] * sc; int p = 0; p = __builtin_amdgcn_cvt_pk_fp8_f32(v[0], v[1], p, false); p = __builtin_amdgcn_cvt_pk_fp8_f32(v[2], v[3], p, true); o[w] = (unsigned)p; }
                const int db = (c.lane >> 3) + 8 * jj;
                *(u32x4*)(dst + ((size_t)db * 16384 + e) * 128 + (c.lane & 7) * 16) = o; } } }
#undef CV_LOAD
}
__device__ __forceinline__ void phase_prologue(KP P, const Ctx& c) {
    unsigned char* ws = P->ws;
    PROBE_REP(14) {
        LAS float* sl = (LAS float*)c.lds;
        LAS float* red = sl + 1280;
        for (int un = blockIdx.x; un < 4 * 24 * 8; un += gridDim.x) {
            const int layer = un / 192, r = un % 192, nb = r / 8, kc = r % 8;
            __syncthreads();
            for (int i = c.tid; i < 5 * 256; i += 512) { const int v = i >> 8, k = kc * 256 + (i & 255); const float x = v < 4 ? P->in[I_C][v * D + k] : P->in[I_CCTX][k]; sl[i] = siluf_(x); }
            __syncthreads();
            const int cg = c.tid & 127, ks = c.tid >> 7;
            const float* w = P->in[I_ADAW] + ((size_t)layer * D + kc * 256 + ks * 64) * 12288 + nb * 512 + cg * 4;
            f32x4 a0 = (f32x4){0.f, 0.f, 0.f, 0.f}, a1 = a0, a2 = a0, a3 = a0, a4 = a0;
            f32x4 wn[8];
#pragma unroll
            for (int i = 0; i < 8; ++i) wn[i] = *(const f32x4*)(w + (size_t)i * 12288);
#pragma unroll 1
            for (int k0 = 0; k0 < 64; k0 += 8) { f32x4 wc[8];
#pragma unroll
                for (int i = 0; i < 8; ++i) wc[i] = wn[i];
                if (k0 + 8 < 64) {
#pragma unroll
                    for (int i = 0; i < 8; ++i) wn[i] = *(const f32x4*)(w + (size_t)(k0 + 8 + i) * 12288); }
#pragma unroll
                for (int i = 0; i < 8; ++i) { const f32x4 wv = wc[i]; const int kk = ks * 64 + k0 + i;
                    a0 += wv * sl[kk]; a1 += wv * sl[256 + kk]; a2 += wv * sl[512 + kk]; a3 += wv * sl[768 + kk]; a4 += wv * sl[1024 + kk]; } }
            LAS float* rp = red + (ks * 5) * 512 + cg * 4;
            *(LAS f32x4*)(rp) = a0; *(LAS f32x4*)(rp + 512) = a1; *(LAS f32x4*)(rp + 1024) = a2; *(LAS f32x4*)(rp + 1536) = a3; *(LAS f32x4*)(rp + 2048) = a4;
            __syncthreads();
            for (int i = c.tid; i < 5 * 512; i += 512) { const int v = i >> 9, n = i & 511;
                const float sum = (red[(0 * 5 + v) * 512 + n] + red[(1 * 5 + v) * 512 + n]) + (red[(2 * 5 + v) * 512 + n] + red[(3 * 5 + v) * 512 + n]);
                ((float*)(ws + WS_MODP))[((size_t)(layer * 8 + kc) * 5 + v) * 12288 + nb * 512 + n] = sum; }
        }
        __syncthreads();
    }
    PROBE_REP(16) {
    int rot = 0;
    for (int j = 0; j < 2; ++j) {
        tr_job(c, rot, P->in[I_RGWIN] + (size_t)j * D * 4096, D, 4096, 4096, (bf16_t*)(ws + WS_RGIN) + (size_t)j * 4096 * D, D, 0);
        tr_job(c, rot, P->in[I_RGWOUT] + (size_t)j * D * D, D, D, D, (bf16_t*)(ws + WS_RGOUT) + (size_t)j * D * D, D, 0);
    }
    {
        LAS float* scr = (LAS float*)(c.lds + c.wave * 16384);
        const int items = 64 * 32;
        int first = c.gw - (rot % c.ngw); if (first < 0) first += c.ngw;
        for (int it = first; it < items; it += c.ngw) {
            const int mat = it >> 5, sub = it & 31, kb = sub >> 3, nb32 = sub & 7;
            const int jl = mat >> 5, d = (mat >> 4) & 1, g = (mat >> 3) & 1, nblk = mat & 7;
            const int n0 = nb32 * 32, hf = n0 >> 7, pn = (d * 8 + nblk) * 2 + hf;
            transpose_item(P->in[I_RGGW] + (size_t)mat * 65536, 256, (bf16_t*)(ws + WS_RGGATE) + (size_t)jl * 8192 * 256, 256, kb * 64, n0, pn * 256 + g * 128 + (n0 & 127), scr, c.lane);
        }
        rot += items;
    }
    for (int m = 0; m < 3; ++m) tr_job(c, rot, P->in[I_RWRKV] + (size_t)m * D * D, D, D, D, (bf16_t*)(ws + WS_RW1), D, m * D);
    for (int d = 0; d < 2; ++d) {
        tr_job(c, rot, P->in[I_RWDEC1] + (size_t)d * D * 96, D, 96, 96, (bf16_t*)(ws + WS_RW1), D, 6144 + d * 96);
        tr_job(c, rot, P->in[I_RWICL1] + (size_t)d * D * 96, D, 96, 96, (bf16_t*)(ws + WS_RW1), D, 6400 + d * 96);
    }
    tr_job(c, rot, P->in[I_RWG1], D, 256, 256, (bf16_t*)(ws + WS_RW1), D, 6656);
    tr_job(c, rot, P->in[I_RWWO], D, D, D, (bf16_t*)(ws + WS_RWO), D, 0);
    tr_job(c, rot, P->in[I_RETWIN], D, 16384, 16384, (bf16_t*)(ws + WS_RETIN), D, 0);
    tr_job(c, rot, P->in[I_RETWOUT], 4096, D, D, (bf16_t*)(ws + WS_RETOUT), 4096, 0);
    }
    PROBE_REP(17) {
    for (size_t i0 = c.gtid; i0 < (size_t)4 * D * D / 8; i0 += 4 * (size_t)c.ngt) { f32x4 a[4], b[4];
#pragma unroll
        for (int u = 0; u < 4; ++u) { const size_t i = i0 + (size_t)u * c.ngt; if (i < (size_t)4 * D * D / 8) { a[u] = *(const f32x4*)(P->in[I_PWQ] + i * 8); b[u] = *(const f32x4*)(P->in[I_PWQ] + i * 8 + 4); } }
#pragma unroll
        for (int u = 0; u < 4; ++u) { const size_t i = i0 + (size_t)u * c.ngt; if (i < (size_t)4 * D * D / 8)
            *(u32x4*)((bf16_t*)(ws + WS_WQN) + i * 8) = (u32x4){cvt_pk_bf16(a[u][0], a[u][1]), cvt_pk_bf16(a[u][2], a[u][3]), cvt_pk_bf16(b[u][0], b[u][1]), cvt_pk_bf16(b[u][2], b[u][3])}; } }
    for (int i = c.gtid; i < 2 * 64 * (D / 8); i += c.ngt) { const int blk = i / (64 * (D / 8)), r = (i / (D / 8)) % 64, c8 = i % (D / 8);
        *(u32x4*)((bf16_t*)(ws + WS_RW1) + (size_t)(6144 + blk * 256 + 192 + r) * D + c8 * 8) = (u32x4){0u, 0u, 0u, 0u}; }
    for (int i = c.gtid; i < 4 * 2048 * 32; i += c.ngt) { const int c8 = i & 31, row = (i >> 5) & 2047, l = i >> 16; const int p = (row >> 7) & 1, col = c8 * 8;
        u32x4 o = (u32x4){0u, 0u, 0u, 0u};
        if ((col >> 7) == p) { const float* s = P->in[I_PKEYS] + ((size_t)l * 2048 + row) * 128 + (col & 127); const f32x4 a = *(const f32x4*)s, b = *(const f32x4*)(s + 4);
            o.x = cvt_pk_bf16(a[0], a[1]); o.y = cvt_pk_bf16(a[2], a[3]); o.z = cvt_pk_bf16(b[0], b[1]); o.w = cvt_pk_bf16(b[2], b[3]); }
        *(u32x4*)((bf16_t*)(ws + WS_KEYS) + ((size_t)l * 2048 + row) * 256 + col) = o; }
    for (int i0 = c.gtid; i0 < 10240 * 256; i0 += 4 * c.ngt) { float v4[4];
#pragma unroll
        for (int u = 0; u < 4; ++u) { const int i = i0 + u * c.ngt; float v = 0.f;
            if (i < 10240 * 256) { const int kc = i & 255, r = i >> 8;
                if (r < 4096) { const int d = r >> 11, cc = r & 2047, k = kc - 96 * d; if (k >= 0 && k < 96) v = P->in[I_RWDEC2][((size_t)d * 96 + k) * D + cc]; }
                else if (r < 8192) { const int rr = r - 4096, d = rr >> 11, cc = rr & 2047, k = kc - 96 * d; if (k >= 0 && k < 96) v = P->in[I_RWICL2][((size_t)d * 96 + k) * D + cc]; }
                else v = P->in[I_RWG2][(size_t)kc * D + (r - 8192)]; }
            v4[u] = v; }
#pragma unroll
        for (int u = 0; u < 4; ++u) { const int i = i0 + u * c.ngt; if (i < 10240 * 256) ((bf16_t*)(ws + WS_RW2))[i] = (bf16_t)(cvt_pk_bf16(v4[u], 0.f) & 0xffffu); } }
    }
    PROBE_REP(18)
    for (int i = c.gtid; i < 2 * 2 * D; i += c.ngt) ((float*)(ws + WS_SPT))[i] = -8.0f * log1pf(expf(-P->in[I_RGLAM][i]));
    PROBE_REP(18)
    for (int i = c.gtid; i < SLEN * 128; i += c.ngt) { const int pos = i >> 7, k = i & 127; const float theta = 1.0f / powf(10000.0f, (float)k / 127.0f); const float ang = (float)pos * theta;
        ((f32x2*)(ws + WS_CS))[i] = (f32x2){cosf(ang), sinf(ang)}; }
}
__device__ __forceinline__ void phase_modfin(KP P, const Ctx& c) {
    for (int i = c.gtid; i < 4 * 5 * 12288; i += c.ngt) { const int n = i % 12288, lv = i / 12288, l = lv / 5, v = lv % 5;
        float s = P->in[I_ADAB][l * 12288 + n];
        for (int kc = 0; kc < 8; ++kc) s += ((const float*)(P->ws + WS_MODP))[((size_t)(l * 8 + kc) * 5 + v) * 12288 + n];
        ((float*)(P->ws + WS_MOD))[i] = s; }
}
__device__ __forceinline__ void phase_xinit(KP P, const Ctx& c) {
    bf16_t* X = (bf16_t*)(P->ws + WS_X); bf16_t* A0 = (bf16_t*)(P->ws + WS_A0);
    for (size_t i0 = c.gtid; i0 < TD / 4; i0 += 4 * (size_t)c.ngt) {
        f32x4 x[4], sh[4], sc[4];
#pragma unroll
        for (int u = 0; u < 4; ++u) { const size_t i = i0 + (size_t)u * c.ngt; if (i < TD / 4) { const int row = (int)(i >> 9), c4 = (int)(i & 511) * 4;
            const float* src = row < NCTX ? P->in[I_CTX] + (size_t)row * D : P->in[I_X] + (size_t)(row - NCTX) * D; const int v = row_vec(row);
            x[u] = *(const f32x4*)(src + c4); sh[u] = *(const f32x4*)(modp(P, 0, v, 0) + c4); sc[u] = *(const f32x4*)(modp(P, 0, v, 1) + c4); } }
#pragma unroll
        for (int u = 0; u < 4; ++u) { const size_t i = i0 + (size_t)u * c.ngt; if (i < TD / 4) { const int row = (int)(i >> 9), c4 = (int)(i & 511) * 4;
            *(u32x2*)(X + (size_t)row * D + c4) = (u32x2){cvt_pk_bf16(x[u][0], x[u][1]), cvt_pk_bf16(x[u][2], x[u][3])};
            const f32x4 h = x[u] * (sc[u] + 1.0f) + sh[u];
            *(u32x2*)(A0 + (size_t)row * D + c4) = (u32x2){cvt_pk_bf16(h[0], h[1]), cvt_pk_bf16(h[2], h[3])}; } } }
}

__device__ __forceinline__ void phase_rg_conv(KP P, const Ctx& c, int jl) {
    const bf16_t* UR = (const bf16_t*)(P->ws + L_UR); bf16_t* XC = (bf16_t*)(P->ws + L_XC);
    const float* cw = P->in[I_RGCW] + (size_t)jl * 4 * D; const float* cb = P->in[I_RGCB] + (size_t)jl * D;
    const int c8 = (int)(c.gtid & 255) * 8;
    float w8[4][8], b8[8];
#pragma unroll
    for (int j = 0; j < 8; ++j) { b8[j] = cb[c8 + j];
#pragma unroll
        for (int tp = 0; tp < 4; ++tp) w8[tp][j] = cw[tp * D + c8 + j]; }
    for (size_t i0 = c.gtid; i0 < TD / 8; i0 += 2 * (size_t)c.ngt) {
        u32x4 u[2][4];
#pragma unroll
        for (int q = 0; q < 2; ++q) { const size_t i = i0 + (size_t)q * c.ngt; const int row = (int)(i >> 8);
            int lo, hi; if (row < NCTX) { lo = row & ~(CTX - 1); hi = lo + CTX; } else { lo = NCTX + ((row - NCTX) & ~(SEQ - 1)); hi = lo + SEQ; }
#pragma unroll
            for (int tp = 0; tp < 4; ++tp) { const int rr = row + tp - 2; u[q][tp] = (u32x4){0u, 0u, 0u, 0u};
                if (i < TD / 8 && rr >= lo && rr < hi) u[q][tp] = *(const u32x4*)(UR + (size_t)rr * D + c8); } }
#pragma unroll
        for (int q = 0; q < 2; ++q) { const size_t i = i0 + (size_t)q * c.ngt; if (i >= TD / 8) break; const int row = (int)(i >> 8);
            float a[8];
#pragma unroll
            for (int j = 0; j < 8; ++j) a[j] = b8[j];
#pragma unroll
            for (int tp = 0; tp < 4; ++tp) { const u32x4 uu = u[q][tp]; const unsigned u0 = uu.x, u1 = uu.y, u2 = uu.z, u3 = uu.w;
                a[0] += w8[tp][0] * bflo(u0); a[1] += w8[tp][1] * bfhi(u0); a[2] += w8[tp][2] * bflo(u1); a[3] += w8[tp][3] * bfhi(u1);
                a[4] += w8[tp][4] * bflo(u2); a[5] += w8[tp][5] * bfhi(u2); a[6] += w8[tp][6] * bflo(u3); a[7] += w8[tp][7] * bfhi(u3); }
            *(u32x4*)(XC + (size_t)row * D + c8) = (u32x4){cvt_pk_bf16(a[0], a[1]), cvt_pk_bf16(a[2], a[3]), cvt_pk_bf16(a[4], a[5]), cvt_pk_bf16(a[6], a[7])}; } }
}
__device__ __forceinline__ void phase_rg_scan1(KP P, const Ctx& c) {
    const bf16_t* LA = (const bf16_t*)(P->ws + L_LA); const bf16_t* BB = (const bf16_t*)(P->ws + L_BB);
    float* CA = (float*)(P->ws + WS_CA); float* CH = (float*)(P->ws + WS_CH);
    for (int u = c.gw; u < 2048; u += c.ngw) { const int b = u >> 9, dir = (u >> 8) & 1, ck = (u >> 2) & 63, ch = (u & 3) * 512 + c.lane * 8;
        float h[8], sl[8];
#pragma unroll
        for (int e = 0; e < 8; ++e) { h[e] = 0.f; sl[e] = 0.f; }
        u32x4 nl[4], nb[4];
#define SC1_LOAD(s0_) do { _Pragma("unroll") for (int i_ = 0; i_ < 4; ++i_) { const int row_ = seq_row(b, dir, ck * 68 + (s0_) + i_); const size_t o_ = ((size_t)row_ * 2 + dir) * D + ch; nl[i_] = *(const u32x4*)(LA + o_); nb[i_] = *(const u32x4*)(BB + o_); } } while (0)
        SC1_LOAD(0);
#pragma unroll 1
        for (int s0 = 0; s0 < 68; s0 += 4) { u32x4 cl[4], cb[4];
#pragma unroll
            for (int i = 0; i < 4; ++i) { cl[i] = nl[i]; cb[i] = nb[i]; }
            if (s0 + 4 < 68) SC1_LOAD(s0 + 4);
#pragma unroll
            for (int i = 0; i < 4; ++i) { float l8[8], b8[8]; unpack8(cl[i], l8); unpack8(cb[i], b8);
#pragma unroll
                for (int e = 0; e < 8; ++e) { h[e] = __expf(l8[e]) * h[e] + b8[e]; sl[e] += l8[e]; } } }
#undef SC1_LOAD
        const size_t o = ((size_t)(b * 2 + dir) * 64 + ck) * D + ch;
        *(f32x4*)(CA + o) = (f32x4){sl[0], sl[1], sl[2], sl[3]}; *(f32x4*)(CA + o + 4) = (f32x4){sl[4], sl[5], sl[6], sl[7]};
        *(f32x4*)(CH + o) = (f32x4){h[0], h[1], h[2], h[3]}; *(f32x4*)(CH + o + 4) = (f32x4){h[4], h[5], h[6], h[7]}; }
}
__device__ __forceinline__ void phase_rg_scan2(KP P, const Ctx& c) {
    const float* CA = (const float*)(P->ws + WS_CA); const float* CH = (const float*)(P->ws + WS_CH); float* CIN = (float*)(P->ws + WS_CIN);
    for (int i = c.gtid; i < 4 * 2 * D; i += c.ngt) { const int ch = i & (D - 1), bd = i >> 11; float carry = 0.f;
#pragma unroll 1
        for (int c0 = 0; c0 < 64; c0 += 16) { float a[16], hh[16];
#pragma unroll
            for (int q = 0; q < 16; ++q) { const size_t o = ((size_t)bd * 64 + c0 + q) * D + ch; a[q] = CA[o]; hh[q] = CH[o]; }
#pragma unroll
            for (int q = 0; q < 16; ++q) { const size_t o = ((size_t)bd * 64 + c0 + q) * D + ch; CIN[o] = carry; carry = __expf(a[q]) * carry + hh[q]; } } }
}
template <int DIR> __device__ __forceinline__ void phase_rg_scan3(KP P, const Ctx& c) {
    const bf16_t* LA = (const bf16_t*)(P->ws + L_LA); const bf16_t* BB = (const bf16_t*)(P->ws + L_BB); const bf16_t* UG = (const bf16_t*)(P->ws + L_UG);
    const float* CIN = (const float*)(P->ws + WS_CIN); bf16_t* YIN = (bf16_t*)(P->ws + L_YIN); bf16_t* HF = (bf16_t*)(P->ws + L_XC);
    for (int u = c.gw; u < 2048; u += c.ngw) { const int b = u >> 9, ck = (u >> 3) & 63, ch = (u & 7) * 256 + c.lane * 4;
        const f32x4 h0 = *(const f32x4*)(CIN + ((size_t)(b * 2 + DIR) * 64 + ck) * D + ch); float h[4] = {h0[0], h0[1], h0[2], h0[3]};
        u32x2 nl[4], nb[4], nf[4], ng[4];
#define SC3_LOAD(s0_) do { _Pragma("unroll") for (int i_ = 0; i_ < 4; ++i_) { const int row_ = seq_row(b, DIR, ck * 68 + (s0_) + i_); const size_t o_ = ((size_t)row_ * 2 + DIR) * D + ch, q_ = (size_t)row_ * D + ch; \
            nl[i_] = *(const u32x2*)(LA + o_); nb[i_] = *(const u32x2*)(BB + o_); if (DIR == 1) { nf[i_] = *(const u32x2*)(HF + q_); ng[i_] = *(const u32x2*)(UG + q_); } } } while (0)
        SC3_LOAD(0);
#pragma unroll 1
        for (int s0 = 0; s0 < 68; s0 += 4) { u32x2 cl[4], cb[4], cf[4], cg[4];
#pragma unroll
            for (int i = 0; i < 4; ++i) { cl[i] = nl[i]; cb[i] = nb[i]; if (DIR == 1) { cf[i] = nf[i]; cg[i] = ng[i]; } }
            if (s0 + 4 < 68) SC3_LOAD(s0 + 4);
#pragma unroll
            for (int i = 0; i < 4; ++i) { const int row = seq_row(b, DIR, ck * 68 + s0 + i); const size_t q = (size_t)row * D + ch;
                const unsigned l0 = cl[i].x, l1 = cl[i].y, b0 = cb[i].x, b1 = cb[i].y;
                h[0] = __expf(bflo(l0)) * h[0] + bflo(b0); h[1] = __expf(bfhi(l0)) * h[1] + bfhi(b0); h[2] = __expf(bflo(l1)) * h[2] + bflo(b1); h[3] = __expf(bfhi(l1)) * h[3] + bfhi(b1);
                if (DIR == 0) { *(u32x2*)(HF + q) = (u32x2){cvt_pk_bf16(h[0], h[1]), cvt_pk_bf16(h[2], h[3])}; }
                else { const unsigned f0 = cf[i].x, f1 = cf[i].y, g0 = cg[i].x, g1 = cg[i].y;
                    *(u32x2*)(YIN + q) = (u32x2){cvt_pk_bf16(bflo(g0) * (bflo(f0) + h[0]), bfhi(g0) * (bfhi(f0) + h[1])), cvt_pk_bf16(bflo(g1) * (bflo(f1) + h[2]), bfhi(g1) * (bfhi(f1) + h[3]))}; } } }
#undef SC3_LOAD
    }
}

__device__ __forceinline__ void phase_ln_mid(KP P, const Ctx& c, int layer, int row_lo) {
    bf16_t* X = (bf16_t*)(P->ws + WS_X); bf16_t* H2 = (bf16_t*)(P->ws + WS_H2);
    const float* lg = P->in[I_LNG] + (size_t)(layer * 2 + 0) * D; const float* lb = P->in[I_LNB] + (size_t)(layer * 2 + 0) * D;
    u32x2 xn[8];
    f32x4 lg8[8], lb8[8];
#pragma unroll
    for (int j = 0; j < 8; ++j) { lg8[j] = *(const f32x4*)(lg + c.lane * 4 + 256 * j); lb8[j] = *(const f32x4*)(lb + c.lane * 4 + 256 * j); }
    const bf16_t* PB = (const bf16_t*)(P->ws + WS_S);
    u32x2 pn[8];
    { const int r0 = row_lo + c.gw; if (r0 < T) {
#pragma unroll
        for (int j = 0; j < 8; ++j) { xn[j] = *(const u32x2*)(X + (size_t)r0 * D + c.lane * 4 + 256 * j); pn[j] = *(const u32x2*)(PB + (size_t)r0 * D + c.lane * 4 + 256 * j); } } }
    f32x4 gt8[8]; int vprev = -1;
    for (int row = row_lo + c.gw; row < T; row += c.ngw) { bf16_t* xr = X + (size_t)row * D + c.lane * 4; const int v = row_vec(row);
        f32x4 x[8]; float s = 0.f;
        if (v != vprev) { const float* gp = modp(P, layer, v, 2) + c.lane * 4; vprev = v;
#pragma unroll
          for (int j = 0; j < 8; ++j) gt8[j] = *(const f32x4*)(gp + 256 * j); }
        {
#pragma unroll
          for (int j = 0; j < 8; ++j) { const unsigned p0 = pn[j].x, p1 = pn[j].y, x0 = xn[j].x, x1 = xn[j].y;
              x[j] = (f32x4){bflo(x0), bfhi(x0), bflo(x1), bfhi(x1)} * ALPHA + gt8[j] * (f32x4){bflo(p0), bfhi(p0), bflo(p1), bfhi(p1)}; } }
        if (row + c.ngw < T) {
#pragma unroll
            for (int j = 0; j < 8; ++j) { xn[j] = *(const u32x2*)(X + (size_t)(row + c.ngw) * D + c.lane * 4 + 256 * j); pn[j] = *(const u32x2*)(PB + (size_t)(row + c.ngw) * D + c.lane * 4 + 256 * j); } }
#pragma unroll
        for (int j = 0; j < 8; ++j) s += (x[j][0] + x[j][1]) + (x[j][2] + x[j][3]);
        const float mean = wave_sum(s) * (1.0f / D); float q = 0.f;
#pragma unroll
        for (int j = 0; j < 8; ++j) { x[j] = x[j] - mean; q += (x[j][0] * x[j][0] + x[j][1] * x[j][1]) + (x[j][2] * x[j][2] + x[j][3] * x[j][3]); }
        const float rstd = rsqrtf(wave_sum(q) * (1.0f / D) + LN_EPS);
        const float* m3 = modp(P, layer, v, 3) + c.lane * 4; const float* m4 = modp(P, layer, v, 4) + c.lane * 4;
#pragma unroll
        for (int jh = 0; jh < 2; ++jh) { f32x4 g4[4], b4[4], p4[4], q4[4];
#pragma unroll
            for (int jj = 0; jj < 4; ++jj) { const int j = 4 * jh + jj; g4[jj] = lg8[j]; b4[jj] = lb8[j];
                p4[jj] = *(const f32x4*)(m4 + 256 * j); q4[jj] = *(const f32x4*)(m3 + 256 * j); }
#pragma unroll
            for (int jj = 0; jj < 4; ++jj) { const int j = 4 * jh + jj;
                const f32x4 y = x[j] * rstd * g4[jj] + b4[jj]; *(u32x2*)(xr + 256 * j) = (u32x2){cvt_pk_bf16(y[0], y[1]), cvt_pk_bf16(y[2], y[3])};
                const f32x4 h = y * (p4[jj] + 1.0f) + q4[jj];
                *(u32x2*)(H2 + (size_t)row * D + c.lane * 4 + 256 * j) = (u32x2){cvt_pk_bf16(h[0], h[1]), cvt_pk_bf16(h[2], h[3])}; } } }
}

__device__ __forceinline__ float dot2bf(unsigned a, unsigned b, float s) { return __builtin_amdgcn_fdot2_f32_bf16(__builtin_bit_cast(bf16v2, a), __builtin_bit_cast(bf16v2, b), s, false); }
__device__ __forceinline__ float dot8(const u32x4 a, const u32x4 b, float s) {
    const unsigned a0 = a.x, a1 = a.y, a2 = a.z, a3 = a.w, b0 = b.x, b1 = b.y, b2 = b.z, b3 = b.w;
    s = dot2bf(a0, b0, s); s = dot2bf(a1, b1, s); s = dot2bf(a2, b2, s); s = dot2bf(a3, b3, s);
    return s;
}
template <int CTRL> __device__ __forceinline__ int dpp_movi(int x) { return __builtin_amdgcn_update_dpp(x, x, CTRL, 0xF, 0xF, false); }
__device__ __forceinline__ int row_max_i(int m) { m = max(m, dpp_movi<0xB1>(m)); m = max(m, dpp_movi<0x4E>(m)); m = max(m, dpp_movi<0x141>(m)); m = max(m, dpp_movi<0x140>(m)); return m; }
template <int PAT> __device__ __forceinline__ int swz(int v) { return __builtin_amdgcn_ds_swizzle(v, PAT); }
__device__ __forceinline__ int f2key(float f) { const int b = __float_as_int(f); return b ^ ((b >> 31) & 0x7fffffff); }
__device__ __forceinline__ float key2f(int k) { return __int_as_float(k ^ ((k >> 31) & 0x7fffffff)); }
__device__ __forceinline__ void row_max_i_pair(int& a, int& b) {
    asm volatile("s_nop 1\n\t"
        "v_max_i32_dpp %0, %0, %0 quad_perm:[1,0,3,2] row_mask:0xf bank_mask:0xf\n\tv_max_i32_dpp %1, %1, %1 quad_perm:[1,0,3,2] row_mask:0xf bank_mask:0xf\n\ts_nop 0\n\t"
        "v_max_i32_dpp %0, %0, %0 quad_perm:[2,3,0,1] row_mask:0xf bank_mask:0xf\n\tv_max_i32_dpp %1, %1, %1 quad_perm:[2,3,0,1] row_mask:0xf bank_mask:0xf\n\ts_nop 0\n\t"
        "v_max_i32_dpp %0, %0, %0 row_half_mirror row_mask:0xf bank_mask:0xf\n\tv_max_i32_dpp %1, %1, %1 row_half_mirror row_mask:0xf bank_mask:0xf\n\ts_nop 0\n\t"
        "v_max_i32_dpp %0, %0, %0 row_mirror row_mask:0xf bank_mask:0xf\n\tv_max_i32_dpp %1, %1, %1 row_mirror row_mask:0xf bank_mask:0xf"
        : "+v"(a), "+v"(b));
}
__device__ __forceinline__ void phase_peer_select(KP P, const Ctx& c, int row_lo) {
    const float* S = (const float*)(P->ws + WS_S); float* SW = (float*)(P->ws + WS_SELW);
    constexpr int KMIN = (int)0x80000000;
    const int nps = (2 * (T - row_lo) - c.gw + c.ngw - 1) / c.ngw;
    f32x4 sn[2][2];
#define SEL_LOAD(k) do { const int pid_ = 2 * row_lo + c.gw + (k) * c.ngw; const float* sp_ = S + (size_t)(pid_ >> 1) * D + (2 * (pid_ & 1)) * 512 + lane * 8; \
        sn[0][0] = *(const f32x4*)sp_; sn[0][1] = *(const f32x4*)(sp_ + 4); sn[1][0] = *(const f32x4*)(sp_ + 512); sn[1][1] = *(const f32x4*)(sp_ + 516); } while (0)
    { int lane = c.lane; asm volatile("" : "+v"(lane)); if (nps > 0) SEL_LOAD(0); }
    {
#pragma unroll 1
        for (int kk = 0; kk < nps; ++kk) {
            const int pid = 2 * row_lo + c.gw + kk * c.ngw, row = pid >> 1, pp = pid & 1;
            int lane = c.lane; asm volatile("" : "+v"(lane));
            const int l16 = lane & 15, isS2 = (lane >> 4) & 1;
            int k8[2][8];
#pragma unroll
            for (int q = 0; q < 2; ++q) {
#pragma unroll
                for (int e = 0; e < 8; ++e) { const float v = sn[q][e >> 2][e & 3]; k8[q][e] = (f2key(v) & ~127) | (127 - (l16 * 8 + e)); } }
            if (kk + 1 < nps) SEL_LOAD(kk + 1);
#define SEL_CE(a, b) do { const int hi_ = max(a, b), lo_ = min(a, b); a = hi_; b = lo_; } while (0)
#pragma unroll
            for (int q = 0; q < 2; ++q) { int (&k)[8] = k8[q];
                SEL_CE(k[0], k[1]); SEL_CE(k[2], k[3]); SEL_CE(k[4], k[5]); SEL_CE(k[6], k[7]); SEL_CE(k[0], k[2]); SEL_CE(k[1], k[3]); SEL_CE(k[4], k[6]); SEL_CE(k[5], k[7]);
                SEL_CE(k[1], k[2]); SEL_CE(k[5], k[6]); SEL_CE(k[0], k[4]); SEL_CE(k[3], k[7]); SEL_CE(k[1], k[5]); SEL_CE(k[2], k[6]); SEL_CE(k[1], k[4]); SEL_CE(k[3], k[6]);
                SEL_CE(k[2], k[4]); SEL_CE(k[3], k[5]); SEL_CE(k[3], k[4]); }
            int own[2] = {KMIN, KMIN};
#pragma unroll
            for (int it = 0; it < 16; ++it) {
                int m0 = k8[0][0], m1 = k8[1][0];
                row_max_i_pair(m0, m1);
                const bool p0 = k8[0][0] == m0, p1 = k8[1][0] == m1;
#pragma unroll
                for (int e = 0; e < 7; ++e) { k8[0][e] = p0 ? k8[0][e + 1] : k8[0][e]; k8[1][e] = p1 ? k8[1][e + 1] : k8[1][e]; }
                k8[0][7] = p0 ? KMIN : k8[0][7]; k8[1][7] = p1 ? KMIN : k8[1][7];
                own[0] = (l16 == it) ? m0 : own[0]; own[1] = (l16 == it) ? m1 : own[1]; }
            int ck[2][4], ownIdx[2];
#pragma unroll
            for (int q = 0; q < 2; ++q) { ownIdx[q] = 127 - (own[q] & 127); const float ownVal = key2f(own[q]);
                int pk[4]; pk[0] = swz<(0x10 << 10) | (0 << 5) | 0x10>(own[q]); pk[1] = swz<(0x10 << 10) | (1 << 5) | 0x10>(own[q]); pk[2] = swz<(0x10 << 10) | (2 << 5) | 0x10>(own[q]); pk[3] = swz<(0x10 << 10) | (3 << 5) | 0x10>(own[q]);
#pragma unroll
                for (int m = 0; m < 4; ++m) { const float pv = key2f(pk[m]);
                    const int ci = isS2 ? m : l16, cj = isS2 ? l16 : m;
                    const bool valid = (isS2 ? (m <= l16) : (m < l16)) && ((ci + 1) * (cj + 1) <= 16);
                    ck[q][m] = valid ? ((f2key(ownVal + pv) & ~255) | (255 - (ci * 16 + cj))) : KMIN; } }
#pragma unroll
            for (int q = 0; q < 2; ++q) { int (&k)[4] = ck[q]; SEL_CE(k[0], k[1]); SEL_CE(k[2], k[3]); SEL_CE(k[0], k[2]); SEL_CE(k[1], k[3]); SEL_CE(k[1], k[2]); }
#undef SEL_CE
            int win[2] = {KMIN, KMIN};
#pragma unroll
            for (int it = 0; it < 16; ++it) {
                int m0 = ck[0][0], m1 = ck[1][0];
                row_max_i_pair(m0, m1);
                m0 = max(m0, swz<(0x10 << 10) | 0x1F>(m0)); m1 = max(m1, swz<(0x10 << 10) | 0x1F>(m1));
                const bool p0 = ck[0][0] == m0, p1 = ck[1][0] == m1;
#pragma unroll
                for (int e = 0; e < 3; ++e) { ck[0][e] = p0 ? ck[0][e + 1] : ck[0][e]; ck[1][e] = p1 ? ck[1][e + 1] : ck[1][e]; }
                ck[0][3] = p0 ? KMIN : ck[0][3]; ck[1][3] = p1 ? KMIN : ck[1][3];
                win[0] = (l16 == it) ? m0 : win[0]; win[1] = (l16 == it) ? m1 : win[1]; }
#pragma unroll
            for (int q = 0; q < 2; ++q) {
                const int cidx = 255 - (win[q] & 255), ci = (cidx >> 4) & 15, cj = cidx & 15, rb = lane & 32;
                const int i1 = __builtin_amdgcn_ds_bpermute((rb + ci) << 2, ownIdx[q]), i2 = __builtin_amdgcn_ds_bpermute((rb + 16 + cj) << 2, ownIdx[q]);
                const float sc = key2f(win[q]);
                const float mxf = key2f(row_max_i(f2key(sc)));
                const float ex = __expf(sc - mxf);
                float sum = ex; sum += dpp_mov<0xB1>(sum); sum += dpp_mov<0x4E>(sum); sum += dpp_mov<0x141>(sum); sum += dpp_mov<0x140>(sum);
                if (!isS2) { const size_t o = ((size_t)row * 8 + (2 * pp + q) * 2 + (lane >> 5)) * 16 + l16; const int e_ = (i1 * 128 + i2) & 16383; ((unsigned short*)(P->ws + P_SE16))[o] = (unsigned short)e_; SW[o] = ex / sum; } }
        }
    }
#undef SEL_LOAD
}

__device__ __forceinline__ float dot2bf_init(bf16v2 a, bf16v2 b) { float r; asm("v_dot2_f32_bf16 %0, %1, %2, 0" : "=v"(r) : "v"(a), "v"(b)); return r; }
__device__ __forceinline__ void unpack16_fp8(const u32x4 a, float (&f)[16]) {
#pragma unroll
    for (int w = 0; w < 4; ++w) { const int aw = (int)a[w]; const f32x2 lo = __builtin_amdgcn_cvt_pk_f32_fp8(aw, false), hi = __builtin_amdgcn_cvt_pk_f32_fp8(aw, true);
        f[4 * w + 0] = lo.x; f[4 * w + 1] = lo.y; f[4 * w + 2] = hi.x; f[4 * w + 3] = hi.y; }
}
#define PEER_QUEUE_BEGIN(phase_id, tg_lo, tg_hi) { \
    unsigned* heads_ = (unsigned*)(P->ws + WS_CTL) + CW_PQ + (phase_id) * 16 * 64; const unsigned x_ = ((PROBE >> 19) & 1) ? ((unsigned)blockIdx.x >> 5) & 7u : (xb_xcc_id() & 7u); \
    for (int k_ = 0; k_ < 16; ++k_) { const int db = (int)((x_ + 8u * (k_ & 1) + (unsigned)(k_ >> 1)) & 15u); \
        for (;;) { unsigned t0_ = 0; if (c.lane == 0) t0_ = __hip_atomic_fetch_add(heads_ + db * 64, 2u, __ATOMIC_RELAXED, __HIP_MEMORY_SCOPE_AGENT); \
            t0_ = (unsigned)__builtin_amdgcn_readfirstlane((int)t0_) + (unsigned)(tg_lo); if (t0_ >= (unsigned)(tg_hi)) break; \
            for (unsigned tg_ = t0_; tg_ < t0_ + 2u && tg_ < (unsigned)(tg_hi); ++tg_) { const int tg = (int)tg_;
#define PEER_QUEUE_END } } } }
__device__ __forceinline__ void phase_peer_u(KP P, const Ctx& c, int layer, int row_lo, int qrep) {
    const bf16_t* H2 = (const bf16_t*)(P->ws + WS_H2); const unsigned short* SE = (const unsigned short*)(P->ws + P_SE16);
    const unsigned char* U = P->ws + WS_PU + (size_t)layer * 16384 * D; bf16_t* PART = (bf16_t*)(P->ws + P_PART);
    PEER_QUEUE_BEGIN(layer * 2 + 0 + 8 * qrep, row_lo / 8, T / 8)
        int lane = c.lane; asm volatile("" : "+v"(lane));
        const int ts = lane >> 3, seg = lane & 7, t = tg * 8 + ts;
        const bf16_t* xp = H2 + (size_t)t * D + db * 128 + seg * 16; const u32x4 xa = *(const u32x4*)xp, xb = *(const u32x4*)(xp + 8);
        const unsigned short* se = SE + (size_t)t * 128; const unsigned char* ub = U + (size_t)db * 16384 * 128; const unsigned seg16 = (unsigned)seg * 16u;
        bf16_t* pp = PART + (((size_t)t * 16 + db) * 8 + seg) * 16;
        u32x4 eA[2], eB[2], gA[16], gB[16];
#define PU_IDX(E, st) do { _Pragma("unroll") for (int i_ = 0; i_ < 2; ++i_) E[i_] = *(const u32x4*)(se + 16 * (st) + 8 * i_); } while (0)
#define PU_GATHER(G, E) do { _Pragma("unroll") for (int k_ = 0; k_ < 16; ++k_) { const unsigned w_ = E[k_ >> 3][(k_ >> 1) & 3]; const unsigned e_ = ((k_ & 1) ? (w_ >> 16) : w_) & 16383u; G[k_] = *(const u32x4*)(ub + (unsigned)((e_ << 7) | seg16)); } } while (0)
#define PU_COMPUTE(G, OUT) do { float v2_[2]; \
            _Pragma("unroll") for (int cc = 0; cc < 2; ++cc) { float sk[8]; \
                _Pragma("unroll") for (int k = 0; k < 8; ++k) { float s0; \
                    _Pragma("unroll") for (int w = 0; w < 4; ++w) { const int gw_ = (int)G[8 * cc + k][w]; const unsigned x0 = w < 2 ? xa[2 * w] : xb[2 * w - 4], x1 = w < 2 ? xa[2 * w + 1] : xb[2 * w - 3]; \
                        if (w == 0) s0 = dot2bf_init(__builtin_amdgcn_cvt_scalef32_pk_bf16_fp8(gw_, 1.0f, false), __builtin_bit_cast(bf16v2, x0)); \
                        else s0 = __builtin_amdgcn_fdot2_f32_bf16(__builtin_amdgcn_cvt_scalef32_pk_bf16_fp8(gw_, 1.0f, false), __builtin_bit_cast(bf16v2, x0), s0, false); \
                        s0 = __builtin_amdgcn_fdot2_f32_bf16(__builtin_amdgcn_cvt_scalef32_pk_bf16_fp8(gw_, 1.0f, true), __builtin_bit_cast(bf16v2, x1), s0, false); } \
                    sk[k] = s0; } \
                sum8_quad(sk[0], sk[1], sk[2], sk[3]); sum8_quad(sk[4], sk[5], sk[6], sk[7]); \
                float v = 0.f; \
                _Pragma("unroll") for (int k = 0; k < 8; ++k) v = (seg == k) ? sk[k] : v; \
                v2_[cc] = v; } \
            OUT = cvt_pk_bf16(v2_[0], v2_[1]); } while (0)
        PU_IDX(eA, 0); PU_IDX(eB, 1); PU_GATHER(gA, eA);
#pragma unroll 1
        for (int j2 = 0; j2 < 4; ++j2) {
            PU_GATHER(gB, eB);
            if (j2 < 3) PU_IDX(eA, 2 * j2 + 2);
            unsigned pw0, pw1;
            PU_COMPUTE(gA, pw0);
            if (j2 < 3) { PU_GATHER(gA, eA); PU_IDX(eB, 2 * j2 + 3); }
            PU_COMPUTE(gB, pw1);
            *(u32x2*)(pp + 4 * j2) = (u32x2){pw0, pw1};
        }
#undef PU_IDX
#undef PU_GATHER
#undef PU_COMPUTE
    PEER_QUEUE_END
}
__device__ __forceinline__ void phase_peer_c(KP P, const Ctx& c, int layer, int row_lo) {
    const bf16_t* PART = (const bf16_t*)(P->ws + P_PART); const unsigned short* SE = (const unsigned short*)(P->ws + P_SE16); const float* SW = (const float*)(P->ws + WS_SELW);
    const float* ISU = (const float*)(P->ws + WS_PSC) + (size_t)layer * 16384; const float* ISV = ISU + (size_t)4 * 16384; bf16_t* C = (bf16_t*)(P->ws + P_C);
    unsigned pw[16]; unsigned short se0, se1; float w0, w1;
#define PC_LOAD(i_) do { const size_t t_ = (i_) >> 6; const int jj_ = (int)((i_) & 7), seg_ = (int)(((i_) >> 3) & 7); const unsigned* pp_ = (const unsigned*)(PART + ((t_ * 16) * 8 + seg_) * 16 + 2 * jj_); \
        _Pragma("unroll") for (int db = 0; db < 16; ++db) pw[db] = pp_[(size_t)db * 64]; \
        const size_t o_ = t_ * 128 + 16 * jj_ + seg_; se0 = SE[o_]; se1 = SE[o_ + 8]; w0 = SW[o_]; w1 = SW[o_ + 8]; } while (0)
    const size_t ibeg = (size_t)row_lo * 64 + c.gtid, iend = (size_t)T * 64;
    if (ibeg < iend) PC_LOAD(ibeg);
    for (size_t i = ibeg; i < iend; i += c.ngt) { const size_t t = i >> 6; const int jj = (int)(i & 7), seg = (int)((i >> 3) & 7);
        const size_t o0 = t * 128 + 16 * jj + seg, o1 = o0 + 8; const int e0 = se0 & 16383, e1 = se1 & 16383; const float cw0 = w0, cw1 = w1;
        const float iu0 = ISU[e0], iv0 = ISV[e0], iu1 = ISU[e1], iv1 = ISV[e1]; float s0 = 0.f, s1 = 0.f;
#pragma unroll
        for (int db = 0; db < 16; ++db) { const unsigned w = pw[db]; s0 += __builtin_bit_cast(float, w << 16); s1 += __builtin_bit_cast(float, w & 0xffff0000u); }
        if (i + c.ngt < iend) PC_LOAD(i + c.ngt);
        C[o0] = (bf16_t)(cvt_pk_bf16(cw0 * gelu_tanh(s0 * iu0) * iv0, 0.f) & 0xffffu);
        C[o1] = (bf16_t)(cvt_pk_bf16(cw1 * gelu_tanh(s1 * iu1) * iv1, 0.f) & 0xffffu); }
#undef PC_LOAD
}
__device__ __forceinline__ void phase_peer_v(KP P, const Ctx& c, int layer, int row_lo, int qrep) {
    const unsigned short* SE = (const unsigned short*)(P->ws + P_SE16); const bf16_t* C = (const bf16_t*)(P->ws + P_C);
    const unsigned char* V = P->ws + WS_PV + (size_t)layer * 16384 * D; bf16_t* Y = (bf16_t*)(P->ws + P_Y);
    PEER_QUEUE_BEGIN(layer * 2 + 1 + 8 * qrep, row_lo / 8, T / 8)
        int lane = c.lane; asm volatile("" : "+v"(lane));
        const int ts = lane >> 3, seg = lane & 7, t = tg * 8 + ts;
        const unsigned short* se = SE + (size_t)t * 128; const bf16_t* cp = C + (size_t)t * 128; const unsigned char* vb = V + (size_t)db * 16384 * 128; const unsigned seg16 = (unsigned)seg * 16u;
        float acc[16];
#pragma unroll
        for (int e = 0; e < 16; ++e) acc[e] = 0.f;
        u32x4 en[2];
#pragma unroll
        for (int i = 0; i < 2; ++i) en[i] = *(const u32x4*)(se + 8 * i);
#pragma unroll 1
        for (int q = 0; q < 8; ++q) { u32x4 ec[2];
#pragma unroll
          for (int i = 0; i < 2; ++i) ec[i] = en[i];
          if (q < 7) {
#pragma unroll
            for (int i = 0; i < 2; ++i) en[i] = *(const u32x4*)(se + 16 * (q + 1) + 8 * i); }
          const u32x4 c0 = *(const u32x4*)(cp + 16 * q), c1 = *(const u32x4*)(cp + 16 * q + 8);
          u32x4 g[16];
#pragma unroll
          for (int k = 0; k < 16; ++k) { const unsigned w_ = ec[k >> 3][(k >> 1) & 3]; const unsigned e = ((k & 1) ? (w_ >> 16) : w_) & 16383u; g[k] = *(const u32x4*)(vb + (unsigned)((e << 7) | seg16)); }
#pragma unroll
          for (int k = 0; k < 16; k += 2) { const unsigned cwu = (k < 8 ? c0 : c1)[(k >> 1) & 3]; const bf16v2 cw = __builtin_bit_cast(bf16v2, cwu);
#pragma unroll
              for (int w = 0; w < 4; ++w) { const unsigned g0 = g[k][w], g1 = g[k + 1][w];
                  const int pa = (int)__builtin_amdgcn_perm(g1, g0, 0x05010400u), pb = (int)__builtin_amdgcn_perm(g1, g0, 0x07030602u);
                  acc[4 * w + 0] = __builtin_amdgcn_fdot2_f32_bf16(__builtin_amdgcn_cvt_scalef32_pk_bf16_fp8(pa, 1.0f, false), cw, acc[4 * w + 0], false);
                  acc[4 * w + 1] = __builtin_amdgcn_fdot2_f32_bf16(__builtin_amdgcn_cvt_scalef32_pk_bf16_fp8(pa, 1.0f, true), cw, acc[4 * w + 1], false);
                  acc[4 * w + 2] = __builtin_amdgcn_fdot2_f32_bf16(__builtin_amdgcn_cvt_scalef32_pk_bf16_fp8(pb, 1.0f, false), cw, acc[4 * w + 2], false);
                  acc[4 * w + 3] = __builtin_amdgcn_fdot2_f32_bf16(__builtin_amdgcn_cvt_scalef32_pk_bf16_fp8(pb, 1.0f, true), cw, acc[4 * w + 3], false); } } }
        bf16_t* yp = Y + (size_t)t * D + db * 128 + seg * 16;
#pragma unroll
        for (int q = 0; q < 2; ++q) *(u32x4*)(yp + 8 * q) = (u32x4){cvt_pk_bf16(acc[8 * q], acc[8 * q + 1]), cvt_pk_bf16(acc[8 * q + 2], acc[8 * q + 3]), cvt_pk_bf16(acc[8 * q + 4], acc[8 * q + 5]), cvt_pk_bf16(acc[8 * q + 6], acc[8 * q + 7])};
    PEER_QUEUE_END
}
template <bool LAST>
__device__ __forceinline__ void phase_peer_final(KP P, const Ctx& c, int layer) {
    const bf16_t* Y = (const bf16_t*)(P->ws + P_Y); bf16_t* X = (bf16_t*)(P->ws + WS_X); bf16_t* A0 = (bf16_t*)(P->ws + WS_A0);
    const float* lg = P->in[I_LNG] + (size_t)(layer * 2 + 1) * D; const float* lb = P->in[I_LNB] + (size_t)(layer * 2 + 1) * D;
    const float ymul = ((DBG_ZERO >> (2 * layer + 1)) & 1) ? 0.f : 1.f;
    u32x2 xn[8]; u32x2 yn[8];
    f32x4 lg8[8], lb8[8];
#pragma unroll
    for (int j = 0; j < 8; ++j) { lg8[j] = *(const f32x4*)(lg + c.lane * 4 + 256 * j); lb8[j] = *(const f32x4*)(lb + c.lane * 4 + 256 * j); }
    { const int r0 = (LAST ? NCTX : 0) + c.gw; if (r0 < T) {
#pragma unroll
        for (int j = 0; j < 8; ++j) { xn[j] = *(const u32x2*)(X + (size_t)r0 * D + c.lane * 4 + 256 * j); yn[j] = *(const u32x2*)(Y + (size_t)r0 * D + c.lane * 4 + 256 * j); } } }
    f32x4 gt8[8]; int vprev = -1;
    for (int row = (LAST ? NCTX : 0) + c.gw; row < T; row += c.ngw) {
        int l4 = c.lane * 4; asm volatile("" : "+v"(l4));
        const int v = row_vec(row);
        if (v != vprev) { const float* m5 = modp(P, layer, v, 5) + l4; vprev = v;
#pragma unroll
            for (int j = 0; j < 8; ++j) gt8[j] = *(const f32x4*)(m5 + 256 * j); }
        f32x4 x[8]; float s = 0.f;
#pragma unroll
        for (int j = 0; j < 8; ++j) { const u32x2 yb = yn[j]; const f32x4 yv = (f32x4){bflo(yb.x), bfhi(yb.x), bflo(yb.y), bfhi(yb.y)};
            const unsigned x0 = xn[j].x, x1 = xn[j].y;
            x[j] = (f32x4){bflo(x0), bfhi(x0), bflo(x1), bfhi(x1)} * ALPHA + gt8[j] * (yv * ymul); s += (x[j][0] + x[j][1]) + (x[j][2] + x[j][3]); }
        if (row + c.ngw < T) {
#pragma unroll
            for (int j = 0; j < 8; ++j) { xn[j] = *(const u32x2*)(X + (size_t)(row + c.ngw) * D + l4 + 256 * j); yn[j] = *(const u32x2*)(Y + (size_t)(row + c.ngw) * D + l4 + 256 * j); } }
        const float mean = wave_sum(s) * (1.0f / D); float q = 0.f;
#pragma unroll
        for (int j = 0; j < 8; ++j) { x[j] = x[j] - mean; q += (x[j][0] * x[j][0] + x[j][1] * x[j][1]) + (x[j][2] * x[j][2] + x[j][3] * x[j][3]); }
        const float rstd = rsqrtf(wave_sum(q) * (1.0f / D) + LN_EPS);
        const bool mk_a0 = !LAST && layer != 0;
#pragma unroll
        for (int jh = 0; jh < 2; ++jh) { f32x4 g4[4], b4[4], p4[4], q4[4];
#pragma unroll
            for (int jj = 0; jj < 4; ++jj) { const int o = l4 + 256 * (4 * jh + jj); g4[jj] = lg8[4 * jh + jj]; b4[jj] = lb8[4 * jh + jj];
                if (mk_a0) { p4[jj] = *(const f32x4*)(modp(P, layer + 1, v, 1) + o); q4[jj] = *(const f32x4*)(modp(P, layer + 1, v, 0) + o); } }
#pragma unroll
            for (int jj = 0; jj < 4; ++jj) { const int j = 4 * jh + jj, o = l4 + 256 * j; const f32x4 y = x[j] * rstd * g4[jj] + b4[jj];
                if (LAST) { *(f32x4*)(P->out + (size_t)(row - NCTX) * D + o) = y; }
                else { *(u32x2*)(X + (size_t)row * D + o) = (u32x2){cvt_pk_bf16(y[0], y[1]), cvt_pk_bf16(y[2], y[3])};
                    if (mk_a0) { const f32x4 hv = y * (p4[jj] + 1.0f) + q4[jj];
                        *(u32x2*)(A0 + (size_t)row * D + o) = (u32x2){cvt_pk_bf16(hv[0], hv[1]), cvt_pk_bf16(hv[2], hv[3])}; } } } }
    }
}

__device__ __forceinline__ void phase_rw_mix(KP P, const Ctx& c, int layer) {
    const bf16_t* X = (const bf16_t*)(P->ws + WS_X); bf16_t* AALL = (bf16_t*)(P->ws + L_AALL); const float* mu = P->in[I_RWMU];
    float mu8[6][8];
    { const int c8 = (int)(c.gtid & 255) * 8;
#pragma unroll
      for (int m = 0; m < 6; ++m) { const f32x4 a = *(const f32x4*)(mu + m * D + c8), b = *(const f32x4*)(mu + m * D + c8 + 4);
#pragma unroll
          for (int j = 0; j < 4; ++j) { mu8[m][j] = a[j]; mu8[m][4 + j] = b[j]; } } }
    const int c8 = (int)(c.gtid & 255) * 8;
    u32x4 nx, nn; f32x4 nsh0, nsh1, nsc0, nsc1; int nnb;
#define MX_LOAD(i_) do { const int row_ = (int)((i_) >> 8); const int v_ = row_vec(row_); int nb_ = -1;     \
        if (row_ < NCTX) { const int t_ = row_ & (CTX - 1); if (c8 < 1024) { if (t_ > 0) nb_ = row_ - 1; } else { if (t_ < CTX - 1) nb_ = row_ + 1; } } \
        else { const int t_ = (row_ - NCTX) & (SEQ - 1), qd_ = c8 >> 9; \
            if (qd_ == 0) { if ((t_ & 63) != 0) nb_ = row_ - 1; } else if (qd_ == 1) { if ((t_ & 63) != 63) nb_ = row_ + 1; } \
            else if (qd_ == 2) { if (t_ >= 64) nb_ = row_ - 64; } else { if (t_ < SEQ - 64) nb_ = row_ + 64; } } \
        nx = *(const u32x4*)(X + (size_t)row_ * D + c8); nnb = nb_; \
        if (nb_ >= 0) nn = *(const u32x4*)(X + (size_t)nb_ * D + c8); \
        const float* sh_ = modp(P, layer, v_, 0) + c8; const float* sc_ = modp(P, layer, v_, 1) + c8; \
        nsh0 = *(const f32x4*)sh_; nsh1 = *(const f32x4*)(sh_ + 4); nsc0 = *(const f32x4*)sc_; nsc1 = *(const f32x4*)(sc_ + 4); } while (0)
    if ((size_t)c.gtid < TD / 8) MX_LOAD((size_t)c.gtid);
    for (size_t i = c.gtid; i < TD / 8; i += c.ngt) { const int row = (int)(i >> 8);
        float h[8], xx[8];
        { const int nb = nnb; float xv[8], nv[8]; unpack8(nx, xv); unpack8(nn, nv);
#pragma unroll
          for (int j = 0; j < 8; ++j) { const float scj = 1.0f + (j < 4 ? nsc0[j & 3] : nsc1[j & 3]), shj = j < 4 ? nsh0[j & 3] : nsh1[j & 3];
              h[j] = xv[j] * scj + shj;
              const float sv = nb >= 0 ? nv[j] * scj + shj : 0.f; xx[j] = sv - h[j]; } }
        if (i + c.ngt < TD / 8) MX_LOAD(i + c.ngt);
#pragma unroll
        for (int m = 0; m < 6; ++m) { float o[8];
#pragma unroll
            for (int j = 0; j < 8; ++j) o[j] = h[j] + xx[j] * mu8[m][j];
            *(u32x4*)(AALL + (size_t)row * (6 * D) + m * D + c8) = (u32x4){cvt_pk_bf16(o[0], o[1]), cvt_pk_bf16(o[2], o[3]), cvt_pk_bf16(o[4], o[5]), cvt_pk_bf16(o[6], o[7])}; } }
#undef MX_LOAD
}
__device__ __forceinline__ void phase_rw_scan(KP P, const Ctx& c) {
    const bf16_t* R = (const bf16_t*)(P->ws + L_RKV); const bf16_t* Kx = R + TD; const bf16_t* Vx = R + 2 * TD;
    const bf16_t* W = (const bf16_t*)(P->ws + L_W); const bf16_t* AD = (const bf16_t*)(P->ws + L_AD);
    LAS float* rL = (LAS float*)c.lds; LAS float* wL = rL + 4096; LAS float* kkL = rL + 8192; LAS float* bL = rL + 12288; LAS float* kdL = rL + 16384; LAS float* vL = rL + 20480; LAS float* yL = rL + 24576; LAS float* scL = rL + 28672;
    const int tok = c.tid >> 3, cq = c.tid & 7;
    for (int chain = blockIdx.x; chain < 256; chain += gridDim.x) {
        const int b = chain >> 6, hd = (chain >> 1) & 31, dir = chain & 1;
        bf16_t* Y = (bf16_t*)(P->ws + (dir ? L_Y1 : L_Y0));
        const int ch0 = hd * 64 + cq * 8;
        float kkw[8], kaw[8];
#pragma unroll
        for (int j = 0; j < 8; ++j) { kkw[j] = P->in[I_RWKK][ch0 + j]; kaw[j] = P->in[I_RWKA][ch0 + j]; }
        float s[8] = {0.f, 0.f, 0.f, 0.f, 0.f, 0.f, 0.f, 0.f};
        u32x4 gr, gk, gv, gw, ga;
#define RW_GLOAD(ck) do { const int row_ = seq_row(b, dir, (ck) * 64 + tok); gr = *(const u32x4*)(R + (size_t)row_ * D + ch0); gk = *(const u32x4*)(Kx + (size_t)row_ * D + ch0); gv = *(const u32x4*)(Vx + (size_t)row_ * D + ch0); \
        gw = *(const u32x4*)(W + ((size_t)row_ * 2 + dir) * D + ch0); ga = *(const u32x4*)(AD + ((size_t)row_ * 2 + dir) * D + ch0); } while (0)
        RW_GLOAD(0);
        for (int ck = 0; ck < SLEN / 64; ++ck) {
            const int row = seq_row(b, dir, ck * 64 + tok);
            float r8[8], k8[8], v8[8], w8[8], a8[8];
            unpack8(gr, r8); unpack8(gk, k8); unpack8(gv, v8); unpack8(gw, w8); unpack8(ga, a8);
            float kx[8], ss = 0.f;
#pragma unroll
            for (int j = 0; j < 8; ++j) { kx[j] = k8[j] * kkw[j]; ss += kx[j] * kx[j]; }
            ss = sum8(ss);
            const float rn = rsqrtf(ss + 1e-12f);
            __syncthreads();
            float pbr = 0.f, pkr = 0.f;
            {   float wr_[8], kk_[8], b_[8], kd_[8];
#pragma unroll
                for (int j = 0; j < 8; ++j) { kk_[j] = kx[j] * rn; b_[j] = kk_[j] * a8[j]; kd_[j] = k8[j] * (1.0f + (a8[j] - 1.0f) * kaw[j]); wr_[j] = w8[j] * r8[j]; pbr += b_[j] * r8[j]; pkr += kd_[j] * r8[j]; }
                const int o = tok * 64 + cq * 8;
#pragma unroll
                for (int hh = 0; hh < 2; ++hh) { const int q = 4 * hh;
                    *(LAS f32x4*)(rL + o + q) = (f32x4){wr_[q], wr_[q + 1], wr_[q + 2], wr_[q + 3]}; *(LAS f32x4*)(wL + o + q) = (f32x4){w8[q], w8[q + 1], w8[q + 2], w8[q + 3]};
                    *(LAS f32x4*)(kkL + o + q) = (f32x4){kk_[q], kk_[q + 1], kk_[q + 2], kk_[q + 3]}; *(LAS f32x4*)(bL + o + q) = (f32x4){b_[q], b_[q + 1], b_[q + 2], b_[q + 3]};
                    *(LAS f32x4*)(kdL + o + q) = (f32x4){kd_[q], kd_[q + 1], kd_[q + 2], kd_[q + 3]}; *(LAS f32x4*)(vL + o + q) = (f32x4){v8[q], v8[q + 1], v8[q + 2], v8[q + 3]}; } }
            pbr = sum8(pbr); pkr = sum8(pkr);
            if (cq == 0) *(LAS f32x2*)(scL + tok * 2) = (f32x2){pbr, pkr};
            __syncthreads();
            if (ck + 1 < SLEN / 64) RW_GLOAD(ck + 1);
            f32x4 kaA, kbA, waA, wbA, baA, bbA, daA, dbA, raA, rbA, kaB, kbB, waB, wbB, baB, bbB, daB, dbB, raB, rbB; float vvA, vvB; f32x2 scA, scB;
#define RW_LLOAD(X, tk_) do { const int o_ = (tk_) * 64 + cq * 8; ka##X = *(const LAS f32x4*)(kkL + o_); kb##X = *(const LAS f32x4*)(kkL + o_ + 4); wa##X = *(const LAS f32x4*)(wL + o_); wb##X = *(const LAS f32x4*)(wL + o_ + 4); \
                ba##X = *(const LAS f32x4*)(bL + o_); bb##X = *(const LAS f32x4*)(bL + o_ + 4); da##X = *(const LAS f32x4*)(kdL + o_); db##X = *(const LAS f32x4*)(kdL + o_ + 4); ra##X = *(const LAS f32x4*)(rL + o_); rb##X = *(const LAS f32x4*)(rL + o_ + 4); \
                vv##X = vL[(tk_) * 64 + tok]; sc##X = *(const LAS f32x2*)(scL + (tk_) * 2); } while (0)
#define RW_STEP(X, tk_) do { \
                float sa = (fma_s(s[0], ka##X[0], mul_s(s[1], ka##X[1])) + fma_s(s[2], ka##X[2], mul_s(s[3], ka##X[3]))) + (fma_s(s[4], kb##X[0], mul_s(s[5], kb##X[1])) + fma_s(s[6], kb##X[2], mul_s(s[7], kb##X[3]))); \
                float yd = (fma_s(s[0], ra##X[0], mul_s(s[1], ra##X[1])) + fma_s(s[2], ra##X[2], mul_s(s[3], ra##X[3]))) + (fma_s(s[4], rb##X[0], mul_s(s[5], rb##X[1])) + fma_s(s[6], rb##X[2], mul_s(s[7], rb##X[3]))); \
                sum8_pair(sa, yd); \
                const float nsa = -sa; \
                _Pragma("unroll") for (int j2 = 0; j2 < 4; ++j2) { s[j2] = fma_s(vv##X, da##X[j2], fma_s(nsa, ba##X[j2], mul_s(s[j2], wa##X[j2]))); s[4 + j2] = fma_s(vv##X, db##X[j2], fma_s(nsa, bb##X[j2], mul_s(s[4 + j2], wb##X[j2]))); } \
                if (cq == 0) yL[(tk_) * 64 + tok] = yd - sa * sc##X[0] + vv##X * sc##X[1]; } while (0)
            RW_LLOAD(A, 0);
#pragma unroll 1
            for (int tk = 0; tk < 64; tk += 2) {
                RW_LLOAD(B, tk + 1);
                RW_STEP(A, tk);
                RW_LLOAD(A, (tk + 2) & 63);
                RW_STEP(B, tk + 1);
            }
#undef RW_STEP
#undef RW_LLOAD
            __syncthreads();
            { const f32x4 ya = *(const LAS f32x4*)(yL + tok * 64 + cq * 8), yb = *(const LAS f32x4*)(yL + tok * 64 + cq * 8 + 4);
              *(u32x4*)(Y + (size_t)row * D + ch0) = (u32x4){cvt_pk_bf16(ya[0], ya[1]), cvt_pk_bf16(ya[2], ya[3]), cvt_pk_bf16(yb[0], yb[1]), cvt_pk_bf16(yb[2], yb[3])}; }
        }
#undef RW_GLOAD
        __syncthreads();
    }
}
__device__ __forceinline__ void phase_rw_finish(KP P, const Ctx& c) {
    const bf16_t* R = (const bf16_t*)(P->ws + L_RKV); const bf16_t* Kx = R + TD; const bf16_t* Vx = R + 2 * TD;
    const bf16_t* AD = (const bf16_t*)(P->ws + L_AD); const bf16_t* G = (const bf16_t*)(P->ws + L_G);
    const bf16_t* Y0 = (const bf16_t*)(P->ws + L_Y0); const bf16_t* Y1 = (const bf16_t*)(P->ws + L_Y1); bf16_t* Z = (bf16_t*)(P->ws + L_Z);
    const int ch = c.lane * 8 + 512 * (c.gw & 3);
    float ka8[8], rk8[8], gg8[8], gb8[8];
#pragma unroll
    for (int e = 0; e < 8; ++e) { ka8[e] = P->in[I_RWKA][ch + e]; rk8[e] = P->in[I_RWRK][ch + e]; gg8[e] = P->in[I_RWGNG][ch + e]; gb8[e] = P->in[I_RWGNB][ch + e]; }
    u32x4 ny0, ny1, nr, nk, nv, na0, na1, ng;
#define RF_LOAD(k_) do { const int row_ = (k_) >> 2; const size_t o_ = (size_t)row_ * D + ch; ny0 = *(const u32x4*)(Y0 + o_); ny1 = *(const u32x4*)(Y1 + o_); nr = *(const u32x4*)(R + o_); nk = *(const u32x4*)(Kx + o_); \
        nv = *(const u32x4*)(Vx + o_); na0 = *(const u32x4*)(AD + ((size_t)row_ * 2 + 0) * D + ch); na1 = *(const u32x4*)(AD + ((size_t)row_ * 2 + 1) * D + ch); ng = *(const u32x4*)(G + o_); } while (0)
    if (c.gw < T * 4) RF_LOAD(c.gw);
    for (int k = c.gw; k < T * 4; k += c.ngw) { const size_t o = (size_t)(k >> 2) * D + ch;
            float y[8]; { float ya_[8], yb_[8]; unpack8(ny0, ya_); unpack8(ny1, yb_);
#pragma unroll
                for (int e = 0; e < 8; ++e) y[e] = ya_[e] + yb_[e]; }
            float r8[8], k8[8], v8[8], a0[8], a1[8], g8[8];
            unpack8(nr, r8); unpack8(nk, k8); unpack8(nv, v8); unpack8(na0, a0); unpack8(na1, a1); unpack8(ng, g8);
            if (k + c.ngw < T * 4) RF_LOAD(k + c.ngw);
            float s = 0.f;
#pragma unroll
            for (int e = 0; e < 8; ++e) s += y[e];
            const float mean = sum8(s) * (1.0f / 64.0f); float q = 0.f;
#pragma unroll
            for (int e = 0; e < 8; ++e) { y[e] -= mean; q += y[e] * y[e]; }
            const float rstd = rsqrtf(sum8(q) * (1.0f / 64.0f) + 64e-5f);
            float bsum = 0.f;
#pragma unroll
            for (int e = 0; e < 8; ++e) { const float ka = ka8[e], rk = rk8[e];
                const float kd0 = k8[e] * (1.0f + (a0[e] - 1.0f) * ka), kd1 = k8[e] * (1.0f + (a1[e] - 1.0f) * ka); bsum += r8[e] * (kd0 + kd1) * rk; }
            bsum = sum8(bsum);
            float z[8];
#pragma unroll
            for (int e = 0; e < 8; ++e) z[e] = (y[e] * rstd * gg8[e] + gb8[e] + bsum * v8[e]) * g8[e];
            *(u32x4*)(Z + o) = (u32x4){cvt_pk_bf16(z[0], z[1]), cvt_pk_bf16(z[2], z[3]), cvt_pk_bf16(z[4], z[5]), cvt_pk_bf16(z[6], z[7])}; }
#undef RF_LOAD
}

__device__ __forceinline__ bf16x8 frag16(const LAS unsigned char* p) { return *(const LAS bf16x8*)p; }
__device__ __forceinline__ void phase_ret_scan(KP P, const Ctx& c) {
    const bf16_t* Q = (const bf16_t*)(P->ws + L_RQ); const bf16_t* Kx = (const bf16_t*)(P->ws + L_RK); const bf16_t* Vx = (const bf16_t*)(P->ws + L_RV);
    constexpr int QP = 528, TP = 144, VP = 272;
    constexpr int OFF_Q = 0, OFF_K = 33792, OFF_KT = 67584, OFF_VT = 104448, OFF_P = 122880;
    LAS unsigned char* L = c.lds;
    const int w = c.wave;
    for (int un = blockIdx.x; un < 256; un += gridDim.x) {
        const int b = un >> 6, h = (un >> 3) & 7, dir = (un >> 2) & 1, dvs = un & 3;
        bf16_t* O = (bf16_t*)(P->ws + (dir ? L_OB : L_OF));
        int tid = c.tid;
        const float gamma = 1.0f - exp2f(-5.0f - (float)h), lg2 = log2f(gamma), g63 = exp2f(63.0f * lg2);
        f32x4 Racc[16];
#pragma unroll
        for (int i = 0; i < 16; ++i) Racc[i] = (f32x4){0.f, 0.f, 0.f, 0.f};
        u32x4 pq[4], pv[2];
#define RET_LOAD_QV(ck) do { \
        _Pragma("unroll") for (int i = 0; i < 4; ++i) { const int id = tid + 512 * i, s_ = id >> 5, dc = id & 31; \
            pq[i] = *(const u32x4*)(Q + (size_t)seq_row(b, dir, (ck) * 64 + s_) * D + h * 256 + dc * 8); } \
        _Pragma("unroll") for (int i = 0; i < 2; ++i) { const int id = tid + 512 * i, s_ = id >> 4, ec = id & 15; \
            pv[i] = *(const u32x4*)(Vx + (size_t)seq_row(b, dir, (ck) * 64 + s_) * 4096 + h * 512 + dvs * 128 + ec * 8); } } while (0)
#define RET_LOAD_K(ck, dst) do { \
        _Pragma("unroll") for (int i = 0; i < 4; ++i) { const int id = tid + 512 * i, s_ = id >> 5, dc = id & 31; \
            dst[i] = *(const u32x4*)(Kx + (size_t)seq_row(b, dir, (ck) * 64 + s_) * D + h * 256 + dc * 8); } } while (0)
#define RET_STORE_K(src) do { \
        _Pragma("unroll") for (int i = 0; i < 4; ++i) { const int id = tid + 512 * i, s_ = id >> 5, dc = id & 31; *(LAS u32x4*)(L + OFF_K + s_ * QP + dc * 16) = src[i]; } } while (0)
        RET_LOAD_QV(0);
        { u32x4 pk0[4]; RET_LOAD_K(0, pk0); __syncthreads(); RET_STORE_K(pk0); }
        for (int ck = 0; ck < SLEN / 64; ++ck) {
            asm volatile("" : "+v"(tid));
            const int lane = tid & 63, r16 = lane & 15, q4 = lane >> 4;
            __syncthreads();
#pragma unroll
            for (int i = 0; i < 4; ++i) { const int id = tid + 512 * i, s_ = id >> 5, dc = id & 31; *(LAS u32x4*)(L + OFF_Q + s_ * QP + dc * 16) = pq[i]; }
#pragma unroll
            for (int i = 0; i < 2; ++i) { const int id = tid + 512 * i, s_ = id >> 4, ec = id & 15; *(LAS u32x4*)(L + OFF_P + s_ * VP + ec * 16) = pv[i]; }
            __syncthreads();
            if (ck + 1 < SLEN / 64) RET_LOAD_QV(ck + 1);
            {   const float vs = exp2f(-lg2 * (float)lane);
#pragma unroll
                for (int i = 0; i < 4; ++i) { const int dc = w + 8 * i;
                    const u32x4 raw = *(const LAS u32x4*)(L + OFF_K + lane * QP + dc * 16);
#pragma unroll
                    for (int e = 0; e < 4; ++e) { *(LAS unsigned short*)(L + OFF_KT + (dc * 8 + 2 * e) * TP + lane * 2) = (unsigned short)(raw[e] & 0xffffu); *(LAS unsigned short*)(L + OFF_KT + (dc * 8 + 2 * e + 1) * TP + lane * 2) = (unsigned short)(raw[e] >> 16); } }
#pragma unroll
                for (int i = 0; i < 2; ++i) { const int ec = w + 8 * i; float t8[8]; unpack8(*(const LAS u32x4*)(L + OFF_P + lane * VP + ec * 16), t8);
#pragma unroll
                    for (int e = 0; e < 4; ++e) { const unsigned pk2 = cvt_pk_bf16(t8[2 * e] * vs, t8[2 * e + 1] * vs);
                        *(LAS unsigned short*)(L + OFF_VT + (ec * 8 + 2 * e) * TP + lane * 2) = (unsigned short)(pk2 & 0xffffu); *(LAS unsigned short*)(L + OFF_VT + (ec * 8 + 2 * e + 1) * TP + lane * 2) = (unsigned short)(pk2 >> 16); } } }
            const int it_s = w >> 1, jt0 = 2 * (w & 1);
            f32x4 s0 = (f32x4){0.f, 0.f, 0.f, 0.f}, s1 = s0;
#pragma unroll
            for (int ks = 0; ks < 8; ++ks) { const int co = (32 * ks + 8 * q4) * 2; if ((ks & 1) == 0) asm volatile("" ::: "memory");
                const bf16x8 qf = frag16(L + OFF_Q + (16 * it_s + r16) * QP + co), k0 = frag16(L + OFF_K + (16 * jt0 + r16) * QP + co), k1 = frag16(L + OFF_K + (16 * jt0 + 16 + r16) * QP + co);
                s0 = __builtin_amdgcn_mfma_f32_16x16x32_bf16(k0, qf, s0, 0, 0, 0); s1 = __builtin_amdgcn_mfma_f32_16x16x32_bf16(k1, qf, s1, 0, 0, 0); }
            __syncthreads();
            {   const int i_ = 16 * it_s + r16; const float gi = exp2f(lg2 * (float)i_);
                const int j0 = 16 * jt0 + 4 * q4, j1 = j0 + 16; float p0[4], p1[4];
#pragma unroll
                for (int r = 0; r < 4; ++r) { p0[r] = (j0 + r <= i_) ? s0[r] * gi : 0.f; p1[r] = (j1 + r <= i_) ? s1[r] * gi : 0.f; }
                *(LAS u32x2*)(L + OFF_P + i_ * TP + j0 * 2) = (u32x2){cvt_pk_bf16(p0[0], p0[1]), cvt_pk_bf16(p0[2], p0[3])};
                *(LAS u32x2*)(L + OFF_P + i_ * TP + j1 * 2) = (u32x2){cvt_pk_bf16(p1[0], p1[1]), cvt_pk_bf16(p1[2], p1[3])}; }
            __syncthreads();
            u32x4 pkn[4]; const bool has_next = ck + 1 < SLEN / 64;
            if (has_next) RET_LOAD_K(ck + 1, pkn);
            const LAS unsigned char* vtp = L + OFF_VT + (16 * w + r16) * TP + (8 * q4) * 2;
#pragma unroll
            for (int it = 0; it < 4; ++it) { const int i_ = 16 * it + r16; f32x4 a = (f32x4){0.f, 0.f, 0.f, 0.f};
                asm volatile("" ::: "memory");
#pragma unroll
                for (int m = 0; m < 8; ++m) {
                    const u32x4 t = (u32x4){cvt_pk_bf16(Racc[2 * m][0], Racc[2 * m][1]), cvt_pk_bf16(Racc[2 * m][2], Racc[2 * m][3]), cvt_pk_bf16(Racc[2 * m + 1][0], Racc[2 * m + 1][1]), cvt_pk_bf16(Racc[2 * m + 1][2], Racc[2 * m + 1][3])};
                    const LAS unsigned char* qp = L + OFF_Q + i_ * QP + (32 * m + 4 * q4) * 2; const u32x2 lo = *(const LAS u32x2*)qp, hi = *(const LAS u32x2*)(qp + 32);
                    const u32x4 tq = (u32x4){lo.x, lo.y, hi.x, hi.y}; a = __builtin_amdgcn_mfma_f32_16x16x32_bf16(__builtin_bit_cast(bf16x8, t), __builtin_bit_cast(bf16x8, tq), a, 0, 0, 0); }
                a = a * exp2f(lg2 * (float)(i_ + 1));
#pragma unroll
                for (int ks = 0; ks < 2; ++ks) a = __builtin_amdgcn_mfma_f32_16x16x32_bf16(frag16(vtp + 64 * ks), frag16(L + OFF_P + i_ * TP + (32 * ks + 8 * q4) * 2), a, 0, 0, 0);
                *(u32x2*)(O + (size_t)seq_row(b, dir, ck * 64 + i_) * 4096 + h * 512 + dvs * 128 + 16 * w + 4 * q4) = (u32x2){cvt_pk_bf16(a[0], a[1]), cvt_pk_bf16(a[2], a[3])}; }
            if (has_next) RET_STORE_K(pkn);
#pragma unroll
            for (int dt = 0; dt < 16; ++dt) { if ((dt & 1) == 0) asm volatile("" ::: "memory");
                f32x4 u = Racc[dt] * gamma;
#pragma unroll
                for (int ks = 0; ks < 2; ++ks) u = __builtin_amdgcn_mfma_f32_16x16x32_bf16(frag16(L + OFF_KT + (16 * dt + r16) * TP + (32 * ks + 8 * q4) * 2), frag16(vtp + 64 * ks), u, 0, 0, 0);
                Racc[dt] = u * g63; }
        }
#undef RET_LOAD_QV
#undef RET_LOAD_K
#undef RET_STORE_K
        __syncthreads();
    }
}
__device__ __forceinline__ void phase_ret_merge(KP P, const Ctx& c) {
    const bf16_t* OF = (const bf16_t*)(P->ws + L_OF); const bf16_t* OB = (const bf16_t*)(P->ws + L_OB); const bf16_t* GF = (const bf16_t*)(P->ws + L_GF); const bf16_t* GB = (const bf16_t*)(P->ws + L_GB);
    bf16_t* Z = (bf16_t*)(P->ws + L_RZ);
    u32x4 nf, nb, ngf, ngb;
#define RM_LOAD(k_) do { const size_t o_ = (size_t)(k_) * 512 + c.lane * 8; nf = *(const u32x4*)(OF + o_); nb = *(const u32x4*)(OB + o_); ngf = *(const u32x4*)(GF + o_); ngb = *(const u32x4*)(GB + o_); } while (0)
    if (c.gw < T * 8) RM_LOAD(c.gw);
    for (int k = c.gw; k < T * 8; k += c.ngw) { const size_t o = (size_t)k * 512 + c.lane * 8;
            float f[8], bk[8], gf[8], gb[8]; unpack8(nf, f); unpack8(nb, bk); unpack8(ngf, gf); unpack8(ngb, gb);
            if (k + c.ngw < T * 8) RM_LOAD(k + c.ngw);
            float sf = 0.f, sb = 0.f;
#pragma unroll
            for (int e = 0; e < 8; ++e) { sf += f[e]; sb += bk[e]; }
            const float mf = wave_sum(sf) * (1.0f / 512.0f), mb = wave_sum(sb) * (1.0f / 512.0f); float qf = 0.f, qb = 0.f;
#pragma unroll
            for (int e = 0; e < 8; ++e) { f[e] -= mf; bk[e] -= mb; qf += f[e] * f[e]; qb += bk[e] * bk[e]; }
            const float rf = rsqrtf(wave_sum(qf) * (1.0f / 512.0f) + LN_EPS), rb = rsqrtf(wave_sum(qb) * (1.0f / 512.0f) + LN_EPS);
            float z[8];
#pragma unroll
            for (int e = 0; e < 8; ++e) z[e] = gf[e] * (f[e] * rf) + gb[e] * (bk[e] * rb);
            *(u32x4*)(Z + o) = (u32x4){cvt_pk_bf16(z[0], z[1]), cvt_pk_bf16(z[2], z[3]), cvt_pk_bf16(z[4], z[5]), cvt_pk_bf16(z[6], z[7])}; }
#undef RM_LOAD
}

__device__ __forceinline__ Ctx make_ctx(LAS unsigned char* lds) {
    int t = threadIdx.x; asm volatile("" : "+v"(t));
    Ctx c; c.lds = lds; c.tid = t; c.lane = t & 63; c.wave = __builtin_amdgcn_readfirstlane(t >> 6);
    c.gw = blockIdx.x * 8 + c.wave; c.ngw = gridDim.x * 8; c.gtid = blockIdx.x * 512 + t; c.ngt = gridDim.x * 512; return c;
}
#define GRID_BAR() xcd_barrier(bar)
template <class Epi, class GT> __device__ __forceinline__ void run_gemm_m(LAS unsigned char* lds, const GT& g, int M, int N, const Epi& E) {
    pg8::StaticOrder S; S.init(M, N, (int)gridDim.x, (int)blockIdx.x); pg8::gemm_phase<Epi, GT>(lds, g, S, E);
}
template <class Epi, class GT> __device__ __forceinline__ void run_gemm(LAS unsigned char* lds, const GT& g, int N, const Epi& E, int pm0 = 0) {
    pg8::StaticOrder S; S.init(T, N, (int)gridDim.x, (int)blockIdx.x, pm0); pg8::gemm_phase<Epi, GT>(lds, g, S, E);
}
template <int LAYER, bool LAST> __device__ __forceinline__ void peer_phases(LAS unsigned char* lds, const XcdBarrier& bar) {
    phase_ln_mid(kp_fresh(), make_ctx(lds), LAYER, LAST ? NCTX : 0); GRID_BAR();
    PROBE_REP(2) { KP P = kp_fresh(); unsigned char* ws = P->ws; GPlain g{(const bf16_t*)(ws + WS_H2), (const bf16_t*)(ws + WS_WQ) + (size_t)LAYER * D * D, D, D, D}; EpiF32Plain E{(float*)(ws + WS_S), D}; run_gemm(lds, g, D, E, LAST ? 4 : 0);
        if (!LAST && _rep == 0) { constexpr int NR = 8 * 16384, SH = (NR + 2) / 3; const int lo = LAYER * SH, hi = (LAYER == 2) ? NR : (LAYER + 1) * SH;
            if ((int)gridDim.x == 256) { if ((int)blockIdx.x >= 32) peer_convert_rows(kp_fresh(), make_ctx(lds), lo, hi, (int)blockIdx.x - 32, 224); }
            else peer_convert_rows(kp_fresh(), make_ctx(lds), lo, hi, (int)blockIdx.x, (int)gridDim.x); }
        GRID_BAR(); }
    PROBE_REP(1) { phase_peer_select(kp_fresh(), make_ctx(lds), LAST ? NCTX : 0); GRID_BAR(); }
    PROBE_REP(0) { phase_peer_u(kp_fresh(), make_ctx(lds), LAYER, LAST ? NCTX : 0, _rep); GRID_BAR(); }
    phase_peer_c(kp_fresh(), make_ctx(lds), LAYER, LAST ? NCTX : 0); GRID_BAR();
    PROBE_REP(9) { phase_peer_v(kp_fresh(), make_ctx(lds), LAYER, LAST ? NCTX : 0, _rep); GRID_BAR(); }
    phase_peer_final<LAST>(kp_fresh(), make_ctx(lds), LAYER); GRID_BAR();
}
template <int LAYER, int JL> __device__ __forceinline__ void rg_phases(LAS unsigned char* lds, const XcdBarrier& bar) {
    PROBE_REP(6) { KP P = kp_fresh(); unsigned char* ws = P->ws; GPlain g{(const bf16_t*)(ws + WS_A0), (const bf16_t*)(ws + WS_RGIN) + (size_t)JL * 4096 * D, D, D, D}; EpiRgIn E{(bf16_t*)(ws + L_UG), (bf16_t*)(ws + L_UR)}; run_gemm(lds, g, 4096, E); GRID_BAR(); }
    PROBE_REP(7) { phase_rg_conv(kp_fresh(), make_ctx(lds), JL); GRID_BAR(); }
    { KP P = kp_fresh(); unsigned char* ws = P->ws; GGate g{(const bf16_t*)(ws + L_XC), (const bf16_t*)(ws + WS_RGGATE) + (size_t)JL * 8192 * 256, 256, D, 256};
      EpiRgGate E{(const bf16_t*)(ws + L_XC), (bf16_t*)(ws + L_LA), (bf16_t*)(ws + L_BB), P->in[I_RGGB] + (size_t)JL * 4 * D, (const float*)(ws + WS_SPT) + (size_t)JL * 2 * D}; PROBE_REP(11) { run_gemm(lds, g, 8192, E); GRID_BAR(); } }
    PROBE_REP(3) { phase_rg_scan1(kp_fresh(), make_ctx(lds)); GRID_BAR();
    phase_rg_scan2(kp_fresh(), make_ctx(lds)); GRID_BAR();
    phase_rg_scan3<0>(kp_fresh(), make_ctx(lds)); GRID_BAR();
    phase_rg_scan3<1>(kp_fresh(), make_ctx(lds)); GRID_BAR(); }
    { KP P = kp_fresh(); unsigned char* ws = P->ws; GPlain g{(const bf16_t*)(ws + L_YIN), (const bf16_t*)(ws + WS_RGOUT) + (size_t)JL * D * D, D, D, D}; EpiBf16Plain E{(bf16_t*)(ws + WS_S), D}; run_gemm(lds, g, D, E, LAYER == 3 ? 4 : 0); } GRID_BAR();
}
template <int LAYER> __device__ __forceinline__ void rw_phases(LAS unsigned char* lds, const XcdBarrier& bar) {
    PROBE_REP(7) { phase_rw_mix(kp_fresh(), make_ctx(lds), LAYER); GRID_BAR(); }
    PROBE_REP(6) { KP P = kp_fresh(); unsigned char* ws = P->ws; GRw1 g{(const bf16_t*)(ws + L_AALL), (const bf16_t*)(ws + WS_RW1), D, 6 * D, D}; EpiRw1 E{(bf16_t*)(ws + L_RKV), (bf16_t*)(ws + L_A2)}; run_gemm(lds, g, 6912, E); GRID_BAR(); }
    { KP P = kp_fresh(); unsigned char* ws = P->ws; GRw2 g{(const bf16_t*)(ws + L_A2), (const bf16_t*)(ws + WS_RW2), 256, 768, 256}; EpiRw2 E{(bf16_t*)(ws + L_W), (bf16_t*)(ws + L_AD), (bf16_t*)(ws + L_G), P->in[I_RWDEC0], P->in[I_RWICL0]}; PROBE_REP(12) { run_gemm(lds, g, 10240, E); GRID_BAR(); } }
    PROBE_REP(4) { phase_rw_scan(kp_fresh(), make_ctx(lds)); GRID_BAR(); }
    PROBE_REP(7) { phase_rw_finish(kp_fresh(), make_ctx(lds)); GRID_BAR(); }
    { KP P = kp_fresh(); unsigned char* ws = P->ws; GPlain g{(const bf16_t*)(ws + L_Z), (const bf16_t*)(ws + WS_RWO), D, D, D}; EpiBf16Plain E{(bf16_t*)(ws + WS_S), D}; run_gemm(lds, g, D, E); } GRID_BAR();
}
template <int LAYER> __device__ __forceinline__ void ret_phases(LAS unsigned char* lds, const XcdBarrier& bar) {
    { KP P = kp_fresh(); unsigned char* ws = P->ws; GPlain g{(const bf16_t*)(ws + WS_A0), (const bf16_t*)(ws + WS_RETIN), D, D, D};
      EpiRetIn E{(bf16_t*)(ws + L_RQ), (bf16_t*)(ws + L_RK), (bf16_t*)(ws + L_RV), (bf16_t*)(ws + L_GF), (bf16_t*)(ws + L_GB), (const float*)(ws + WS_CS)}; PROBE_REP(10) { run_gemm(lds, g, 16384, E); GRID_BAR(); } }
    PROBE_REP(5) { phase_ret_scan(kp_fresh(), make_ctx(lds)); GRID_BAR(); }
    PROBE_REP(7) { phase_ret_merge(kp_fresh(), make_ctx(lds)); GRID_BAR(); }
    { KP P = kp_fresh(); unsigned char* ws = P->ws; GPlain g{(const bf16_t*)(ws + L_RZ), (const bf16_t*)(ws + WS_RETOUT), 4096, 4096, 4096}; EpiBf16Plain E{(bf16_t*)(ws + WS_S), D}; run_gemm(lds, g, D, E); } GRID_BAR();
}

__global__ void __launch_bounds__(512, 2) hybrid_fwd(Params Pkernarg) {
    extern __shared__ __attribute__((aligned(16))) unsigned char lds_raw[];
    LAS unsigned char* lds = (LAS unsigned char*)lds_raw;
    volatile LAS unsigned* MISC = (volatile LAS unsigned*)(lds + MISC_OFF);
    if (threadIdx.x < 64) MISC[threadIdx.x] = 0u;
    __syncthreads();
    XcdBarrier bar = xcd_barrier_post((unsigned*)(kp_fresh()->ws + WS_CTL) + 4096, MISC + 8);

    if ((PROBE >> 13) & 1) { for (int i = 0; i < 64; ++i) GRID_BAR(); }
    PROBE_REP(8) { phase_prologue(kp_fresh(), make_ctx(lds)); GRID_BAR(); }
    { KP P = kp_fresh(); unsigned char* ws = P->ws; GFold g{(const bf16_t*)(ws + WS_KEYS), (const bf16_t*)(ws + WS_WQN), 256, 256, D}; EpiBf16Plain E{(bf16_t*)(ws + WS_WQ), D}; run_gemm_m(lds, g, 4 * D, D, E); }
    phase_modfin(kp_fresh(), make_ctx(lds)); GRID_BAR();
    phase_xinit(kp_fresh(), make_ctx(lds)); GRID_BAR();
    rg_phases<0, 0>(lds, bar);  peer_phases<0, false>(lds, bar);
    rw_phases<1>(lds, bar);     peer_phases<1, false>(lds, bar);
    ret_phases<2>(lds, bar);    peer_phases<2, false>(lds, bar);
    rg_phases<3, 1>(lds, bar);  peer_phases<3, true>(lds, bar);
}

extern "C" void kernel_launch(void* const* d_in, const int* in_sizes, int n_in, void* d_out, int out_size, void* d_ws, size_t ws_size, hipStream_t stream) {
    static int grid = 0;
    if (!grid) {
        if (n_in != 37 || ws_size < WS_END) { fprintf(stderr, "kernel_launch: unexpected problem (n_in %d, ws %zu)\n", n_in, ws_size); grid = -1; return; }
        int dev = 0, cus = 0, per_cu = 0;
        if (hipGetDevice(&dev) != hipSuccess || hipDeviceGetAttribute(&cus, hipDeviceAttributeMultiprocessorCount, dev) != hipSuccess) { grid = -1; return; }
        if (hipFuncSetAttribute((const void*)hybrid_fwd, hipFuncAttributeMaxDynamicSharedMemorySize, LDS_BYTES) != hipSuccess) { fprintf(stderr, "kernel_launch: hipFuncSetAttribute failed\n"); grid = -1; return; }
        if (hipOccupancyMaxActiveBlocksPerMultiprocessor(&per_cu, (const void*)hybrid_fwd, 512, LDS_BYTES) != hipSuccess || per_cu < 1) { fprintf(stderr, "kernel_launch: occupancy query says %d\n", per_cu); grid = -1; return; }
        grid = cus;
    }
    if (grid <= 0) return;
    hipMemsetAsync((char*)d_ws + WS_CTL, 0, CTL_BYTES, stream);
    Params p; memset(&p, 0, sizeof(p));
    for (int i = 0; i < 37; ++i) p.in[i] = (const float*)d_in[i];
    p.out = (float*)d_out; p.ws = (unsigned char*)d_ws;
    hipLaunchKernelGGL(hybrid_fwd, dim3(grid), dim3(512), LDS_BYTES, stream, p);
}
```
